# Optimizing an MI355X kernel written in HIP

```python
import jax, jax.numpy as jnp
from jax import lax
import numpy as np

D_MODEL = 1024
BATCH = 4
SEQ = 8192
DEPTH = 2

HG_HEADS = 4
HG_DK = 128
HG_DV = 128
HG_W = HG_HEADS * HG_DK
HG_CHUNK = 64
GM_GROUPS = 4
GM_CHUNK = 128
GM_W = 512
GM_DG = GM_W // GM_GROUPS
SB_HEADS = 8
SB_DH = 64
SB_W = SB_HEADS * SB_DH
SB_BLOCK = 128
N_BRANCH = 3
BRANCH_W = 512
D_FF = 3584
N_EXPERTS = 8
TOP_K = 2
MOE_BLOCK = 256
N_DENSE = (DEPTH + 1) // 2
N_MOE = DEPTH // 2
EPS = 1e-6
IN_SIZES = (HG_W, HG_W, HG_W, HG_W, GM_W, GM_W, SB_W, SB_W, SB_W, N_BRANCH * D_MODEL)
IN_COLS = 4 * HG_W + 2 * GM_W + 3 * SB_W + N_BRANCH * D_MODEL

kernel_name = "hybrid_hgrn2_gmlp_stickbreak_moe"


def rms_norm(x, g):
    xf = x.astype(jnp.float32)
    y = xf * lax.rsqrt(jnp.mean(xf * xf, axis=-1, keepdims=True) + EPS)
    return (y * g.astype(jnp.float32)).astype(x.dtype)


def split_cols(p):
    idx, acc = [], 0
    for s in IN_SIZES[:-1]:
        acc += s
        idx.append(acc)
    return jnp.split(p, idx, axis=-1)


def hgrn2_chunked(q, k, v, log_f):
    B, S, H, DK = q.shape
    DV = v.shape[-1]
    C = HG_CHUNK
    n = S // C

    def to_chunks(a):
        return a.reshape(B, n, C, H, a.shape[-1]).transpose(1, 0, 3, 2, 4)

    qs, ks, vs, gs = to_chunks(q), to_chunks(k), to_chunks(v), to_chunks(log_f)
    causal = jnp.tril(jnp.ones((C, C), bool))[:, :, None]

    def step(state, inp):
        qc, kc, vc, gc = inp
        G = jnp.cumsum(gc, axis=2)
        diff = G[:, :, :, None, :] - G[:, :, None, :, :]
        decay = jnp.exp(jnp.where(causal, diff, -jnp.inf))
        scores = jnp.einsum('bhtd,bhtsd,bhsd->bhts', qc, decay, kc)
        o = (jnp.einsum('bhts,bhsv->bhtv', scores, vc)
             + jnp.einsum('bhtd,bhdv->bhtv', qc * jnp.exp(G), state))
        G_last = G[:, :, -1]
        state = (jnp.exp(G_last)[..., None] * state
                 + jnp.einsum('bhsd,bhsv->bhdv', kc * jnp.exp(G_last[:, :, None] - G), vc))
        return state, o

    s0 = jnp.zeros((B, H, DK, DV), jnp.float32)
    _, o = lax.scan(step, s0, (qs, ks, vs, gs))
    return o.transpose(1, 0, 3, 2, 4).reshape(B, S, H, DV)


def chunk_gmlp(u, v, w_s, b_s, g_v):
    B, S, _ = u.shape
    u = jax.nn.gelu(u)
    v = rms_norm(jax.nn.gelu(v), g_v)
    vr = v.reshape(B, S // GM_CHUNK, GM_CHUNK, GM_GROUPS, GM_DG)
    w_masked = w_s * jnp.tril(jnp.ones((GM_CHUNK, GM_CHUNK), w_s.dtype))[None]
    mix = jnp.einsum('gts,bnsgd->bntgd', w_masked, vr) + b_s.T[None, None, :, :, None]
    return u * mix.reshape(B, S, GM_W)


def stick_breaking_attention(q, k, v):
    S = q.shape[1]
    scale = SB_DH ** -0.5
    outs = []
    for blk in range(S // SB_BLOCK):
        t0, t1 = blk * SB_BLOCK, (blk + 1) * SB_BLOCK
        z = jnp.einsum('bthd,bshd->bhts', q[:, t0:t1], k[:, :t1]).astype(jnp.float32) * scale
        causal = jnp.arange(t1)[None, :] < jnp.arange(t0, t1)[:, None]
        log_keep = jnp.where(causal, jax.nn.log_sigmoid(-z), 0.0)
        suffix = lax.cumsum(log_keep, axis=3, reverse=True) - log_keep
        A = jnp.where(causal, jnp.exp(jax.nn.log_sigmoid(z) + suffix), 0.0)
        outs.append(jnp.einsum('bhts,bshd->bthd', A.astype(v.dtype), v[:, :t1]))
    return jnp.concatenate(outs, axis=1)


def swiglu(h, w_gate, w_up, w_down):
    return (jax.nn.silu(h @ w_gate) * (h @ w_up)) @ w_down


def moe_swiglu(h, w_router, b_router, w_gate, w_up, w_down):
    B, S, D = h.shape
    N = B * S
    NK = N * TOP_K
    hf = h.reshape(N, D)
    logits = hf.astype(jnp.float32) @ w_router.astype(jnp.float32) + b_router.astype(jnp.float32)
    top_logit, top_idx = lax.top_k(logits, TOP_K)
    top_w = jax.nn.softmax(top_logit, axis=-1)
    e_flat = top_idx.reshape(-1)
    tok_flat = jnp.repeat(jnp.arange(N, dtype=jnp.int32), TOP_K)
    w_flat = top_w.reshape(-1)
    order = jnp.argsort(e_flat)
    e_s, tok_s, w_s = e_flat[order], tok_flat[order], w_flat[order]
    counts = jnp.bincount(e_flat, length=N_EXPERTS)
    padded = (counts + MOE_BLOCK - 1) // MOE_BLOCK * MOE_BLOCK
    start = jnp.cumsum(counts) - counts
    pend = jnp.cumsum(padded)
    pstart = pend - padded
    slot = pstart[e_s] + jnp.arange(NK) - start[e_s]
    n_blocks = (NK + MOE_BLOCK - 1) // MOE_BLOCK + N_EXPERTS
    n_slots = n_blocks * MOE_BLOCK
    slot_tok = jnp.full((n_slots,), N, jnp.int32).at[slot].set(tok_s)
    block_expert = jnp.minimum(
        jnp.searchsorted(pend, jnp.arange(n_blocks) * MOE_BLOCK, side='right'), N_EXPERTS - 1)
    xs = jnp.concatenate([hf, jnp.zeros((1, D), hf.dtype)], axis=0)[slot_tok]
    xs = xs.reshape(n_blocks, MOE_BLOCK, D)

    def expert_block(args):
        xb, e = args
        return swiglu(xb, w_gate[e], w_up[e], w_down[e])

    ys = lax.map(expert_block, (xs, block_expert)).reshape(n_slots, D)
    y = jnp.zeros((N, D), h.dtype).at[tok_s].add(ys[slot] * w_s[:, None].astype(h.dtype))
    return y.reshape(B, S, D)


def setup_inputs(seed: int = 0) -> dict:
    key = jax.random.key(seed)
    ks = jax.random.split(key, 24)
    f32 = jnp.float32
    nrm = lambda k, shape, scale: jax.random.normal(k, shape, f32) * scale
    gain = lambda k, shape: 1.0 + 0.02 * jax.random.normal(k, shape, f32)
    return {
        "x": nrm(ks[0], (BATCH, SEQ, D_MODEL), 1.0),
        "norm_mix": gain(ks[1], (DEPTH, D_MODEL)),
        "w_in": nrm(ks[2], (DEPTH, D_MODEL, IN_COLS), D_MODEL ** -0.5),
        "hgrn_lower_bound": nrm(ks[3], (DEPTH, HG_W), 1.0),
        "hgrn_out_norm": gain(ks[4], (DEPTH, HG_DV)),
        "gmlp_v_norm": gain(ks[5], (DEPTH, GM_W)),
        "gmlp_w_s": nrm(ks[6], (DEPTH, GM_GROUPS, GM_CHUNK, GM_CHUNK), GM_CHUNK ** -0.5),
        "gmlp_b_s": gain(ks[7], (DEPTH, GM_GROUPS, GM_CHUNK)),
        "sb_q_norm": gain(ks[8], (DEPTH, SB_DH)),
        "sb_k_norm": gain(ks[9], (DEPTH, SB_DH)),
        "w_branch": nrm(ks[10], (DEPTH, N_BRANCH, BRANCH_W, D_MODEL), BRANCH_W ** -0.5),
        "w_out": nrm(ks[11], (DEPTH, D_MODEL, D_MODEL), D_MODEL ** -0.5),
        "norm_ffn": gain(ks[12], (DEPTH, D_MODEL)),
        "ffn_w_gate": nrm(ks[13], (N_DENSE, D_MODEL, D_FF), D_MODEL ** -0.5),
        "ffn_w_up": nrm(ks[14], (N_DENSE, D_MODEL, D_FF), D_MODEL ** -0.5),
        "ffn_w_down": nrm(ks[15], (N_DENSE, D_FF, D_MODEL), D_FF ** -0.5),
        "router_w": nrm(ks[16], (N_MOE, D_MODEL, N_EXPERTS), D_MODEL ** -0.5),
        "router_b": nrm(ks[17], (N_MOE, N_EXPERTS), 0.01),
        "moe_w_gate": nrm(ks[18], (N_MOE, N_EXPERTS, D_MODEL, D_FF), D_MODEL ** -0.5),
        "moe_w_up": nrm(ks[19], (N_MOE, N_EXPERTS, D_MODEL, D_FF), D_MODEL ** -0.5),
        "moe_w_down": nrm(ks[20], (N_MOE, N_EXPERTS, D_FF, D_MODEL), D_FF ** -0.5),
    }


def reference(x, norm_mix, w_in, hgrn_lower_bound, hgrn_out_norm, gmlp_v_norm, gmlp_w_s, gmlp_b_s,
              sb_q_norm, sb_k_norm, w_branch, w_out, norm_ffn, ffn_w_gate, ffn_w_up, ffn_w_down,
              router_w, router_b, moe_w_gate, moe_w_up, moe_w_down):
    B, S, D = x.shape
    dt = x.dtype
    lb_p = jax.nn.softmax(hgrn_lower_bound.astype(jnp.float32), axis=0)
    lower_bounds = jnp.cumsum(lb_p, axis=0) - lb_p[0:1]
    for l in range(DEPTH):
        xn = rms_norm(x, norm_mix[l])
        p = xn @ w_in[l]
        hq, hf, hi, hg, gu, gv, sq, sk, sv, gates = split_cols(p)

        lb = lower_bounds[l]
        f = lb + (1.0 - lb) * jax.nn.sigmoid(hf.astype(jnp.float32))
        to_heads = lambda a, d: a.reshape(B, S, HG_HEADS, d)
        oa = hgrn2_chunked(to_heads(jax.nn.silu(hq.astype(jnp.float32)), HG_DK),
                           to_heads(1.0 - f, HG_DK),
                           to_heads(hi.astype(jnp.float32), HG_DV),
                           to_heads(jnp.log(f), HG_DK))
        oa = rms_norm(oa, hgrn_out_norm[l]).reshape(B, S, HG_HEADS * HG_DV).astype(dt) * jax.nn.silu(hg)

        ob = chunk_gmlp(gu, gv, gmlp_w_s[l], gmlp_b_s[l], gmlp_v_norm[l])

        qh = rms_norm(sq.reshape(B, S, SB_HEADS, SB_DH), sb_q_norm[l])
        kh = rms_norm(sk.reshape(B, S, SB_HEADS, SB_DH), sb_k_norm[l])
        vh = sv.reshape(B, S, SB_HEADS, SB_DH)
        oc = stick_breaking_attention(qh, kh, vh).reshape(B, S, SB_W)

        o_cat = jnp.stack([oa, ob.astype(dt), oc.astype(dt)], axis=2)
        h = jnp.einsum('bsnc,ncd->bsnd', o_cat, w_branch[l])
        g = jax.nn.sigmoid(gates.reshape(B, S, N_BRANCH, D))
        x = x + jnp.sum(g * h, axis=2) @ w_out[l]

        xn2 = rms_norm(x, norm_ffn[l])
        if l % 2 == 0:
            i = l // 2
            x = x + swiglu(xn2, ffn_w_gate[i], ffn_w_up[i], ffn_w_down[i])
        else:
            i = l // 2
            x = x + moe_swiglu(xn2, router_w[i], router_b[i], moe_w_gate[i], moe_w_up[i], moe_w_down[i])
    return x
```

```cpp
#include <hip/hip_runtime.h>
#include <cstdio>
#include <cstdint>
#include <cstddef>

#define LAS __attribute__((address_space(3)))
#define XB_TMO      128
#define XB_XCNT(j)  (256  + 64 * (j))
#define XB_XSUB(j)  (1280 + 64 * (j))
#define XB_XGEN(j)  (2304 + 64 * (j))
#define XB_TOP      3328
#define XB_TOPGEN   3392
#define XCD_BAR_WORDS 3456
#define XB_SPIN_CAP (1u << 18)

__device__ __forceinline__ unsigned xb_ld(unsigned* p)              { return __hip_atomic_load(p, __ATOMIC_RELAXED, __HIP_MEMORY_SCOPE_AGENT); }
__device__ __forceinline__ unsigned xb_add(unsigned* p, unsigned v) { return __hip_atomic_fetch_add(p, v, __ATOMIC_RELAXED, __HIP_MEMORY_SCOPE_AGENT); }
__device__ __forceinline__ unsigned xb_xcc_id() { return (unsigned)__builtin_amdgcn_s_getreg((3 << 11) | 20) & 0xFu; }
#define XB_SPIN(cond, bar) do { unsigned _sp = 0; while (cond) { __builtin_amdgcn_s_sleep(1); \
    if ((++_sp & 255u) == 0u) { if (xb_ld(&(bar)[XB_TMO])) break; if (_sp > XB_SPIN_CAP) { atomicAdd(&(bar)[XB_TMO], 1u); break; } } } } while (0)

struct XcdBarrier {
    unsigned* bar; unsigned x;
    volatile LAS unsigned* st;
};

__device__ __forceinline__ XcdBarrier xcd_barrier_post(unsigned* bar, volatile LAS unsigned* st) {
    XcdBarrier b; b.bar = bar; b.x = xb_xcc_id(); b.st = st;
    if (threadIdx.x == 0) (void)xb_add(&bar[XB_XCNT(b.x)], 1u);
    return b;
}
__device__ __forceinline__ void xcd_barrier_complete(unsigned* bar, unsigned x, unsigned& nloc, unsigned& nx) {
    const unsigned G = gridDim.x * gridDim.y * gridDim.z;
    unsigned sum, cnt, mine, sp = 0u;
    for (;;) {
        sum = 0u; cnt = 0u; mine = 0u;
#pragma unroll
        for (unsigned j = 0; j < 16; ++j) { const unsigned c = xb_ld(&bar[XB_XCNT(j)]); sum += c; cnt += (c > 0u) ? 1u : 0u; mine = (j == x) ? c : mine; }
        if (sum == G) break;
        __builtin_amdgcn_s_sleep(1);
        if ((++sp & 255u) == 0u) { if (xb_ld(&bar[XB_TMO])) break; if (sp > XB_SPIN_CAP) { atomicAdd(&bar[XB_TMO], 1u); break; } }
    }
    nloc = mine > 0u ? mine : 1u; nx = cnt > 0u ? cnt : 1u;
}

__device__ __forceinline__ void xcd_barrier(const XcdBarrier& b) {
    asm volatile("s_waitcnt vmcnt(0)" ::: "memory");
    __syncthreads();
    if (threadIdx.x == 0) {
        unsigned* bar = b.bar;
        __builtin_amdgcn_s_waitcnt(0);
        unsigned nloc = b.st[0], nx = b.st[1];
        if (nloc == 0u) { xcd_barrier_complete(bar, b.x, nloc, nx); b.st[0] = nloc; b.st[1] = nx; }
        const unsigned old = xb_add(&bar[XB_XSUB(b.x)], 1u);
        const unsigned gen = old / nloc;
        if (old + 1u == (gen + 1u) * nloc) {
            __builtin_amdgcn_fence(__ATOMIC_RELEASE, "agent");
            asm volatile("s_waitcnt vmcnt(0)" ::: "memory");
            const unsigned og = xb_add(&bar[XB_TOP], 1u);
            const unsigned tg = og / nx;
            if (og + 1u == (tg + 1u) * nx) xb_add(&bar[XB_TOPGEN], 1u);
            else XB_SPIN(xb_ld(&bar[XB_TOPGEN]) == tg, bar);
            __builtin_amdgcn_fence(__ATOMIC_ACQUIRE, "agent");
            xb_add(&bar[XB_XGEN(b.x)], 1u);
            asm volatile("s_waitcnt vmcnt(0)" ::: "memory");
        } else {
            XB_SPIN(xb_ld(&bar[XB_XGEN(b.x)]) == gen, bar);
            __builtin_amdgcn_fence(__ATOMIC_ACQUIRE, "agent");
            asm volatile("s_waitcnt vmcnt(0)" ::: "memory");
        }
    }
    __syncthreads();
}
namespace pg8 {
#define PG8_LAS __attribute__((address_space(3)))
typedef unsigned short bf16_t;
typedef short bf16x8 __attribute__((ext_vector_type(8)));
typedef float f32x4 __attribute__((ext_vector_type(4)));
typedef unsigned u32x4 __attribute__((ext_vector_type(4)));
constexpr int BM = 256, BK = 64, HALF = 128, HTB = HALF * BK * 2  , STAGE_BYTES = 8 * HTB, NXCD = 8, WGM = 8;

__host__ __device__ __forceinline__ int lds_byte(int r, int c) { const int st = (r >> 4) * 2 + (c >> 5), rr = r & 15, cc = c & 31, ob = rr * 64 + cc * 2; return st * 1024 + (ob ^ (((ob >> 9) & 1) << 5)); }
__host__ __device__ __forceinline__ void stage_rc(int b, int& R, int& C) { const int st = b / 1024, sb = b % 1024, swz = sb ^ (((sb >> 9) & 1) << 5); R = (st >> 1) * 16 + swz / 64; C = (st & 1) * 32 + (swz % 64) / 2; }
__host__ __device__ __forceinline__ int perm32(int rho) { const int n = rho >> 4, i = rho & 15; return 8 * (i >> 2) + 4 * n + (i & 3); }

struct Unit { int pm, pn; const char* a; const char* b; };

typedef float f32x2 __attribute__((ext_vector_type(2))); typedef __bf16 bf16x2_t __attribute__((ext_vector_type(2)));
__device__ __forceinline__ unsigned cvt_pk_bf16(float lo, float hi) { f32x2 v = {lo, hi}; bf16x2_t b = __builtin_convertvector(v, bf16x2_t); return __builtin_bit_cast(unsigned, b); }
template <class Epi, class Sched, bool ALIGN_EPI = false, bool SP2 = false>
__device__ __forceinline__ void gemm_phase(PG8_LAS unsigned char* lds, const int K, const Sched& S, const Epi& E) {
    int tid = threadIdx.x; asm volatile("" : "+v"(tid));
    const int wid = __builtin_amdgcn_readfirstlane(tid >> 6), lane = tid & 63, wr = wid >> 2, wc = wid & 3, fr = lane & 15, fq = lane >> 4;
    const int nt = K / BK;
    unsigned voffA[2], voffB[2];
#pragma unroll
    for (int i = 0; i < 2; ++i) { int R, C; stage_rc(tid * 16 + i * 8192, R, C); const int Rb = Epi::PERM ? ((R & ~31) + perm32(R & 31)) : R;
        voffA[i] = (unsigned)(R * K + C) * 2u; voffB[i] = (unsigned)(Rb * K + C) * 2u; }
    const size_t kstep = (size_t)(BK * 2);
    const size_t hstep = (size_t)HALF * K * 2;
    const unsigned ldsw = (unsigned)wid * 1024u;
    const int aoff = lds_byte(wr * 64 + fr, fq * 8), boff = lds_byte(wc * 32 + fr, fq * 8);
#define PG8_SA(b, h) (((b) * 2 + (h)) * HTB)
#define PG8_SB(b, h) ((4 + (b) * 2 + (h)) * HTB)
#define PG8_STAGE(bufoff, gbase, voff) do { _Pragma("unroll") for (int _i = 0; _i < 2; ++_i) \
        __builtin_amdgcn_global_load_lds((const unsigned*)((const char*)(gbase) + (voff)[_i]), (PG8_LAS unsigned*)(lds + (bufoff) + ldsw + _i * 8192), 16, 0, 0); } while (0)
#define PG8_LDA(dst, b, h) do { _Pragma("unroll") for (int m = 0; m < 4; ++m) _Pragma("unroll") for (int k = 0; k < 2; ++k) dst[m][k] = *(const PG8_LAS bf16x8*)(lds + PG8_SA(b, h) + aoff + m * 2048 + k * 1024); } while (0)
#define PG8_LDB(dst, b, h) do { _Pragma("unroll") for (int n = 0; n < 2; ++n) _Pragma("unroll") for (int k = 0; k < 2; ++k) dst[n][k] = *(const PG8_LAS bf16x8*)(lds + PG8_SB(b, h) + boff + n * 2048 + k * 1024); } while (0)
#define PG8_MMA(ai, bj, At, Bt) do { __builtin_amdgcn_s_setprio(1); _Pragma("unroll") for (int m = 0; m < 4; ++m) _Pragma("unroll") for (int n = 0; n < 2; ++n) _Pragma("unroll") for (int k = 0; k < 2; ++k) \
        acc[ai][bj][m][n] = __builtin_amdgcn_mfma_f32_16x16x32_bf16(Bt[n][k], At[m][k], acc[ai][bj][m][n], 0, 0, 0); __builtin_amdgcn_s_setprio(0); } while (0)
#define PG8_WAIT_V(n) asm volatile("s_waitcnt vmcnt(" #n ")" ::: "memory")
#define PG8_WAIT_L(n) asm volatile("s_waitcnt lgkmcnt(" #n ")" ::: "memory")
#define PG8_BAR __builtin_amdgcn_s_barrier()
#define PG8_SCHED __builtin_amdgcn_sched_barrier(0)
    Unit cur, nxt; int ui = 0;
    if (!S.next(0, cur)) return;
    f32x4 acc[2][2][4][2];
#pragma unroll
    for (int a = 0; a < 2; ++a)
#pragma unroll
        for (int b = 0; b < 2; ++b)
#pragma unroll
            for (int m = 0; m < 4; ++m)
#pragma unroll
                for (int n = 0; n < 2; ++n) acc[a][b][m][n] = (f32x4){0.f, 0.f, 0.f, 0.f};
    bf16x8 At[4][2], B0[2][2], B1[2][2];
    const char* cA = cur.a; const char* cB = cur.b;
    S.a_ready(cur);
    if constexpr (SP2) {
        PG8_STAGE(PG8_SB(0, 0), cB, voffB); PG8_STAGE(PG8_SB(0, 1), cB + hstep, voffB); PG8_STAGE(PG8_SA(0, 0), cA, voffA); PG8_STAGE(PG8_SA(0, 1), cA + hstep, voffA);
        if (wr == 1) PG8_BAR;
        PG8_WAIT_V(2); PG8_BAR;
        PG8_STAGE(PG8_SB(1, 0), cB + kstep, voffB); PG8_STAGE(PG8_SA(1, 0), cA + kstep, voffA); PG8_STAGE(PG8_SB(1, 1), cB + hstep + kstep, voffB);
        PG8_WAIT_V(6); PG8_BAR;
    } else {
        PG8_STAGE(PG8_SB(0, 0), cB, voffB); PG8_STAGE(PG8_SA(0, 0), cA, voffA); PG8_STAGE(PG8_SB(0, 1), cB + hstep, voffB); PG8_STAGE(PG8_SA(0, 1), cA + hstep, voffA);
        if (wr == 1) PG8_BAR;
        PG8_WAIT_V(4); PG8_BAR;
        PG8_STAGE(PG8_SB(1, 0), cB + kstep, voffB); PG8_STAGE(PG8_SA(1, 0), cA + kstep, voffA); PG8_STAGE(PG8_SB(1, 1), cB + hstep + kstep, voffB);
        PG8_WAIT_V(6); PG8_BAR;
    }
    for (;;) {
        const bool has_next = S.next(ui + 1, nxt);
        const char* nA = has_next ? nxt.a : cA; const char* nB = has_next ? nxt.b : cB;
        for (int t = 0; t < nt; t += 2) {
            const bool last = (t == nt - 2);
            const char* a1 = cA + (size_t)(t + 1) * kstep;
            const char* a2 = last ? nA : cA + (size_t)(t + 2) * kstep; const char* b2 = last ? nB : cB + (size_t)(t + 2) * kstep;
            const char* a3 = a2 + kstep; const char* b3 = b2 + kstep;
            if (last && has_next) S.a_ready(nxt);
            if constexpr (SP2) {
            PG8_LDB(B0, 0, 0); PG8_LDB(B1, 0, 1); PG8_SCHED; PG8_LDA(At, 0, 0); PG8_STAGE(PG8_SA(1, 1), a1 + hstep, voffA);
            PG8_WAIT_V(8); PG8_WAIT_L(0); PG8_BAR; PG8_MMA(0, 0, At, B0); PG8_MMA(0, 1, At, B1); PG8_BAR; PG8_SCHED;
            PG8_LDA(At, 0, 1); PG8_STAGE(PG8_SB(0, 0), b2, voffB); PG8_STAGE(PG8_SB(0, 1), b2 + hstep, voffB); PG8_STAGE(PG8_SA(0, 0), a2, voffA);
            PG8_WAIT_V(8); PG8_WAIT_L(0); PG8_BAR; PG8_MMA(1, 0, At, B0); PG8_MMA(1, 1, At, B1); PG8_BAR; PG8_SCHED;
            PG8_LDB(B0, 1, 0); PG8_LDB(B1, 1, 1); PG8_SCHED; PG8_LDA(At, 1, 0); PG8_STAGE(PG8_SA(0, 1), a2 + hstep, voffA);
            PG8_WAIT_V(8); PG8_WAIT_L(0); PG8_BAR; PG8_MMA(0, 0, At, B0); PG8_MMA(0, 1, At, B1); PG8_BAR; PG8_SCHED;
            PG8_LDA(At, 1, 1); PG8_STAGE(PG8_SB(1, 0), b3, voffB); PG8_STAGE(PG8_SB(1, 1), b3 + hstep, voffB); PG8_STAGE(PG8_SA(1, 0), a3, voffA);
            PG8_WAIT_V(8); PG8_WAIT_L(0); PG8_BAR; PG8_MMA(1, 0, At, B0); PG8_MMA(1, 1, At, B1); PG8_BAR; PG8_SCHED;
            } else {
            PG8_LDB(B0, 0, 0); PG8_SCHED; PG8_LDA(At, 0, 0); PG8_STAGE(PG8_SA(1, 1), a1 + hstep, voffA);
            PG8_WAIT_L(8); PG8_BAR; PG8_WAIT_L(0); PG8_MMA(0, 0, At, B0); PG8_BAR; PG8_SCHED;
            PG8_LDB(B1, 0, 1); PG8_STAGE(PG8_SB(0, 0), b2, voffB);
            PG8_BAR; PG8_WAIT_L(0); PG8_MMA(0, 1, At, B1); PG8_BAR;
            PG8_LDA(At, 0, 1); PG8_STAGE(PG8_SA(0, 0), a2, voffA);
            PG8_BAR; PG8_WAIT_L(0); PG8_MMA(1, 0, At, B0); PG8_BAR; PG8_SCHED;
            PG8_STAGE(PG8_SB(0, 1), b2 + hstep, voffB);
            PG8_WAIT_V(6); PG8_BAR; PG8_MMA(1, 1, At, B1); PG8_BAR;
            PG8_LDB(B0, 1, 0); PG8_SCHED; PG8_LDA(At, 1, 0); PG8_STAGE(PG8_SA(0, 1), a2 + hstep, voffA);
            PG8_WAIT_L(8); PG8_BAR; PG8_WAIT_L(0); PG8_MMA(0, 0, At, B0); PG8_BAR; PG8_SCHED;
            PG8_LDB(B1, 1, 1); PG8_STAGE(PG8_SB(1, 0), b3, voffB);
            PG8_BAR; PG8_WAIT_L(0); PG8_MMA(0, 1, At, B1); PG8_BAR;
            PG8_LDA(At, 1, 1); PG8_STAGE(PG8_SA(1, 0), a3, voffA);
            PG8_BAR; PG8_WAIT_L(0); PG8_MMA(1, 0, At, B0); PG8_BAR; PG8_SCHED;
            PG8_STAGE(PG8_SB(1, 1), b3 + hstep, voffB);
            PG8_WAIT_V(6); PG8_BAR; PG8_MMA(1, 1, At, B1); PG8_BAR;
            }
        }
        if constexpr (ALIGN_EPI) { if (wr == 0) PG8_BAR; }
        if constexpr (!Epi::AFTER_DRAIN) { E(acc, cur, wr, wc, fr, fq); S.done(cur); }
        if (!has_next) break;
#pragma unroll
        for (int a = 0; a < 2; ++a)
#pragma unroll
            for (int b = 0; b < 2; ++b)
#pragma unroll
                for (int m = 0; m < 4; ++m)
#pragma unroll
                    for (int n = 0; n < 2; ++n) acc[a][b][m][n] = (f32x4){0.f, 0.f, 0.f, 0.f};
        cur = nxt; cA = nA; cB = nB; ++ui;
        if constexpr (ALIGN_EPI) { if (wr == 1) PG8_BAR; }
    }
    PG8_WAIT_V(0);
    if constexpr (!ALIGN_EPI) { if (wr == 0) PG8_BAR; }
    PG8_BAR;
    if constexpr (Epi::AFTER_DRAIN) { E.fused(acc, cur, wr, wc, fr, fq, lds, wid, lane); S.done(cur); }
#undef PG8_SA
#undef PG8_SB
#undef PG8_STAGE
#undef PG8_LDA
#undef PG8_LDB
#undef PG8_MMA
#undef PG8_WAIT_V
#undef PG8_WAIT_L
#undef PG8_BAR
#undef PG8_SCHED
}
}

typedef pg8::bf16_t bf16_t;
typedef pg8::f32x4 f32x4;
typedef pg8::u32x4 u32x4;
using pg8::cvt_pk_bf16;
constexpr int NB = 4, SEQ = 8192, D = 1024, MTOK = NB * SEQ;
constexpr int PCOLS = 4608, GCOLS = 3072, INCOLS = 7680, DFF = 3584, NEXP = 8;
constexpr int C_HQ = 0, C_HF = 512, C_HI = 1024, C_HG = 1536, C_GU = 2048, C_GV = 2560, C_SQ = 3072, C_SK = 3584, C_SV = 4096;
constexpr float EPS = 1e-6f;
constexpr int NSLOT = 2 * MTOK + NEXP * 256;
constexpr int NTHREADS = 512, NWAVES = 8;
constexpr int LDS_BYTES = 147456, LDS_MISC = LDS_BYTES - 256;

constexpr size_t WS_CTL = 0, CTL_BYTES = 65536;
constexpr size_t CW_BAR = 0;
constexpr size_t WS_META = WS_CTL + CTL_BYTES;
constexpr size_t WS_LB = WS_META + 4096;
constexpr size_t WS_TOKE = WS_LB + 4096;
constexpr size_t WS_TOKW = WS_TOKE + (size_t)MTOK * 4;
constexpr size_t WS_SLOTTOK = WS_TOKW + (size_t)MTOK * 8;
constexpr size_t WS_SLOTW = WS_SLOTTOK + (size_t)NSLOT * 4;
constexpr size_t WS_W = 2u << 20;
static_assert(WS_SLOTW + (size_t)NSLOT * 4 <= WS_W, "small buffers");
constexpr size_t WS_WIN = WS_W;
constexpr size_t WS_WBR = WS_WIN + (size_t)2 * INCOLS * D * 2;
constexpr size_t WS_WOUT = WS_WBR + (size_t)2 * 3 * D * 512 * 2;
constexpr size_t WS_WGU = WS_WOUT + (size_t)2 * D * D * 2;
constexpr size_t WS_WD = WS_WGU + (size_t)2 * DFF * D * 2;
constexpr size_t WS_XN = WS_WD + (size_t)D * DFF * 2;
constexpr size_t WS_C = WS_XN + (size_t)MTOK * D * 2;
constexpr size_t WS_P = WS_C;
constexpr size_t WS_G = WS_C;
constexpr size_t WS_HID = WS_C;
constexpr size_t WS_OCAT = WS_C + (size_t)MTOK * PCOLS * 2;
constexpr size_t WS_ORAW = WS_OCAT + (size_t)3 * MTOK * 512 * 2;
constexpr size_t WS_END1 = WS_ORAW + (size_t)MTOK * 512 * 4;
constexpr size_t WS_MWGU = WS_C;
constexpr size_t WS_MWD = WS_MWGU + (size_t)NEXP * 2 * DFF * D * 2;
constexpr size_t WS_XS = WS_MWD + (size_t)NEXP * D * DFF * 2;
constexpr size_t WS_MHID = WS_XS + (size_t)MTOK * D * 2;
constexpr size_t WS_END2 = WS_MHID + (size_t)MTOK * DFF * 2;
constexpr size_t WS_NEED = WS_END1 > WS_END2 ? WS_END1 : WS_END2;
static_assert(WS_NEED <= 615053344ull, "workspace budget (sum of the inputs)");

#define LAUNDER(v) asm volatile("" : "+v"(v))
__device__ __forceinline__ float bf2f(unsigned v) { return __uint_as_float(v << 16); }
__device__ __forceinline__ float bflo(unsigned w) { return __uint_as_float(w << 16); }
__device__ __forceinline__ float bfhi(unsigned w) { return __uint_as_float(w & 0xffff0000u); }
__device__ __forceinline__ bf16_t f2bf(float f) { return (bf16_t)(cvt_pk_bf16(f, 0.f) & 0xffffu); }
__device__ __forceinline__ float wave_sum(float v) {
#pragma unroll
    for (int o = 32; o > 0; o >>= 1) v += __shfl_xor(v, o);
    return v;
}
__device__ __forceinline__ float sigmoidf_(float x) { return __builtin_amdgcn_rcpf(1.f + __expf(-x)); }
__device__ __forceinline__ float siluf_(float x) { return x * sigmoidf_(x); }
__device__ __forceinline__ float gelu_tanh_(float x) { return x * sigmoidf_(1.5957691216057308f * (x + 0.044715f * x * x * x)); }
__device__ __forceinline__ float softplusf_(float z) { return fmaxf(z, 0.f) + __logf(1.f + __expf(-fabsf(z))); }

struct Order {
    int nM, nN, nwg, G, c, mode; const char* A; const char* Bt; size_t tstep, abr, bbr;
    __device__ void init(const void* A_, const void* Bt_, int M, int N, int K, int G_, int c_, int mode_ = 0, size_t abr_ = 0, size_t bbr_ = 0) {
        nM = M / 256; nN = N / 256; nwg = nM * nN; G = G_; c = c_; mode = mode_; A = (const char*)A_; Bt = (const char*)Bt_; tstep = (size_t)256 * K * 2; abr = abr_; bbr = bbr_; }
    __device__ bool next(int i, pg8::Unit& u) const {
        const long L = (long)i * G + c; if (L >= nwg) return false;
        int wgid = (int)L; { const int q = nwg / 8, r = nwg % 8, xcd = wgid % 8, off = wgid / 8; wgid = (xcd < r ? xcd * (q + 1) : r * (q + 1) + (xcd - r) * q) + off; }
        const int nig = 8 * nN, gid = wgid / nig, fm = gid * 8, gsz = (nM - fm) < 8 ? (nM - fm) : 8;
        u.pm = fm + ((wgid % nig) % gsz); u.pn = (wgid % nig) / gsz;
        if (mode == 0) { u.a = A + (size_t)u.pm * tstep; u.b = Bt + (size_t)u.pn * tstep; }
        else { const int br = u.pn >> 2; u.a = A + (size_t)br * abr + (size_t)u.pm * tstep; u.b = Bt + (size_t)br * bbr + (size_t)(u.pn & 3) * tstep; }
        return true;
    }
    __device__ __forceinline__ void a_ready(const pg8::Unit&) const {}
    __device__ __forceinline__ void done(const pg8::Unit&) const {}
};

template <int ACT> __device__ __forceinline__ float act_(float x, float lb) {
    if (ACT == 1) return siluf_(x);
    if (ACT == 2) return __logf(lb + (1.f - lb) * sigmoidf_(x));
    if (ACT == 3) return gelu_tanh_(x);
    if (ACT == 4) return sigmoidf_(x);
    return x;
}
struct EpiAct {
    static constexpr bool PERM = true, AFTER_DRAIN = false;
    bf16_t* O; int ldc; const float* lb; int inproj;
    template <int ACT> __device__ __forceinline__ void run(const f32x4 (&acc)[2][2][4][2], const pg8::Unit& u, int wr, int wc, int fr, int fq) const {
        const int row0 = u.pm * 256 + wr * 64 + fr, col0 = u.pn * 256 + wc * 32 + 8 * fq;
        f32x4 lbv[2][2];
#pragma unroll
        for (int bj = 0; bj < 2; ++bj)
#pragma unroll
            for (int n = 0; n < 2; ++n) lbv[bj][n] = (ACT == 2) ? *(const f32x4*)(lb + (col0 - C_HF) + bj * 128 + 4 * n) : (f32x4){0.f, 0.f, 0.f, 0.f};
#pragma unroll
        for (int ai = 0; ai < 2; ++ai)
#pragma unroll
            for (int m = 0; m < 4; ++m) { bf16_t* rowp = O + (size_t)(row0 + ai * 128 + m * 16) * ldc + col0;
#pragma unroll
                for (int bj = 0; bj < 2; ++bj) { f32x4 v0 = acc[ai][bj][m][0], v1 = acc[ai][bj][m][1];
#pragma unroll
                    for (int i = 0; i < 4; ++i) { v0[i] = act_<ACT>(v0[i], lbv[bj][0][i]); v1[i] = act_<ACT>(v1[i], lbv[bj][1][i]); }
                    u32x4 w; w.x = cvt_pk_bf16(v0[0], v0[1]); w.y = cvt_pk_bf16(v0[2], v0[3]); w.z = cvt_pk_bf16(v1[0], v1[1]); w.w = cvt_pk_bf16(v1[2], v1[3]);
                    *(u32x4*)(rowp + bj * 128) = w; } }
    }
    __device__ __forceinline__ void operator()(const f32x4 (&acc)[2][2][4][2], const pg8::Unit& u, int wr, int wc, int fr, int fq) const {
        if (!inproj) { run<4>(acc, u, wr, wc, fr, fq); return; }
        const int kind = u.pn >> 1;
        if (kind == 0 || kind == 3) run<1>(acc, u, wr, wc, fr, fq);
        else if (kind == 1) run<2>(acc, u, wr, wc, fr, fq);
        else if (kind == 4 || kind == 5) run<3>(acc, u, wr, wc, fr, fq);
        else run<0>(acc, u, wr, wc, fr, fq);
    }
};
struct EpiBranch {
    static constexpr bool PERM = true, AFTER_DRAIN = false;
    bf16_t* GH;
    __device__ __forceinline__ void operator()(const f32x4 (&acc)[2][2][4][2], const pg8::Unit& u, int wr, int wc, int fr, int fq) const {
        const int row0 = u.pm * 256 + wr * 64 + fr, col0 = u.pn * 256 + wc * 32 + 8 * fq;
#pragma unroll
        for (int ai = 0; ai < 2; ++ai)
#pragma unroll
            for (int m = 0; m < 4; ++m) { bf16_t* rowp = GH + (size_t)(row0 + ai * 128 + m * 16) * GCOLS + col0;
#pragma unroll
                for (int bj = 0; bj < 2; ++bj) { const f32x4 v0 = acc[ai][bj][m][0], v1 = acc[ai][bj][m][1];
                    const u32x4 g = *(const u32x4*)(rowp + bj * 128); u32x4 w;
                    w.x = cvt_pk_bf16(v0[0] * bflo(g.x), v0[1] * bfhi(g.x)); w.y = cvt_pk_bf16(v0[2] * bflo(g.y), v0[3] * bfhi(g.y));
                    w.z = cvt_pk_bf16(v1[0] * bflo(g.z), v1[1] * bfhi(g.z)); w.w = cvt_pk_bf16(v1[2] * bflo(g.w), v1[3] * bfhi(g.w));
                    *(u32x4*)(rowp + bj * 128) = w; } }
    }
};
struct EpiResid {
    static constexpr bool PERM = false, AFTER_DRAIN = false;
    const float* xin; float* xout;
    __device__ __forceinline__ void operator()(const f32x4 (&acc)[2][2][4][2], const pg8::Unit& u, int wr, int wc, int fr, int fq) const {
        const int row0 = u.pm * 256 + wr * 64 + fr, col0 = u.pn * 256 + wc * 32 + 4 * fq;
#pragma unroll
        for (int ai = 0; ai < 2; ++ai)
#pragma unroll
            for (int m = 0; m < 4; ++m) { const size_t ro = (size_t)(row0 + ai * 128 + m * 16) * D + col0;
#pragma unroll
                for (int bj = 0; bj < 2; ++bj)
#pragma unroll
                    for (int n = 0; n < 2; ++n) *(f32x4*)(xout + ro + bj * 128 + n * 16) = *(const f32x4*)(xin + ro + bj * 128 + n * 16) + acc[ai][bj][m][n]; }
    }
};
struct EpiGU {
    static constexpr bool PERM = true, AFTER_DRAIN = false;
    bf16_t* H;
    __device__ __forceinline__ void operator()(const f32x4 (&acc)[2][2][4][2], const pg8::Unit& u, int wr, int wc, int fr, int fq) const {
        const int row0 = u.pm * 256 + wr * 64 + fr, col0 = u.pn * 128 + wc * 32 + 8 * fq;
#pragma unroll
        for (int ai = 0; ai < 2; ++ai)
#pragma unroll
            for (int m = 0; m < 4; ++m) { bf16_t* rowp = H + (size_t)(row0 + ai * 128 + m * 16) * DFF + col0;
                const f32x4 g0 = acc[ai][0][m][0], g1 = acc[ai][0][m][1], u0 = acc[ai][1][m][0], u1 = acc[ai][1][m][1]; u32x4 w;
                w.x = cvt_pk_bf16(siluf_(g0[0]) * u0[0], siluf_(g0[1]) * u0[1]); w.y = cvt_pk_bf16(siluf_(g0[2]) * u0[2], siluf_(g0[3]) * u0[3]);
                w.z = cvt_pk_bf16(siluf_(g1[0]) * u1[0], siluf_(g1[1]) * u1[1]); w.w = cvt_pk_bf16(siluf_(g1[2]) * u1[2], siluf_(g1[3]) * u1[3]);
                *(u32x4*)rowp = w; }
    }
};
struct EpiMoeDown {
    static constexpr bool PERM = false, AFTER_DRAIN = false;
    float* out; const int* stok; const float* sw;
    __device__ __forceinline__ void operator()(const f32x4 (&acc)[2][2][4][2], const pg8::Unit& u, int wr, int wc, int fr, int fq) const {
        const int row0 = u.pm * 256 + wr * 64 + fr, col0 = u.pn * 256 + wc * 32 + 4 * fq;
#pragma unroll
        for (int ai = 0; ai < 2; ++ai)
#pragma unroll
            for (int m = 0; m < 4; ++m) { const int rl = row0 + ai * 128 + m * 16; const int tok = stok[rl]; const float w = sw[rl];
                if (tok >= 0) { float* rp = out + (size_t)tok * D + col0;
#pragma unroll
                    for (int bj = 0; bj < 2; ++bj)
#pragma unroll
                        for (int n = 0; n < 2; ++n) { f32x4 o = *(const f32x4*)(rp + bj * 128 + n * 16); o = o + acc[ai][bj][m][n] * w; *(f32x4*)(rp + bj * 128 + n * 16) = o; } } }
    }
};

__device__ void tc_job(const float* __restrict__ src, int K, int N, bf16_t* dst, int mode, LAS float* tile, int wg, int G, int tid) {
    LAUNDER(tid);
    const int tn = N / 64, nt = (K / 64) * tn;
    for (int t = wg; t < nt; t += G) {
        const int k0 = (t / tn) * 64, n0 = (t % tn) * 64;
#pragma unroll
        for (int ps = 0; ps < 2; ++ps) { const int r = (tid >> 4) + ps * 32; const float4 v = *(const float4*)(src + (size_t)(k0 + r) * N + n0 + (tid & 15) * 4);
            LAS float* tp = tile + r * 65 + (tid & 15) * 4; tp[0] = v.x; tp[1] = v.y; tp[2] = v.z; tp[3] = v.w; }
        __syncthreads();
        { const int n = tid >> 3, kg = (tid & 7) * 8; unsigned w[4];
#pragma unroll
          for (int j = 0; j < 4; ++j) w[j] = cvt_pk_bf16(tile[(kg + 2 * j) * 65 + n], tile[(kg + 2 * j + 1) * 65 + n]);
          const int nn = n0 + n; const int drow = mode == 0 ? nn : ((nn >> 7) * 256 + (nn & 127) + (mode == 2 ? 128 : 0));
          *(uint4*)(dst + (size_t)drow * K + k0 + kg) = make_uint4(w[0], w[1], w[2], w[3]); }
        __syncthreads();
    }
}

template <bool ROUTER>
__device__ void phase_rmsnorm(const float* __restrict__ x, const float* __restrict__ gain, bf16_t* xn, const float* __restrict__ rw, const float* __restrict__ rb,
                              int* toke, float2* tokw, int wg, int G, int wid, int lane) {
    LAUNDER(lane);
    for (int row = wg * NWAVES + wid; row < MTOK; row += G * NWAVES) {
        const float* xr = x + (size_t)row * D; float4 v[4]; float ss = 0.f;
#pragma unroll
        for (int j = 0; j < 4; ++j) { v[j] = *(const float4*)(xr + j * 256 + lane * 4); ss += v[j].x * v[j].x + v[j].y * v[j].y + v[j].z * v[j].z + v[j].w * v[j].w; }
        ss = wave_sum(ss);
        const float rstd = rsqrtf(ss * (1.f / D) + EPS);
        float lg[NEXP];
#pragma unroll
        for (int e = 0; e < NEXP; ++e) lg[e] = 0.f;
#pragma unroll
        for (int j = 0; j < 4; ++j) { const float4 g = *(const float4*)(gain + j * 256 + lane * 4);
            const float y0 = v[j].x * rstd * g.x, y1 = v[j].y * rstd * g.y, y2 = v[j].z * rstd * g.z, y3 = v[j].w * rstd * g.w;
            *(uint2*)(xn + (size_t)row * D + j * 256 + lane * 4) = make_uint2(cvt_pk_bf16(y0, y1), cvt_pk_bf16(y2, y3));
            if (ROUTER) { const float ys[4] = {y0, y1, y2, y3};
#pragma unroll
                for (int i = 0; i < 4; ++i) { const float* wr_ = rw + (size_t)(j * 256 + lane * 4 + i) * NEXP; const float4 wa = *(const float4*)wr_, wb = *(const float4*)(wr_ + 4);
                    lg[0] += ys[i] * wa.x; lg[1] += ys[i] * wa.y; lg[2] += ys[i] * wa.z; lg[3] += ys[i] * wa.w; lg[4] += ys[i] * wb.x; lg[5] += ys[i] * wb.y; lg[6] += ys[i] * wb.z; lg[7] += ys[i] * wb.w; } } }
        if (ROUTER) {
#pragma unroll
            for (int e = 0; e < NEXP; ++e) lg[e] = wave_sum(lg[e]) + rb[e];
            int i0 = 0; float l0 = lg[0];
#pragma unroll
            for (int e = 1; e < NEXP; ++e) if (lg[e] > l0) { l0 = lg[e]; i0 = e; }
            int i1 = -1; float l1 = -3.4e38f;
#pragma unroll
            for (int e = 0; e < NEXP; ++e) if (e != i0 && lg[e] > l1) { l1 = lg[e]; i1 = e; }
            const float w0 = __builtin_amdgcn_rcpf(1.f + __expf(l1 - l0));
            if (lane == 0) { toke[row] = i0 | (i1 << 8); tokw[row] = make_float2(w0, 1.f - w0); }
        }
    }
}

__device__ void phase_combine(const bf16_t* GH, bf16_t* mix, int wg, int G, int tid) {
    LAUNDER(tid);
    for (size_t v = (size_t)wg * NTHREADS + tid; v < (size_t)MTOK * (D / 8); v += (size_t)G * NTHREADS) {
        const size_t r = v / (D / 8); const int c = (int)(v % (D / 8)) * 8; const bf16_t* gp = GH + r * GCOLS + c;
        const uint4 a = *(const uint4*)gp, b = *(const uint4*)(gp + 1024), cc = *(const uint4*)(gp + 2048); uint4 o;
        o.x = cvt_pk_bf16(bflo(a.x) + bflo(b.x) + bflo(cc.x), bfhi(a.x) + bfhi(b.x) + bfhi(cc.x));
        o.y = cvt_pk_bf16(bflo(a.y) + bflo(b.y) + bflo(cc.y), bfhi(a.y) + bfhi(b.y) + bfhi(cc.y));
        o.z = cvt_pk_bf16(bflo(a.z) + bflo(b.z) + bflo(cc.z), bfhi(a.z) + bfhi(b.z) + bfhi(cc.z));
        o.w = cvt_pk_bf16(bflo(a.w) + bflo(b.w) + bflo(cc.w), bfhi(a.w) + bfhi(b.w) + bfhi(cc.w));
        *(uint4*)(mix + r * D + c) = o;
    }
}

__device__ void phase_hgrn_naive(const bf16_t* P, float* oraw, int wg, int G, int wid, int lane) {
    LAUNDER(lane);
    for (int task = wg * NWAVES + wid; task < NB * 4 * 32; task += G * NWAVES) {
        const int b = task >> 7, h = (task >> 5) & 3, vg = task & 31;
        const bf16_t* base = P + (size_t)b * SEQ * PCOLS + h * 128;
        float* ob = oraw + (size_t)b * SEQ * 512 + h * 128 + vg * 4;
        float s00 = 0, s01 = 0, s02 = 0, s03 = 0, s10 = 0, s11 = 0, s12 = 0, s13 = 0;
        for (int t0 = 0; t0 < SEQ; t0 += 8) {
            unsigned q0[8], q1[8], f0[8], f1[8]; uint2 vv[8];
#pragma unroll
            for (int j = 0; j < 8; ++j) { const bf16_t* row = base + (size_t)(t0 + j) * PCOLS;
                q0[j] = row[C_HQ + lane]; q1[j] = row[C_HQ + 64 + lane]; f0[j] = row[C_HF + lane]; f1[j] = row[C_HF + 64 + lane]; vv[j] = *(const uint2*)(row + C_HI + vg * 4); }
#pragma unroll
            for (int j = 0; j < 8; ++j) {
                const float fa = __expf(bf2f(f0[j])), fb = __expf(bf2f(f1[j])), ka = 1.f - fa, kb = 1.f - fb, qa = bf2f(q0[j]), qb = bf2f(q1[j]);
                const float v0 = bflo(vv[j].x), v1 = bfhi(vv[j].x), v2 = bflo(vv[j].y), v3 = bfhi(vv[j].y);
                s00 = fa * s00 + ka * v0; s01 = fa * s01 + ka * v1; s02 = fa * s02 + ka * v2; s03 = fa * s03 + ka * v3;
                s10 = fb * s10 + kb * v0; s11 = fb * s11 + kb * v1; s12 = fb * s12 + kb * v2; s13 = fb * s13 + kb * v3;
                const float o0 = wave_sum(qa * s00 + qb * s10), o1 = wave_sum(qa * s01 + qb * s11), o2 = wave_sum(qa * s02 + qb * s12), o3 = wave_sum(qa * s03 + qb * s13);
                if (lane == 0) *(float4*)(ob + (size_t)(t0 + j) * 512) = make_float4(o0, o1, o2, o3);
            }
        }
    }
}
__device__ void phase_hgrn_fin(const float* oraw, const bf16_t* P, const float* __restrict__ gain, bf16_t* oa, int wg, int G, int wid, int lane) {
    LAUNDER(lane);
    for (int row = wg * NWAVES + wid; row < MTOK; row += G * NWAVES) {
        const float* orow = oraw + (size_t)row * 512 + lane * 8; const float4 a = *(const float4*)orow, b = *(const float4*)(orow + 4);
        float ss = a.x * a.x + a.y * a.y + a.z * a.z + a.w * a.w + b.x * b.x + b.y * b.y + b.z * b.z + b.w * b.w;
        ss += __shfl_xor(ss, 1); ss += __shfl_xor(ss, 2); ss += __shfl_xor(ss, 4); ss += __shfl_xor(ss, 8);
        const float rstd = rsqrtf(ss * (1.f / 128.f) + EPS);
        const int vi = (lane & 15) * 8; const float4 g0 = *(const float4*)(gain + vi), g1 = *(const float4*)(gain + vi + 4);
        const uint4 hg = *(const uint4*)(P + (size_t)row * PCOLS + C_HG + lane * 8); uint4 o;
        o.x = cvt_pk_bf16(a.x * rstd * g0.x * bflo(hg.x), a.y * rstd * g0.y * bfhi(hg.x)); o.y = cvt_pk_bf16(a.z * rstd * g0.z * bflo(hg.y), a.w * rstd * g0.w * bfhi(hg.y));
        o.z = cvt_pk_bf16(b.x * rstd * g1.x * bflo(hg.z), b.y * rstd * g1.y * bfhi(hg.z)); o.w = cvt_pk_bf16(b.z * rstd * g1.z * bflo(hg.w), b.w * rstd * g1.w * bfhi(hg.w));
        *(uint4*)(oa + (size_t)row * 512 + lane * 8) = o;
    }
}
__device__ void phase_gmlp_naive(const bf16_t* P, const float* __restrict__ ws_l  , const float* __restrict__ bs_l  , const float* __restrict__ gv_l  ,
                                 bf16_t* ob, LAS unsigned char* lds, int wg, int G, int tid, int wid, int lane) {
    LAUNDER(tid); LAUNDER(lane);
    LAS float* vn = (LAS float*)lds; LAS float* W = vn + 128 * 128; LAS float* rs = W + 128 * 128;
    for (int item = wg; item < (MTOK / 128) * 4; item += G) {
        const int chunk = item >> 2, g = item & 3; const size_t tok0 = (size_t)chunk * 128;
        for (int s = wid; s < 128; s += NWAVES) { const uint4 x = *(const uint4*)(P + (tok0 + s) * PCOLS + C_GV + lane * 8);
            float ss = bflo(x.x) * bflo(x.x) + bfhi(x.x) * bfhi(x.x) + bflo(x.y) * bflo(x.y) + bfhi(x.y) * bfhi(x.y) + bflo(x.z) * bflo(x.z) + bfhi(x.z) * bfhi(x.z) + bflo(x.w) * bflo(x.w) + bfhi(x.w) * bfhi(x.w);
            ss = wave_sum(ss); if (lane == 0) rs[s] = rsqrtf(ss * (1.f / 512.f) + EPS); }
        __syncthreads();
        for (int i = tid; i < 128 * 128; i += NTHREADS) { const int s = i >> 7, c = i & 127;
            vn[i] = bf2f(P[(tok0 + s) * PCOLS + C_GV + g * 128 + c]) * rs[s] * gv_l[g * 128 + c]; W[i] = ws_l[(size_t)g * 16384 + i]; }
        __syncthreads();
        { const int c = tid & 127;
          for (int t = tid >> 7; t < 128; t += 4) { float acc = 0.f; for (int s = 0; s <= t; ++s) acc += W[t * 128 + s] * vn[s * 128 + c];
              const float mixv = acc + bs_l[g * 128 + t]; const float uu = bf2f(P[(tok0 + t) * PCOLS + C_GU + g * 128 + c]);
              ob[(tok0 + t) * 512 + g * 128 + c] = f2bf(uu * mixv); } }
        __syncthreads();
    }
}
__device__ void phase_attn_naive(const bf16_t* P, const float* __restrict__ gq, const float* __restrict__ gk, bf16_t* oc, LAS unsigned char* lds, int wg, int G, int wid, int lane) {
    LAUNDER(lane);
    LAS float* red = (LAS float*)lds + wid * (64 * 65); LAS float* qs = (LAS float*)lds + NWAVES * 64 * 65 + wid * 64;
    for (int item = wg; item < MTOK * 8 / NWAVES; item += G) {
        const int q_id = item * NWAVES + wid;
        const int t = q_id & (SEQ - 1), h = (q_id >> 13) & 7, b = q_id >> 16;
        const size_t tokb = (size_t)b * SEQ;
        { const float qv = bf2f(P[(tokb + t) * PCOLS + C_SQ + h * 64 + lane]); const float ss = wave_sum(qv * qv);
          qs[lane] = qv * rsqrtf(ss * (1.f / 64.f) + EPS) * gq[lane] * gk[lane] * 0.125f; }
        float op[64];
#pragma unroll
        for (int d = 0; d < 64; ++d) op[d] = 0.f;
        float carry = 0.f;
        for (int s0 = t - 1; s0 >= 0; s0 -= 64) {
            const int s = s0 - lane; const bool valid = s >= 0; const int sc = valid ? s : 0;
            const bf16_t* kr = P + (tokb + sc) * PCOLS + C_SK + h * 64; float dot = 0.f, ssk = 0.f;
#pragma unroll
            for (int j = 0; j < 8; ++j) { const uint4 kk = *(const uint4*)(kr + j * 8); const float k0 = bflo(kk.x), k1 = bfhi(kk.x), k2 = bflo(kk.y), k3 = bfhi(kk.y), k4 = bflo(kk.z), k5 = bfhi(kk.z), k6 = bflo(kk.w), k7 = bfhi(kk.w);
                dot += qs[j * 8 + 0] * k0 + qs[j * 8 + 1] * k1 + qs[j * 8 + 2] * k2 + qs[j * 8 + 3] * k3 + qs[j * 8 + 4] * k4 + qs[j * 8 + 5] * k5 + qs[j * 8 + 6] * k6 + qs[j * 8 + 7] * k7;
                ssk += k0 * k0 + k1 * k1 + k2 * k2 + k3 * k3 + k4 * k4 + k5 * k5 + k6 * k6 + k7 * k7; }
            const float z = dot * rsqrtf(ssk * (1.f / 64.f) + EPS);
            const float sp = valid ? softplusf_(z) : 0.f;
            float pre = sp;
#pragma unroll
            for (int o = 1; o < 64; o <<= 1) { const float tt = __shfl_up(pre, o); if (lane >= o) pre += tt; }
            const float a = valid ? __expf(z - carry - pre) : 0.f;
            const bf16_t* vr = P + (tokb + sc) * PCOLS + C_SV + h * 64;
#pragma unroll
            for (int j = 0; j < 8; ++j) { const uint4 vv = *(const uint4*)(vr + j * 8);
                op[j * 8 + 0] += a * bflo(vv.x); op[j * 8 + 1] += a * bfhi(vv.x); op[j * 8 + 2] += a * bflo(vv.y); op[j * 8 + 3] += a * bfhi(vv.y);
                op[j * 8 + 4] += a * bflo(vv.z); op[j * 8 + 5] += a * bfhi(vv.z); op[j * 8 + 6] += a * bflo(vv.w); op[j * 8 + 7] += a * bfhi(vv.w); }
            carry += __shfl(pre, 63);
            if (carry > 104.f) break;
        }
#pragma unroll
        for (int d = 0; d < 64; ++d) red[lane * 65 + d] = op[d];
        float o = 0.f;
#pragma unroll 8
        for (int l = 0; l < 64; ++l) o += red[l * 65 + lane];
        oc[(tokb + t) * 512 + h * 64 + lane] = f2bf(o);
    }
}

__device__ void moe_assign(const int* toke, const float2* tokw, int* meta, int* stok, float* sw, LAS unsigned char* lds, int tid) {
    LAUNDER(tid);
    LAS int* cnt = (LAS int*)lds;
    LAS int* tot = cnt + 512 * 8;
    int c[NEXP];
#pragma unroll
    for (int e = 0; e < NEXP; ++e) c[e] = 0;
    const int t0 = tid * (MTOK / NTHREADS);
    for (int i = 0; i < MTOK / NTHREADS; ++i) { const int ee = toke[t0 + i]; const int e0 = ee & 255, e1 = (ee >> 8) & 255;
#pragma unroll
        for (int e = 0; e < NEXP; ++e) c[e] += (e0 == e) + (e1 == e); }
#pragma unroll
    for (int e = 0; e < NEXP; ++e) cnt[tid * 8 + e] = c[e];
    __syncthreads();
    if (tid < NEXP) { int run = 0; for (int i = 0; i < NTHREADS; ++i) { const int v = cnt[i * 8 + tid]; cnt[i * 8 + tid] = run; run += v; } tot[tid] = run; }
    __syncthreads();
    if (tid == 0) { int run = 0; for (int e = 0; e < NEXP; ++e) { const int n = tot[e], pad = (n + 255) & ~255; tot[8 + e] = run; meta[e] = n; meta[8 + e] = pad; meta[16 + e] = run; run += pad; } }
    __syncthreads();
    int pos[NEXP];
#pragma unroll
    for (int e = 0; e < NEXP; ++e) pos[e] = tot[8 + e] + cnt[tid * 8 + e];
    for (int i = 0; i < MTOK / NTHREADS; ++i) { const int tk = t0 + i; const int ee = toke[tk]; const int e0 = ee & 255, e1 = (ee >> 8) & 255; const float2 w = tokw[tk];
        int p0 = 0, p1 = 0;
#pragma unroll
        for (int e = 0; e < NEXP; ++e) { if (e0 == e) { p0 = pos[e]; pos[e]++; } }
#pragma unroll
        for (int e = 0; e < NEXP; ++e) { if (e1 == e) { p1 = pos[e]; pos[e]++; } }
        stok[p0] = tk; sw[p0] = w.x; stok[p1] = tk; sw[p1] = w.y; }
    for (int e = 0; e < NEXP; ++e) { const int n = tot[e], pad = (n + 255) & ~255, base = tot[8 + e]; for (int i = n + tid; i < pad; i += NTHREADS) { stok[base + i] = -1; sw[base + i] = 0.f; } }
}
__device__ void moe_gather(const bf16_t* xn, const int* stok, int rows, bf16_t* xs, int wg, int G, int wid, int lane) {
    LAUNDER(lane);
    for (int r = wg * NWAVES + wid; r < rows; r += G * NWAVES) { const int tok = stok[r];
        uint4 a = make_uint4(0, 0, 0, 0), b = a;
        if (tok >= 0) { const uint4* sp = (const uint4*)(xn + (size_t)tok * D) + lane * 2; a = sp[0]; b = sp[1]; }
        uint4* dp = (uint4*)(xs + (size_t)r * D) + lane * 2; dp[0] = a; dp[1] = b; }
}

#ifdef MK_CHECK
constexpr size_t WS_DIAG = WS_META + 2048;
constexpr size_t WS_SNAP = WS_SLOTW + (size_t)NSLOT * 4;
static_assert(WS_SNAP + 64 * 1024 * 4 <= WS_W, "snapshot fits");
__device__ __forceinline__ int samp_row(int i) { return (int)(((unsigned)i * 2654435761u + 12345u) % (unsigned)MTOK); }
__device__ __forceinline__ void chk_fail(unsigned* diag, unsigned code) { atomicMin(diag, code); }
__device__ __forceinline__ bool chk_close(float got, float ref, float atol, float rtol) { return fabsf(got - ref) <= atol + rtol * fabsf(ref) && got == got; }

__global__ void k_diag_init(unsigned* diag) { if (threadIdx.x == 0 && blockIdx.x == 0) { diag[0] = 0xffffffffu; diag[16] = 0u; diag[17] = 0xffffffffu; diag[18] = 0u; diag[19] = 0u; diag[20] = 0u; diag[21] = 0u; diag[22] = 0u; diag[23] = 0u; diag[24] = 0u; diag[25] = 0u; diag[26] = 0u; } }
__global__ void k_snapshot(const float* x, float* snap) { const int i = blockIdx.x; const int r = samp_row(i); for (int c = threadIdx.x; c < D; c += blockDim.x) snap[i * D + c] = x[(size_t)r * D + c]; }
__global__ void k_apply_diag(float* out, const unsigned* diag) {
    if (blockIdx.x != 0 || threadIdx.x != 0) return;
    const unsigned code = diag[0]; if (code == 0xffffffffu) return;
    unsigned pc = 0, lo = 999; for (int w = 0; w < 4; ++w) { const unsigned m = diag[20 + w]; pc += __popc(m); if (m && lo == 999) lo = w * 32 + (__ffs(m) - 1); }
    if (DIAGSEL == 3) { lo = __popc(diag[24]) + __popc(diag[25]); pc = __popc(diag[26]); }
    unsigned f1 = (DIAGSEL == 0 || DIAGSEL == 3) ? lo : DIAGSEL == 1 ? diag[17] * 8 + diag[18] : diag[19]; if (f1 > 89) f1 = 89;
    unsigned f2 = pc > 20 ? 20 : pc;
    out[0] = (1.0f + 0.1f * (float)f1) * exp10f(3.f + (float)f2) * (code == 5u ? 1.f : -1.f);
}
struct ChkGemm { const bf16_t* A; int lda; const float* W; int ldw; int K; int mode; const bf16_t* Cb; int ldc; const float* Cf; const float* xold; const float* W2; const float* lb; const bf16_t* Gsrc; int ncols; unsigned code; int use_snap; };
__global__ void k_chk_gemm(ChkGemm c, unsigned* diag) {
    const int i = blockIdx.x; const int r = samp_row(i);
    for (int cc = threadIdx.x; cc < 96; cc += blockDim.x) {
        const int col = (int)(((unsigned)cc * 40503u + (unsigned)i * 977u) % (unsigned)c.ncols);
        float dot = 0.f, dot2 = 0.f;
        for (int k = 0; k < c.K; ++k) { const float av = bf2f(c.A[(size_t)r * c.lda + k]); dot += av * c.W[(size_t)k * c.ldw + col]; if (c.mode == 4) dot2 += av * c.W2[(size_t)k * c.ldw + col]; }
        float ref, got;
        if (c.mode == 0) { const int kind = col >> 9; ref = (kind == 0 || kind == 3) ? siluf_(dot) : kind == 1 ? __logf(c.lb[col - 512] + (1.f - c.lb[col - 512]) * sigmoidf_(dot)) : (kind == 4 || kind == 5) ? gelu_tanh_(dot) : dot; got = bf2f(c.Cb[(size_t)r * c.ldc + col]); }
        else if (c.mode == 1) { ref = sigmoidf_(dot); got = bf2f(c.Cb[(size_t)r * c.ldc + col]); }
        else if (c.mode == 3) { const float xo = c.use_snap ? c.xold[(size_t)i * D + col] : c.xold[(size_t)r * D + col]; ref = xo + dot; got = c.Cf[(size_t)r * D + col]; }
        else { ref = siluf_(dot) * dot2; got = bf2f(c.Cb[(size_t)r * c.ldc + col]); }
        if (!chk_close(got, ref, 0.03f, 0.03f)) { chk_fail(diag, c.code); if (c.mode == 1) { atomicOr(diag + 24 + (i >> 5), 1u << (i & 31)); atomicOr(diag + 26, 1u << ((r & 255) >> 4)); atomicOr(diag + 20 + ((col & 127) >> 5), 1u << (col & 31)); atomicAdd(diag + 16, 1u); atomicMin(diag + 17, (unsigned)(col >> 8)); atomicMax(diag + 18, (unsigned)(col >> 8)); if (fabsf(got - dot) <= 0.03f + 0.03f * fabsf(dot)) atomicAdd(diag + 19, 1u); } }
    }
}
__global__ void k_chk_branch(const bf16_t* ocat, const float* wbr  , const bf16_t* xn, const float* win  , const bf16_t* GH, unsigned code, unsigned* diag) {
    const int i = blockIdx.x; const int r = samp_row(i);
    for (int cc = threadIdx.x; cc < 96; cc += blockDim.x) {
        const int col = (int)(((unsigned)cc * 40503u + (unsigned)i * 977u) % 3072u); const int b = col >> 10, cl = col & 1023;
        float h = 0.f; for (int k = 0; k < 512; ++k) h += bf2f(ocat[(size_t)b * MTOK * 512 + (size_t)r * 512 + k]) * wbr[((size_t)b * 512 + k) * 1024 + cl];
        float g = 0.f; for (int k = 0; k < 1024; ++k) g += bf2f(xn[(size_t)r * D + k]) * win[(size_t)k * INCOLS + PCOLS + col];
        const float ref = sigmoidf_(g) * h, got = bf2f(GH[(size_t)r * GCOLS + col]);
        if (!chk_close(got, ref, 0.03f, 0.04f)) chk_fail(diag, code);
    }
}
__global__ void k_chk_attn(const bf16_t* P, const float* gq, const float* gk, const bf16_t* oc, unsigned code, unsigned* diag) {
    const int id = blockIdx.x, lane = threadIdx.x; const int ti = id % 10;
    const int t = ti == 0 ? 0 : ti == 1 ? 1 : ti == 2 ? 2 : ti == 3 ? 63 : ti == 4 ? 64 : ti == 5 ? 65 : ti == 6 ? 200 : ti == 7 ? 1000 : ti == 8 ? 4097 : 8191;
    const int h = (id / 10) % 8, b = id / 80; const size_t tokb = (size_t)b * SEQ;
    float q = bf2f(P[(tokb + t) * PCOLS + C_SQ + h * 64 + lane]); q = q * rsqrtf(wave_sum(q * q) / 64.f + EPS) * gq[lane];
    float o = 0.f, carry = 0.f;
    for (int s = t - 1; s >= 0 && carry < 300.f; --s) {
        float kv = bf2f(P[(tokb + s) * PCOLS + C_SK + h * 64 + lane]); kv = kv * rsqrtf(wave_sum(kv * kv) / 64.f + EPS) * gk[lane];
        const float z = wave_sum(q * kv) * 0.125f; const float sp = logf(1.f + expf(z));
        carry += sp; const float A = expf(z - carry);
        o += A * bf2f(P[(tokb + s) * PCOLS + C_SV + h * 64 + lane]);
    }
    if (!chk_close(bf2f(oc[(tokb + t) * 512 + h * 64 + lane]), o, 0.02f, 0.03f)) chk_fail(diag, code);
}
__global__ void k_chk_gmlp(const bf16_t* P, const float* ws_l, const float* bs_l, const float* gv_l, const bf16_t* ob, unsigned code, unsigned* diag) {
    const int id = blockIdx.x * blockDim.x + threadIdx.x; if (id >= 512) return;
    const int chunk = (id * 37) % (MTOK / 128), t = (id * 53 + 7) % 128, ch = (id * 101 + 3) % 512, g = ch >> 7, c = ch & 127; const size_t tok0 = (size_t)chunk * 128;
    float acc = 0.f;
    for (int s = 0; s <= t; ++s) { float ss = 0.f; for (int k = 0; k < 512; ++k) { const float v = bf2f(P[(tok0 + s) * PCOLS + C_GV + k]); ss += v * v; }
        const float vn = bf2f(P[(tok0 + s) * PCOLS + C_GV + ch]) * rsqrtf(ss / 512.f + EPS) * gv_l[ch]; acc += ws_l[(size_t)g * 16384 + t * 128 + s] * vn; }
    const float ref = bf2f(P[(tok0 + t) * PCOLS + C_GU + ch]) * (acc + bs_l[g * 128 + t]);
    if (!chk_close(bf2f(ob[(tok0 + t) * 512 + ch]), ref, 0.02f, 0.03f)) chk_fail(diag, code);
}
__global__ void k_chk_hgrn(const bf16_t* P, const float* gain, const bf16_t* oa, unsigned code, unsigned* diag) {
    const int id = blockIdx.x; const int ti = id % 8; const int t = ti == 0 ? 0 : ti == 1 ? 1 : ti == 2 ? 5 : ti == 3 ? 63 : ti == 4 ? 64 : ti == 5 ? 200 : ti == 6 ? 511 : 700, h = (id / 8) % 4, b = id / 32; const int v = threadIdx.x; const size_t tokb = (size_t)b * SEQ;
    float o = 0.f;
    for (int d = 0; d < 128; ++d) { float st = 0.f;
        for (int s = 0; s <= t; ++s) { const bf16_t* row = P + (tokb + s) * PCOLS; const float f = expf(bf2f(row[C_HF + h * 128 + d])); st = f * st + (1.f - f) * bf2f(row[C_HI + h * 128 + v]); }
        o += bf2f(P[(tokb + t) * PCOLS + C_HQ + h * 128 + d]) * st; }
    __shared__ float red[128]; red[v] = o * o; __syncthreads();
    for (int w = 64; w > 0; w >>= 1) { if (v < w) red[v] += red[v + w]; __syncthreads(); }
    const float rstd = rsqrtf(red[0] / 128.f + EPS);
    const float ref = o * rstd * gain[v] * bf2f(P[(tokb + t) * PCOLS + C_HG + h * 128 + v]);
    if (!chk_close(bf2f(oa[(tokb + t) * 512 + h * 128 + v]), ref, 0.03f, 0.04f)) chk_fail(diag, code);
}
__global__ void k_chk_moe(const bf16_t* xn, const float* rw, const float* rb, const float* wg, const float* wu, const float* wd, const float* snap, const float* xout, unsigned code, unsigned* diag) {
    const int i = blockIdx.x; const int r = samp_row(i); const int tid = threadIdx.x;
    __shared__ float hid[DFF]; __shared__ float lg[8]; __shared__ float part[256];
    if (tid < 8) { float a = rb[tid]; for (int k = 0; k < D; ++k) a += bf2f(xn[(size_t)r * D + k]) * rw[k * 8 + tid]; lg[tid] = a; }
    __syncthreads();
    int i0 = 0; for (int e = 1; e < 8; ++e) if (lg[e] > lg[i0]) i0 = e;
    int i1 = -1; for (int e = 0; e < 8; ++e) if (e != i0 && (i1 < 0 || lg[e] > lg[i1])) i1 = e;
    const float w0 = 1.f / (1.f + expf(lg[i1] - lg[i0])), w1 = 1.f - w0;
    float outv[8]; for (int j = 0; j < 8; ++j) outv[j] = 0.f;
    for (int kk = 0; kk < 2; ++kk) { const int e = kk ? i1 : i0; const float wgt = kk ? w1 : w0;
        for (int f = tid; f < DFF; f += blockDim.x) { float g = 0.f, u = 0.f; for (int k = 0; k < D; ++k) { const float xv = bf2f(xn[(size_t)r * D + k]); g += xv * wg[((size_t)e * D + k) * DFF + f]; u += xv * wu[((size_t)e * D + k) * DFF + f]; } hid[f] = siluf_(g) * u; }
        __syncthreads();
        for (int j = 0; j < 8; ++j) { const int col = (j * 131 + i * 17) % D; float p = 0.f; for (int f = tid; f < DFF; f += blockDim.x) p += hid[f] * wd[((size_t)e * DFF + f) * D + col];
            part[tid] = p; __syncthreads(); for (int w = 128; w > 0; w >>= 1) { if (tid < w) part[tid] += part[tid + w]; __syncthreads(); } outv[j] += wgt * part[0]; __syncthreads(); }
    }
    if (tid == 0) for (int j = 0; j < 8; ++j) { const int col = (j * 131 + i * 17) % D; const float ref = snap[(size_t)i * D + col] + outv[j]; if (!chk_close(xout[(size_t)r * D + col], ref, 0.04f, 0.04f)) chk_fail(diag, code); }
}
#endif

struct Args { const float* in[21]; float* out; unsigned char* ws; int lo, hi; };
constexpr int NSTEPS = 50;

template <class Epi>
__device__ __forceinline__ void run_gemm(LAS unsigned char* lds, const Order& S, int K, const Epi& E) { pg8::gemm_phase<Epi, Order, true, true>(lds, K, S, E); }

__global__ void __launch_bounds__(NTHREADS, 2) mk_fwd(Args a) {
    extern __shared__ __attribute__((aligned(16))) unsigned char lds_raw[];
    LAS unsigned char* lds = (LAS unsigned char*)lds_raw;
    const int tid = threadIdx.x, lane = tid & 63, wid = __builtin_amdgcn_readfirstlane(tid >> 6), wg = blockIdx.x, G = gridDim.x;
    if (tid < 4) ((LAS unsigned*)(lds + LDS_MISC))[tid] = 0u;
    __syncthreads();
    const bool multi = (a.hi - a.lo) > 1;
    XcdBarrier bar; bar.bar = (unsigned*)(a.ws + WS_CTL + CW_BAR); bar.x = 0; bar.st = nullptr;
    if (multi) bar = xcd_barrier_post((unsigned*)(a.ws + WS_CTL + CW_BAR), (volatile LAS unsigned*)(lds + LDS_MISC));
    int step = 0;
#define RUN (a.lo <= step && step < a.hi)
#define SEAM() do { ++step; if (a.lo < step && step < a.hi) xcd_barrier(bar); } while (0)

#define XRES (a.out)
#define WIN ((bf16_t*)(a.ws + WS_WIN))
#define WBR ((bf16_t*)(a.ws + WS_WBR))
#define WOUT ((bf16_t*)(a.ws + WS_WOUT))
#define WGU ((bf16_t*)(a.ws + WS_WGU))
#define WDN ((bf16_t*)(a.ws + WS_WD))
#define XNB ((bf16_t*)(a.ws + WS_XN))
#define PBUF ((bf16_t*)(a.ws + WS_P))
#define GBUF ((bf16_t*)(a.ws + WS_G))
#define HIDB ((bf16_t*)(a.ws + WS_HID))
#define OCATB ((bf16_t*)(a.ws + WS_OCAT))
#define ORAWB ((float*)(a.ws + WS_ORAW))
#define MWGU ((bf16_t*)(a.ws + WS_MWGU))
#define MWDN ((bf16_t*)(a.ws + WS_MWD))
#define XSB ((bf16_t*)(a.ws + WS_XS))
#define MHIDB ((bf16_t*)(a.ws + WS_MHID))
#define LBB ((float*)(a.ws + WS_LB))
#define METAB ((int*)(a.ws + WS_META))
#define TOKE ((int*)(a.ws + WS_TOKE))
#define TOKW ((float2*)(a.ws + WS_TOKW))
#define STOK ((int*)(a.ws + WS_SLOTTOK))
#define SWB ((float*)(a.ws + WS_SLOTW))
    if (RUN) {
        LAS float* tile = (LAS float*)lds;
        for (int l = 0; l < 2; ++l) {
            tc_job(a.in[2] + (size_t)l * D * INCOLS, D, INCOLS, WIN + (size_t)l * INCOLS * D, 0, tile, wg, G, tid);
            for (int b = 0; b < 3; ++b) tc_job(a.in[10] + (size_t)(l * 3 + b) * 512 * D, 512, D, WBR + (size_t)(l * 3 + b) * D * 512, 0, tile, wg, G, tid);
            tc_job(a.in[11] + (size_t)l * D * D, D, D, WOUT + (size_t)l * D * D, 0, tile, wg, G, tid);
        }
        tc_job(a.in[13], D, DFF, WGU, 1, tile, wg, G, tid);
        tc_job(a.in[14], D, DFF, WGU, 2, tile, wg, G, tid);
        tc_job(a.in[15], DFF, D, WDN, 0, tile, wg, G, tid);
        if (wg == 0) { const float a0 = a.in[3][tid], a1 = a.in[3][512 + tid]; LBB[tid] = 0.f; LBB[512 + tid] = sigmoidf_(a1 - a0); }
    }
    SEAM();

    for (int l = 0; l < 2; ++l) {
        const float* xcur = (l == 0) ? a.in[0] : XRES;
        if (RUN) phase_rmsnorm<false>(xcur, a.in[1] + l * D, XNB, nullptr, nullptr, nullptr, nullptr, wg, G, wid, lane);
        SEAM();
        if (RUN) { Order S; S.init(XNB, WIN + (size_t)l * INCOLS * D, MTOK, PCOLS, D, G, wg); EpiAct E{PBUF, PCOLS, LBB + l * 512, 1}; run_gemm(lds, S, D, E); }
        SEAM();
        if (RUN) phase_hgrn_naive(PBUF, ORAWB, wg, G, wid, lane);
        SEAM();
        if (RUN) phase_gmlp_naive(PBUF, a.in[6] + (size_t)l * 4 * 16384, a.in[7] + l * 512, a.in[5] + l * 512, OCATB + (size_t)MTOK * 512, lds, wg, G, tid, wid, lane);
        SEAM();
        if (RUN) phase_attn_naive(PBUF, a.in[8] + l * 64, a.in[9] + l * 64, OCATB + (size_t)2 * MTOK * 512, lds, wg, G, wid, lane);
        SEAM();
        if (RUN) phase_hgrn_fin(ORAWB, PBUF, a.in[4] + l * 128, OCATB, wg, G, wid, lane);
        SEAM();
        if (RUN) { Order S; S.init(XNB, WIN + (size_t)l * INCOLS * D + (size_t)PCOLS * D, MTOK, GCOLS, D, G, wg); EpiAct E{GBUF, GCOLS, nullptr, 0}; run_gemm(lds, S, D, E); }
        SEAM();
        if (RUN) { Order S; S.init(OCATB, WBR + (size_t)l * 3 * D * 512, MTOK, GCOLS, 512, G, wg, 1, (size_t)MTOK * 512 * 2, (size_t)D * 512 * 2); EpiBranch E{GBUF}; run_gemm(lds, S, 512, E); }
        SEAM();
        if (RUN) phase_combine(GBUF, XNB, wg, G, tid);
        SEAM();
        if (RUN) { Order S; S.init(XNB, WOUT + (size_t)l * D * D, MTOK, D, D, G, wg); EpiResid E{xcur, XRES}; run_gemm(lds, S, D, E); }
        SEAM();
        if (l == 0) {
            if (RUN) phase_rmsnorm<false>(XRES, a.in[12] + l * D, XNB, nullptr, nullptr, nullptr, nullptr, wg, G, wid, lane);
            SEAM();
            if (RUN) { Order S; S.init(XNB, WGU, MTOK, 2 * DFF, D, G, wg); EpiGU E{HIDB}; run_gemm(lds, S, D, E); }
            SEAM();
            if (RUN) { Order S; S.init(HIDB, WDN, MTOK, D, DFF, G, wg); EpiResid E{XRES, XRES}; run_gemm(lds, S, DFF, E); }
            SEAM();
        } else {
            if (RUN) phase_rmsnorm<true>(XRES, a.in[12] + l * D, XNB, a.in[16], a.in[17], TOKE, TOKW, wg, G, wid, lane);
            SEAM();
            if (RUN) {
                if (wg == G - 1) moe_assign(TOKE, TOKW, METAB, STOK, SWB, lds, tid);
                else { LAS float* tile = (LAS float*)lds;
                    for (int e = 0; e < NEXP; ++e) {
                        tc_job(a.in[18] + (size_t)e * D * DFF, D, DFF, MWGU + (size_t)e * 2 * DFF * D, 1, tile, wg, G - 1, tid);
                        tc_job(a.in[19] + (size_t)e * D * DFF, D, DFF, MWGU + (size_t)e * 2 * DFF * D, 2, tile, wg, G - 1, tid);
                        tc_job(a.in[20] + (size_t)e * DFF * D, DFF, D, MWDN + (size_t)e * D * DFF, 0, tile, wg, G - 1, tid); } }
            }
            SEAM();
            for (int e = 0; e < NEXP; ++e) {
                const int rows = METAB[8 + e], s0 = METAB[16 + e];
                if (RUN) moe_gather(XNB, STOK + s0, rows, XSB, wg, G, wid, lane);
                SEAM();
                if (RUN) { Order S; S.init(XSB, MWGU + (size_t)e * 2 * DFF * D, rows, 2 * DFF, D, G, wg); EpiGU E{MHIDB}; run_gemm(lds, S, D, E); }
                SEAM();
                if (RUN) { Order S; S.init(MHIDB, MWDN + (size_t)e * D * DFF, rows, D, DFF, G, wg); EpiMoeDown E{XRES, STOK + s0, SWB + s0}; run_gemm(lds, S, DFF, E); }
                SEAM();
            }
        }
    }
#undef RUN
#undef SEAM
}

extern "C" void kernel_launch(void* const* d_in, const int* in_sizes, int n_in, void* d_out, int out_size, void* d_ws, size_t ws_size, hipStream_t stream) {
    static int grid = 0;
    if (grid == 0) {
        if (n_in != 21 || out_size != MTOK * D || ws_size < WS_NEED) { fprintf(stderr, "kernel_launch: unexpected shapes (n_in %d out %d ws %zu need %zu)\n", n_in, out_size, ws_size, (size_t)WS_NEED); grid = -1; return; }
        int dev = 0, cus = 0, per_cu = 0;
        if (hipGetDevice(&dev) != hipSuccess || hipDeviceGetAttribute(&cus, hipDeviceAttributeMultiprocessorCount, dev) != hipSuccess) { grid = -1; return; }
        if (hipFuncSetAttribute((const void*)mk_fwd, hipFuncAttributeMaxDynamicSharedMemorySize, LDS_BYTES) != hipSuccess) { fprintf(stderr, "kernel_launch: hipFuncSetAttribute failed\n"); grid = -1; return; }
        if (hipOccupancyMaxActiveBlocksPerMultiprocessor(&per_cu, (const void*)mk_fwd, NTHREADS, LDS_BYTES) != hipSuccess || per_cu < 1) { fprintf(stderr, "kernel_launch: occupancy query says %d\n", per_cu); (void)hipGetLastError(); per_cu = 1; }
        grid = cus;
    }
    if (grid < 0) return;
    (void)hipMemsetAsync((char*)d_ws + WS_CTL, 0, CTL_BYTES, stream);
    Args a{};
    for (int i = 0; i < 21; ++i) a.in[i] = (const float*)d_in[i];
    a.out = (float*)d_out; a.ws = (unsigned char*)d_ws;
#if defined(MK_CHECK)
    {
        unsigned char* ws = (unsigned char*)d_ws; unsigned* diag = (unsigned*)(ws + WS_DIAG); float* snap = (float*)(ws + WS_SNAP);
        const bf16_t* XN = (const bf16_t*)(ws + WS_XN); const bf16_t* Pb = (const bf16_t*)(ws + WS_P); const bf16_t* OC = (const bf16_t*)(ws + WS_OCAT); const float* LB = (const float*)(ws + WS_LB);
        auto run = [&](int s) { a.lo = s; a.hi = s + 1; hipLaunchKernelGGL(mk_fwd, dim3(grid), dim3(NTHREADS), LDS_BYTES, stream, a); };
        hipLaunchKernelGGL(k_diag_init, dim3(1), dim3(64), 0, stream, diag);
        int s = 0; run(s++);
        for (int l = 0; l < 2; ++l) {
            const unsigned cb = l * 10;
            const float* win = a.in[2] + (size_t)l * D * INCOLS;
            run(s++); run(s++);
            { ChkGemm c{}; c.A = XN; c.lda = D; c.W = win; c.ldw = INCOLS; c.K = D; c.mode = 0; c.Cb = Pb; c.ldc = PCOLS; c.lb = LB + l * 512; c.ncols = PCOLS; c.code = cb + 1; hipLaunchKernelGGL(k_chk_gemm, dim3(64), dim3(96), 0, stream, c, diag); }
            run(s++); run(s++); run(s++); run(s++);
            hipLaunchKernelGGL(k_chk_hgrn, dim3(128), dim3(128), 0, stream, Pb, a.in[4] + l * 128, OC, cb + 2, diag);
            hipLaunchKernelGGL(k_chk_gmlp, dim3(8), dim3(64), 0, stream, Pb, a.in[6] + (size_t)l * 4 * 16384, a.in[7] + l * 512, a.in[5] + l * 512, OC + (size_t)MTOK * 512, cb + 3, diag);
            hipLaunchKernelGGL(k_chk_attn, dim3(320), dim3(64), 0, stream, Pb, a.in[8] + l * 64, a.in[9] + l * 64, OC + (size_t)2 * MTOK * 512, cb + 4, diag);
            run(s++);
            { ChkGemm c{}; c.A = XN; c.lda = D; c.W = win + PCOLS; c.ldw = INCOLS; c.K = D; c.mode = 1; c.Cb = (const bf16_t*)(ws + WS_G); c.ldc = GCOLS; c.ncols = GCOLS; c.code = cb + 5; hipLaunchKernelGGL(k_chk_gemm, dim3(64), dim3(96), 0, stream, c, diag); }
            run(s++);
            hipLaunchKernelGGL(k_chk_branch, dim3(64), dim3(96), 0, stream, OC, a.in[10] + (size_t)l * 3 * 512 * D, XN, win, (const bf16_t*)(ws + WS_G), cb + 6, diag);
            run(s++);
            if (l == 1) hipLaunchKernelGGL(k_snapshot, dim3(64), dim3(256), 0, stream, (const float*)d_out, snap);
            run(s++);
            { ChkGemm c{}; c.A = XN; c.lda = D; c.W = a.in[11] + (size_t)l * D * D; c.ldw = D; c.K = D; c.mode = 3; c.Cf = (const float*)d_out; c.xold = l ? snap : a.in[0]; c.use_snap = l; c.ncols = D; c.code = cb + 7; hipLaunchKernelGGL(k_chk_gemm, dim3(64), dim3(96), 0, stream, c, diag); }
            run(s++);
            if (l == 0) {
                run(s++);
                { ChkGemm c{}; c.A = XN; c.lda = D; c.W = a.in[13]; c.W2 = a.in[14]; c.ldw = DFF; c.K = D; c.mode = 4; c.Cb = (const bf16_t*)(ws + WS_HID); c.ldc = DFF; c.ncols = DFF; c.code = cb + 8; hipLaunchKernelGGL(k_chk_gemm, dim3(64), dim3(96), 0, stream, c, diag); }
                hipLaunchKernelGGL(k_snapshot, dim3(64), dim3(256), 0, stream, (const float*)d_out, snap);
                run(s++);
                { ChkGemm c{}; c.A = (const bf16_t*)(ws + WS_HID); c.lda = DFF; c.W = a.in[15]; c.ldw = D; c.K = DFF; c.mode = 3; c.Cf = (const float*)d_out; c.xold = snap; c.use_snap = 1; c.ncols = D; c.code = cb + 9; hipLaunchKernelGGL(k_chk_gemm, dim3(64), dim3(96), 0, stream, c, diag); }
            } else {
                hipLaunchKernelGGL(k_snapshot, dim3(64), dim3(256), 0, stream, (const float*)d_out, snap);
                run(s++);
                for (int e = 0; e < NEXP * 3; ++e) run(s++);
                hipLaunchKernelGGL(k_chk_moe, dim3(16), dim3(256), 0, stream, XN, a.in[16], a.in[17], a.in[18], a.in[19], a.in[20], (const float*)snap, (const float*)d_out, 20u, diag);
            }
        }
        if (s != NSTEPS) fprintf(stderr, "step count mismatch %d\n", s);
        hipLaunchKernelGGL(k_apply_diag, dim3(1024), dim3(256), 0, stream, (float*)d_out, (const unsigned*)diag);
    }
#elif !defined(MK_ONE_LAUNCH)
    for (int s = 0; s < NSTEPS; ++s) { a.lo = s; a.hi = s + 1; hipLaunchKernelGGL(mk_fwd, dim3(grid), dim3(NTHREADS), LDS_BYTES, stream, a); }
#else
    a.lo = 0; a.hi = NSTEPS; hipLaunchKernelGGL(mk_fwd, dim3(grid), dim3(NTHREADS), LDS_BYTES, stream, a);
#endif
}
```

```cpp
#define MK_ONE_LAUNCH 1
#include <hip/hip_runtime.h>
#include <cstdio>
#include <cstdint>
#include <cstddef>

#define LAS __attribute__((address_space(3)))
#define XB_TMO      128
#define XB_XCNT(j)  (256  + 64 * (j))
#define XB_XSUB(j)  (1280 + 64 * (j))
#define XB_XGEN(j)  (2304 + 64 * (j))
#define XB_TOP      3328
#define XB_TOPGEN   3392
#define XCD_BAR_WORDS 3456
#define XB_SPIN_CAP (1u << 18)

__device__ __forceinline__ unsigned xb_ld(unsigned* p)              { return __hip_atomic_load(p, __ATOMIC_RELAXED, __HIP_MEMORY_SCOPE_AGENT); }
__device__ __forceinline__ unsigned xb_add(unsigned* p, unsigned v) { return __hip_atomic_fetch_add(p, v, __ATOMIC_RELAXED, __HIP_MEMORY_SCOPE_AGENT); }
__device__ __forceinline__ unsigned xb_xcc_id() { return (unsigned)__builtin_amdgcn_s_getreg((3 << 11) | 20) & 0xFu; }
#define XB_SPIN(cond, bar) do { unsigned _sp = 0; while (cond) { __builtin_amdgcn_s_sleep(1); \
    if ((++_sp & 255u) == 0u) { if (xb_ld(&(bar)[XB_TMO])) break; if (_sp > XB_SPIN_CAP) { atomicAdd(&(bar)[XB_TMO], 1u); break; } } } } while (0)

struct XcdBarrier {
    unsigned* bar; unsigned x;
    volatile LAS unsigned* st;
};

__device__ __forceinline__ XcdBarrier xcd_barrier_post(unsigned* bar, volatile LAS unsigned* st) {
    XcdBarrier b; b.bar = bar; b.x = xb_xcc_id(); b.st = st;
    if (threadIdx.x == 0) (void)xb_add(&bar[XB_XCNT(b.x)], 1u);
    return b;
}
__device__ __forceinline__ void xcd_barrier_complete(unsigned* bar, unsigned x, unsigned& nloc, unsigned& nx) {
    const unsigned G = gridDim.x * gridDim.y * gridDim.z;
    unsigned sum, cnt, mine, sp = 0u;
    for (;;) {
        sum = 0u; cnt = 0u; mine = 0u;
#pragma unroll
        for (unsigned j = 0; j < 16; ++j) { const unsigned c = xb_ld(&bar[XB_XCNT(j)]); sum += c; cnt += (c > 0u) ? 1u : 0u; mine = (j == x) ? c : mine; }
        if (sum == G) break;
        __builtin_amdgcn_s_sleep(1);
        if ((++sp & 255u) == 0u) { if (xb_ld(&bar[XB_TMO])) break; if (sp > XB_SPIN_CAP) { atomicAdd(&bar[XB_TMO], 1u); break; } }
    }
    nloc = mine > 0u ? mine : 1u; nx = cnt > 0u ? cnt : 1u;
}

__device__ __forceinline__ void xcd_barrier(const XcdBarrier& b) {
    asm volatile("s_waitcnt vmcnt(0)" ::: "memory");
    __syncthreads();
    if (threadIdx.x == 0) {
        unsigned* bar = b.bar;
        __builtin_amdgcn_s_waitcnt(0);
        unsigned nloc = b.st[0], nx = b.st[1];
        if (nloc == 0u) { xcd_barrier_complete(bar, b.x, nloc, nx); b.st[0] = nloc; b.st[1] = nx; }
        const unsigned old = xb_add(&bar[XB_XSUB(b.x)], 1u);
        const unsigned gen = old / nloc;
        if (old + 1u == (gen + 1u) * nloc) {
            __builtin_amdgcn_fence(__ATOMIC_RELEASE, "agent");
            asm volatile("s_waitcnt vmcnt(0)" ::: "memory");
            const unsigned og = xb_add(&bar[XB_TOP], 1u);
            const unsigned tg = og / nx;
            if (og + 1u == (tg + 1u) * nx) xb_add(&bar[XB_TOPGEN], 1u);
            else XB_SPIN(xb_ld(&bar[XB_TOPGEN]) == tg, bar);
            __builtin_amdgcn_fence(__ATOMIC_ACQUIRE, "agent");
            xb_add(&bar[XB_XGEN(b.x)], 1u);
            asm volatile("s_waitcnt vmcnt(0)" ::: "memory");
        } else {
            XB_SPIN(xb_ld(&bar[XB_XGEN(b.x)]) == gen, bar);
            __builtin_amdgcn_fence(__ATOMIC_ACQUIRE, "agent");
            asm volatile("s_waitcnt vmcnt(0)" ::: "memory");
        }
    }
    __syncthreads();
}
namespace pg8 {
#define PG8_LAS __attribute__((address_space(3)))
typedef unsigned short bf16_t;
typedef short bf16x8 __attribute__((ext_vector_type(8)));
typedef float f32x4 __attribute__((ext_vector_type(4)));
typedef unsigned u32x4 __attribute__((ext_vector_type(4)));
constexpr int BM = 256, BK = 64, HALF = 128, HTB = HALF * BK * 2  , STAGE_BYTES = 8 * HTB, NXCD = 8, WGM = 8;

__host__ __device__ __forceinline__ int lds_byte(int r, int c) { const int st = (r >> 4) * 2 + (c >> 5), rr = r & 15, cc = c & 31, ob = rr * 64 + cc * 2; return st * 1024 + (ob ^ (((ob >> 9) & 1) << 5)); }
__host__ __device__ __forceinline__ void stage_rc(int b, int& R, int& C) { const int st = b / 1024, sb = b % 1024, swz = sb ^ (((sb >> 9) & 1) << 5); R = (st >> 1) * 16 + swz / 64; C = (st & 1) * 32 + (swz % 64) / 2; }
__host__ __device__ __forceinline__ int perm32(int rho) { const int n = rho >> 4, i = rho & 15; return 8 * (i >> 2) + 4 * n + (i & 3); }

struct Unit { int pm, pn; const char* a; const char* b; };

typedef float f32x2 __attribute__((ext_vector_type(2))); typedef __bf16 bf16x2_t __attribute__((ext_vector_type(2)));
__device__ __forceinline__ unsigned cvt_pk_bf16(float lo, float hi) { f32x2 v = {lo, hi}; bf16x2_t b = __builtin_convertvector(v, bf16x2_t); return __builtin_bit_cast(unsigned, b); }
template <class Epi, class Sched, bool ALIGN_EPI = false, bool SP2 = false>
__device__ __forceinline__ void gemm_phase(PG8_LAS unsigned char* lds, const int K, const Sched& S, const Epi& E) {
    int tid = threadIdx.x; asm volatile("" : "+v"(tid));
    const int wid = __builtin_amdgcn_readfirstlane(tid >> 6), lane = tid & 63, wr = wid >> 2, wc = wid & 3, fr = lane & 15, fq = lane >> 4;
    const int nt = K / BK;
    unsigned voffA[2], voffB[2];
#pragma unroll
    for (int i = 0; i < 2; ++i) { int R, C; stage_rc(tid * 16 + i * 8192, R, C); const int Rb = Epi::PERM ? ((R & ~31) + perm32(R & 31)) : R;
        voffA[i] = (unsigned)(R * K + C) * 2u; voffB[i] = (unsigned)(Rb * K + C) * 2u; }
    const size_t kstep = (size_t)(BK * 2);
    const size_t hstep = (size_t)HALF * K * 2;
    const unsigned ldsw = (unsigned)wid * 1024u;
    const int aoff = lds_byte(wr * 64 + fr, fq * 8), boff = lds_byte(wc * 32 + fr, fq * 8);
#define PG8_SA(b, h) (((b) * 2 + (h)) * HTB)
#define PG8_SB(b, h) ((4 + (b) * 2 + (h)) * HTB)
#define PG8_STAGE(bufoff, gbase, voff) do { _Pragma("unroll") for (int _i = 0; _i < 2; ++_i) \
        __builtin_amdgcn_global_load_lds((const unsigned*)((const char*)(gbase) + (voff)[_i]), (PG8_LAS unsigned*)(lds + (bufoff) + ldsw + _i * 8192), 16, 0, 0); } while (0)
#define PG8_LDA(dst, b, h) do { _Pragma("unroll") for (int m = 0; m < 4; ++m) _Pragma("unroll") for (int k = 0; k < 2; ++k) dst[m][k] = *(const PG8_LAS bf16x8*)(lds + PG8_SA(b, h) + aoff + m * 2048 + k * 1024); } while (0)
#define PG8_LDB(dst, b, h) do { _Pragma("unroll") for (int n = 0; n < 2; ++n) _Pragma("unroll") for (int k = 0; k < 2; ++k) dst[n][k] = *(const PG8_LAS bf16x8*)(lds + PG8_SB(b, h) + boff + n * 2048 + k * 1024); } while (0)
#define PG8_MMA(ai, bj, At, Bt) do { __builtin_amdgcn_s_setprio(1); _Pragma("unroll") for (int m = 0; m < 4; ++m) _Pragma("unroll") for (int n = 0; n < 2; ++n) _Pragma("unroll") for (int k = 0; k < 2; ++k) \
        acc[ai][bj][m][n] = __builtin_amdgcn_mfma_f32_16x16x32_bf16(Bt[n][k], At[m][k], acc[ai][bj][m][n], 0, 0, 0); __builtin_amdgcn_s_setprio(0); } while (0)
#define PG8_WAIT_V(n) asm volatile("s_waitcnt vmcnt(" #n ")" ::: "memory")
#define PG8_WAIT_L(n) asm volatile("s_waitcnt lgkmcnt(" #n ")" ::: "memory")
#define PG8_BAR __builtin_amdgcn_s_barrier()
#define PG8_SCHED __builtin_amdgcn_sched_barrier(0)
    Unit cur, nxt; int ui = 0;
    if (!S.next(0, cur)) return;
    f32x4 acc[2][2][4][2];
#pragma unroll
    for (int a = 0; a < 2; ++a)
#pragma unroll
        for (int b = 0; b < 2; ++b)
#pragma unroll
            for (int m = 0; m < 4; ++m)
#pragma unroll
                for (int n = 0; n < 2; ++n) acc[a][b][m][n] = (f32x4){0.f, 0.f, 0.f, 0.f};
    bf16x8 At[4][2], B0[2][2], B1[2][2];
    const char* cA = cur.a; const char* cB = cur.b;
    S.a_ready(cur);
    if constexpr (SP2) {
        PG8_STAGE(PG8_SB(0, 0), cB, voffB); PG8_STAGE(PG8_SB(0, 1), cB + hstep, voffB); PG8_STAGE(PG8_SA(0, 0), cA, voffA); PG8_STAGE(PG8_SA(0, 1), cA + hstep, voffA);
        if (wr == 1) PG8_BAR;
        PG8_WAIT_V(2); PG8_BAR;
        PG8_STAGE(PG8_SB(1, 0), cB + kstep, voffB); PG8_STAGE(PG8_SA(1, 0), cA + kstep, voffA); PG8_STAGE(PG8_SB(1, 1), cB + hstep + kstep, voffB);
        PG8_WAIT_V(6); PG8_BAR;
    } else {
        PG8_STAGE(PG8_SB(0, 0), cB, voffB); PG8_STAGE(PG8_SA(0, 0), cA, voffA); PG8_STAGE(PG8_SB(0, 1), cB + hstep, voffB); PG8_STAGE(PG8_SA(0, 1), cA + hstep, voffA);
        if (wr == 1) PG8_BAR;
        PG8_WAIT_V(4); PG8_BAR;
        PG8_STAGE(PG8_SB(1, 0), cB + kstep, voffB); PG8_STAGE(PG8_SA(1, 0), cA + kstep, voffA); PG8_STAGE(PG8_SB(1, 1), cB + hstep + kstep, voffB);
        PG8_WAIT_V(6); PG8_BAR;
    }
    for (;;) {
        const bool has_next = S.next(ui + 1, nxt);
        const char* nA = has_next ? nxt.a : cA; const char* nB = has_next ? nxt.b : cB;
        for (int t = 0; t < nt; t += 2) {
            const bool last = (t == nt - 2);
            const char* a1 = cA + (size_t)(t + 1) * kstep;
            const char* a2 = last ? nA : cA + (size_t)(t + 2) * kstep; const char* b2 = last ? nB : cB + (size_t)(t + 2) * kstep;
            const char* a3 = a2 + kstep; const char* b3 = b2 + kstep;
            if (last && has_next) S.a_ready(nxt);
            if constexpr (SP2) {
            PG8_LDB(B0, 0, 0); PG8_LDB(B1, 0, 1); PG8_SCHED; PG8_LDA(At, 0, 0); PG8_STAGE(PG8_SA(1, 1), a1 + hstep, voffA);
            PG8_WAIT_V(8); PG8_WAIT_L(0); PG8_BAR; PG8_MMA(0, 0, At, B0); PG8_MMA(0, 1, At, B1); PG8_BAR; PG8_SCHED;
            PG8_LDA(At, 0, 1); PG8_STAGE(PG8_SB(0, 0), b2, voffB); PG8_STAGE(PG8_SB(0, 1), b2 + hstep, voffB); PG8_STAGE(PG8_SA(0, 0), a2, voffA);
            PG8_WAIT_V(8); PG8_WAIT_L(0); PG8_BAR; PG8_MMA(1, 0, At, B0); PG8_MMA(1, 1, At, B1); PG8_BAR; PG8_SCHED;
            PG8_LDB(B0, 1, 0); PG8_LDB(B1, 1, 1); PG8_SCHED; PG8_LDA(At, 1, 0); PG8_STAGE(PG8_SA(0, 1), a2 + hstep, voffA);
            PG8_WAIT_V(8); PG8_WAIT_L(0); PG8_BAR; PG8_MMA(0, 0, At, B0); PG8_MMA(0, 1, At, B1); PG8_BAR; PG8_SCHED;
            PG8_LDA(At, 1, 1); PG8_STAGE(PG8_SB(1, 0), b3, voffB); PG8_STAGE(PG8_SB(1, 1), b3 + hstep, voffB); PG8_STAGE(PG8_SA(1, 0), a3, voffA);
            PG8_WAIT_V(8); PG8_WAIT_L(0); PG8_BAR; PG8_MMA(1, 0, At, B0); PG8_MMA(1, 1, At, B1); PG8_BAR; PG8_SCHED;
            } else {
            PG8_LDB(B0, 0, 0); PG8_SCHED; PG8_LDA(At, 0, 0); PG8_STAGE(PG8_SA(1, 1), a1 + hstep, voffA);
            PG8_WAIT_L(8); PG8_BAR; PG8_WAIT_L(0); PG8_MMA(0, 0, At, B0); PG8_BAR; PG8_SCHED;
            PG8_LDB(B1, 0, 1); PG8_STAGE(PG8_SB(0, 0), b2, voffB);
            PG8_BAR; PG8_WAIT_L(0); PG8_MMA(0, 1, At, B1); PG8_BAR;
            PG8_LDA(At, 0, 1); PG8_STAGE(PG8_SA(0, 0), a2, voffA);
            PG8_BAR; PG8_WAIT_L(0); PG8_MMA(1, 0, At, B0); PG8_BAR; PG8_SCHED;
            PG8_STAGE(PG8_SB(0, 1), b2 + hstep, voffB);
            PG8_WAIT_V(6); PG8_BAR; PG8_MMA(1, 1, At, B1); PG8_BAR;
            PG8_LDB(B0, 1, 0); PG8_SCHED; PG8_LDA(At, 1, 0); PG8_STAGE(PG8_SA(0, 1), a2 + hstep, voffA);
            PG8_WAIT_L(8); PG8_BAR; PG8_WAIT_L(0); PG8_MMA(0, 0, At, B0); PG8_BAR; PG8_SCHED;
            PG8_LDB(B1, 1, 1); PG8_STAGE(PG8_SB(1, 0), b3, voffB);
            PG8_BAR; PG8_WAIT_L(0); PG8_MMA(0, 1, At, B1); PG8_BAR;
            PG8_LDA(At, 1, 1); PG8_STAGE(PG8_SA(1, 0), a3, voffA);
            PG8_BAR; PG8_WAIT_L(0); PG8_MMA(1, 0, At, B0); PG8_BAR; PG8_SCHED;
            PG8_STAGE(PG8_SB(1, 1), b3 + hstep, voffB);
            PG8_WAIT_V(6); PG8_BAR; PG8_MMA(1, 1, At, B1); PG8_BAR;
            }
        }
        if constexpr (ALIGN_EPI) { if (wr == 0) PG8_BAR; }
        if constexpr (!Epi::AFTER_DRAIN) { E(acc, cur, wr, wc, fr, fq); S.done(cur); }
        if (!has_next) break;
#pragma unroll
        for (int a = 0; a < 2; ++a)
#pragma unroll
            for (int b = 0; b < 2; ++b)
#pragma unroll
                for (int m = 0; m < 4; ++m)
#pragma unroll
                    for (int n = 0; n < 2; ++n) acc[a][b][m][n] = (f32x4){0.f, 0.f, 0.f, 0.f};
        cur = nxt; cA = nA; cB = nB; ++ui;
        if constexpr (ALIGN_EPI) { if (wr == 1) PG8_BAR; }
    }
    PG8_WAIT_V(0);
    if constexpr (!ALIGN_EPI) { if (wr == 0) PG8_BAR; }
    PG8_BAR;
    if constexpr (Epi::AFTER_DRAIN) { E.fused(acc, cur, wr, wc, fr, fq, lds, wid, lane); S.done(cur); }
#undef PG8_SA
#undef PG8_SB
#undef PG8_STAGE
#undef PG8_LDA
#undef PG8_LDB
#undef PG8_MMA
#undef PG8_WAIT_V
#undef PG8_WAIT_L
#undef PG8_BAR
#undef PG8_SCHED
}
}

typedef pg8::bf16_t bf16_t;
typedef pg8::f32x4 f32x4;
typedef pg8::u32x4 u32x4;
using pg8::cvt_pk_bf16;
constexpr int NB = 4, SEQ = 8192, D = 1024, MTOK = NB * SEQ;
constexpr int PCOLS = 4608, GCOLS = 3072, INCOLS = 7680, DFF = 3584, NEXP = 8;
constexpr int C_HQ = 0, C_HF = 512, C_HI = 1024, C_HG = 1536, C_GU = 2048, C_GV = 2560, C_SQ = 3072, C_SK = 3584, C_SV = 4096;
constexpr float EPS = 1e-6f;
constexpr int NSLOT = 2 * MTOK + NEXP * 256;
constexpr int NTHREADS = 512, NWAVES = 8;
constexpr int LDS_BYTES = 147456, LDS_MISC = LDS_BYTES - 256;

constexpr size_t WS_CTL = 0, CTL_BYTES = 65536;
constexpr size_t CW_BAR = 0;
constexpr size_t WS_META = WS_CTL + CTL_BYTES;
constexpr size_t WS_LB = WS_META + 4096;
constexpr size_t WS_TOKE = WS_LB + 4096;
constexpr size_t WS_TOKW = WS_TOKE + (size_t)MTOK * 4;
constexpr size_t WS_SLOTTOK = WS_TOKW + (size_t)MTOK * 8;
constexpr size_t WS_SLOTW = WS_SLOTTOK + (size_t)NSLOT * 4;
constexpr size_t WS_W = 2u << 20;
static_assert(WS_SLOTW + (size_t)NSLOT * 4 <= WS_W, "small buffers");
constexpr size_t WS_WIN = WS_W;
constexpr size_t WS_WBR = WS_WIN + (size_t)2 * INCOLS * D * 2;
constexpr size_t WS_WOUT = WS_WBR + (size_t)2 * 3 * D * 512 * 2;
constexpr size_t WS_WGU = WS_WOUT + (size_t)2 * D * D * 2;
constexpr size_t WS_WD = WS_WGU + (size_t)2 * DFF * D * 2;
constexpr size_t WS_XN = WS_WD + (size_t)D * DFF * 2;
constexpr size_t WS_C = WS_XN + (size_t)MTOK * D * 2;
constexpr size_t WS_P = WS_C;
constexpr size_t WS_G = WS_C;
constexpr size_t WS_HID = WS_C;
constexpr size_t WS_OCAT = WS_C + (size_t)MTOK * PCOLS * 2;
constexpr size_t WS_ORAW = WS_OCAT + (size_t)3 * MTOK * 512 * 2;
constexpr size_t WS_END1 = WS_ORAW + (size_t)MTOK * 512 * 4;
constexpr size_t WS_MWGU = WS_C;
constexpr size_t WS_MWD = WS_MWGU + (size_t)NEXP * 2 * DFF * D * 2;
constexpr size_t WS_XS = WS_MWD + (size_t)NEXP * D * DFF * 2;
constexpr size_t WS_MHID = WS_XS + (size_t)MTOK * D * 2;
constexpr size_t WS_END2 = WS_MHID + (size_t)MTOK * DFF * 2;
constexpr size_t WS_NEED = WS_END1 > WS_END2 ? WS_END1 : WS_END2;
static_assert(WS_NEED <= 615053344ull, "workspace budget (sum of the inputs)");

#define LAUNDER(v) asm volatile("" : "+v"(v))
__device__ __forceinline__ float bf2f(unsigned v) { return __uint_as_float(v << 16); }
__device__ __forceinline__ float bflo(unsigned w) { return __uint_as_float(w << 16); }
__device__ __forceinline__ float bfhi(unsigned w) { return __uint_as_float(w & 0xffff0000u); }
__device__ __forceinline__ bf16_t f2bf(float f) { return (bf16_t)(cvt_pk_bf16(f, 0.f) & 0xffffu); }
__device__ __forceinline__ float wave_sum(float v) {
#pragma unroll
    for (int o = 32; o > 0; o >>= 1) v += __shfl_xor(v, o);
    return v;
}
__device__ __forceinline__ float sigmoidf_(float x) { return __builtin_amdgcn_rcpf(1.f + __expf(-x)); }
__device__ __forceinline__ float siluf_(float x) { return x * sigmoidf_(x); }
__device__ __forceinline__ float gelu_tanh_(float x) { return x * sigmoidf_(1.5957691216057308f * (x + 0.044715f * x * x * x)); }
__device__ __forceinline__ float softplusf_(float z) { return fmaxf(z, 0.f) + __logf(1.f + __expf(-fabsf(z))); }

struct Order {
    int nM, nN, nwg, G, c, mode; const char* A; const char* Bt; size_t tstep, abr, bbr;
    __device__ void init(const void* A_, const void* Bt_, int M, int N, int K, int G_, int c_, int mode_ = 0, size_t abr_ = 0, size_t bbr_ = 0) {
        nM = M / 256; nN = N / 256; nwg = nM * nN; G = G_; c = c_; mode = mode_; A = (const char*)A_; Bt = (const char*)Bt_; tstep = (size_t)256 * K * 2; abr = abr_; bbr = bbr_; }
    __device__ bool next(int i, pg8::Unit& u) const {
        const long L = (long)i * G + c; if (L >= nwg) return false;
        int wgid = (int)L; { const int q = nwg / 8, r = nwg % 8, xcd = wgid % 8, off = wgid / 8; wgid = (xcd < r ? xcd * (q + 1) : r * (q + 1) + (xcd - r) * q) + off; }
        const int nig = 8 * nN, gid = wgid / nig, fm = gid * 8, gsz = (nM - fm) < 8 ? (nM - fm) : 8;
        u.pm = fm + ((wgid % nig) % gsz); u.pn = (wgid % nig) / gsz;
        if (mode == 0) { u.a = A + (size_t)u.pm * tstep; u.b = Bt + (size_t)u.pn * tstep; }
        else { const int br = u.pn >> 2; u.a = A + (size_t)br * abr + (size_t)u.pm * tstep; u.b = Bt + (size_t)br * bbr + (size_t)(u.pn & 3) * tstep; }
        return true;
    }
    __device__ __forceinline__ void a_ready(const pg8::Unit&) const {}
    __device__ __forceinline__ void done(const pg8::Unit&) const {}
};

template <int ACT> __device__ __forceinline__ float act_(float x, float lb) {
    if (ACT == 1) return siluf_(x);
    if (ACT == 2) return __logf(lb + (1.f - lb) * sigmoidf_(x));
    if (ACT == 3) return gelu_tanh_(x);
    if (ACT == 4) return sigmoidf_(x);
    return x;
}
struct EpiAct {
    static constexpr bool PERM = true, AFTER_DRAIN = false;
    bf16_t* O; int ldc; const float* lb; int inproj;
    template <int ACT> __device__ __forceinline__ void run(const f32x4 (&acc)[2][2][4][2], const pg8::Unit& u, int wr, int wc, int fr, int fq) const {
        const int row0 = u.pm * 256 + wr * 64 + fr, col0 = u.pn * 256 + wc * 32 + 8 * fq;
        f32x4 lbv[2][2];
#pragma unroll
        for (int bj = 0; bj < 2; ++bj)
#pragma unroll
            for (int n = 0; n < 2; ++n) lbv[bj][n] = (ACT == 2) ? *(const f32x4*)(lb + (col0 - C_HF) + bj * 128 + 4 * n) : (f32x4){0.f, 0.f, 0.f, 0.f};
#pragma unroll
        for (int ai = 0; ai < 2; ++ai)
#pragma unroll
            for (int m = 0; m < 4; ++m) { bf16_t* rowp = O + (size_t)(row0 + ai * 128 + m * 16) * ldc + col0;
#pragma unroll
                for (int bj = 0; bj < 2; ++bj) { f32x4 v0 = acc[ai][bj][m][0], v1 = acc[ai][bj][m][1];
#pragma unroll
                    for (int i = 0; i < 4; ++i) { v0[i] = act_<ACT>(v0[i], lbv[bj][0][i]); v1[i] = act_<ACT>(v1[i], lbv[bj][1][i]); }
                    u32x4 w; w.x = cvt_pk_bf16(v0[0], v0[1]); w.y = cvt_pk_bf16(v0[2], v0[3]); w.z = cvt_pk_bf16(v1[0], v1[1]); w.w = cvt_pk_bf16(v1[2], v1[3]);
                    *(u32x4*)(rowp + bj * 128) = w; } }
    }
    __device__ __forceinline__ void operator()(const f32x4 (&acc)[2][2][4][2], const pg8::Unit& u, int wr, int wc, int fr, int fq) const {
        if (!inproj) { run<4>(acc, u, wr, wc, fr, fq); return; }
        const int kind = u.pn >> 1;
        if (kind == 0 || kind == 3) run<1>(acc, u, wr, wc, fr, fq);
        else if (kind == 1) run<2>(acc, u, wr, wc, fr, fq);
        else if (kind == 4 || kind == 5) run<3>(acc, u, wr, wc, fr, fq);
        else run<0>(acc, u, wr, wc, fr, fq);
    }
};
struct EpiBranch {
    static constexpr bool PERM = true, AFTER_DRAIN = false;
    bf16_t* GH;
    __device__ __forceinline__ void operator()(const f32x4 (&acc)[2][2][4][2], const pg8::Unit& u, int wr, int wc, int fr, int fq) const {
        const int row0 = u.pm * 256 + wr * 64 + fr, col0 = u.pn * 256 + wc * 32 + 8 * fq;
#pragma unroll
        for (int ai = 0; ai < 2; ++ai)
#pragma unroll
            for (int m = 0; m < 4; ++m) { bf16_t* rowp = GH + (size_t)(row0 + ai * 128 + m * 16) * GCOLS + col0;
#pragma unroll
                for (int bj = 0; bj < 2; ++bj) { const f32x4 v0 = acc[ai][bj][m][0], v1 = acc[ai][bj][m][1];
                    const u32x4 g = *(const u32x4*)(rowp + bj * 128); u32x4 w;
                    w.x = cvt_pk_bf16(v0[0] * bflo(g.x), v0[1] * bfhi(g.x)); w.y = cvt_pk_bf16(v0[2] * bflo(g.y), v0[3] * bfhi(g.y));
                    w.z = cvt_pk_bf16(v1[0] * bflo(g.z), v1[1] * bfhi(g.z)); w.w = cvt_pk_bf16(v1[2] * bflo(g.w), v1[3] * bfhi(g.w));
                    *(u32x4*)(rowp + bj * 128) = w; } }
    }
};
struct EpiResid {
    static constexpr bool PERM = false, AFTER_DRAIN = false;
    const float* xin; float* xout;
    __device__ __forceinline__ void operator()(const f32x4 (&acc)[2][2][4][2], const pg8::Unit& u, int wr, int wc, int fr, int fq) const {
        const int row0 = u.pm * 256 + wr * 64 + fr, col0 = u.pn * 256 + wc * 32 + 4 * fq;
#pragma unroll
        for (int ai = 0; ai < 2; ++ai)
#pragma unroll
            for (int m = 0; m < 4; ++m) { const size_t ro = (size_t)(row0 + ai * 128 + m * 16) * D + col0;
#pragma unroll
                for (int bj = 0; bj < 2; ++bj)
#pragma unroll
                    for (int n = 0; n < 2; ++n) *(f32x4*)(xout + ro + bj * 128 + n * 16) = *(const f32x4*)(xin + ro + bj * 128 + n * 16) + acc[ai][bj][m][n]; }
    }
};
struct EpiGU {
    static constexpr bool PERM = true, AFTER_DRAIN = false;
    bf16_t* H;
    __device__ __forceinline__ void operator()(const f32x4 (&acc)[2][2][4][2], const pg8::Unit& u, int wr, int wc, int fr, int fq) const {
        const int row0 = u.pm * 256 + wr * 64 + fr, col0 = u.pn * 128 + wc * 32 + 8 * fq;
#pragma unroll
        for (int ai = 0; ai < 2; ++ai)
#pragma unroll
            for (int m = 0; m < 4; ++m) { bf16_t* rowp = H + (size_t)(row0 + ai * 128 + m * 16) * DFF + col0;
                const f32x4 g0 = acc[ai][0][m][0], g1 = acc[ai][0][m][1], u0 = acc[ai][1][m][0], u1 = acc[ai][1][m][1]; u32x4 w;
                w.x = cvt_pk_bf16(siluf_(g0[0]) * u0[0], siluf_(g0[1]) * u0[1]); w.y = cvt_pk_bf16(siluf_(g0[2]) * u0[2], siluf_(g0[3]) * u0[3]);
                w.z = cvt_pk_bf16(siluf_(g1[0]) * u1[0], siluf_(g1[1]) * u1[1]); w.w = cvt_pk_bf16(siluf_(g1[2]) * u1[2], siluf_(g1[3]) * u1[3]);
                *(u32x4*)rowp = w; }
    }
};
struct EpiMoeDown {
    static constexpr bool PERM = false, AFTER_DRAIN = false;
    float* out; const int* stok; const float* sw;
    __device__ __forceinline__ void operator()(const f32x4 (&acc)[2][2][4][2], const pg8::Unit& u, int wr, int wc, int fr, int fq) const {
        const int row0 = u.pm * 256 + wr * 64 + fr, col0 = u.pn * 256 + wc * 32 + 4 * fq;
#pragma unroll
        for (int ai = 0; ai < 2; ++ai)
#pragma unroll
            for (int m = 0; m < 4; ++m) { const int rl = row0 + ai * 128 + m * 16; const int tok = stok[rl]; const float w = sw[rl];
                if (tok >= 0) { float* rp = out + (size_t)tok * D + col0;
#pragma unroll
                    for (int bj = 0; bj < 2; ++bj)
#pragma unroll
                        for (int n = 0; n < 2; ++n) { f32x4 o = *(const f32x4*)(rp + bj * 128 + n * 16); o = o + acc[ai][bj][m][n] * w; *(f32x4*)(rp + bj * 128 + n * 16) = o; } } }
    }
};

__device__ void tc_job(const float* __restrict__ src, int K, int N, bf16_t* dst, int mode, LAS float* tile, int wg, int G, int tid) {
    LAUNDER(tid);
    const int tn = N / 64, nt = (K / 64) * tn;
    for (int t = wg; t < nt; t += G) {
        const int k0 = (t / tn) * 64, n0 = (t % tn) * 64;
#pragma unroll
        for (int ps = 0; ps < 2; ++ps) { const int r = (tid >> 4) + ps * 32; const float4 v = *(const float4*)(src + (size_t)(k0 + r) * N + n0 + (tid & 15) * 4);
            LAS float* tp = tile + r * 65 + (tid & 15) * 4; tp[0] = v.x; tp[1] = v.y; tp[2] = v.z; tp[3] = v.w; }
        __syncthreads();
        { const int n = tid >> 3, kg = (tid & 7) * 8; unsigned w[4];
#pragma unroll
          for (int j = 0; j < 4; ++j) w[j] = cvt_pk_bf16(tile[(kg + 2 * j) * 65 + n], tile[(kg + 2 * j + 1) * 65 + n]);
          const int nn = n0 + n; const int drow = mode == 0 ? nn : ((nn >> 7) * 256 + (nn & 127) + (mode == 2 ? 128 : 0));
          *(uint4*)(dst + (size_t)drow * K + k0 + kg) = make_uint4(w[0], w[1], w[2], w[3]); }
        __syncthreads();
    }
}

template <bool ROUTER>
__device__ void phase_rmsnorm(const float* __restrict__ x, const float* __restrict__ gain, bf16_t* xn, const float* __restrict__ rw, const float* __restrict__ rb,
                              int* toke, float2* tokw, int wg, int G, int wid, int lane) {
    LAUNDER(lane);
    for (int row = wg * NWAVES + wid; row < MTOK; row += G * NWAVES) {
        const float* xr = x + (size_t)row * D; float4 v[4]; float ss = 0.f;
#pragma unroll
        for (int j = 0; j < 4; ++j) { v[j] = *(const float4*)(xr + j * 256 + lane * 4); ss += v[j].x * v[j].x + v[j].y * v[j].y + v[j].z * v[j].z + v[j].w * v[j].w; }
        ss = wave_sum(ss);
        const float rstd = rsqrtf(ss * (1.f / D) + EPS);
        float lg[NEXP];
#pragma unroll
        for (int e = 0; e < NEXP; ++e) lg[e] = 0.f;
#pragma unroll
        for (int j = 0; j < 4; ++j) { const float4 g = *(const float4*)(gain + j * 256 + lane * 4);
            const float y0 = v[j].x * rstd * g.x, y1 = v[j].y * rstd * g.y, y2 = v[j].z * rstd * g.z, y3 = v[j].w * rstd * g.w;
            *(uint2*)(xn + (size_t)row * D + j * 256 + lane * 4) = make_uint2(cvt_pk_bf16(y0, y1), cvt_pk_bf16(y2, y3));
            if (ROUTER) { const float ys[4] = {y0, y1, y2, y3};
#pragma unroll
                for (int i = 0; i < 4; ++i) { const float* wr_ = rw + (size_t)(j * 256 + lane * 4 + i) * NEXP; const float4 wa = *(const float4*)wr_, wb = *(const float4*)(wr_ + 4);
                    lg[0] += ys[i] * wa.x; lg[1] += ys[i] * wa.y; lg[2] += ys[i] * wa.z; lg[3] += ys[i] * wa.w; lg[4] += ys[i] * wb.x; lg[5] += ys[i] * wb.y; lg[6] += ys[i] * wb.z; lg[7] += ys[i] * wb.w; } } }
        if (ROUTER) {
#pragma unroll
            for (int e = 0; e < NEXP; ++e) lg[e] = wave_sum(lg[e]) + rb[e];
            int i0 = 0; float l0 = lg[0];
#pragma unroll
            for (int e = 1; e < NEXP; ++e) if (lg[e] > l0) { l0 = lg[e]; i0 = e; }
            int i1 = -1; float l1 = -3.4e38f;
#pragma unroll
            for (int e = 0; e < NEXP; ++e) if (e != i0 && lg[e] > l1) { l1 = lg[e]; i1 = e; }
            const float w0 = __builtin_amdgcn_rcpf(1.f + __expf(l1 - l0));
            if (lane == 0) { toke[row] = i0 | (i1 << 8); tokw[row] = make_float2(w0, 1.f - w0); }
        }
    }
}

__device__ void phase_combine(const bf16_t* GH, bf16_t* mix, int wg, int G, int tid) {
    LAUNDER(tid);
    for (size_t v = (size_t)wg * NTHREADS + tid; v < (size_t)MTOK * (D / 8); v += (size_t)G * NTHREADS) {
        const size_t r = v / (D / 8); const int c = (int)(v % (D / 8)) * 8; const bf16_t* gp = GH + r * GCOLS + c;
        const uint4 a = *(const uint4*)gp, b = *(const uint4*)(gp + 1024), cc = *(const uint4*)(gp + 2048); uint4 o;
        o.x = cvt_pk_bf16(bflo(a.x) + bflo(b.x) + bflo(cc.x), bfhi(a.x) + bfhi(b.x) + bfhi(cc.x));
        o.y = cvt_pk_bf16(bflo(a.y) + bflo(b.y) + bflo(cc.y), bfhi(a.y) + bfhi(b.y) + bfhi(cc.y));
        o.z = cvt_pk_bf16(bflo(a.z) + bflo(b.z) + bflo(cc.z), bfhi(a.z) + bfhi(b.z) + bfhi(cc.z));
        o.w = cvt_pk_bf16(bflo(a.w) + bflo(b.w) + bflo(cc.w), bfhi(a.w) + bfhi(b.w) + bfhi(cc.w));
        *(uint4*)(mix + r * D + c) = o;
    }
}

__device__ void phase_hgrn_naive(const bf16_t* P, float* oraw, int wg, int G, int wid, int lane) {
    LAUNDER(lane);
    for (int task = wg * NWAVES + wid; task < NB * 4 * 32; task += G * NWAVES) {
        const int b = task >> 7, h = (task >> 5) & 3, vg = task & 31;
        const bf16_t* base = P + (size_t)b * SEQ * PCOLS + h * 128;
        float* ob = oraw + (size_t)b * SEQ * 512 + h * 128 + vg * 4;
        float s00 = 0, s01 = 0, s02 = 0, s03 = 0, s10 = 0, s11 = 0, s12 = 0, s13 = 0;
        for (int t0 = 0; t0 < SEQ; t0 += 8) {
            unsigned q0[8], q1[8], f0[8], f1[8]; uint2 vv[8];
#pragma unroll
            for (int j = 0; j < 8; ++j) { const bf16_t* row = base + (size_t)(t0 + j) * PCOLS;
                q0[j] = row[C_HQ + lane]; q1[j] = row[C_HQ + 64 + lane]; f0[j] = row[C_HF + lane]; f1[j] = row[C_HF + 64 + lane]; vv[j] = *(const uint2*)(row + C_HI + vg * 4); }
#pragma unroll
            for (int j = 0; j < 8; ++j) {
                const float fa = __expf(bf2f(f0[j])), fb = __expf(bf2f(f1[j])), ka = 1.f - fa, kb = 1.f - fb, qa = bf2f(q0[j]), qb = bf2f(q1[j]);
                const float v0 = bflo(vv[j].x), v1 = bfhi(vv[j].x), v2 = bflo(vv[j].y), v3 = bfhi(vv[j].y);
                s00 = fa * s00 + ka * v0; s01 = fa * s01 + ka * v1; s02 = fa * s02 + ka * v2; s03 = fa * s03 + ka * v3;
                s10 = fb * s10 + kb * v0; s11 = fb * s11 + kb * v1; s12 = fb * s12 + kb * v2; s13 = fb * s13 + kb * v3;
                const float o0 = wave_sum(qa * s00 + qb * s10), o1 = wave_sum(qa * s01 + qb * s11), o2 = wave_sum(qa * s02 + qb * s12), o3 = wave_sum(qa * s03 + qb * s13);
                if (lane == 0) *(float4*)(ob + (size_t)(t0 + j) * 512) = make_float4(o0, o1, o2, o3);
            }
        }
    }
}
__device__ void phase_hgrn_fin(const float* oraw, const bf16_t* P, const float* __restrict__ gain, bf16_t* oa, int wg, int G, int wid, int lane) {
    LAUNDER(lane);
    for (int row = wg * NWAVES + wid; row < MTOK; row += G * NWAVES) {
        const float* orow = oraw + (size_t)row * 512 + lane * 8; const float4 a = *(const float4*)orow, b = *(const float4*)(orow + 4);
        float ss = a.x * a.x + a.y * a.y + a.z * a.z + a.w * a.w + b.x * b.x + b.y * b.y + b.z * b.z + b.w * b.w;
        ss += __shfl_xor(ss, 1); ss += __shfl_xor(ss, 2); ss += __shfl_xor(ss, 4); ss += __shfl_xor(ss, 8);
        const float rstd = rsqrtf(ss * (1.f / 128.f) + EPS);
        const int vi = (lane & 15) * 8; const float4 g0 = *(const float4*)(gain + vi), g1 = *(const float4*)(gain + vi + 4);
        const uint4 hg = *(const uint4*)(P + (size_t)row * PCOLS + C_HG + lane * 8); uint4 o;
        o.x = cvt_pk_bf16(a.x * rstd * g0.x * bflo(hg.x), a.y * rstd * g0.y * bfhi(hg.x)); o.y = cvt_pk_bf16(a.z * rstd * g0.z * bflo(hg.y), a.w * rstd * g0.w * bfhi(hg.y));
        o.z = cvt_pk_bf16(b.x * rstd * g1.x * bflo(hg.z), b.y * rstd * g1.y * bfhi(hg.z)); o.w = cvt_pk_bf16(b.z * rstd * g1.z * bflo(hg.w), b.w * rstd * g1.w * bfhi(hg.w));
        *(uint4*)(oa + (size_t)row * 512 + lane * 8) = o;
    }
}
__device__ void phase_gmlp_naive(const bf16_t* P, const float* __restrict__ ws_l  , const float* __restrict__ bs_l  , const float* __restrict__ gv_l  ,
                                 bf16_t* ob, LAS unsigned char* lds, int wg, int G, int tid, int wid, int lane) {
    LAUNDER(tid); LAUNDER(lane);
    LAS float* vn = (LAS float*)lds; LAS float* W = vn + 128 * 128; LAS float* rs = W + 128 * 128;
    for (int item = wg; item < (MTOK / 128) * 4; item += G) {
        const int chunk = item >> 2, g = item & 3; const size_t tok0 = (size_t)chunk * 128;
        for (int s = wid; s < 128; s += NWAVES) { const uint4 x = *(const uint4*)(P + (tok0 + s) * PCOLS + C_GV + lane * 8);
            float ss = bflo(x.x) * bflo(x.x) + bfhi(x.x) * bfhi(x.x) + bflo(x.y) * bflo(x.y) + bfhi(x.y) * bfhi(x.y) + bflo(x.z) * bflo(x.z) + bfhi(x.z) * bfhi(x.z) + bflo(x.w) * bflo(x.w) + bfhi(x.w) * bfhi(x.w);
            ss = wave_sum(ss); if (lane == 0) rs[s] = rsqrtf(ss * (1.f / 512.f) + EPS); }
        __syncthreads();
        for (int i = tid; i < 128 * 128; i += NTHREADS) { const int s = i >> 7, c = i & 127;
            vn[i] = bf2f(P[(tok0 + s) * PCOLS + C_GV + g * 128 + c]) * rs[s] * gv_l[g * 128 + c]; W[i] = ws_l[(size_t)g * 16384 + i]; }
        __syncthreads();
        { const int c = tid & 127;
          for (int t = tid >> 7; t < 128; t += 4) { float acc = 0.f; for (int s = 0; s <= t; ++s) acc += W[t * 128 + s] * vn[s * 128 + c];
              const float mixv = acc + bs_l[g * 128 + t]; const float uu = bf2f(P[(tok0 + t) * PCOLS + C_GU + g * 128 + c]);
              ob[(tok0 + t) * 512 + g * 128 + c] = f2bf(uu * mixv); } }
        __syncthreads();
    }
}
__device__ void phase_attn_naive(const bf16_t* P, const float* __restrict__ gq, const float* __restrict__ gk, bf16_t* oc, LAS unsigned char* lds, int wg, int G, int wid, int lane) {
    LAUNDER(lane);
    LAS float* red = (LAS float*)lds + wid * (64 * 65); LAS float* qs = (LAS float*)lds + NWAVES * 64 * 65 + wid * 64;
    for (int item = wg; item < MTOK * 8 / NWAVES; item += G) {
        const int q_id = item * NWAVES + wid;
        const int t = q_id & (SEQ - 1), h = (q_id >> 13) & 7, b = q_id >> 16;
        const size_t tokb = (size_t)b * SEQ;
        { const float qv = bf2f(P[(tokb + t) * PCOLS + C_SQ + h * 64 + lane]); const float ss = wave_sum(qv * qv);
          qs[lane] = qv * rsqrtf(ss * (1.f / 64.f) + EPS) * gq[lane] * gk[lane] * 0.125f; }
        float op[64];
#pragma unroll
        for (int d = 0; d < 64; ++d) op[d] = 0.f;
        float carry = 0.f;
        for (int s0 = t - 1; s0 >= 0; s0 -= 64) {
            const int s = s0 - lane; const bool valid = s >= 0; const int sc = valid ? s : 0;
            const bf16_t* kr = P + (tokb + sc) * PCOLS + C_SK + h * 64; float dot = 0.f, ssk = 0.f;
#pragma unroll
            for (int j = 0; j < 8; ++j) { const uint4 kk = *(const uint4*)(kr + j * 8); const float k0 = bflo(kk.x), k1 = bfhi(kk.x), k2 = bflo(kk.y), k3 = bfhi(kk.y), k4 = bflo(kk.z), k5 = bfhi(kk.z), k6 = bflo(kk.w), k7 = bfhi(kk.w);
                dot += qs[j * 8 + 0] * k0 + qs[j * 8 + 1] * k1 + qs[j * 8 + 2] * k2 + qs[j * 8 + 3] * k3 + qs[j * 8 + 4] * k4 + qs[j * 8 + 5] * k5 + qs[j * 8 + 6] * k6 + qs[j * 8 + 7] * k7;
                ssk += k0 * k0 + k1 * k1 + k2 * k2 + k3 * k3 + k4 * k4 + k5 * k5 + k6 * k6 + k7 * k7; }
            const float z = dot * rsqrtf(ssk * (1.f / 64.f) + EPS);
            const float sp = valid ? softplusf_(z) : 0.f;
            float pre = sp;
#pragma unroll
            for (int o = 1; o < 64; o <<= 1) { const float tt = __shfl_up(pre, o); if (lane >= o) pre += tt; }
            const float a = valid ? __expf(z - carry - pre) : 0.f;
            const bf16_t* vr = P + (tokb + sc) * PCOLS + C_SV + h * 64;
#pragma unroll
            for (int j = 0; j < 8; ++j) { const uint4 vv = *(const uint4*)(vr + j * 8);
                op[j * 8 + 0] += a * bflo(vv.x); op[j * 8 + 1] += a * bfhi(vv.x); op[j * 8 + 2] += a * bflo(vv.y); op[j * 8 + 3] += a * bfhi(vv.y);
                op[j * 8 + 4] += a * bflo(vv.z); op[j * 8 + 5] += a * bfhi(vv.z); op[j * 8 + 6] += a * bflo(vv.w); op[j * 8 + 7] += a * bfhi(vv.w); }
            carry += __shfl(pre, 63);
            if (carry > 104.f) break;
        }
#pragma unroll
        for (int d = 0; d < 64; ++d) red[lane * 65 + d] = op[d];
        float o = 0.f;
#pragma unroll 8
        for (int l = 0; l < 64; ++l) o += red[l * 65 + lane];
        oc[(tokb + t) * 512 + h * 64 + lane] = f2bf(o);
    }
}

__device__ void moe_assign(const int* toke, const float2* tokw, int* meta, int* stok, float* sw, LAS unsigned char* lds, int tid) {
    LAUNDER(tid);
    LAS int* cnt = (LAS int*)lds;
    LAS int* tot = cnt + 512 * 8;
    int c[NEXP];
#pragma unroll
    for (int e = 0; e < NEXP; ++e) c[e] = 0;
    const int t0 = tid * (MTOK / NTHREADS);
    for (int i = 0; i < MTOK / NTHREADS; ++i) { const int ee = toke[t0 + i]; const int e0 = ee & 255, e1 = (ee >> 8) & 255;
#pragma unroll
        for (int e = 0; e < NEXP; ++e) c[e] += (e0 == e) + (e1 == e); }
#pragma unroll
    for (int e = 0; e < NEXP; ++e) cnt[tid * 8 + e] = c[e];
    __syncthreads();
    if (tid < NEXP) { int run = 0; for (int i = 0; i < NTHREADS; ++i) { const int v = cnt[i * 8 + tid]; cnt[i * 8 + tid] = run; run += v; } tot[tid] = run; }
    __syncthreads();
    if (tid == 0) { int run = 0; for (int e = 0; e < NEXP; ++e) { const int n = tot[e], pad = (n + 255) & ~255; tot[8 + e] = run; meta[e] = n; meta[8 + e] = pad; meta[16 + e] = run; run += pad; } }
    __syncthreads();
    int pos[NEXP];
#pragma unroll
    for (int e = 0; e < NEXP; ++e) pos[e] = tot[8 + e] + cnt[tid * 8 + e];
    for (int i = 0; i < MTOK / NTHREADS; ++i) { const int tk = t0 + i; const int ee = toke[tk]; const int e0 = ee & 255, e1 = (ee >> 8) & 255; const float2 w = tokw[tk];
        int p0 = 0, p1 = 0;
#pragma unroll
        for (int e = 0; e < NEXP; ++e) { if (e0 == e) { p0 = pos[e]; pos[e]++; } }
#pragma unroll
        for (int e = 0; e < NEXP; ++e) { if (e1 == e) { p1 = pos[e]; pos[e]++; } }
        stok[p0] = tk; sw[p0] = w.x; stok[p1] = tk; sw[p1] = w.y; }
    for (int e = 0; e < NEXP; ++e) { const int n = tot[e], pad = (n + 255) & ~255, base = tot[8 + e]; for (int i = n + tid; i < pad; i += NTHREADS) { stok[base + i] = -1; sw[base + i] = 0.f; } }
}
__device__ void moe_gather(const bf16_t* xn, const int* stok, int rows, bf16_t* xs, int wg, int G, int wid, int lane) {
    LAUNDER(lane);
    for (int r = wg * NWAVES + wid; r < rows; r += G * NWAVES) { const int tok = __hip_atomic_load(stok + r, __ATOMIC_RELAXED, __HIP_MEMORY_SCOPE_AGENT);
        uint4 a = make_uint4(0, 0, 0, 0), b = a;
        if (tok >= 0) { const uint4* sp = (const uint4*)(xn + (size_t)tok * D) + lane * 2; a = sp[0]; b = sp[1]; }
        uint4* dp = (uint4*)(xs + (size_t)r * D) + lane * 2; dp[0] = a; dp[1] = b; }
}

#ifdef MK_CHECK
constexpr size_t WS_DIAG = WS_META + 2048;
constexpr size_t WS_SNAP = WS_SLOTW + (size_t)NSLOT * 4;
static_assert(WS_SNAP + 64 * 1024 * 4 <= WS_W, "snapshot fits");
__device__ __forceinline__ int samp_row(int i) { return (int)(((unsigned)i * 2654435761u + 12345u) % (unsigned)MTOK); }
__device__ __forceinline__ void chk_fail(unsigned* diag, unsigned code) { atomicMin(diag, code); }
__device__ __forceinline__ bool chk_close(float got, float ref, float atol, float rtol) { return fabsf(got - ref) <= atol + rtol * fabsf(ref) && got == got; }

__global__ void k_diag_init(unsigned* diag) { if (threadIdx.x == 0 && blockIdx.x == 0) { diag[0] = 0xffffffffu; diag[16] = 0u; diag[17] = 0xffffffffu; diag[18] = 0u; diag[19] = 0u; diag[20] = 0u; diag[21] = 0u; diag[22] = 0u; diag[23] = 0u; diag[24] = 0u; diag[25] = 0u; diag[26] = 0u; } }
__global__ void k_snapshot(const float* x, float* snap) { const int i = blockIdx.x; const int r = samp_row(i); for (int c = threadIdx.x; c < D; c += blockDim.x) snap[i * D + c] = x[(size_t)r * D + c]; }
__global__ void k_apply_diag(float* out, const unsigned* diag) {
    if (blockIdx.x != 0 || threadIdx.x != 0) return;
    const unsigned code = diag[0]; if (code == 0xffffffffu) return;
    unsigned pc = 0, lo = 999; for (int w = 0; w < 4; ++w) { const unsigned m = diag[20 + w]; pc += __popc(m); if (m && lo == 999) lo = w * 32 + (__ffs(m) - 1); }
    if (DIAGSEL == 3) { lo = __popc(diag[24]) + __popc(diag[25]); pc = __popc(diag[26]); }
    unsigned f1 = (DIAGSEL == 0 || DIAGSEL == 3) ? lo : DIAGSEL == 1 ? diag[17] * 8 + diag[18] : diag[19]; if (f1 > 89) f1 = 89;
    unsigned f2 = pc > 20 ? 20 : pc;
    out[0] = (1.0f + 0.1f * (float)f1) * exp10f(3.f + (float)f2) * (code == 5u ? 1.f : -1.f);
}
struct ChkGemm { const bf16_t* A; int lda; const float* W; int ldw; int K; int mode; const bf16_t* Cb; int ldc; const float* Cf; const float* xold; const float* W2; const float* lb; const bf16_t* Gsrc; int ncols; unsigned code; int use_snap; };
__global__ void k_chk_gemm(ChkGemm c, unsigned* diag) {
    const int i = blockIdx.x; const int r = samp_row(i);
    for (int cc = threadIdx.x; cc < 96; cc += blockDim.x) {
        const int col = (int)(((unsigned)cc * 40503u + (unsigned)i * 977u) % (unsigned)c.ncols);
        float dot = 0.f, dot2 = 0.f;
        for (int k = 0; k < c.K; ++k) { const float av = bf2f(c.A[(size_t)r * c.lda + k]); dot += av * c.W[(size_t)k * c.ldw + col]; if (c.mode == 4) dot2 += av * c.W2[(size_t)k * c.ldw + col]; }
        float ref, got;
        if (c.mode == 0) { const int kind = col >> 9; ref = (kind == 0 || kind == 3) ? siluf_(dot) : kind == 1 ? __logf(c.lb[col - 512] + (1.f - c.lb[col - 512]) * sigmoidf_(dot)) : (kind == 4 || kind == 5) ? gelu_tanh_(dot) : dot; got = bf2f(c.Cb[(size_t)r * c.ldc + col]); }
        else if (c.mode == 1) { ref = sigmoidf_(dot); got = bf2f(c.Cb[(size_t)r * c.ldc + col]); }
        else if (c.mode == 3) { const float xo = c.use_snap ? c.xold[(size_t)i * D + col] : c.xold[(size_t)r * D + col]; ref = xo + dot; got = c.Cf[(size_t)r * D + col]; }
        else { ref = siluf_(dot) * dot2; got = bf2f(c.Cb[(size_t)r * c.ldc + col]); }
        if (!chk_close(got, ref, 0.03f, 0.03f)) { chk_fail(diag, c.code); if (c.mode == 1) { atomicOr(diag + 24 + (i >> 5), 1u << (i & 31)); atomicOr(diag + 26, 1u << ((r & 255) >> 4)); atomicOr(diag + 20 + ((col & 127) >> 5), 1u << (col & 31)); atomicAdd(diag + 16, 1u); atomicMin(diag + 17, (unsigned)(col >> 8)); atomicMax(diag + 18, (unsigned)(col >> 8)); if (fabsf(got - dot) <= 0.03f + 0.03f * fabsf(dot)) atomicAdd(diag + 19, 1u); } }
    }
}
__global__ void k_chk_branch(const bf16_t* ocat, const float* wbr  , const bf16_t* xn, const float* win  , const bf16_t* GH, unsigned code, unsigned* diag) {
    const int i = blockIdx.x; const int r = samp_row(i);
    for (int cc = threadIdx.x; cc < 96; cc += blockDim.x) {
        const int col = (int)(((unsigned)cc * 40503u + (unsigned)i * 977u) % 3072u); const int b = col >> 10, cl = col & 1023;
        float h = 0.f; for (int k = 0; k < 512; ++k) h += bf2f(ocat[(size_t)b * MTOK * 512 + (size_t)r * 512 + k]) * wbr[((size_t)b * 512 + k) * 1024 + cl];
        float g = 0.f; for (int k = 0; k < 1024; ++k) g += bf2f(xn[(size_t)r * D + k]) * win[(size_t)k * INCOLS + PCOLS + col];
        const float ref = sigmoidf_(g) * h, got = bf2f(GH[(size_t)r * GCOLS + col]);
        if (!chk_close(got, ref, 0.03f, 0.04f)) chk_fail(diag, code);
    }
}
__global__ void k_chk_attn(const bf16_t* P, const float* gq, const float* gk, const bf16_t* oc, unsigned code, unsigned* diag) {
    const int id = blockIdx.x, lane = threadIdx.x; const int ti = id % 10;
    const int t = ti == 0 ? 0 : ti == 1 ? 1 : ti == 2 ? 2 : ti == 3 ? 63 : ti == 4 ? 64 : ti == 5 ? 65 : ti == 6 ? 200 : ti == 7 ? 1000 : ti == 8 ? 4097 : 8191;
    const int h = (id / 10) % 8, b = id / 80; const size_t tokb = (size_t)b * SEQ;
    float q = bf2f(P[(tokb + t) * PCOLS + C_SQ + h * 64 + lane]); q = q * rsqrtf(wave_sum(q * q) / 64.f + EPS) * gq[lane];
    float o = 0.f, carry = 0.f;
    for (int s = t - 1; s >= 0 && carry < 300.f; --s) {
        float kv = bf2f(P[(tokb + s) * PCOLS + C_SK + h * 64 + lane]); kv = kv * rsqrtf(wave_sum(kv * kv) / 64.f + EPS) * gk[lane];
        const float z = wave_sum(q * kv) * 0.125f; const float sp = logf(1.f + expf(z));
        carry += sp; const float A = expf(z - carry);
        o += A * bf2f(P[(tokb + s) * PCOLS + C_SV + h * 64 + lane]);
    }
    if (!chk_close(bf2f(oc[(tokb + t) * 512 + h * 64 + lane]), o, 0.02f, 0.03f)) chk_fail(diag, code);
}
__global__ void k_chk_gmlp(const bf16_t* P, const float* ws_l, const float* bs_l, const float* gv_l, const bf16_t* ob, unsigned code, unsigned* diag) {
    const int id = blockIdx.x * blockDim.x + threadIdx.x; if (id >= 512) return;
    const int chunk = (id * 37) % (MTOK / 128), t = (id * 53 + 7) % 128, ch = (id * 101 + 3) % 512, g = ch >> 7, c = ch & 127; const size_t tok0 = (size_t)chunk * 128;
    float acc = 0.f;
    for (int s = 0; s <= t; ++s) { float ss = 0.f; for (int k = 0; k < 512; ++k) { const float v = bf2f(P[(tok0 + s) * PCOLS + C_GV + k]); ss += v * v; }
        const float vn = bf2f(P[(tok0 + s) * PCOLS + C_GV + ch]) * rsqrtf(ss / 512.f + EPS) * gv_l[ch]; acc += ws_l[(size_t)g * 16384 + t * 128 + s] * vn; }
    const float ref = bf2f(P[(tok0 + t) * PCOLS + C_GU + ch]) * (acc + bs_l[g * 128 + t]);
    if (!chk_close(bf2f(ob[(tok0 + t) * 512 + ch]), ref, 0.02f, 0.03f)) chk_fail(diag, code);
}
__global__ void k_chk_hgrn(const bf16_t* P, const float* gain, const bf16_t* oa, unsigned code, unsigned* diag) {
    const int id = blockIdx.x; const int ti = id % 8; const int t = ti == 0 ? 0 : ti == 1 ? 1 : ti == 2 ? 5 : ti == 3 ? 63 : ti == 4 ? 64 : ti == 5 ? 200 : ti == 6 ? 511 : 700, h = (id / 8) % 4, b = id / 32; const int v = threadIdx.x; const size_t tokb = (size_t)b * SEQ;
    float o = 0.f;
    for (int d = 0; d < 128; ++d) { float st = 0.f;
        for (int s = 0; s <= t; ++s) { const bf16_t* row = P + (tokb + s) * PCOLS; const float f = expf(bf2f(row[C_HF + h * 128 + d])); st = f * st + (1.f - f) * bf2f(row[C_HI + h * 128 + v]); }
        o += bf2f(P[(tokb + t) * PCOLS + C_HQ + h * 128 + d]) * st; }
    __shared__ float red[128]; red[v] = o * o; __syncthreads();
    for (int w = 64; w > 0; w >>= 1) { if (v < w) red[v] += red[v + w]; __syncthreads(); }
    const float rstd = rsqrtf(red[0] / 128.f + EPS);
    const float ref = o * rstd * gain[v] * bf2f(P[(tokb + t) * PCOLS + C_HG + h * 128 + v]);
    if (!chk_close(bf2f(oa[(tokb + t) * 512 + h * 128 + v]), ref, 0.03f, 0.04f)) chk_fail(diag, code);
}
__global__ void k_chk_moe(const bf16_t* xn, const float* rw, const float* rb, const float* wg, const float* wu, const float* wd, const float* snap, const float* xout, unsigned code, unsigned* diag) {
    const int i = blockIdx.x; const int r = samp_row(i); const int tid = threadIdx.x;
    __shared__ float hid[DFF]; __shared__ float lg[8]; __shared__ float part[256];
    if (tid < 8) { float a = rb[tid]; for (int k = 0; k < D; ++k) a += bf2f(xn[(size_t)r * D + k]) * rw[k * 8 + tid]; lg[tid] = a; }
    __syncthreads();
    int i0 = 0; for (int e = 1; e < 8; ++e) if (lg[e] > lg[i0]) i0 = e;
    int i1 = -1; for (int e = 0; e < 8; ++e) if (e != i0 && (i1 < 0 || lg[e] > lg[i1])) i1 = e;
    const float w0 = 1.f / (1.f + expf(lg[i1] - lg[i0])), w1 = 1.f - w0;
    float outv[8]; for (int j = 0; j < 8; ++j) outv[j] = 0.f;
    for (int kk = 0; kk < 2; ++kk) { const int e = kk ? i1 : i0; const float wgt = kk ? w1 : w0;
        for (int f = tid; f < DFF; f += blockDim.x) { float g = 0.f, u = 0.f; for (int k = 0; k < D; ++k) { const float xv = bf2f(xn[(size_t)r * D + k]); g += xv * wg[((size_t)e * D + k) * DFF + f]; u += xv * wu[((size_t)e * D + k) * DFF + f]; } hid[f] = siluf_(g) * u; }
        __syncthreads();
        for (int j = 0; j < 8; ++j) { const int col = (j * 131 + i * 17) % D; float p = 0.f; for (int f = tid; f < DFF; f += blockDim.x) p += hid[f] * wd[((size_t)e * DFF + f) * D + col];
            part[tid] = p; __syncthreads(); for (int w = 128; w > 0; w >>= 1) { if (tid < w) part[tid] += part[tid + w]; __syncthreads(); } outv[j] += wgt * part[0]; __syncthreads(); }
    }
    if (tid == 0) for (int j = 0; j < 8; ++j) { const int col = (j * 131 + i * 17) % D; const float ref = snap[(size_t)i * D + col] + outv[j]; if (!chk_close(xout[(size_t)r * D + col], ref, 0.04f, 0.04f)) chk_fail(diag, code); }
}
#endif

struct Args { const float* in[21]; float* out; unsigned char* ws; int lo, hi; };
constexpr int NSTEPS = 50;

template <class Epi>
__device__ __forceinline__ void run_gemm(LAS unsigned char* lds, const Order& S, int K, const Epi& E) { pg8::gemm_phase<Epi, Order, true, true>(lds, K, S, E); }

__global__ void __launch_bounds__(NTHREADS, 2) mk_fwd(Args a) {
    extern __shared__ __attribute__((aligned(16))) unsigned char lds_raw[];
    LAS unsigned char* lds = (LAS unsigned char*)lds_raw;
    const int tid = threadIdx.x, lane = tid & 63, wid = __builtin_amdgcn_readfirstlane(tid >> 6), wg = blockIdx.x, G = gridDim.x;
    if (tid < 4) ((LAS unsigned*)(lds + LDS_MISC))[tid] = 0u;
    __syncthreads();
    const bool multi = (a.hi - a.lo) > 1;
    XcdBarrier bar; bar.bar = (unsigned*)(a.ws + WS_CTL + CW_BAR); bar.x = 0; bar.st = nullptr;
    if (multi) bar = xcd_barrier_post((unsigned*)(a.ws + WS_CTL + CW_BAR), (volatile LAS unsigned*)(lds + LDS_MISC));
    int step = 0;
#define RUN (a.lo <= step && step < a.hi)
#define SEAM() do { ++step; if (a.lo < step && step < a.hi) xcd_barrier(bar); } while (0)

#define XRES (a.out)
#define WIN ((bf16_t*)(a.ws + WS_WIN))
#define WBR ((bf16_t*)(a.ws + WS_WBR))
#define WOUT ((bf16_t*)(a.ws + WS_WOUT))
#define WGU ((bf16_t*)(a.ws + WS_WGU))
#define WDN ((bf16_t*)(a.ws + WS_WD))
#define XNB ((bf16_t*)(a.ws + WS_XN))
#define PBUF ((bf16_t*)(a.ws + WS_P))
#define GBUF ((bf16_t*)(a.ws + WS_G))
#define HIDB ((bf16_t*)(a.ws + WS_HID))
#define OCATB ((bf16_t*)(a.ws + WS_OCAT))
#define ORAWB ((float*)(a.ws + WS_ORAW))
#define MWGU ((bf16_t*)(a.ws + WS_MWGU))
#define MWDN ((bf16_t*)(a.ws + WS_MWD))
#define XSB ((bf16_t*)(a.ws + WS_XS))
#define MHIDB ((bf16_t*)(a.ws + WS_MHID))
#define LBB ((float*)(a.ws + WS_LB))
#define METAB ((int*)(a.ws + WS_META))
#define TOKE ((int*)(a.ws + WS_TOKE))
#define TOKW ((float2*)(a.ws + WS_TOKW))
#define STOK ((int*)(a.ws + WS_SLOTTOK))
#define SWB ((float*)(a.ws + WS_SLOTW))
    if (RUN) {
        LAS float* tile = (LAS float*)lds;
        for (int l = 0; l < 2; ++l) {
            tc_job(a.in[2] + (size_t)l * D * INCOLS, D, INCOLS, WIN + (size_t)l * INCOLS * D, 0, tile, wg, G, tid);
            for (int b = 0; b < 3; ++b) tc_job(a.in[10] + (size_t)(l * 3 + b) * 512 * D, 512, D, WBR + (size_t)(l * 3 + b) * D * 512, 0, tile, wg, G, tid);
            tc_job(a.in[11] + (size_t)l * D * D, D, D, WOUT + (size_t)l * D * D, 0, tile, wg, G, tid);
        }
        tc_job(a.in[13], D, DFF, WGU, 1, tile, wg, G, tid);
        tc_job(a.in[14], D, DFF, WGU, 2, tile, wg, G, tid);
        tc_job(a.in[15], DFF, D, WDN, 0, tile, wg, G, tid);
        if (wg == 0) { const float a0 = a.in[3][tid], a1 = a.in[3][512 + tid]; LBB[tid] = 0.f; LBB[512 + tid] = sigmoidf_(a1 - a0); }
    }
    SEAM();

    for (int l = 0; l < 2; ++l) {
        const float* xcur = (l == 0) ? a.in[0] : XRES;
        if (RUN) phase_rmsnorm<false>(xcur, a.in[1] + l * D, XNB, nullptr, nullptr, nullptr, nullptr, wg, G, wid, lane);
        SEAM();
        if (RUN) { Order S; S.init(XNB, WIN + (size_t)l * INCOLS * D, MTOK, PCOLS, D, G, wg); EpiAct E{PBUF, PCOLS, LBB + l * 512, 1}; run_gemm(lds, S, D, E); }
        SEAM();
        if (RUN) phase_hgrn_naive(PBUF, ORAWB, wg, G, wid, lane);
        SEAM();
        if (RUN) phase_gmlp_naive(PBUF, a.in[6] + (size_t)l * 4 * 16384, a.in[7] + l * 512, a.in[5] + l * 512, OCATB + (size_t)MTOK * 512, lds, wg, G, tid, wid, lane);
        SEAM();
        if (RUN) phase_attn_naive(PBUF, a.in[8] + l * 64, a.in[9] + l * 64, OCATB + (size_t)2 * MTOK * 512, lds, wg, G, wid, lane);
        SEAM();
        if (RUN) phase_hgrn_fin(ORAWB, PBUF, a.in[4] + l * 128, OCATB, wg, G, wid, lane);
        SEAM();
        if (RUN) { Order S; S.init(XNB, WIN + (size_t)l * INCOLS * D + (size_t)PCOLS * D, MTOK, GCOLS, D, G, wg); EpiAct E{GBUF, GCOLS, nullptr, 0}; run_gemm(lds, S, D, E); }
        SEAM();
        if (RUN) { Order S; S.init(OCATB, WBR + (size_t)l * 3 * D * 512, MTOK, GCOLS, 512, G, wg, 1, (size_t)MTOK * 512 * 2, (size_t)D * 512 * 2); EpiBranch E{GBUF}; run_gemm(lds, S, 512, E); }
        SEAM();
        if (RUN) phase_combine(GBUF, XNB, wg, G, tid);
        SEAM();
        if (RUN) { Order S; S.init(XNB, WOUT + (size_t)l * D * D, MTOK, D, D, G, wg); EpiResid E{xcur, XRES}; run_gemm(lds, S, D, E); }
        SEAM();
        if (l == 0) {
            if (RUN) phase_rmsnorm<false>(XRES, a.in[12] + l * D, XNB, nullptr, nullptr, nullptr, nullptr, wg, G, wid, lane);
            SEAM();
            if (RUN) { Order S; S.init(XNB, WGU, MTOK, 2 * DFF, D, G, wg); EpiGU E{HIDB}; run_gemm(lds, S, D, E); }
            SEAM();
            if (RUN) { Order S; S.init(HIDB, WDN, MTOK, D, DFF, G, wg); EpiResid E{XRES, XRES}; run_gemm(lds, S, DFF, E); }
            SEAM();
        } else {
            if (RUN) phase_rmsnorm<true>(XRES, a.in[12] + l * D, XNB, a.in[16], a.in[17], TOKE, TOKW, wg, G, wid, lane);
            SEAM();
            if (RUN) {
                if (wg == G - 1) moe_assign(TOKE, TOKW, METAB, STOK, SWB, lds, tid);
                else { LAS float* tile = (LAS float*)lds;
                    for (int e = 0; e < NEXP; ++e) {
                        tc_job(a.in[18] + (size_t)e * D * DFF, D, DFF, MWGU + (size_t)e * 2 * DFF * D, 1, tile, wg, G - 1, tid);
                        tc_job(a.in[19] + (size_t)e * D * DFF, D, DFF, MWGU + (size_t)e * 2 * DFF * D, 2, tile, wg, G - 1, tid);
                        tc_job(a.in[20] + (size_t)e * DFF * D, DFF, D, MWDN + (size_t)e * D * DFF, 0, tile, wg, G - 1, tid); } }
            }
            SEAM();
            for (int e = 0; e < NEXP; ++e) {
                const int rows = __hip_atomic_load(METAB + 8 + e, __ATOMIC_RELAXED, __HIP_MEMORY_SCOPE_AGENT), s0 = __hip_atomic_load(METAB + 16 + e, __ATOMIC_RELAXED, __HIP_MEMORY_SCOPE_AGENT);
                if (RUN) moe_gather(XNB, STOK + s0, rows, XSB, wg, G, wid, lane);
                SEAM();
                if (RUN) { Order S; S.init(XSB, MWGU + (size_t)e * 2 * DFF * D, rows, 2 * DFF, D, G, wg); EpiGU E{MHIDB}; run_gemm(lds, S, D, E); }
                SEAM();
                if (RUN) { Order S; S.init(MHIDB, MWDN + (size_t)e * D * DFF, rows, D, DFF, G, wg); EpiMoeDown E{XRES, STOK + s0, SWB + s0}; run_gemm(lds, S, DFF, E); }
                SEAM();
            }
        }
    }
#undef RUN
#undef SEAM
}

extern "C" void kernel_launch(void* const* d_in, const int* in_sizes, int n_in, void* d_out, int out_size, void* d_ws, size_t ws_size, hipStream_t stream) {
    static int grid = 0;
    if (grid == 0) {
        if (n_in != 21 || out_size != MTOK * D || ws_size < WS_NEED) { fprintf(stderr, "kernel_launch: unexpected shapes (n_in %d out %d ws %zu need %zu)\n", n_in, out_size, ws_size, (size_t)WS_NEED); grid = -1; return; }
        int dev = 0, cus = 0, per_cu = 0;
        if (hipGetDevice(&dev) != hipSuccess || hipDeviceGetAttribute(&cus, hipDeviceAttributeMultiprocessorCount, dev) != hipSuccess) { grid = -1; return; }
        if (hipFuncSetAttribute((const void*)mk_fwd, hipFuncAttributeMaxDynamicSharedMemorySize, LDS_BYTES) != hipSuccess) { fprintf(stderr, "kernel_launch: hipFuncSetAttribute failed\n"); grid = -1; return; }
        if (hipOccupancyMaxActiveBlocksPerMultiprocessor(&per_cu, (const void*)mk_fwd, NTHREADS, LDS_BYTES) != hipSuccess || per_cu < 1) { fprintf(stderr, "kernel_launch: occupancy query says %d\n", per_cu); (void)hipGetLastError(); per_cu = 1; }
        grid = cus;
    }
    if (grid < 0) return;
    (void)hipMemsetAsync((char*)d_ws + WS_CTL, 0, CTL_BYTES, stream);
    Args a{};
    for (int i = 0; i < 21; ++i) a.in[i] = (const float*)d_in[i];
    a.out = (float*)d_out; a.ws = (unsigned char*)d_ws;
#if defined(MK_CHECK)
    {
        unsigned char* ws = (unsigned char*)d_ws; unsigned* diag = (unsigned*)(ws + WS_DIAG); float* snap = (float*)(ws + WS_SNAP);
        const bf16_t* XN = (const bf16_t*)(ws + WS_XN); const bf16_t* Pb = (const bf16_t*)(ws + WS_P); const bf16_t* OC = (const bf16_t*)(ws + WS_OCAT); const float* LB = (const float*)(ws + WS_LB);
        auto run = [&](int s) { a.lo = s; a.hi = s + 1; hipLaunchKernelGGL(mk_fwd, dim3(grid), dim3(NTHREADS), LDS_BYTES, stream, a); };
        hipLaunchKernelGGL(k_diag_init, dim3(1), dim3(64), 0, stream, diag);
        int s = 0; run(s++);
        for (int l = 0; l < 2; ++l) {
            const unsigned cb = l * 10;
            const float* win = a.in[2] + (size_t)l * D * INCOLS;
            run(s++); run(s++);
            { ChkGemm c{}; c.A = XN; c.lda = D; c.W = win; c.ldw = INCOLS; c.K = D; c.mode = 0; c.Cb = Pb; c.ldc = PCOLS; c.lb = LB + l * 512; c.ncols = PCOLS; c.code = cb + 1; hipLaunchKernelGGL(k_chk_gemm, dim3(64), dim3(96), 0, stream, c, diag); }
            run(s++); run(s++); run(s++); run(s++);
            hipLaunchKernelGGL(k_chk_hgrn, dim3(128), dim3(128), 0, stream, Pb, a.in[4] + l * 128, OC, cb + 2, diag);
            hipLaunchKernelGGL(k_chk_gmlp, dim3(8), dim3(64), 0, stream, Pb, a.in[6] + (size_t)l * 4 * 16384, a.in[7] + l * 512, a.in[5] + l * 512, OC + (size_t)MTOK * 512, cb + 3, diag);
            hipLaunchKernelGGL(k_chk_attn, dim3(320), dim3(64), 0, stream, Pb, a.in[8] + l * 64, a.in[9] + l * 64, OC + (size_t)2 * MTOK * 512, cb + 4, diag);
            run(s++);
            { ChkGemm c{}; c.A = XN; c.lda = D; c.W = win + PCOLS; c.ldw = INCOLS; c.K = D; c.mode = 1; c.Cb = (const bf16_t*)(ws + WS_G); c.ldc = GCOLS; c.ncols = GCOLS; c.code = cb + 5; hipLaunchKernelGGL(k_chk_gemm, dim3(64), dim3(96), 0, stream, c, diag); }
            run(s++);
            hipLaunchKernelGGL(k_chk_branch, dim3(64), dim3(96), 0, stream, OC, a.in[10] + (size_t)l * 3 * 512 * D, XN, win, (const bf16_t*)(ws + WS_G), cb + 6, diag);
            run(s++);
            if (l == 1) hipLaunchKernelGGL(k_snapshot, dim3(64), dim3(256), 0, stream, (const float*)d_out, snap);
            run(s++);
            { ChkGemm c{}; c.A = XN; c.lda = D; c.W = a.in[11] + (size_t)l * D * D; c.ldw = D; c.K = D; c.mode = 3; c.Cf = (const float*)d_out; c.xold = l ? snap : a.in[0]; c.use_snap = l; c.ncols = D; c.code = cb + 7; hipLaunchKernelGGL(k_chk_gemm, dim3(64), dim3(96), 0, stream, c, diag); }
            run(s++);
            if (l == 0) {
                run(s++);
                { ChkGemm c{}; c.A = XN; c.lda = D; c.W = a.in[13]; c.W2 = a.in[14]; c.ldw = DFF; c.K = D; c.mode = 4; c.Cb = (const bf16_t*)(ws + WS_HID); c.ldc = DFF; c.ncols = DFF; c.code = cb + 8; hipLaunchKernelGGL(k_chk_gemm, dim3(64), dim3(96), 0, stream, c, diag); }
                hipLaunchKernelGGL(k_snapshot, dim3(64), dim3(256), 0, stream, (const float*)d_out, snap);
                run(s++);
                { ChkGemm c{}; c.A = (const bf16_t*)(ws + WS_HID); c.lda = DFF; c.W = a.in[15]; c.ldw = D; c.K = DFF; c.mode = 3; c.Cf = (const float*)d_out; c.xold = snap; c.use_snap = 1; c.ncols = D; c.code = cb + 9; hipLaunchKernelGGL(k_chk_gemm, dim3(64), dim3(96), 0, stream, c, diag); }
            } else {
                hipLaunchKernelGGL(k_snapshot, dim3(64), dim3(256), 0, stream, (const float*)d_out, snap);
                run(s++);
                for (int e = 0; e < NEXP * 3; ++e) run(s++);
                hipLaunchKernelGGL(k_chk_moe, dim3(16), dim3(256), 0, stream, XN, a.in[16], a.in[17], a.in[18], a.in[19], a.in[20], (const float*)snap, (const float*)d_out, 20u, diag);
            }
        }
        if (s != NSTEPS) fprintf(stderr, "step count mismatch %d\n", s);
        hipLaunchKernelGGL(k_apply_diag, dim3(1024), dim3(256), 0, stream, (float*)d_out, (const unsigned*)diag);
    }
#elif !defined(MK_ONE_LAUNCH)
    for (int s = 0; s < NSTEPS; ++s) { a.lo = s; a.hi = s + 1; hipLaunchKernelGGL(mk_fwd, dim3(grid), dim3(NTHREADS), LDS_BYTES, stream, a); }
#else
    a.lo = 0; a.hi = NSTEPS; hipLaunchKernelGGL(mk_fwd, dim3(grid), dim3(NTHREADS), LDS_BYTES, stream, a);
#endif
}
```

```cpp
#define MK_ONE_LAUNCH 1
#include <hip/hip_runtime.h>
#include <cstdio>
#include <cstdint>
#include <cstddef>

#define LAS __attribute__((address_space(3)))
#define XB_TMO      128
#define XB_XCNT(j)  (256  + 64 * (j))
#define XB_XSUB(j)  (1280 + 64 * (j))
#define XB_XGEN(j)  (2304 + 64 * (j))
#define XB_TOP      3328
#define XB_TOPGEN   3392
#define XCD_BAR_WORDS 3456
#define XB_SPIN_CAP (1u << 18)

__device__ __forceinline__ unsigned xb_ld(unsigned* p)              { return __hip_atomic_load(p, __ATOMIC_RELAXED, __HIP_MEMORY_SCOPE_AGENT); }
__device__ __forceinline__ unsigned xb_add(unsigned* p, unsigned v) { return __hip_atomic_fetch_add(p, v, __ATOMIC_RELAXED, __HIP_MEMORY_SCOPE_AGENT); }
__device__ __forceinline__ unsigned xb_xcc_id() { return (unsigned)__builtin_amdgcn_s_getreg((3 << 11) | 20) & 0xFu; }
#define XB_SPIN(cond, bar) do { unsigned _sp = 0; while (cond) { __builtin_amdgcn_s_sleep(1); \
    if ((++_sp & 255u) == 0u) { if (xb_ld(&(bar)[XB_TMO])) break; if (_sp > XB_SPIN_CAP) { atomicAdd(&(bar)[XB_TMO], 1u); break; } } } } while (0)

struct XcdBarrier {
    unsigned* bar; unsigned x;
    volatile LAS unsigned* st;
};

__device__ __forceinline__ XcdBarrier xcd_barrier_post(unsigned* bar, volatile LAS unsigned* st) {
    XcdBarrier b; b.bar = bar; b.x = xb_xcc_id(); b.st = st;
    if (threadIdx.x == 0) (void)xb_add(&bar[XB_XCNT(b.x)], 1u);
    return b;
}
__device__ __forceinline__ void xcd_barrier_complete(unsigned* bar, unsigned x, unsigned& nloc, unsigned& nx) {
    const unsigned G = gridDim.x * gridDim.y * gridDim.z;
    unsigned sum, cnt, mine, sp = 0u;
    for (;;) {
        sum = 0u; cnt = 0u; mine = 0u;
#pragma unroll
        for (unsigned j = 0; j < 16; ++j) { const unsigned c = xb_ld(&bar[XB_XCNT(j)]); sum += c; cnt += (c > 0u) ? 1u : 0u; mine = (j == x) ? c : mine; }
        if (sum == G) break;
        __builtin_amdgcn_s_sleep(1);
        if ((++sp & 255u) == 0u) { if (xb_ld(&bar[XB_TMO])) break; if (sp > XB_SPIN_CAP) { atomicAdd(&bar[XB_TMO], 1u); break; } }
    }
    nloc = mine > 0u ? mine : 1u; nx = cnt > 0u ? cnt : 1u;
}

__device__ __forceinline__ void xcd_barrier(const XcdBarrier& b) {
    asm volatile("s_waitcnt vmcnt(0)" ::: "memory");
    __syncthreads();
    if (threadIdx.x == 0) {
        unsigned* bar = b.bar;
        __builtin_amdgcn_s_waitcnt(0);
        unsigned nloc = b.st[0], nx = b.st[1];
        if (nloc == 0u) { xcd_barrier_complete(bar, b.x, nloc, nx); b.st[0] = nloc; b.st[1] = nx; }
        const unsigned old = xb_add(&bar[XB_XSUB(b.x)], 1u);
        const unsigned gen = old / nloc;
        if (old + 1u == (gen + 1u) * nloc) {
            __builtin_amdgcn_fence(__ATOMIC_RELEASE, "agent");
            asm volatile("s_waitcnt vmcnt(0)" ::: "memory");
            const unsigned og = xb_add(&bar[XB_TOP], 1u);
            const unsigned tg = og / nx;
            if (og + 1u == (tg + 1u) * nx) xb_add(&bar[XB_TOPGEN], 1u);
            else XB_SPIN(xb_ld(&bar[XB_TOPGEN]) == tg, bar);
            __builtin_amdgcn_fence(__ATOMIC_ACQUIRE, "agent");
            xb_add(&bar[XB_XGEN(b.x)], 1u);
            asm volatile("s_waitcnt vmcnt(0)" ::: "memory");
        } else {
            XB_SPIN(xb_ld(&bar[XB_XGEN(b.x)]) == gen, bar);
            __builtin_amdgcn_fence(__ATOMIC_ACQUIRE, "agent");
            asm volatile("s_waitcnt vmcnt(0)" ::: "memory");
        }
    }
    __syncthreads();
}
namespace pg8 {
#define PG8_LAS __attribute__((address_space(3)))
typedef unsigned short bf16_t;
typedef short bf16x8 __attribute__((ext_vector_type(8)));
typedef float f32x4 __attribute__((ext_vector_type(4)));
typedef unsigned u32x4 __attribute__((ext_vector_type(4)));
constexpr int BM = 256, BK = 64, HALF = 128, HTB = HALF * BK * 2  , STAGE_BYTES = 8 * HTB, NXCD = 8, WGM = 8;

__host__ __device__ __forceinline__ int lds_byte(int r, int c) { const int st = (r >> 4) * 2 + (c >> 5), rr = r & 15, cc = c & 31, ob = rr * 64 + cc * 2; return st * 1024 + (ob ^ (((ob >> 9) & 1) << 5)); }
__host__ __device__ __forceinline__ void stage_rc(int b, int& R, int& C) { const int st = b / 1024, sb = b % 1024, swz = sb ^ (((sb >> 9) & 1) << 5); R = (st >> 1) * 16 + swz / 64; C = (st & 1) * 32 + (swz % 64) / 2; }
__host__ __device__ __forceinline__ int perm32(int rho) { const int n = rho >> 4, i = rho & 15; return 8 * (i >> 2) + 4 * n + (i & 3); }

struct Unit { int pm, pn; const char* a; const char* b; };

typedef float f32x2 __attribute__((ext_vector_type(2))); typedef __bf16 bf16x2_t __attribute__((ext_vector_type(2)));
__device__ __forceinline__ unsigned cvt_pk_bf16(float lo, float hi) { f32x2 v = {lo, hi}; bf16x2_t b = __builtin_convertvector(v, bf16x2_t); return __builtin_bit_cast(unsigned, b); }
template <class Epi, class Sched, bool ALIGN_EPI = false, bool SP2 = false>
__device__ __forceinline__ void gemm_phase(PG8_LAS unsigned char* lds, const int K, const Sched& S, const Epi& E, const int wid) {
    const int lane = (int)__builtin_amdgcn_mbcnt_hi(~0u, __builtin_amdgcn_mbcnt_lo(~0u, 0u)), tid = wid * 64 + lane, wr = wid >> 2, wc = wid & 3, fr = lane & 15, fq = lane >> 4;
    const int nt = K / BK;
    unsigned voffA[2];
#pragma unroll
    for (int i = 0; i < 2; ++i) { int R, C; stage_rc(tid * 16 + i * 8192, R, C); voffA[i] = (unsigned)(R * K + C) * 2u; }
    const size_t kstep = (size_t)(BK * 2);
    const size_t hstep = (size_t)HALF * K * 2;
    const unsigned ldsw = (unsigned)wid * 1024u;
    const int aoff = lds_byte(wr * 64 + fr, fq * 8), boff = lds_byte(wc * 32 + fr, fq * 8);
#define PG8_SA(b, h) (((b) * 2 + (h)) * HTB)
#define PG8_SB(b, h) ((4 + (b) * 2 + (h)) * HTB)
#define PG8_STAGE(bufoff, gbase, voff) do { _Pragma("unroll") for (int _i = 0; _i < 2; ++_i) \
        __builtin_amdgcn_global_load_lds((const unsigned*)((const char*)(gbase) + (voff)[_i]), (PG8_LAS unsigned*)(lds + (bufoff) + ldsw + _i * 8192), 16, 0, 0); } while (0)
#define PG8_LDA(dst, b, h) do { _Pragma("unroll") for (int m = 0; m < 4; ++m) _Pragma("unroll") for (int k = 0; k < 2; ++k) dst[m][k] = *(const PG8_LAS bf16x8*)(lds + PG8_SA(b, h) + aoff + m * 2048 + k * 1024); } while (0)
#define PG8_LDB(dst, b, h) do { _Pragma("unroll") for (int n = 0; n < 2; ++n) _Pragma("unroll") for (int k = 0; k < 2; ++k) dst[n][k] = *(const PG8_LAS bf16x8*)(lds + PG8_SB(b, h) + boff + n * 2048 + k * 1024); } while (0)
#define PG8_MMA(ai, bj, At, Bt) do { __builtin_amdgcn_s_setprio(1); _Pragma("unroll") for (int m = 0; m < 4; ++m) _Pragma("unroll") for (int n = 0; n < 2; ++n) _Pragma("unroll") for (int k = 0; k < 2; ++k) \
        acc[ai][bj][m][n] = __builtin_amdgcn_mfma_f32_16x16x32_bf16(Bt[n][k], At[m][k], acc[ai][bj][m][n], 0, 0, 0); __builtin_amdgcn_s_setprio(0); } while (0)
#define PG8_WAIT_V(n) asm volatile("s_waitcnt vmcnt(" #n ")" ::: "memory")
#define PG8_WAIT_L(n) asm volatile("s_waitcnt lgkmcnt(" #n ")" ::: "memory")
#define PG8_BAR __builtin_amdgcn_s_barrier()
#define PG8_SCHED __builtin_amdgcn_sched_barrier(0)
    Unit cur, nxt; int ui = 0;
    if (!S.next(0, cur)) return;
    f32x4 acc[2][2][4][2];
#pragma unroll
    for (int a = 0; a < 2; ++a)
#pragma unroll
        for (int b = 0; b < 2; ++b)
#pragma unroll
            for (int m = 0; m < 4; ++m)
#pragma unroll
                for (int n = 0; n < 2; ++n) acc[a][b][m][n] = (f32x4){0.f, 0.f, 0.f, 0.f};
    bf16x8 At[4][2], B0[2][2], B1[2][2];
    const char* cA = cur.a; const char* cB = cur.b;
    S.a_ready(cur);
    if constexpr (SP2) {
        PG8_STAGE(PG8_SB(0, 0), cB, voffA); PG8_STAGE(PG8_SB(0, 1), cB + hstep, voffA); PG8_STAGE(PG8_SA(0, 0), cA, voffA); PG8_STAGE(PG8_SA(0, 1), cA + hstep, voffA);
        if (wr == 1) PG8_BAR;
        PG8_WAIT_V(2); PG8_BAR;
        PG8_STAGE(PG8_SB(1, 0), cB + kstep, voffA); PG8_STAGE(PG8_SA(1, 0), cA + kstep, voffA); PG8_STAGE(PG8_SB(1, 1), cB + hstep + kstep, voffA);
        PG8_WAIT_V(6); PG8_BAR;
    } else {
        PG8_STAGE(PG8_SB(0, 0), cB, voffA); PG8_STAGE(PG8_SA(0, 0), cA, voffA); PG8_STAGE(PG8_SB(0, 1), cB + hstep, voffA); PG8_STAGE(PG8_SA(0, 1), cA + hstep, voffA);
        if (wr == 1) PG8_BAR;
        PG8_WAIT_V(4); PG8_BAR;
        PG8_STAGE(PG8_SB(1, 0), cB + kstep, voffA); PG8_STAGE(PG8_SA(1, 0), cA + kstep, voffA); PG8_STAGE(PG8_SB(1, 1), cB + hstep + kstep, voffA);
        PG8_WAIT_V(6); PG8_BAR;
    }
    for (;;) {
        const bool has_next = S.next(ui + 1, nxt);
        const char* nA = has_next ? nxt.a : cA; const char* nB = has_next ? nxt.b : cB;
        for (int t = 0; t < nt; t += 2) {
            const bool last = (t == nt - 2);
            const char* a1 = cA + (size_t)(t + 1) * kstep;
            const char* a2 = last ? nA : cA + (size_t)(t + 2) * kstep; const char* b2 = last ? nB : cB + (size_t)(t + 2) * kstep;
            const char* a3 = a2 + kstep; const char* b3 = b2 + kstep;
            if (last && has_next) S.a_ready(nxt);
            if constexpr (SP2) {
            PG8_LDB(B0, 0, 0); PG8_LDB(B1, 0, 1); PG8_SCHED; PG8_LDA(At, 0, 0); PG8_STAGE(PG8_SA(1, 1), a1 + hstep, voffA);
            PG8_WAIT_V(8); PG8_WAIT_L(0); PG8_BAR; PG8_MMA(0, 0, At, B0); PG8_MMA(0, 1, At, B1); PG8_BAR; PG8_SCHED;
            PG8_LDA(At, 0, 1); PG8_STAGE(PG8_SB(0, 0), b2, voffA); PG8_STAGE(PG8_SB(0, 1), b2 + hstep, voffA); PG8_STAGE(PG8_SA(0, 0), a2, voffA);
            PG8_WAIT_V(8); PG8_WAIT_L(0); PG8_BAR; PG8_MMA(1, 0, At, B0); PG8_MMA(1, 1, At, B1); PG8_BAR; PG8_SCHED;
            PG8_LDB(B0, 1, 0); PG8_LDB(B1, 1, 1); PG8_SCHED; PG8_LDA(At, 1, 0); PG8_STAGE(PG8_SA(0, 1), a2 + hstep, voffA);
            PG8_WAIT_V(8); PG8_WAIT_L(0); PG8_BAR; PG8_MMA(0, 0, At, B0); PG8_MMA(0, 1, At, B1); PG8_BAR; PG8_SCHED;
            PG8_LDA(At, 1, 1); PG8_STAGE(PG8_SB(1, 0), b3, voffA); PG8_STAGE(PG8_SB(1, 1), b3 + hstep, voffA); PG8_STAGE(PG8_SA(1, 0), a3, voffA);
            PG8_WAIT_V(8); PG8_WAIT_L(0); PG8_BAR; PG8_MMA(1, 0, At, B0); PG8_MMA(1, 1, At, B1); PG8_BAR; PG8_SCHED;
            } else {
            PG8_LDB(B0, 0, 0); PG8_SCHED; PG8_LDA(At, 0, 0); PG8_STAGE(PG8_SA(1, 1), a1 + hstep, voffA);
            PG8_WAIT_L(8); PG8_BAR; PG8_WAIT_L(0); PG8_MMA(0, 0, At, B0); PG8_BAR; PG8_SCHED;
            PG8_LDB(B1, 0, 1); PG8_STAGE(PG8_SB(0, 0), b2, voffA);
            PG8_BAR; PG8_WAIT_L(0); PG8_MMA(0, 1, At, B1); PG8_BAR;
            PG8_LDA(At, 0, 1); PG8_STAGE(PG8_SA(0, 0), a2, voffA);
            PG8_BAR; PG8_WAIT_L(0); PG8_MMA(1, 0, At, B0); PG8_BAR; PG8_SCHED;
            PG8_STAGE(PG8_SB(0, 1), b2 + hstep, voffA);
            PG8_WAIT_V(6); PG8_BAR; PG8_MMA(1, 1, At, B1); PG8_BAR;
            PG8_LDB(B0, 1, 0); PG8_SCHED; PG8_LDA(At, 1, 0); PG8_STAGE(PG8_SA(0, 1), a2 + hstep, voffA);
            PG8_WAIT_L(8); PG8_BAR; PG8_WAIT_L(0); PG8_MMA(0, 0, At, B0); PG8_BAR; PG8_SCHED;
            PG8_LDB(B1, 1, 1); PG8_STAGE(PG8_SB(1, 0), b3, voffA);
            PG8_BAR; PG8_WAIT_L(0); PG8_MMA(0, 1, At, B1); PG8_BAR;
            PG8_LDA(At, 1, 1); PG8_STAGE(PG8_SA(1, 0), a3, voffA);
            PG8_BAR; PG8_WAIT_L(0); PG8_MMA(1, 0, At, B0); PG8_BAR; PG8_SCHED;
            PG8_STAGE(PG8_SB(1, 1), b3 + hstep, voffA);
            PG8_WAIT_V(6); PG8_BAR; PG8_MMA(1, 1, At, B1); PG8_BAR;
            }
        }
        if constexpr (ALIGN_EPI) { if (wr == 0) PG8_BAR; }
        if constexpr (!Epi::AFTER_DRAIN) { E(acc, cur, wr, wc, fr, fq); S.done(cur); }
        if (!has_next) break;
#pragma unroll
        for (int a = 0; a < 2; ++a)
#pragma unroll
            for (int b = 0; b < 2; ++b)
#pragma unroll
                for (int m = 0; m < 4; ++m)
#pragma unroll
                    for (int n = 0; n < 2; ++n) acc[a][b][m][n] = (f32x4){0.f, 0.f, 0.f, 0.f};
        cur = nxt; cA = nA; cB = nB; ++ui;
        if constexpr (ALIGN_EPI) { if (wr == 1) PG8_BAR; }
    }
    PG8_WAIT_V(0);
    if constexpr (!ALIGN_EPI) { if (wr == 0) PG8_BAR; }
    PG8_BAR;
    if constexpr (Epi::AFTER_DRAIN) { E.fused(acc, cur, wr, wc, fr, fq, lds, wid, lane); S.done(cur); }
#undef PG8_SA
#undef PG8_SB
#undef PG8_STAGE
#undef PG8_LDA
#undef PG8_LDB
#undef PG8_MMA
#undef PG8_WAIT_V
#undef PG8_WAIT_L
#undef PG8_BAR
#undef PG8_SCHED
}
}

typedef pg8::bf16_t bf16_t;
typedef pg8::f32x4 f32x4;
typedef pg8::u32x4 u32x4;
using pg8::cvt_pk_bf16;
constexpr int NB = 4, SEQ = 8192, D = 1024, MTOK = NB * SEQ;
constexpr int PCOLS = 4608, GCOLS = 3072, INCOLS = 7680, DFF = 3584, NEXP = 8;
constexpr int C_HQ = 0, C_HF = 512, C_HI = 1024, C_HG = 1536, C_GU = 2048, C_GV = 2560, C_SQ = 3072, C_SK = 3584, C_SV = 4096;
constexpr float EPS = 1e-6f;
constexpr int NSLOT = 2 * MTOK + NEXP * 256;
constexpr int NTHREADS = 512, NWAVES = 8;
constexpr int LDS_BYTES = 147456, LDS_MISC = LDS_BYTES - 256;

constexpr size_t WS_CTL = 0, CTL_BYTES = 65536;
constexpr size_t CW_BAR = 0;
constexpr size_t WS_META = WS_CTL + CTL_BYTES;
constexpr size_t WS_LB = WS_META + 4096;
constexpr size_t WS_TOKE = WS_LB + 4096;
constexpr size_t WS_TOKW = WS_TOKE + (size_t)MTOK * 4;
constexpr size_t WS_SLOTTOK = WS_TOKW + (size_t)MTOK * 8;
constexpr size_t WS_SLOTW = WS_SLOTTOK + (size_t)NSLOT * 4;
constexpr size_t WS_W = 2u << 20;
static_assert(WS_SLOTW + (size_t)NSLOT * 4 <= WS_W, "small buffers");
constexpr size_t WS_WIN = WS_W;
constexpr size_t WS_WBR = WS_WIN + (size_t)2 * INCOLS * D * 2;
constexpr size_t WS_WOUT = WS_WBR + (size_t)2 * 3 * D * 512 * 2;
constexpr size_t WS_WGU = WS_WOUT + (size_t)2 * D * D * 2;
constexpr size_t WS_WD = WS_WGU + (size_t)2 * DFF * D * 2;
constexpr size_t WS_XN = WS_WD + (size_t)D * DFF * 2;
constexpr size_t WS_C = WS_XN + (size_t)MTOK * D * 2;
constexpr size_t WS_P = WS_C;
constexpr size_t WS_G = WS_C;
constexpr size_t WS_HID = WS_C;
constexpr size_t WS_OCAT = WS_C + (size_t)MTOK * PCOLS * 2;
constexpr size_t WS_ORAW = WS_OCAT + (size_t)3 * MTOK * 512 * 2;
constexpr size_t WS_END1 = WS_ORAW + (size_t)MTOK * 512 * 4;
constexpr size_t WS_MWGU = WS_C;
constexpr size_t WS_MWD = WS_MWGU + (size_t)NEXP * 2 * DFF * D * 2;
constexpr size_t WS_XS = WS_MWD + (size_t)NEXP * D * DFF * 2;
constexpr size_t WS_MHID = WS_XS + (size_t)MTOK * D * 2;
constexpr size_t WS_END2 = WS_MHID + (size_t)MTOK * DFF * 2;
constexpr size_t WS_NEED = WS_END1 > WS_END2 ? WS_END1 : WS_END2;
static_assert(WS_NEED <= 615053344ull, "workspace budget (sum of the inputs)");

#define LAUNDER(v) asm volatile("" : "+v"(v))
__device__ __forceinline__ float bf2f(unsigned v) { return __uint_as_float(v << 16); }
__device__ __forceinline__ float bflo(unsigned w) { return __uint_as_float(w << 16); }
__device__ __forceinline__ float bfhi(unsigned w) { return __uint_as_float(w & 0xffff0000u); }
__device__ __forceinline__ bf16_t f2bf(float f) { return (bf16_t)(cvt_pk_bf16(f, 0.f) & 0xffffu); }
__device__ __forceinline__ float wave_sum(float v) {
#pragma unroll
    for (int o = 32; o > 0; o >>= 1) v += __shfl_xor(v, o);
    return v;
}
__device__ __forceinline__ float sigmoidf_(float x) { return __builtin_amdgcn_rcpf(1.f + __expf(-x)); }
__device__ __forceinline__ float siluf_(float x) { return x * sigmoidf_(x); }
__device__ __forceinline__ float gelu_tanh_(float x) { return x * sigmoidf_(1.5957691216057308f * (x + 0.044715f * x * x * x)); }
__device__ __forceinline__ float softplusf_(float z) { return fmaxf(z, 0.f) + __logf(1.f + __expf(-fabsf(z))); }

struct Order {
    int nM, nN, nwg, G, c, mode; const char* A; const char* Bt; size_t tstep, abr, bbr;
    __device__ void init(const void* A_, const void* Bt_, int M, int N, int K, int G_, int c_, int mode_ = 0, size_t abr_ = 0, size_t bbr_ = 0) {
        nM = M / 256; nN = N / 256; nwg = nM * nN; G = G_; c = c_; mode = mode_; A = (const char*)A_; Bt = (const char*)Bt_; tstep = (size_t)256 * K * 2; abr = abr_; bbr = bbr_; }
    __device__ bool next(int i, pg8::Unit& u) const {
        const long L = (long)i * G + c; if (L >= nwg) return false;
        int wgid = (int)L; { const int q = nwg / 8, r = nwg % 8, xcd = wgid % 8, off = wgid / 8; wgid = (xcd < r ? xcd * (q + 1) : r * (q + 1) + (xcd - r) * q) + off; }
        const int nig = 8 * nN, gid = wgid / nig, fm = gid * 8, gsz = (nM - fm) < 8 ? (nM - fm) : 8;
        u.pm = fm + ((wgid % nig) % gsz); u.pn = (wgid % nig) / gsz;
        if (mode == 0) { u.a = A + (size_t)u.pm * tstep; u.b = Bt + (size_t)u.pn * tstep; }
        else { const int br = u.pn >> 2; u.a = A + (size_t)br * abr + (size_t)u.pm * tstep; u.b = Bt + (size_t)br * bbr + (size_t)(u.pn & 3) * tstep; }
        return true;
    }
    __device__ __forceinline__ void a_ready(const pg8::Unit&) const {}
    __device__ __forceinline__ void done(const pg8::Unit&) const {}
};

template <int ACT> __device__ __forceinline__ float act_(float x, float lb) {
    if (ACT == 1) return siluf_(x);
    if (ACT == 2) return __logf(lb + (1.f - lb) * sigmoidf_(x));
    if (ACT == 3) return gelu_tanh_(x);
    if (ACT == 4) return sigmoidf_(x);
    return x;
}
struct EpiAct {
    static constexpr bool PERM = true, AFTER_DRAIN = false;
    bf16_t* O; int ldc; const float* lb; int inproj;
    template <int ACT> __device__ __forceinline__ void run(const f32x4 (&acc)[2][2][4][2], const pg8::Unit& u, int wr, int wc, int fr, int fq) const {
        const int row0 = u.pm * 256 + wr * 64 + fr, col0 = u.pn * 256 + wc * 32 + 8 * fq;
        f32x4 lbv[2][2];
#pragma unroll
        for (int bj = 0; bj < 2; ++bj)
#pragma unroll
            for (int n = 0; n < 2; ++n) lbv[bj][n] = (ACT == 2) ? *(const f32x4*)(lb + (col0 - C_HF) + bj * 128 + 4 * n) : (f32x4){0.f, 0.f, 0.f, 0.f};
#pragma unroll
        for (int ai = 0; ai < 2; ++ai)
#pragma unroll
            for (int m = 0; m < 4; ++m) { bf16_t* rowp = O + (size_t)(row0 + ai * 128 + m * 16) * ldc + col0;
#pragma unroll
                for (int bj = 0; bj < 2; ++bj) { f32x4 v0 = acc[ai][bj][m][0], v1 = acc[ai][bj][m][1];
#pragma unroll
                    for (int i = 0; i < 4; ++i) { v0[i] = act_<ACT>(v0[i], lbv[bj][0][i]); v1[i] = act_<ACT>(v1[i], lbv[bj][1][i]); }
                    u32x4 w; w.x = cvt_pk_bf16(v0[0], v0[1]); w.y = cvt_pk_bf16(v0[2], v0[3]); w.z = cvt_pk_bf16(v1[0], v1[1]); w.w = cvt_pk_bf16(v1[2], v1[3]);
                    *(u32x4*)(rowp + bj * 128) = w; } }
    }
    __device__ __forceinline__ void operator()(const f32x4 (&acc)[2][2][4][2], const pg8::Unit& u, int wr, int wc, int fr, int fq) const {
        if (!inproj) { run<4>(acc, u, wr, wc, fr, fq); return; }
        const int kind = u.pn >> 1;
        if (kind == 0 || kind == 3) run<1>(acc, u, wr, wc, fr, fq);
        else if (kind == 1) run<2>(acc, u, wr, wc, fr, fq);
        else if (kind == 4 || kind == 5) run<3>(acc, u, wr, wc, fr, fq);
        else run<0>(acc, u, wr, wc, fr, fq);
    }
};
struct EpiBranch {
    static constexpr bool PERM = true, AFTER_DRAIN = false;
    bf16_t* GH;
    __device__ __forceinline__ void operator()(const f32x4 (&acc)[2][2][4][2], const pg8::Unit& u, int wr, int wc, int fr, int fq) const {
        const int row0 = u.pm * 256 + wr * 64 + fr, col0 = u.pn * 256 + wc * 32 + 8 * fq;
#pragma unroll
        for (int ai = 0; ai < 2; ++ai)
#pragma unroll
            for (int m = 0; m < 4; ++m) { bf16_t* rowp = GH + (size_t)(row0 + ai * 128 + m * 16) * GCOLS + col0;
#pragma unroll
                for (int bj = 0; bj < 2; ++bj) { const f32x4 v0 = acc[ai][bj][m][0], v1 = acc[ai][bj][m][1];
                    const u32x4 g = *(const u32x4*)(rowp + bj * 128); u32x4 w;
                    w.x = cvt_pk_bf16(v0[0] * bflo(g.x), v0[1] * bfhi(g.x)); w.y = cvt_pk_bf16(v0[2] * bflo(g.y), v0[3] * bfhi(g.y));
                    w.z = cvt_pk_bf16(v1[0] * bflo(g.z), v1[1] * bfhi(g.z)); w.w = cvt_pk_bf16(v1[2] * bflo(g.w), v1[3] * bfhi(g.w));
                    *(u32x4*)(rowp + bj * 128) = w; } }
    }
};
struct EpiResid {
    static constexpr bool PERM = false, AFTER_DRAIN = false;
    const float* xin; float* xout;
    __device__ __forceinline__ void operator()(const f32x4 (&acc)[2][2][4][2], const pg8::Unit& u, int wr, int wc, int fr, int fq) const {
        const int row0 = u.pm * 256 + wr * 64 + fr, col0 = u.pn * 256 + wc * 32 + 4 * fq;
#pragma unroll
        for (int ai = 0; ai < 2; ++ai)
#pragma unroll
            for (int m = 0; m < 4; ++m) { const size_t ro = (size_t)(row0 + ai * 128 + m * 16) * D + col0;
#pragma unroll
                for (int bj = 0; bj < 2; ++bj)
#pragma unroll
                    for (int n = 0; n < 2; ++n) *(f32x4*)(xout + ro + bj * 128 + n * 16) = *(const f32x4*)(xin + ro + bj * 128 + n * 16) + acc[ai][bj][m][n]; }
    }
};
struct EpiGU {
    static constexpr bool PERM = true, AFTER_DRAIN = false;
    bf16_t* H;
    __device__ __forceinline__ void operator()(const f32x4 (&acc)[2][2][4][2], const pg8::Unit& u, int wr, int wc, int fr, int fq) const {
        const int row0 = u.pm * 256 + wr * 64 + fr, col0 = u.pn * 128 + wc * 32 + 8 * fq;
#pragma unroll
        for (int ai = 0; ai < 2; ++ai)
#pragma unroll
            for (int m = 0; m < 4; ++m) { bf16_t* rowp = H + (size_t)(row0 + ai * 128 + m * 16) * DFF + col0;
                const f32x4 g0 = acc[ai][0][m][0], g1 = acc[ai][0][m][1], u0 = acc[ai][1][m][0], u1 = acc[ai][1][m][1]; u32x4 w;
                w.x = cvt_pk_bf16(siluf_(g0[0]) * u0[0], siluf_(g0[1]) * u0[1]); w.y = cvt_pk_bf16(siluf_(g0[2]) * u0[2], siluf_(g0[3]) * u0[3]);
                w.z = cvt_pk_bf16(siluf_(g1[0]) * u1[0], siluf_(g1[1]) * u1[1]); w.w = cvt_pk_bf16(siluf_(g1[2]) * u1[2], siluf_(g1[3]) * u1[3]);
                *(u32x4*)rowp = w; }
    }
};
struct EpiMoeDown {
    static constexpr bool PERM = false, AFTER_DRAIN = false;
    float* out; const int* stok; const float* sw;
    __device__ __forceinline__ void operator()(const f32x4 (&acc)[2][2][4][2], const pg8::Unit& u, int wr, int wc, int fr, int fq) const {
        const int row0 = u.pm * 256 + wr * 64 + fr, col0 = u.pn * 256 + wc * 32 + 4 * fq;
#pragma unroll
        for (int ai = 0; ai < 2; ++ai)
#pragma unroll
            for (int m = 0; m < 4; ++m) { const int rl = row0 + ai * 128 + m * 16; const int tok = stok[rl]; const float w = sw[rl];
                if (tok >= 0) { float* rp = out + (size_t)tok * D + col0;
#pragma unroll
                    for (int bj = 0; bj < 2; ++bj)
#pragma unroll
                        for (int n = 0; n < 2; ++n) { f32x4 o = *(const f32x4*)(rp + bj * 128 + n * 16); o = o + acc[ai][bj][m][n] * w; *(f32x4*)(rp + bj * 128 + n * 16) = o; } } }
    }
};

__device__ void tc_job(const float* __restrict__ src, int K, int N, bf16_t* dst, int mode, int perm, LAS float* tile, int wg, int G, int tid) {
    LAUNDER(tid);
    const int tn = N / 64, nt = (K / 64) * tn;
    for (int t = wg; t < nt; t += G) {
        const int k0 = (t / tn) * 64, n0 = (t % tn) * 64;
#pragma unroll
        for (int ps = 0; ps < 2; ++ps) { const int r = (tid >> 4) + ps * 32; const float4 v = *(const float4*)(src + (size_t)(k0 + r) * N + n0 + (tid & 15) * 4);
            LAS float* tp = tile + r * 65 + (tid & 15) * 4; tp[0] = v.x; tp[1] = v.y; tp[2] = v.z; tp[3] = v.w; }
        __syncthreads();
        { const int n = tid >> 3, kg = (tid & 7) * 8; unsigned w[4];
#pragma unroll
          for (int j = 0; j < 4; ++j) w[j] = cvt_pk_bf16(tile[(kg + 2 * j) * 65 + n], tile[(kg + 2 * j + 1) * 65 + n]);
          const int nn = n0 + n; int drow = mode == 0 ? nn : ((nn >> 7) * 256 + (nn & 127) + (mode == 2 ? 128 : 0));
          if (perm) { const int c5 = drow & 31; drow = (drow & ~31) + 16 * ((c5 >> 2) & 1) + 4 * (c5 >> 3) + (c5 & 3); }
          *(uint4*)(dst + (size_t)drow * K + k0 + kg) = make_uint4(w[0], w[1], w[2], w[3]); }
        __syncthreads();
    }
}

template <bool ROUTER>
__device__ void phase_rmsnorm(const float* __restrict__ x, const float* __restrict__ gain, bf16_t* xn, const float* __restrict__ rw, const float* __restrict__ rb,
                              int* toke, float2* tokw, int wg, int G, int wid, int lane) {
    LAUNDER(lane);
    for (int row = wg * NWAVES + wid; row < MTOK; row += G * NWAVES) {
        const float* xr = x + (size_t)row * D; float4 v[4]; float ss = 0.f;
#pragma unroll
        for (int j = 0; j < 4; ++j) { v[j] = *(const float4*)(xr + j * 256 + lane * 4); ss += v[j].x * v[j].x + v[j].y * v[j].y + v[j].z * v[j].z + v[j].w * v[j].w; }
        ss = wave_sum(ss);
        const float rstd = rsqrtf(ss * (1.f / D) + EPS);
        float lg[NEXP];
#pragma unroll
        for (int e = 0; e < NEXP; ++e) lg[e] = 0.f;
#pragma unroll
        for (int j = 0; j < 4; ++j) { const float4 g = *(const float4*)(gain + j * 256 + lane * 4);
            const float y0 = v[j].x * rstd * g.x, y1 = v[j].y * rstd * g.y, y2 = v[j].z * rstd * g.z, y3 = v[j].w * rstd * g.w;
            *(uint2*)(xn + (size_t)row * D + j * 256 + lane * 4) = make_uint2(cvt_pk_bf16(y0, y1), cvt_pk_bf16(y2, y3));
            if (ROUTER) { const float ys[4] = {y0, y1, y2, y3};
#pragma unroll
                for (int i = 0; i < 4; ++i) { const float* wr_ = rw + (size_t)(j * 256 + lane * 4 + i) * NEXP; const float4 wa = *(const float4*)wr_, wb = *(const float4*)(wr_ + 4);
                    lg[0] += ys[i] * wa.x; lg[1] += ys[i] * wa.y; lg[2] += ys[i] * wa.z; lg[3] += ys[i] * wa.w; lg[4] += ys[i] * wb.x; lg[5] += ys[i] * wb.y; lg[6] += ys[i] * wb.z; lg[7] += ys[i] * wb.w; } } }
        if (ROUTER) {
#pragma unroll
            for (int e = 0; e < NEXP; ++e) lg[e] = wave_sum(lg[e]) + rb[e];
            int i0 = 0; float l0 = lg[0];
#pragma unroll
            for (int e = 1; e < NEXP; ++e) if (lg[e] > l0) { l0 = lg[e]; i0 = e; }
            int i1 = -1; float l1 = -3.4e38f;
#pragma unroll
            for (int e = 0; e < NEXP; ++e) if (e != i0 && lg[e] > l1) { l1 = lg[e]; i1 = e; }
            const float w0 = __builtin_amdgcn_rcpf(1.f + __expf(l1 - l0));
            if (lane == 0) { toke[row] = i0 | (i1 << 8); tokw[row] = make_float2(w0, 1.f - w0); }
        }
    }
}

__device__ void phase_combine(const bf16_t* GH, bf16_t* mix, int wg, int G, int tid) {
    LAUNDER(tid);
    for (size_t v = (size_t)wg * NTHREADS + tid; v < (size_t)MTOK * (D / 8); v += (size_t)G * NTHREADS) {
        const size_t r = v / (D / 8); const int c = (int)(v % (D / 8)) * 8; const bf16_t* gp = GH + r * GCOLS + c;
        const uint4 a = *(const uint4*)gp, b = *(const uint4*)(gp + 1024), cc = *(const uint4*)(gp + 2048); uint4 o;
        o.x = cvt_pk_bf16(bflo(a.x) + bflo(b.x) + bflo(cc.x), bfhi(a.x) + bfhi(b.x) + bfhi(cc.x));
        o.y = cvt_pk_bf16(bflo(a.y) + bflo(b.y) + bflo(cc.y), bfhi(a.y) + bfhi(b.y) + bfhi(cc.y));
        o.z = cvt_pk_bf16(bflo(a.z) + bflo(b.z) + bflo(cc.z), bfhi(a.z) + bfhi(b.z) + bfhi(cc.z));
        o.w = cvt_pk_bf16(bflo(a.w) + bflo(b.w) + bflo(cc.w), bfhi(a.w) + bfhi(b.w) + bfhi(cc.w));
        *(uint4*)(mix + r * D + c) = o;
    }
}

__device__ void phase_hgrn_naive(const bf16_t* P, float* oraw, int wg, int G, int wid, int lane) {
    LAUNDER(lane);
    for (int task = wg * NWAVES + wid; task < NB * 4 * 32; task += G * NWAVES) {
        const int b = task >> 7, h = (task >> 5) & 3, vg = task & 31;
        const bf16_t* base = P + (size_t)b * SEQ * PCOLS + h * 128;
        float* ob = oraw + (size_t)b * SEQ * 512 + h * 128 + vg * 4;
        float s00 = 0, s01 = 0, s02 = 0, s03 = 0, s10 = 0, s11 = 0, s12 = 0, s13 = 0;
        for (int t0 = 0; t0 < SEQ; t0 += 8) {
            unsigned q0[8], q1[8], f0[8], f1[8]; uint2 vv[8];
#pragma unroll
            for (int j = 0; j < 8; ++j) { const bf16_t* row = base + (size_t)(t0 + j) * PCOLS;
                q0[j] = row[C_HQ + lane]; q1[j] = row[C_HQ + 64 + lane]; f0[j] = row[C_HF + lane]; f1[j] = row[C_HF + 64 + lane]; vv[j] = *(const uint2*)(row + C_HI + vg * 4); }
#pragma unroll
            for (int j = 0; j < 8; ++j) {
                const float fa = __expf(bf2f(f0[j])), fb = __expf(bf2f(f1[j])), ka = 1.f - fa, kb = 1.f - fb, qa = bf2f(q0[j]), qb = bf2f(q1[j]);
                const float v0 = bflo(vv[j].x), v1 = bfhi(vv[j].x), v2 = bflo(vv[j].y), v3 = bfhi(vv[j].y);
                s00 = fa * s00 + ka * v0; s01 = fa * s01 + ka * v1; s02 = fa * s02 + ka * v2; s03 = fa * s03 + ka * v3;
                s10 = fb * s10 + kb * v0; s11 = fb * s11 + kb * v1; s12 = fb * s12 + kb * v2; s13 = fb * s13 + kb * v3;
                const float o0 = wave_sum(qa * s00 + qb * s10), o1 = wave_sum(qa * s01 + qb * s11), o2 = wave_sum(qa * s02 + qb * s12), o3 = wave_sum(qa * s03 + qb * s13);
                if (lane == 0) *(float4*)(ob + (size_t)(t0 + j) * 512) = make_float4(o0, o1, o2, o3);
            }
        }
    }
}
__device__ void phase_hgrn_fin(const float* oraw, const bf16_t* P, const float* __restrict__ gain, bf16_t* oa, int wg, int G, int wid, int lane) {
    LAUNDER(lane);
    for (int row = wg * NWAVES + wid; row < MTOK; row += G * NWAVES) {
        const float* orow = oraw + (size_t)row * 512 + lane * 8; const float4 a = *(const float4*)orow, b = *(const float4*)(orow + 4);
        float ss = a.x * a.x + a.y * a.y + a.z * a.z + a.w * a.w + b.x * b.x + b.y * b.y + b.z * b.z + b.w * b.w;
        ss += __shfl_xor(ss, 1); ss += __shfl_xor(ss, 2); ss += __shfl_xor(ss, 4); ss += __shfl_xor(ss, 8);
        const float rstd = rsqrtf(ss * (1.f / 128.f) + EPS);
        const int vi = (lane & 15) * 8; const float4 g0 = *(const float4*)(gain + vi), g1 = *(const float4*)(gain + vi + 4);
        const uint4 hg = *(const uint4*)(P + (size_t)row * PCOLS + C_HG + lane * 8); uint4 o;
        o.x = cvt_pk_bf16(a.x * rstd * g0.x * bflo(hg.x), a.y * rstd * g0.y * bfhi(hg.x)); o.y = cvt_pk_bf16(a.z * rstd * g0.z * bflo(hg.y), a.w * rstd * g0.w * bfhi(hg.y));
        o.z = cvt_pk_bf16(b.x * rstd * g1.x * bflo(hg.z), b.y * rstd * g1.y * bfhi(hg.z)); o.w = cvt_pk_bf16(b.z * rstd * g1.z * bflo(hg.w), b.w * rstd * g1.w * bfhi(hg.w));
        *(uint4*)(oa + (size_t)row * 512 + lane * 8) = o;
    }
}
__device__ void phase_gmlp_naive(const bf16_t* P, const float* __restrict__ ws_l  , const float* __restrict__ bs_l  , const float* __restrict__ gv_l  ,
                                 bf16_t* ob, LAS unsigned char* lds, int wg, int G, int tid, int wid, int lane) {
    LAUNDER(tid); LAUNDER(lane);
    LAS float* vn = (LAS float*)lds; LAS float* W = vn + 128 * 128; LAS float* rs = W + 128 * 128;
    for (int item = wg; item < (MTOK / 128) * 4; item += G) {
        const int chunk = item >> 2, g = item & 3; const size_t tok0 = (size_t)chunk * 128;
        for (int s = wid; s < 128; s += NWAVES) { const uint4 x = *(const uint4*)(P + (tok0 + s) * PCOLS + C_GV + lane * 8);
            float ss = bflo(x.x) * bflo(x.x) + bfhi(x.x) * bfhi(x.x) + bflo(x.y) * bflo(x.y) + bfhi(x.y) * bfhi(x.y) + bflo(x.z) * bflo(x.z) + bfhi(x.z) * bfhi(x.z) + bflo(x.w) * bflo(x.w) + bfhi(x.w) * bfhi(x.w);
            ss = wave_sum(ss); if (lane == 0) rs[s] = rsqrtf(ss * (1.f / 512.f) + EPS); }
        __syncthreads();
        for (int i = tid; i < 128 * 128; i += NTHREADS) { const int s = i >> 7, c = i & 127;
            vn[i] = bf2f(P[(tok0 + s) * PCOLS + C_GV + g * 128 + c]) * rs[s] * gv_l[g * 128 + c]; W[i] = ws_l[(size_t)g * 16384 + i]; }
        __syncthreads();
        { const int c = tid & 127;
          for (int t = tid >> 7; t < 128; t += 4) { float acc = 0.f; for (int s = 0; s <= t; ++s) acc += W[t * 128 + s] * vn[s * 128 + c];
              const float mixv = acc + bs_l[g * 128 + t]; const float uu = bf2f(P[(tok0 + t) * PCOLS + C_GU + g * 128 + c]);
              ob[(tok0 + t) * 512 + g * 128 + c] = f2bf(uu * mixv); } }
        __syncthreads();
    }
}
__device__ void phase_attn_naive(const bf16_t* P, const float* __restrict__ gq, const float* __restrict__ gk, bf16_t* oc, LAS unsigned char* lds, int wg, int G, int wid, int lane) {
    LAUNDER(lane);
    LAS float* red = (LAS float*)lds + wid * (64 * 65); LAS float* qs = (LAS float*)lds + NWAVES * 64 * 65 + wid * 64;
    for (int item = wg; item < MTOK * 8 / NWAVES; item += G) {
        const int q_id = item * NWAVES + wid;
        const int t = q_id & (SEQ - 1), h = (q_id >> 13) & 7, b = q_id >> 16;
        const size_t tokb = (size_t)b * SEQ;
        { const float qv = bf2f(P[(tokb + t) * PCOLS + C_SQ + h * 64 + lane]); const float ss = wave_sum(qv * qv);
          qs[lane] = qv * rsqrtf(ss * (1.f / 64.f) + EPS) * gq[lane] * gk[lane] * 0.125f; }
        float op[64];
#pragma unroll
        for (int d = 0; d < 64; ++d) op[d] = 0.f;
        float carry = 0.f;
        for (int s0 = t - 1; s0 >= 0; s0 -= 64) {
            const int s = s0 - lane; const bool valid = s >= 0; const int sc = valid ? s : 0;
            const bf16_t* kr = P + (tokb + sc) * PCOLS + C_SK + h * 64; float dot = 0.f, ssk = 0.f;
#pragma unroll
            for (int j = 0; j < 8; ++j) { const uint4 kk = *(const uint4*)(kr + j * 8); const float k0 = bflo(kk.x), k1 = bfhi(kk.x), k2 = bflo(kk.y), k3 = bfhi(kk.y), k4 = bflo(kk.z), k5 = bfhi(kk.z), k6 = bflo(kk.w), k7 = bfhi(kk.w);
                dot += qs[j * 8 + 0] * k0 + qs[j * 8 + 1] * k1 + qs[j * 8 + 2] * k2 + qs[j * 8 + 3] * k3 + qs[j * 8 + 4] * k4 + qs[j * 8 + 5] * k5 + qs[j * 8 + 6] * k6 + qs[j * 8 + 7] * k7;
                ssk += k0 * k0 + k1 * k1 + k2 * k2 + k3 * k3 + k4 * k4 + k5 * k5 + k6 * k6 + k7 * k7; }
            const float z = dot * rsqrtf(ssk * (1.f / 64.f) + EPS);
            const float sp = valid ? softplusf_(z) : 0.f;
            float pre = sp;
#pragma unroll
            for (int o = 1; o < 64; o <<= 1) { const float tt = __shfl_up(pre, o); if (lane >= o) pre += tt; }
            const float a = valid ? __expf(z - carry - pre) : 0.f;
            const bf16_t* vr = P + (tokb + sc) * PCOLS + C_SV + h * 64;
#pragma unroll
            for (int j = 0; j < 8; ++j) { const uint4 vv = *(const uint4*)(vr + j * 8);
                op[j * 8 + 0] += a * bflo(vv.x); op[j * 8 + 1] += a * bfhi(vv.x); op[j * 8 + 2] += a * bflo(vv.y); op[j * 8 + 3] += a * bfhi(vv.y);
                op[j * 8 + 4] += a * bflo(vv.z); op[j * 8 + 5] += a * bfhi(vv.z); op[j * 8 + 6] += a * bflo(vv.w); op[j * 8 + 7] += a * bfhi(vv.w); }
            carry += __shfl(pre, 63);
            if (carry > 104.f) break;
        }
#pragma unroll
        for (int d = 0; d < 64; ++d) red[lane * 65 + d] = op[d];
        float o = 0.f;
#pragma unroll 8
        for (int l = 0; l < 64; ++l) o += red[l * 65 + lane];
        oc[(tokb + t) * 512 + h * 64 + lane] = f2bf(o);
    }
}

__device__ void moe_assign(const int* toke, const float2* tokw, int* meta, int* stok, float* sw, LAS unsigned char* lds, int tid) {
    LAUNDER(tid);
    LAS int* cnt = (LAS int*)lds;
    LAS int* tot = cnt + 512 * 8;
    int c[NEXP];
#pragma unroll
    for (int e = 0; e < NEXP; ++e) c[e] = 0;
    const int t0 = tid * (MTOK / NTHREADS);
    for (int i = 0; i < MTOK / NTHREADS; ++i) { const int ee = toke[t0 + i]; const int e0 = ee & 255, e1 = (ee >> 8) & 255;
#pragma unroll
        for (int e = 0; e < NEXP; ++e) c[e] += (e0 == e) + (e1 == e); }
#pragma unroll
    for (int e = 0; e < NEXP; ++e) cnt[tid * 8 + e] = c[e];
    __syncthreads();
    if (tid < NEXP) { int run = 0; for (int i = 0; i < NTHREADS; ++i) { const int v = cnt[i * 8 + tid]; cnt[i * 8 + tid] = run; run += v; } tot[tid] = run; }
    __syncthreads();
    if (tid == 0) { int run = 0; for (int e = 0; e < NEXP; ++e) { const int n = tot[e], pad = (n + 255) & ~255; tot[8 + e] = run; meta[e] = n; meta[8 + e] = pad; meta[16 + e] = run; run += pad; } }
    __syncthreads();
    int pos[NEXP];
#pragma unroll
    for (int e = 0; e < NEXP; ++e) pos[e] = tot[8 + e] + cnt[tid * 8 + e];
    for (int i = 0; i < MTOK / NTHREADS; ++i) { const int tk = t0 + i; const int ee = toke[tk]; const int e0 = ee & 255, e1 = (ee >> 8) & 255; const float2 w = tokw[tk];
        int p0 = 0, p1 = 0;
#pragma unroll
        for (int e = 0; e < NEXP; ++e) { if (e0 == e) { p0 = pos[e]; pos[e]++; } }
#pragma unroll
        for (int e = 0; e < NEXP; ++e) { if (e1 == e) { p1 = pos[e]; pos[e]++; } }
        stok[p0] = tk; sw[p0] = w.x; stok[p1] = tk; sw[p1] = w.y; }
    for (int e = 0; e < NEXP; ++e) { const int n = tot[e], pad = (n + 255) & ~255, base = tot[8 + e]; for (int i = n + tid; i < pad; i += NTHREADS) { stok[base + i] = -1; sw[base + i] = 0.f; } }
}
__device__ void moe_gather(const bf16_t* xn, const int* stok, int rows, bf16_t* xs, int wg, int G, int wid, int lane) {
    LAUNDER(lane);
    for (int r = wg * NWAVES + wid; r < rows; r += G * NWAVES) { const int tok = __hip_atomic_load(stok + r, __ATOMIC_RELAXED, __HIP_MEMORY_SCOPE_AGENT);
        uint4 a = make_uint4(0, 0, 0, 0), b = a;
        if (tok >= 0) { const uint4* sp = (const uint4*)(xn + (size_t)tok * D) + lane * 2; a = sp[0]; b = sp[1]; }
        uint4* dp = (uint4*)(xs + (size_t)r * D) + lane * 2; dp[0] = a; dp[1] = b; }
}

typedef pg8::bf16x8 bf16x8;
typedef unsigned u32x2 __attribute__((ext_vector_type(2)));
#define MFMA16(A, B, C) __builtin_amdgcn_mfma_f32_16x16x32_bf16((A), (B), (C), 0, 0, 0)
__device__ __forceinline__ bf16x8 mk8(unsigned a, unsigned b, unsigned c, unsigned d) { u32x4 v = {a, b, c, d}; return __builtin_bit_cast(bf16x8, v); }

constexpr int H_QD = 0, H_KD = 8704, H_KB = 17408, H_QG = 21760, H_KET = 30464, H_VT = 40704, H_PM = 50944, H_TP = 53504, H_GE = 55552;
constexpr size_t HG_DUMP_BYTES = (size_t)MTOK * 512 * 2, HG_U_BYTES = (size_t)256 * 128 * 128 * 4;
__device__ void phase_hgrn_a(const bf16_t* P, bf16_t* qsc  , uint2* dump, float* U, float* Dsc, LAS unsigned char* lds, int wg, int G, int tid, int wid, int lane) {
    LAUNDER(tid); LAUNDER(lane);
    const int d = tid & 127, part = tid >> 7, g = lane >> 4, c16 = lane & 15;
    LAS float* TP = (LAS float*)(lds + H_TP); LAS float* GE = (LAS float*)(lds + H_GE);
    for (int item = wg; item < 256; item += G) {
        const int b = item >> 6, h = (item >> 4) & 3, sc = item & 15; const size_t tok0 = (size_t)b * SEQ + (size_t)sc * 512;
        f32x4 S[8];
#pragma unroll
        for (int i = 0; i < 8; ++i) S[i] = (f32x4){0.f, 0.f, 0.f, 0.f};
        float gsc = 0.f;
        unsigned lfv[8], qv[8], vv[8];
        { const bf16_t* base = P + (tok0 + 8 * part) * PCOLS + h * 128 + d;
#pragma unroll
          for (int j = 0; j < 8; ++j) { lfv[j] = base[(size_t)j * PCOLS + C_HF]; qv[j] = base[(size_t)j * PCOLS + C_HQ]; vv[j] = base[(size_t)j * PCOLS + C_HI]; } }
        for (int c = 0; c < 16; ++c) {
            float gl[8], lf[8], qf[8]; unsigned vb[8]; float run = 0.f;
#pragma unroll
            for (int j = 0; j < 8; ++j) { lf[j] = bf2f(lfv[j]); qf[j] = bf2f(qv[j]); vb[j] = vv[j]; run += lf[j]; gl[j] = run; }
            if (c < 15) { const bf16_t* base = P + (tok0 + (c + 1) * 32 + 8 * part) * PCOLS + h * 128 + d;
#pragma unroll
                for (int j = 0; j < 8; ++j) { lfv[j] = base[(size_t)j * PCOLS + C_HF]; qv[j] = base[(size_t)j * PCOLS + C_HQ]; vv[j] = base[(size_t)j * PCOLS + C_HI]; } }
            TP[part * 128 + d] = run;
            __syncthreads();
            const float t0 = TP[d], t1 = TP[128 + d], t2 = TP[256 + d], t3 = TP[384 + d];
            const float T0 = t0 + t1, gend = T0 + t2 + t3;
            const float pre = (part == 1) ? t0 : (part == 3) ? t2 : 0.f, gb = (part >> 1) ? T0 : 0.f;
            unsigned kep[4];
#pragma unroll
            for (int j = 0; j < 8; j += 2) {
                float ke2[2];
#pragma unroll
                for (int jj = 0; jj < 2; ++jj) { const int t = 8 * part + j + jj; const float Gl = pre + gl[j + jj], Gt = gb + Gl; const float k = 1.f - __expf(lf[j + jj]), q = qf[j + jj];
                    *(LAS bf16_t*)(lds + H_QD + t * 272 + d * 2) = f2bf(q * __expf(Gl));
                    *(LAS bf16_t*)(lds + H_KD + t * 272 + d * 2) = f2bf(k * __expf(fminf(-Gl, 80.f)));
                    if (part < 2) *(LAS bf16_t*)(lds + H_KB + t * 272 + d * 2) = f2bf(k * __expf(T0 - Gl));
                    *(LAS bf16_t*)(lds + H_QG + t * 272 + d * 2) = f2bf(q * __expf(Gt));
                    qsc[(tok0 + c * 32 + t) * 512 + h * 128 + d] = f2bf(q * __expf(gsc + Gt));
                    ke2[jj] = k * __expf(gend - Gt); }
                kep[j >> 1] = cvt_pk_bf16(ke2[0], ke2[1]); }
            *(LAS u32x4*)(lds + H_KET + d * 80 + part * 16) = (u32x4){kep[0], kep[1], kep[2], kep[3]};
            *(LAS u32x4*)(lds + H_VT + d * 80 + part * 16) = (u32x4){vb[0] | (vb[1] << 16), vb[2] | (vb[3] << 16), vb[4] | (vb[5] << 16), vb[6] | (vb[7] << 16)};
            if (part == 0) GE[d] = __expf(gend);
            gsc += gend;
            __syncthreads();
            if (wid < 3) { const int I = (wid == 0) ? 0 : 1, J = (wid == 2) ? 0 : I; f32x4 acc = {0.f, 0.f, 0.f, 0.f};
#pragma unroll
                for (int kk = 0; kk < 4; ++kk) { const bf16x8 A = *(const LAS bf16x8*)(lds + H_QD + (16 * I + c16) * 272 + kk * 64 + g * 16);
                    const bf16x8 B = (wid == 2) ? *(const LAS bf16x8*)(lds + H_KB + c16 * 272 + kk * 64 + g * 16) : *(const LAS bf16x8*)(lds + H_KD + (16 * J + c16) * 272 + kk * 64 + g * 16);
                    acc = MFMA16(A, B, acc); }
#pragma unroll
                for (int r = 0; r < 4; ++r) { const int t = 4 * g + r; const float v = (I == J && c16 > t) ? 0.f : acc[r]; *(LAS bf16_t*)(lds + H_PM + (16 * I + t) * 80 + (16 * J + c16) * 2) = f2bf(v); }
            } else if (wid == 3) {
#pragma unroll
                for (int r = 0; r < 4; ++r) *(LAS bf16_t*)(lds + H_PM + (4 * g + r) * 80 + (16 + c16) * 2) = (bf16_t)0;
            }
            __syncthreads();
            { const bf16x8 Bv = *(const LAS bf16x8*)(lds + H_VT + (16 * wid + c16) * 80 + g * 16);
              unsigned sp[8][2];
#pragma unroll
              for (int i = 0; i < 8; ++i) { sp[i][0] = cvt_pk_bf16(S[i][0], S[i][1]); sp[i][1] = cvt_pk_bf16(S[i][2], S[i][3]); }
              const size_t chunk_g = (tok0 >> 5) + c;
#pragma unroll
              for (int rt = 0; rt < 2; ++rt) { f32x4 o = {0.f, 0.f, 0.f, 0.f};
                  o = MFMA16(*(const LAS bf16x8*)(lds + H_PM + (16 * rt + c16) * 80 + g * 16), Bv, o);
#pragma unroll
                  for (int kk = 0; kk < 4; ++kk) { const LAS unsigned char* qp = lds + H_QG + (16 * rt + c16) * 272 + (32 * kk + 4 * g) * 2;
                      const u32x2 lo = *(const LAS u32x2*)qp, hi = *(const LAS u32x2*)(qp + 32);
                      o = MFMA16(mk8(lo.x, lo.y, hi.x, hi.y), mk8(sp[2 * kk][0], sp[2 * kk][1], sp[2 * kk + 1][0], sp[2 * kk + 1][1]), o); }
                  dump[(((chunk_g * 4 + h) * 2 + rt) * 8 + wid) * 64 + lane] = make_uint2(cvt_pk_bf16(o[0], o[1]), cvt_pk_bf16(o[2], o[3])); }
#pragma unroll
              for (int i = 0; i < 8; ++i) { const f32x4 dec = *(const LAS f32x4*)(lds + H_GE + (16 * i + 4 * g) * 4); S[i] = S[i] * dec;
                  S[i] = MFMA16(*(const LAS bf16x8*)(lds + H_KET + (16 * i + c16) * 80 + g * 16), Bv, S[i]); } }
            __syncthreads();
        }
#pragma unroll
        for (int i = 0; i < 8; ++i)
#pragma unroll
            for (int r = 0; r < 4; ++r) U[((size_t)item * 128 + 16 * i + 4 * g + r) * 128 + 16 * wid + c16] = S[i][r];
        if (part == 0) Dsc[item * 128 + d] = __expf(gsc);
    }
}
constexpr int HC_SIN = 0;
__device__ void phase_hgrn_c(const bf16_t* P, bf16_t* qoa  , const uint2* dump, const float* U, const float* Dsc, const float* gain, LAS unsigned char* lds, int wg, int G, int tid, int wid, int lane) {
    LAUNDER(tid); LAUNDER(lane);
    const int g = lane >> 4, c16 = lane & 15;
    for (int item = wg; item < 256; item += G) {
        const int b = item >> 6, h = (item >> 4) & 3, sc = item & 15; const size_t tok0 = (size_t)b * SEQ + (size_t)sc * 512;
#pragma unroll 1
        for (int kq = 0; kq < 4; ++kq) { float s[8];
#pragma unroll
          for (int k = 0; k < 8; ++k) s[k] = 0.f;
#pragma unroll 1
          for (int j = 0; j < sc; ++j) { const size_t it = (size_t)(item - sc + j);
#pragma unroll
              for (int k = 0; k < 8; ++k) { const int e = tid + 512 * (kq * 8 + k); s[k] = Dsc[it * 128 + (e >> 7)] * s[k] + U[it * 16384 + e]; } }
#pragma unroll
          for (int k = 0; k < 8; ++k) { const int e = tid + 512 * (kq * 8 + k); *(LAS bf16_t*)(lds + HC_SIN + (e & 127) * 272 + (e >> 7) * 2) = f2bf(s[k]); } }
        __syncthreads();
#pragma unroll 1
        for (int rtile = 0; rtile < 4; ++rtile) {
            const size_t row0 = tok0 + 64 * wid + 16 * rtile; const size_t chunk_g = (tok0 >> 5) + 2 * wid + (rtile >> 1); const int rt = rtile & 1;
            bf16x8 A[4];
#pragma unroll
            for (int kk = 0; kk < 4; ++kk) A[kk] = *(const bf16x8*)(qoa + (row0 + c16) * 512 + h * 128 + 32 * kk + 8 * g);
            f32x4 acc[8]; float ss[4] = {0.f, 0.f, 0.f, 0.f};
#pragma unroll
            for (int vt = 0; vt < 8; ++vt) { acc[vt] = (f32x4){0.f, 0.f, 0.f, 0.f};
#pragma unroll
                for (int kk = 0; kk < 4; ++kk) acc[vt] = MFMA16(A[kk], *(const LAS bf16x8*)(lds + HC_SIN + (16 * vt + c16) * 272 + (32 * kk + 8 * g) * 2), acc[vt]);
                const uint2 ol = dump[(((chunk_g * 4 + h) * 2 + rt) * 8 + vt) * 64 + lane];
                acc[vt][0] += bflo(ol.x); acc[vt][1] += bfhi(ol.x); acc[vt][2] += bflo(ol.y); acc[vt][3] += bfhi(ol.y);
#pragma unroll
                for (int r = 0; r < 4; ++r) ss[r] += acc[vt][r] * acc[vt][r]; }
            float rstd[4];
#pragma unroll
            for (int r = 0; r < 4; ++r) { float s = ss[r]; s += __shfl_xor(s, 1); s += __shfl_xor(s, 2); s += __shfl_xor(s, 4); s += __shfl_xor(s, 8); rstd[r] = rsqrtf(s * (1.f / 128.f) + EPS); }
#pragma unroll
            for (int vt = 0; vt < 8; ++vt) { const float gn = gain[16 * vt + c16];
#pragma unroll
                for (int r = 0; r < 4; ++r) { const size_t row = row0 + 4 * g + r; const float hg = bf2f(P[row * PCOLS + C_HG + h * 128 + 16 * vt + c16]);
                    qoa[row * 512 + h * 128 + 16 * vt + c16] = f2bf(acc[vt][r] * rstd[r] * gn * hg); } }
        }
        __syncthreads();
    }
}

constexpr int GM_VT = 0, GM_W = 34816, GM_RS = 69632;
__device__ void phase_gmlp(const bf16_t* P, const float* __restrict__ ws_l, const float* __restrict__ bs_l, const float* __restrict__ gv_l, bf16_t* ob, LAS unsigned char* lds, int wg, int G, int tid, int wid, int lane) {
    LAUNDER(tid); LAUNDER(lane);
    const int g = lane >> 4, c16 = lane & 15; LAS float* RS = (LAS float*)(lds + GM_RS);
    for (int item = wg; item < MTOK / 128; item += G) {
        const size_t tok0 = (size_t)item * 128;
        { const int s = tid >> 2, qd = tid & 3; const bf16_t* rp = P + (tok0 + s) * PCOLS + C_GV + qd * 128; float ss = 0.f;
#pragma unroll
          for (int j = 0; j < 16; ++j) { const uint4 x = *(const uint4*)(rp + j * 8); ss += bflo(x.x) * bflo(x.x) + bfhi(x.x) * bfhi(x.x) + bflo(x.y) * bflo(x.y) + bfhi(x.y) * bfhi(x.y) + bflo(x.z) * bflo(x.z) + bfhi(x.z) * bfhi(x.z) + bflo(x.w) * bflo(x.w) + bfhi(x.w) * bfhi(x.w); }
          ss += __shfl_xor(ss, 1); ss += __shfl_xor(ss, 2); if (qd == 0) RS[s] = rsqrtf(ss * (1.f / 512.f) + EPS); }
        for (int grp = 0; grp < 4; ++grp) {
            __syncthreads();
#pragma unroll
            for (int ps = 0; ps < 4; ++ps) { const int idx = tid + ps * 512, s = idx >> 4, c8 = (idx & 15) * 8; const uint4 x = *(const uint4*)(P + (tok0 + s) * PCOLS + C_GV + grp * 128 + c8);
                const float rs = RS[s]; const float4 ga = *(const float4*)(gv_l + grp * 128 + c8), gb = *(const float4*)(gv_l + grp * 128 + c8 + 4);
                const float e[8] = {bflo(x.x) * rs * ga.x, bfhi(x.x) * rs * ga.y, bflo(x.y) * rs * ga.z, bfhi(x.y) * rs * ga.w, bflo(x.z) * rs * gb.x, bfhi(x.z) * rs * gb.y, bflo(x.w) * rs * gb.z, bfhi(x.w) * rs * gb.w};
#pragma unroll
                for (int i = 0; i < 8; ++i) *(LAS bf16_t*)(lds + GM_VT + (c8 + i) * 272 + s * 2) = f2bf(e[i]);
                const int t = idx >> 4, s8 = (idx & 15) * 8; const float4 wa = *(const float4*)(ws_l + (size_t)grp * 16384 + t * 128 + s8), wb = *(const float4*)(ws_l + (size_t)grp * 16384 + t * 128 + s8 + 4);
                *(LAS u32x4*)(lds + GM_W + t * 272 + s8 * 2) = (u32x4){cvt_pk_bf16(s8 + 0 <= t ? wa.x : 0.f, s8 + 1 <= t ? wa.y : 0.f), cvt_pk_bf16(s8 + 2 <= t ? wa.z : 0.f, s8 + 3 <= t ? wa.w : 0.f),
                                                                    cvt_pk_bf16(s8 + 4 <= t ? wb.x : 0.f, s8 + 5 <= t ? wb.y : 0.f), cvt_pk_bf16(s8 + 6 <= t ? wb.z : 0.f, s8 + 7 <= t ? wb.w : 0.f)}; }
            __syncthreads();
            f32x4 acc[8];
#pragma unroll
            for (int ct = 0; ct < 8; ++ct) acc[ct] = (f32x4){0.f, 0.f, 0.f, 0.f};
            for (int kk = 0; kk <= (wid >> 1); ++kk) { const bf16x8 A = *(const LAS bf16x8*)(lds + GM_W + (16 * wid + c16) * 272 + kk * 64 + g * 16);
#pragma unroll
                for (int ct = 0; ct < 8; ++ct) acc[ct] = MFMA16(A, *(const LAS bf16x8*)(lds + GM_VT + (16 * ct + c16) * 272 + kk * 64 + g * 16), acc[ct]); }
#pragma unroll
            for (int r = 0; r < 4; ++r) { const int t = 16 * wid + 4 * g + r; const float bias = bs_l[grp * 128 + t]; const size_t tok = tok0 + t;
#pragma unroll
                for (int ct = 0; ct < 8; ++ct) { const int ch = grp * 128 + 16 * ct + c16; ob[tok * 512 + ch] = f2bf(bf2f(P[tok * PCOLS + C_GU + ch]) * (acc[ct][r] + bias)); } }
        }
        __syncthreads();
    }
}

constexpr int AT_KL = 0, AT_VT = 9216, AT_MIN = 9216 + 64 * 136;
__device__ void phase_attn(const bf16_t* P, const float* __restrict__ gq, const float* __restrict__ gk, bf16_t* oc, LAS unsigned char* lds, int wg, int G, int tid, int wid, int lane) {
    LAUNDER(tid); LAUNDER(lane);
    const int g = lane >> 4, c16 = lane & 15; LAS float* MINW = (LAS float*)(lds + AT_MIN);
    const unsigned ONES = 0x3F803F80u;
    const unsigned tri_lo = ((4 * g + 0 >= c16) ? 0x3F80u : 0u) | ((4 * g + 1 >= c16) ? 0x3F800000u : 0u), tri_hi = ((4 * g + 2 >= c16) ? 0x3F80u : 0u) | ((4 * g + 3 >= c16) ? 0x3F800000u : 0u);
    for (int item = wg; item < NB * 8 * (SEQ / 128); item += G) {
        const int qt = item & 63, h = (item >> 6) & 7, b = item >> 9; const int t0 = qt * 128, tq0 = t0 + 16 * wid, t = tq0 + c16; const size_t tokb = (size_t)b * SEQ;
        bf16x8 Bq[2];
        { const bf16_t* qp = P + (tokb + t) * PCOLS + C_SQ + h * 64; const uint4 x0 = *(const uint4*)(qp + 8 * g), x1 = *(const uint4*)(qp + 32 + 8 * g);
          float e[16] = {bflo(x0.x), bfhi(x0.x), bflo(x0.y), bfhi(x0.y), bflo(x0.z), bfhi(x0.z), bflo(x0.w), bfhi(x0.w), bflo(x1.x), bfhi(x1.x), bflo(x1.y), bfhi(x1.y), bflo(x1.z), bfhi(x1.z), bflo(x1.w), bfhi(x1.w)};
          float ss = 0.f;
#pragma unroll
          for (int i = 0; i < 16; ++i) ss += e[i] * e[i];
          ss += __shfl_xor(ss, 16); ss += __shfl_xor(ss, 32);
          const float rq = rsqrtf(ss * (1.f / 64.f) + EPS) * 0.125f;
#pragma unroll
          for (int i = 0; i < 16; ++i) { const int dd = (i < 8 ? 8 * g + i : 32 + 8 * g + (i - 8)); e[i] = e[i] * rq * gq[dd] * gk[dd]; }
          Bq[0] = mk8(cvt_pk_bf16(e[0], e[1]), cvt_pk_bf16(e[2], e[3]), cvt_pk_bf16(e[4], e[5]), cvt_pk_bf16(e[6], e[7]));
          Bq[1] = mk8(cvt_pk_bf16(e[8], e[9]), cvt_pk_bf16(e[10], e[11]), cvt_pk_bf16(e[12], e[13]), cvt_pk_bf16(e[14], e[15])); }
        f32x4 O[4];
#pragma unroll
        for (int i = 0; i < 4; ++i) O[i] = (f32x4){0.f, 0.f, 0.f, 0.f};
        float carry = 0.f;
        for (int kb = (t0 + 127) >> 6; kb >= 0; --kb) {
            const int sb0 = kb * 64;
            __syncthreads();
            { const int s = tid >> 3, pc = tid & 7; const bf16_t* rp = P + (tokb + sb0 + s) * PCOLS + h * 64 + pc * 8;
              const uint4 kx = *(const uint4*)(rp + C_SK), vx = *(const uint4*)(rp + C_SV);
              float ke[8] = {bflo(kx.x), bfhi(kx.x), bflo(kx.y), bfhi(kx.y), bflo(kx.z), bfhi(kx.z), bflo(kx.w), bfhi(kx.w)}; float ssk = 0.f;
#pragma unroll
              for (int i = 0; i < 8; ++i) ssk += ke[i] * ke[i];
              ssk += __shfl_xor(ssk, 1); ssk += __shfl_xor(ssk, 2); ssk += __shfl_xor(ssk, 4);
              const float rk = rsqrtf(ssk * (1.f / 64.f) + EPS);
              *(LAS u32x4*)(lds + AT_KL + s * 144 + pc * 16) = (u32x4){cvt_pk_bf16(ke[0] * rk, ke[1] * rk), cvt_pk_bf16(ke[2] * rk, ke[3] * rk), cvt_pk_bf16(ke[4] * rk, ke[5] * rk), cvt_pk_bf16(ke[6] * rk, ke[7] * rk)};
              const unsigned vw[4] = {vx.x, vx.y, vx.z, vx.w};
#pragma unroll
              for (int i = 0; i < 8; ++i) *(LAS bf16_t*)(lds + AT_VT + (pc * 8 + i) * 136 + s * 2) = (bf16_t)((vw[i >> 1] >> ((i & 1) * 16)) & 0xffffu); }
            __syncthreads();
            if (sb0 < tq0 + 15) {
                f32x4 z[4]; unsigned hi[4][2], lo[4][2];
#pragma unroll
                for (int st = 0; st < 4; ++st) { z[st] = (f32x4){0.f, 0.f, 0.f, 0.f};
#pragma unroll
                    for (int kk = 0; kk < 2; ++kk) z[st] = MFMA16(*(const LAS bf16x8*)(lds + AT_KL + (16 * st + c16) * 144 + kk * 64 + g * 16), Bq[kk], z[st]);
                    float spv[4];
#pragma unroll
                    for (int r = 0; r < 4; ++r) { const int s = sb0 + 16 * st + 4 * g + r; spv[r] = (s < t) ? softplusf_(z[st][r]) : 0.f; }
                    hi[st][0] = cvt_pk_bf16(spv[0], spv[1]); hi[st][1] = cvt_pk_bf16(spv[2], spv[3]);
                    lo[st][0] = cvt_pk_bf16(spv[0] - bflo(hi[st][0]), spv[1] - bfhi(hi[st][0])); lo[st][1] = cvt_pk_bf16(spv[2] - bflo(hi[st][1]), spv[3] - bfhi(hi[st][1])); }
                f32x4 sf[4];
#pragma unroll
                for (int so = 0; so < 4; ++so) { sf[so] = (f32x4){0.f, 0.f, 0.f, 0.f};
#pragma unroll
                    for (int kk = 0; kk < 2; ++kk) { if (2 * kk + 1 < so) continue;
                        const unsigned a0 = (2 * kk > so) ? ONES : (2 * kk == so) ? tri_lo : 0u, a1 = (2 * kk > so) ? ONES : (2 * kk == so) ? tri_hi : 0u;
                        const unsigned a2 = (2 * kk + 1 > so) ? ONES : tri_lo, a3 = (2 * kk + 1 > so) ? ONES : tri_hi;
                        const bf16x8 Lm = mk8(a0, a1, a2, a3);
                        sf[so] = MFMA16(Lm, mk8(hi[2 * kk][0], hi[2 * kk][1], hi[2 * kk + 1][0], hi[2 * kk + 1][1]), sf[so]);
                        sf[so] = MFMA16(Lm, mk8(lo[2 * kk][0], lo[2 * kk][1], lo[2 * kk + 1][0], lo[2 * kk + 1][1]), sf[so]); } }
                unsigned pa[4][2];
#pragma unroll
                for (int st = 0; st < 4; ++st) { float av[4];
#pragma unroll
                    for (int r = 0; r < 4; ++r) { const int s = sb0 + 16 * st + 4 * g + r; av[r] = (s < t) ? __expf(z[st][r] - carry - sf[st][r]) : 0.f; }
                    pa[st][0] = cvt_pk_bf16(av[0], av[1]); pa[st][1] = cvt_pk_bf16(av[2], av[3]); }
#pragma unroll
                for (int kk = 0; kk < 2; ++kk) { const bf16x8 Aop = mk8(pa[2 * kk][0], pa[2 * kk][1], pa[2 * kk + 1][0], pa[2 * kk + 1][1]);
#pragma unroll
                    for (int dt = 0; dt < 4; ++dt) { const LAS unsigned char* vp = lds + AT_VT + (16 * dt + c16) * 136 + (32 * kk + 4 * g) * 2; const u32x2 v0 = *(const LAS u32x2*)vp, v1 = *(const LAS u32x2*)(vp + 32);
                        O[dt] = MFMA16(Aop, mk8(v0.x, v0.y, v1.x, v1.y), O[dt]); } }
                carry += __shfl(sf[0][0], c16);
            }
            float mn = carry; mn = fminf(mn, __shfl_xor(mn, 1)); mn = fminf(mn, __shfl_xor(mn, 2)); mn = fminf(mn, __shfl_xor(mn, 4)); mn = fminf(mn, __shfl_xor(mn, 8));
            if (lane == 0) MINW[wid] = mn;
            __syncthreads();
            float mall = MINW[0];
#pragma unroll
            for (int w = 1; w < 8; ++w) mall = fminf(mall, MINW[w]);
            if (mall > 104.f) break;
        }
#pragma unroll
        for (int dt = 0; dt < 4; ++dt)
#pragma unroll
            for (int r = 0; r < 4; ++r) oc[(tokb + tq0 + 4 * g + r) * 512 + h * 64 + 16 * dt + c16] = f2bf(O[dt][r]);
    }
}

#ifdef MK_CHECK
constexpr size_t WS_DIAG = WS_META + 2048;
constexpr size_t WS_SNAP = WS_SLOTW + (size_t)NSLOT * 4;
static_assert(WS_SNAP + 64 * 1024 * 4 <= WS_W, "snapshot fits");
__device__ __forceinline__ int samp_row(int i) { return (int)(((unsigned)i * 2654435761u + 12345u) % (unsigned)MTOK); }
__device__ __forceinline__ void chk_fail(unsigned* diag, unsigned code) { atomicMin(diag, code); }
__device__ __forceinline__ bool chk_close(float got, float ref, float atol, float rtol) { return fabsf(got - ref) <= atol + rtol * fabsf(ref) && got == got; }

__global__ void k_diag_init(unsigned* diag) { if (threadIdx.x == 0 && blockIdx.x == 0) { diag[0] = 0xffffffffu; diag[16] = 0u; diag[17] = 0xffffffffu; diag[18] = 0u; diag[19] = 0u; diag[20] = 0u; diag[21] = 0u; diag[22] = 0u; diag[23] = 0u; diag[24] = 0u; diag[25] = 0u; diag[26] = 0u; } }
__global__ void k_snapshot(const float* x, float* snap) { const int i = blockIdx.x; const int r = samp_row(i); for (int c = threadIdx.x; c < D; c += blockDim.x) snap[i * D + c] = x[(size_t)r * D + c]; }
__global__ void k_apply_diag(float* out, const unsigned* diag) {
    if (blockIdx.x != 0 || threadIdx.x != 0) return;
    const unsigned code = diag[0]; if (code == 0xffffffffu) return;
    unsigned pc = 0, lo = 999; for (int w = 0; w < 4; ++w) { const unsigned m = diag[20 + w]; pc += __popc(m); if (m && lo == 999) lo = w * 32 + (__ffs(m) - 1); }
    if (DIAGSEL == 3) { lo = __popc(diag[24]) + __popc(diag[25]); pc = __popc(diag[26]); }
    unsigned f1 = (DIAGSEL == 0 || DIAGSEL == 3) ? lo : DIAGSEL == 1 ? diag[17] * 8 + diag[18] : diag[19]; if (f1 > 89) f1 = 89;
    unsigned f2 = pc > 20 ? 20 : pc;
    out[0] = (1.0f + 0.1f * (float)f1) * exp10f(3.f + (float)f2) * (code == 5u ? 1.f : -1.f);
}
struct ChkGemm { const bf16_t* A; int lda; const float* W; int ldw; int K; int mode; const bf16_t* Cb; int ldc; const float* Cf; const float* xold; const float* W2; const float* lb; const bf16_t* Gsrc; int ncols; unsigned code; int use_snap; };
__global__ void k_chk_gemm(ChkGemm c, unsigned* diag) {
    const int i = blockIdx.x; const int r = samp_row(i);
    for (int cc = threadIdx.x; cc < 96; cc += blockDim.x) {
        const int col = (int)(((unsigned)cc * 40503u + (unsigned)i * 977u) % (unsigned)c.ncols);
        float dot = 0.f, dot2 = 0.f;
        for (int k = 0; k < c.K; ++k) { const float av = bf2f(c.A[(size_t)r * c.lda + k]); dot += av * c.W[(size_t)k * c.ldw + col]; if (c.mode == 4) dot2 += av * c.W2[(size_t)k * c.ldw + col]; }
        float ref, got;
        if (c.mode == 0) { const int kind = col >> 9; ref = (kind == 0 || kind == 3) ? siluf_(dot) : kind == 1 ? __logf(c.lb[col - 512] + (1.f - c.lb[col - 512]) * sigmoidf_(dot)) : (kind == 4 || kind == 5) ? gelu_tanh_(dot) : dot; got = bf2f(c.Cb[(size_t)r * c.ldc + col]); }
        else if (c.mode == 1) { ref = sigmoidf_(dot); got = bf2f(c.Cb[(size_t)r * c.ldc + col]); }
        else if (c.mode == 3) { const float xo = c.use_snap ? c.xold[(size_t)i * D + col] : c.xold[(size_t)r * D + col]; ref = xo + dot; got = c.Cf[(size_t)r * D + col]; }
        else { ref = siluf_(dot) * dot2; got = bf2f(c.Cb[(size_t)r * c.ldc + col]); }
        if (!chk_close(got, ref, 0.03f, 0.03f)) { chk_fail(diag, c.code); if (c.mode == 1) { atomicOr(diag + 24 + (i >> 5), 1u << (i & 31)); atomicOr(diag + 26, 1u << ((r & 255) >> 4)); atomicOr(diag + 20 + ((col & 127) >> 5), 1u << (col & 31)); atomicAdd(diag + 16, 1u); atomicMin(diag + 17, (unsigned)(col >> 8)); atomicMax(diag + 18, (unsigned)(col >> 8)); if (fabsf(got - dot) <= 0.03f + 0.03f * fabsf(dot)) atomicAdd(diag + 19, 1u); } }
    }
}
__global__ void k_chk_branch(const bf16_t* ocat, const float* wbr  , const bf16_t* xn, const float* win  , const bf16_t* GH, unsigned code, unsigned* diag) {
    const int i = blockIdx.x; const int r = samp_row(i);
    for (int cc = threadIdx.x; cc < 96; cc += blockDim.x) {
        const int col = (int)(((unsigned)cc * 40503u + (unsigned)i * 977u) % 3072u); const int b = col >> 10, cl = col & 1023;
        float h = 0.f; for (int k = 0; k < 512; ++k) h += bf2f(ocat[(size_t)b * MTOK * 512 + (size_t)r * 512 + k]) * wbr[((size_t)b * 512 + k) * 1024 + cl];
        float g = 0.f; for (int k = 0; k < 1024; ++k) g += bf2f(xn[(size_t)r * D + k]) * win[(size_t)k * INCOLS + PCOLS + col];
        const float ref = sigmoidf_(g) * h, got = bf2f(GH[(size_t)r * GCOLS + col]);
        if (!chk_close(got, ref, 0.03f, 0.04f)) chk_fail(diag, code);
    }
}
__global__ void k_chk_attn(const bf16_t* P, const float* gq, const float* gk, const bf16_t* oc, unsigned code, unsigned* diag) {
    const int id = blockIdx.x, lane = threadIdx.x; const int ti = id % 10;
    const int t = ti == 0 ? 0 : ti == 1 ? 1 : ti == 2 ? 2 : ti == 3 ? 63 : ti == 4 ? 64 : ti == 5 ? 65 : ti == 6 ? 200 : ti == 7 ? 1000 : ti == 8 ? 4097 : 8191;
    const int h = (id / 10) % 8, b = id / 80; const size_t tokb = (size_t)b * SEQ;
    float q = bf2f(P[(tokb + t) * PCOLS + C_SQ + h * 64 + lane]); q = q * rsqrtf(wave_sum(q * q) / 64.f + EPS) * gq[lane];
    float o = 0.f, carry = 0.f;
    for (int s = t - 1; s >= 0 && carry < 300.f; --s) {
        float kv = bf2f(P[(tokb + s) * PCOLS + C_SK + h * 64 + lane]); kv = kv * rsqrtf(wave_sum(kv * kv) / 64.f + EPS) * gk[lane];
        const float z = wave_sum(q * kv) * 0.125f; const float sp = logf(1.f + expf(z));
        carry += sp; const float A = expf(z - carry);
        o += A * bf2f(P[(tokb + s) * PCOLS + C_SV + h * 64 + lane]);
    }
    if (!chk_close(bf2f(oc[(tokb + t) * 512 + h * 64 + lane]), o, 0.02f, 0.03f)) chk_fail(diag, code);
}
__global__ void k_chk_gmlp(const bf16_t* P, const float* ws_l, const float* bs_l, const float* gv_l, const bf16_t* ob, unsigned code, unsigned* diag) {
    const int id = blockIdx.x * blockDim.x + threadIdx.x; if (id >= 512) return;
    const int chunk = (id * 37) % (MTOK / 128), t = (id * 53 + 7) % 128, ch = (id * 101 + 3) % 512, g = ch >> 7, c = ch & 127; const size_t tok0 = (size_t)chunk * 128;
    float acc = 0.f;
    for (int s = 0; s <= t; ++s) { float ss = 0.f; for (int k = 0; k < 512; ++k) { const float v = bf2f(P[(tok0 + s) * PCOLS + C_GV + k]); ss += v * v; }
        const float vn = bf2f(P[(tok0 + s) * PCOLS + C_GV + ch]) * rsqrtf(ss / 512.f + EPS) * gv_l[ch]; acc += ws_l[(size_t)g * 16384 + t * 128 + s] * vn; }
    const float ref = bf2f(P[(tok0 + t) * PCOLS + C_GU + ch]) * (acc + bs_l[g * 128 + t]);
    if (!chk_close(bf2f(ob[(tok0 + t) * 512 + ch]), ref, 0.02f, 0.03f)) chk_fail(diag, code);
}
__global__ void k_chk_hgrn(const bf16_t* P, const float* gain, const bf16_t* oa, unsigned code, unsigned* diag) {
    const int id = blockIdx.x; const int ti = id % 8; const int t = ti == 0 ? 0 : ti == 1 ? 1 : ti == 2 ? 5 : ti == 3 ? 63 : ti == 4 ? 64 : ti == 5 ? 200 : ti == 6 ? 511 : 700, h = (id / 8) % 4, b = id / 32; const int v = threadIdx.x; const size_t tokb = (size_t)b * SEQ;
    float o = 0.f;
    for (int d = 0; d < 128; ++d) { float st = 0.f;
        for (int s = 0; s <= t; ++s) { const bf16_t* row = P + (tokb + s) * PCOLS; const float f = expf(bf2f(row[C_HF + h * 128 + d])); st = f * st + (1.f - f) * bf2f(row[C_HI + h * 128 + v]); }
        o += bf2f(P[(tokb + t) * PCOLS + C_HQ + h * 128 + d]) * st; }
    __shared__ float red[128]; red[v] = o * o; __syncthreads();
    for (int w = 64; w > 0; w >>= 1) { if (v < w) red[v] += red[v + w]; __syncthreads(); }
    const float rstd = rsqrtf(red[0] / 128.f + EPS);
    const float ref = o * rstd * gain[v] * bf2f(P[(tokb + t) * PCOLS + C_HG + h * 128 + v]);
    if (!chk_close(bf2f(oa[(tokb + t) * 512 + h * 128 + v]), ref, 0.03f, 0.04f)) chk_fail(diag, code);
}
__global__ void k_chk_moe(const bf16_t* xn, const float* rw, const float* rb, const float* wg, const float* wu, const float* wd, const float* snap, const float* xout, unsigned code, unsigned* diag) {
    const int i = blockIdx.x; const int r = samp_row(i); const int tid = threadIdx.x;
    __shared__ float hid[DFF]; __shared__ float lg[8]; __shared__ float part[256];
    if (tid < 8) { float a = rb[tid]; for (int k = 0; k < D; ++k) a += bf2f(xn[(size_t)r * D + k]) * rw[k * 8 + tid]; lg[tid] = a; }
    __syncthreads();
    int i0 = 0; for (int e = 1; e < 8; ++e) if (lg[e] > lg[i0]) i0 = e;
    int i1 = -1; for (int e = 0; e < 8; ++e) if (e != i0 && (i1 < 0 || lg[e] > lg[i1])) i1 = e;
    const float w0 = 1.f / (1.f + expf(lg[i1] - lg[i0])), w1 = 1.f - w0;
    float outv[8]; for (int j = 0; j < 8; ++j) outv[j] = 0.f;
    for (int kk = 0; kk < 2; ++kk) { const int e = kk ? i1 : i0; const float wgt = kk ? w1 : w0;
        for (int f = tid; f < DFF; f += blockDim.x) { float g = 0.f, u = 0.f; for (int k = 0; k < D; ++k) { const float xv = bf2f(xn[(size_t)r * D + k]); g += xv * wg[((size_t)e * D + k) * DFF + f]; u += xv * wu[((size_t)e * D + k) * DFF + f]; } hid[f] = siluf_(g) * u; }
        __syncthreads();
        for (int j = 0; j < 8; ++j) { const int col = (j * 131 + i * 17) % D; float p = 0.f; for (int f = tid; f < DFF; f += blockDim.x) p += hid[f] * wd[((size_t)e * DFF + f) * D + col];
            part[tid] = p; __syncthreads(); for (int w = 128; w > 0; w >>= 1) { if (tid < w) part[tid] += part[tid + w]; __syncthreads(); } outv[j] += wgt * part[0]; __syncthreads(); }
    }
    if (tid == 0) for (int j = 0; j < 8; ++j) { const int col = (j * 131 + i * 17) % D; const float ref = snap[(size_t)i * D + col] + outv[j]; if (!chk_close(xout[(size_t)r * D + col], ref, 0.04f, 0.04f)) chk_fail(diag, code); }
}
#endif

struct Args { const float* in[21]; float* out; unsigned char* ws; int lo, hi; };
constexpr int NSTEPS = 50;
#define LANEID ((int)__builtin_amdgcn_mbcnt_hi(~0u, __builtin_amdgcn_mbcnt_lo(~0u, 0u)))

template <class Epi>
__device__ __forceinline__ void run_gemm(LAS unsigned char* lds, const Order& S, int K, const Epi& E, int wid) { pg8::gemm_phase<Epi, Order, true, true>(lds, K, S, E, wid); }

__global__ void __launch_bounds__(NTHREADS, 2) mk_fwd(Args a) {
    extern __shared__ __attribute__((aligned(16))) unsigned char lds_raw[];
    LAS unsigned char* lds = (LAS unsigned char*)lds_raw;
    const int wid = __builtin_amdgcn_readfirstlane((int)threadIdx.x >> 6);
    LAS unsigned* cblk = (LAS unsigned*)(lds + LDS_MISC);
    { const int tid = threadIdx.x;
      if (tid < 4) cblk[tid] = (tid == 2) ? xb_xcc_id() : 0u;
      if (tid < 46) { const unsigned long long pv = (tid < 42) ? (unsigned long long)a.in[tid >> 1] : (tid < 44) ? (unsigned long long)a.out : (unsigned long long)a.ws; cblk[4 + tid] = (tid & 1) ? (unsigned)(pv >> 32) : (unsigned)pv; }
      if (tid == 46) cblk[50] = (unsigned)a.lo; if (tid == 47) cblk[51] = (unsigned)a.hi; }
    __syncthreads();
#define CW(i) ((int)__builtin_amdgcn_readfirstlane(cblk[i]))
#define ARGP(i) ((unsigned char*)(((unsigned long long)(unsigned)CW(5 + 2 * (i)) << 32) | (unsigned long long)(unsigned)CW(4 + 2 * (i))))
#define IN(i) ((const float*)ARGP(i))
#define OUTP ((float*)ARGP(21))
#define WSP (ARGP(22))
#define GSZ ((int)gridDim.x)
#define WGI ((int)blockIdx.x)
    if (CW(51) - CW(50) > 1 && threadIdx.x == 0) (void)xb_add((unsigned*)(WSP + WS_CTL + CW_BAR) + XB_XCNT(CW(2)), 1u);
#define RUN(k) (CW(50) <= (k) && (k) < CW(51))
#define SEAM(k) do { if (CW(50) <= (k) && (k) + 1 < CW(51)) { XcdBarrier bar_; bar_.bar = (unsigned*)(WSP + WS_CTL + CW_BAR); bar_.x = (unsigned)CW(2); bar_.st = (volatile LAS unsigned*)cblk; xcd_barrier(bar_); } } while (0)

#define XRES (OUTP)
#define WIN ((bf16_t*)(WSP + WS_WIN))
#define WBR ((bf16_t*)(WSP + WS_WBR))
#define WOUT ((bf16_t*)(WSP + WS_WOUT))
#define WGU ((bf16_t*)(WSP + WS_WGU))
#define WDN ((bf16_t*)(WSP + WS_WD))
#define XNB ((bf16_t*)(WSP + WS_XN))
#define PBUF ((bf16_t*)(WSP + WS_P))
#define GBUF ((bf16_t*)(WSP + WS_G))
#define HIDB ((bf16_t*)(WSP + WS_HID))
#define OCATB ((bf16_t*)(WSP + WS_OCAT))
#define MWGU ((bf16_t*)(WSP + WS_MWGU))
#define MWDN ((bf16_t*)(WSP + WS_MWD))
#define XSB ((bf16_t*)(WSP + WS_XS))
#define MHIDB ((bf16_t*)(WSP + WS_MHID))
#define LBB ((float*)(WSP + WS_LB))
#define METAB ((int*)(WSP + WS_META))
#define TOKE ((int*)(WSP + WS_TOKE))
#define TOKW ((float2*)(WSP + WS_TOKW))
#define STOK ((int*)(WSP + WS_SLOTTOK))
#define SWB ((float*)(WSP + WS_SLOTW))
#define HDUMP ((uint2*)(WSP + WS_ORAW))
#define HU ((float*)(WSP + WS_ORAW + HG_DUMP_BYTES))
#define HDSC ((float*)(WSP + WS_ORAW + HG_DUMP_BYTES + HG_U_BYTES))
#define TIDV (wid * 64 + LANEID)
    if (RUN(0)) {
        LAS float* tile = (LAS float*)lds; const int tid = TIDV;
        for (int l = 0; l < 2; ++l) {
            tc_job(IN(2) + (size_t)l * D * INCOLS, D, INCOLS, WIN + (size_t)l * INCOLS * D, 0, 1, tile, WGI, GSZ, tid);
            for (int b = 0; b < 3; ++b) tc_job(IN(10) + (size_t)(l * 3 + b) * 512 * D, 512, D, WBR + (size_t)(l * 3 + b) * D * 512, 0, 1, tile, WGI, GSZ, tid);
            tc_job(IN(11) + (size_t)l * D * D, D, D, WOUT + (size_t)l * D * D, 0, 0, tile, WGI, GSZ, tid);
        }
        tc_job(IN(13), D, DFF, WGU, 1, 1, tile, WGI, GSZ, tid);
        tc_job(IN(14), D, DFF, WGU, 2, 1, tile, WGI, GSZ, tid);
        tc_job(IN(15), DFF, D, WDN, 0, 0, tile, WGI, GSZ, tid);
        if (WGI == 0) { const float a0 = IN(3)[tid], a1 = IN(3)[512 + tid]; LBB[tid] = 0.f; LBB[512 + tid] = sigmoidf_(a1 - a0); }
    }
    SEAM(0);

    for (int l = 0; l < 2; ++l) {
        const int sb = (l == 0) ? 1 : 14;
        if (RUN(sb + 0)) phase_rmsnorm<false>((l == 0) ? IN(0) : (const float*)XRES, IN(1) + l * D, XNB, nullptr, nullptr, nullptr, nullptr, WGI, GSZ, wid, LANEID);
        SEAM(sb + 0);
        if (RUN(sb + 1)) { Order S; S.init(XNB, WIN + (size_t)l * INCOLS * D, MTOK, PCOLS, D, GSZ, WGI); EpiAct E{PBUF, PCOLS, LBB + l * 512, 1}; run_gemm(lds, S, D, E, wid); }
        SEAM(sb + 1);
        if (RUN(sb + 2)) phase_hgrn_a(PBUF, OCATB, HDUMP, HU, HDSC, lds, WGI, GSZ, TIDV, wid, LANEID);
        SEAM(sb + 2);
        if (RUN(sb + 3)) phase_gmlp(PBUF, IN(6) + (size_t)l * 4 * 16384, IN(7) + l * 512, IN(5) + l * 512, OCATB + (size_t)MTOK * 512, lds, WGI, GSZ, TIDV, wid, LANEID);
        SEAM(sb + 3);
        if (RUN(sb + 4)) phase_attn(PBUF, IN(8) + l * 64, IN(9) + l * 64, OCATB + (size_t)2 * MTOK * 512, lds, WGI, GSZ, TIDV, wid, LANEID);
        SEAM(sb + 4);
        if (RUN(sb + 5)) phase_hgrn_c(PBUF, OCATB, HDUMP, HU, HDSC, IN(4) + l * 128, lds, WGI, GSZ, TIDV, wid, LANEID);
        SEAM(sb + 5);
        if (RUN(sb + 6)) { Order S; S.init(XNB, WIN + (size_t)l * INCOLS * D + (size_t)PCOLS * D, MTOK, GCOLS, D, GSZ, WGI); EpiAct E{GBUF, GCOLS, nullptr, 0}; run_gemm(lds, S, D, E, wid); }
        SEAM(sb + 6);
        if (RUN(sb + 7)) { Order S; S.init(OCATB, WBR + (size_t)l * 3 * D * 512, MTOK, GCOLS, 512, GSZ, WGI, 1, (size_t)MTOK * 512 * 2, (size_t)D * 512 * 2); EpiBranch E{GBUF}; run_gemm(lds, S, 512, E, wid); }
        SEAM(sb + 7);
        if (RUN(sb + 8)) phase_combine(GBUF, XNB, WGI, GSZ, TIDV);
        SEAM(sb + 8);
        if (RUN(sb + 9)) { Order S; S.init(XNB, WOUT + (size_t)l * D * D, MTOK, D, D, GSZ, WGI); EpiResid E{(l == 0) ? IN(0) : (const float*)XRES, XRES}; run_gemm(lds, S, D, E, wid); }
        SEAM(sb + 9);
        if (l == 0) {
            if (RUN(11)) phase_rmsnorm<false>(XRES, IN(12), XNB, nullptr, nullptr, nullptr, nullptr, WGI, GSZ, wid, LANEID);
            SEAM(11);
            if (RUN(12)) { Order S; S.init(XNB, WGU, MTOK, 2 * DFF, D, GSZ, WGI); EpiGU E{HIDB}; run_gemm(lds, S, D, E, wid); }
            SEAM(12);
            if (RUN(13)) { Order S; S.init(HIDB, WDN, MTOK, D, DFF, GSZ, WGI); EpiResid E{XRES, XRES}; run_gemm(lds, S, DFF, E, wid); }
            SEAM(13);
        } else {
            if (RUN(24)) phase_rmsnorm<true>(XRES, IN(12) + D, XNB, IN(16), IN(17), TOKE, TOKW, WGI, GSZ, wid, LANEID);
            SEAM(24);
            if (RUN(25)) {
                if (WGI == GSZ - 1) moe_assign(TOKE, TOKW, METAB, STOK, SWB, lds, TIDV);
                else { LAS float* tile = (LAS float*)lds; const int tid = TIDV;
                    for (int e = 0; e < NEXP; ++e) {
                        tc_job(IN(18) + (size_t)e * D * DFF, D, DFF, MWGU + (size_t)e * 2 * DFF * D, 1, 1, tile, WGI, GSZ - 1, tid);
                        tc_job(IN(19) + (size_t)e * D * DFF, D, DFF, MWGU + (size_t)e * 2 * DFF * D, 2, 1, tile, WGI, GSZ - 1, tid);
                        tc_job(IN(20) + (size_t)e * DFF * D, DFF, D, MWDN + (size_t)e * D * DFF, 0, 0, tile, WGI, GSZ - 1, tid); } }
            }
            SEAM(25);
            for (int e = 0; e < NEXP; ++e) {
                const int se = 26 + 3 * e;
                if (RUN(se)) { const int rows = __hip_atomic_load(METAB + 8 + e, __ATOMIC_RELAXED, __HIP_MEMORY_SCOPE_AGENT), s0 = __hip_atomic_load(METAB + 16 + e, __ATOMIC_RELAXED, __HIP_MEMORY_SCOPE_AGENT);
                    moe_gather(XNB, STOK + s0, rows, XSB, WGI, GSZ, wid, LANEID); }
                SEAM(se);
                if (RUN(se + 1)) { const int rows = __hip_atomic_load(METAB + 8 + e, __ATOMIC_RELAXED, __HIP_MEMORY_SCOPE_AGENT);
                    Order S; S.init(XSB, MWGU + (size_t)e * 2 * DFF * D, rows, 2 * DFF, D, GSZ, WGI); EpiGU E{MHIDB}; run_gemm(lds, S, D, E, wid); }
                SEAM(se + 1);
                if (RUN(se + 2)) { const int rows = __hip_atomic_load(METAB + 8 + e, __ATOMIC_RELAXED, __HIP_MEMORY_SCOPE_AGENT), s0 = __hip_atomic_load(METAB + 16 + e, __ATOMIC_RELAXED, __HIP_MEMORY_SCOPE_AGENT);
                    Order S; S.init(MHIDB, MWDN + (size_t)e * D * DFF, rows, D, DFF, GSZ, WGI); EpiMoeDown E{XRES, STOK + s0, SWB + s0}; run_gemm(lds, S, DFF, E, wid); }
                SEAM(se + 2);
            }
        }
    }
}

extern "C" void kernel_launch(void* const* d_in, const int* in_sizes, int n_in, void* d_out, int out_size, void* d_ws, size_t ws_size, hipStream_t stream) {
    static int grid = 0;
    if (grid == 0) {
        if (n_in != 21 || out_size != MTOK * D || ws_size < WS_NEED) { fprintf(stderr, "kernel_launch: unexpected shapes (n_in %d out %d ws %zu need %zu)\n", n_in, out_size, ws_size, (size_t)WS_NEED); grid = -1; return; }
        int dev = 0, cus = 0, per_cu = 0;
        if (hipGetDevice(&dev) != hipSuccess || hipDeviceGetAttribute(&cus, hipDeviceAttributeMultiprocessorCount, dev) != hipSuccess) { grid = -1; return; }
        if (hipFuncSetAttribute((const void*)mk_fwd, hipFuncAttributeMaxDynamicSharedMemorySize, LDS_BYTES) != hipSuccess) { fprintf(stderr, "kernel_launch: hipFuncSetAttribute failed\n"); grid = -1; return; }
        if (hipOccupancyMaxActiveBlocksPerMultiprocessor(&per_cu, (const void*)mk_fwd, NTHREADS, LDS_BYTES) != hipSuccess || per_cu < 1) { fprintf(stderr, "kernel_launch: occupancy query says %d\n", per_cu); (void)hipGetLastError(); per_cu = 1; }
        grid = cus;
    }
    if (grid < 0) return;
    (void)hipMemsetAsync((char*)d_ws + WS_CTL, 0, CTL_BYTES, stream);
    Args a{};
    for (int i = 0; i < 21; ++i) a.in[i] = (const float*)d_in[i];
    a.out = (float*)d_out; a.ws = (unsigned char*)d_ws;
#if defined(MK_CHECK)
    {
        unsigned char* ws = (unsigned char*)d_ws; unsigned* diag = (unsigned*)(ws + WS_DIAG); float* snap = (float*)(ws + WS_SNAP);
        const bf16_t* XN = (const bf16_t*)(ws + WS_XN); const bf16_t* Pb = (const bf16_t*)(ws + WS_P); const bf16_t* OC = (const bf16_t*)(ws + WS_OCAT); const float* LB = (const float*)(ws + WS_LB);
        auto run = [&](int s) { a.lo = s; a.hi = s + 1; hipLaunchKernelGGL(mk_fwd, dim3(grid), dim3(NTHREADS), LDS_BYTES, stream, a); };
        hipLaunchKernelGGL(k_diag_init, dim3(1), dim3(64), 0, stream, diag);
        int s = 0; run(s++);
        for (int l = 0; l < 2; ++l) {
            const unsigned cb = l * 10;
            const float* win = a.in[2] + (size_t)l * D * INCOLS;
            run(s++); run(s++);
            { ChkGemm c{}; c.A = XN; c.lda = D; c.W = win; c.ldw = INCOLS; c.K = D; c.mode = 0; c.Cb = Pb; c.ldc = PCOLS; c.lb = LB + l * 512; c.ncols = PCOLS; c.code = cb + 1; hipLaunchKernelGGL(k_chk_gemm, dim3(64), dim3(96), 0, stream, c, diag); }
            run(s++); run(s++); run(s++); run(s++);
            hipLaunchKernelGGL(k_chk_hgrn, dim3(128), dim3(128), 0, stream, Pb, a.in[4] + l * 128, OC, cb + 2, diag);
            hipLaunchKernelGGL(k_chk_gmlp, dim3(8), dim3(64), 0, stream, Pb, a.in[6] + (size_t)l * 4 * 16384, a.in[7] + l * 512, a.in[5] + l * 512, OC + (size_t)MTOK * 512, cb + 3, diag);
            hipLaunchKernelGGL(k_chk_attn, dim3(320), dim3(64), 0, stream, Pb, a.in[8] + l * 64, a.in[9] + l * 64, OC + (size_t)2 * MTOK * 512, cb + 4, diag);
            run(s++);
            { ChkGemm c{}; c.A = XN; c.lda = D; c.W = win + PCOLS; c.ldw = INCOLS; c.K = D; c.mode = 1; c.Cb = (const bf16_t*)(ws + WS_G); c.ldc = GCOLS; c.ncols = GCOLS; c.code = cb + 5; hipLaunchKernelGGL(k_chk_gemm, dim3(64), dim3(96), 0, stream, c, diag); }
            run(s++);
            hipLaunchKernelGGL(k_chk_branch, dim3(64), dim3(96), 0, stream, OC, a.in[10] + (size_t)l * 3 * 512 * D, XN, win, (const bf16_t*)(ws + WS_G), cb + 6, diag);
            run(s++);
            if (l == 1) hipLaunchKernelGGL(k_snapshot, dim3(64), dim3(256), 0, stream, (const float*)d_out, snap);
            run(s++);
            { ChkGemm c{}; c.A = XN; c.lda = D; c.W = a.in[11] + (size_t)l * D * D; c.ldw = D; c.K = D; c.mode = 3; c.Cf = (const float*)d_out; c.xold = l ? snap : a.in[0]; c.use_snap = l; c.ncols = D; c.code = cb + 7; hipLaunchKernelGGL(k_chk_gemm, dim3(64), dim3(96), 0, stream, c, diag); }
            run(s++);
            if (l == 0) {
                run(s++);
                { ChkGemm c{}; c.A = XN; c.lda = D; c.W = a.in[13]; c.W2 = a.in[14]; c.ldw = DFF; c.K = D; c.mode = 4; c.Cb = (const bf16_t*)(ws + WS_HID); c.ldc = DFF; c.ncols = DFF; c.code = cb + 8; hipLaunchKernelGGL(k_chk_gemm, dim3(64), dim3(96), 0, stream, c, diag); }
                hipLaunchKernelGGL(k_snapshot, dim3(64), dim3(256), 0, stream, (const float*)d_out, snap);
                run(s++);
                { ChkGemm c{}; c.A = (const bf16_t*)(ws + WS_HID); c.lda = DFF; c.W = a.in[15]; c.ldw = D; c.K = DFF; c.mode = 3; c.Cf = (const float*)d_out; c.xold = snap; c.use_snap = 1; c.ncols = D; c.code = cb + 9; hipLaunchKernelGGL(k_chk_gemm, dim3(64), dim3(96), 0, stream, c, diag); }
            } else {
                hipLaunchKernelGGL(k_snapshot, dim3(64), dim3(256), 0, stream, (const float*)d_out, snap);
                run(s++);
                for (int e = 0; e < NEXP * 3; ++e) run(s++);
                hipLaunchKernelGGL(k_chk_moe, dim3(16), dim3(256), 0, stream, XN, a.in[16], a.in[17], a.in[18], a.in[19], a.in[20], (const float*)snap, (const float*)d_out, 20u, diag);
            }
        }
        if (s != NSTEPS) fprintf(stderr, "step count mismatch %d\n", s);
        hipLaunchKernelGGL(k_apply_diag, dim3(1024), dim3(256), 0, stream, (float*)d_out, (const unsigned*)diag);
    }
#elif !defined(MK_ONE_LAUNCH)
    for (int s = 0; s < NSTEPS; ++s) { a.lo = s; a.hi = s + 1; hipLaunchKernelGGL(mk_fwd, dim3(grid), dim3(NTHREADS), LDS_BYTES, stream, a); }
#else
    a.lo = 0; a.hi = NSTEPS; hipLaunchKernelGGL(mk_fwd, dim3(grid), dim3(NTHREADS), LDS_BYTES, stream, a);
#endif
}
```

```cpp
#define MK_ONE_LAUNCH 1
#include <hip/hip_runtime.h>
#include <cstdio>
#include <cstdint>
#include <cstddef>

#define LAS __attribute__((address_space(3)))
#define XB_TMO      128
#define XB_XCNT(j)  (256  + 64 * (j))
#define XB_XSUB(j)  (1280 + 64 * (j))
#define XB_XGEN(j)  (2304 + 64 * (j))
#define XB_TOP      3328
#define XB_TOPGEN   3392
#define XCD_BAR_WORDS 3456
#define XB_SPIN_CAP (1u << 18)

__device__ __forceinline__ unsigned xb_ld(unsigned* p)              { return __hip_atomic_load(p, __ATOMIC_RELAXED, __HIP_MEMORY_SCOPE_AGENT); }
__device__ __forceinline__ unsigned xb_add(unsigned* p, unsigned v) { return __hip_atomic_fetch_add(p, v, __ATOMIC_RELAXED, __HIP_MEMORY_SCOPE_AGENT); }
__device__ __forceinline__ unsigned xb_xcc_id() { return (unsigned)__builtin_amdgcn_s_getreg((3 << 11) | 20) & 0xFu; }
#define XB_SPIN(cond, bar) do { unsigned _sp = 0; while (cond) { __builtin_amdgcn_s_sleep(1); \
    if ((++_sp & 255u) == 0u) { if (xb_ld(&(bar)[XB_TMO])) break; if (_sp > XB_SPIN_CAP) { atomicAdd(&(bar)[XB_TMO], 1u); break; } } } } while (0)

struct XcdBarrier {
    unsigned* bar; unsigned x;
    volatile LAS unsigned* st;
};

__device__ __forceinline__ XcdBarrier xcd_barrier_post(unsigned* bar, volatile LAS unsigned* st) {
    XcdBarrier b; b.bar = bar; b.x = xb_xcc_id(); b.st = st;
    if (threadIdx.x == 0) (void)xb_add(&bar[XB_XCNT(b.x)], 1u);
    return b;
}
__device__ __forceinline__ void xcd_barrier_complete(unsigned* bar, unsigned x, unsigned& nloc, unsigned& nx) {
    const unsigned G = gridDim.x * gridDim.y * gridDim.z;
    unsigned sum, cnt, mine, sp = 0u;
    for (;;) {
        sum = 0u; cnt = 0u; mine = 0u;
#pragma unroll
        for (unsigned j = 0; j < 16; ++j) { const unsigned c = xb_ld(&bar[XB_XCNT(j)]); sum += c; cnt += (c > 0u) ? 1u : 0u; mine = (j == x) ? c : mine; }
        if (sum == G) break;
        __builtin_amdgcn_s_sleep(1);
        if ((++sp & 255u) == 0u) { if (xb_ld(&bar[XB_TMO])) break; if (sp > XB_SPIN_CAP) { atomicAdd(&bar[XB_TMO], 1u); break; } }
    }
    nloc = mine > 0u ? mine : 1u; nx = cnt > 0u ? cnt : 1u;
}

__device__ __forceinline__ void xcd_barrier(const XcdBarrier& b) {
    asm volatile("s_waitcnt vmcnt(0)" ::: "memory");
    __syncthreads();
    if (threadIdx.x == 0) {
        unsigned* bar = b.bar;
        __builtin_amdgcn_s_waitcnt(0);
        unsigned nloc = b.st[0], nx = b.st[1];
        if (nloc == 0u) { xcd_barrier_complete(bar, b.x, nloc, nx); b.st[0] = nloc; b.st[1] = nx; }
        const unsigned old = xb_add(&bar[XB_XSUB(b.x)], 1u);
        const unsigned gen = old / nloc;
        if (old + 1u == (gen + 1u) * nloc) {
            __builtin_amdgcn_fence(__ATOMIC_RELEASE, "agent");
            asm volatile("s_waitcnt vmcnt(0)" ::: "memory");
            const unsigned og = xb_add(&bar[XB_TOP], 1u);
            const unsigned tg = og / nx;
            if (og + 1u == (tg + 1u) * nx) xb_add(&bar[XB_TOPGEN], 1u);
            else XB_SPIN(xb_ld(&bar[XB_TOPGEN]) == tg, bar);
            __builtin_amdgcn_fence(__ATOMIC_ACQUIRE, "agent");
            xb_add(&bar[XB_XGEN(b.x)], 1u);
            asm volatile("s_waitcnt vmcnt(0)" ::: "memory");
        } else {
            XB_SPIN(xb_ld(&bar[XB_XGEN(b.x)]) == gen, bar);
            __builtin_amdgcn_fence(__ATOMIC_ACQUIRE, "agent");
            asm volatile("s_waitcnt vmcnt(0)" ::: "memory");
        }
    }
    __syncthreads();
}
namespace pg8 {
#define PG8_LAS __attribute__((address_space(3)))
typedef unsigned short bf16_t;
typedef short bf16x8 __attribute__((ext_vector_type(8)));
typedef float f32x4 __attribute__((ext_vector_type(4)));
typedef unsigned u32x4 __attribute__((ext_vector_type(4)));
constexpr int BM = 256, BK = 64, HALF = 128, HTB = HALF * BK * 2  , STAGE_BYTES = 8 * HTB, NXCD = 8, WGM = 8;

__host__ __device__ __forceinline__ int lds_byte(int r, int c) { const int st = (r >> 4) * 2 + (c >> 5), rr = r & 15, cc = c & 31, ob = rr * 64 + cc * 2; return st * 1024 + (ob ^ (((ob >> 9) & 1) << 5)); }
__host__ __device__ __forceinline__ void stage_rc(int b, int& R, int& C) { const int st = b / 1024, sb = b % 1024, swz = sb ^ (((sb >> 9) & 1) << 5); R = (st >> 1) * 16 + swz / 64; C = (st & 1) * 32 + (swz % 64) / 2; }
__host__ __device__ __forceinline__ int perm32(int rho) { const int n = rho >> 4, i = rho & 15; return 8 * (i >> 2) + 4 * n + (i & 3); }

struct Unit { int pm, pn; const char* a; const char* b; };

typedef float f32x2 __attribute__((ext_vector_type(2))); typedef __bf16 bf16x2_t __attribute__((ext_vector_type(2)));
__device__ __forceinline__ unsigned cvt_pk_bf16(float lo, float hi) { f32x2 v = {lo, hi}; bf16x2_t b = __builtin_convertvector(v, bf16x2_t); return __builtin_bit_cast(unsigned, b); }
template <class Epi, class Sched, bool ALIGN_EPI = false, bool SP2 = false>
__device__ __forceinline__ void gemm_phase(PG8_LAS unsigned char* lds, const int K, const Sched& S, const Epi& E, const int wid) {
    int lane; asm volatile("v_mbcnt_lo_u32_b32 %0, -1, 0\n\tv_mbcnt_hi_u32_b32 %0, -1, %0" : "=v"(lane));
    const int tid = wid * 64 + lane, wr = wid >> 2, wc = wid & 3, fr = lane & 15, fq = lane >> 4;
    const int nt = K / BK;
    unsigned voffA[2];
#pragma unroll
    for (int i = 0; i < 2; ++i) { int R, C; stage_rc(tid * 16 + i * 8192, R, C); voffA[i] = (unsigned)(R * K + C) * 2u; }
    const size_t kstep = (size_t)(BK * 2);
    const size_t hstep = (size_t)HALF * K * 2;
    const unsigned ldsw = (unsigned)wid * 1024u;
    const int aoff = lds_byte(wr * 64 + fr, fq * 8), boff = lds_byte(wc * 32 + fr, fq * 8);
#define PG8_SA(b, h) (((b) * 2 + (h)) * HTB)
#define PG8_SB(b, h) ((4 + (b) * 2 + (h)) * HTB)
#define PG8_STAGE(bufoff, gbase, voff) do { _Pragma("unroll") for (int _i = 0; _i < 2; ++_i) \
        __builtin_amdgcn_global_load_lds((const unsigned*)((const char*)(gbase) + (voff)[_i]), (PG8_LAS unsigned*)(lds + (bufoff) + ldsw + _i * 8192), 16, 0, 0); } while (0)
#define PG8_LDA(dst, b, h) do { _Pragma("unroll") for (int m = 0; m < 4; ++m) _Pragma("unroll") for (int k = 0; k < 2; ++k) dst[m][k] = *(const PG8_LAS bf16x8*)(lds + PG8_SA(b, h) + aoff + m * 2048 + k * 1024); } while (0)
#define PG8_LDB(dst, b, h) do { _Pragma("unroll") for (int n = 0; n < 2; ++n) _Pragma("unroll") for (int k = 0; k < 2; ++k) dst[n][k] = *(const PG8_LAS bf16x8*)(lds + PG8_SB(b, h) + boff + n * 2048 + k * 1024); } while (0)
#define PG8_MMA(ai, bj, At, Bt) do { __builtin_amdgcn_s_setprio(1); _Pragma("unroll") for (int m = 0; m < 4; ++m) _Pragma("unroll") for (int n = 0; n < 2; ++n) _Pragma("unroll") for (int k = 0; k < 2; ++k) \
        acc[ai][bj][m][n] = __builtin_amdgcn_mfma_f32_16x16x32_bf16(Bt[n][k], At[m][k], acc[ai][bj][m][n], 0, 0, 0); __builtin_amdgcn_s_setprio(0); } while (0)
#define PG8_WAIT_V(n) asm volatile("s_waitcnt vmcnt(" #n ")" ::: "memory")
#define PG8_WAIT_L(n) asm volatile("s_waitcnt lgkmcnt(" #n ")" ::: "memory")
#define PG8_BAR __builtin_amdgcn_s_barrier()
#define PG8_SCHED __builtin_amdgcn_sched_barrier(0)
    Unit cur, nxt; int ui = 0;
    if (!S.next(0, cur)) return;
    f32x4 acc[2][2][4][2];
#pragma unroll
    for (int a = 0; a < 2; ++a)
#pragma unroll
        for (int b = 0; b < 2; ++b)
#pragma unroll
            for (int m = 0; m < 4; ++m)
#pragma unroll
                for (int n = 0; n < 2; ++n) acc[a][b][m][n] = (f32x4){0.f, 0.f, 0.f, 0.f};
    bf16x8 At[4][2], B0[2][2], B1[2][2];
    const char* cA = cur.a; const char* cB = cur.b;
    S.a_ready(cur);
    if constexpr (SP2) {
        PG8_STAGE(PG8_SB(0, 0), cB, voffA); PG8_STAGE(PG8_SB(0, 1), cB + hstep, voffA); PG8_STAGE(PG8_SA(0, 0), cA, voffA); PG8_STAGE(PG8_SA(0, 1), cA + hstep, voffA);
        if (wr == 1) PG8_BAR;
        PG8_WAIT_V(2); PG8_BAR;
        PG8_STAGE(PG8_SB(1, 0), cB + kstep, voffA); PG8_STAGE(PG8_SA(1, 0), cA + kstep, voffA); PG8_STAGE(PG8_SB(1, 1), cB + hstep + kstep, voffA);
        PG8_WAIT_V(6); PG8_BAR;
    } else {
        PG8_STAGE(PG8_SB(0, 0), cB, voffA); PG8_STAGE(PG8_SA(0, 0), cA, voffA); PG8_STAGE(PG8_SB(0, 1), cB + hstep, voffA); PG8_STAGE(PG8_SA(0, 1), cA + hstep, voffA);
        if (wr == 1) PG8_BAR;
        PG8_WAIT_V(4); PG8_BAR;
        PG8_STAGE(PG8_SB(1, 0), cB + kstep, voffA); PG8_STAGE(PG8_SA(1, 0), cA + kstep, voffA); PG8_STAGE(PG8_SB(1, 1), cB + hstep + kstep, voffA);
        PG8_WAIT_V(6); PG8_BAR;
    }
    for (;;) {
        const bool has_next = S.next(ui + 1, nxt);
        const char* nA = has_next ? nxt.a : cA; const char* nB = has_next ? nxt.b : cB;
        for (int t = 0; t < nt; t += 2) {
            const bool last = (t == nt - 2);
            const char* a1 = cA + (size_t)(t + 1) * kstep;
            const char* a2 = last ? nA : cA + (size_t)(t + 2) * kstep; const char* b2 = last ? nB : cB + (size_t)(t + 2) * kstep;
            const char* a3 = a2 + kstep; const char* b3 = b2 + kstep;
            if (last && has_next) S.a_ready(nxt);
            if constexpr (SP2) {
            PG8_LDB(B0, 0, 0); PG8_LDB(B1, 0, 1); PG8_SCHED; PG8_LDA(At, 0, 0); PG8_STAGE(PG8_SA(1, 1), a1 + hstep, voffA);
            PG8_WAIT_V(8); PG8_WAIT_L(0); PG8_BAR; PG8_MMA(0, 0, At, B0); PG8_MMA(0, 1, At, B1); PG8_BAR; PG8_SCHED;
            PG8_LDA(At, 0, 1); PG8_STAGE(PG8_SB(0, 0), b2, voffA); PG8_STAGE(PG8_SB(0, 1), b2 + hstep, voffA); PG8_STAGE(PG8_SA(0, 0), a2, voffA);
            PG8_WAIT_V(8); PG8_WAIT_L(0); PG8_BAR; PG8_MMA(1, 0, At, B0); PG8_MMA(1, 1, At, B1); PG8_BAR; PG8_SCHED;
            PG8_LDB(B0, 1, 0); PG8_LDB(B1, 1, 1); PG8_SCHED; PG8_LDA(At, 1, 0); PG8_STAGE(PG8_SA(0, 1), a2 + hstep, voffA);
            PG8_WAIT_V(8); PG8_WAIT_L(0); PG8_BAR; PG8_MMA(0, 0, At, B0); PG8_MMA(0, 1, At, B1); PG8_BAR; PG8_SCHED;
            PG8_LDA(At, 1, 1); PG8_STAGE(PG8_SB(1, 0), b3, voffA); PG8_STAGE(PG8_SB(1, 1), b3 + hstep, voffA); PG8_STAGE(PG8_SA(1, 0), a3, voffA);
            PG8_WAIT_V(8); PG8_WAIT_L(0); PG8_BAR; PG8_MMA(1, 0, At, B0); PG8_MMA(1, 1, At, B1); PG8_BAR; PG8_SCHED;
            } else {
            PG8_LDB(B0, 0, 0); PG8_SCHED; PG8_LDA(At, 0, 0); PG8_STAGE(PG8_SA(1, 1), a1 + hstep, voffA);
            PG8_WAIT_L(8); PG8_BAR; PG8_WAIT_L(0); PG8_MMA(0, 0, At, B0); PG8_BAR; PG8_SCHED;
            PG8_LDB(B1, 0, 1); PG8_STAGE(PG8_SB(0, 0), b2, voffA);
            PG8_BAR; PG8_WAIT_L(0); PG8_MMA(0, 1, At, B1); PG8_BAR;
            PG8_LDA(At, 0, 1); PG8_STAGE(PG8_SA(0, 0), a2, voffA);
            PG8_BAR; PG8_WAIT_L(0); PG8_MMA(1, 0, At, B0); PG8_BAR; PG8_SCHED;
            PG8_STAGE(PG8_SB(0, 1), b2 + hstep, voffA);
            PG8_WAIT_V(6); PG8_BAR; PG8_MMA(1, 1, At, B1); PG8_BAR;
            PG8_LDB(B0, 1, 0); PG8_SCHED; PG8_LDA(At, 1, 0); PG8_STAGE(PG8_SA(0, 1), a2 + hstep, voffA);
            PG8_WAIT_L(8); PG8_BAR; PG8_WAIT_L(0); PG8_MMA(0, 0, At, B0); PG8_BAR; PG8_SCHED;
            PG8_LDB(B1, 1, 1); PG8_STAGE(PG8_SB(1, 0), b3, voffA);
            PG8_BAR; PG8_WAIT_L(0); PG8_MMA(0, 1, At, B1); PG8_BAR;
            PG8_LDA(At, 1, 1); PG8_STAGE(PG8_SA(1, 0), a3, voffA);
            PG8_BAR; PG8_WAIT_L(0); PG8_MMA(1, 0, At, B0); PG8_BAR; PG8_SCHED;
            PG8_STAGE(PG8_SB(1, 1), b3 + hstep, voffA);
            PG8_WAIT_V(6); PG8_BAR; PG8_MMA(1, 1, At, B1); PG8_BAR;
            }
        }
        if constexpr (ALIGN_EPI) { if (wr == 0) PG8_BAR; }
        if constexpr (!Epi::AFTER_DRAIN) { E(acc, cur, wr, wc, fr, fq); S.done(cur); }
        if (!has_next) break;
#pragma unroll
        for (int a = 0; a < 2; ++a)
#pragma unroll
            for (int b = 0; b < 2; ++b)
#pragma unroll
                for (int m = 0; m < 4; ++m)
#pragma unroll
                    for (int n = 0; n < 2; ++n) acc[a][b][m][n] = (f32x4){0.f, 0.f, 0.f, 0.f};
        cur = nxt; cA = nA; cB = nB; ++ui;
        if constexpr (ALIGN_EPI) { if (wr == 1) PG8_BAR; }
    }
    PG8_WAIT_V(0);
    if constexpr (!ALIGN_EPI) { if (wr == 0) PG8_BAR; }
    PG8_BAR;
    if constexpr (Epi::AFTER_DRAIN) { E.fused(acc, cur, wr, wc, fr, fq, lds, wid, lane); S.done(cur); }
#undef PG8_SA
#undef PG8_SB
#undef PG8_STAGE
#undef PG8_LDA
#undef PG8_LDB
#undef PG8_MMA
#undef PG8_WAIT_V
#undef PG8_WAIT_L
#undef PG8_BAR
#undef PG8_SCHED
}
}

typedef pg8::bf16_t bf16_t;
typedef pg8::f32x4 f32x4;
typedef pg8::u32x4 u32x4;
using pg8::cvt_pk_bf16;
constexpr int NB = 4, SEQ = 8192, D = 1024, MTOK = NB * SEQ;
constexpr int PCOLS = 4608, GCOLS = 3072, INCOLS = 7680, DFF = 3584, NEXP = 8;
constexpr int C_HQ = 0, C_HF = 512, C_HI = 1024, C_HG = 1536, C_GU = 2048, C_GV = 2560, C_SQ = 3072, C_SK = 3584, C_SV = 4096;
constexpr float EPS = 1e-6f;
constexpr int NSLOT = 2 * MTOK + 2 * NEXP * 256, MOE_MAXBLK = MTOK / 256 + NEXP;
constexpr int NTHREADS = 512, NWAVES = 8;
constexpr int LDS_BYTES = 147456, LDS_MISC = LDS_BYTES - 256;

constexpr size_t WS_CTL = 0, CTL_BYTES = 65536;
constexpr size_t CW_BAR = 0;
constexpr size_t WS_META = WS_CTL + CTL_BYTES;
constexpr size_t WS_LB = WS_META + 4096;
constexpr size_t WS_TOKE = WS_LB + 4096;
constexpr size_t WS_TOKW = WS_TOKE + (size_t)MTOK * 4;
constexpr size_t WS_SLOTTOK = WS_TOKW + (size_t)MTOK * 8;
constexpr size_t WS_SLOTW = WS_SLOTTOK + (size_t)NSLOT * 4;
constexpr size_t WS_BLKE = WS_SLOTW + (size_t)NSLOT * 4;
constexpr size_t WS_W = 2u << 20;
static_assert(WS_BLKE + 4096 <= WS_W, "small buffers");
constexpr size_t WS_WIN = WS_W;
constexpr size_t WS_WBR = WS_WIN + (size_t)2 * INCOLS * D * 2;
constexpr size_t WS_WOUT = WS_WBR + (size_t)2 * 3 * D * 512 * 2;
constexpr size_t WS_WGU = WS_WOUT + (size_t)2 * D * D * 2;
constexpr size_t WS_WD = WS_WGU + (size_t)2 * DFF * D * 2;
constexpr size_t WS_XN = WS_WD + (size_t)D * DFF * 2;
constexpr size_t WS_C = WS_XN + (size_t)MTOK * D * 2;
constexpr size_t WS_P = WS_C;
constexpr size_t WS_G = WS_C;
constexpr size_t WS_HID = WS_C;
constexpr size_t WS_OCAT = WS_C + (size_t)MTOK * PCOLS * 2;
constexpr size_t WS_ORAW = WS_OCAT + (size_t)3 * MTOK * 512 * 2;
constexpr size_t WS_END1 = WS_ORAW + (size_t)MTOK * 512 * 4;
constexpr size_t WS_MWD = WS_W;
static_assert(WS_MWD + (size_t)NEXP * D * DFF * 2 <= WS_XN, "moe down weights fit below XN");
constexpr size_t WS_MWGU = WS_C;
constexpr size_t WS_XS = WS_MWGU + (size_t)NEXP * 2 * DFF * D * 2;
constexpr size_t WS_MHID = WS_XS + (size_t)MOE_MAXBLK * 256 * D * 2;
constexpr size_t WS_END2 = WS_MHID + (size_t)MOE_MAXBLK * 256 * DFF * 2;
constexpr size_t WS_NEED = WS_END1 > WS_END2 ? WS_END1 : WS_END2;
static_assert(WS_NEED <= 615053344ull, "workspace budget (sum of the inputs)");

#define LAUNDER(v) asm volatile("" : "+v"(v))
__device__ __forceinline__ float bf2f(unsigned v) { return __uint_as_float(v << 16); }
__device__ __forceinline__ float bflo(unsigned w) { return __uint_as_float(w << 16); }
__device__ __forceinline__ float bfhi(unsigned w) { return __uint_as_float(w & 0xffff0000u); }
__device__ __forceinline__ bf16_t f2bf(float f) { return (bf16_t)(cvt_pk_bf16(f, 0.f) & 0xffffu); }
template <int M> __device__ __forceinline__ float xor_f(float v) { return __builtin_bit_cast(float, __builtin_amdgcn_ds_swizzle(__builtin_bit_cast(int, v), (M << 10) | 0x1f)); }
__device__ __forceinline__ float bperm_f(float v, int src_lane) { return __builtin_bit_cast(float, __builtin_amdgcn_ds_bpermute(src_lane << 2, __builtin_bit_cast(int, v))); }
__device__ __forceinline__ float wave_sum(float v) {
    v += xor_f<1>(v); v += xor_f<2>(v); v += xor_f<4>(v); v += xor_f<8>(v); v += xor_f<16>(v);
    return __builtin_bit_cast(float, __builtin_amdgcn_readlane(__builtin_bit_cast(int, v), 0)) + __builtin_bit_cast(float, __builtin_amdgcn_readlane(__builtin_bit_cast(int, v), 32));
}
__device__ __forceinline__ float sigmoidf_(float x) { return __builtin_amdgcn_rcpf(1.f + __expf(-x)); }
__device__ __forceinline__ float siluf_(float x) { return x * sigmoidf_(x); }
__device__ __forceinline__ float gelu_tanh_(float x) { return x * sigmoidf_(1.5957691216057308f * (x + 0.044715f * x * x * x)); }
__device__ __forceinline__ float softplusf_(float z) { return fmaxf(z, 0.f) + __logf(1.f + __expf(-fabsf(z))); }

struct Order {
    int nM, nN, nwg, G, c, mode; const char* A; const char* Bt; size_t tstep, abr, bbr; const int* bmap;
    __device__ void init(const void* A_, const void* Bt_, int M, int N, int K, int G_, int c_, int mode_ = 0, size_t abr_ = 0, size_t bbr_ = 0, const int* bmap_ = nullptr) { bmap = bmap_;
        nM = M / 256; nN = N / 256; nwg = nM * nN; G = G_; c = c_; mode = mode_; A = (const char*)A_; Bt = (const char*)Bt_; tstep = (size_t)256 * K * 2; abr = abr_; bbr = bbr_; }
    __device__ bool next(int i, pg8::Unit& u) const {
        const long L = (long)i * G + c; if (L >= nwg) return false;
        int wgid = (int)L; { const int q = nwg / 8, r = nwg % 8, xcd = wgid % 8, off = wgid / 8; wgid = (xcd < r ? xcd * (q + 1) : r * (q + 1) + (xcd - r) * q) + off; }
        const int nig = 8 * nN, gid = wgid / nig, fm = gid * 8, gsz = (nM - fm) < 8 ? (nM - fm) : 8;
        u.pm = fm + ((wgid % nig) % gsz); u.pn = (wgid % nig) / gsz;
        if (mode == 0) { u.a = A + (size_t)u.pm * tstep; u.b = Bt + (size_t)u.pn * tstep; }
        else if (mode == 2) { const int ex = __hip_atomic_load(bmap + u.pm, __ATOMIC_RELAXED, __HIP_MEMORY_SCOPE_AGENT); u.a = A + (size_t)u.pm * tstep; u.b = Bt + (size_t)ex * bbr + (size_t)u.pn * tstep; }
        else { const int br = u.pn >> 2; u.a = A + (size_t)br * abr + (size_t)u.pm * tstep; u.b = Bt + (size_t)br * bbr + (size_t)(u.pn & 3) * tstep; }
        return true;
    }
    __device__ __forceinline__ void a_ready(const pg8::Unit&) const {}
    __device__ __forceinline__ void done(const pg8::Unit&) const {}
};

template <int ACT> __device__ __forceinline__ float act_(float x, float lb) {
    if (ACT == 1) return siluf_(x);
    if (ACT == 2) return __logf(lb + (1.f - lb) * sigmoidf_(x));
    if (ACT == 3) return gelu_tanh_(x);
    if (ACT == 4) return sigmoidf_(x);
    return x;
}
struct EpiAct {
    static constexpr bool PERM = true, AFTER_DRAIN = false;
    bf16_t* O; int ldc; const float* lb; int inproj;
    template <int ACT> __device__ __forceinline__ void run(const f32x4 (&acc)[2][2][4][2], const pg8::Unit& u, int wr, int wc, int fr, int fq) const {
        const int row0 = u.pm * 256 + wr * 64 + fr, col0 = u.pn * 256 + wc * 32 + 8 * fq;
        f32x4 lbv[2][2];
#pragma unroll
        for (int bj = 0; bj < 2; ++bj)
#pragma unroll
            for (int n = 0; n < 2; ++n) lbv[bj][n] = (ACT == 2) ? *(const f32x4*)(lb + (col0 - C_HF) + bj * 128 + 4 * n) : (f32x4){0.f, 0.f, 0.f, 0.f};
#pragma unroll
        for (int ai = 0; ai < 2; ++ai)
#pragma unroll
            for (int m = 0; m < 4; ++m) { bf16_t* rowp = O + (size_t)(row0 + ai * 128 + m * 16) * ldc + col0;
#pragma unroll
                for (int bj = 0; bj < 2; ++bj) { f32x4 v0 = acc[ai][bj][m][0], v1 = acc[ai][bj][m][1];
#pragma unroll
                    for (int i = 0; i < 4; ++i) { v0[i] = act_<ACT>(v0[i], lbv[bj][0][i]); v1[i] = act_<ACT>(v1[i], lbv[bj][1][i]); }
                    u32x4 w; w.x = cvt_pk_bf16(v0[0], v0[1]); w.y = cvt_pk_bf16(v0[2], v0[3]); w.z = cvt_pk_bf16(v1[0], v1[1]); w.w = cvt_pk_bf16(v1[2], v1[3]);
                    *(u32x4*)(rowp + bj * 128) = w; } }
    }
    __device__ __forceinline__ void operator()(const f32x4 (&acc)[2][2][4][2], const pg8::Unit& u, int wr, int wc, int fr, int fq) const {
        if (!inproj) { run<4>(acc, u, wr, wc, fr, fq); return; }
        const int kind = u.pn >> 1;
        if (kind == 0 || kind == 3) run<1>(acc, u, wr, wc, fr, fq);
        else if (kind == 1) run<2>(acc, u, wr, wc, fr, fq);
        else if (kind == 4 || kind == 5) run<3>(acc, u, wr, wc, fr, fq);
        else run<0>(acc, u, wr, wc, fr, fq);
    }
};
struct EpiBranch {
    static constexpr bool PERM = true, AFTER_DRAIN = false;
    bf16_t* GH;
    __device__ __forceinline__ void operator()(const f32x4 (&acc)[2][2][4][2], const pg8::Unit& u, int wr, int wc, int fr, int fq) const {
        const int row0 = u.pm * 256 + wr * 64 + fr, col0 = u.pn * 256 + wc * 32 + 8 * fq;
#pragma unroll
        for (int ai = 0; ai < 2; ++ai)
#pragma unroll
            for (int m = 0; m < 4; ++m) { bf16_t* rowp = GH + (size_t)(row0 + ai * 128 + m * 16) * GCOLS + col0;
#pragma unroll
                for (int bj = 0; bj < 2; ++bj) { const f32x4 v0 = acc[ai][bj][m][0], v1 = acc[ai][bj][m][1];
                    const u32x4 g = *(const u32x4*)(rowp + bj * 128); u32x4 w;
                    w.x = cvt_pk_bf16(v0[0] * bflo(g.x), v0[1] * bfhi(g.x)); w.y = cvt_pk_bf16(v0[2] * bflo(g.y), v0[3] * bfhi(g.y));
                    w.z = cvt_pk_bf16(v1[0] * bflo(g.z), v1[1] * bfhi(g.z)); w.w = cvt_pk_bf16(v1[2] * bflo(g.w), v1[3] * bfhi(g.w));
                    *(u32x4*)(rowp + bj * 128) = w; } }
    }
};
struct EpiResid {
    static constexpr bool PERM = false, AFTER_DRAIN = false;
    const float* xin; float* xout;
    __device__ __forceinline__ void operator()(const f32x4 (&acc)[2][2][4][2], const pg8::Unit& u, int wr, int wc, int fr, int fq) const {
        const int row0 = u.pm * 256 + wr * 64 + fr, col0 = u.pn * 256 + wc * 32 + 4 * fq;
#pragma unroll
        for (int ai = 0; ai < 2; ++ai)
#pragma unroll
            for (int m = 0; m < 4; ++m) { const size_t ro = (size_t)(row0 + ai * 128 + m * 16) * D + col0;
#pragma unroll
                for (int bj = 0; bj < 2; ++bj)
#pragma unroll
                    for (int n = 0; n < 2; ++n) *(f32x4*)(xout + ro + bj * 128 + n * 16) = *(const f32x4*)(xin + ro + bj * 128 + n * 16) + acc[ai][bj][m][n]; }
    }
};
struct EpiGU {
    static constexpr bool PERM = true, AFTER_DRAIN = false;
    bf16_t* H;
    __device__ __forceinline__ void operator()(const f32x4 (&acc)[2][2][4][2], const pg8::Unit& u, int wr, int wc, int fr, int fq) const {
        const int row0 = u.pm * 256 + wr * 64 + fr, col0 = u.pn * 128 + wc * 32 + 8 * fq;
#pragma unroll
        for (int ai = 0; ai < 2; ++ai)
#pragma unroll
            for (int m = 0; m < 4; ++m) { bf16_t* rowp = H + (size_t)(row0 + ai * 128 + m * 16) * DFF + col0;
                const f32x4 g0 = acc[ai][0][m][0], g1 = acc[ai][0][m][1], u0 = acc[ai][1][m][0], u1 = acc[ai][1][m][1]; u32x4 w;
                w.x = cvt_pk_bf16(siluf_(g0[0]) * u0[0], siluf_(g0[1]) * u0[1]); w.y = cvt_pk_bf16(siluf_(g0[2]) * u0[2], siluf_(g0[3]) * u0[3]);
                w.z = cvt_pk_bf16(siluf_(g1[0]) * u1[0], siluf_(g1[1]) * u1[1]); w.w = cvt_pk_bf16(siluf_(g1[2]) * u1[2], siluf_(g1[3]) * u1[3]);
                *(u32x4*)rowp = w; }
    }
};
struct EpiMoeDown {
    static constexpr bool PERM = false, AFTER_DRAIN = false;
    float* out; const int* stok; const float* sw;
    __device__ __forceinline__ void operator()(const f32x4 (&acc)[2][2][4][2], const pg8::Unit& u, int wr, int wc, int fr, int fq) const {
        const int row0 = u.pm * 256 + wr * 64 + fr, col0 = u.pn * 256 + wc * 32 + 4 * fq;
#pragma unroll
        for (int ai = 0; ai < 2; ++ai)
#pragma unroll
            for (int m = 0; m < 4; ++m) { const int rl = row0 + ai * 128 + m * 16; const int tok = stok[rl]; const float w = sw[rl];
                if (tok >= 0) { float* rp = out + (size_t)tok * D + col0;
#pragma unroll
                    for (int bj = 0; bj < 2; ++bj)
#pragma unroll
                        for (int n = 0; n < 2; ++n) { f32x4 o = *(const f32x4*)(rp + bj * 128 + n * 16); o = o + acc[ai][bj][m][n] * w; *(f32x4*)(rp + bj * 128 + n * 16) = o; } } }
    }
};

__device__ void tc_job(const float* __restrict__ src, int K, int N, bf16_t* dst, int mode, int perm, LAS float* tile, int wg, int G, int tid) {
    LAUNDER(tid);
    const int tn = N / 64, nt = (K / 64) * tn;
    for (int t = wg; t < nt; t += G) {
        const int k0 = (t / tn) * 64, n0 = (t % tn) * 64;
#pragma unroll
        for (int ps = 0; ps < 2; ++ps) { const int r = (tid >> 4) + ps * 32; const float4 v = *(const float4*)(src + (size_t)(k0 + r) * N + n0 + (tid & 15) * 4);
            LAS float* tp = tile + r * 65 + (tid & 15) * 4; tp[0] = v.x; tp[1] = v.y; tp[2] = v.z; tp[3] = v.w; }
        __syncthreads();
        { const int n = tid >> 3, kg = (tid & 7) * 8; unsigned w[4];
#pragma unroll
          for (int j = 0; j < 4; ++j) w[j] = cvt_pk_bf16(tile[(kg + 2 * j) * 65 + n], tile[(kg + 2 * j + 1) * 65 + n]);
          const int nn = n0 + n; int drow = mode == 0 ? nn : ((nn >> 7) * 256 + (nn & 127) + (mode == 2 ? 128 : 0));
          if (perm) { const int c5 = drow & 31; drow = (drow & ~31) + 16 * ((c5 >> 2) & 1) + 4 * (c5 >> 3) + (c5 & 3); }
          *(uint4*)(dst + (size_t)drow * K + k0 + kg) = make_uint4(w[0], w[1], w[2], w[3]); }
        __syncthreads();
    }
}

template <bool ROUTER>
__device__ void phase_rmsnorm(const float* __restrict__ x, const float* __restrict__ gain, bf16_t* xn, const float* __restrict__ rw, const float* __restrict__ rb,
                              int* toke, float2* tokw, int wg, int G, int wid, int lane) {
    LAUNDER(lane);
    for (int row = wg * NWAVES + wid; row < MTOK; row += G * NWAVES) {
        const float* xr = x + (size_t)row * D; float4 v[4]; float ss = 0.f;
#pragma unroll
        for (int j = 0; j < 4; ++j) { v[j] = *(const float4*)(xr + j * 256 + lane * 4); ss += v[j].x * v[j].x + v[j].y * v[j].y + v[j].z * v[j].z + v[j].w * v[j].w; }
        ss = wave_sum(ss);
        const float rstd = rsqrtf(ss * (1.f / D) + EPS);
        float lg[NEXP];
#pragma unroll
        for (int e = 0; e < NEXP; ++e) lg[e] = 0.f;
#pragma unroll
        for (int j = 0; j < 4; ++j) { const float4 g = *(const float4*)(gain + j * 256 + lane * 4);
            const float y0 = v[j].x * rstd * g.x, y1 = v[j].y * rstd * g.y, y2 = v[j].z * rstd * g.z, y3 = v[j].w * rstd * g.w;
            *(uint2*)(xn + (size_t)row * D + j * 256 + lane * 4) = make_uint2(cvt_pk_bf16(y0, y1), cvt_pk_bf16(y2, y3));
            if (ROUTER) { const float ys[4] = {y0, y1, y2, y3};
#pragma unroll
                for (int i = 0; i < 4; ++i) { const float* wr_ = rw + (size_t)(j * 256 + lane * 4 + i) * NEXP; const float4 wa = *(const float4*)wr_, wb = *(const float4*)(wr_ + 4);
                    lg[0] += ys[i] * wa.x; lg[1] += ys[i] * wa.y; lg[2] += ys[i] * wa.z; lg[3] += ys[i] * wa.w; lg[4] += ys[i] * wb.x; lg[5] += ys[i] * wb.y; lg[6] += ys[i] * wb.z; lg[7] += ys[i] * wb.w; } } }
        if (ROUTER) {
#pragma unroll
            for (int e = 0; e < NEXP; ++e) lg[e] = wave_sum(lg[e]) + rb[e];
            int i0 = 0; float l0 = lg[0];
#pragma unroll
            for (int e = 1; e < NEXP; ++e) if (lg[e] > l0) { l0 = lg[e]; i0 = e; }
            int i1 = -1; float l1 = -3.4e38f;
#pragma unroll
            for (int e = 0; e < NEXP; ++e) if (e != i0 && lg[e] > l1) { l1 = lg[e]; i1 = e; }
            const float w0 = __builtin_amdgcn_rcpf(1.f + __expf(l1 - l0));
            if (lane == 0) { toke[row] = i0 | (i1 << 8); tokw[row] = make_float2(w0, 1.f - w0); }
        }
    }
}

__device__ void phase_combine(const bf16_t* GH, bf16_t* mix, int wg, int G, int tid) {
    LAUNDER(tid);
    for (size_t v = (size_t)wg * NTHREADS + tid; v < (size_t)MTOK * (D / 8); v += (size_t)G * NTHREADS) {
        const size_t r = v / (D / 8); const int c = (int)(v % (D / 8)) * 8; const bf16_t* gp = GH + r * GCOLS + c;
        const uint4 a = *(const uint4*)gp, b = *(const uint4*)(gp + 1024), cc = *(const uint4*)(gp + 2048); uint4 o;
        o.x = cvt_pk_bf16(bflo(a.x) + bflo(b.x) + bflo(cc.x), bfhi(a.x) + bfhi(b.x) + bfhi(cc.x));
        o.y = cvt_pk_bf16(bflo(a.y) + bflo(b.y) + bflo(cc.y), bfhi(a.y) + bfhi(b.y) + bfhi(cc.y));
        o.z = cvt_pk_bf16(bflo(a.z) + bflo(b.z) + bflo(cc.z), bfhi(a.z) + bfhi(b.z) + bfhi(cc.z));
        o.w = cvt_pk_bf16(bflo(a.w) + bflo(b.w) + bflo(cc.w), bfhi(a.w) + bfhi(b.w) + bfhi(cc.w));
        *(uint4*)(mix + r * D + c) = o;
    }
}

__device__ void moe_assign(const int* toke, const float2* tokw, int* meta, int* stok, float* sw, int* blke, LAS unsigned char* lds, int tid) {
    LAUNDER(tid);
    LAS int* cnt = (LAS int*)lds;
    LAS int* tot = cnt + 512 * 16;
    int c[16];
#pragma unroll
    for (int j = 0; j < 16; ++j) c[j] = 0;
    const int t0 = tid * (MTOK / NTHREADS);
    for (int i = 0; i < MTOK / NTHREADS; ++i) { const int ee = toke[t0 + i]; const int e0 = ee & 255, e1 = 8 + ((ee >> 8) & 255);
#pragma unroll
        for (int j = 0; j < 16; ++j) c[j] += (e0 == j) + (e1 == j); }
#pragma unroll
    for (int j = 0; j < 16; ++j) cnt[tid * 16 + j] = c[j];
    __syncthreads();
    if (tid < 16) { int run = 0; for (int i = 0; i < NTHREADS; ++i) { const int v = cnt[i * 16 + tid]; cnt[i * 16 + tid] = run; run += v; } tot[tid] = run; }
    __syncthreads();
    if (tid == 0) { int run = 0; for (int j = 0; j < 16; ++j) { const int n = tot[j], pad = (n + 255) & ~255; tot[16 + j] = run; if (j == 8) { meta[0] = run; meta[3] = run; } run += pad; } meta[1] = run - tot[16 + 8]; meta[2] = 0; meta[4] = run; }
    __syncthreads();
    for (int bk = tid; bk < 2 * MOE_MAXBLK; bk += NTHREADS) { int ex = 0;
        for (int j = 0; j < 16; ++j) { const int base = tot[16 + j], pad = (tot[j] + 255) & ~255; if (bk * 256 >= base && bk * 256 < base + pad) ex = j & 7; }
        blke[bk] = ex; }
    int pos[16];
#pragma unroll
    for (int j = 0; j < 16; ++j) pos[j] = tot[16 + j] + cnt[tid * 16 + j];
    for (int i = 0; i < MTOK / NTHREADS; ++i) { const int tk = t0 + i; const int ee = toke[tk]; const int e0 = ee & 255, e1 = 8 + ((ee >> 8) & 255); const float2 w = tokw[tk];
        int p0 = 0, p1 = 0;
#pragma unroll
        for (int j = 0; j < 16; ++j) { if (e0 == j) { p0 = pos[j]; pos[j]++; } if (e1 == j) { p1 = pos[j]; pos[j]++; } }
        stok[p0] = tk; sw[p0] = w.x; stok[p1] = tk; sw[p1] = w.y; }
    for (int j = 0; j < 16; ++j) { const int n = tot[j], pad = (n + 255) & ~255, base = tot[16 + j]; for (int i = n + tid; i < pad; i += NTHREADS) { stok[base + i] = -1; sw[base + i] = 0.f; } }
}
__device__ void moe_gather(const bf16_t* xn, const int* stok, int rows, bf16_t* xs, int wg, int G, int wid, int lane) {
    LAUNDER(lane);
    for (int r = wg * NWAVES + wid; r < rows; r += G * NWAVES) { const int tok = __hip_atomic_load(stok + r, __ATOMIC_RELAXED, __HIP_MEMORY_SCOPE_AGENT);
        uint4 a = make_uint4(0, 0, 0, 0), b = a;
        if (tok >= 0) { const uint4* sp = (const uint4*)(xn + (size_t)tok * D) + lane * 2; a = sp[0]; b = sp[1]; }
        uint4* dp = (uint4*)(xs + (size_t)r * D) + lane * 2; dp[0] = a; dp[1] = b; }
}

typedef pg8::bf16x8 bf16x8;
typedef unsigned u32x2 __attribute__((ext_vector_type(2)));
#define MFMA16(A, B, C) __builtin_amdgcn_mfma_f32_16x16x32_bf16((A), (B), (C), 0, 0, 0)
__device__ __forceinline__ bf16x8 mk8(unsigned a, unsigned b, unsigned c, unsigned d) { u32x4 v = {a, b, c, d}; return __builtin_bit_cast(bf16x8, v); }

constexpr int H_QD = 0, H_KD = 8704, H_KB = 17408, H_QG = 21760, H_KET = 30464, H_VT = 40704, H_PM = 50944, H_TP = 53504, H_GE = 55552;
constexpr size_t HG_DUMP_BYTES = (size_t)MTOK * 512 * 2, HG_U_BYTES = (size_t)256 * 128 * 128 * 4;
__device__ void phase_hgrn_a(const bf16_t* P, bf16_t* qsc  , uint2* dump, float* U, float* Dsc, LAS unsigned char* lds, int wg, int G, int tid, int wid, int lane) {
    LAUNDER(tid); LAUNDER(lane);
    const int d = tid & 127, part = tid >> 7, g = lane >> 4, c16 = lane & 15;
    LAS float* TP = (LAS float*)(lds + H_TP); LAS float* GE = (LAS float*)(lds + H_GE);
    for (int item = wg; item < 256; item += G) {
        const int b = item >> 6, h = (item >> 4) & 3, sc = item & 15; const size_t tok0 = (size_t)b * SEQ + (size_t)sc * 512;
        f32x4 S[8];
#pragma unroll
        for (int i = 0; i < 8; ++i) S[i] = (f32x4){0.f, 0.f, 0.f, 0.f};
        float gsc = 0.f;
        unsigned lfv[8], qv[8], vv[8];
        { const bf16_t* base = P + (tok0 + 8 * part) * PCOLS + h * 128 + d;
#pragma unroll
          for (int j = 0; j < 8; ++j) { lfv[j] = base[(size_t)j * PCOLS + C_HF]; qv[j] = base[(size_t)j * PCOLS + C_HQ]; vv[j] = base[(size_t)j * PCOLS + C_HI]; } }
        for (int c = 0; c < 16; ++c) {
            float gl[8], lf[8], qf[8]; unsigned vb[8]; float run = 0.f;
#pragma unroll
            for (int j = 0; j < 8; ++j) { lf[j] = bf2f(lfv[j]); qf[j] = bf2f(qv[j]); vb[j] = vv[j]; run += lf[j]; gl[j] = run; }
            if (c < 15) { const bf16_t* base = P + (tok0 + (c + 1) * 32 + 8 * part) * PCOLS + h * 128 + d;
#pragma unroll
                for (int j = 0; j < 8; ++j) { lfv[j] = base[(size_t)j * PCOLS + C_HF]; qv[j] = base[(size_t)j * PCOLS + C_HQ]; vv[j] = base[(size_t)j * PCOLS + C_HI]; } }
            TP[part * 128 + d] = run;
            __syncthreads();
            const float t0 = TP[d], t1 = TP[128 + d], t2 = TP[256 + d], t3 = TP[384 + d];
            const float T0 = t0 + t1, gend = T0 + t2 + t3;
            const float pre = (part == 1) ? t0 : (part == 3) ? t2 : 0.f, gb = (part >> 1) ? T0 : 0.f;
            unsigned kep[4];
#pragma unroll
            for (int j = 0; j < 8; j += 2) {
                float ke2[2];
#pragma unroll
                for (int jj = 0; jj < 2; ++jj) { const int t = 8 * part + j + jj; const float Gl = pre + gl[j + jj], Gt = gb + Gl; const float k = 1.f - __expf(lf[j + jj]), q = qf[j + jj];
                    *(LAS bf16_t*)(lds + H_QD + t * 272 + d * 2) = f2bf(q * __expf(Gl));
                    *(LAS bf16_t*)(lds + H_KD + t * 272 + d * 2) = f2bf(k * __expf(fminf(-Gl, 80.f)));
                    if (part < 2) *(LAS bf16_t*)(lds + H_KB + t * 272 + d * 2) = f2bf(k * __expf(T0 - Gl));
                    *(LAS bf16_t*)(lds + H_QG + t * 272 + d * 2) = f2bf(q * __expf(Gt));
                    qsc[(tok0 + c * 32 + t) * 512 + h * 128 + d] = f2bf(q * __expf(gsc + Gt));
                    ke2[jj] = k * __expf(gend - Gt); }
                kep[j >> 1] = cvt_pk_bf16(ke2[0], ke2[1]); }
            *(LAS u32x4*)(lds + H_KET + d * 80 + part * 16) = (u32x4){kep[0], kep[1], kep[2], kep[3]};
            *(LAS u32x4*)(lds + H_VT + d * 80 + part * 16) = (u32x4){vb[0] | (vb[1] << 16), vb[2] | (vb[3] << 16), vb[4] | (vb[5] << 16), vb[6] | (vb[7] << 16)};
            if (part == 0) GE[d] = __expf(gend);
            gsc += gend;
            __syncthreads();
            if (wid < 3) { const int I = (wid == 0) ? 0 : 1, J = (wid == 2) ? 0 : I; f32x4 acc = {0.f, 0.f, 0.f, 0.f};
#pragma unroll
                for (int kk = 0; kk < 4; ++kk) { const bf16x8 A = *(const LAS bf16x8*)(lds + H_QD + (16 * I + c16) * 272 + kk * 64 + g * 16);
                    const bf16x8 B = (wid == 2) ? *(const LAS bf16x8*)(lds + H_KB + c16 * 272 + kk * 64 + g * 16) : *(const LAS bf16x8*)(lds + H_KD + (16 * J + c16) * 272 + kk * 64 + g * 16);
                    acc = MFMA16(A, B, acc); }
#pragma unroll
                for (int r = 0; r < 4; ++r) { const int t = 4 * g + r; const float v = (I == J && c16 > t) ? 0.f : acc[r]; *(LAS bf16_t*)(lds + H_PM + (16 * I + t) * 80 + (16 * J + c16) * 2) = f2bf(v); }
            } else if (wid == 3) {
#pragma unroll
                for (int r = 0; r < 4; ++r) *(LAS bf16_t*)(lds + H_PM + (4 * g + r) * 80 + (16 + c16) * 2) = (bf16_t)0;
            }
            __syncthreads();
            { const bf16x8 Bv = *(const LAS bf16x8*)(lds + H_VT + (16 * wid + c16) * 80 + g * 16);
              unsigned sp[8][2];
#pragma unroll
              for (int i = 0; i < 8; ++i) { sp[i][0] = cvt_pk_bf16(S[i][0], S[i][1]); sp[i][1] = cvt_pk_bf16(S[i][2], S[i][3]); }
              const size_t chunk_g = (tok0 >> 5) + c;
#pragma unroll
              for (int rt = 0; rt < 2; ++rt) { f32x4 o = {0.f, 0.f, 0.f, 0.f};
                  o = MFMA16(*(const LAS bf16x8*)(lds + H_PM + (16 * rt + c16) * 80 + g * 16), Bv, o);
#pragma unroll
                  for (int kk = 0; kk < 4; ++kk) { const LAS unsigned char* qp = lds + H_QG + (16 * rt + c16) * 272 + (32 * kk + 4 * g) * 2;
                      const u32x2 lo = *(const LAS u32x2*)qp, hi = *(const LAS u32x2*)(qp + 32);
                      o = MFMA16(mk8(lo.x, lo.y, hi.x, hi.y), mk8(sp[2 * kk][0], sp[2 * kk][1], sp[2 * kk + 1][0], sp[2 * kk + 1][1]), o); }
                  dump[(((chunk_g * 4 + h) * 2 + rt) * 8 + wid) * 64 + lane] = make_uint2(cvt_pk_bf16(o[0], o[1]), cvt_pk_bf16(o[2], o[3])); }
#pragma unroll
              for (int i = 0; i < 8; ++i) { const f32x4 dec = *(const LAS f32x4*)(lds + H_GE + (16 * i + 4 * g) * 4); S[i] = S[i] * dec;
                  S[i] = MFMA16(*(const LAS bf16x8*)(lds + H_KET + (16 * i + c16) * 80 + g * 16), Bv, S[i]); } }
            __syncthreads();
        }
#pragma unroll
        for (int i = 0; i < 8; ++i)
#pragma unroll
            for (int r = 0; r < 4; ++r) U[((size_t)item * 128 + 16 * i + 4 * g + r) * 128 + 16 * wid + c16] = S[i][r];
        if (part == 0) Dsc[item * 128 + d] = __expf(gsc);
    }
}
constexpr int HC_SIN = 0;
__device__ void phase_hgrn_c(const bf16_t* P, bf16_t* qoa  , const uint2* dump, const float* U, const float* Dsc, const float* gain, LAS unsigned char* lds, int wg, int G, int tid, int wid, int lane) {
    LAUNDER(tid); LAUNDER(lane);
    const int g = lane >> 4, c16 = lane & 15;
    for (int item = wg; item < 256; item += G) {
        const int b = item >> 6, h = (item >> 4) & 3, sc = item & 15; const size_t tok0 = (size_t)b * SEQ + (size_t)sc * 512;
#pragma unroll 1
        for (int kq = 0; kq < 4; ++kq) { float s[8];
#pragma unroll
          for (int k = 0; k < 8; ++k) s[k] = 0.f;
#pragma unroll 1
          for (int j = 0; j < sc; ++j) { const size_t it = (size_t)(item - sc + j);
#pragma unroll
              for (int k = 0; k < 8; ++k) { const int e = tid + 512 * (kq * 8 + k); s[k] = Dsc[it * 128 + (e >> 7)] * s[k] + U[it * 16384 + e]; } }
#pragma unroll
          for (int k = 0; k < 8; ++k) { const int e = tid + 512 * (kq * 8 + k); *(LAS bf16_t*)(lds + HC_SIN + (e & 127) * 272 + (e >> 7) * 2) = f2bf(s[k]); } }
        __syncthreads();
#pragma unroll 1
        for (int rtile = 0; rtile < 4; ++rtile) {
            const size_t row0 = tok0 + 64 * wid + 16 * rtile; const size_t chunk_g = (tok0 >> 5) + 2 * wid + (rtile >> 1); const int rt = rtile & 1;
            bf16x8 A[4];
#pragma unroll
            for (int kk = 0; kk < 4; ++kk) A[kk] = *(const bf16x8*)(qoa + (row0 + c16) * 512 + h * 128 + 32 * kk + 8 * g);
            f32x4 acc[8]; float ss[4] = {0.f, 0.f, 0.f, 0.f};
#pragma unroll
            for (int vt = 0; vt < 8; ++vt) { acc[vt] = (f32x4){0.f, 0.f, 0.f, 0.f};
#pragma unroll
                for (int kk = 0; kk < 4; ++kk) acc[vt] = MFMA16(A[kk], *(const LAS bf16x8*)(lds + HC_SIN + (16 * vt + c16) * 272 + (32 * kk + 8 * g) * 2), acc[vt]);
                const uint2 ol = dump[(((chunk_g * 4 + h) * 2 + rt) * 8 + vt) * 64 + lane];
                acc[vt][0] += bflo(ol.x); acc[vt][1] += bfhi(ol.x); acc[vt][2] += bflo(ol.y); acc[vt][3] += bfhi(ol.y);
#pragma unroll
                for (int r = 0; r < 4; ++r) ss[r] += acc[vt][r] * acc[vt][r]; }
            float rstd[4];
#pragma unroll
            for (int r = 0; r < 4; ++r) { float s = ss[r]; s += xor_f<1>(s); s += xor_f<2>(s); s += xor_f<4>(s); s += xor_f<8>(s); rstd[r] = rsqrtf(s * (1.f / 128.f) + EPS); }
#pragma unroll
            for (int vt = 0; vt < 8; ++vt) { const float gn = gain[16 * vt + c16];
#pragma unroll
                for (int r = 0; r < 4; ++r) { const size_t row = row0 + 4 * g + r; const float hg = bf2f(P[row * PCOLS + C_HG + h * 128 + 16 * vt + c16]);
                    qoa[row * 512 + h * 128 + 16 * vt + c16] = f2bf(acc[vt][r] * rstd[r] * gn * hg); } }
        }
        __syncthreads();
    }
}

constexpr int GM_VT = 0, GM_W = 34816, GM_RS = 69632;
__device__ void phase_gmlp(const bf16_t* P, const float* __restrict__ ws_l, const float* __restrict__ bs_l, const float* __restrict__ gv_l, bf16_t* ob, LAS unsigned char* lds, int wg, int G, int tid, int wid, int lane) {
    LAUNDER(tid); LAUNDER(lane);
    const int g = lane >> 4, c16 = lane & 15; LAS float* RS = (LAS float*)(lds + GM_RS);
    for (int item = wg; item < MTOK / 128; item += G) {
        const size_t tok0 = (size_t)item * 128;
        { const int s = tid >> 2, qd = tid & 3; const bf16_t* rp = P + (tok0 + s) * PCOLS + C_GV + qd * 128; float ss = 0.f;
#pragma unroll
          for (int j = 0; j < 16; ++j) { const uint4 x = *(const uint4*)(rp + j * 8); ss += bflo(x.x) * bflo(x.x) + bfhi(x.x) * bfhi(x.x) + bflo(x.y) * bflo(x.y) + bfhi(x.y) * bfhi(x.y) + bflo(x.z) * bflo(x.z) + bfhi(x.z) * bfhi(x.z) + bflo(x.w) * bflo(x.w) + bfhi(x.w) * bfhi(x.w); }
          ss += xor_f<1>(ss); ss += xor_f<2>(ss); if (qd == 0) RS[s] = rsqrtf(ss * (1.f / 512.f) + EPS); }
        for (int grp = 0; grp < 4; ++grp) {
            __syncthreads();
#pragma unroll
            for (int ps = 0; ps < 4; ++ps) { const int idx = tid + ps * 512, s = idx >> 4, c8 = (idx & 15) * 8; const uint4 x = *(const uint4*)(P + (tok0 + s) * PCOLS + C_GV + grp * 128 + c8);
                const float rs = RS[s]; const float4 ga = *(const float4*)(gv_l + grp * 128 + c8), gb = *(const float4*)(gv_l + grp * 128 + c8 + 4);
                const float e[8] = {bflo(x.x) * rs * ga.x, bfhi(x.x) * rs * ga.y, bflo(x.y) * rs * ga.z, bfhi(x.y) * rs * ga.w, bflo(x.z) * rs * gb.x, bfhi(x.z) * rs * gb.y, bflo(x.w) * rs * gb.z, bfhi(x.w) * rs * gb.w};
#pragma unroll
                for (int i = 0; i < 8; ++i) *(LAS bf16_t*)(lds + GM_VT + (c8 + i) * 272 + s * 2) = f2bf(e[i]);
                const int t = idx >> 4, s8 = (idx & 15) * 8; const float4 wa = *(const float4*)(ws_l + (size_t)grp * 16384 + t * 128 + s8), wb = *(const float4*)(ws_l + (size_t)grp * 16384 + t * 128 + s8 + 4);
                *(LAS u32x4*)(lds + GM_W + t * 272 + s8 * 2) = (u32x4){cvt_pk_bf16(s8 + 0 <= t ? wa.x : 0.f, s8 + 1 <= t ? wa.y : 0.f), cvt_pk_bf16(s8 + 2 <= t ? wa.z : 0.f, s8 + 3 <= t ? wa.w : 0.f),
                                                                    cvt_pk_bf16(s8 + 4 <= t ? wb.x : 0.f, s8 + 5 <= t ? wb.y : 0.f), cvt_pk_bf16(s8 + 6 <= t ? wb.z : 0.f, s8 + 7 <= t ? wb.w : 0.f)}; }
            __syncthreads();
            f32x4 acc[8];
#pragma unroll
            for (int ct = 0; ct < 8; ++ct) acc[ct] = (f32x4){0.f, 0.f, 0.f, 0.f};
            for (int kk = 0; kk <= (wid >> 1); ++kk) { const bf16x8 A = *(const LAS bf16x8*)(lds + GM_W + (16 * wid + c16) * 272 + kk * 64 + g * 16);
#pragma unroll
                for (int ct = 0; ct < 8; ++ct) acc[ct] = MFMA16(A, *(const LAS bf16x8*)(lds + GM_VT + (16 * ct + c16) * 272 + kk * 64 + g * 16), acc[ct]); }
#pragma unroll
            for (int r = 0; r < 4; ++r) { const int t = 16 * wid + 4 * g + r; const float bias = bs_l[grp * 128 + t]; const size_t tok = tok0 + t;
#pragma unroll
                for (int ct = 0; ct < 8; ++ct) { const int ch = grp * 128 + 16 * ct + c16; ob[tok * 512 + ch] = f2bf(bf2f(P[tok * PCOLS + C_GU + ch]) * (acc[ct][r] + bias)); } }
        }
        __syncthreads();
    }
}

constexpr int AT_KL = 0, AT_VT = 9216, AT_MIN = 9216 + 64 * 136;
__device__ void phase_attn(const bf16_t* P, const float* __restrict__ gq, const float* __restrict__ gk, bf16_t* oc, LAS unsigned char* lds, int wg, int G, int tid, int wid, int lane) {
    LAUNDER(tid); LAUNDER(lane);
    const int g = lane >> 4, c16 = lane & 15; LAS float* MINW = (LAS float*)(lds + AT_MIN);
    const unsigned ONES = 0x3F803F80u;
    const unsigned tri_lo = ((4 * g + 0 >= c16) ? 0x3F80u : 0u) | ((4 * g + 1 >= c16) ? 0x3F800000u : 0u), tri_hi = ((4 * g + 2 >= c16) ? 0x3F80u : 0u) | ((4 * g + 3 >= c16) ? 0x3F800000u : 0u);
    for (int item = wg; item < NB * 8 * (SEQ / 128); item += G) {
        const int qt = item & 63, h = (item >> 6) & 7, b = item >> 9; const int t0 = qt * 128, tq0 = t0 + 16 * wid, t = tq0 + c16; const size_t tokb = (size_t)b * SEQ;
        bf16x8 Bq[2];
        { const bf16_t* qp = P + (tokb + t) * PCOLS + C_SQ + h * 64; const uint4 x0 = *(const uint4*)(qp + 8 * g), x1 = *(const uint4*)(qp + 32 + 8 * g);
          float e[16] = {bflo(x0.x), bfhi(x0.x), bflo(x0.y), bfhi(x0.y), bflo(x0.z), bfhi(x0.z), bflo(x0.w), bfhi(x0.w), bflo(x1.x), bfhi(x1.x), bflo(x1.y), bfhi(x1.y), bflo(x1.z), bfhi(x1.z), bflo(x1.w), bfhi(x1.w)};
          float ss = 0.f;
#pragma unroll
          for (int i = 0; i < 16; ++i) ss += e[i] * e[i];
          ss += xor_f<16>(ss); ss += bperm_f(ss, lane ^ 32);
          const float rq = rsqrtf(ss * (1.f / 64.f) + EPS) * 0.125f;
#pragma unroll
          for (int i = 0; i < 16; ++i) { const int dd = (i < 8 ? 8 * g + i : 32 + 8 * g + (i - 8)); e[i] = e[i] * rq * gq[dd] * gk[dd]; }
          Bq[0] = mk8(cvt_pk_bf16(e[0], e[1]), cvt_pk_bf16(e[2], e[3]), cvt_pk_bf16(e[4], e[5]), cvt_pk_bf16(e[6], e[7]));
          Bq[1] = mk8(cvt_pk_bf16(e[8], e[9]), cvt_pk_bf16(e[10], e[11]), cvt_pk_bf16(e[12], e[13]), cvt_pk_bf16(e[14], e[15])); }
        f32x4 O[4];
#pragma unroll
        for (int i = 0; i < 4; ++i) O[i] = (f32x4){0.f, 0.f, 0.f, 0.f};
        float carry = 0.f;
        for (int kb = (t0 + 127) >> 6; kb >= 0; --kb) {
            const int sb0 = kb * 64;
            __syncthreads();
            { const int s = tid >> 3, pc = tid & 7; const bf16_t* rp = P + (tokb + sb0 + s) * PCOLS + h * 64 + pc * 8;
              const uint4 kx = *(const uint4*)(rp + C_SK), vx = *(const uint4*)(rp + C_SV);
              float ke[8] = {bflo(kx.x), bfhi(kx.x), bflo(kx.y), bfhi(kx.y), bflo(kx.z), bfhi(kx.z), bflo(kx.w), bfhi(kx.w)}; float ssk = 0.f;
#pragma unroll
              for (int i = 0; i < 8; ++i) ssk += ke[i] * ke[i];
              ssk += xor_f<1>(ssk); ssk += xor_f<2>(ssk); ssk += xor_f<4>(ssk);
              const float rk = rsqrtf(ssk * (1.f / 64.f) + EPS);
              *(LAS u32x4*)(lds + AT_KL + s * 144 + pc * 16) = (u32x4){cvt_pk_bf16(ke[0] * rk, ke[1] * rk), cvt_pk_bf16(ke[2] * rk, ke[3] * rk), cvt_pk_bf16(ke[4] * rk, ke[5] * rk), cvt_pk_bf16(ke[6] * rk, ke[7] * rk)};
              const unsigned vw[4] = {vx.x, vx.y, vx.z, vx.w};
#pragma unroll
              for (int i = 0; i < 8; ++i) *(LAS bf16_t*)(lds + AT_VT + (pc * 8 + i) * 136 + s * 2) = (bf16_t)((vw[i >> 1] >> ((i & 1) * 16)) & 0xffffu); }
            __syncthreads();
            if (sb0 < tq0 + 15) {
                f32x4 z[4]; unsigned hi[4][2], lo[4][2];
#pragma unroll
                for (int st = 0; st < 4; ++st) { z[st] = (f32x4){0.f, 0.f, 0.f, 0.f};
#pragma unroll
                    for (int kk = 0; kk < 2; ++kk) z[st] = MFMA16(*(const LAS bf16x8*)(lds + AT_KL + (16 * st + c16) * 144 + kk * 64 + g * 16), Bq[kk], z[st]);
                    float spv[4];
#pragma unroll
                    for (int r = 0; r < 4; ++r) { const int s = sb0 + 16 * st + 4 * g + r; spv[r] = (s < t) ? softplusf_(z[st][r]) : 0.f; }
                    hi[st][0] = cvt_pk_bf16(spv[0], spv[1]); hi[st][1] = cvt_pk_bf16(spv[2], spv[3]);
                    lo[st][0] = cvt_pk_bf16(spv[0] - bflo(hi[st][0]), spv[1] - bfhi(hi[st][0])); lo[st][1] = cvt_pk_bf16(spv[2] - bflo(hi[st][1]), spv[3] - bfhi(hi[st][1])); }
                f32x4 sf[4];
#pragma unroll
                for (int so = 0; so < 4; ++so) { sf[so] = (f32x4){0.f, 0.f, 0.f, 0.f};
#pragma unroll
                    for (int kk = 0; kk < 2; ++kk) { if (2 * kk + 1 < so) continue;
                        const unsigned a0 = (2 * kk > so) ? ONES : (2 * kk == so) ? tri_lo : 0u, a1 = (2 * kk > so) ? ONES : (2 * kk == so) ? tri_hi : 0u;
                        const unsigned a2 = (2 * kk + 1 > so) ? ONES : tri_lo, a3 = (2 * kk + 1 > so) ? ONES : tri_hi;
                        const bf16x8 Lm = mk8(a0, a1, a2, a3);
                        sf[so] = MFMA16(Lm, mk8(hi[2 * kk][0], hi[2 * kk][1], hi[2 * kk + 1][0], hi[2 * kk + 1][1]), sf[so]);
                        sf[so] = MFMA16(Lm, mk8(lo[2 * kk][0], lo[2 * kk][1], lo[2 * kk + 1][0], lo[2 * kk + 1][1]), sf[so]); } }
                unsigned pa[4][2];
#pragma unroll
                for (int st = 0; st < 4; ++st) { float av[4];
#pragma unroll
                    for (int r = 0; r < 4; ++r) { const int s = sb0 + 16 * st + 4 * g + r; av[r] = (s < t) ? __expf(z[st][r] - carry - sf[st][r]) : 0.f; }
                    pa[st][0] = cvt_pk_bf16(av[0], av[1]); pa[st][1] = cvt_pk_bf16(av[2], av[3]); }
#pragma unroll
                for (int kk = 0; kk < 2; ++kk) { const bf16x8 Aop = mk8(pa[2 * kk][0], pa[2 * kk][1], pa[2 * kk + 1][0], pa[2 * kk + 1][1]);
#pragma unroll
                    for (int dt = 0; dt < 4; ++dt) { const LAS unsigned char* vp = lds + AT_VT + (16 * dt + c16) * 136 + (32 * kk + 4 * g) * 2; const u32x2 v0 = *(const LAS u32x2*)vp, v1 = *(const LAS u32x2*)(vp + 32);
                        O[dt] = MFMA16(Aop, mk8(v0.x, v0.y, v1.x, v1.y), O[dt]); } }
                carry += bperm_f(sf[0][0], c16);
            }
            float mn = carry; mn = fminf(mn, xor_f<1>(mn)); mn = fminf(mn, xor_f<2>(mn)); mn = fminf(mn, xor_f<4>(mn)); mn = fminf(mn, xor_f<8>(mn));
            if (lane == 0) MINW[wid] = mn;
            __syncthreads();
            float mall = MINW[0];
#pragma unroll
            for (int w = 1; w < 8; ++w) mall = fminf(mall, MINW[w]);
            if (mall > 104.f) break;
        }
#pragma unroll
        for (int dt = 0; dt < 4; ++dt)
#pragma unroll
            for (int r = 0; r < 4; ++r) oc[(tokb + tq0 + 4 * g + r) * 512 + h * 64 + 16 * dt + c16] = f2bf(O[dt][r]);
    }
}

#ifdef MK_CHECK
constexpr size_t WS_DIAG = WS_META + 2048;
constexpr size_t WS_SNAP = WS_BLKE + 4096;
static_assert(WS_SNAP + 64 * 1024 * 4 <= WS_W, "snapshot fits");
__device__ __forceinline__ int samp_row(int i) { return (int)(((unsigned)i * 2654435761u + 12345u) % (unsigned)MTOK); }
__device__ __forceinline__ void chk_fail(unsigned* diag, unsigned code) { atomicMin(diag, code); }
__device__ __forceinline__ bool chk_close(float got, float ref, float atol, float rtol) { return fabsf(got - ref) <= atol + rtol * fabsf(ref) && got == got; }

__global__ void k_diag_init(unsigned* diag) { if (threadIdx.x == 0 && blockIdx.x == 0) { diag[0] = 0xffffffffu; diag[16] = 0u; diag[17] = 0xffffffffu; diag[18] = 0u; diag[19] = 0u; diag[20] = 0u; diag[21] = 0u; diag[22] = 0u; diag[23] = 0u; diag[24] = 0u; diag[25] = 0u; diag[26] = 0u; } }
__global__ void k_snapshot(const float* x, float* snap) { const int i = blockIdx.x; const int r = samp_row(i); for (int c = threadIdx.x; c < D; c += blockDim.x) snap[i * D + c] = x[(size_t)r * D + c]; }
__global__ void k_apply_diag(float* out, const unsigned* diag) {
    if (blockIdx.x != 0 || threadIdx.x != 0) return;
    const unsigned code = diag[0]; if (code == 0xffffffffu) return;
    out[0] = (1.0f + 0.1f * (float)(code > 89u ? 89u : code)) * 1.0e6f;
}
struct ChkGemm { const bf16_t* A; int lda; const float* W; int ldw; int K; int mode; const bf16_t* Cb; int ldc; const float* Cf; const float* xold; const float* W2; const float* lb; const bf16_t* Gsrc; int ncols; unsigned code; int use_snap; };
__global__ void k_chk_gemm(ChkGemm c, unsigned* diag) {
    const int i = blockIdx.x; const int r = samp_row(i);
    for (int cc = threadIdx.x; cc < 96; cc += blockDim.x) {
        const int col = (int)(((unsigned)cc * 40503u + (unsigned)i * 977u) % (unsigned)c.ncols);
        float dot = 0.f, dot2 = 0.f;
        for (int k = 0; k < c.K; ++k) { const float av = bf2f(c.A[(size_t)r * c.lda + k]); dot += av * c.W[(size_t)k * c.ldw + col]; if (c.mode == 4) dot2 += av * c.W2[(size_t)k * c.ldw + col]; }
        float ref, got;
        if (c.mode == 0) { const int kind = col >> 9; ref = (kind == 0 || kind == 3) ? siluf_(dot) : kind == 1 ? __logf(c.lb[col - 512] + (1.f - c.lb[col - 512]) * sigmoidf_(dot)) : (kind == 4 || kind == 5) ? gelu_tanh_(dot) : dot; got = bf2f(c.Cb[(size_t)r * c.ldc + col]); }
        else if (c.mode == 1) { ref = sigmoidf_(dot); got = bf2f(c.Cb[(size_t)r * c.ldc + col]); }
        else if (c.mode == 3) { const float xo = c.use_snap ? c.xold[(size_t)i * D + col] : c.xold[(size_t)r * D + col]; ref = xo + dot; got = c.Cf[(size_t)r * D + col]; }
        else { ref = siluf_(dot) * dot2; got = bf2f(c.Cb[(size_t)r * c.ldc + col]); }
        if (!chk_close(got, ref, 0.03f, 0.03f)) { chk_fail(diag, c.code); if (c.mode == 1) { atomicOr(diag + 24 + (i >> 5), 1u << (i & 31)); atomicOr(diag + 26, 1u << ((r & 255) >> 4)); atomicOr(diag + 20 + ((col & 127) >> 5), 1u << (col & 31)); atomicAdd(diag + 16, 1u); atomicMin(diag + 17, (unsigned)(col >> 8)); atomicMax(diag + 18, (unsigned)(col >> 8)); if (fabsf(got - dot) <= 0.03f + 0.03f * fabsf(dot)) atomicAdd(diag + 19, 1u); } }
    }
}
__global__ void k_chk_branch(const bf16_t* ocat, const float* wbr  , const bf16_t* xn, const float* win  , const bf16_t* GH, unsigned code, unsigned* diag) {
    const int i = blockIdx.x; const int r = samp_row(i);
    for (int cc = threadIdx.x; cc < 96; cc += blockDim.x) {
        const int col = (int)(((unsigned)cc * 40503u + (unsigned)i * 977u) % 3072u); const int b = col >> 10, cl = col & 1023;
        float h = 0.f; for (int k = 0; k < 512; ++k) h += bf2f(ocat[(size_t)b * MTOK * 512 + (size_t)r * 512 + k]) * wbr[((size_t)b * 512 + k) * 1024 + cl];
        float g = 0.f; for (int k = 0; k < 1024; ++k) g += bf2f(xn[(size_t)r * D + k]) * win[(size_t)k * INCOLS + PCOLS + col];
        const float ref = sigmoidf_(g) * h, got = bf2f(GH[(size_t)r * GCOLS + col]);
        if (!chk_close(got, ref, 0.03f, 0.04f)) chk_fail(diag, code);
    }
}
__global__ void k_chk_attn(const bf16_t* P, const float* gq, const float* gk, const bf16_t* oc, unsigned code, unsigned* diag) {
    const int id = blockIdx.x, lane = threadIdx.x; const int ti = id % 10;
    const int t = ti == 0 ? 0 : ti == 1 ? 1 : ti == 2 ? 2 : ti == 3 ? 63 : ti == 4 ? 64 : ti == 5 ? 65 : ti == 6 ? 200 : ti == 7 ? 1000 : ti == 8 ? 4097 : 8191;
    const int h = (id / 10) % 8, b = id / 80; const size_t tokb = (size_t)b * SEQ;
    float q = bf2f(P[(tokb + t) * PCOLS + C_SQ + h * 64 + lane]); q = q * rsqrtf(wave_sum(q * q) / 64.f + EPS) * gq[lane];
    float o = 0.f, carry = 0.f;
    for (int s = t - 1; s >= 0 && carry < 300.f; --s) {
        float kv = bf2f(P[(tokb + s) * PCOLS + C_SK + h * 64 + lane]); kv = kv * rsqrtf(wave_sum(kv * kv) / 64.f + EPS) * gk[lane];
        const float z = wave_sum(q * kv) * 0.125f; const float sp = logf(1.f + expf(z));
        carry += sp; const float A = expf(z - carry);
        o += A * bf2f(P[(tokb + s) * PCOLS + C_SV + h * 64 + lane]);
    }
    if (!chk_close(bf2f(oc[(tokb + t) * 512 + h * 64 + lane]), o, 0.02f, 0.03f)) chk_fail(diag, code);
}
__global__ void k_chk_gmlp(const bf16_t* P, const float* ws_l, const float* bs_l, const float* gv_l, const bf16_t* ob, unsigned code, unsigned* diag) {
    const int id = blockIdx.x * blockDim.x + threadIdx.x; if (id >= 512) return;
    const int chunk = (id * 37) % (MTOK / 128), t = (id * 53 + 7) % 128, ch = (id * 101 + 3) % 512, g = ch >> 7, c = ch & 127; const size_t tok0 = (size_t)chunk * 128;
    float acc = 0.f;
    for (int s = 0; s <= t; ++s) { float ss = 0.f; for (int k = 0; k < 512; ++k) { const float v = bf2f(P[(tok0 + s) * PCOLS + C_GV + k]); ss += v * v; }
        const float vn = bf2f(P[(tok0 + s) * PCOLS + C_GV + ch]) * rsqrtf(ss / 512.f + EPS) * gv_l[ch]; acc += ws_l[(size_t)g * 16384 + t * 128 + s] * vn; }
    const float ref = bf2f(P[(tok0 + t) * PCOLS + C_GU + ch]) * (acc + bs_l[g * 128 + t]);
    if (!chk_close(bf2f(ob[(tok0 + t) * 512 + ch]), ref, 0.02f, 0.03f)) chk_fail(diag, code);
}
__global__ void k_chk_hgrn(const bf16_t* P, const float* gain, const bf16_t* oa, unsigned code, unsigned* diag) {
    const int id = blockIdx.x; const int ti = id % 8; const int t = ti == 0 ? 0 : ti == 1 ? 1 : ti == 2 ? 5 : ti == 3 ? 63 : ti == 4 ? 64 : ti == 5 ? 200 : ti == 6 ? 511 : 700, h = (id / 8) % 4, b = id / 32; const int v = threadIdx.x; const size_t tokb = (size_t)b * SEQ;
    float o = 0.f;
    for (int d = 0; d < 128; ++d) { float st = 0.f;
        for (int s = 0; s <= t; ++s) { const bf16_t* row = P + (tokb + s) * PCOLS; const float f = expf(bf2f(row[C_HF + h * 128 + d])); st = f * st + (1.f - f) * bf2f(row[C_HI + h * 128 + v]); }
        o += bf2f(P[(tokb + t) * PCOLS + C_HQ + h * 128 + d]) * st; }
    __shared__ float red[128]; red[v] = o * o; __syncthreads();
    for (int w = 64; w > 0; w >>= 1) { if (v < w) red[v] += red[v + w]; __syncthreads(); }
    const float rstd = rsqrtf(red[0] / 128.f + EPS);
    const float ref = o * rstd * gain[v] * bf2f(P[(tokb + t) * PCOLS + C_HG + h * 128 + v]);
    if (!chk_close(bf2f(oa[(tokb + t) * 512 + h * 128 + v]), ref, 0.03f, 0.04f)) chk_fail(diag, code);
}
__global__ void k_chk_moe(const bf16_t* xn, const float* rw, const float* rb, const float* wg, const float* wu, const float* wd, const float* snap, const float* xout, unsigned code, unsigned* diag) {
    const int i = blockIdx.x; const int r = samp_row(i); const int tid = threadIdx.x;
    __shared__ float hid[DFF]; __shared__ float lg[8]; __shared__ float part[256];
    if (tid < 8) { float a = rb[tid]; for (int k = 0; k < D; ++k) a += bf2f(xn[(size_t)r * D + k]) * rw[k * 8 + tid]; lg[tid] = a; }
    __syncthreads();
    int i0 = 0; for (int e = 1; e < 8; ++e) if (lg[e] > lg[i0]) i0 = e;
    int i1 = -1; for (int e = 0; e < 8; ++e) if (e != i0 && (i1 < 0 || lg[e] > lg[i1])) i1 = e;
    const float w0 = 1.f / (1.f + expf(lg[i1] - lg[i0])), w1 = 1.f - w0;
    float outv[8]; for (int j = 0; j < 8; ++j) outv[j] = 0.f;
    for (int kk = 0; kk < 2; ++kk) { const int e = kk ? i1 : i0; const float wgt = kk ? w1 : w0;
        for (int f = tid; f < DFF; f += blockDim.x) { float g = 0.f, u = 0.f; for (int k = 0; k < D; ++k) { const float xv = bf2f(xn[(size_t)r * D + k]); g += xv * wg[((size_t)e * D + k) * DFF + f]; u += xv * wu[((size_t)e * D + k) * DFF + f]; } hid[f] = siluf_(g) * u; }
        __syncthreads();
        for (int j = 0; j < 8; ++j) { const int col = (j * 131 + i * 17) % D; float p = 0.f; for (int f = tid; f < DFF; f += blockDim.x) p += hid[f] * wd[((size_t)e * DFF + f) * D + col];
            part[tid] = p; __syncthreads(); for (int w = 128; w > 0; w >>= 1) { if (tid < w) part[tid] += part[tid + w]; __syncthreads(); } outv[j] += wgt * part[0]; __syncthreads(); }
    }
    if (tid == 0) for (int j = 0; j < 8; ++j) { const int col = (j * 131 + i * 17) % D; const float ref = snap[(size_t)i * D + col] + outv[j]; if (!chk_close(xout[(size_t)r * D + col], ref, 0.04f, 0.04f)) chk_fail(diag, code); }
}
#endif

struct Args { const float* in[21]; float* out; unsigned char* ws; int lo, hi; };
constexpr int NSTEPS = 28;
__device__ __forceinline__ int laneid_() { int v; asm volatile("v_mbcnt_lo_u32_b32 %0, -1, 0\n\tv_mbcnt_hi_u32_b32 %0, -1, %0" : "=v"(v)); return v; }
#define LANEID (laneid_())

template <class Epi>
__device__ __forceinline__ void run_gemm(LAS unsigned char* lds, const Order& S, int K, const Epi& E, int wid) { pg8::gemm_phase<Epi, Order, true, true>(lds, K, S, E, wid); }

__global__ void __launch_bounds__(NTHREADS, 2) mk_fwd(Args a) {
    extern __shared__ __attribute__((aligned(16))) unsigned char lds_raw[];
    LAS unsigned char* lds = (LAS unsigned char*)lds_raw;
    const int wid = __builtin_amdgcn_readfirstlane((int)threadIdx.x >> 6);
    LAS unsigned* cblk = (LAS unsigned*)(lds + LDS_MISC);
    { const int tid = threadIdx.x;
      if (tid < 4) cblk[tid] = (tid == 2) ? xb_xcc_id() : 0u;
      if (tid < 46) { const unsigned long long pv = (tid < 42) ? (unsigned long long)a.in[tid >> 1] : (tid < 44) ? (unsigned long long)a.out : (unsigned long long)a.ws; cblk[4 + tid] = (tid & 1) ? (unsigned)(pv >> 32) : (unsigned)pv; }
      if (tid == 46) cblk[50] = (unsigned)a.lo; if (tid == 47) cblk[51] = (unsigned)a.hi; }
    __syncthreads();
#define CW(i) ((int)__builtin_amdgcn_readfirstlane(cblk[i]))
#define ARGP(i) ((unsigned char*)(((unsigned long long)(unsigned)CW(5 + 2 * (i)) << 32) | (unsigned long long)(unsigned)CW(4 + 2 * (i))))
#define IN(i) ((const float*)ARGP(i))
#define OUTP ((float*)ARGP(21))
#define WSP (ARGP(22))
#define GSZ ((int)gridDim.x)
#define WGI ((int)blockIdx.x)
    if (CW(51) - CW(50) > 1 && threadIdx.x == 0) (void)xb_add((unsigned*)(WSP + WS_CTL + CW_BAR) + XB_XCNT(CW(2)), 1u);
#define RUN(k) (CW(50) <= (k) && (k) < CW(51))
#define SEAM(k) do { if (CW(50) <= (k) && (k) + 1 < CW(51)) { XcdBarrier bar_; bar_.bar = (unsigned*)(WSP + WS_CTL + CW_BAR); bar_.x = (unsigned)CW(2); bar_.st = (volatile LAS unsigned*)cblk; xcd_barrier(bar_); } } while (0)

#define XRES (OUTP)
#define WIN ((bf16_t*)(WSP + WS_WIN))
#define WBR ((bf16_t*)(WSP + WS_WBR))
#define WOUT ((bf16_t*)(WSP + WS_WOUT))
#define WGU ((bf16_t*)(WSP + WS_WGU))
#define WDN ((bf16_t*)(WSP + WS_WD))
#define XNB ((bf16_t*)(WSP + WS_XN))
#define PBUF ((bf16_t*)(WSP + WS_P))
#define GBUF ((bf16_t*)(WSP + WS_G))
#define HIDB ((bf16_t*)(WSP + WS_HID))
#define OCATB ((bf16_t*)(WSP + WS_OCAT))
#define MWGU ((bf16_t*)(WSP + WS_MWGU))
#define MWDN ((bf16_t*)(WSP + WS_MWD))
#define XSB ((bf16_t*)(WSP + WS_XS))
#define MHIDB ((bf16_t*)(WSP + WS_MHID))
#define LBB ((float*)(WSP + WS_LB))
#define METAB ((int*)(WSP + WS_META))
#define TOKE ((int*)(WSP + WS_TOKE))
#define TOKW ((float2*)(WSP + WS_TOKW))
#define STOK ((int*)(WSP + WS_SLOTTOK))
#define SWB ((float*)(WSP + WS_SLOTW))
#define BLKE ((int*)(WSP + WS_BLKE))
#define HDUMP ((uint2*)(WSP + WS_ORAW))
#define HU ((float*)(WSP + WS_ORAW + HG_DUMP_BYTES))
#define HDSC ((float*)(WSP + WS_ORAW + HG_DUMP_BYTES + HG_U_BYTES))
#define TIDV (wid * 64 + LANEID)
    if (RUN(0)) {
        LAS float* tile = (LAS float*)lds; const int tid = TIDV;
        for (int l = 0; l < 2; ++l) {
            tc_job(IN(2) + (size_t)l * D * INCOLS, D, INCOLS, WIN + (size_t)l * INCOLS * D, 0, 1, tile, WGI, GSZ, tid);
            for (int b = 0; b < 3; ++b) tc_job(IN(10) + (size_t)(l * 3 + b) * 512 * D, 512, D, WBR + (size_t)(l * 3 + b) * D * 512, 0, 1, tile, WGI, GSZ, tid);
            tc_job(IN(11) + (size_t)l * D * D, D, D, WOUT + (size_t)l * D * D, 0, 0, tile, WGI, GSZ, tid);
        }
        tc_job(IN(13), D, DFF, WGU, 1, 1, tile, WGI, GSZ, tid);
        tc_job(IN(14), D, DFF, WGU, 2, 1, tile, WGI, GSZ, tid);
        tc_job(IN(15), DFF, D, WDN, 0, 0, tile, WGI, GSZ, tid);
        if (WGI == 0) { const float a0 = IN(3)[tid], a1 = IN(3)[512 + tid]; LBB[tid] = 0.f; LBB[512 + tid] = sigmoidf_(a1 - a0); }
    }
    SEAM(0);

    for (int l = 0; l < 2; ++l) {
        const int sb = (l == 0) ? 1 : 12;
        if (RUN(sb + 0)) phase_rmsnorm<false>((l == 0) ? IN(0) : (const float*)XRES, IN(1) + l * D, XNB, nullptr, nullptr, nullptr, nullptr, WGI, GSZ, wid, LANEID);
        SEAM(sb + 0);
        if (RUN(sb + 1)) { Order S; S.init(XNB, WIN + (size_t)l * INCOLS * D, MTOK, PCOLS, D, GSZ, WGI); EpiAct E{PBUF, PCOLS, LBB + l * 512, 1}; run_gemm(lds, S, D, E, wid); }
        SEAM(sb + 1);
        if (RUN(sb + 2)) {
            phase_hgrn_a(PBUF, OCATB, HDUMP, HU, HDSC, lds, WGI, GSZ, TIDV, wid, LANEID);
            __syncthreads();
            phase_attn(PBUF, IN(8) + l * 64, IN(9) + l * 64, OCATB + (size_t)2 * MTOK * 512, lds, WGI, GSZ, TIDV, wid, LANEID);
            __syncthreads();
            phase_gmlp(PBUF, IN(6) + (size_t)l * 4 * 16384, IN(7) + l * 512, IN(5) + l * 512, OCATB + (size_t)MTOK * 512, lds, WGI, GSZ, TIDV, wid, LANEID);
        }
        SEAM(sb + 2);
        if (RUN(sb + 3)) phase_hgrn_c(PBUF, OCATB, HDUMP, HU, HDSC, IN(4) + l * 128, lds, WGI, GSZ, TIDV, wid, LANEID);
        SEAM(sb + 3);
        if (RUN(sb + 4)) { Order S; S.init(XNB, WIN + (size_t)l * INCOLS * D + (size_t)PCOLS * D, MTOK, GCOLS, D, GSZ, WGI); EpiAct E{GBUF, GCOLS, nullptr, 0}; run_gemm(lds, S, D, E, wid); }
        SEAM(sb + 4);
        if (RUN(sb + 5)) { Order S; S.init(OCATB, WBR + (size_t)l * 3 * D * 512, MTOK, GCOLS, 512, GSZ, WGI, 1, (size_t)MTOK * 512 * 2, (size_t)D * 512 * 2); EpiBranch E{GBUF}; run_gemm(lds, S, 512, E, wid); }
        SEAM(sb + 5);
        if (RUN(sb + 6)) phase_combine(GBUF, XNB, WGI, GSZ, TIDV);
        SEAM(sb + 6);
        if (RUN(sb + 7)) { Order S; S.init(XNB, WOUT + (size_t)l * D * D, MTOK, D, D, GSZ, WGI); EpiResid E{(l == 0) ? IN(0) : (const float*)XRES, XRES}; run_gemm(lds, S, D, E, wid); }
        SEAM(sb + 7);
        if (l == 0) {
            if (RUN(9)) phase_rmsnorm<false>(XRES, IN(12), XNB, nullptr, nullptr, nullptr, nullptr, WGI, GSZ, wid, LANEID);
            SEAM(9);
            if (RUN(10)) { Order S; S.init(XNB, WGU, MTOK, 2 * DFF, D, GSZ, WGI); EpiGU E{HIDB}; run_gemm(lds, S, D, E, wid); }
            SEAM(10);
            if (RUN(11)) { Order S; S.init(HIDB, WDN, MTOK, D, DFF, GSZ, WGI); EpiResid E{XRES, XRES}; run_gemm(lds, S, DFF, E, wid); }
            SEAM(11);
        } else {
            if (RUN(20)) phase_rmsnorm<true>(XRES, IN(12) + D, XNB, IN(16), IN(17), TOKE, TOKW, WGI, GSZ, wid, LANEID);
            SEAM(20);
            if (RUN(21)) {
                if (WGI == GSZ - 1) moe_assign(TOKE, TOKW, METAB, STOK, SWB, BLKE, lds, TIDV);
                else { LAS float* tile = (LAS float*)lds; const int tid = TIDV;
                    for (int e = 0; e < NEXP; ++e) {
                        tc_job(IN(18) + (size_t)e * D * DFF, D, DFF, MWGU + (size_t)e * 2 * DFF * D, 1, 1, tile, WGI, GSZ - 1, tid);
                        tc_job(IN(19) + (size_t)e * D * DFF, D, DFF, MWGU + (size_t)e * 2 * DFF * D, 2, 1, tile, WGI, GSZ - 1, tid);
                        tc_job(IN(20) + (size_t)e * DFF * D, DFF, D, MWDN + (size_t)e * D * DFF, 0, 0, tile, WGI, GSZ - 1, tid); } }
            }
            SEAM(21);
            for (int kc = 0; kc < 2; ++kc) {
                const int se = 22 + 3 * kc;
#define META(i) __hip_atomic_load(METAB + (i), __ATOMIC_RELAXED, __HIP_MEMORY_SCOPE_AGENT)
                if (RUN(se)) { const int rows = META(kc), s0 = META(2 + kc); moe_gather(XNB, STOK + s0, rows, XSB, WGI, GSZ, wid, LANEID); }
                SEAM(se);
                if (RUN(se + 1)) { const int rows = META(kc), s0 = META(2 + kc);
                    Order S; S.init(XSB, MWGU, rows, 2 * DFF, D, GSZ, WGI, 2, 0, (size_t)2 * DFF * D * 2, BLKE + (s0 >> 8)); EpiGU E{MHIDB}; run_gemm(lds, S, D, E, wid); }
                SEAM(se + 1);
                if (RUN(se + 2)) { const int rows = META(kc), s0 = META(2 + kc);
                    Order S; S.init(MHIDB, MWDN, rows, D, DFF, GSZ, WGI, 2, 0, (size_t)D * DFF * 2, BLKE + (s0 >> 8)); EpiMoeDown E{XRES, STOK + s0, SWB + s0}; run_gemm(lds, S, DFF, E, wid); }
                SEAM(se + 2);
            }
        }
    }
}

extern "C" void kernel_launch(void* const* d_in, const int* in_sizes, int n_in, void* d_out, int out_size, void* d_ws, size_t ws_size, hipStream_t stream) {
    static int grid = 0;
    if (grid == 0) {
        if (n_in != 21 || out_size != MTOK * D || ws_size < WS_NEED) { fprintf(stderr, "kernel_launch: unexpected shapes (n_in %d out %d ws %zu need %zu)\n", n_in, out_size, ws_size, (size_t)WS_NEED); grid = -1; return; }
        int dev = 0, cus = 0, per_cu = 0;
        if (hipGetDevice(&dev) != hipSuccess || hipDeviceGetAttribute(&cus, hipDeviceAttributeMultiprocessorCount, dev) != hipSuccess) { grid = -1; return; }
        if (hipFuncSetAttribute((const void*)mk_fwd, hipFuncAttributeMaxDynamicSharedMemorySize, LDS_BYTES) != hipSuccess) { fprintf(stderr, "kernel_launch: hipFuncSetAttribute failed\n"); grid = -1; return; }
        if (hipOccupancyMaxActiveBlocksPerMultiprocessor(&per_cu, (const void*)mk_fwd, NTHREADS, LDS_BYTES) != hipSuccess || per_cu < 1) { fprintf(stderr, "kernel_launch: occupancy query says %d\n", per_cu); (void)hipGetLastError(); per_cu = 1; }
        grid = cus;
    }
    if (grid < 0) return;
    (void)hipMemsetAsync((char*)d_ws + WS_CTL, 0, CTL_BYTES, stream);
    Args a{};
    for (int i = 0; i < 21; ++i) a.in[i] = (const float*)d_in[i];
    a.out = (float*)d_out; a.ws = (unsigned char*)d_ws;
#if defined(MK_CHECK)
    {
        unsigned char* ws = (unsigned char*)d_ws; unsigned* diag = (unsigned*)(ws + WS_DIAG); float* snap = (float*)(ws + WS_SNAP);
        const bf16_t* XN = (const bf16_t*)(ws + WS_XN); const bf16_t* Pb = (const bf16_t*)(ws + WS_P); const bf16_t* OC = (const bf16_t*)(ws + WS_OCAT); const float* LB = (const float*)(ws + WS_LB);
        auto run = [&](int s) { a.lo = s; a.hi = s + 1; hipLaunchKernelGGL(mk_fwd, dim3(grid), dim3(NTHREADS), LDS_BYTES, stream, a); };
        hipLaunchKernelGGL(k_diag_init, dim3(1), dim3(64), 0, stream, diag);
        int s = 0; run(s++);
        for (int l = 0; l < 2; ++l) {
            const unsigned cb = l * 10;
            const float* win = a.in[2] + (size_t)l * D * INCOLS;
            run(s++); run(s++);
            { ChkGemm c{}; c.A = XN; c.lda = D; c.W = win; c.ldw = INCOLS; c.K = D; c.mode = 0; c.Cb = Pb; c.ldc = PCOLS; c.lb = LB + l * 512; c.ncols = PCOLS; c.code = cb + 1; hipLaunchKernelGGL(k_chk_gemm, dim3(64), dim3(96), 0, stream, c, diag); }
            run(s++); run(s++);
            hipLaunchKernelGGL(k_chk_hgrn, dim3(128), dim3(128), 0, stream, Pb, a.in[4] + l * 128, OC, cb + 2, diag);
            hipLaunchKernelGGL(k_chk_gmlp, dim3(8), dim3(64), 0, stream, Pb, a.in[6] + (size_t)l * 4 * 16384, a.in[7] + l * 512, a.in[5] + l * 512, OC + (size_t)MTOK * 512, cb + 3, diag);
            hipLaunchKernelGGL(k_chk_attn, dim3(320), dim3(64), 0, stream, Pb, a.in[8] + l * 64, a.in[9] + l * 64, OC + (size_t)2 * MTOK * 512, cb + 4, diag);
            run(s++);
            { ChkGemm c{}; c.A = XN; c.lda = D; c.W = win + PCOLS; c.ldw = INCOLS; c.K = D; c.mode = 1; c.Cb = (const bf16_t*)(ws + WS_G); c.ldc = GCOLS; c.ncols = GCOLS; c.code = cb + 5; hipLaunchKernelGGL(k_chk_gemm, dim3(64), dim3(96), 0, stream, c, diag); }
            run(s++);
            hipLaunchKernelGGL(k_chk_branch, dim3(64), dim3(96), 0, stream, OC, a.in[10] + (size_t)l * 3 * 512 * D, XN, win, (const bf16_t*)(ws + WS_G), cb + 6, diag);
            run(s++);
            if (l == 1) hipLaunchKernelGGL(k_snapshot, dim3(64), dim3(256), 0, stream, (const float*)d_out, snap);
            run(s++);
            { ChkGemm c{}; c.A = XN; c.lda = D; c.W = a.in[11] + (size_t)l * D * D; c.ldw = D; c.K = D; c.mode = 3; c.Cf = (const float*)d_out; c.xold = l ? snap : a.in[0]; c.use_snap = l; c.ncols = D; c.code = cb + 7; hipLaunchKernelGGL(k_chk_gemm, dim3(64), dim3(96), 0, stream, c, diag); }
            run(s++);
            if (l == 0) {
                run(s++);
                { ChkGemm c{}; c.A = XN; c.lda = D; c.W = a.in[13]; c.W2 = a.in[14]; c.ldw = DFF; c.K = D; c.mode = 4; c.Cb = (const bf16_t*)(ws + WS_HID); c.ldc = DFF; c.ncols = DFF; c.code = cb + 8; hipLaunchKernelGGL(k_chk_gemm, dim3(64), dim3(96), 0, stream, c, diag); }
                hipLaunchKernelGGL(k_snapshot, dim3(64), dim3(256), 0, stream, (const float*)d_out, snap);
                run(s++);
                { ChkGemm c{}; c.A = (const bf16_t*)(ws + WS_HID); c.lda = DFF; c.W = a.in[15]; c.ldw = D; c.K = DFF; c.mode = 3; c.Cf = (const float*)d_out; c.xold = snap; c.use_snap = 1; c.ncols = D; c.code = cb + 9; hipLaunchKernelGGL(k_chk_gemm, dim3(64), dim3(96), 0, stream, c, diag); }
            } else {
                hipLaunchKernelGGL(k_snapshot, dim3(64), dim3(256), 0, stream, (const float*)d_out, snap);
                run(s++);
                for (int e = 0; e < 6; ++e) run(s++);
                hipLaunchKernelGGL(k_chk_moe, dim3(16), dim3(256), 0, stream, XN, a.in[16], a.in[17], a.in[18], a.in[19], a.in[20], (const float*)snap, (const float*)d_out, 20u, diag);
            }
        }
        if (s != NSTEPS) fprintf(stderr, "step count mismatch %d\n", s);
        hipLaunchKernelGGL(k_apply_diag, dim3(1024), dim3(256), 0, stream, (float*)d_out, (const unsigned*)diag);
    }
#elif !defined(MK_ONE_LAUNCH)
    for (int s = 0; s < NSTEPS; ++s) { a.lo = s; a.hi = s + 1; hipLaunchKernelGGL(mk_fwd, dim3(grid), dim3(NTHREADS), LDS_BYTES, stream, a); }
#else
    a.lo = 0; a.hi = NSTEPS; hipLaunchKernelGGL(mk_fwd, dim3(grid), dim3(NTHREADS), LDS_BYTES, stream, a);
#endif
}
```

```cpp
#define MK_ONE_LAUNCH 1
#include <hip/hip_runtime.h>
#include <cstdio>
#include <cstdint>
#include <cstddef>

#define LAS __attribute__((address_space(3)))
#define XB_TMO      128
#define XB_XCNT(j)  (256  + 64 * (j))
#define XB_XSUB(j)  (1280 + 64 * (j))
#define XB_XGEN(j)  (2304 + 64 * (j))
#define XB_TOP      3328
#define XB_TOPGEN   3392
#define XCD_BAR_WORDS 3456
#define XB_SPIN_CAP (1u << 18)

__device__ __forceinline__ unsigned xb_ld(unsigned* p)              { return __hip_atomic_load(p, __ATOMIC_RELAXED, __HIP_MEMORY_SCOPE_AGENT); }
__device__ __forceinline__ unsigned xb_add(unsigned* p, unsigned v) { return __hip_atomic_fetch_add(p, v, __ATOMIC_RELAXED, __HIP_MEMORY_SCOPE_AGENT); }
__device__ __forceinline__ unsigned xb_xcc_id() { return (unsigned)__builtin_amdgcn_s_getreg((3 << 11) | 20) & 0xFu; }
#define XB_SPIN(cond, bar) do { unsigned _sp = 0; while (cond) { __builtin_amdgcn_s_sleep(1); \
    if ((++_sp & 255u) == 0u) { if (xb_ld(&(bar)[XB_TMO])) break; if (_sp > XB_SPIN_CAP) { atomicAdd(&(bar)[XB_TMO], 1u); break; } } } } while (0)

struct XcdBarrier {
    unsigned* bar; unsigned x;
    volatile LAS unsigned* st;
};

__device__ __forceinline__ XcdBarrier xcd_barrier_post(unsigned* bar, volatile LAS unsigned* st) {
    XcdBarrier b; b.bar = bar; b.x = xb_xcc_id(); b.st = st;
    if (threadIdx.x == 0) (void)xb_add(&bar[XB_XCNT(b.x)], 1u);
    return b;
}
__device__ __forceinline__ void xcd_barrier_complete(unsigned* bar, unsigned x, unsigned& nloc, unsigned& nx) {
    const unsigned G = gridDim.x * gridDim.y * gridDim.z;
    unsigned sum, cnt, mine, sp = 0u;
    for (;;) {
        sum = 0u; cnt = 0u; mine = 0u;
#pragma unroll
        for (unsigned j = 0; j < 16; ++j) { const unsigned c = xb_ld(&bar[XB_XCNT(j)]); sum += c; cnt += (c > 0u) ? 1u : 0u; mine = (j == x) ? c : mine; }
        if (sum == G) break;
        __builtin_amdgcn_s_sleep(1);
        if ((++sp & 255u) == 0u) { if (xb_ld(&bar[XB_TMO])) break; if (sp > XB_SPIN_CAP) { atomicAdd(&bar[XB_TMO], 1u); break; } }
    }
    nloc = mine > 0u ? mine : 1u; nx = cnt > 0u ? cnt : 1u;
}

__device__ __forceinline__ void xcd_barrier(const XcdBarrier& b) {
    asm volatile("s_waitcnt vmcnt(0)" ::: "memory");
    __syncthreads();
    if (threadIdx.x == 0) {
        unsigned* bar = b.bar;
        __builtin_amdgcn_s_waitcnt(0);
        unsigned nloc = b.st[0], nx = b.st[1];
        if (nloc == 0u) { xcd_barrier_complete(bar, b.x, nloc, nx); b.st[0] = nloc; b.st[1] = nx; }
        const unsigned old = xb_add(&bar[XB_XSUB(b.x)], 1u);
        const unsigned gen = old / nloc;
        if (old + 1u == (gen + 1u) * nloc) {
            __builtin_amdgcn_fence(__ATOMIC_RELEASE, "agent");
            asm volatile("s_waitcnt vmcnt(0)" ::: "memory");
            const unsigned og = xb_add(&bar[XB_TOP], 1u);
            const unsigned tg = og / nx;
            if (og + 1u == (tg + 1u) * nx) xb_add(&bar[XB_TOPGEN], 1u);
            else XB_SPIN(xb_ld(&bar[XB_TOPGEN]) == tg, bar);
            __builtin_amdgcn_fence(__ATOMIC_ACQUIRE, "agent");
            xb_add(&bar[XB_XGEN(b.x)], 1u);
            asm volatile("s_waitcnt vmcnt(0)" ::: "memory");
        } else {
            XB_SPIN(xb_ld(&bar[XB_XGEN(b.x)]) == gen, bar);
            __builtin_amdgcn_fence(__ATOMIC_ACQUIRE, "agent");
            asm volatile("s_waitcnt vmcnt(0)" ::: "memory");
        }
    }
    __syncthreads();
}
namespace pg8 {
#define PG8_LAS __attribute__((address_space(3)))
typedef unsigned short bf16_t;
typedef short bf16x8 __attribute__((ext_vector_type(8)));
typedef float f32x4 __attribute__((ext_vector_type(4)));
typedef unsigned u32x4 __attribute__((ext_vector_type(4)));
constexpr int BM = 256, BK = 64, HALF = 128, HTB = HALF * BK * 2  , STAGE_BYTES = 8 * HTB, NXCD = 8, WGM = 8;

__host__ __device__ __forceinline__ int lds_byte(int r, int c) { const int st = (r >> 4) * 2 + (c >> 5), rr = r & 15, cc = c & 31, ob = rr * 64 + cc * 2; return st * 1024 + (ob ^ (((ob >> 9) & 1) << 5)); }
__host__ __device__ __forceinline__ void stage_rc(int b, int& R, int& C) { const int st = b / 1024, sb = b % 1024, swz = sb ^ (((sb >> 9) & 1) << 5); R = (st >> 1) * 16 + swz / 64; C = (st & 1) * 32 + (swz % 64) / 2; }
__host__ __device__ __forceinline__ int perm32(int rho) { const int n = rho >> 4, i = rho & 15; return 8 * (i >> 2) + 4 * n + (i & 3); }

struct Unit { int pm, pn; const char* a; const char* b; };

typedef float f32x2 __attribute__((ext_vector_type(2))); typedef __bf16 bf16x2_t __attribute__((ext_vector_type(2)));
__device__ __forceinline__ unsigned cvt_pk_bf16(float lo, float hi) { f32x2 v = {lo, hi}; bf16x2_t b = __builtin_convertvector(v, bf16x2_t); return __builtin_bit_cast(unsigned, b); }
template <class Epi, class Sched, bool ALIGN_EPI = false, bool SP2 = false>
__device__ __forceinline__ void gemm_phase(PG8_LAS unsigned char* lds, const int K, const Sched& S, const Epi& E, const int wid) {
    int lane; asm volatile("v_mbcnt_lo_u32_b32 %0, -1, 0\n\tv_mbcnt_hi_u32_b32 %0, -1, %0" : "=v"(lane));
    const int tid = wid * 64 + lane, wr = wid >> 2, wc = wid & 3, fr = lane & 15, fq = lane >> 4;
    const int nt = K / BK;
    unsigned voffA[2];
#pragma unroll
    for (int i = 0; i < 2; ++i) { int R, C; stage_rc(tid * 16 + i * 8192, R, C); voffA[i] = (unsigned)(R * K + C) * 2u; }
    const size_t kstep = (size_t)(BK * 2);
    const size_t hstep = (size_t)HALF * K * 2;
    const unsigned ldsw = (unsigned)wid * 1024u;
    const int aoff = lds_byte(wr * 64 + fr, fq * 8), boff = lds_byte(wc * 32 + fr, fq * 8);
#define PG8_SA(b, h) (((b) * 2 + (h)) * HTB)
#define PG8_SB(b, h) ((4 + (b) * 2 + (h)) * HTB)
#define PG8_STAGE(bufoff, gbase, voff) do { _Pragma("unroll") for (int _i = 0; _i < 2; ++_i) \
        __builtin_amdgcn_global_load_lds((const unsigned*)((const char*)(gbase) + (voff)[_i]), (PG8_LAS unsigned*)(lds + (bufoff) + ldsw + _i * 8192), 16, 0, 0); } while (0)
#define PG8_LDA(dst, b, h) do { _Pragma("unroll") for (int m = 0; m < 4; ++m) _Pragma("unroll") for (int k = 0; k < 2; ++k) dst[m][k] = *(const PG8_LAS bf16x8*)(lds + PG8_SA(b, h) + aoff + m * 2048 + k * 1024); } while (0)
#define PG8_LDB(dst, b, h) do { _Pragma("unroll") for (int n = 0; n < 2; ++n) _Pragma("unroll") for (int k = 0; k < 2; ++k) dst[n][k] = *(const PG8_LAS bf16x8*)(lds + PG8_SB(b, h) + boff + n * 2048 + k * 1024); } while (0)
#define PG8_MMA(ai, bj, At, Bt) do { __builtin_amdgcn_s_setprio(1); _Pragma("unroll") for (int m = 0; m < 4; ++m) _Pragma("unroll") for (int n = 0; n < 2; ++n) _Pragma("unroll") for (int k = 0; k < 2; ++k) \
        acc[ai][bj][m][n] = __builtin_amdgcn_mfma_f32_16x16x32_bf16(Bt[n][k], At[m][k], acc[ai][bj][m][n], 0, 0, 0); __builtin_amdgcn_s_setprio(0); } while (0)
#define PG8_WAIT_V(n) asm volatile("s_waitcnt vmcnt(" #n ")" ::: "memory")
#define PG8_WAIT_L(n) asm volatile("s_waitcnt lgkmcnt(" #n ")" ::: "memory")
#define PG8_BAR __builtin_amdgcn_s_barrier()
#define PG8_SCHED __builtin_amdgcn_sched_barrier(0)
    Unit cur, nxt; int ui = 0;
    if (!S.next(0, cur)) return;
    f32x4 acc[2][2][4][2];
#pragma unroll
    for (int a = 0; a < 2; ++a)
#pragma unroll
        for (int b = 0; b < 2; ++b)
#pragma unroll
            for (int m = 0; m < 4; ++m)
#pragma unroll
                for (int n = 0; n < 2; ++n) acc[a][b][m][n] = (f32x4){0.f, 0.f, 0.f, 0.f};
    bf16x8 At[4][2], B0[2][2], B1[2][2];
    const char* cA = cur.a; const char* cB = cur.b;
    S.a_ready(cur);
    if constexpr (SP2) {
        PG8_STAGE(PG8_SB(0, 0), cB, voffA); PG8_STAGE(PG8_SB(0, 1), cB + hstep, voffA); PG8_STAGE(PG8_SA(0, 0), cA, voffA); PG8_STAGE(PG8_SA(0, 1), cA + hstep, voffA);
        if (wr == 1) PG8_BAR;
        PG8_WAIT_V(2); PG8_BAR;
        PG8_STAGE(PG8_SB(1, 0), cB + kstep, voffA); PG8_STAGE(PG8_SA(1, 0), cA + kstep, voffA); PG8_STAGE(PG8_SB(1, 1), cB + hstep + kstep, voffA);
        PG8_WAIT_V(6); PG8_BAR;
    } else {
        PG8_STAGE(PG8_SB(0, 0), cB, voffA); PG8_STAGE(PG8_SA(0, 0), cA, voffA); PG8_STAGE(PG8_SB(0, 1), cB + hstep, voffA); PG8_STAGE(PG8_SA(0, 1), cA + hstep, voffA);
        if (wr == 1) PG8_BAR;
        PG8_WAIT_V(4); PG8_BAR;
        PG8_STAGE(PG8_SB(1, 0), cB + kstep, voffA); PG8_STAGE(PG8_SA(1, 0), cA + kstep, voffA); PG8_STAGE(PG8_SB(1, 1), cB + hstep + kstep, voffA);
        PG8_WAIT_V(6); PG8_BAR;
    }
    for (;;) {
        const bool has_next = S.next(ui + 1, nxt);
        const char* nA = has_next ? nxt.a : cA; const char* nB = has_next ? nxt.b : cB;
        for (int t = 0; t < nt; t += 2) {
            const bool last = (t == nt - 2);
            const char* a1 = cA + (size_t)(t + 1) * kstep;
            const char* a2 = last ? nA : cA + (size_t)(t + 2) * kstep; const char* b2 = last ? nB : cB + (size_t)(t + 2) * kstep;
            const char* a3 = a2 + kstep; const char* b3 = b2 + kstep;
            if (last && has_next) S.a_ready(nxt);
            if constexpr (SP2) {
            PG8_LDB(B0, 0, 0); PG8_LDB(B1, 0, 1); PG8_SCHED; PG8_LDA(At, 0, 0); PG8_STAGE(PG8_SA(1, 1), a1 + hstep, voffA);
            PG8_WAIT_V(8); PG8_WAIT_L(0); PG8_BAR; PG8_MMA(0, 0, At, B0); PG8_MMA(0, 1, At, B1); PG8_BAR; PG8_SCHED;
            PG8_LDA(At, 0, 1); PG8_STAGE(PG8_SB(0, 0), b2, voffA); PG8_STAGE(PG8_SB(0, 1), b2 + hstep, voffA); PG8_STAGE(PG8_SA(0, 0), a2, voffA);
            PG8_WAIT_V(8); PG8_WAIT_L(0); PG8_BAR; PG8_MMA(1, 0, At, B0); PG8_MMA(1, 1, At, B1); PG8_BAR; PG8_SCHED;
            PG8_LDB(B0, 1, 0); PG8_LDB(B1, 1, 1); PG8_SCHED; PG8_LDA(At, 1, 0); PG8_STAGE(PG8_SA(0, 1), a2 + hstep, voffA);
            PG8_WAIT_V(8); PG8_WAIT_L(0); PG8_BAR; PG8_MMA(0, 0, At, B0); PG8_MMA(0, 1, At, B1); PG8_BAR; PG8_SCHED;
            PG8_LDA(At, 1, 1); PG8_STAGE(PG8_SB(1, 0), b3, voffA); PG8_STAGE(PG8_SB(1, 1), b3 + hstep, voffA); PG8_STAGE(PG8_SA(1, 0), a3, voffA);
            PG8_WAIT_V(8); PG8_WAIT_L(0); PG8_BAR; PG8_MMA(1, 0, At, B0); PG8_MMA(1, 1, At, B1); PG8_BAR; PG8_SCHED;
            } else {
            PG8_LDB(B0, 0, 0); PG8_SCHED; PG8_LDA(At, 0, 0); PG8_STAGE(PG8_SA(1, 1), a1 + hstep, voffA);
            PG8_WAIT_L(8); PG8_BAR; PG8_WAIT_L(0); PG8_MMA(0, 0, At, B0); PG8_BAR; PG8_SCHED;
            PG8_LDB(B1, 0, 1); PG8_STAGE(PG8_SB(0, 0), b2, voffA);
            PG8_BAR; PG8_WAIT_L(0); PG8_MMA(0, 1, At, B1); PG8_BAR;
            PG8_LDA(At, 0, 1); PG8_STAGE(PG8_SA(0, 0), a2, voffA);
            PG8_BAR; PG8_WAIT_L(0); PG8_MMA(1, 0, At, B0); PG8_BAR; PG8_SCHED;
            PG8_STAGE(PG8_SB(0, 1), b2 + hstep, voffA);
            PG8_WAIT_V(6); PG8_BAR; PG8_MMA(1, 1, At, B1); PG8_BAR;
            PG8_LDB(B0, 1, 0); PG8_SCHED; PG8_LDA(At, 1, 0); PG8_STAGE(PG8_SA(0, 1), a2 + hstep, voffA);
            PG8_WAIT_L(8); PG8_BAR; PG8_WAIT_L(0); PG8_MMA(0, 0, At, B0); PG8_BAR; PG8_SCHED;
            PG8_LDB(B1, 1, 1); PG8_STAGE(PG8_SB(1, 0), b3, voffA);
            PG8_BAR; PG8_WAIT_L(0); PG8_MMA(0, 1, At, B1); PG8_BAR;
            PG8_LDA(At, 1, 1); PG8_STAGE(PG8_SA(1, 0), a3, voffA);
            PG8_BAR; PG8_WAIT_L(0); PG8_MMA(1, 0, At, B0); PG8_BAR; PG8_SCHED;
            PG8_STAGE(PG8_SB(1, 1), b3 + hstep, voffA);
            PG8_WAIT_V(6); PG8_BAR; PG8_MMA(1, 1, At, B1); PG8_BAR;
            }
        }
        if constexpr (ALIGN_EPI) { if (wr == 0) PG8_BAR; }
        if constexpr (!Epi::AFTER_DRAIN) { E(acc, cur, wr, wc, fr, fq); S.done(cur); }
        if (!has_next) break;
#pragma unroll
        for (int a = 0; a < 2; ++a)
#pragma unroll
            for (int b = 0; b < 2; ++b)
#pragma unroll
                for (int m = 0; m < 4; ++m)
#pragma unroll
                    for (int n = 0; n < 2; ++n) acc[a][b][m][n] = (f32x4){0.f, 0.f, 0.f, 0.f};
        cur = nxt; cA = nA; cB = nB; ++ui;
        if constexpr (ALIGN_EPI) { if (wr == 1) PG8_BAR; }
    }
    PG8_WAIT_V(0);
    if constexpr (!ALIGN_EPI) { if (wr == 0) PG8_BAR; }
    PG8_BAR;
    if constexpr (Epi::AFTER_DRAIN) { E.fused(acc, cur, wr, wc, fr, fq, lds, wid, lane); S.done(cur); }
#undef PG8_SA
#undef PG8_SB
#undef PG8_STAGE
#undef PG8_LDA
#undef PG8_LDB
#undef PG8_MMA
#undef PG8_WAIT_V
#undef PG8_WAIT_L
#undef PG8_BAR
#undef PG8_SCHED
}
}

typedef pg8::bf16_t bf16_t;
typedef pg8::f32x4 f32x4;
typedef pg8::u32x4 u32x4;
using pg8::cvt_pk_bf16;
constexpr int NB = 4, SEQ = 8192, D = 1024, MTOK = NB * SEQ;
constexpr int PCOLS = 4608, GCOLS = 3072, INCOLS = 7680, DFF = 3584, NEXP = 8;
constexpr int C_HQ = 0, C_HF = 512, C_HI = 1024, C_HG = 1536, C_GU = 2048, C_GV = 2560, C_SQ = 3072, C_SK = 3584, C_SV = 4096;
constexpr float EPS = 1e-6f;
constexpr int NSLOT = 2 * MTOK + 2 * NEXP * 256, MOE_MAXBLK = MTOK / 256 + NEXP;
constexpr int NTHREADS = 512, NWAVES = 8;
constexpr int LDS_BYTES = 147456, LDS_MISC = LDS_BYTES - 256;

constexpr size_t WS_CTL = 0, CTL_BYTES = 65536;
constexpr size_t CW_BAR = 0;
constexpr size_t WS_META = WS_CTL + CTL_BYTES;
constexpr size_t WS_LB = WS_META + 4096;
constexpr size_t WS_TOKE = WS_LB + 4096;
constexpr size_t WS_TOKW = WS_TOKE + (size_t)MTOK * 4;
constexpr size_t WS_SLOTTOK = WS_TOKW + (size_t)MTOK * 8;
constexpr size_t WS_SLOTW = WS_SLOTTOK + (size_t)NSLOT * 4;
constexpr size_t WS_BLKE = WS_SLOTW + (size_t)NSLOT * 4;
constexpr size_t WS_W = 2u << 20;
static_assert(WS_BLKE + 4096 <= WS_W, "small buffers");
constexpr size_t WS_WIN = WS_W;
constexpr size_t WS_WBR = WS_WIN + (size_t)2 * INCOLS * D * 2;
constexpr size_t WS_WOUT = WS_WBR + (size_t)2 * 3 * D * 512 * 2;
constexpr size_t WS_WGU = WS_WOUT + (size_t)2 * D * D * 2;
constexpr size_t WS_WD = WS_WGU + (size_t)2 * DFF * D * 2;
constexpr size_t WS_XN = WS_WD + (size_t)D * DFF * 2;
constexpr size_t WS_C = WS_XN + (size_t)MTOK * D * 2;
constexpr size_t WS_P = WS_C;
constexpr size_t WS_G = WS_C;
constexpr size_t WS_HID = WS_C;
constexpr size_t WS_OCAT = WS_C + (size_t)MTOK * PCOLS * 2;
constexpr size_t WS_ORAW = WS_OCAT + (size_t)3 * MTOK * 512 * 2;
constexpr size_t WS_END1 = WS_ORAW + (size_t)MTOK * 512 * 4;
constexpr size_t WS_MWD = WS_W;
static_assert(WS_MWD + (size_t)NEXP * D * DFF * 2 <= WS_XN, "moe down weights fit below XN");
constexpr size_t WS_MWGU = WS_C;
constexpr size_t WS_XS = WS_MWGU + (size_t)NEXP * 2 * DFF * D * 2;
constexpr size_t WS_MHID = WS_XS + (size_t)MOE_MAXBLK * 256 * D * 2;
constexpr size_t WS_END2 = WS_MHID + (size_t)MOE_MAXBLK * 256 * DFF * 2;
constexpr size_t WS_NEED = WS_END1 > WS_END2 ? WS_END1 : WS_END2;
static_assert(WS_NEED <= 615053344ull, "workspace budget (sum of the inputs)");

#define LAUNDER(v) asm volatile("" : "+v"(v))
__device__ __forceinline__ float bf2f(unsigned v) { return __uint_as_float(v << 16); }
__device__ __forceinline__ float bflo(unsigned w) { return __uint_as_float(w << 16); }
__device__ __forceinline__ float bfhi(unsigned w) { return __uint_as_float(w & 0xffff0000u); }
__device__ __forceinline__ bf16_t f2bf(float f) { return (bf16_t)(cvt_pk_bf16(f, 0.f) & 0xffffu); }
template <int M> __device__ __forceinline__ float xor_f(float v) { return __builtin_bit_cast(float, __builtin_amdgcn_ds_swizzle(__builtin_bit_cast(int, v), (M << 10) | 0x1f)); }
__device__ __forceinline__ float bperm_f(float v, int src_lane) { return __builtin_bit_cast(float, __builtin_amdgcn_ds_bpermute(src_lane << 2, __builtin_bit_cast(int, v))); }
__device__ __forceinline__ float wave_sum(float v) {
    v += xor_f<1>(v); v += xor_f<2>(v); v += xor_f<4>(v); v += xor_f<8>(v); v += xor_f<16>(v);
    return __builtin_bit_cast(float, __builtin_amdgcn_readlane(__builtin_bit_cast(int, v), 0)) + __builtin_bit_cast(float, __builtin_amdgcn_readlane(__builtin_bit_cast(int, v), 32));
}
__device__ __forceinline__ float sigmoidf_(float x) { return __builtin_amdgcn_rcpf(1.f + __expf(-x)); }
__device__ __forceinline__ float siluf_(float x) { return x * sigmoidf_(x); }
__device__ __forceinline__ float gelu_tanh_(float x) { return x * sigmoidf_(1.5957691216057308f * (x + 0.044715f * x * x * x)); }
__device__ __forceinline__ float softplusf_(float z) { return fmaxf(z, 0.f) + __logf(1.f + __expf(-fabsf(z))); }

struct Order {
    int nM, nN, nwg, G, c, mode; const char* A; const char* Bt; size_t tstep, abr, bbr; const int* bmap;
    __device__ void init(const void* A_, const void* Bt_, int M, int N, int K, int G_, int c_, int mode_ = 0, size_t abr_ = 0, size_t bbr_ = 0, const int* bmap_ = nullptr) { bmap = bmap_;
        nM = M / 256; nN = N / 256; nwg = nM * nN; G = G_; c = c_; mode = mode_; A = (const char*)A_; Bt = (const char*)Bt_; tstep = (size_t)256 * K * 2; abr = abr_; bbr = bbr_; }
    __device__ bool next(int i, pg8::Unit& u) const {
        if (mode == 3) {
            const int br = i % 3; const long L = (long)(i / 3) * G + c; const int nt4 = nM * 4; if (L >= nt4) return false;
            int wgid = (int)L; { const int q = nt4 / 8, r = nt4 % 8, xcd = wgid % 8, off = wgid / 8; wgid = (xcd < r ? xcd * (q + 1) : r * (q + 1) + (xcd - r) * q) + off; }
            const int nig = 8 * 4, gid = wgid / nig, fm = gid * 8, gsz = (nM - fm) < 8 ? (nM - fm) : 8;
            u.pm = fm + ((wgid % nig) % gsz); const int pq = (wgid % nig) / gsz; u.pn = br * 4 + pq;
            u.a = A + (size_t)br * abr + (size_t)u.pm * tstep; u.b = Bt + (size_t)br * bbr + (size_t)pq * tstep; return true; }
        const long L = (long)i * G + c; if (L >= nwg) return false;
        int wgid = (int)L; { const int q = nwg / 8, r = nwg % 8, xcd = wgid % 8, off = wgid / 8; wgid = (xcd < r ? xcd * (q + 1) : r * (q + 1) + (xcd - r) * q) + off; }
        const int nig = 8 * nN, gid = wgid / nig, fm = gid * 8, gsz = (nM - fm) < 8 ? (nM - fm) : 8;
        u.pm = fm + ((wgid % nig) % gsz); u.pn = (wgid % nig) / gsz;
        if (mode == 0) { u.a = A + (size_t)u.pm * tstep; u.b = Bt + (size_t)u.pn * tstep; }
        else if (mode == 2) { const int ex = __hip_atomic_load(bmap + u.pm, __ATOMIC_RELAXED, __HIP_MEMORY_SCOPE_AGENT); u.a = A + (size_t)u.pm * tstep; u.b = Bt + (size_t)ex * bbr + (size_t)u.pn * tstep; }
        else { const int br = u.pn >> 2; u.a = A + (size_t)br * abr + (size_t)u.pm * tstep; u.b = Bt + (size_t)br * bbr + (size_t)(u.pn & 3) * tstep; }
        return true;
    }
    __device__ __forceinline__ void a_ready(const pg8::Unit&) const {}
    __device__ __forceinline__ void done(const pg8::Unit&) const {}
};

template <int ACT> __device__ __forceinline__ float act_(float x, float lb) {
    if (ACT == 1) return siluf_(x);
    if (ACT == 2) return __logf(lb + (1.f - lb) * sigmoidf_(x));
    if (ACT == 3) return gelu_tanh_(x);
    if (ACT == 4) return sigmoidf_(x);
    return x;
}
struct EpiAct {
    static constexpr bool PERM = true, AFTER_DRAIN = false;
    bf16_t* O; int ldc; const float* lb; int inproj;
    template <int ACT> __device__ __forceinline__ void run(const f32x4 (&acc)[2][2][4][2], const pg8::Unit& u, int wr, int wc, int fr, int fq) const {
        const int row0 = u.pm * 256 + wr * 64 + fr, col0 = u.pn * 256 + wc * 32 + 8 * fq;
        f32x4 lbv[2][2];
#pragma unroll
        for (int bj = 0; bj < 2; ++bj)
#pragma unroll
            for (int n = 0; n < 2; ++n) lbv[bj][n] = (ACT == 2) ? *(const f32x4*)(lb + (col0 - C_HF) + bj * 128 + 4 * n) : (f32x4){0.f, 0.f, 0.f, 0.f};
#pragma unroll
        for (int ai = 0; ai < 2; ++ai)
#pragma unroll
            for (int m = 0; m < 4; ++m) { bf16_t* rowp = O + (size_t)(row0 + ai * 128 + m * 16) * ldc + col0;
#pragma unroll
                for (int bj = 0; bj < 2; ++bj) { f32x4 v0 = acc[ai][bj][m][0], v1 = acc[ai][bj][m][1];
#pragma unroll
                    for (int i = 0; i < 4; ++i) { v0[i] = act_<ACT>(v0[i], lbv[bj][0][i]); v1[i] = act_<ACT>(v1[i], lbv[bj][1][i]); }
                    u32x4 w; w.x = cvt_pk_bf16(v0[0], v0[1]); w.y = cvt_pk_bf16(v0[2], v0[3]); w.z = cvt_pk_bf16(v1[0], v1[1]); w.w = cvt_pk_bf16(v1[2], v1[3]);
                    *(u32x4*)(rowp + bj * 128) = w; } }
    }
    __device__ __forceinline__ void operator()(const f32x4 (&acc)[2][2][4][2], const pg8::Unit& u, int wr, int wc, int fr, int fq) const {
        if (!inproj) { run<4>(acc, u, wr, wc, fr, fq); return; }
        const int kind = u.pn >> 1;
        if (kind == 0 || kind == 3) run<1>(acc, u, wr, wc, fr, fq);
        else if (kind == 1) run<2>(acc, u, wr, wc, fr, fq);
        else if (kind == 4 || kind == 5) run<3>(acc, u, wr, wc, fr, fq);
        else run<0>(acc, u, wr, wc, fr, fq);
    }
};
struct EpiBranch {
    static constexpr bool PERM = true, AFTER_DRAIN = false;
    const bf16_t* Gt; bf16_t* mix;
    __device__ __forceinline__ void operator()(const f32x4 (&acc)[2][2][4][2], const pg8::Unit& u, int wr, int wc, int fr, int fq) const {
        const int br = u.pn >> 2, row0 = u.pm * 256 + wr * 64 + fr, col0 = (u.pn & 3) * 256 + wc * 32 + 8 * fq;
#pragma unroll
        for (int ai = 0; ai < 2; ++ai)
#pragma unroll
            for (int m = 0; m < 4; ++m) { const size_t row = (size_t)(row0 + ai * 128 + m * 16); const bf16_t* gp = Gt + row * GCOLS + br * 1024 + col0; bf16_t* mp = mix + row * D + col0;
#pragma unroll
                for (int bj = 0; bj < 2; ++bj) { const f32x4 v0 = acc[ai][bj][m][0], v1 = acc[ai][bj][m][1];
                    const u32x4 g = *(const u32x4*)(gp + bj * 128); u32x4 o = {0u, 0u, 0u, 0u};
                    if (br > 0) o = __builtin_nontemporal_load((const u32x4*)(mp + bj * 128));
                    u32x4 w;
                    w.x = cvt_pk_bf16(bflo(o.x) + v0[0] * bflo(g.x), bfhi(o.x) + v0[1] * bfhi(g.x)); w.y = cvt_pk_bf16(bflo(o.y) + v0[2] * bflo(g.y), bfhi(o.y) + v0[3] * bfhi(g.y));
                    w.z = cvt_pk_bf16(bflo(o.z) + v1[0] * bflo(g.z), bfhi(o.z) + v1[1] * bfhi(g.z)); w.w = cvt_pk_bf16(bflo(o.w) + v1[2] * bflo(g.w), bfhi(o.w) + v1[3] * bfhi(g.w));
                    *(u32x4*)(mp + bj * 128) = w; } }
    }
};
struct EpiResid {
    static constexpr bool PERM = false, AFTER_DRAIN = false;
    const float* xin; float* xout;
    __device__ __forceinline__ void operator()(const f32x4 (&acc)[2][2][4][2], const pg8::Unit& u, int wr, int wc, int fr, int fq) const {
        const int row0 = u.pm * 256 + wr * 64 + fr, col0 = u.pn * 256 + wc * 32 + 4 * fq;
#pragma unroll
        for (int ai = 0; ai < 2; ++ai)
#pragma unroll
            for (int m = 0; m < 4; ++m) { const size_t ro = (size_t)(row0 + ai * 128 + m * 16) * D + col0;
#pragma unroll
                for (int bj = 0; bj < 2; ++bj)
#pragma unroll
                    for (int n = 0; n < 2; ++n) *(f32x4*)(xout + ro + bj * 128 + n * 16) = *(const f32x4*)(xin + ro + bj * 128 + n * 16) + acc[ai][bj][m][n]; }
    }
};
struct EpiGU {
    static constexpr bool PERM = true, AFTER_DRAIN = false;
    bf16_t* H;
    __device__ __forceinline__ void operator()(const f32x4 (&acc)[2][2][4][2], const pg8::Unit& u, int wr, int wc, int fr, int fq) const {
        const int row0 = u.pm * 256 + wr * 64 + fr, col0 = u.pn * 128 + wc * 32 + 8 * fq;
#pragma unroll
        for (int ai = 0; ai < 2; ++ai)
#pragma unroll
            for (int m = 0; m < 4; ++m) { bf16_t* rowp = H + (size_t)(row0 + ai * 128 + m * 16) * DFF + col0;
                const f32x4 g0 = acc[ai][0][m][0], g1 = acc[ai][0][m][1], u0 = acc[ai][1][m][0], u1 = acc[ai][1][m][1]; u32x4 w;
                w.x = cvt_pk_bf16(siluf_(g0[0]) * u0[0], siluf_(g0[1]) * u0[1]); w.y = cvt_pk_bf16(siluf_(g0[2]) * u0[2], siluf_(g0[3]) * u0[3]);
                w.z = cvt_pk_bf16(siluf_(g1[0]) * u1[0], siluf_(g1[1]) * u1[1]); w.w = cvt_pk_bf16(siluf_(g1[2]) * u1[2], siluf_(g1[3]) * u1[3]);
                *(u32x4*)rowp = w; }
    }
};
struct EpiMoeDown {
    static constexpr bool PERM = false, AFTER_DRAIN = false;
    float* out; const int* stok; const float* sw;
    __device__ __forceinline__ void operator()(const f32x4 (&acc)[2][2][4][2], const pg8::Unit& u, int wr, int wc, int fr, int fq) const {
        const int row0 = u.pm * 256 + wr * 64 + fr, col0 = u.pn * 256 + wc * 32 + 4 * fq;
#pragma unroll
        for (int ai = 0; ai < 2; ++ai)
#pragma unroll
            for (int m = 0; m < 4; ++m) { const int rl = row0 + ai * 128 + m * 16; const int tok = stok[rl]; const float w = sw[rl];
                if (tok >= 0) { float* rp = out + (size_t)tok * D + col0;
#pragma unroll
                    for (int bj = 0; bj < 2; ++bj)
#pragma unroll
                        for (int n = 0; n < 2; ++n) { f32x4 o = *(const f32x4*)(rp + bj * 128 + n * 16); o = o + acc[ai][bj][m][n] * w; *(f32x4*)(rp + bj * 128 + n * 16) = o; } } }
    }
};

__device__ __forceinline__ void tc_job(const float* __restrict__ src, int K, int N, bf16_t* dst, int mode, int perm, LAS float* tile, int wg, int G, int tid) {
    LAUNDER(tid);
    const int tn = N / 64, nt = (K / 64) * tn;
    for (int t = wg; t < nt; t += G) {
        const int k0 = (t / tn) * 64, n0 = (t % tn) * 64;
#pragma unroll
        for (int ps = 0; ps < 2; ++ps) { const int r = (tid >> 4) + ps * 32; const float4 v = *(const float4*)(src + (size_t)(k0 + r) * N + n0 + (tid & 15) * 4);
            LAS float* tp = tile + r * 65 + (tid & 15) * 4; tp[0] = v.x; tp[1] = v.y; tp[2] = v.z; tp[3] = v.w; }
        __syncthreads();
        { const int n = tid >> 3, kg = (tid & 7) * 8; unsigned w[4];
#pragma unroll
          for (int j = 0; j < 4; ++j) w[j] = cvt_pk_bf16(tile[(kg + 2 * j) * 65 + n], tile[(kg + 2 * j + 1) * 65 + n]);
          const int nn = n0 + n; int drow = mode == 0 ? nn : ((nn >> 7) * 256 + (nn & 127) + (mode == 2 ? 128 : 0));
          if (perm) { const int c5 = drow & 31; drow = (drow & ~31) + 16 * ((c5 >> 2) & 1) + 4 * (c5 >> 3) + (c5 & 3); }
          *(uint4*)(dst + (size_t)drow * K + k0 + kg) = make_uint4(w[0], w[1], w[2], w[3]); }
        __syncthreads();
    }
}

template <bool ROUTER>
__device__ __forceinline__ void phase_rmsnorm(const float* __restrict__ x, const float* __restrict__ gain, bf16_t* xn, const float* __restrict__ rw, const float* __restrict__ rb,
                              int* toke, float2* tokw, int wg, int G, int wid, int lane) {
    LAUNDER(lane);
    for (int row = wg * NWAVES + wid; row < MTOK; row += G * NWAVES) {
        const float* xr = x + (size_t)row * D; float4 v[4]; float ss = 0.f;
#pragma unroll
        for (int j = 0; j < 4; ++j) { v[j] = *(const float4*)(xr + j * 256 + lane * 4); ss += v[j].x * v[j].x + v[j].y * v[j].y + v[j].z * v[j].z + v[j].w * v[j].w; }
        ss = wave_sum(ss);
        const float rstd = rsqrtf(ss * (1.f / D) + EPS);
        float lg[NEXP];
#pragma unroll
        for (int e = 0; e < NEXP; ++e) lg[e] = 0.f;
#pragma unroll
        for (int j = 0; j < 4; ++j) { const float4 g = *(const float4*)(gain + j * 256 + lane * 4);
            const float y0 = v[j].x * rstd * g.x, y1 = v[j].y * rstd * g.y, y2 = v[j].z * rstd * g.z, y3 = v[j].w * rstd * g.w;
            *(uint2*)(xn + (size_t)row * D + j * 256 + lane * 4) = make_uint2(cvt_pk_bf16(y0, y1), cvt_pk_bf16(y2, y3));
            if (ROUTER) { const float ys[4] = {y0, y1, y2, y3};
#pragma unroll
                for (int i = 0; i < 4; ++i) { const float* wr_ = rw + (size_t)(j * 256 + lane * 4 + i) * NEXP; const float4 wa = *(const float4*)wr_, wb = *(const float4*)(wr_ + 4);
                    lg[0] += ys[i] * wa.x; lg[1] += ys[i] * wa.y; lg[2] += ys[i] * wa.z; lg[3] += ys[i] * wa.w; lg[4] += ys[i] * wb.x; lg[5] += ys[i] * wb.y; lg[6] += ys[i] * wb.z; lg[7] += ys[i] * wb.w; } } }
        if (ROUTER) {
#pragma unroll
            for (int e = 0; e < NEXP; ++e) lg[e] = wave_sum(lg[e]) + rb[e];
            int i0 = 0; float l0 = lg[0];
#pragma unroll
            for (int e = 1; e < NEXP; ++e) if (lg[e] > l0) { l0 = lg[e]; i0 = e; }
            int i1 = -1; float l1 = -3.4e38f;
#pragma unroll
            for (int e = 0; e < NEXP; ++e) if (e != i0 && lg[e] > l1) { l1 = lg[e]; i1 = e; }
            const float w0 = __builtin_amdgcn_rcpf(1.f + __expf(l1 - l0));
            if (lane == 0) { toke[row] = i0 | (i1 << 8); tokw[row] = make_float2(w0, 1.f - w0); }
        }
    }
}

__device__ void phase_combine(const bf16_t* GH, bf16_t* mix, int wg, int G, int tid) {
    LAUNDER(tid);
    for (size_t v = (size_t)wg * NTHREADS + tid; v < (size_t)MTOK * (D / 8); v += (size_t)G * NTHREADS) {
        const size_t r = v / (D / 8); const int c = (int)(v % (D / 8)) * 8; const bf16_t* gp = GH + r * GCOLS + c;
        const uint4 a = *(const uint4*)gp, b = *(const uint4*)(gp + 1024), cc = *(const uint4*)(gp + 2048); uint4 o;
        o.x = cvt_pk_bf16(bflo(a.x) + bflo(b.x) + bflo(cc.x), bfhi(a.x) + bfhi(b.x) + bfhi(cc.x));
        o.y = cvt_pk_bf16(bflo(a.y) + bflo(b.y) + bflo(cc.y), bfhi(a.y) + bfhi(b.y) + bfhi(cc.y));
        o.z = cvt_pk_bf16(bflo(a.z) + bflo(b.z) + bflo(cc.z), bfhi(a.z) + bfhi(b.z) + bfhi(cc.z));
        o.w = cvt_pk_bf16(bflo(a.w) + bflo(b.w) + bflo(cc.w), bfhi(a.w) + bfhi(b.w) + bfhi(cc.w));
        *(uint4*)(mix + r * D + c) = o;
    }
}

__device__ __forceinline__ void moe_assign(const int* toke, const float2* tokw, int* meta, int* stok, float* sw, int* blke, LAS unsigned char* lds, int tid) {
    LAS int* cnt = (LAS int*)lds;
    LAS int* tot = cnt + 512 * 16;
    const int t0 = tid * (MTOK / NTHREADS);
    { int z = 0; asm volatile("" : "+v"(z));
      for (int j = 0; j < 16; ++j) cnt[tid * 16 + j] = z; }
    for (int i = 0; i < MTOK / NTHREADS; ++i) { const int ee = toke[t0 + i]; cnt[tid * 16 + (ee & 255)] += 1; cnt[tid * 16 + 8 + ((ee >> 8) & 255)] += 1; }
    __syncthreads();
    if (tid < 16) { int run = 0; for (int i = 0; i < NTHREADS; ++i) { const int v = cnt[i * 16 + tid]; cnt[i * 16 + tid] = run; run += v; } tot[tid] = run; }
    __syncthreads();
    if (tid == 0) { int run = 0; for (int j = 0; j < 16; ++j) { const int n = tot[j], pad = (n + 255) & ~255; tot[16 + j] = run; if (j == 8) { meta[0] = run; meta[3] = run; } run += pad; } meta[1] = run - tot[16 + 8]; meta[2] = 0; meta[4] = run; }
    __syncthreads();
    for (int bk = tid; bk < 2 * MOE_MAXBLK; bk += NTHREADS) { int ex = 0;
        for (int j = 0; j < 16; ++j) { const int base = tot[16 + j], pad = (tot[j] + 255) & ~255; if (bk * 256 >= base && bk * 256 < base + pad) ex = j & 7; }
        blke[bk] = ex; }
    for (int j = 0; j < 16; ++j) cnt[tid * 16 + j] += tot[16 + j];
    for (int i = 0; i < MTOK / NTHREADS; ++i) { const int tk = t0 + i; const int ee = toke[tk]; const int j0 = ee & 255, j1 = 8 + ((ee >> 8) & 255); const float2 w = tokw[tk];
        const int p0 = cnt[tid * 16 + j0]; cnt[tid * 16 + j0] = p0 + 1; const int p1 = cnt[tid * 16 + j1]; cnt[tid * 16 + j1] = p1 + 1;
        stok[p0] = tk; sw[p0] = w.x; stok[p1] = tk; sw[p1] = w.y; }
    for (int j = 0; j < 16; ++j) { const int n = tot[j], pad = (n + 255) & ~255, base = tot[16 + j]; for (int i = n + tid; i < pad; i += NTHREADS) { stok[base + i] = -1; sw[base + i] = 0.f; } }
}
__device__ __forceinline__ void moe_gather(const bf16_t* xn, const int* stok, int rows, bf16_t* xs, int wg, int G, int wid, int lane) {
    LAUNDER(lane);
    for (int r = wg * NWAVES + wid; r < rows; r += G * NWAVES) { const int tok = __hip_atomic_load(stok + r, __ATOMIC_RELAXED, __HIP_MEMORY_SCOPE_AGENT);
        uint4 a = make_uint4(0, 0, 0, 0), b = a;
        if (tok >= 0) { const uint4* sp = (const uint4*)(xn + (size_t)tok * D) + lane * 2; a = sp[0]; b = sp[1]; }
        uint4* dp = (uint4*)(xs + (size_t)r * D) + lane * 2; dp[0] = a; dp[1] = b; }
}

typedef pg8::bf16x8 bf16x8;
typedef unsigned u32x2 __attribute__((ext_vector_type(2)));
#define MFMA16(A, B, C) __builtin_amdgcn_mfma_f32_16x16x32_bf16((A), (B), (C), 0, 0, 0)
__device__ __forceinline__ bf16x8 mk8(unsigned a, unsigned b, unsigned c, unsigned d) { u32x4 v = {a, b, c, d}; return __builtin_bit_cast(bf16x8, v); }

constexpr int H_QD = 0, H_KD = 8704, H_KB = 17408, H_QG = 21760, H_KET = 30464, H_VT = 40704, H_PM = 50944, H_TP = 53504, H_GE = 55552;
constexpr size_t HG_DUMP_BYTES = (size_t)MTOK * 512 * 2, HG_U_BYTES = (size_t)256 * 128 * 128 * 4;
__device__ __forceinline__ void phase_hgrn_a(const bf16_t* P, bf16_t* qsc  , uint2* dump, float* U, float* Dsc, LAS unsigned char* lds, int wg, int G, int tid, int wid, int lane) {
    LAUNDER(tid); LAUNDER(lane);
    const int d = tid & 127, part = tid >> 7, g = lane >> 4, c16 = lane & 15;
    LAS float* TP = (LAS float*)(lds + H_TP); LAS float* GE = (LAS float*)(lds + H_GE);
    for (int item = wg; item < 256; item += G) {
        const int b = item >> 6, h = (item >> 4) & 3, sc = item & 15; const size_t tok0 = (size_t)b * SEQ + (size_t)sc * 512;
        f32x4 S[8];
#pragma unroll
        for (int i = 0; i < 8; ++i) S[i] = (f32x4){0.f, 0.f, 0.f, 0.f};
        float gsc = 0.f;
        unsigned lfv[8], qv[8], vv[8];
        { const bf16_t* base = P + (tok0 + 8 * part) * PCOLS + h * 128 + d;
#pragma unroll
          for (int j = 0; j < 8; ++j) { lfv[j] = base[(size_t)j * PCOLS + C_HF]; qv[j] = base[(size_t)j * PCOLS + C_HQ]; vv[j] = base[(size_t)j * PCOLS + C_HI]; } }
        for (int c = 0; c < 16; ++c) {
            float gl[8], lf[8], qf[8]; unsigned vb[8]; float run = 0.f;
#pragma unroll
            for (int j = 0; j < 8; ++j) { lf[j] = bf2f(lfv[j]); qf[j] = bf2f(qv[j]); vb[j] = vv[j]; run += lf[j]; gl[j] = run; }
            if (c < 15) { const bf16_t* base = P + (tok0 + (c + 1) * 32 + 8 * part) * PCOLS + h * 128 + d;
#pragma unroll
                for (int j = 0; j < 8; ++j) { lfv[j] = base[(size_t)j * PCOLS + C_HF]; qv[j] = base[(size_t)j * PCOLS + C_HQ]; vv[j] = base[(size_t)j * PCOLS + C_HI]; } }
            TP[part * 128 + d] = run;
            __syncthreads();
            const float t0 = TP[d], t1 = TP[128 + d], t2 = TP[256 + d], t3 = TP[384 + d];
            const float T0 = t0 + t1, gend = T0 + t2 + t3;
            const float pre = (part == 1) ? t0 : (part == 3) ? t2 : 0.f, gb = (part >> 1) ? T0 : 0.f;
            unsigned kep[4];
#pragma unroll
            for (int j = 0; j < 8; j += 2) {
                float ke2[2];
#pragma unroll
                for (int jj = 0; jj < 2; ++jj) { const int t = 8 * part + j + jj; const float Gl = pre + gl[j + jj], Gt = gb + Gl; const float k = 1.f - __expf(lf[j + jj]), q = qf[j + jj];
                    *(LAS bf16_t*)(lds + H_QD + t * 272 + d * 2) = f2bf(q * __expf(Gl));
                    *(LAS bf16_t*)(lds + H_KD + t * 272 + d * 2) = f2bf(k * __expf(fminf(-Gl, 80.f)));
                    if (part < 2) *(LAS bf16_t*)(lds + H_KB + t * 272 + d * 2) = f2bf(k * __expf(T0 - Gl));
                    *(LAS bf16_t*)(lds + H_QG + t * 272 + d * 2) = f2bf(q * __expf(Gt));
                    qsc[(tok0 + c * 32 + t) * 512 + h * 128 + d] = f2bf(q * __expf(gsc + Gt));
                    ke2[jj] = k * __expf(gend - Gt); }
                kep[j >> 1] = cvt_pk_bf16(ke2[0], ke2[1]); }
            *(LAS u32x4*)(lds + H_KET + d * 80 + part * 16) = (u32x4){kep[0], kep[1], kep[2], kep[3]};
            *(LAS u32x4*)(lds + H_VT + d * 80 + part * 16) = (u32x4){vb[0] | (vb[1] << 16), vb[2] | (vb[3] << 16), vb[4] | (vb[5] << 16), vb[6] | (vb[7] << 16)};
            if (part == 0) GE[d] = __expf(gend);
            gsc += gend;
            __syncthreads();
            if (wid < 3) { const int I = (wid == 0) ? 0 : 1, J = (wid == 2) ? 0 : I; f32x4 acc = {0.f, 0.f, 0.f, 0.f};
#pragma unroll
                for (int kk = 0; kk < 4; ++kk) { const bf16x8 A = *(const LAS bf16x8*)(lds + H_QD + (16 * I + c16) * 272 + kk * 64 + g * 16);
                    const bf16x8 B = (wid == 2) ? *(const LAS bf16x8*)(lds + H_KB + c16 * 272 + kk * 64 + g * 16) : *(const LAS bf16x8*)(lds + H_KD + (16 * J + c16) * 272 + kk * 64 + g * 16);
                    acc = MFMA16(A, B, acc); }
#pragma unroll
                for (int r = 0; r < 4; ++r) { const int t = 4 * g + r; const float v = (I == J && c16 > t) ? 0.f : acc[r]; *(LAS bf16_t*)(lds + H_PM + (16 * I + t) * 80 + (16 * J + c16) * 2) = f2bf(v); }
            } else if (wid == 3) {
#pragma unroll
                for (int r = 0; r < 4; ++r) *(LAS bf16_t*)(lds + H_PM + (4 * g + r) * 80 + (16 + c16) * 2) = (bf16_t)0;
            }
            __syncthreads();
            { const bf16x8 Bv = *(const LAS bf16x8*)(lds + H_VT + (16 * wid + c16) * 80 + g * 16);
              unsigned sp[8][2];
#pragma unroll
              for (int i = 0; i < 8; ++i) { sp[i][0] = cvt_pk_bf16(S[i][0], S[i][1]); sp[i][1] = cvt_pk_bf16(S[i][2], S[i][3]); }
              const size_t chunk_g = (tok0 >> 5) + c;
#pragma unroll
              for (int rt = 0; rt < 2; ++rt) { f32x4 o = {0.f, 0.f, 0.f, 0.f};
                  o = MFMA16(*(const LAS bf16x8*)(lds + H_PM + (16 * rt + c16) * 80 + g * 16), Bv, o);
#pragma unroll
                  for (int kk = 0; kk < 4; ++kk) { const LAS unsigned char* qp = lds + H_QG + (16 * rt + c16) * 272 + (32 * kk + 4 * g) * 2;
                      const u32x2 lo = *(const LAS u32x2*)qp, hi = *(const LAS u32x2*)(qp + 32);
                      o = MFMA16(mk8(lo.x, lo.y, hi.x, hi.y), mk8(sp[2 * kk][0], sp[2 * kk][1], sp[2 * kk + 1][0], sp[2 * kk + 1][1]), o); }
                  dump[(((chunk_g * 4 + h) * 2 + rt) * 8 + wid) * 64 + lane] = make_uint2(cvt_pk_bf16(o[0], o[1]), cvt_pk_bf16(o[2], o[3])); }
#pragma unroll
              for (int i = 0; i < 8; ++i) { const f32x4 dec = *(const LAS f32x4*)(lds + H_GE + (16 * i + 4 * g) * 4); S[i] = S[i] * dec;
                  S[i] = MFMA16(*(const LAS bf16x8*)(lds + H_KET + (16 * i + c16) * 80 + g * 16), Bv, S[i]); } }
            __syncthreads();
        }
#pragma unroll
        for (int i = 0; i < 8; ++i)
#pragma unroll
            for (int r = 0; r < 4; ++r) U[((size_t)item * 128 + 16 * i + 4 * g + r) * 128 + 16 * wid + c16] = S[i][r];
        if (part == 0) Dsc[item * 128 + d] = __expf(gsc);
    }
}
constexpr int HC_SIN = 0;
__device__ __forceinline__ void phase_hgrn_c(const bf16_t* P, bf16_t* qoa  , const uint2* dump, const float* U, const float* Dsc, const float* gain, LAS unsigned char* lds, int wg, int G, int tid, int wid, int lane) {
    LAUNDER(tid); LAUNDER(lane);
    const int g = lane >> 4, c16 = lane & 15;
    for (int item = wg; item < 256; item += G) {
        const int b = item >> 6, h = (item >> 4) & 3, sc = item & 15; const size_t tok0 = (size_t)b * SEQ + (size_t)sc * 512;
#pragma unroll 1
        for (int kq = 0; kq < 4; ++kq) { float s[8];
#pragma unroll
          for (int k = 0; k < 8; ++k) s[k] = 0.f;
#pragma unroll 1
          for (int j = 0; j < sc; ++j) { const size_t it = (size_t)(item - sc + j);
#pragma unroll
              for (int k = 0; k < 8; ++k) { const int e = tid + 512 * (kq * 8 + k); s[k] = Dsc[it * 128 + (e >> 7)] * s[k] + U[it * 16384 + e]; } }
#pragma unroll
          for (int k = 0; k < 8; ++k) { const int e = tid + 512 * (kq * 8 + k); *(LAS bf16_t*)(lds + HC_SIN + (e & 127) * 272 + (e >> 7) * 2) = f2bf(s[k]); } }
        __syncthreads();
#pragma unroll 1
        for (int rtile = 0; rtile < 4; ++rtile) {
            const size_t row0 = tok0 + 64 * wid + 16 * rtile; const size_t chunk_g = (tok0 >> 5) + 2 * wid + (rtile >> 1); const int rt = rtile & 1;
            bf16x8 A[4];
#pragma unroll
            for (int kk = 0; kk < 4; ++kk) A[kk] = *(const bf16x8*)(qoa + (row0 + c16) * 512 + h * 128 + 32 * kk + 8 * g);
            f32x4 acc[8]; float ss[4] = {0.f, 0.f, 0.f, 0.f};
#pragma unroll
            for (int vt = 0; vt < 8; ++vt) { acc[vt] = (f32x4){0.f, 0.f, 0.f, 0.f};
#pragma unroll
                for (int kk = 0; kk < 4; ++kk) acc[vt] = MFMA16(A[kk], *(const LAS bf16x8*)(lds + HC_SIN + (16 * vt + c16) * 272 + (32 * kk + 8 * g) * 2), acc[vt]);
                const uint2 ol = dump[(((chunk_g * 4 + h) * 2 + rt) * 8 + vt) * 64 + lane];
                acc[vt][0] += bflo(ol.x); acc[vt][1] += bfhi(ol.x); acc[vt][2] += bflo(ol.y); acc[vt][3] += bfhi(ol.y);
#pragma unroll
                for (int r = 0; r < 4; ++r) ss[r] += acc[vt][r] * acc[vt][r]; }
            float rstd[4];
#pragma unroll
            for (int r = 0; r < 4; ++r) { float s = ss[r]; s += xor_f<1>(s); s += xor_f<2>(s); s += xor_f<4>(s); s += xor_f<8>(s); rstd[r] = rsqrtf(s * (1.f / 128.f) + EPS); }
#pragma unroll
            for (int vt = 0; vt < 8; ++vt) { const float gn = gain[16 * vt + c16];
#pragma unroll
                for (int r = 0; r < 4; ++r) { const size_t row = row0 + 4 * g + r; const float hg = bf2f(P[row * PCOLS + C_HG + h * 128 + 16 * vt + c16]);
                    qoa[row * 512 + h * 128 + 16 * vt + c16] = f2bf(acc[vt][r] * rstd[r] * gn * hg); } }
        }
        __syncthreads();
    }
}

constexpr int GM_VT = 0, GM_W = 34816, GM_RS = 69632;
__device__ __forceinline__ void phase_gmlp(const bf16_t* P, const float* __restrict__ ws_l, const float* __restrict__ bs_l, const float* __restrict__ gv_l, bf16_t* ob, LAS unsigned char* lds, int wg, int G, int tid, int wid, int lane) {
    LAUNDER(tid); LAUNDER(lane);
    const int g = lane >> 4, c16 = lane & 15; LAS float* RS = (LAS float*)(lds + GM_RS);
    for (int item = wg; item < MTOK / 128; item += G) {
        const size_t tok0 = (size_t)item * 128;
        { const int s = tid >> 2, qd = tid & 3; const bf16_t* rp = P + (tok0 + s) * PCOLS + C_GV + qd * 128; float ss = 0.f;
#pragma unroll
          for (int j = 0; j < 16; ++j) { const uint4 x = *(const uint4*)(rp + j * 8); ss += bflo(x.x) * bflo(x.x) + bfhi(x.x) * bfhi(x.x) + bflo(x.y) * bflo(x.y) + bfhi(x.y) * bfhi(x.y) + bflo(x.z) * bflo(x.z) + bfhi(x.z) * bfhi(x.z) + bflo(x.w) * bflo(x.w) + bfhi(x.w) * bfhi(x.w); }
          ss += xor_f<1>(ss); ss += xor_f<2>(ss); if (qd == 0) RS[s] = rsqrtf(ss * (1.f / 512.f) + EPS); }
        for (int grp = 0; grp < 4; ++grp) {
            __syncthreads();
#pragma unroll
            for (int ps = 0; ps < 4; ++ps) { const int idx = tid + ps * 512, s = idx >> 4, c8 = (idx & 15) * 8; const uint4 x = *(const uint4*)(P + (tok0 + s) * PCOLS + C_GV + grp * 128 + c8);
                const float rs = RS[s]; const float4 ga = *(const float4*)(gv_l + grp * 128 + c8), gb = *(const float4*)(gv_l + grp * 128 + c8 + 4);
                const float e[8] = {bflo(x.x) * rs * ga.x, bfhi(x.x) * rs * ga.y, bflo(x.y) * rs * ga.z, bfhi(x.y) * rs * ga.w, bflo(x.z) * rs * gb.x, bfhi(x.z) * rs * gb.y, bflo(x.w) * rs * gb.z, bfhi(x.w) * rs * gb.w};
#pragma unroll
                for (int i = 0; i < 8; ++i) *(LAS bf16_t*)(lds + GM_VT + (c8 + i) * 272 + s * 2) = f2bf(e[i]);
                const int t = idx >> 4, s8 = (idx & 15) * 8; const float4 wa = *(const float4*)(ws_l + (size_t)grp * 16384 + t * 128 + s8), wb = *(const float4*)(ws_l + (size_t)grp * 16384 + t * 128 + s8 + 4);
                *(LAS u32x4*)(lds + GM_W + t * 272 + s8 * 2) = (u32x4){cvt_pk_bf16(s8 + 0 <= t ? wa.x : 0.f, s8 + 1 <= t ? wa.y : 0.f), cvt_pk_bf16(s8 + 2 <= t ? wa.z : 0.f, s8 + 3 <= t ? wa.w : 0.f),
                                                                    cvt_pk_bf16(s8 + 4 <= t ? wb.x : 0.f, s8 + 5 <= t ? wb.y : 0.f), cvt_pk_bf16(s8 + 6 <= t ? wb.z : 0.f, s8 + 7 <= t ? wb.w : 0.f)}; }
            __syncthreads();
            f32x4 acc[8];
#pragma unroll
            for (int ct = 0; ct < 8; ++ct) acc[ct] = (f32x4){0.f, 0.f, 0.f, 0.f};
            for (int kk = 0; kk <= (wid >> 1); ++kk) { const bf16x8 A = *(const LAS bf16x8*)(lds + GM_W + (16 * wid + c16) * 272 + kk * 64 + g * 16);
#pragma unroll
                for (int ct = 0; ct < 8; ++ct) acc[ct] = MFMA16(A, *(const LAS bf16x8*)(lds + GM_VT + (16 * ct + c16) * 272 + kk * 64 + g * 16), acc[ct]); }
#pragma unroll
            for (int r = 0; r < 4; ++r) { const int t = 16 * wid + 4 * g + r; const float bias = bs_l[grp * 128 + t]; const size_t tok = tok0 + t;
#pragma unroll
                for (int ct = 0; ct < 8; ++ct) { const int ch = grp * 128 + 16 * ct + c16; ob[tok * 512 + ch] = f2bf(bf2f(P[tok * PCOLS + C_GU + ch]) * (acc[ct][r] + bias)); } }
        }
        __syncthreads();
    }
}

constexpr int AT_KL = 0, AT_VT = 9216, AT_MIN = 9216 + 64 * 136;
__device__ __forceinline__ void phase_attn(const bf16_t* P, const float* __restrict__ gq, const float* __restrict__ gk, bf16_t* oc, LAS unsigned char* lds, int wg, int G, int tid, int wid, int lane) {
    LAUNDER(tid); LAUNDER(lane);
    const int g = lane >> 4, c16 = lane & 15; LAS float* MINW = (LAS float*)(lds + AT_MIN);
    const unsigned ONES = 0x3F803F80u;
    const unsigned tri_lo = ((4 * g + 0 >= c16) ? 0x3F80u : 0u) | ((4 * g + 1 >= c16) ? 0x3F800000u : 0u), tri_hi = ((4 * g + 2 >= c16) ? 0x3F80u : 0u) | ((4 * g + 3 >= c16) ? 0x3F800000u : 0u);
    for (int item = wg; item < NB * 8 * (SEQ / 128); item += G) {
        const int qt = item & 63, h = (item >> 6) & 7, b = item >> 9; const int t0 = qt * 128, tq0 = t0 + 16 * wid, t = tq0 + c16; const size_t tokb = (size_t)b * SEQ;
        bf16x8 Bq[2];
        { const bf16_t* qp = P + (tokb + t) * PCOLS + C_SQ + h * 64; const uint4 x0 = *(const uint4*)(qp + 8 * g), x1 = *(const uint4*)(qp + 32 + 8 * g);
          float e[16] = {bflo(x0.x), bfhi(x0.x), bflo(x0.y), bfhi(x0.y), bflo(x0.z), bfhi(x0.z), bflo(x0.w), bfhi(x0.w), bflo(x1.x), bfhi(x1.x), bflo(x1.y), bfhi(x1.y), bflo(x1.z), bfhi(x1.z), bflo(x1.w), bfhi(x1.w)};
          float ss = 0.f;
#pragma unroll
          for (int i = 0; i < 16; ++i) ss += e[i] * e[i];
          ss += xor_f<16>(ss); ss += bperm_f(ss, lane ^ 32);
          const float rq = rsqrtf(ss * (1.f / 64.f) + EPS) * 0.125f;
#pragma unroll
          for (int i = 0; i < 16; ++i) { const int dd = (i < 8 ? 8 * g + i : 32 + 8 * g + (i - 8)); e[i] = e[i] * rq * gq[dd] * gk[dd]; }
          Bq[0] = mk8(cvt_pk_bf16(e[0], e[1]), cvt_pk_bf16(e[2], e[3]), cvt_pk_bf16(e[4], e[5]), cvt_pk_bf16(e[6], e[7]));
          Bq[1] = mk8(cvt_pk_bf16(e[8], e[9]), cvt_pk_bf16(e[10], e[11]), cvt_pk_bf16(e[12], e[13]), cvt_pk_bf16(e[14], e[15])); }
        f32x4 O[4];
#pragma unroll
        for (int i = 0; i < 4; ++i) O[i] = (f32x4){0.f, 0.f, 0.f, 0.f};
        float carry = 0.f;
        for (int kb = (t0 + 127) >> 6; kb >= 0; --kb) {
            const int sb0 = kb * 64;
            __syncthreads();
            { const int s = tid >> 3, pc = tid & 7; const bf16_t* rp = P + (tokb + sb0 + s) * PCOLS + h * 64 + pc * 8;
              const uint4 kx = *(const uint4*)(rp + C_SK), vx = *(const uint4*)(rp + C_SV);
              float ke[8] = {bflo(kx.x), bfhi(kx.x), bflo(kx.y), bfhi(kx.y), bflo(kx.z), bfhi(kx.z), bflo(kx.w), bfhi(kx.w)}; float ssk = 0.f;
#pragma unroll
              for (int i = 0; i < 8; ++i) ssk += ke[i] * ke[i];
              ssk += xor_f<1>(ssk); ssk += xor_f<2>(ssk); ssk += xor_f<4>(ssk);
              const float rk = rsqrtf(ssk * (1.f / 64.f) + EPS);
              *(LAS u32x4*)(lds + AT_KL + s * 144 + pc * 16) = (u32x4){cvt_pk_bf16(ke[0] * rk, ke[1] * rk), cvt_pk_bf16(ke[2] * rk, ke[3] * rk), cvt_pk_bf16(ke[4] * rk, ke[5] * rk), cvt_pk_bf16(ke[6] * rk, ke[7] * rk)};
              const unsigned vw[4] = {vx.x, vx.y, vx.z, vx.w};
#pragma unroll
              for (int i = 0; i < 8; ++i) *(LAS bf16_t*)(lds + AT_VT + (pc * 8 + i) * 136 + s * 2) = (bf16_t)((vw[i >> 1] >> ((i & 1) * 16)) & 0xffffu); }
            __syncthreads();
            if (sb0 < tq0 + 15) {
                f32x4 z[4]; unsigned hi[4][2], lo[4][2];
#pragma unroll
                for (int st = 0; st < 4; ++st) { z[st] = (f32x4){0.f, 0.f, 0.f, 0.f};
#pragma unroll
                    for (int kk = 0; kk < 2; ++kk) z[st] = MFMA16(*(const LAS bf16x8*)(lds + AT_KL + (16 * st + c16) * 144 + kk * 64 + g * 16), Bq[kk], z[st]);
                    float spv[4];
#pragma unroll
                    for (int r = 0; r < 4; ++r) { const int s = sb0 + 16 * st + 4 * g + r; spv[r] = (s < t) ? softplusf_(z[st][r]) : 0.f; }
                    hi[st][0] = cvt_pk_bf16(spv[0], spv[1]); hi[st][1] = cvt_pk_bf16(spv[2], spv[3]);
                    lo[st][0] = cvt_pk_bf16(spv[0] - bflo(hi[st][0]), spv[1] - bfhi(hi[st][0])); lo[st][1] = cvt_pk_bf16(spv[2] - bflo(hi[st][1]), spv[3] - bfhi(hi[st][1])); }
                f32x4 sf[4];
#pragma unroll
                for (int so = 0; so < 4; ++so) { sf[so] = (f32x4){0.f, 0.f, 0.f, 0.f};
#pragma unroll
                    for (int kk = 0; kk < 2; ++kk) { if (2 * kk + 1 < so) continue;
                        const unsigned a0 = (2 * kk > so) ? ONES : (2 * kk == so) ? tri_lo : 0u, a1 = (2 * kk > so) ? ONES : (2 * kk == so) ? tri_hi : 0u;
                        const unsigned a2 = (2 * kk + 1 > so) ? ONES : tri_lo, a3 = (2 * kk + 1 > so) ? ONES : tri_hi;
                        const bf16x8 Lm = mk8(a0, a1, a2, a3);
                        sf[so] = MFMA16(Lm, mk8(hi[2 * kk][0], hi[2 * kk][1], hi[2 * kk + 1][0], hi[2 * kk + 1][1]), sf[so]);
                        sf[so] = MFMA16(Lm, mk8(lo[2 * kk][0], lo[2 * kk][1], lo[2 * kk + 1][0], lo[2 * kk + 1][1]), sf[so]); } }
                unsigned pa[4][2];
#pragma unroll
                for (int st = 0; st < 4; ++st) { float av[4];
#pragma unroll
                    for (int r = 0; r < 4; ++r) { const int s = sb0 + 16 * st + 4 * g + r; av[r] = (s < t) ? __expf(z[st][r] - carry - sf[st][r]) : 0.f; }
                    pa[st][0] = cvt_pk_bf16(av[0], av[1]); pa[st][1] = cvt_pk_bf16(av[2], av[3]); }
#pragma unroll
                for (int kk = 0; kk < 2; ++kk) { const bf16x8 Aop = mk8(pa[2 * kk][0], pa[2 * kk][1], pa[2 * kk + 1][0], pa[2 * kk + 1][1]);
#pragma unroll
                    for (int dt = 0; dt < 4; ++dt) { const LAS unsigned char* vp = lds + AT_VT + (16 * dt + c16) * 136 + (32 * kk + 4 * g) * 2; const u32x2 v0 = *(const LAS u32x2*)vp, v1 = *(const LAS u32x2*)(vp + 32);
                        O[dt] = MFMA16(Aop, mk8(v0.x, v0.y, v1.x, v1.y), O[dt]); } }
                carry += bperm_f(sf[0][0], c16);
            }
            float mn = carry; mn = fminf(mn, xor_f<1>(mn)); mn = fminf(mn, xor_f<2>(mn)); mn = fminf(mn, xor_f<4>(mn)); mn = fminf(mn, xor_f<8>(mn));
            if (lane == 0) MINW[wid] = mn;
            __syncthreads();
            float mall = MINW[0];
#pragma unroll
            for (int w = 1; w < 8; ++w) mall = fminf(mall, MINW[w]);
            if (mall > 104.f) break;
        }
#pragma unroll
        for (int dt = 0; dt < 4; ++dt)
#pragma unroll
            for (int r = 0; r < 4; ++r) oc[(tokb + tq0 + 4 * g + r) * 512 + h * 64 + 16 * dt + c16] = f2bf(O[dt][r]);
    }
}

#ifdef MK_CHECK
constexpr size_t WS_DIAG = WS_META + 2048;
constexpr size_t WS_SNAP = WS_BLKE + 4096;
static_assert(WS_SNAP + 64 * 1024 * 4 <= WS_W, "snapshot fits");
__device__ __forceinline__ int samp_row(int i) { return (int)(((unsigned)i * 2654435761u + 12345u) % (unsigned)MTOK); }
__device__ __forceinline__ void chk_fail(unsigned* diag, unsigned code) { atomicMin(diag, code); }
__device__ __forceinline__ bool chk_close(float got, float ref, float atol, float rtol) { return fabsf(got - ref) <= atol + rtol * fabsf(ref) && got == got; }

__global__ void k_diag_init(unsigned* diag) { if (threadIdx.x == 0 && blockIdx.x == 0) { diag[0] = 0xffffffffu; diag[16] = 0u; diag[17] = 0xffffffffu; diag[18] = 0u; diag[19] = 0u; diag[20] = 0u; diag[21] = 0u; diag[22] = 0u; diag[23] = 0u; diag[24] = 0u; diag[25] = 0u; diag[26] = 0u; } }
__global__ void k_snapshot(const float* x, float* snap) { const int i = blockIdx.x; const int r = samp_row(i); for (int c = threadIdx.x; c < D; c += blockDim.x) snap[i * D + c] = x[(size_t)r * D + c]; }
__global__ void k_apply_diag(float* out, const unsigned* diag) {
    if (blockIdx.x != 0 || threadIdx.x != 0) return;
    const unsigned code = diag[0]; if (code == 0xffffffffu) return;
    out[0] = (1.0f + 0.1f * (float)(code > 89u ? 89u : code)) * 1.0e6f;
}
struct ChkGemm { const bf16_t* A; int lda; const float* W; int ldw; int K; int mode; const bf16_t* Cb; int ldc; const float* Cf; const float* xold; const float* W2; const float* lb; const bf16_t* Gsrc; int ncols; unsigned code; int use_snap; };
__global__ void k_chk_gemm(ChkGemm c, unsigned* diag) {
    const int i = blockIdx.x; const int r = samp_row(i);
    for (int cc = threadIdx.x; cc < 96; cc += blockDim.x) {
        const int col = (int)(((unsigned)cc * 40503u + (unsigned)i * 977u) % (unsigned)c.ncols);
        float dot = 0.f, dot2 = 0.f;
        for (int k = 0; k < c.K; ++k) { const float av = bf2f(c.A[(size_t)r * c.lda + k]); dot += av * c.W[(size_t)k * c.ldw + col]; if (c.mode == 4) dot2 += av * c.W2[(size_t)k * c.ldw + col]; }
        float ref, got;
        if (c.mode == 0) { const int kind = col >> 9; ref = (kind == 0 || kind == 3) ? siluf_(dot) : kind == 1 ? __logf(c.lb[col - 512] + (1.f - c.lb[col - 512]) * sigmoidf_(dot)) : (kind == 4 || kind == 5) ? gelu_tanh_(dot) : dot; got = bf2f(c.Cb[(size_t)r * c.ldc + col]); }
        else if (c.mode == 1) { ref = sigmoidf_(dot); got = bf2f(c.Cb[(size_t)r * c.ldc + col]); }
        else if (c.mode == 3) { const float xo = c.use_snap ? c.xold[(size_t)i * D + col] : c.xold[(size_t)r * D + col]; ref = xo + dot; got = c.Cf[(size_t)r * D + col]; }
        else { ref = siluf_(dot) * dot2; got = bf2f(c.Cb[(size_t)r * c.ldc + col]); }
        if (!chk_close(got, ref, 0.03f, 0.03f)) { chk_fail(diag, c.code); if (c.mode == 1) { atomicOr(diag + 24 + (i >> 5), 1u << (i & 31)); atomicOr(diag + 26, 1u << ((r & 255) >> 4)); atomicOr(diag + 20 + ((col & 127) >> 5), 1u << (col & 31)); atomicAdd(diag + 16, 1u); atomicMin(diag + 17, (unsigned)(col >> 8)); atomicMax(diag + 18, (unsigned)(col >> 8)); if (fabsf(got - dot) <= 0.03f + 0.03f * fabsf(dot)) atomicAdd(diag + 19, 1u); } }
    }
}
__global__ void k_chk_branch(const bf16_t* ocat, const float* wbr  , const bf16_t* xn, const float* win  , const bf16_t* GH, unsigned code, unsigned* diag) {
    const int i = blockIdx.x; const int r = samp_row(i);
    for (int cc = threadIdx.x; cc < 96; cc += blockDim.x) {
        const int col = (int)(((unsigned)cc * 40503u + (unsigned)i * 977u) % 3072u); const int b = col >> 10, cl = col & 1023;
        float h = 0.f; for (int k = 0; k < 512; ++k) h += bf2f(ocat[(size_t)b * MTOK * 512 + (size_t)r * 512 + k]) * wbr[((size_t)b * 512 + k) * 1024 + cl];
        float g = 0.f; for (int k = 0; k < 1024; ++k) g += bf2f(xn[(size_t)r * D + k]) * win[(size_t)k * INCOLS + PCOLS + col];
        const float ref = sigmoidf_(g) * h, got = bf2f(GH[(size_t)r * GCOLS + col]);
        if (!chk_close(got, ref, 0.03f, 0.04f)) chk_fail(diag, code);
    }
}
__global__ void k_chk_attn(const bf16_t* P, const float* gq, const float* gk, const bf16_t* oc, unsigned code, unsigned* diag) {
    const int id = blockIdx.x, lane = threadIdx.x; const int ti = id % 10;
    const int t = ti == 0 ? 0 : ti == 1 ? 1 : ti == 2 ? 2 : ti == 3 ? 63 : ti == 4 ? 64 : ti == 5 ? 65 : ti == 6 ? 200 : ti == 7 ? 1000 : ti == 8 ? 4097 : 8191;
    const int h = (id / 10) % 8, b = id / 80; const size_t tokb = (size_t)b * SEQ;
    float q = bf2f(P[(tokb + t) * PCOLS + C_SQ + h * 64 + lane]); q = q * rsqrtf(wave_sum(q * q) / 64.f + EPS) * gq[lane];
    float o = 0.f, carry = 0.f;
    for (int s = t - 1; s >= 0 && carry < 300.f; --s) {
        float kv = bf2f(P[(tokb + s) * PCOLS + C_SK + h * 64 + lane]); kv = kv * rsqrtf(wave_sum(kv * kv) / 64.f + EPS) * gk[lane];
        const float z = wave_sum(q * kv) * 0.125f; const float sp = logf(1.f + expf(z));
        carry += sp; const float A = expf(z - carry);
        o += A * bf2f(P[(tokb + s) * PCOLS + C_SV + h * 64 + lane]);
    }
    if (!chk_close(bf2f(oc[(tokb + t) * 512 + h * 64 + lane]), o, 0.02f, 0.03f)) chk_fail(diag, code);
}
__global__ void k_chk_gmlp(const bf16_t* P, const float* ws_l, const float* bs_l, const float* gv_l, const bf16_t* ob, unsigned code, unsigned* diag) {
    const int id = blockIdx.x * blockDim.x + threadIdx.x; if (id >= 512) return;
    const int chunk = (id * 37) % (MTOK / 128), t = (id * 53 + 7) % 128, ch = (id * 101 + 3) % 512, g = ch >> 7, c = ch & 127; const size_t tok0 = (size_t)chunk * 128;
    float acc = 0.f;
    for (int s = 0; s <= t; ++s) { float ss = 0.f; for (int k = 0; k < 512; ++k) { const float v = bf2f(P[(tok0 + s) * PCOLS + C_GV + k]); ss += v * v; }
        const float vn = bf2f(P[(tok0 + s) * PCOLS + C_GV + ch]) * rsqrtf(ss / 512.f + EPS) * gv_l[ch]; acc += ws_l[(size_t)g * 16384 + t * 128 + s] * vn; }
    const float ref = bf2f(P[(tok0 + t) * PCOLS + C_GU + ch]) * (acc + bs_l[g * 128 + t]);
    if (!chk_close(bf2f(ob[(tok0 + t) * 512 + ch]), ref, 0.02f, 0.03f)) chk_fail(diag, code);
}
__global__ void k_chk_hgrn(const bf16_t* P, const float* gain, const bf16_t* oa, unsigned code, unsigned* diag) {
    const int id = blockIdx.x; const int ti = id % 8; const int t = ti == 0 ? 0 : ti == 1 ? 1 : ti == 2 ? 5 : ti == 3 ? 63 : ti == 4 ? 64 : ti == 5 ? 200 : ti == 6 ? 511 : 700, h = (id / 8) % 4, b = id / 32; const int v = threadIdx.x; const size_t tokb = (size_t)b * SEQ;
    float o = 0.f;
    for (int d = 0; d < 128; ++d) { float st = 0.f;
        for (int s = 0; s <= t; ++s) { const bf16_t* row = P + (tokb + s) * PCOLS; const float f = expf(bf2f(row[C_HF + h * 128 + d])); st = f * st + (1.f - f) * bf2f(row[C_HI + h * 128 + v]); }
        o += bf2f(P[(tokb + t) * PCOLS + C_HQ + h * 128 + d]) * st; }
    __shared__ float red[128]; red[v] = o * o; __syncthreads();
    for (int w = 64; w > 0; w >>= 1) { if (v < w) red[v] += red[v + w]; __syncthreads(); }
    const float rstd = rsqrtf(red[0] / 128.f + EPS);
    const float ref = o * rstd * gain[v] * bf2f(P[(tokb + t) * PCOLS + C_HG + h * 128 + v]);
    if (!chk_close(bf2f(oa[(tokb + t) * 512 + h * 128 + v]), ref, 0.03f, 0.04f)) chk_fail(diag, code);
}
__global__ void k_chk_moe(const bf16_t* xn, const float* rw, const float* rb, const float* wg, const float* wu, const float* wd, const float* snap, const float* xout, unsigned code, unsigned* diag) {
    const int i = blockIdx.x; const int r = samp_row(i); const int tid = threadIdx.x;
    __shared__ float hid[DFF]; __shared__ float lg[8]; __shared__ float part[256];
    if (tid < 8) { float a = rb[tid]; for (int k = 0; k < D; ++k) a += bf2f(xn[(size_t)r * D + k]) * rw[k * 8 + tid]; lg[tid] = a; }
    __syncthreads();
    int i0 = 0; for (int e = 1; e < 8; ++e) if (lg[e] > lg[i0]) i0 = e;
    int i1 = -1; for (int e = 0; e < 8; ++e) if (e != i0 && (i1 < 0 || lg[e] > lg[i1])) i1 = e;
    const float w0 = 1.f / (1.f + expf(lg[i1] - lg[i0])), w1 = 1.f - w0;
    float outv[8]; for (int j = 0; j < 8; ++j) outv[j] = 0.f;
    for (int kk = 0; kk < 2; ++kk) { const int e = kk ? i1 : i0; const float wgt = kk ? w1 : w0;
        for (int f = tid; f < DFF; f += blockDim.x) { float g = 0.f, u = 0.f; for (int k = 0; k < D; ++k) { const float xv = bf2f(xn[(size_t)r * D + k]); g += xv * wg[((size_t)e * D + k) * DFF + f]; u += xv * wu[((size_t)e * D + k) * DFF + f]; } hid[f] = siluf_(g) * u; }
        __syncthreads();
        for (int j = 0; j < 8; ++j) { const int col = (j * 131 + i * 17) % D; float p = 0.f; for (int f = tid; f < DFF; f += blockDim.x) p += hid[f] * wd[((size_t)e * DFF + f) * D + col];
            part[tid] = p; __syncthreads(); for (int w = 128; w > 0; w >>= 1) { if (tid < w) part[tid] += part[tid + w]; __syncthreads(); } outv[j] += wgt * part[0]; __syncthreads(); }
    }
    if (tid == 0) for (int j = 0; j < 8; ++j) { const int col = (j * 131 + i * 17) % D; const float ref = snap[(size_t)i * D + col] + outv[j]; if (!chk_close(xout[(size_t)r * D + col], ref, 0.04f, 0.04f)) chk_fail(diag, code); }
}
#endif

struct Args { const float* in[21]; float* out; unsigned char* ws; int lo, hi; };
constexpr int NSTEPS = 24;
__device__ __forceinline__ int laneid_() { int v; asm volatile("v_mbcnt_lo_u32_b32 %0, -1, 0\n\tv_mbcnt_hi_u32_b32 %0, -1, %0" : "=v"(v)); return v; }
#define LANEID (laneid_())

template <class Epi>
__device__ __forceinline__ void run_gemm(LAS unsigned char* lds, const Order& S, int K, const Epi& E, int wid) { pg8::gemm_phase<Epi, Order, true, true>(lds, K, S, E, wid); }

__global__ void __launch_bounds__(NTHREADS, 2) mk_fwd(Args a) {
    extern __shared__ __attribute__((aligned(16))) unsigned char lds_raw[];
    LAS unsigned char* lds = (LAS unsigned char*)lds_raw;
    const int wid = __builtin_amdgcn_readfirstlane((int)threadIdx.x >> 6);
    LAS unsigned* cblk = (LAS unsigned*)(lds + LDS_MISC);
    { const int tid = threadIdx.x;
      if (tid < 4) cblk[tid] = (tid == 2) ? xb_xcc_id() : 0u;
      if (tid < 46) { const unsigned long long pv = (tid < 42) ? (unsigned long long)a.in[tid >> 1] : (tid < 44) ? (unsigned long long)a.out : (unsigned long long)a.ws; cblk[4 + tid] = (tid & 1) ? (unsigned)(pv >> 32) : (unsigned)pv; }
      if (tid == 46) cblk[50] = (unsigned)a.lo; if (tid == 47) cblk[51] = (unsigned)a.hi; }
    __syncthreads();
#define CW(i) ((int)__builtin_amdgcn_readfirstlane(cblk[i]))
typedef __attribute__((address_space(1))) unsigned char gu8_t;
#define ARGP(i) ((unsigned char*)(gu8_t*)(((unsigned long long)(unsigned)CW(5 + 2 * (i)) << 32) | (unsigned long long)(unsigned)CW(4 + 2 * (i))))
#define IN(i) ((const float*)ARGP(i))
#define OUTP ((float*)ARGP(21))
#define WSP (ARGP(22))
#define GSZ ((int)gridDim.x)
#define WGI ((int)blockIdx.x)
    if (CW(51) - CW(50) > 1 && threadIdx.x == 0) (void)xb_add((unsigned*)(WSP + WS_CTL + CW_BAR) + XB_XCNT(CW(2)), 1u);
#ifndef PROBE_REP
#define PROBE_REP 0ull
#endif
#define RUN(k) (CW(50) <= (k) && (k) < CW(51))
#define NREP(bit) (((PROBE_REP >> (bit)) & 1ull) ? 2 : 1)
#define SEAM(k) do { if (CW(50) <= (k) && (k) + 1 < CW(51)) { XcdBarrier bar_; bar_.bar = (unsigned*)(WSP + WS_CTL + CW_BAR); bar_.x = (unsigned)CW(2); bar_.st = (volatile LAS unsigned*)cblk; xcd_barrier(bar_); } } while (0)

#define XRES (OUTP)
#define WIN ((bf16_t*)(WSP + WS_WIN))
#define WBR ((bf16_t*)(WSP + WS_WBR))
#define WOUT ((bf16_t*)(WSP + WS_WOUT))
#define WGU ((bf16_t*)(WSP + WS_WGU))
#define WDN ((bf16_t*)(WSP + WS_WD))
#define XNB ((bf16_t*)(WSP + WS_XN))
#define PBUF ((bf16_t*)(WSP + WS_P))
#define GBUF ((bf16_t*)(WSP + WS_G))
#define HIDB ((bf16_t*)(WSP + WS_HID))
#define OCATB ((bf16_t*)(WSP + WS_OCAT))
#define MWGU ((bf16_t*)(WSP + WS_MWGU))
#define MWDN ((bf16_t*)(WSP + WS_MWD))
#define XSB ((bf16_t*)(WSP + WS_XS))
#define MHIDB ((bf16_t*)(WSP + WS_MHID))
#define LBB ((float*)(WSP + WS_LB))
#define METAB ((int*)(WSP + WS_META))
#define TOKE ((int*)(WSP + WS_TOKE))
#define TOKW ((float2*)(WSP + WS_TOKW))
#define STOK ((int*)(WSP + WS_SLOTTOK))
#define SWB ((float*)(WSP + WS_SLOTW))
#define BLKE ((int*)(WSP + WS_BLKE))
#define HDUMP ((uint2*)(WSP + WS_ORAW))
#define HU ((float*)(WSP + WS_ORAW + HG_DUMP_BYTES))
#define HDSC ((float*)(WSP + WS_ORAW + HG_DUMP_BYTES + HG_U_BYTES))
#define TIDV (wid * 64 + LANEID)
    for (int rep_ = 0; rep_ < NREP(0); ++rep_) if (RUN(0)) {
        LAS float* tile = (LAS float*)lds; const int tid = TIDV;
#pragma unroll 1
        for (int j = 0; j < 13; ++j) {
            const float* src; bf16_t* dst; int K, N, mode = 0, perm = 1;
            if (j < 10) { const int l = j / 5, r = j % 5;
                if (r == 0) { src = IN(2) + (size_t)l * D * INCOLS; dst = WIN + (size_t)l * INCOLS * D; K = D; N = INCOLS; }
                else if (r < 4) { src = IN(10) + (size_t)(l * 3 + r - 1) * 512 * D; dst = WBR + (size_t)(l * 3 + r - 1) * D * 512; K = 512; N = D; }
                else { src = IN(11) + (size_t)l * D * D; dst = WOUT + (size_t)l * D * D; K = D; N = D; perm = 0; } }
            else if (j == 10) { src = IN(13); dst = WGU; K = D; N = DFF; mode = 1; }
            else if (j == 11) { src = IN(14); dst = WGU; K = D; N = DFF; mode = 2; }
            else { src = IN(15); dst = WDN; K = DFF; N = D; perm = 0; }
            tc_job(src, K, N, dst, mode, perm, tile, WGI, GSZ, tid);
        }
        if (WGI == 0) { const float a0 = IN(3)[tid], a1 = IN(3)[512 + tid]; LBB[tid] = 0.f; LBB[512 + tid] = sigmoidf_(a1 - a0); }
    }
    if (RUN(0)) { __syncthreads(); phase_rmsnorm<false>(IN(0), IN(1), XNB, nullptr, nullptr, nullptr, nullptr, WGI, GSZ, wid, LANEID); }
    SEAM(0);

    for (int l = 0; l < 2; ++l) {
        const int sb = l * 10;
        if (l == 1) { for (int rep_ = 0; rep_ < NREP(1); ++rep_) if (RUN(10)) phase_rmsnorm<false>(XRES, IN(1) + D, XNB, nullptr, nullptr, nullptr, nullptr, WGI, GSZ, wid, LANEID); SEAM(10); }
        for (int rep_ = 0; rep_ < NREP(2); ++rep_) if (RUN(sb + 1)) { Order S; S.init(XNB, WIN + (size_t)l * INCOLS * D, MTOK, PCOLS, D, GSZ, WGI); EpiAct E{PBUF, PCOLS, LBB + l * 512, 1}; run_gemm(lds, S, D, E, wid); }
        SEAM(sb + 1);
        for (int rep_ = 0; rep_ < NREP(3); ++rep_) if (RUN(sb + 2)) {
            phase_hgrn_a(PBUF, OCATB, HDUMP, HU, HDSC, lds, WGI, GSZ, TIDV, wid, LANEID);
            __syncthreads();
            phase_attn(PBUF, IN(8) + l * 64, IN(9) + l * 64, OCATB + (size_t)2 * MTOK * 512, lds, WGI, GSZ, TIDV, wid, LANEID);
            __syncthreads();
            phase_gmlp(PBUF, IN(6) + (size_t)l * 4 * 16384, IN(7) + l * 512, IN(5) + l * 512, OCATB + (size_t)MTOK * 512, lds, WGI, GSZ, TIDV, wid, LANEID);
        }
        SEAM(sb + 2);
        if (RUN(sb + 3)) phase_hgrn_c(PBUF, OCATB, HDUMP, HU, HDSC, IN(4) + l * 128, lds, WGI, GSZ, TIDV, wid, LANEID);
        SEAM(sb + 3);
        for (int rep_ = 0; rep_ < NREP(4); ++rep_) if (RUN(sb + 4)) { Order S; S.init(XNB, WIN + (size_t)l * INCOLS * D + (size_t)PCOLS * D, MTOK, GCOLS, D, GSZ, WGI); EpiAct E{GBUF, GCOLS, nullptr, 0}; run_gemm(lds, S, D, E, wid); }
        SEAM(sb + 4);
        if (RUN(sb + 5)) { Order S; S.init(OCATB, WBR + (size_t)l * 3 * D * 512, MTOK, GCOLS, 512, GSZ, WGI, 3, (size_t)MTOK * 512 * 2, (size_t)D * 512 * 2); EpiBranch E{GBUF, XNB}; run_gemm(lds, S, 512, E, wid); }
        SEAM(sb + 5);
        if (RUN(sb + 6)) { Order S; S.init(XNB, WOUT + (size_t)l * D * D, MTOK, D, D, GSZ, WGI); EpiResid E{(l == 0) ? IN(0) : (const float*)XRES, XRES}; run_gemm(lds, S, D, E, wid); }
        SEAM(sb + 6);
        if (l == 0) {
            for (int rep_ = 0; rep_ < NREP(6); ++rep_) if (RUN(7)) phase_rmsnorm<false>(XRES, IN(12), XNB, nullptr, nullptr, nullptr, nullptr, WGI, GSZ, wid, LANEID);
            SEAM(7);
            for (int rep_ = 0; rep_ < NREP(7); ++rep_) if (RUN(8)) { Order S; S.init(XNB, WGU, MTOK, 2 * DFF, D, GSZ, WGI); EpiGU E{HIDB}; run_gemm(lds, S, D, E, wid); }
            SEAM(8);
            if (RUN(9)) { Order S; S.init(HIDB, WDN, MTOK, D, DFF, GSZ, WGI); EpiResid E{XRES, XRES}; run_gemm(lds, S, DFF, E, wid); }
            SEAM(9);
        } else {
            for (int rep_ = 0; rep_ < NREP(8); ++rep_) if (RUN(17)) phase_rmsnorm<true>(XRES, IN(12) + D, XNB, IN(16), IN(17), TOKE, TOKW, WGI, GSZ, wid, LANEID);
            SEAM(17);
            for (int rep_ = 0; rep_ < NREP(9); ++rep_) if (RUN(18)) {
                if (WGI == GSZ - 1) moe_assign(TOKE, TOKW, METAB, STOK, SWB, BLKE, lds, TIDV);
                else { LAS float* tile = (LAS float*)lds; const int tid = TIDV;
#pragma unroll 1
                    for (int j = 0; j < 3 * NEXP; ++j) { const int e = j / 3, r = j % 3;
                        const float* src = (r == 0 ? IN(18) : r == 1 ? IN(19) : IN(20)) + (size_t)e * D * DFF;
                        bf16_t* dst = (r == 2) ? MWDN + (size_t)e * D * DFF : MWGU + (size_t)e * 2 * DFF * D;
                        tc_job(src, r == 2 ? DFF : D, r == 2 ? D : DFF, dst, r == 2 ? 0 : r + 1, r == 2 ? 0 : 1, tile, WGI, GSZ - 1, tid); } }
            }
            SEAM(18);
#define META(i) __hip_atomic_load(METAB + (i), __ATOMIC_RELAXED, __HIP_MEMORY_SCOPE_AGENT)
            if (RUN(19)) { const int rows = META(0), s0 = META(2); moe_gather(XNB, STOK + s0, rows, XSB, WGI, GSZ, wid, LANEID); }
            SEAM(19);
            for (int kc = 0; kc < 2; ++kc) {
                const int se = 20 + 2 * kc;
                for (int rep_ = 0; rep_ < NREP(11); ++rep_) if (RUN(se)) { const int rows = META(kc), s0 = META(2 + kc);
                    Order S; S.init(XSB, MWGU, rows, 2 * DFF, D, GSZ, WGI, 2, 0, (size_t)2 * DFF * D * 2, BLKE + (s0 >> 8)); EpiGU E{MHIDB}; run_gemm(lds, S, D, E, wid); }
                SEAM(se);
                if (RUN(se + 1)) { const int rows = META(kc), s0 = META(2 + kc);
                    Order S; S.init(MHIDB, MWDN, rows, D, DFF, GSZ, WGI, 2, 0, (size_t)D * DFF * 2, BLKE + (s0 >> 8)); EpiMoeDown E{XRES, STOK + s0, SWB + s0}; run_gemm(lds, S, DFF, E, wid);
                    if (kc == 0) { const int rows1 = META(1), s1 = META(3); moe_gather(XNB, STOK + s1, rows1, XSB, WGI, GSZ, wid, LANEID); } }
                SEAM(se + 1);
            }
        }
    }
}

extern "C" void kernel_launch(void* const* d_in, const int* in_sizes, int n_in, void* d_out, int out_size, void* d_ws, size_t ws_size, hipStream_t stream) {
    static int grid = 0;
    if (grid == 0) {
        if (n_in != 21 || out_size != MTOK * D || ws_size < WS_NEED) { fprintf(stderr, "kernel_launch: unexpected shapes (n_in %d out %d ws %zu need %zu)\n", n_in, out_size, ws_size, (size_t)WS_NEED); grid = -1; return; }
        int dev = 0, cus = 0, per_cu = 0;
        if (hipGetDevice(&dev) != hipSuccess || hipDeviceGetAttribute(&cus, hipDeviceAttributeMultiprocessorCount, dev) != hipSuccess) { grid = -1; return; }
        if (hipFuncSetAttribute((const void*)mk_fwd, hipFuncAttributeMaxDynamicSharedMemorySize, LDS_BYTES) != hipSuccess) { fprintf(stderr, "kernel_launch: hipFuncSetAttribute failed\n"); grid = -1; return; }
        if (hipOccupancyMaxActiveBlocksPerMultiprocessor(&per_cu, (const void*)mk_fwd, NTHREADS, LDS_BYTES) != hipSuccess || per_cu < 1) { fprintf(stderr, "kernel_launch: occupancy query says %d\n", per_cu); (void)hipGetLastError(); per_cu = 1; }
        grid = cus;
    }
    if (grid < 0) return;
    (void)hipMemsetAsync((char*)d_ws + WS_CTL, 0, CTL_BYTES, stream);
    Args a{};
    for (int i = 0; i < 21; ++i) a.in[i] = (const float*)d_in[i];
    a.out = (float*)d_out; a.ws = (unsigned char*)d_ws;
#if defined(MK_CHECK)
    {
        unsigned char* ws = (unsigned char*)d_ws; unsigned* diag = (unsigned*)(ws + WS_DIAG); float* snap = (float*)(ws + WS_SNAP);
        const bf16_t* XN = (const bf16_t*)(ws + WS_XN); const bf16_t* Pb = (const bf16_t*)(ws + WS_P); const bf16_t* OC = (const bf16_t*)(ws + WS_OCAT); const float* LB = (const float*)(ws + WS_LB);
        auto run = [&](int s) { a.lo = s; a.hi = s + 1; hipLaunchKernelGGL(mk_fwd, dim3(grid), dim3(NTHREADS), LDS_BYTES, stream, a); };
        hipLaunchKernelGGL(k_diag_init, dim3(1), dim3(64), 0, stream, diag);
        int s = 0; run(s++);
        for (int l = 0; l < 2; ++l) {
            const unsigned cb = l * 10;
            const float* win = a.in[2] + (size_t)l * D * INCOLS;
            if (l == 1) run(s++);
            run(s++);
            { ChkGemm c{}; c.A = XN; c.lda = D; c.W = win; c.ldw = INCOLS; c.K = D; c.mode = 0; c.Cb = Pb; c.ldc = PCOLS; c.lb = LB + l * 512; c.ncols = PCOLS; c.code = cb + 1; hipLaunchKernelGGL(k_chk_gemm, dim3(64), dim3(96), 0, stream, c, diag); }
            run(s++); run(s++);
            hipLaunchKernelGGL(k_chk_hgrn, dim3(128), dim3(128), 0, stream, Pb, a.in[4] + l * 128, OC, cb + 2, diag);
            hipLaunchKernelGGL(k_chk_gmlp, dim3(8), dim3(64), 0, stream, Pb, a.in[6] + (size_t)l * 4 * 16384, a.in[7] + l * 512, a.in[5] + l * 512, OC + (size_t)MTOK * 512, cb + 3, diag);
            hipLaunchKernelGGL(k_chk_attn, dim3(320), dim3(64), 0, stream, Pb, a.in[8] + l * 64, a.in[9] + l * 64, OC + (size_t)2 * MTOK * 512, cb + 4, diag);
            run(s++);
            { ChkGemm c{}; c.A = XN; c.lda = D; c.W = win + PCOLS; c.ldw = INCOLS; c.K = D; c.mode = 1; c.Cb = (const bf16_t*)(ws + WS_G); c.ldc = GCOLS; c.ncols = GCOLS; c.code = cb + 5; hipLaunchKernelGGL(k_chk_gemm, dim3(64), dim3(96), 0, stream, c, diag); }
            run(s++);
            if (l == 1) hipLaunchKernelGGL(k_snapshot, dim3(64), dim3(256), 0, stream, (const float*)d_out, snap);
            run(s++);
            { ChkGemm c{}; c.A = XN; c.lda = D; c.W = a.in[11] + (size_t)l * D * D; c.ldw = D; c.K = D; c.mode = 3; c.Cf = (const float*)d_out; c.xold = l ? snap : a.in[0]; c.use_snap = l; c.ncols = D; c.code = cb + 7; hipLaunchKernelGGL(k_chk_gemm, dim3(64), dim3(96), 0, stream, c, diag); }
            run(s++);
            if (l == 0) {
                run(s++);
                { ChkGemm c{}; c.A = XN; c.lda = D; c.W = a.in[13]; c.W2 = a.in[14]; c.ldw = DFF; c.K = D; c.mode = 4; c.Cb = (const bf16_t*)(ws + WS_HID); c.ldc = DFF; c.ncols = DFF; c.code = cb + 8; hipLaunchKernelGGL(k_chk_gemm, dim3(64), dim3(96), 0, stream, c, diag); }
                hipLaunchKernelGGL(k_snapshot, dim3(64), dim3(256), 0, stream, (const float*)d_out, snap);
                run(s++);
                { ChkGemm c{}; c.A = (const bf16_t*)(ws + WS_HID); c.lda = DFF; c.W = a.in[15]; c.ldw = D; c.K = DFF; c.mode = 3; c.Cf = (const float*)d_out; c.xold = snap; c.use_snap = 1; c.ncols = D; c.code = cb + 9; hipLaunchKernelGGL(k_chk_gemm, dim3(64), dim3(96), 0, stream, c, diag); }
            } else {
                hipLaunchKernelGGL(k_snapshot, dim3(64), dim3(256), 0, stream, (const float*)d_out, snap);
                for (int e = 0; e < 6; ++e) run(s++);
                hipLaunchKernelGGL(k_chk_moe, dim3(16), dim3(256), 0, stream, XN, a.in[16], a.in[17], a.in[18], a.in[19], a.in[20], (const float*)snap, (const float*)d_out, 20u, diag);
            }
        }
        if (s != NSTEPS) fprintf(stderr, "step count mismatch %d\n", s);
        hipLaunchKernelGGL(k_apply_diag, dim3(1024), dim3(256), 0, stream, (float*)d_out, (const unsigned*)diag);
    }
#elif !defined(MK_ONE_LAUNCH)
    for (int s = 0; s < NSTEPS; ++s) { a.lo = s; a.hi = s + 1; hipLaunchKernelGGL(mk_fwd, dim3(grid), dim3(NTHREADS), LDS_BYTES, stream, a); }
#else
    a.lo = 0; a.hi = NSTEPS; hipLaunchKernelGGL(mk_fwd, dim3(grid), dim3(NTHREADS), LDS_BYTES, stream, a);
#endif
}
```

```cpp
#define MK_ONE_LAUNCH 1
#include <hip/hip_runtime.h>
#include <cstdio>
#include <cstdint>
#include <cstddef>

#define LAS __attribute__((address_space(3)))
#define XB_TMO      128
#define XB_XCNT(j)  (256  + 64 * (j))
#define XB_XSUB(j)  (1280 + 64 * (j))
#define XB_XGEN(j)  (2304 + 64 * (j))
#define XB_TOP      3328
#define XB_TOPGEN   3392
#define XCD_BAR_WORDS 3456
#define XB_SPIN_CAP (1u << 18)

__device__ __forceinline__ unsigned xb_ld(unsigned* p)              { return __hip_atomic_load(p, __ATOMIC_RELAXED, __HIP_MEMORY_SCOPE_AGENT); }
__device__ __forceinline__ unsigned xb_add(unsigned* p, unsigned v) { return __hip_atomic_fetch_add(p, v, __ATOMIC_RELAXED, __HIP_MEMORY_SCOPE_AGENT); }
__device__ __forceinline__ unsigned xb_xcc_id() { return (unsigned)__builtin_amdgcn_s_getreg((3 << 11) | 20) & 0xFu; }
#define XB_SPIN(cond, bar) do { unsigned _sp = 0; while (cond) { __builtin_amdgcn_s_sleep(1); \
    if ((++_sp & 255u) == 0u) { if (xb_ld(&(bar)[XB_TMO])) break; if (_sp > XB_SPIN_CAP) { atomicAdd(&(bar)[XB_TMO], 1u); break; } } } } while (0)

struct XcdBarrier {
    unsigned* bar; unsigned x;
    volatile LAS unsigned* st;
};

__device__ __forceinline__ XcdBarrier xcd_barrier_post(unsigned* bar, volatile LAS unsigned* st) {
    XcdBarrier b; b.bar = bar; b.x = xb_xcc_id(); b.st = st;
    if (threadIdx.x == 0) (void)xb_add(&bar[XB_XCNT(b.x)], 1u);
    return b;
}
__device__ __forceinline__ void xcd_barrier_complete(unsigned* bar, unsigned x, unsigned& nloc, unsigned& nx) {
    const unsigned G = gridDim.x * gridDim.y * gridDim.z;
    unsigned sum, cnt, mine, sp = 0u;
    for (;;) {
        sum = 0u; cnt = 0u; mine = 0u;
#pragma unroll
        for (unsigned j = 0; j < 16; ++j) { const unsigned c = xb_ld(&bar[XB_XCNT(j)]); sum += c; cnt += (c > 0u) ? 1u : 0u; mine = (j == x) ? c : mine; }
        if (sum == G) break;
        __builtin_amdgcn_s_sleep(1);
        if ((++sp & 255u) == 0u) { if (xb_ld(&bar[XB_TMO])) break; if (sp > XB_SPIN_CAP) { atomicAdd(&bar[XB_TMO], 1u); break; } }
    }
    nloc = mine > 0u ? mine : 1u; nx = cnt > 0u ? cnt : 1u;
}

__device__ __forceinline__ void xcd_barrier(const XcdBarrier& b) {
    asm volatile("s_waitcnt vmcnt(0)" ::: "memory");
    __syncthreads();
    if (threadIdx.x == 0) {
        unsigned* bar = b.bar;
        __builtin_amdgcn_s_waitcnt(0);
        unsigned nloc = b.st[0], nx = b.st[1];
        if (nloc == 0u) { xcd_barrier_complete(bar, b.x, nloc, nx); b.st[0] = nloc; b.st[1] = nx; }
        const unsigned old = xb_add(&bar[XB_XSUB(b.x)], 1u);
        const unsigned gen = old / nloc;
        if (old + 1u == (gen + 1u) * nloc) {
            __builtin_amdgcn_fence(__ATOMIC_RELEASE, "agent");
            asm volatile("s_waitcnt vmcnt(0)" ::: "memory");
            const unsigned og = xb_add(&bar[XB_TOP], 1u);
            const unsigned tg = og / nx;
            if (og + 1u == (tg + 1u) * nx) xb_add(&bar[XB_TOPGEN], 1u);
            else XB_SPIN(xb_ld(&bar[XB_TOPGEN]) == tg, bar);
            __builtin_amdgcn_fence(__ATOMIC_ACQUIRE, "agent");
            xb_add(&bar[XB_XGEN(b.x)], 1u);
            asm volatile("s_waitcnt vmcnt(0)" ::: "memory");
        } else {
            XB_SPIN(xb_ld(&bar[XB_XGEN(b.x)]) == gen, bar);
            __builtin_amdgcn_fence(__ATOMIC_ACQUIRE, "agent");
            asm volatile("s_waitcnt vmcnt(0)" ::: "memory");
        }
    }
    __syncthreads();
}
namespace pg8 {
#define PG8_LAS __attribute__((address_space(3)))
typedef unsigned short bf16_t;
typedef short bf16x8 __attribute__((ext_vector_type(8)));
typedef float f32x4 __attribute__((ext_vector_type(4)));
typedef unsigned u32x4 __attribute__((ext_vector_type(4)));
constexpr int BM = 256, BK = 64, HALF = 128, HTB = HALF * BK * 2  , STAGE_BYTES = 8 * HTB, NXCD = 8, WGM = 8;

__host__ __device__ __forceinline__ int lds_byte(int r, int c) { const int st = (r >> 4) * 2 + (c >> 5), rr = r & 15, cc = c & 31, ob = rr * 64 + cc * 2; return st * 1024 + (ob ^ (((ob >> 9) & 1) << 5)); }
__host__ __device__ __forceinline__ void stage_rc(int b, int& R, int& C) { const int st = b / 1024, sb = b % 1024, swz = sb ^ (((sb >> 9) & 1) << 5); R = (st >> 1) * 16 + swz / 64; C = (st & 1) * 32 + (swz % 64) / 2; }
__host__ __device__ __forceinline__ int perm32(int rho) { const int n = rho >> 4, i = rho & 15; return 8 * (i >> 2) + 4 * n + (i & 3); }

struct Unit { int pm, pn; const char* a; const char* b; };

typedef float f32x2 __attribute__((ext_vector_type(2))); typedef __bf16 bf16x2_t __attribute__((ext_vector_type(2)));
__device__ __forceinline__ unsigned cvt_pk_bf16(float lo, float hi) { f32x2 v = {lo, hi}; bf16x2_t b = __builtin_convertvector(v, bf16x2_t); return __builtin_bit_cast(unsigned, b); }
template <class Epi, class Sched, bool ALIGN_EPI = false, bool SP2 = false>
__device__ __forceinline__ void gemm_phase(PG8_LAS unsigned char* lds, const int K, const Sched& S, const Epi& E, const int wid) {
    int lane; asm volatile("v_mbcnt_lo_u32_b32 %0, -1, 0\n\tv_mbcnt_hi_u32_b32 %0, -1, %0" : "=v"(lane));
    const int tid = wid * 64 + lane, wr = wid >> 2, wc = wid & 3, fr = lane & 15, fq = lane >> 4;
    const int nt = K / BK;
    unsigned voffA[2];
#pragma unroll
    for (int i = 0; i < 2; ++i) { int R, C; stage_rc(tid * 16 + i * 8192, R, C); voffA[i] = (unsigned)(R * K + C) * 2u; }
    const size_t kstep = (size_t)(BK * 2);
    const size_t hstep = (size_t)HALF * K * 2;
    const unsigned ldsw = (unsigned)wid * 1024u;
    const int aoff = lds_byte(wr * 64 + fr, fq * 8), boff = lds_byte(wc * 32 + fr, fq * 8);
#define PG8_SA(b, h) (((b) * 2 + (h)) * HTB)
#define PG8_SB(b, h) ((4 + (b) * 2 + (h)) * HTB)
#define PG8_STAGE(bufoff, gbase, voff) do { _Pragma("unroll") for (int _i = 0; _i < 2; ++_i) \
        __builtin_amdgcn_global_load_lds((const unsigned*)((const char*)(gbase) + (voff)[_i]), (PG8_LAS unsigned*)(lds + (bufoff) + ldsw + _i * 8192), 16, 0, 0); } while (0)
#define PG8_LDA(dst, b, h) do { _Pragma("unroll") for (int m = 0; m < 4; ++m) _Pragma("unroll") for (int k = 0; k < 2; ++k) dst[m][k] = *(const PG8_LAS bf16x8*)(lds + PG8_SA(b, h) + aoff + m * 2048 + k * 1024); } while (0)
#define PG8_LDB(dst, b, h) do { _Pragma("unroll") for (int n = 0; n < 2; ++n) _Pragma("unroll") for (int k = 0; k < 2; ++k) dst[n][k] = *(const PG8_LAS bf16x8*)(lds + PG8_SB(b, h) + boff + n * 2048 + k * 1024); } while (0)
#define PG8_MMA(ai, bj, At, Bt) do { __builtin_amdgcn_s_setprio(1); _Pragma("unroll") for (int m = 0; m < 4; ++m) _Pragma("unroll") for (int n = 0; n < 2; ++n) _Pragma("unroll") for (int k = 0; k < 2; ++k) \
        acc[ai][bj][m][n] = __builtin_amdgcn_mfma_f32_16x16x32_bf16(Bt[n][k], At[m][k], acc[ai][bj][m][n], 0, 0, 0); __builtin_amdgcn_s_setprio(0); } while (0)
#define PG8_WAIT_V(n) asm volatile("s_waitcnt vmcnt(" #n ")" ::: "memory")
#define PG8_WAIT_L(n) asm volatile("s_waitcnt lgkmcnt(" #n ")" ::: "memory")
#define PG8_BAR __builtin_amdgcn_s_barrier()
#define PG8_SCHED __builtin_amdgcn_sched_barrier(0)
    Unit cur, nxt; int ui = 0;
    if (!S.next(0, cur)) return;
    f32x4 acc[2][2][4][2];
#pragma unroll
    for (int a = 0; a < 2; ++a)
#pragma unroll
        for (int b = 0; b < 2; ++b)
#pragma unroll
            for (int m = 0; m < 4; ++m)
#pragma unroll
                for (int n = 0; n < 2; ++n) acc[a][b][m][n] = (f32x4){0.f, 0.f, 0.f, 0.f};
    bf16x8 At[4][2], B0[2][2], B1[2][2];
    const char* cA = cur.a; const char* cB = cur.b;
    S.a_ready(cur);
    if constexpr (SP2) {
        PG8_STAGE(PG8_SB(0, 0), cB, voffA); PG8_STAGE(PG8_SB(0, 1), cB + hstep, voffA); PG8_STAGE(PG8_SA(0, 0), cA, voffA); PG8_STAGE(PG8_SA(0, 1), cA + hstep, voffA);
        if (wr == 1) PG8_BAR;
        PG8_WAIT_V(2); PG8_BAR;
        PG8_STAGE(PG8_SB(1, 0), cB + kstep, voffA); PG8_STAGE(PG8_SA(1, 0), cA + kstep, voffA); PG8_STAGE(PG8_SB(1, 1), cB + hstep + kstep, voffA);
        PG8_WAIT_V(6); PG8_BAR;
    } else {
        PG8_STAGE(PG8_SB(0, 0), cB, voffA); PG8_STAGE(PG8_SA(0, 0), cA, voffA); PG8_STAGE(PG8_SB(0, 1), cB + hstep, voffA); PG8_STAGE(PG8_SA(0, 1), cA + hstep, voffA);
        if (wr == 1) PG8_BAR;
        PG8_WAIT_V(4); PG8_BAR;
        PG8_STAGE(PG8_SB(1, 0), cB + kstep, voffA); PG8_STAGE(PG8_SA(1, 0), cA + kstep, voffA); PG8_STAGE(PG8_SB(1, 1), cB + hstep + kstep, voffA);
        PG8_WAIT_V(6); PG8_BAR;
    }
    for (;;) {
        const bool has_next = S.next(ui + 1, nxt);
        const char* nA = has_next ? nxt.a : cA; const char* nB = has_next ? nxt.b : cB;
        for (int t = 0; t < nt; t += 2) {
            const bool last = (t == nt - 2);
            const char* a1 = cA + (size_t)(t + 1) * kstep;
            const char* a2 = last ? nA : cA + (size_t)(t + 2) * kstep; const char* b2 = last ? nB : cB + (size_t)(t + 2) * kstep;
            const char* a3 = a2 + kstep; const char* b3 = b2 + kstep;
            if (last && has_next) S.a_ready(nxt);
            if constexpr (SP2) {
            PG8_LDB(B0, 0, 0); PG8_LDB(B1, 0, 1); PG8_SCHED; PG8_LDA(At, 0, 0); PG8_STAGE(PG8_SA(1, 1), a1 + hstep, voffA);
            PG8_WAIT_V(8); PG8_WAIT_L(0); PG8_BAR; PG8_MMA(0, 0, At, B0); PG8_MMA(0, 1, At, B1); PG8_BAR; PG8_SCHED;
            PG8_LDA(At, 0, 1); PG8_STAGE(PG8_SB(0, 0), b2, voffA); PG8_STAGE(PG8_SB(0, 1), b2 + hstep, voffA); PG8_STAGE(PG8_SA(0, 0), a2, voffA);
            PG8_WAIT_V(8); PG8_WAIT_L(0); PG8_BAR; PG8_MMA(1, 0, At, B0); PG8_MMA(1, 1, At, B1); PG8_BAR; PG8_SCHED;
            PG8_LDB(B0, 1, 0); PG8_LDB(B1, 1, 1); PG8_SCHED; PG8_LDA(At, 1, 0); PG8_STAGE(PG8_SA(0, 1), a2 + hstep, voffA);
            PG8_WAIT_V(8); PG8_WAIT_L(0); PG8_BAR; PG8_MMA(0, 0, At, B0); PG8_MMA(0, 1, At, B1); PG8_BAR; PG8_SCHED;
            PG8_LDA(At, 1, 1); PG8_STAGE(PG8_SB(1, 0), b3, voffA); PG8_STAGE(PG8_SB(1, 1), b3 + hstep, voffA); PG8_STAGE(PG8_SA(1, 0), a3, voffA);
            PG8_WAIT_V(8); PG8_WAIT_L(0); PG8_BAR; PG8_MMA(1, 0, At, B0); PG8_MMA(1, 1, At, B1); PG8_BAR; PG8_SCHED;
            } else {
            PG8_LDB(B0, 0, 0); PG8_SCHED; PG8_LDA(At, 0, 0); PG8_STAGE(PG8_SA(1, 1), a1 + hstep, voffA);
            PG8_WAIT_L(8); PG8_BAR; PG8_WAIT_L(0); PG8_MMA(0, 0, At, B0); PG8_BAR; PG8_SCHED;
            PG8_LDB(B1, 0, 1); PG8_STAGE(PG8_SB(0, 0), b2, voffA);
            PG8_BAR; PG8_WAIT_L(0); PG8_MMA(0, 1, At, B1); PG8_BAR;
            PG8_LDA(At, 0, 1); PG8_STAGE(PG8_SA(0, 0), a2, voffA);
            PG8_BAR; PG8_WAIT_L(0); PG8_MMA(1, 0, At, B0); PG8_BAR; PG8_SCHED;
            PG8_STAGE(PG8_SB(0, 1), b2 + hstep, voffA);
            PG8_WAIT_V(6); PG8_BAR; PG8_MMA(1, 1, At, B1); PG8_BAR;
            PG8_LDB(B0, 1, 0); PG8_SCHED; PG8_LDA(At, 1, 0); PG8_STAGE(PG8_SA(0, 1), a2 + hstep, voffA);
            PG8_WAIT_L(8); PG8_BAR; PG8_WAIT_L(0); PG8_MMA(0, 0, At, B0); PG8_BAR; PG8_SCHED;
            PG8_LDB(B1, 1, 1); PG8_STAGE(PG8_SB(1, 0), b3, voffA);
            PG8_BAR; PG8_WAIT_L(0); PG8_MMA(0, 1, At, B1); PG8_BAR;
            PG8_LDA(At, 1, 1); PG8_STAGE(PG8_SA(1, 0), a3, voffA);
            PG8_BAR; PG8_WAIT_L(0); PG8_MMA(1, 0, At, B0); PG8_BAR; PG8_SCHED;
            PG8_STAGE(PG8_SB(1, 1), b3 + hstep, voffA);
            PG8_WAIT_V(6); PG8_BAR; PG8_MMA(1, 1, At, B1); PG8_BAR;
            }
        }
        if constexpr (ALIGN_EPI) { if (wr == 0) PG8_BAR; }
        if constexpr (!Epi::AFTER_DRAIN) { E(acc, cur, wr, wc, fr, fq); S.done(cur); }
        if (!has_next) break;
#pragma unroll
        for (int a = 0; a < 2; ++a)
#pragma unroll
            for (int b = 0; b < 2; ++b)
#pragma unroll
                for (int m = 0; m < 4; ++m)
#pragma unroll
                    for (int n = 0; n < 2; ++n) acc[a][b][m][n] = (f32x4){0.f, 0.f, 0.f, 0.f};
        cur = nxt; cA = nA; cB = nB; ++ui;
        if constexpr (ALIGN_EPI) { if (wr == 1) PG8_BAR; }
    }
    PG8_WAIT_V(0);
    if constexpr (!ALIGN_EPI) { if (wr == 0) PG8_BAR; }
    PG8_BAR;
    if constexpr (Epi::AFTER_DRAIN) { E.fused(acc, cur, wr, wc, fr, fq, lds, wid, lane); S.done(cur); }
#undef PG8_SA
#undef PG8_SB
#undef PG8_STAGE
#undef PG8_LDA
#undef PG8_LDB
#undef PG8_MMA
#undef PG8_WAIT_V
#undef PG8_WAIT_L
#undef PG8_BAR
#undef PG8_SCHED
}
}

typedef pg8::bf16_t bf16_t;
typedef pg8::f32x4 f32x4;
typedef pg8::u32x4 u32x4;
using pg8::cvt_pk_bf16;
constexpr int NB = 4, SEQ = 8192, D = 1024, MTOK = NB * SEQ;
constexpr int PCOLS = 4608, GCOLS = 3072, INCOLS = 7680, DFF = 3584, NEXP = 8;
constexpr int C_HQ = 0, C_HF = 512, C_HI = 1024, C_HG = 1536, C_GU = 2048, C_GV = 2560, C_SQ = 3072, C_SK = 3584, C_SV = 4096;
constexpr float EPS = 1e-6f;
constexpr int NSLOT = 2 * MTOK + 2 * NEXP * 256, MOE_MAXBLK = MTOK / 256 + NEXP;
constexpr int NTHREADS = 512, NWAVES = 8;
constexpr int LDS_BYTES = 147456, LDS_MISC = LDS_BYTES - 256;

constexpr size_t WS_CTL = 0, CTL_BYTES = 65536;
constexpr size_t CW_BAR = 0;
constexpr size_t WS_META = WS_CTL + CTL_BYTES;
constexpr size_t WS_LB = WS_META + 4096;
constexpr size_t WS_TOKE = WS_LB + 4096;
constexpr size_t WS_TOKW = WS_TOKE + (size_t)MTOK * 4;
constexpr size_t WS_SLOTTOK = WS_TOKW + (size_t)MTOK * 8;
constexpr size_t WS_SLOTW = WS_SLOTTOK + (size_t)NSLOT * 4;
constexpr size_t WS_BLKE = WS_SLOTW + (size_t)NSLOT * 4;
constexpr size_t WS_W = 2u << 20;
static_assert(WS_BLKE + 4096 <= WS_W, "small buffers");
constexpr size_t WS_WIN = WS_W;
constexpr size_t WS_WBR = WS_WIN + (size_t)2 * INCOLS * D * 2;
constexpr size_t WS_WOUT = WS_WBR + (size_t)2 * 3 * D * 512 * 2;
constexpr size_t WS_WGU = WS_WOUT + (size_t)2 * D * D * 2;
constexpr size_t WS_WD = WS_WGU + (size_t)2 * DFF * D * 2;
constexpr size_t WS_XN = WS_WD + (size_t)D * DFF * 2;
constexpr size_t WS_C = WS_XN + (size_t)MTOK * D * 2;
constexpr size_t WS_P = WS_C;
constexpr size_t WS_G = WS_C;
constexpr size_t WS_HID = WS_C;
constexpr size_t WS_OCAT = WS_C + (size_t)MTOK * PCOLS * 2;
constexpr size_t WS_ORAW = WS_OCAT + (size_t)3 * MTOK * 512 * 2;
constexpr size_t WS_END1 = WS_ORAW + (size_t)MTOK * 512 * 4;
constexpr size_t WS_MWD = WS_W;
static_assert(WS_MWD + (size_t)NEXP * D * DFF * 2 <= WS_XN, "moe down weights fit below XN");
constexpr size_t WS_MWGU = WS_C;
constexpr size_t WS_XS = WS_MWGU + (size_t)NEXP * 2 * DFF * D * 2;
constexpr size_t WS_MHID = WS_XS + (size_t)MOE_MAXBLK * 256 * D * 2;
constexpr size_t WS_END2 = WS_MHID + (size_t)MOE_MAXBLK * 256 * DFF * 2;
constexpr size_t WS_NEED = WS_END1 > WS_END2 ? WS_END1 : WS_END2;
static_assert(WS_NEED <= 615053344ull, "workspace budget (sum of the inputs)");

#define LAUNDER(v) asm volatile("" : "+v"(v))
__device__ __forceinline__ float bf2f(unsigned v) { return __uint_as_float(v << 16); }
__device__ __forceinline__ float bflo(unsigned w) { return __uint_as_float(w << 16); }
__device__ __forceinline__ float bfhi(unsigned w) { return __uint_as_float(w & 0xffff0000u); }
__device__ __forceinline__ bf16_t f2bf(float f) { return (bf16_t)(cvt_pk_bf16(f, 0.f) & 0xffffu); }
template <int M> __device__ __forceinline__ float xor_f(float v) { return __builtin_bit_cast(float, __builtin_amdgcn_ds_swizzle(__builtin_bit_cast(int, v), (M << 10) | 0x1f)); }
__device__ __forceinline__ float bperm_f(float v, int src_lane) { return __builtin_bit_cast(float, __builtin_amdgcn_ds_bpermute(src_lane << 2, __builtin_bit_cast(int, v))); }
__device__ __forceinline__ float wave_sum(float v) {
    v += xor_f<1>(v); v += xor_f<2>(v); v += xor_f<4>(v); v += xor_f<8>(v); v += xor_f<16>(v);
    return __builtin_bit_cast(float, __builtin_amdgcn_readlane(__builtin_bit_cast(int, v), 0)) + __builtin_bit_cast(float, __builtin_amdgcn_readlane(__builtin_bit_cast(int, v), 32));
}
__device__ __forceinline__ float sigmoidf_(float x) { return __builtin_amdgcn_rcpf(1.f + __expf(-x)); }
__device__ __forceinline__ float siluf_(float x) { return x * sigmoidf_(x); }
__device__ __forceinline__ float gelu_tanh_(float x) { return x * sigmoidf_(1.5957691216057308f * (x + 0.044715f * x * x * x)); }
__device__ __forceinline__ float softplusf_(float z) { return fmaxf(z, 0.f) + __logf(1.f + __expf(-fabsf(z))); }

struct Order {
    int nM, nN, nwg, G, c, mode; const char* A; const char* Bt; size_t tstep, abr, bbr; const int* bmap;
    __device__ void init(const void* A_, const void* Bt_, int M, int N, int K, int G_, int c_, int mode_ = 0, size_t abr_ = 0, size_t bbr_ = 0, const int* bmap_ = nullptr) { bmap = bmap_;
        nM = M / 256; nN = N / 256; nwg = nM * nN; G = G_; c = c_; mode = mode_; A = (const char*)A_; Bt = (const char*)Bt_; tstep = (size_t)256 * K * 2; abr = abr_; bbr = bbr_; }
    __device__ bool next(int i, pg8::Unit& u) const {
        if (mode == 3) {
            const int br = i % 3; const long L = (long)(i / 3) * G + c; const int nt4 = nM * 4; if (L >= nt4) return false;
            int wgid = (int)L; { const int q = nt4 / 8, r = nt4 % 8, xcd = wgid % 8, off = wgid / 8; wgid = (xcd < r ? xcd * (q + 1) : r * (q + 1) + (xcd - r) * q) + off; }
            const int nig = 8 * 4, gid = wgid / nig, fm = gid * 8, gsz = (nM - fm) < 8 ? (nM - fm) : 8;
            u.pm = fm + ((wgid % nig) % gsz); const int pq = (wgid % nig) / gsz; u.pn = br * 4 + pq;
            u.a = A + (size_t)br * abr + (size_t)u.pm * tstep; u.b = Bt + (size_t)br * bbr + (size_t)pq * tstep; return true; }
        const long L = (long)i * G + c; if (L >= nwg) return false;
        int wgid = (int)L; { const int q = nwg / 8, r = nwg % 8, xcd = wgid % 8, off = wgid / 8; wgid = (xcd < r ? xcd * (q + 1) : r * (q + 1) + (xcd - r) * q) + off; }
        const int nig = 8 * nN, gid = wgid / nig, fm = gid * 8, gsz = (nM - fm) < 8 ? (nM - fm) : 8;
        u.pm = fm + ((wgid % nig) % gsz); u.pn = (wgid % nig) / gsz;
        if (mode == 0) { u.a = A + (size_t)u.pm * tstep; u.b = Bt + (size_t)u.pn * tstep; }
        else if (mode == 2) { const int ex = __hip_atomic_load(bmap + u.pm, __ATOMIC_RELAXED, __HIP_MEMORY_SCOPE_AGENT); u.a = A + (size_t)u.pm * tstep; u.b = Bt + (size_t)ex * bbr + (size_t)u.pn * tstep; }
        else { const int br = u.pn >> 2; u.a = A + (size_t)br * abr + (size_t)u.pm * tstep; u.b = Bt + (size_t)br * bbr + (size_t)(u.pn & 3) * tstep; }
        return true;
    }
    __device__ __forceinline__ void a_ready(const pg8::Unit&) const {}
    __device__ __forceinline__ void done(const pg8::Unit&) const {}
};

template <int ACT> __device__ __forceinline__ float act_(float x, float lb) {
    if (ACT == 1) return siluf_(x);
    if (ACT == 2) return __logf(lb + (1.f - lb) * sigmoidf_(x));
    if (ACT == 3) return gelu_tanh_(x);
    if (ACT == 4) return sigmoidf_(x);
    return x;
}
struct EpiAct {
    static constexpr bool PERM = true, AFTER_DRAIN = false;
    bf16_t* O; int ldc; const float* lb; int inproj;
    template <int ACT> __device__ __forceinline__ void run(const f32x4 (&acc)[2][2][4][2], const pg8::Unit& u, int wr, int wc, int fr, int fq) const {
        const int row0 = u.pm * 256 + wr * 64 + fr, col0 = u.pn * 256 + wc * 32 + 8 * fq;
        f32x4 lbv[2][2];
#pragma unroll
        for (int bj = 0; bj < 2; ++bj)
#pragma unroll
            for (int n = 0; n < 2; ++n) lbv[bj][n] = (ACT == 2) ? *(const f32x4*)(lb + (col0 - C_HF) + bj * 128 + 4 * n) : (f32x4){0.f, 0.f, 0.f, 0.f};
#pragma unroll
        for (int ai = 0; ai < 2; ++ai)
#pragma unroll
            for (int m = 0; m < 4; ++m) { bf16_t* rowp = O + (size_t)(row0 + ai * 128 + m * 16) * ldc + col0;
#pragma unroll
                for (int bj = 0; bj < 2; ++bj) { f32x4 v0 = acc[ai][bj][m][0], v1 = acc[ai][bj][m][1];
#pragma unroll
                    for (int i = 0; i < 4; ++i) { v0[i] = act_<ACT>(v0[i], lbv[bj][0][i]); v1[i] = act_<ACT>(v1[i], lbv[bj][1][i]); }
                    u32x4 w; w.x = cvt_pk_bf16(v0[0], v0[1]); w.y = cvt_pk_bf16(v0[2], v0[3]); w.z = cvt_pk_bf16(v1[0], v1[1]); w.w = cvt_pk_bf16(v1[2], v1[3]);
                    *(u32x4*)(rowp + bj * 128) = w; } }
    }
    __device__ __forceinline__ void operator()(const f32x4 (&acc)[2][2][4][2], const pg8::Unit& u, int wr, int wc, int fr, int fq) const {
        if (!inproj) { run<4>(acc, u, wr, wc, fr, fq); return; }
        const int kind = u.pn >> 1;
        if (kind == 0 || kind == 3) run<1>(acc, u, wr, wc, fr, fq);
        else if (kind == 1) run<2>(acc, u, wr, wc, fr, fq);
        else if (kind == 4 || kind == 5) run<3>(acc, u, wr, wc, fr, fq);
        else run<0>(acc, u, wr, wc, fr, fq);
    }
};
struct EpiBranch {
    static constexpr bool PERM = true, AFTER_DRAIN = false;
    const bf16_t* Gt; bf16_t* mix;
    __device__ __forceinline__ void operator()(const f32x4 (&acc)[2][2][4][2], const pg8::Unit& u, int wr, int wc, int fr, int fq) const {
        const int br = u.pn >> 2, row0 = u.pm * 256 + wr * 64 + fr, col0 = (u.pn & 3) * 256 + wc * 32 + 8 * fq;
#pragma unroll
        for (int ai = 0; ai < 2; ++ai)
#pragma unroll
            for (int m = 0; m < 4; ++m) { const size_t row = (size_t)(row0 + ai * 128 + m * 16); const bf16_t* gp = Gt + row * GCOLS + br * 1024 + col0; bf16_t* mp = mix + row * D + col0;
#pragma unroll
                for (int bj = 0; bj < 2; ++bj) { const f32x4 v0 = acc[ai][bj][m][0], v1 = acc[ai][bj][m][1];
                    const u32x4 g = *(const u32x4*)(gp + bj * 128); u32x4 o = {0u, 0u, 0u, 0u};
                    if (br > 0) o = __builtin_nontemporal_load((const u32x4*)(mp + bj * 128));
                    u32x4 w;
                    w.x = cvt_pk_bf16(bflo(o.x) + v0[0] * bflo(g.x), bfhi(o.x) + v0[1] * bfhi(g.x)); w.y = cvt_pk_bf16(bflo(o.y) + v0[2] * bflo(g.y), bfhi(o.y) + v0[3] * bfhi(g.y));
                    w.z = cvt_pk_bf16(bflo(o.z) + v1[0] * bflo(g.z), bfhi(o.z) + v1[1] * bfhi(g.z)); w.w = cvt_pk_bf16(bflo(o.w) + v1[2] * bflo(g.w), bfhi(o.w) + v1[3] * bfhi(g.w));
                    *(u32x4*)(mp + bj * 128) = w; } }
    }
};
struct EpiResid {
    static constexpr bool PERM = false, AFTER_DRAIN = false;
    const float* xin; float* xout;
    __device__ __forceinline__ void operator()(const f32x4 (&acc)[2][2][4][2], const pg8::Unit& u, int wr, int wc, int fr, int fq) const {
        const int row0 = u.pm * 256 + wr * 64 + fr, col0 = u.pn * 256 + wc * 32 + 4 * fq;
#pragma unroll
        for (int ai = 0; ai < 2; ++ai)
#pragma unroll
            for (int m = 0; m < 4; ++m) { const size_t ro = (size_t)(row0 + ai * 128 + m * 16) * D + col0;
#pragma unroll
                for (int bj = 0; bj < 2; ++bj)
#pragma unroll
                    for (int n = 0; n < 2; ++n) *(f32x4*)(xout + ro + bj * 128 + n * 16) = *(const f32x4*)(xin + ro + bj * 128 + n * 16) + acc[ai][bj][m][n]; }
    }
};
struct EpiGU {
    static constexpr bool PERM = true, AFTER_DRAIN = false;
    bf16_t* H;
    __device__ __forceinline__ void operator()(const f32x4 (&acc)[2][2][4][2], const pg8::Unit& u, int wr, int wc, int fr, int fq) const {
        const int row0 = u.pm * 256 + wr * 64 + fr, col0 = u.pn * 128 + wc * 32 + 8 * fq;
#pragma unroll
        for (int ai = 0; ai < 2; ++ai)
#pragma unroll
            for (int m = 0; m < 4; ++m) { bf16_t* rowp = H + (size_t)(row0 + ai * 128 + m * 16) * DFF + col0;
                const f32x4 g0 = acc[ai][0][m][0], g1 = acc[ai][0][m][1], u0 = acc[ai][1][m][0], u1 = acc[ai][1][m][1]; u32x4 w;
                w.x = cvt_pk_bf16(siluf_(g0[0]) * u0[0], siluf_(g0[1]) * u0[1]); w.y = cvt_pk_bf16(siluf_(g0[2]) * u0[2], siluf_(g0[3]) * u0[3]);
                w.z = cvt_pk_bf16(siluf_(g1[0]) * u1[0], siluf_(g1[1]) * u1[1]); w.w = cvt_pk_bf16(siluf_(g1[2]) * u1[2], siluf_(g1[3]) * u1[3]);
                *(u32x4*)rowp = w; }
    }
};
struct EpiMoeDown {
    static constexpr bool PERM = false, AFTER_DRAIN = false;
    float* out; const int* stok; const float* sw;
    __device__ __forceinline__ void operator()(const f32x4 (&acc)[2][2][4][2], const pg8::Unit& u, int wr, int wc, int fr, int fq) const {
        const int row0 = u.pm * 256 + wr * 64 + fr, col0 = u.pn * 256 + wc * 32 + 4 * fq;
#pragma unroll
        for (int ai = 0; ai < 2; ++ai)
#pragma unroll
            for (int m = 0; m < 4; ++m) { const int rl = row0 + ai * 128 + m * 16; const int tok = stok[rl]; const float w = sw[rl];
                if (tok >= 0) { float* rp = out + (size_t)tok * D + col0;
#pragma unroll
                    for (int bj = 0; bj < 2; ++bj)
#pragma unroll
                        for (int n = 0; n < 2; ++n) { f32x4 o = *(const f32x4*)(rp + bj * 128 + n * 16); o = o + acc[ai][bj][m][n] * w; *(f32x4*)(rp + bj * 128 + n * 16) = o; } } }
    }
};

__device__ __forceinline__ void tc_job(const float* __restrict__ src, int K, int N, bf16_t* dst, int mode, int perm, LAS float* tile, int wg, int G, int tid) {
    LAUNDER(tid);
    const int tn = N / 64, nt = (K / 64) * tn;
    for (int t = wg; t < nt; t += G) {
        const int k0 = (t / tn) * 64, n0 = (t % tn) * 64;
#pragma unroll
        for (int ps = 0; ps < 2; ++ps) { const int r = (tid >> 4) + ps * 32; const float4 v = *(const float4*)(src + (size_t)(k0 + r) * N + n0 + (tid & 15) * 4);
            LAS float* tp = tile + r * 65 + (tid & 15) * 4; tp[0] = v.x; tp[1] = v.y; tp[2] = v.z; tp[3] = v.w; }
        __syncthreads();
        { const int n = tid >> 3, kg = (tid & 7) * 8; unsigned w[4];
#pragma unroll
          for (int j = 0; j < 4; ++j) w[j] = cvt_pk_bf16(tile[(kg + 2 * j) * 65 + n], tile[(kg + 2 * j + 1) * 65 + n]);
          const int nn = n0 + n; int drow = mode == 0 ? nn : ((nn >> 7) * 256 + (nn & 127) + (mode == 2 ? 128 : 0));
          if (perm) { const int c5 = drow & 31; drow = (drow & ~31) + 16 * ((c5 >> 2) & 1) + 4 * (c5 >> 3) + (c5 & 3); }
          *(uint4*)(dst + (size_t)drow * K + k0 + kg) = make_uint4(w[0], w[1], w[2], w[3]); }
        __syncthreads();
    }
}

template <bool ROUTER>
__device__ __forceinline__ void phase_rmsnorm(const float* __restrict__ x, const float* __restrict__ gain, bf16_t* xn, const float* __restrict__ rw, const float* __restrict__ rb,
                              int* toke, float2* tokw, int wg, int G, int wid, int lane) {
    LAUNDER(lane);
    for (int row = wg * NWAVES + wid; row < MTOK; row += G * NWAVES) {
        const float* xr = x + (size_t)row * D; float4 v[4]; float ss = 0.f;
#pragma unroll
        for (int j = 0; j < 4; ++j) { v[j] = *(const float4*)(xr + j * 256 + lane * 4); ss += v[j].x * v[j].x + v[j].y * v[j].y + v[j].z * v[j].z + v[j].w * v[j].w; }
        ss = wave_sum(ss);
        const float rstd = rsqrtf(ss * (1.f / D) + EPS);
        float lg[NEXP];
#pragma unroll
        for (int e = 0; e < NEXP; ++e) lg[e] = 0.f;
#pragma unroll
        for (int j = 0; j < 4; ++j) { const float4 g = *(const float4*)(gain + j * 256 + lane * 4);
            const float y0 = v[j].x * rstd * g.x, y1 = v[j].y * rstd * g.y, y2 = v[j].z * rstd * g.z, y3 = v[j].w * rstd * g.w;
            *(uint2*)(xn + (size_t)row * D + j * 256 + lane * 4) = make_uint2(cvt_pk_bf16(y0, y1), cvt_pk_bf16(y2, y3));
            if (ROUTER) { const float ys[4] = {y0, y1, y2, y3};
#pragma unroll
                for (int i = 0; i < 4; ++i) { const float* wr_ = rw + (size_t)(j * 256 + lane * 4 + i) * NEXP; const float4 wa = *(const float4*)wr_, wb = *(const float4*)(wr_ + 4);
                    lg[0] += ys[i] * wa.x; lg[1] += ys[i] * wa.y; lg[2] += ys[i] * wa.z; lg[3] += ys[i] * wa.w; lg[4] += ys[i] * wb.x; lg[5] += ys[i] * wb.y; lg[6] += ys[i] * wb.z; lg[7] += ys[i] * wb.w; } } }
        if (ROUTER) {
#pragma unroll
            for (int e = 0; e < NEXP; ++e) lg[e] = wave_sum(lg[e]) + rb[e];
            int i0 = 0; float l0 = lg[0];
#pragma unroll
            for (int e = 1; e < NEXP; ++e) if (lg[e] > l0) { l0 = lg[e]; i0 = e; }
            int i1 = -1; float l1 = -3.4e38f;
#pragma unroll
            for (int e = 0; e < NEXP; ++e) if (e != i0 && lg[e] > l1) { l1 = lg[e]; i1 = e; }
            const float w0 = __builtin_amdgcn_rcpf(1.f + __expf(l1 - l0));
            if (lane == 0) { toke[row] = i0 | (i1 << 8); tokw[row] = make_float2(w0, 1.f - w0); }
        }
    }
}

__device__ void phase_combine(const bf16_t* GH, bf16_t* mix, int wg, int G, int tid) {
    LAUNDER(tid);
    for (size_t v = (size_t)wg * NTHREADS + tid; v < (size_t)MTOK * (D / 8); v += (size_t)G * NTHREADS) {
        const size_t r = v / (D / 8); const int c = (int)(v % (D / 8)) * 8; const bf16_t* gp = GH + r * GCOLS + c;
        const uint4 a = *(const uint4*)gp, b = *(const uint4*)(gp + 1024), cc = *(const uint4*)(gp + 2048); uint4 o;
        o.x = cvt_pk_bf16(bflo(a.x) + bflo(b.x) + bflo(cc.x), bfhi(a.x) + bfhi(b.x) + bfhi(cc.x));
        o.y = cvt_pk_bf16(bflo(a.y) + bflo(b.y) + bflo(cc.y), bfhi(a.y) + bfhi(b.y) + bfhi(cc.y));
        o.z = cvt_pk_bf16(bflo(a.z) + bflo(b.z) + bflo(cc.z), bfhi(a.z) + bfhi(b.z) + bfhi(cc.z));
        o.w = cvt_pk_bf16(bflo(a.w) + bflo(b.w) + bflo(cc.w), bfhi(a.w) + bfhi(b.w) + bfhi(cc.w));
        *(uint4*)(mix + r * D + c) = o;
    }
}

__device__ __forceinline__ void moe_assign(const int* toke, const float2* tokw, int* meta, int* stok, float* sw, int* blke, LAS unsigned char* lds, int tid) {
    LAS int* cnt = (LAS int*)lds;
    LAS int* tot = cnt + 512 * 16;
    const int t0 = tid * (MTOK / NTHREADS);
    { int z = 0; asm volatile("" : "+v"(z));
      for (int j = 0; j < 16; ++j) cnt[tid * 16 + j] = z; }
    for (int i = 0; i < MTOK / NTHREADS; ++i) { const int ee = toke[t0 + i]; cnt[tid * 16 + (ee & 255)] += 1; cnt[tid * 16 + 8 + ((ee >> 8) & 255)] += 1; }
    __syncthreads();
    if (tid < 16) { int run = 0; for (int i = 0; i < NTHREADS; ++i) { const int v = cnt[i * 16 + tid]; cnt[i * 16 + tid] = run; run += v; } tot[tid] = run; }
    __syncthreads();
    if (tid == 0) { int run = 0; for (int j = 0; j < 16; ++j) { const int n = tot[j], pad = (n + 255) & ~255; tot[16 + j] = run; if (j == 8) { meta[0] = run; meta[3] = run; } run += pad; } meta[1] = run - tot[16 + 8]; meta[2] = 0; meta[4] = run; }
    __syncthreads();
    for (int bk = tid; bk < 2 * MOE_MAXBLK; bk += NTHREADS) { int ex = 0;
        for (int j = 0; j < 16; ++j) { const int base = tot[16 + j], pad = (tot[j] + 255) & ~255; if (bk * 256 >= base && bk * 256 < base + pad) ex = j & 7; }
        blke[bk] = ex; }
    for (int j = 0; j < 16; ++j) cnt[tid * 16 + j] += tot[16 + j];
    for (int i = 0; i < MTOK / NTHREADS; ++i) { const int tk = t0 + i; const int ee = toke[tk]; const int j0 = ee & 255, j1 = 8 + ((ee >> 8) & 255); const float2 w = tokw[tk];
        const int p0 = cnt[tid * 16 + j0]; cnt[tid * 16 + j0] = p0 + 1; const int p1 = cnt[tid * 16 + j1]; cnt[tid * 16 + j1] = p1 + 1;
        stok[p0] = tk; sw[p0] = w.x; stok[p1] = tk; sw[p1] = w.y; }
    for (int j = 0; j < 16; ++j) { const int n = tot[j], pad = (n + 255) & ~255, base = tot[16 + j]; for (int i = n + tid; i < pad; i += NTHREADS) { stok[base + i] = -1; sw[base + i] = 0.f; } }
}
__device__ __forceinline__ void moe_gather(const bf16_t* xn, const int* stok, int rows, bf16_t* xs, int wg, int G, int wid, int lane) {
    LAUNDER(lane);
    for (int r = wg * NWAVES + wid; r < rows; r += G * NWAVES) { const int tok = __hip_atomic_load(stok + r, __ATOMIC_RELAXED, __HIP_MEMORY_SCOPE_AGENT);
        uint4 a = make_uint4(0, 0, 0, 0), b = a;
        if (tok >= 0) { const uint4* sp = (const uint4*)(xn + (size_t)tok * D) + lane * 2; a = sp[0]; b = sp[1]; }
        uint4* dp = (uint4*)(xs + (size_t)r * D) + lane * 2; dp[0] = a; dp[1] = b; }
}

typedef pg8::bf16x8 bf16x8;
typedef unsigned u32x2 __attribute__((ext_vector_type(2)));
#define MFMA16(A, B, C) __builtin_amdgcn_mfma_f32_16x16x32_bf16((A), (B), (C), 0, 0, 0)
__device__ __forceinline__ bf16x8 mk8(unsigned a, unsigned b, unsigned c, unsigned d) { u32x4 v = {a, b, c, d}; return __builtin_bit_cast(bf16x8, v); }

constexpr int H_QD = 0, H_KD = 8704, H_KB = 17408, H_QG = 21760, H_KET = 30464, H_VT = 40704, H_PM = 50944, H_TP = 53504, H_GE = 55552;
constexpr size_t HG_DUMP_BYTES = (size_t)MTOK * 512 * 2, HG_U_BYTES = (size_t)256 * 128 * 128 * 4;
__device__ __forceinline__ void phase_hgrn_a(const bf16_t* P, bf16_t* qsc  , uint2* dump, float* U, float* Dsc, LAS unsigned char* lds, int wg, int G, int tid, int wid, int lane) {
    LAUNDER(tid); LAUNDER(lane);
    const int d = tid & 127, part = tid >> 7, g = lane >> 4, c16 = lane & 15;
    LAS float* TP = (LAS float*)(lds + H_TP); LAS float* GE = (LAS float*)(lds + H_GE);
    for (int item = wg; item < 256; item += G) {
        const int b = item >> 6, h = (item >> 4) & 3, sc = item & 15; const size_t tok0 = (size_t)b * SEQ + (size_t)sc * 512;
        f32x4 S[8];
#pragma unroll
        for (int i = 0; i < 8; ++i) S[i] = (f32x4){0.f, 0.f, 0.f, 0.f};
        float gsc = 0.f;
        unsigned lfv[8], qv[8], vv[8];
        { const bf16_t* base = P + (tok0 + 8 * part) * PCOLS + h * 128 + d;
#pragma unroll
          for (int j = 0; j < 8; ++j) { lfv[j] = base[(size_t)j * PCOLS + C_HF]; qv[j] = base[(size_t)j * PCOLS + C_HQ]; vv[j] = base[(size_t)j * PCOLS + C_HI]; } }
        for (int c = 0; c < 16; ++c) {
            float gl[8], lf[8], qf[8]; unsigned vb[8]; float run = 0.f;
#pragma unroll
            for (int j = 0; j < 8; ++j) { lf[j] = bf2f(lfv[j]); qf[j] = bf2f(qv[j]); vb[j] = vv[j]; run += lf[j]; gl[j] = run; }
            if (c < 15) { const bf16_t* base = P + (tok0 + (c + 1) * 32 + 8 * part) * PCOLS + h * 128 + d;
#pragma unroll
                for (int j = 0; j < 8; ++j) { lfv[j] = base[(size_t)j * PCOLS + C_HF]; qv[j] = base[(size_t)j * PCOLS + C_HQ]; vv[j] = base[(size_t)j * PCOLS + C_HI]; } }
            TP[part * 128 + d] = run;
            __syncthreads();
            const float t0 = TP[d], t1 = TP[128 + d], t2 = TP[256 + d], t3 = TP[384 + d];
            const float T0 = t0 + t1, gend = T0 + t2 + t3;
            const float pre = (part == 1) ? t0 : (part == 3) ? t2 : 0.f, gb = (part >> 1) ? T0 : 0.f;
            unsigned kep[4];
#pragma unroll
            for (int j = 0; j < 8; j += 2) {
                float ke2[2];
#pragma unroll
                for (int jj = 0; jj < 2; ++jj) { const int t = 8 * part + j + jj; const float Gl = pre + gl[j + jj], Gt = gb + Gl; const float k = 1.f - __expf(lf[j + jj]), q = qf[j + jj];
                    *(LAS bf16_t*)(lds + H_QD + t * 272 + d * 2) = f2bf(q * __expf(Gl));
                    *(LAS bf16_t*)(lds + H_KD + t * 272 + d * 2) = f2bf(k * __expf(fminf(-Gl, 80.f)));
                    if (part < 2) *(LAS bf16_t*)(lds + H_KB + t * 272 + d * 2) = f2bf(k * __expf(T0 - Gl));
                    *(LAS bf16_t*)(lds + H_QG + t * 272 + d * 2) = f2bf(q * __expf(Gt));
                    qsc[(tok0 + c * 32 + t) * 512 + h * 128 + d] = f2bf(q * __expf(gsc + Gt));
                    ke2[jj] = k * __expf(gend - Gt); }
                kep[j >> 1] = cvt_pk_bf16(ke2[0], ke2[1]); }
            *(LAS u32x4*)(lds + H_KET + d * 80 + part * 16) = (u32x4){kep[0], kep[1], kep[2], kep[3]};
            *(LAS u32x4*)(lds + H_VT + d * 80 + part * 16) = (u32x4){vb[0] | (vb[1] << 16), vb[2] | (vb[3] << 16), vb[4] | (vb[5] << 16), vb[6] | (vb[7] << 16)};
            if (part == 0) GE[d] = __expf(gend);
            gsc += gend;
            __syncthreads();
            if (wid < 3) { const int I = (wid == 0) ? 0 : 1, J = (wid == 2) ? 0 : I; f32x4 acc = {0.f, 0.f, 0.f, 0.f};
#pragma unroll
                for (int kk = 0; kk < 4; ++kk) { const bf16x8 A = *(const LAS bf16x8*)(lds + H_QD + (16 * I + c16) * 272 + kk * 64 + g * 16);
                    const bf16x8 B = (wid == 2) ? *(const LAS bf16x8*)(lds + H_KB + c16 * 272 + kk * 64 + g * 16) : *(const LAS bf16x8*)(lds + H_KD + (16 * J + c16) * 272 + kk * 64 + g * 16);
                    acc = MFMA16(A, B, acc); }
#pragma unroll
                for (int r = 0; r < 4; ++r) { const int t = 4 * g + r; const float v = (I == J && c16 > t) ? 0.f : acc[r]; *(LAS bf16_t*)(lds + H_PM + (16 * I + t) * 80 + (16 * J + c16) * 2) = f2bf(v); }
            } else if (wid == 3) {
#pragma unroll
                for (int r = 0; r < 4; ++r) *(LAS bf16_t*)(lds + H_PM + (4 * g + r) * 80 + (16 + c16) * 2) = (bf16_t)0;
            }
            __syncthreads();
            { const bf16x8 Bv = *(const LAS bf16x8*)(lds + H_VT + (16 * wid + c16) * 80 + g * 16);
              unsigned sp[8][2];
#pragma unroll
              for (int i = 0; i < 8; ++i) { sp[i][0] = cvt_pk_bf16(S[i][0], S[i][1]); sp[i][1] = cvt_pk_bf16(S[i][2], S[i][3]); }
              const size_t chunk_g = (tok0 >> 5) + c;
#pragma unroll
              for (int rt = 0; rt < 2; ++rt) { f32x4 o = {0.f, 0.f, 0.f, 0.f};
                  o = MFMA16(*(const LAS bf16x8*)(lds + H_PM + (16 * rt + c16) * 80 + g * 16), Bv, o);
#pragma unroll
                  for (int kk = 0; kk < 4; ++kk) { const LAS unsigned char* qp = lds + H_QG + (16 * rt + c16) * 272 + (32 * kk + 4 * g) * 2;
                      const u32x2 lo = *(const LAS u32x2*)qp, hi = *(const LAS u32x2*)(qp + 32);
                      o = MFMA16(mk8(lo.x, lo.y, hi.x, hi.y), mk8(sp[2 * kk][0], sp[2 * kk][1], sp[2 * kk + 1][0], sp[2 * kk + 1][1]), o); }
                  dump[(((chunk_g * 4 + h) * 2 + rt) * 8 + wid) * 64 + lane] = make_uint2(cvt_pk_bf16(o[0], o[1]), cvt_pk_bf16(o[2], o[3])); }
#pragma unroll
              for (int i = 0; i < 8; ++i) { const f32x4 dec = *(const LAS f32x4*)(lds + H_GE + (16 * i + 4 * g) * 4); S[i] = S[i] * dec;
                  S[i] = MFMA16(*(const LAS bf16x8*)(lds + H_KET + (16 * i + c16) * 80 + g * 16), Bv, S[i]); } }
            __syncthreads();
        }
#pragma unroll
        for (int i = 0; i < 8; ++i)
#pragma unroll
            for (int r = 0; r < 4; ++r) U[((size_t)item * 128 + 16 * i + 4 * g + r) * 128 + 16 * wid + c16] = S[i][r];
        if (part == 0) Dsc[item * 128 + d] = __expf(gsc);
    }
}
constexpr int HC_SIN = 0;
__device__ __forceinline__ void phase_hgrn_c(const bf16_t* P, bf16_t* qoa  , const uint2* dump, const float* U, const float* Dsc, const float* gain, LAS unsigned char* lds, int wg, int G, int tid, int wid, int lane) {
    LAUNDER(tid); LAUNDER(lane);
    const int g = lane >> 4, c16 = lane & 15;
    for (int item = wg; item < 256; item += G) {
        const int b = item >> 6, h = (item >> 4) & 3, sc = item & 15; const size_t tok0 = (size_t)b * SEQ + (size_t)sc * 512;
#pragma unroll 1
        for (int kq = 0; kq < 4; ++kq) { float s[8];
#pragma unroll
          for (int k = 0; k < 8; ++k) s[k] = 0.f;
#pragma unroll 1
          for (int j = 0; j < sc; ++j) { const size_t it = (size_t)(item - sc + j);
#pragma unroll
              for (int k = 0; k < 8; ++k) { const int e = tid + 512 * (kq * 8 + k); s[k] = Dsc[it * 128 + (e >> 7)] * s[k] + U[it * 16384 + e]; } }
#pragma unroll
          for (int k = 0; k < 8; ++k) { const int e = tid + 512 * (kq * 8 + k); *(LAS bf16_t*)(lds + HC_SIN + (e & 127) * 272 + (e >> 7) * 2) = f2bf(s[k]); } }
        __syncthreads();
#pragma unroll 1
        for (int rtile = 0; rtile < 4; ++rtile) {
            const size_t row0 = tok0 + 64 * wid + 16 * rtile; const size_t chunk_g = (tok0 >> 5) + 2 * wid + (rtile >> 1); const int rt = rtile & 1;
            bf16x8 A[4];
#pragma unroll
            for (int kk = 0; kk < 4; ++kk) A[kk] = *(const bf16x8*)(qoa + (row0 + c16) * 512 + h * 128 + 32 * kk + 8 * g);
            f32x4 acc[8]; float ss[4] = {0.f, 0.f, 0.f, 0.f};
#pragma unroll
            for (int vt = 0; vt < 8; ++vt) { acc[vt] = (f32x4){0.f, 0.f, 0.f, 0.f};
#pragma unroll
                for (int kk = 0; kk < 4; ++kk) acc[vt] = MFMA16(A[kk], *(const LAS bf16x8*)(lds + HC_SIN + (16 * vt + c16) * 272 + (32 * kk + 8 * g) * 2), acc[vt]);
                const uint2 ol = dump[(((chunk_g * 4 + h) * 2 + rt) * 8 + vt) * 64 + lane];
                acc[vt][0] += bflo(ol.x); acc[vt][1] += bfhi(ol.x); acc[vt][2] += bflo(ol.y); acc[vt][3] += bfhi(ol.y);
#pragma unroll
                for (int r = 0; r < 4; ++r) ss[r] += acc[vt][r] * acc[vt][r]; }
            float rstd[4];
#pragma unroll
            for (int r = 0; r < 4; ++r) { float s = ss[r]; s += xor_f<1>(s); s += xor_f<2>(s); s += xor_f<4>(s); s += xor_f<8>(s); rstd[r] = rsqrtf(s * (1.f / 128.f) + EPS); }
#pragma unroll
            for (int vt = 0; vt < 8; ++vt) { const float gn = gain[16 * vt + c16];
#pragma unroll
                for (int r = 0; r < 4; ++r) { const size_t row = row0 + 4 * g + r; const float hg = bf2f(P[row * PCOLS + C_HG + h * 128 + 16 * vt + c16]);
                    qoa[row * 512 + h * 128 + 16 * vt + c16] = f2bf(acc[vt][r] * rstd[r] * gn * hg); } }
        }
        __syncthreads();
    }
}

constexpr int GM_VT = 0, GM_W = 34816, GM_RS = 69632;
__device__ __forceinline__ void phase_gmlp(const bf16_t* P, const float* __restrict__ ws_l, const float* __restrict__ bs_l, const float* __restrict__ gv_l, bf16_t* ob, LAS unsigned char* lds, int wg, int G, int tid, int wid, int lane) {
    LAUNDER(tid); LAUNDER(lane);
    const int g = lane >> 4, c16 = lane & 15; LAS float* RS = (LAS float*)(lds + GM_RS);
    for (int item = wg; item < MTOK / 128; item += G) {
        const size_t tok0 = (size_t)item * 128;
        { const int s = tid >> 2, qd = tid & 3; const bf16_t* rp = P + (tok0 + s) * PCOLS + C_GV + qd * 128; float ss = 0.f;
#pragma unroll
          for (int j = 0; j < 16; ++j) { const uint4 x = *(const uint4*)(rp + j * 8); ss += bflo(x.x) * bflo(x.x) + bfhi(x.x) * bfhi(x.x) + bflo(x.y) * bflo(x.y) + bfhi(x.y) * bfhi(x.y) + bflo(x.z) * bflo(x.z) + bfhi(x.z) * bfhi(x.z) + bflo(x.w) * bflo(x.w) + bfhi(x.w) * bfhi(x.w); }
          ss += xor_f<1>(ss); ss += xor_f<2>(ss); if (qd == 0) RS[s] = rsqrtf(ss * (1.f / 512.f) + EPS); }
        for (int grp = 0; grp < 4; ++grp) {
            __syncthreads();
#pragma unroll
            for (int ps = 0; ps < 4; ++ps) { const int idx = tid + ps * 512, s = idx >> 4, c8 = (idx & 15) * 8; const uint4 x = *(const uint4*)(P + (tok0 + s) * PCOLS + C_GV + grp * 128 + c8);
                const float rs = RS[s]; const float4 ga = *(const float4*)(gv_l + grp * 128 + c8), gb = *(const float4*)(gv_l + grp * 128 + c8 + 4);
                const float e[8] = {bflo(x.x) * rs * ga.x, bfhi(x.x) * rs * ga.y, bflo(x.y) * rs * ga.z, bfhi(x.y) * rs * ga.w, bflo(x.z) * rs * gb.x, bfhi(x.z) * rs * gb.y, bflo(x.w) * rs * gb.z, bfhi(x.w) * rs * gb.w};
#pragma unroll
                for (int i = 0; i < 8; ++i) *(LAS bf16_t*)(lds + GM_VT + (c8 + i) * 272 + s * 2) = f2bf(e[i]);
                const int t = idx >> 4, s8 = (idx & 15) * 8; const float4 wa = *(const float4*)(ws_l + (size_t)grp * 16384 + t * 128 + s8), wb = *(const float4*)(ws_l + (size_t)grp * 16384 + t * 128 + s8 + 4);
                *(LAS u32x4*)(lds + GM_W + t * 272 + s8 * 2) = (u32x4){cvt_pk_bf16(s8 + 0 <= t ? wa.x : 0.f, s8 + 1 <= t ? wa.y : 0.f), cvt_pk_bf16(s8 + 2 <= t ? wa.z : 0.f, s8 + 3 <= t ? wa.w : 0.f),
                                                                    cvt_pk_bf16(s8 + 4 <= t ? wb.x : 0.f, s8 + 5 <= t ? wb.y : 0.f), cvt_pk_bf16(s8 + 6 <= t ? wb.z : 0.f, s8 + 7 <= t ? wb.w : 0.f)}; }
            __syncthreads();
            f32x4 acc[8];
#pragma unroll
            for (int ct = 0; ct < 8; ++ct) acc[ct] = (f32x4){0.f, 0.f, 0.f, 0.f};
            for (int kk = 0; kk <= (wid >> 1); ++kk) { const bf16x8 A = *(const LAS bf16x8*)(lds + GM_W + (16 * wid + c16) * 272 + kk * 64 + g * 16);
#pragma unroll
                for (int ct = 0; ct < 8; ++ct) acc[ct] = MFMA16(A, *(const LAS bf16x8*)(lds + GM_VT + (16 * ct + c16) * 272 + kk * 64 + g * 16), acc[ct]); }
#pragma unroll
            for (int r = 0; r < 4; ++r) { const int t = 16 * wid + 4 * g + r; const float bias = bs_l[grp * 128 + t]; const size_t tok = tok0 + t;
#pragma unroll
                for (int ct = 0; ct < 8; ++ct) { const int ch = grp * 128 + 16 * ct + c16; ob[tok * 512 + ch] = f2bf(bf2f(P[tok * PCOLS + C_GU + ch]) * (acc[ct][r] + bias)); } }
        }
        __syncthreads();
    }
}

constexpr int AT_KL = 0, AT_VT = 9216, AT_MIN = 9216 + 64 * 136;
template <bool DIAG>
__device__ __forceinline__ void attn_block(LAS unsigned char* lds, const bf16x8 (&Bq)[2], f32x4 (&O)[4], float& carry, int sb0, int t, int g, int c16, unsigned tri_lo, unsigned tri_hi) {
    const unsigned ONES = 0x3F803F80u;
    f32x4 z[4]; unsigned hi[4][2];
#pragma unroll
    for (int st = 0; st < 4; ++st) { z[st] = (f32x4){0.f, 0.f, 0.f, 0.f};
#pragma unroll
        for (int kk = 0; kk < 2; ++kk) z[st] = MFMA16(*(const LAS bf16x8*)(lds + AT_KL + (16 * st + c16) * 144 + kk * 64 + g * 16), Bq[kk], z[st]);
        float spv[4];
#pragma unroll
        for (int r = 0; r < 4; ++r) { const float sp = __builtin_amdgcn_logf(1.f + __builtin_amdgcn_exp2f(z[st][r])); spv[r] = (!DIAG || (sb0 + 16 * st + 4 * g + r < t)) ? sp : 0.f; }
        hi[st][0] = cvt_pk_bf16(spv[0], spv[1]); hi[st][1] = cvt_pk_bf16(spv[2], spv[3]); }
    f32x4 sf[4];
#pragma unroll
    for (int so = 0; so < 4; ++so) { sf[so] = (f32x4){0.f, 0.f, 0.f, 0.f};
#pragma unroll
        for (int kk = 0; kk < 2; ++kk) { if (2 * kk + 1 < so) continue;
            const unsigned a0 = (2 * kk > so) ? ONES : (2 * kk == so) ? tri_lo : 0u, a1 = (2 * kk > so) ? ONES : (2 * kk == so) ? tri_hi : 0u;
            const unsigned a2 = (2 * kk + 1 > so) ? ONES : tri_lo, a3 = (2 * kk + 1 > so) ? ONES : tri_hi;
            sf[so] = MFMA16(mk8(a0, a1, a2, a3), mk8(hi[2 * kk][0], hi[2 * kk][1], hi[2 * kk + 1][0], hi[2 * kk + 1][1]), sf[so]); } }
    unsigned pa[4][2];
#pragma unroll
    for (int st = 0; st < 4; ++st) { float av[4];
#pragma unroll
        for (int r = 0; r < 4; ++r) { const float a = __builtin_amdgcn_exp2f(z[st][r] - carry - sf[st][r]); av[r] = (!DIAG || (sb0 + 16 * st + 4 * g + r < t)) ? a : 0.f; }
        pa[st][0] = cvt_pk_bf16(av[0], av[1]); pa[st][1] = cvt_pk_bf16(av[2], av[3]); }
#pragma unroll
    for (int kk = 0; kk < 2; ++kk) { const bf16x8 Aop = mk8(pa[2 * kk][0], pa[2 * kk][1], pa[2 * kk + 1][0], pa[2 * kk + 1][1]);
#pragma unroll
        for (int dt = 0; dt < 4; ++dt) { const LAS unsigned char* vp = lds + AT_VT + (16 * dt + c16) * 136 + (32 * kk + 4 * g) * 2; const u32x2 v0 = *(const LAS u32x2*)vp, v1 = *(const LAS u32x2*)(vp + 32);
            O[dt] = MFMA16(Aop, mk8(v0.x, v0.y, v1.x, v1.y), O[dt]); } }
    carry += bperm_f(sf[0][0], c16);
}
__device__ __forceinline__ void phase_attn(const bf16_t* P, const float* __restrict__ gq, const float* __restrict__ gk, bf16_t* oc, LAS unsigned char* lds, int wg, int G, int tid, int wid, int lane) {
    LAUNDER(tid); LAUNDER(lane);
    const int g = lane >> 4, c16 = lane & 15; LAS float* MINW = (LAS float*)(lds + AT_MIN);
    const unsigned tri_lo = ((4 * g + 0 >= c16) ? 0x3F80u : 0u) | ((4 * g + 1 >= c16) ? 0x3F800000u : 0u), tri_hi = ((4 * g + 2 >= c16) ? 0x3F80u : 0u) | ((4 * g + 3 >= c16) ? 0x3F800000u : 0u);
    for (int item = wg; item < NB * 8 * (SEQ / 128); item += G) {
        const int qt = item & 63, h = (item >> 6) & 7, b = item >> 9; const int t0 = qt * 128, tq0 = t0 + 16 * wid, t = tq0 + c16; const size_t tokb = (size_t)b * SEQ;
        bf16x8 Bq[2];
        { const bf16_t* qp = P + (tokb + t) * PCOLS + C_SQ + h * 64; const uint4 x0 = *(const uint4*)(qp + 8 * g), x1 = *(const uint4*)(qp + 32 + 8 * g);
          float e[16] = {bflo(x0.x), bfhi(x0.x), bflo(x0.y), bfhi(x0.y), bflo(x0.z), bfhi(x0.z), bflo(x0.w), bfhi(x0.w), bflo(x1.x), bfhi(x1.x), bflo(x1.y), bfhi(x1.y), bflo(x1.z), bfhi(x1.z), bflo(x1.w), bfhi(x1.w)};
          float ss = 0.f;
#pragma unroll
          for (int i = 0; i < 16; ++i) ss += e[i] * e[i];
          ss += xor_f<16>(ss); ss += bperm_f(ss, lane ^ 32);
          const float rq = rsqrtf(ss * (1.f / 64.f) + EPS) * (0.125f * 1.4426950408889634f);
#pragma unroll
          for (int i = 0; i < 16; ++i) { const int dd = (i < 8 ? 8 * g + i : 32 + 8 * g + (i - 8)); e[i] = e[i] * rq * gq[dd] * gk[dd]; }
          Bq[0] = mk8(cvt_pk_bf16(e[0], e[1]), cvt_pk_bf16(e[2], e[3]), cvt_pk_bf16(e[4], e[5]), cvt_pk_bf16(e[6], e[7]));
          Bq[1] = mk8(cvt_pk_bf16(e[8], e[9]), cvt_pk_bf16(e[10], e[11]), cvt_pk_bf16(e[12], e[13]), cvt_pk_bf16(e[14], e[15])); }
        f32x4 O[4];
#pragma unroll
        for (int i = 0; i < 4; ++i) O[i] = (f32x4){0.f, 0.f, 0.f, 0.f};
        float carry = 0.f, wmin = 0.f;
        for (int kb = (t0 + 127) >> 6; kb >= 0; --kb) {
            const int sb0 = kb * 64;
            __syncthreads();
            { const int s = tid >> 3, pc = tid & 7; const bf16_t* rp = P + (tokb + sb0 + s) * PCOLS + h * 64 + pc * 8;
              const uint4 kx = *(const uint4*)(rp + C_SK), vx = *(const uint4*)(rp + C_SV);
              float ke[8] = {bflo(kx.x), bfhi(kx.x), bflo(kx.y), bfhi(kx.y), bflo(kx.z), bfhi(kx.z), bflo(kx.w), bfhi(kx.w)}; float ssk = 0.f;
#pragma unroll
              for (int i = 0; i < 8; ++i) ssk += ke[i] * ke[i];
              ssk += xor_f<1>(ssk); ssk += xor_f<2>(ssk); ssk += xor_f<4>(ssk);
              const float rk = rsqrtf(ssk * (1.f / 64.f) + EPS);
              *(LAS u32x4*)(lds + AT_KL + s * 144 + pc * 16) = (u32x4){cvt_pk_bf16(ke[0] * rk, ke[1] * rk), cvt_pk_bf16(ke[2] * rk, ke[3] * rk), cvt_pk_bf16(ke[4] * rk, ke[5] * rk), cvt_pk_bf16(ke[6] * rk, ke[7] * rk)};
              const unsigned vw[4] = {vx.x, vx.y, vx.z, vx.w};
#pragma unroll
              for (int i = 0; i < 8; ++i) *(LAS bf16_t*)(lds + AT_VT + (pc * 8 + i) * 136 + s * 2) = (bf16_t)((vw[i >> 1] >> ((i & 1) * 16)) & 0xffffu); }
            __syncthreads();
            if (sb0 < tq0 + 15 && wmin <= 150.04f) {
                if (sb0 + 63 < tq0) attn_block<false>(lds, Bq, O, carry, sb0, t, g, c16, tri_lo, tri_hi);
                else attn_block<true>(lds, Bq, O, carry, sb0, t, g, c16, tri_lo, tri_hi);
            }
            float mn = carry; mn = fminf(mn, xor_f<1>(mn)); mn = fminf(mn, xor_f<2>(mn)); mn = fminf(mn, xor_f<4>(mn)); mn = fminf(mn, xor_f<8>(mn));
            wmin = __builtin_bit_cast(float, __builtin_amdgcn_readfirstlane(__builtin_bit_cast(int, mn)));
            if (lane == 0) MINW[wid] = mn;
            __syncthreads();
            float mall = MINW[0];
#pragma unroll
            for (int w = 1; w < 8; ++w) mall = fminf(mall, MINW[w]);
            if (mall > 150.04f) break;
        }
#pragma unroll
        for (int dt = 0; dt < 4; ++dt)
#pragma unroll
            for (int r = 0; r < 4; ++r) oc[(tokb + tq0 + 4 * g + r) * 512 + h * 64 + 16 * dt + c16] = f2bf(O[dt][r]);
    }
}

#ifdef MK_CHECK
constexpr size_t WS_DIAG = WS_META + 2048;
constexpr size_t WS_SNAP = WS_BLKE + 4096;
static_assert(WS_SNAP + 64 * 1024 * 4 <= WS_W, "snapshot fits");
__device__ __forceinline__ int samp_row(int i) { return (int)(((unsigned)i * 2654435761u + 12345u) % (unsigned)MTOK); }
__device__ __forceinline__ void chk_fail(unsigned* diag, unsigned code) { atomicMin(diag, code); }
__device__ __forceinline__ bool chk_close(float got, float ref, float atol, float rtol) { return fabsf(got - ref) <= atol + rtol * fabsf(ref) && got == got; }

__global__ void k_diag_init(unsigned* diag) { if (threadIdx.x == 0 && blockIdx.x == 0) { diag[0] = 0xffffffffu; diag[16] = 0u; diag[17] = 0xffffffffu; diag[18] = 0u; diag[19] = 0u; diag[20] = 0u; diag[21] = 0u; diag[22] = 0u; diag[23] = 0u; diag[24] = 0u; diag[25] = 0u; diag[26] = 0u; } }
__global__ void k_snapshot(const float* x, float* snap) { const int i = blockIdx.x; const int r = samp_row(i); for (int c = threadIdx.x; c < D; c += blockDim.x) snap[i * D + c] = x[(size_t)r * D + c]; }
__global__ void k_apply_diag(float* out, const unsigned* diag) {
    if (blockIdx.x != 0 || threadIdx.x != 0) return;
    const unsigned code = diag[0]; if (code == 0xffffffffu) return;
    out[0] = (1.0f + 0.1f * (float)(code > 89u ? 89u : code)) * 1.0e6f;
}
struct ChkGemm { const bf16_t* A; int lda; const float* W; int ldw; int K; int mode; const bf16_t* Cb; int ldc; const float* Cf; const float* xold; const float* W2; const float* lb; const bf16_t* Gsrc; int ncols; unsigned code; int use_snap; };
__global__ void k_chk_gemm(ChkGemm c, unsigned* diag) {
    const int i = blockIdx.x; const int r = samp_row(i);
    for (int cc = threadIdx.x; cc < 96; cc += blockDim.x) {
        const int col = (int)(((unsigned)cc * 40503u + (unsigned)i * 977u) % (unsigned)c.ncols);
        float dot = 0.f, dot2 = 0.f;
        for (int k = 0; k < c.K; ++k) { const float av = bf2f(c.A[(size_t)r * c.lda + k]); dot += av * c.W[(size_t)k * c.ldw + col]; if (c.mode == 4) dot2 += av * c.W2[(size_t)k * c.ldw + col]; }
        float ref, got;
        if (c.mode == 0) { const int kind = col >> 9; ref = (kind == 0 || kind == 3) ? siluf_(dot) : kind == 1 ? __logf(c.lb[col - 512] + (1.f - c.lb[col - 512]) * sigmoidf_(dot)) : (kind == 4 || kind == 5) ? gelu_tanh_(dot) : dot; got = bf2f(c.Cb[(size_t)r * c.ldc + col]); }
        else if (c.mode == 1) { ref = sigmoidf_(dot); got = bf2f(c.Cb[(size_t)r * c.ldc + col]); }
        else if (c.mode == 3) { const float xo = c.use_snap ? c.xold[(size_t)i * D + col] : c.xold[(size_t)r * D + col]; ref = xo + dot; got = c.Cf[(size_t)r * D + col]; }
        else { ref = siluf_(dot) * dot2; got = bf2f(c.Cb[(size_t)r * c.ldc + col]); }
        if (!chk_close(got, ref, 0.03f, 0.03f)) { chk_fail(diag, c.code); if (c.mode == 1) { atomicOr(diag + 24 + (i >> 5), 1u << (i & 31)); atomicOr(diag + 26, 1u << ((r & 255) >> 4)); atomicOr(diag + 20 + ((col & 127) >> 5), 1u << (col & 31)); atomicAdd(diag + 16, 1u); atomicMin(diag + 17, (unsigned)(col >> 8)); atomicMax(diag + 18, (unsigned)(col >> 8)); if (fabsf(got - dot) <= 0.03f + 0.03f * fabsf(dot)) atomicAdd(diag + 19, 1u); } }
    }
}
__global__ void k_chk_branch(const bf16_t* ocat, const float* wbr  , const bf16_t* xn, const float* win  , const bf16_t* GH, unsigned code, unsigned* diag) {
    const int i = blockIdx.x; const int r = samp_row(i);
    for (int cc = threadIdx.x; cc < 96; cc += blockDim.x) {
        const int col = (int)(((unsigned)cc * 40503u + (unsigned)i * 977u) % 3072u); const int b = col >> 10, cl = col & 1023;
        float h = 0.f; for (int k = 0; k < 512; ++k) h += bf2f(ocat[(size_t)b * MTOK * 512 + (size_t)r * 512 + k]) * wbr[((size_t)b * 512 + k) * 1024 + cl];
        float g = 0.f; for (int k = 0; k < 1024; ++k) g += bf2f(xn[(size_t)r * D + k]) * win[(size_t)k * INCOLS + PCOLS + col];
        const float ref = sigmoidf_(g) * h, got = bf2f(GH[(size_t)r * GCOLS + col]);
        if (!chk_close(got, ref, 0.03f, 0.04f)) chk_fail(diag, code);
    }
}
__global__ void k_chk_attn(const bf16_t* P, const float* gq, const float* gk, const bf16_t* oc, unsigned code, unsigned* diag) {
    const int id = blockIdx.x, lane = threadIdx.x; const int ti = id % 10;
    const int t = ti == 0 ? 0 : ti == 1 ? 1 : ti == 2 ? 2 : ti == 3 ? 63 : ti == 4 ? 64 : ti == 5 ? 65 : ti == 6 ? 200 : ti == 7 ? 1000 : ti == 8 ? 4097 : 8191;
    const int h = (id / 10) % 8, b = id / 80; const size_t tokb = (size_t)b * SEQ;
    float q = bf2f(P[(tokb + t) * PCOLS + C_SQ + h * 64 + lane]); q = q * rsqrtf(wave_sum(q * q) / 64.f + EPS) * gq[lane];
    float o = 0.f, carry = 0.f;
    for (int s = t - 1; s >= 0 && carry < 300.f; --s) {
        float kv = bf2f(P[(tokb + s) * PCOLS + C_SK + h * 64 + lane]); kv = kv * rsqrtf(wave_sum(kv * kv) / 64.f + EPS) * gk[lane];
        const float z = wave_sum(q * kv) * 0.125f; const float sp = logf(1.f + expf(z));
        carry += sp; const float A = expf(z - carry);
        o += A * bf2f(P[(tokb + s) * PCOLS + C_SV + h * 64 + lane]);
    }
    if (!chk_close(bf2f(oc[(tokb + t) * 512 + h * 64 + lane]), o, 0.02f, 0.03f)) chk_fail(diag, code);
}
__global__ void k_chk_gmlp(const bf16_t* P, const float* ws_l, const float* bs_l, const float* gv_l, const bf16_t* ob, unsigned code, unsigned* diag) {
    const int id = blockIdx.x * blockDim.x + threadIdx.x; if (id >= 512) return;
    const int chunk = (id * 37) % (MTOK / 128), t = (id * 53 + 7) % 128, ch = (id * 101 + 3) % 512, g = ch >> 7, c = ch & 127; const size_t tok0 = (size_t)chunk * 128;
    float acc = 0.f;
    for (int s = 0; s <= t; ++s) { float ss = 0.f; for (int k = 0; k < 512; ++k) { const float v = bf2f(P[(tok0 + s) * PCOLS + C_GV + k]); ss += v * v; }
        const float vn = bf2f(P[(tok0 + s) * PCOLS + C_GV + ch]) * rsqrtf(ss / 512.f + EPS) * gv_l[ch]; acc += ws_l[(size_t)g * 16384 + t * 128 + s] * vn; }
    const float ref = bf2f(P[(tok0 + t) * PCOLS + C_GU + ch]) * (acc + bs_l[g * 128 + t]);
    if (!chk_close(bf2f(ob[(tok0 + t) * 512 + ch]), ref, 0.02f, 0.03f)) chk_fail(diag, code);
}
__global__ void k_chk_hgrn(const bf16_t* P, const float* gain, const bf16_t* oa, unsigned code, unsigned* diag) {
    const int id = blockIdx.x; const int ti = id % 8; const int t = ti == 0 ? 0 : ti == 1 ? 1 : ti == 2 ? 5 : ti == 3 ? 63 : ti == 4 ? 64 : ti == 5 ? 200 : ti == 6 ? 511 : 700, h = (id / 8) % 4, b = id / 32; const int v = threadIdx.x; const size_t tokb = (size_t)b * SEQ;
    float o = 0.f;
    for (int d = 0; d < 128; ++d) { float st = 0.f;
        for (int s = 0; s <= t; ++s) { const bf16_t* row = P + (tokb + s) * PCOLS; const float f = expf(bf2f(row[C_HF + h * 128 + d])); st = f * st + (1.f - f) * bf2f(row[C_HI + h * 128 + v]); }
        o += bf2f(P[(tokb + t) * PCOLS + C_HQ + h * 128 + d]) * st; }
    __shared__ float red[128]; red[v] = o * o; __syncthreads();
    for (int w = 64; w > 0; w >>= 1) { if (v < w) red[v] += red[v + w]; __syncthreads(); }
    const float rstd = rsqrtf(red[0] / 128.f + EPS);
    const float ref = o * rstd * gain[v] * bf2f(P[(tokb + t) * PCOLS + C_HG + h * 128 + v]);
    if (!chk_close(bf2f(oa[(tokb + t) * 512 + h * 128 + v]), ref, 0.03f, 0.04f)) chk_fail(diag, code);
}
__global__ void k_chk_moe(const bf16_t* xn, const float* rw, const float* rb, const float* wg, const float* wu, const float* wd, const float* snap, const float* xout, unsigned code, unsigned* diag) {
    const int i = blockIdx.x; const int r = samp_row(i); const int tid = threadIdx.x;
    __shared__ float hid[DFF]; __shared__ float lg[8]; __shared__ float part[256];
    if (tid < 8) { float a = rb[tid]; for (int k = 0; k < D; ++k) a += bf2f(xn[(size_t)r * D + k]) * rw[k * 8 + tid]; lg[tid] = a; }
    __syncthreads();
    int i0 = 0; for (int e = 1; e < 8; ++e) if (lg[e] > lg[i0]) i0 = e;
    int i1 = -1; for (int e = 0; e < 8; ++e) if (e != i0 && (i1 < 0 || lg[e] > lg[i1])) i1 = e;
    const float w0 = 1.f / (1.f + expf(lg[i1] - lg[i0])), w1 = 1.f - w0;
    float outv[8]; for (int j = 0; j < 8; ++j) outv[j] = 0.f;
    for (int kk = 0; kk < 2; ++kk) { const int e = kk ? i1 : i0; const float wgt = kk ? w1 : w0;
        for (int f = tid; f < DFF; f += blockDim.x) { float g = 0.f, u = 0.f; for (int k = 0; k < D; ++k) { const float xv = bf2f(xn[(size_t)r * D + k]); g += xv * wg[((size_t)e * D + k) * DFF + f]; u += xv * wu[((size_t)e * D + k) * DFF + f]; } hid[f] = siluf_(g) * u; }
        __syncthreads();
        for (int j = 0; j < 8; ++j) { const int col = (j * 131 + i * 17) % D; float p = 0.f; for (int f = tid; f < DFF; f += blockDim.x) p += hid[f] * wd[((size_t)e * DFF + f) * D + col];
            part[tid] = p; __syncthreads(); for (int w = 128; w > 0; w >>= 1) { if (tid < w) part[tid] += part[tid + w]; __syncthreads(); } outv[j] += wgt * part[0]; __syncthreads(); }
    }
    if (tid == 0) for (int j = 0; j < 8; ++j) { const int col = (j * 131 + i * 17) % D; const float ref = snap[(size_t)i * D + col] + outv[j]; if (!chk_close(xout[(size_t)r * D + col], ref, 0.04f, 0.04f)) chk_fail(diag, code); }
}
#endif

struct Args { const float* in[21]; float* out; unsigned char* ws; int lo, hi; };
constexpr int NSTEPS = 24;
__device__ __forceinline__ int laneid_() { int v; asm volatile("v_mbcnt_lo_u32_b32 %0, -1, 0\n\tv_mbcnt_hi_u32_b32 %0, -1, %0" : "=v"(v)); return v; }
#define LANEID (laneid_())

template <class Epi>
__device__ __forceinline__ void run_gemm(LAS unsigned char* lds, const Order& S, int K, const Epi& E, int wid) { pg8::gemm_phase<Epi, Order, true, true>(lds, K, S, E, wid); }

__global__ void __launch_bounds__(NTHREADS, 2) mk_fwd(Args a) {
    extern __shared__ __attribute__((aligned(16))) unsigned char lds_raw[];
    LAS unsigned char* lds = (LAS unsigned char*)lds_raw;
    const int wid = __builtin_amdgcn_readfirstlane((int)threadIdx.x >> 6);
    LAS unsigned* cblk = (LAS unsigned*)(lds + LDS_MISC);
    { const int tid = threadIdx.x;
      if (tid < 4) cblk[tid] = (tid == 2) ? xb_xcc_id() : 0u;
      if (tid < 46) { const unsigned long long pv = (tid < 42) ? (unsigned long long)a.in[tid >> 1] : (tid < 44) ? (unsigned long long)a.out : (unsigned long long)a.ws; cblk[4 + tid] = (tid & 1) ? (unsigned)(pv >> 32) : (unsigned)pv; }
      if (tid == 46) cblk[50] = (unsigned)a.lo; if (tid == 47) cblk[51] = (unsigned)a.hi; }
    __syncthreads();
#define CW(i) ((int)__builtin_amdgcn_readfirstlane(cblk[i]))
typedef __attribute__((address_space(1))) unsigned char gu8_t;
#define ARGP(i) ((unsigned char*)(gu8_t*)(((unsigned long long)(unsigned)CW(5 + 2 * (i)) << 32) | (unsigned long long)(unsigned)CW(4 + 2 * (i))))
#define IN(i) ((const float*)ARGP(i))
#define OUTP ((float*)ARGP(21))
#define WSP (ARGP(22))
#define GSZ ((int)gridDim.x)
#define WGI ((int)blockIdx.x)
    if (CW(51) - CW(50) > 1 && threadIdx.x == 0) (void)xb_add((unsigned*)(WSP + WS_CTL + CW_BAR) + XB_XCNT(CW(2)), 1u);
#ifndef PROBE_REP
#define PROBE_REP 0ull
#endif
#define RUN(k) (CW(50) <= (k) && (k) < CW(51))
#define NREP(bit) (((PROBE_REP >> (bit)) & 1ull) ? 2 : 1)
#define SEAM(k) do { if (CW(50) <= (k) && (k) + 1 < CW(51)) { XcdBarrier bar_; bar_.bar = (unsigned*)(WSP + WS_CTL + CW_BAR); bar_.x = (unsigned)CW(2); bar_.st = (volatile LAS unsigned*)cblk; xcd_barrier(bar_); } } while (0)

#define XRES (OUTP)
#define WIN ((bf16_t*)(WSP + WS_WIN))
#define WBR ((bf16_t*)(WSP + WS_WBR))
#define WOUT ((bf16_t*)(WSP + WS_WOUT))
#define WGU ((bf16_t*)(WSP + WS_WGU))
#define WDN ((bf16_t*)(WSP + WS_WD))
#define XNB ((bf16_t*)(WSP + WS_XN))
#define PBUF ((bf16_t*)(WSP + WS_P))
#define GBUF ((bf16_t*)(WSP + WS_G))
#define HIDB ((bf16_t*)(WSP + WS_HID))
#define OCATB ((bf16_t*)(WSP + WS_OCAT))
#define MWGU ((bf16_t*)(WSP + WS_MWGU))
#define MWDN ((bf16_t*)(WSP + WS_MWD))
#define XSB ((bf16_t*)(WSP + WS_XS))
#define MHIDB ((bf16_t*)(WSP + WS_MHID))
#define LBB ((float*)(WSP + WS_LB))
#define METAB ((int*)(WSP + WS_META))
#define TOKE ((int*)(WSP + WS_TOKE))
#define TOKW ((float2*)(WSP + WS_TOKW))
#define STOK ((int*)(WSP + WS_SLOTTOK))
#define SWB ((float*)(WSP + WS_SLOTW))
#define BLKE ((int*)(WSP + WS_BLKE))
#define HDUMP ((uint2*)(WSP + WS_ORAW))
#define HU ((float*)(WSP + WS_ORAW + HG_DUMP_BYTES))
#define HDSC ((float*)(WSP + WS_ORAW + HG_DUMP_BYTES + HG_U_BYTES))
#define TIDV (wid * 64 + LANEID)
    for (int rep_ = 0; rep_ < NREP(0); ++rep_) if (RUN(0)) {
        LAS float* tile = (LAS float*)lds; const int tid = TIDV;
#pragma unroll 1
        for (int j = 0; j < 13; ++j) {
            const float* src; bf16_t* dst; int K, N, mode = 0, perm = 1;
            if (j < 10) { const int l = j / 5, r = j % 5;
                if (r == 0) { src = IN(2) + (size_t)l * D * INCOLS; dst = WIN + (size_t)l * INCOLS * D; K = D; N = INCOLS; }
                else if (r < 4) { src = IN(10) + (size_t)(l * 3 + r - 1) * 512 * D; dst = WBR + (size_t)(l * 3 + r - 1) * D * 512; K = 512; N = D; }
                else { src = IN(11) + (size_t)l * D * D; dst = WOUT + (size_t)l * D * D; K = D; N = D; perm = 0; } }
            else if (j == 10) { src = IN(13); dst = WGU; K = D; N = DFF; mode = 1; }
            else if (j == 11) { src = IN(14); dst = WGU; K = D; N = DFF; mode = 2; }
            else { src = IN(15); dst = WDN; K = DFF; N = D; perm = 0; }
            tc_job(src, K, N, dst, mode, perm, tile, WGI, GSZ, tid);
        }
        if (WGI == 0) { const float a0 = IN(3)[tid], a1 = IN(3)[512 + tid]; LBB[tid] = 0.f; LBB[512 + tid] = sigmoidf_(a1 - a0); }
    }
    if (RUN(0)) { __syncthreads(); phase_rmsnorm<false>(IN(0), IN(1), XNB, nullptr, nullptr, nullptr, nullptr, WGI, GSZ, wid, LANEID); }
    SEAM(0);

    for (int l = 0; l < 2; ++l) {
        const int sb = l * 10;
        if (l == 1) { for (int rep_ = 0; rep_ < NREP(1); ++rep_) if (RUN(10)) phase_rmsnorm<false>(XRES, IN(1) + D, XNB, nullptr, nullptr, nullptr, nullptr, WGI, GSZ, wid, LANEID); SEAM(10); }
        for (int rep_ = 0; rep_ < NREP(2); ++rep_) if (RUN(sb + 1)) { Order S; S.init(XNB, WIN + (size_t)l * INCOLS * D, MTOK, PCOLS, D, GSZ, WGI); EpiAct E{PBUF, PCOLS, LBB + l * 512, 1}; run_gemm(lds, S, D, E, wid); }
        SEAM(sb + 1);
        for (int rep_ = 0; rep_ < NREP(3); ++rep_) if (RUN(sb + 2)) {
            phase_hgrn_a(PBUF, OCATB, HDUMP, HU, HDSC, lds, WGI, GSZ, TIDV, wid, LANEID);
            __syncthreads();
            phase_attn(PBUF, IN(8) + l * 64, IN(9) + l * 64, OCATB + (size_t)2 * MTOK * 512, lds, WGI, GSZ, TIDV, wid, LANEID);
            __syncthreads();
            phase_gmlp(PBUF, IN(6) + (size_t)l * 4 * 16384, IN(7) + l * 512, IN(5) + l * 512, OCATB + (size_t)MTOK * 512, lds, WGI, GSZ, TIDV, wid, LANEID);
        }
        SEAM(sb + 2);
        if (RUN(sb + 3)) phase_hgrn_c(PBUF, OCATB, HDUMP, HU, HDSC, IN(4) + l * 128, lds, WGI, GSZ, TIDV, wid, LANEID);
        SEAM(sb + 3);
        for (int rep_ = 0; rep_ < NREP(4); ++rep_) if (RUN(sb + 4)) { Order S; S.init(XNB, WIN + (size_t)l * INCOLS * D + (size_t)PCOLS * D, MTOK, GCOLS, D, GSZ, WGI); EpiAct E{GBUF, GCOLS, nullptr, 0}; run_gemm(lds, S, D, E, wid); }
        SEAM(sb + 4);
        if (RUN(sb + 5)) { Order S; S.init(OCATB, WBR + (size_t)l * 3 * D * 512, MTOK, GCOLS, 512, GSZ, WGI, 3, (size_t)MTOK * 512 * 2, (size_t)D * 512 * 2); EpiBranch E{GBUF, XNB}; run_gemm(lds, S, 512, E, wid); }
        SEAM(sb + 5);
        if (RUN(sb + 6)) { Order S; S.init(XNB, WOUT + (size_t)l * D * D, MTOK, D, D, GSZ, WGI); EpiResid E{(l == 0) ? IN(0) : (const float*)XRES, XRES}; run_gemm(lds, S, D, E, wid); }
        SEAM(sb + 6);
        if (l == 0) {
            for (int rep_ = 0; rep_ < NREP(6); ++rep_) if (RUN(7)) phase_rmsnorm<false>(XRES, IN(12), XNB, nullptr, nullptr, nullptr, nullptr, WGI, GSZ, wid, LANEID);
            SEAM(7);
            for (int rep_ = 0; rep_ < NREP(7); ++rep_) if (RUN(8)) { Order S; S.init(XNB, WGU, MTOK, 2 * DFF, D, GSZ, WGI); EpiGU E{HIDB}; run_gemm(lds, S, D, E, wid); }
            SEAM(8);
            if (RUN(9)) { Order S; S.init(HIDB, WDN, MTOK, D, DFF, GSZ, WGI); EpiResid E{XRES, XRES}; run_gemm(lds, S, DFF, E, wid); }
            SEAM(9);
        } else {
            for (int rep_ = 0; rep_ < NREP(8); ++rep_) if (RUN(17)) phase_rmsnorm<true>(XRES, IN(12) + D, XNB, IN(16), IN(17), TOKE, TOKW, WGI, GSZ, wid, LANEID);
            SEAM(17);
            for (int rep_ = 0; rep_ < NREP(9); ++rep_) if (RUN(18)) {
                if (WGI == GSZ - 1) moe_assign(TOKE, TOKW, METAB, STOK, SWB, BLKE, lds, TIDV);
                else { LAS float* tile = (LAS float*)lds; const int tid = TIDV;
#pragma unroll 1
                    for (int j = 0; j < 3 * NEXP; ++j) { const int e = j / 3, r = j % 3;
                        const float* src = (r == 0 ? IN(18) : r == 1 ? IN(19) : IN(20)) + (size_t)e * D * DFF;
                        bf16_t* dst = (r == 2) ? MWDN + (size_t)e * D * DFF : MWGU + (size_t)e * 2 * DFF * D;
                        tc_job(src, r == 2 ? DFF : D, r == 2 ? D : DFF, dst, r == 2 ? 0 : r + 1, r == 2 ? 0 : 1, tile, WGI, GSZ - 1, tid); } }
            }
            SEAM(18);
#define META(i) __hip_atomic_load(METAB + (i), __ATOMIC_RELAXED, __HIP_MEMORY_SCOPE_AGENT)
            if (RUN(19)) { const int rows = META(0), s0 = META(2); moe_gather(XNB, STOK + s0, rows, XSB, WGI, GSZ, wid, LANEID); }
            SEAM(19);
            for (int kc = 0; kc < 2; ++kc) {
                const int se = 20 + 2 * kc;
                for (int rep_ = 0; rep_ < NREP(11); ++rep_) if (RUN(se)) { const int rows = META(kc), s0 = META(2 + kc);
                    Order S; S.init(XSB, MWGU, rows, 2 * DFF, D, GSZ, WGI, 2, 0, (size_t)2 * DFF * D * 2, BLKE + (s0 >> 8)); EpiGU E{MHIDB}; run_gemm(lds, S, D, E, wid); }
                SEAM(se);
                if (RUN(se + 1)) { const int rows = META(kc), s0 = META(2 + kc);
                    Order S; S.init(MHIDB, MWDN, rows, D, DFF, GSZ, WGI, 2, 0, (size_t)D * DFF * 2, BLKE + (s0 >> 8)); EpiMoeDown E{XRES, STOK + s0, SWB + s0}; run_gemm(lds, S, DFF, E, wid);
                    if (kc == 0) { const int rows1 = META(1), s1 = META(3); moe_gather(XNB, STOK + s1, rows1, XSB, WGI, GSZ, wid, LANEID); } }
                SEAM(se + 1);
            }
        }
    }
}

extern "C" void kernel_launch(void* const* d_in, const int* in_sizes, int n_in, void* d_out, int out_size, void* d_ws, size_t ws_size, hipStream_t stream) {
    static int grid = 0;
    if (grid == 0) {
        if (n_in != 21 || out_size != MTOK * D || ws_size < WS_NEED) { fprintf(stderr, "kernel_launch: unexpected shapes (n_in %d out %d ws %zu need %zu)\n", n_in, out_size, ws_size, (size_t)WS_NEED); grid = -1; return; }
        int dev = 0, cus = 0, per_cu = 0;
        if (hipGetDevice(&dev) != hipSuccess || hipDeviceGetAttribute(&cus, hipDeviceAttributeMultiprocessorCount, dev) != hipSuccess) { grid = -1; return; }
        if (hipFuncSetAttribute((const void*)mk_fwd, hipFuncAttributeMaxDynamicSharedMemorySize, LDS_BYTES) != hipSuccess) { fprintf(stderr, "kernel_launch: hipFuncSetAttribute failed\n"); grid = -1; return; }
        if (hipOccupancyMaxActiveBlocksPerMultiprocessor(&per_cu, (const void*)mk_fwd, NTHREADS, LDS_BYTES) != hipSuccess || per_cu < 1) { fprintf(stderr, "kernel_launch: occupancy query says %d\n", per_cu); (void)hipGetLastError(); per_cu = 1; }
        grid = cus;
    }
    if (grid < 0) return;
    (void)hipMemsetAsync((char*)d_ws + WS_CTL, 0, CTL_BYTES, stream);
    Args a{};
    for (int i = 0; i < 21; ++i) a.in[i] = (const float*)d_in[i];
    a.out = (float*)d_out; a.ws = (unsigned char*)d_ws;
#if defined(MK_CHECK)
    {
        unsigned char* ws = (unsigned char*)d_ws; unsigned* diag = (unsigned*)(ws + WS_DIAG); float* snap = (float*)(ws + WS_SNAP);
        const bf16_t* XN = (const bf16_t*)(ws + WS_XN); const bf16_t* Pb = (const bf16_t*)(ws + WS_P); const bf16_t* OC = (const bf16_t*)(ws + WS_OCAT); const float* LB = (const float*)(ws + WS_LB);
        auto run = [&](int s) { a.lo = s; a.hi = s + 1; hipLaunchKernelGGL(mk_fwd, dim3(grid), dim3(NTHREADS), LDS_BYTES, stream, a); };
        hipLaunchKernelGGL(k_diag_init, dim3(1), dim3(64), 0, stream, diag);
        int s = 0; run(s++);
        for (int l = 0; l < 2; ++l) {
            const unsigned cb = l * 10;
            const float* win = a.in[2] + (size_t)l * D * INCOLS;
            if (l == 1) run(s++);
            run(s++);
            { ChkGemm c{}; c.A = XN; c.lda = D; c.W = win; c.ldw = INCOLS; c.K = D; c.mode = 0; c.Cb = Pb; c.ldc = PCOLS; c.lb = LB + l * 512; c.ncols = PCOLS; c.code = cb + 1; hipLaunchKernelGGL(k_chk_gemm, dim3(64), dim3(96), 0, stream, c, diag); }
            run(s++); run(s++);
            hipLaunchKernelGGL(k_chk_hgrn, dim3(128), dim3(128), 0, stream, Pb, a.in[4] + l * 128, OC, cb + 2, diag);
            hipLaunchKernelGGL(k_chk_gmlp, dim3(8), dim3(64), 0, stream, Pb, a.in[6] + (size_t)l * 4 * 16384, a.in[7] + l * 512, a.in[5] + l * 512, OC + (size_t)MTOK * 512, cb + 3, diag);
            hipLaunchKernelGGL(k_chk_attn, dim3(320), dim3(64), 0, stream, Pb, a.in[8] + l * 64, a.in[9] + l * 64, OC + (size_t)2 * MTOK * 512, cb + 4, diag);
            run(s++);
            { ChkGemm c{}; c.A = XN; c.lda = D; c.W = win + PCOLS; c.ldw = INCOLS; c.K = D; c.mode = 1; c.Cb = (const bf16_t*)(ws + WS_G); c.ldc = GCOLS; c.ncols = GCOLS; c.code = cb + 5; hipLaunchKernelGGL(k_chk_gemm, dim3(64), dim3(96), 0, stream, c, diag); }
            run(s++);
            if (l == 1) hipLaunchKernelGGL(k_snapshot, dim3(64), dim3(256), 0, stream, (const float*)d_out, snap);
            run(s++);
            { ChkGemm c{}; c.A = XN; c.lda = D; c.W = a.in[11] + (size_t)l * D * D; c.ldw = D; c.K = D; c.mode = 3; c.Cf = (const float*)d_out; c.xold = l ? snap : a.in[0]; c.use_snap = l; c.ncols = D; c.code = cb + 7; hipLaunchKernelGGL(k_chk_gemm, dim3(64), dim3(96), 0, stream, c, diag); }
            run(s++);
            if (l == 0) {
                run(s++);
                { ChkGemm c{}; c.A = XN; c.lda = D; c.W = a.in[13]; c.W2 = a.in[14]; c.ldw = DFF; c.K = D; c.mode = 4; c.Cb = (const bf16_t*)(ws + WS_HID); c.ldc = DFF; c.ncols = DFF; c.code = cb + 8; hipLaunchKernelGGL(k_chk_gemm, dim3(64), dim3(96), 0, stream, c, diag); }
                hipLaunchKernelGGL(k_snapshot, dim3(64), dim3(256), 0, stream, (const float*)d_out, snap);
                run(s++);
                { ChkGemm c{}; c.A = (const bf16_t*)(ws + WS_HID); c.lda = DFF; c.W = a.in[15]; c.ldw = D; c.K = DFF; c.mode = 3; c.Cf = (const float*)d_out; c.xold = snap; c.use_snap = 1; c.ncols = D; c.code = cb + 9; hipLaunchKernelGGL(k_chk_gemm, dim3(64), dim3(96), 0, stream, c, diag); }
            } else {
                hipLaunchKernelGGL(k_snapshot, dim3(64), dim3(256), 0, stream, (const float*)d_out, snap);
                for (int e = 0; e < 6; ++e) run(s++);
                hipLaunchKernelGGL(k_chk_moe, dim3(16), dim3(256), 0, stream, XN, a.in[16], a.in[17], a.in[18], a.in[19], a.in[20], (const float*)snap, (const float*)d_out, 20u, diag);
            }
        }
        if (s != NSTEPS) fprintf(stderr, "step count mismatch %d\n", s);
        hipLaunchKernelGGL(k_apply_diag, dim3(1024), dim3(256), 0, stream, (float*)d_out, (const unsigned*)diag);
    }
#elif !defined(MK_ONE_LAUNCH)
    for (int s = 0; s < NSTEPS; ++s) { a.lo = s; a.hi = s + 1; hipLaunchKernelGGL(mk_fwd, dim3(grid), dim3(NTHREADS), LDS_BYTES, stream, a); }
#else
    a.lo = 0; a.hi = NSTEPS; hipLaunchKernelGGL(mk_fwd, dim3(grid), dim3(NTHREADS), LDS_BYTES, stream, a);
#endif
}
```

```cpp
#define MK_ONE_LAUNCH 1
#include <hip/hip_runtime.h>
#include <cstdio>
#include <cstdint>
#include <cstddef>

#define LAS __attribute__((address_space(3)))
#define XB_TMO      128
#define XB_XCNT(j)  (256  + 64 * (j))
#define XB_XSUB(j)  (1280 + 64 * (j))
#define XB_XGEN(j)  (2304 + 64 * (j))
#define XB_TOP      3328
#define XB_TOPGEN   3392
#define XCD_BAR_WORDS 3456
#define XB_SPIN_CAP (1u << 18)

__device__ __forceinline__ unsigned xb_ld(unsigned* p)              { return __hip_atomic_load(p, __ATOMIC_RELAXED, __HIP_MEMORY_SCOPE_AGENT); }
__device__ __forceinline__ unsigned xb_add(unsigned* p, unsigned v) { return __hip_atomic_fetch_add(p, v, __ATOMIC_RELAXED, __HIP_MEMORY_SCOPE_AGENT); }
__device__ __forceinline__ unsigned xb_xcc_id() { return (unsigned)__builtin_amdgcn_s_getreg((3 << 11) | 20) & 0xFu; }
#define XB_SPIN(cond, bar) do { unsigned _sp = 0; while (cond) { __builtin_amdgcn_s_sleep(1); \
    if ((++_sp & 255u) == 0u) { if (xb_ld(&(bar)[XB_TMO])) break; if (_sp > XB_SPIN_CAP) { atomicAdd(&(bar)[XB_TMO], 1u); break; } } } } while (0)

struct XcdBarrier {
    unsigned* bar; unsigned x;
    volatile LAS unsigned* st;
};

__device__ __forceinline__ XcdBarrier xcd_barrier_post(unsigned* bar, volatile LAS unsigned* st) {
    XcdBarrier b; b.bar = bar; b.x = xb_xcc_id(); b.st = st;
    if (threadIdx.x == 0) (void)xb_add(&bar[XB_XCNT(b.x)], 1u);
    return b;
}
__device__ __forceinline__ void xcd_barrier_complete(unsigned* bar, unsigned x, unsigned& nloc, unsigned& nx) {
    const unsigned G = gridDim.x * gridDim.y * gridDim.z;
    unsigned sum, cnt, mine, sp = 0u;
    for (;;) {
        sum = 0u; cnt = 0u; mine = 0u;
#pragma unroll
        for (unsigned j = 0; j < 16; ++j) { const unsigned c = xb_ld(&bar[XB_XCNT(j)]); sum += c; cnt += (c > 0u) ? 1u : 0u; mine = (j == x) ? c : mine; }
        if (sum == G) break;
        __builtin_amdgcn_s_sleep(1);
        if ((++sp & 255u) == 0u) { if (xb_ld(&bar[XB_TMO])) break; if (sp > XB_SPIN_CAP) { atomicAdd(&bar[XB_TMO], 1u); break; } }
    }
    nloc = mine > 0u ? mine : 1u; nx = cnt > 0u ? cnt : 1u;
}

__device__ __forceinline__ void xcd_barrier(const XcdBarrier& b) {
    asm volatile("s_waitcnt vmcnt(0)" ::: "memory");
    __syncthreads();
    if (threadIdx.x == 0) {
        unsigned* bar = b.bar;
        __builtin_amdgcn_s_waitcnt(0);
        unsigned nloc = b.st[0], nx = b.st[1];
        if (nloc == 0u) { xcd_barrier_complete(bar, b.x, nloc, nx); b.st[0] = nloc; b.st[1] = nx; }
        const unsigned old = xb_add(&bar[XB_XSUB(b.x)], 1u);
        const unsigned gen = old / nloc;
        if (old + 1u == (gen + 1u) * nloc) {
            __builtin_amdgcn_fence(__ATOMIC_RELEASE, "agent");
            asm volatile("s_waitcnt vmcnt(0)" ::: "memory");
            const unsigned og = xb_add(&bar[XB_TOP], 1u);
            const unsigned tg = og / nx;
            if (og + 1u == (tg + 1u) * nx) xb_add(&bar[XB_TOPGEN], 1u);
            else XB_SPIN(xb_ld(&bar[XB_TOPGEN]) == tg, bar);
            __builtin_amdgcn_fence(__ATOMIC_ACQUIRE, "agent");
            xb_add(&bar[XB_XGEN(b.x)], 1u);
            asm volatile("s_waitcnt vmcnt(0)" ::: "memory");
        } else {
            XB_SPIN(xb_ld(&bar[XB_XGEN(b.x)]) == gen, bar);
            __builtin_amdgcn_fence(__ATOMIC_ACQUIRE, "agent");
            asm volatile("s_waitcnt vmcnt(0)" ::: "memory");
        }
    }
    __syncthreads();
}
namespace pg8 {
#define PG8_LAS __attribute__((address_space(3)))
typedef unsigned short bf16_t;
typedef short bf16x8 __attribute__((ext_vector_type(8)));
typedef float f32x4 __attribute__((ext_vector_type(4)));
typedef unsigned u32x4 __attribute__((ext_vector_type(4)));
constexpr int BM = 256, BK = 64, HALF = 128, HTB = HALF * BK * 2  , STAGE_BYTES = 8 * HTB, NXCD = 8, WGM = 8;

__host__ __device__ __forceinline__ int lds_byte(int r, int c) { const int st = (r >> 4) * 2 + (c >> 5), rr = r & 15, cc = c & 31, ob = rr * 64 + cc * 2; return st * 1024 + (ob ^ (((ob >> 9) & 1) << 5)); }
__host__ __device__ __forceinline__ void stage_rc(int b, int& R, int& C) { const int st = b / 1024, sb = b % 1024, swz = sb ^ (((sb >> 9) & 1) << 5); R = (st >> 1) * 16 + swz / 64; C = (st & 1) * 32 + (swz % 64) / 2; }
__host__ __device__ __forceinline__ int perm32(int rho) { const int n = rho >> 4, i = rho & 15; return 8 * (i >> 2) + 4 * n + (i & 3); }

struct Unit { int pm, pn; const char* a; const char* b; int nt, atomic; };

typedef float f32x2 __attribute__((ext_vector_type(2))); typedef __bf16 bf16x2_t __attribute__((ext_vector_type(2)));
__device__ __forceinline__ unsigned cvt_pk_bf16(float lo, float hi) { f32x2 v = {lo, hi}; bf16x2_t b = __builtin_convertvector(v, bf16x2_t); return __builtin_bit_cast(unsigned, b); }
template <class Epi, class Sched, bool ALIGN_EPI = false, bool SP2 = false, bool VARNT = false, int NSEG = 1>
__device__ __forceinline__ void gemm_phase(PG8_LAS unsigned char* lds, const int K, const Sched& S, const Epi& E, const int wid) {
    int lane; asm volatile("v_mbcnt_lo_u32_b32 %0, -1, 0\n\tv_mbcnt_hi_u32_b32 %0, -1, %0" : "=v"(lane));
    const int tid = wid * 64 + lane, wr = wid >> 2, wc = wid & 3, fr = lane & 15, fq = lane >> 4;
    unsigned voffA[2];
#pragma unroll
    for (int i = 0; i < 2; ++i) { int R, C; stage_rc(tid * 16 + i * 8192, R, C); voffA[i] = (unsigned)(R * K + C) * 2u; }
    const size_t kstep = (size_t)(BK * 2);
    const size_t hstep = (size_t)HALF * K * 2;
    const unsigned ldsw = (unsigned)wid * 1024u;
    const int aoff = lds_byte(wr * 64 + fr, fq * 8), boff = lds_byte(wc * 32 + fr, fq * 8);
#define PG8_SA(b, h) (((b) * 2 + (h)) * HTB)
#define PG8_SB(b, h) ((4 + (b) * 2 + (h)) * HTB)
#define PG8_STAGE(bufoff, gbase, voff) do { _Pragma("unroll") for (int _i = 0; _i < 2; ++_i) \
        __builtin_amdgcn_global_load_lds((const unsigned*)((const char*)(gbase) + (voff)[_i]), (PG8_LAS unsigned*)(lds + (bufoff) + ldsw + _i * 8192), 16, 0, 0); } while (0)
#define PG8_LDA(dst, b, h) do { _Pragma("unroll") for (int m = 0; m < 4; ++m) _Pragma("unroll") for (int k = 0; k < 2; ++k) dst[m][k] = *(const PG8_LAS bf16x8*)(lds + PG8_SA(b, h) + aoff + m * 2048 + k * 1024); } while (0)
#define PG8_LDB(dst, b, h) do { _Pragma("unroll") for (int n = 0; n < 2; ++n) _Pragma("unroll") for (int k = 0; k < 2; ++k) dst[n][k] = *(const PG8_LAS bf16x8*)(lds + PG8_SB(b, h) + boff + n * 2048 + k * 1024); } while (0)
#define PG8_MMA(ai, bj, At, Bt) do { __builtin_amdgcn_s_setprio(1); _Pragma("unroll") for (int m = 0; m < 4; ++m) _Pragma("unroll") for (int n = 0; n < 2; ++n) _Pragma("unroll") for (int k = 0; k < 2; ++k) \
        acc[ai][bj][m][n] = __builtin_amdgcn_mfma_f32_16x16x32_bf16(Bt[n][k], At[m][k], acc[ai][bj][m][n], 0, 0, 0); __builtin_amdgcn_s_setprio(0); } while (0)
#define PG8_WAIT_V(n) asm volatile("s_waitcnt vmcnt(" #n ")" ::: "memory")
#define PG8_WAIT_L(n) asm volatile("s_waitcnt lgkmcnt(" #n ")" ::: "memory")
#define PG8_BAR __builtin_amdgcn_s_barrier()
#define PG8_SCHED __builtin_amdgcn_sched_barrier(0)
    Unit cur, nxt; int ui = 0;
    if (!S.next(0, cur)) return;
    f32x4 acc[2][2][4][2];
#pragma unroll
    for (int a = 0; a < 2; ++a)
#pragma unroll
        for (int b = 0; b < 2; ++b)
#pragma unroll
            for (int m = 0; m < 4; ++m)
#pragma unroll
                for (int n = 0; n < 2; ++n) acc[a][b][m][n] = (f32x4){0.f, 0.f, 0.f, 0.f};
    bf16x8 At[4][2], B0[2][2], B1[2][2];
    const char* cA = cur.a; const char* cB = cur.b;
    S.a_ready(cur);
    if constexpr (SP2) {
        PG8_STAGE(PG8_SB(0, 0), cB, voffA); PG8_STAGE(PG8_SB(0, 1), cB + hstep, voffA); PG8_STAGE(PG8_SA(0, 0), cA, voffA); PG8_STAGE(PG8_SA(0, 1), cA + hstep, voffA);
        if (wr == 1) PG8_BAR;
        PG8_WAIT_V(2); PG8_BAR;
        PG8_STAGE(PG8_SB(1, 0), cB + kstep, voffA); PG8_STAGE(PG8_SA(1, 0), cA + kstep, voffA); PG8_STAGE(PG8_SB(1, 1), cB + hstep + kstep, voffA);
        PG8_WAIT_V(6); PG8_BAR;
    } else {
        PG8_STAGE(PG8_SB(0, 0), cB, voffA); PG8_STAGE(PG8_SA(0, 0), cA, voffA); PG8_STAGE(PG8_SB(0, 1), cB + hstep, voffA); PG8_STAGE(PG8_SA(0, 1), cA + hstep, voffA);
        if (wr == 1) PG8_BAR;
        PG8_WAIT_V(4); PG8_BAR;
        PG8_STAGE(PG8_SB(1, 0), cB + kstep, voffA); PG8_STAGE(PG8_SA(1, 0), cA + kstep, voffA); PG8_STAGE(PG8_SB(1, 1), cB + hstep + kstep, voffA);
        PG8_WAIT_V(6); PG8_BAR;
    }
    for (;;) {
        const bool has_next = S.next(ui + 1, nxt);
        const char* nA = has_next ? nxt.a : cA; const char* nB = has_next ? nxt.b : cB;
        const int nt = VARNT ? cur.nt : NSEG * (K / BK); constexpr bool SEGD = (NSEG > 1); const int KT = K / BK;
        for (int t = 0; t < nt; t += 2) {
            const bool last = (t == nt - 2);
            const char* a1 = SEGD ? cA + (size_t)((t + 1) / KT) * S.abr + (size_t)((t + 1) % KT) * kstep : cA + (size_t)(t + 1) * kstep;
            const char* a2 = last ? nA : (SEGD ? cA + (size_t)((t + 2) / KT) * S.abr + (size_t)((t + 2) % KT) * kstep : cA + (size_t)(t + 2) * kstep);
            const char* b2 = last ? nB : (SEGD ? cB + (size_t)((t + 2) / KT) * S.bbr + (size_t)((t + 2) % KT) * kstep : cB + (size_t)(t + 2) * kstep);
            const char* a3 = a2 + kstep; const char* b3 = b2 + kstep;
            if (last && has_next) S.a_ready(nxt);
            if constexpr (SP2) {
            PG8_LDB(B0, 0, 0); PG8_LDB(B1, 0, 1); PG8_SCHED; PG8_LDA(At, 0, 0); PG8_STAGE(PG8_SA(1, 1), a1 + hstep, voffA);
            PG8_WAIT_V(8); PG8_WAIT_L(0); PG8_BAR; PG8_MMA(0, 0, At, B0); PG8_MMA(0, 1, At, B1); PG8_BAR; PG8_SCHED;
            PG8_LDA(At, 0, 1); PG8_STAGE(PG8_SB(0, 0), b2, voffA); PG8_STAGE(PG8_SB(0, 1), b2 + hstep, voffA); PG8_STAGE(PG8_SA(0, 0), a2, voffA);
            PG8_WAIT_V(8); PG8_WAIT_L(0); PG8_BAR; PG8_MMA(1, 0, At, B0); PG8_MMA(1, 1, At, B1); PG8_BAR; PG8_SCHED;
            PG8_LDB(B0, 1, 0); PG8_LDB(B1, 1, 1); PG8_SCHED; PG8_LDA(At, 1, 0); PG8_STAGE(PG8_SA(0, 1), a2 + hstep, voffA);
            PG8_WAIT_V(8); PG8_WAIT_L(0); PG8_BAR; PG8_MMA(0, 0, At, B0); PG8_MMA(0, 1, At, B1); PG8_BAR; PG8_SCHED;
            PG8_LDA(At, 1, 1); PG8_STAGE(PG8_SB(1, 0), b3, voffA); PG8_STAGE(PG8_SB(1, 1), b3 + hstep, voffA); PG8_STAGE(PG8_SA(1, 0), a3, voffA);
            PG8_WAIT_V(8); PG8_WAIT_L(0); PG8_BAR; PG8_MMA(1, 0, At, B0); PG8_MMA(1, 1, At, B1); PG8_BAR; PG8_SCHED;
            } else {
            PG8_LDB(B0, 0, 0); PG8_SCHED; PG8_LDA(At, 0, 0); PG8_STAGE(PG8_SA(1, 1), a1 + hstep, voffA);
            PG8_WAIT_L(8); PG8_BAR; PG8_WAIT_L(0); PG8_MMA(0, 0, At, B0); PG8_BAR; PG8_SCHED;
            PG8_LDB(B1, 0, 1); PG8_STAGE(PG8_SB(0, 0), b2, voffA);
            PG8_BAR; PG8_WAIT_L(0); PG8_MMA(0, 1, At, B1); PG8_BAR;
            PG8_LDA(At, 0, 1); PG8_STAGE(PG8_SA(0, 0), a2, voffA);
            PG8_BAR; PG8_WAIT_L(0); PG8_MMA(1, 0, At, B0); PG8_BAR; PG8_SCHED;
            PG8_STAGE(PG8_SB(0, 1), b2 + hstep, voffA);
            PG8_WAIT_V(6); PG8_BAR; PG8_MMA(1, 1, At, B1); PG8_BAR;
            PG8_LDB(B0, 1, 0); PG8_SCHED; PG8_LDA(At, 1, 0); PG8_STAGE(PG8_SA(0, 1), a2 + hstep, voffA);
            PG8_WAIT_L(8); PG8_BAR; PG8_WAIT_L(0); PG8_MMA(0, 0, At, B0); PG8_BAR; PG8_SCHED;
            PG8_LDB(B1, 1, 1); PG8_STAGE(PG8_SB(1, 0), b3, voffA);
            PG8_BAR; PG8_WAIT_L(0); PG8_MMA(0, 1, At, B1); PG8_BAR;
            PG8_LDA(At, 1, 1); PG8_STAGE(PG8_SA(1, 0), a3, voffA);
            PG8_BAR; PG8_WAIT_L(0); PG8_MMA(1, 0, At, B0); PG8_BAR; PG8_SCHED;
            PG8_STAGE(PG8_SB(1, 1), b3 + hstep, voffA);
            PG8_WAIT_V(6); PG8_BAR; PG8_MMA(1, 1, At, B1); PG8_BAR;
            }
            if constexpr (SEGD) { if (((t + 2) % KT) == 0 && t + 2 < nt) E.mid(acc, cur, (t + 2) / KT - 1, wr, wc, fr, fq); }
        }
        if constexpr (ALIGN_EPI) { if (wr == 0) PG8_BAR; }
        if constexpr (!Epi::AFTER_DRAIN) { E(acc, cur, wr, wc, fr, fq); S.done(cur); }
        if (!has_next) break;
#pragma unroll
        for (int a = 0; a < 2; ++a)
#pragma unroll
            for (int b = 0; b < 2; ++b)
#pragma unroll
                for (int m = 0; m < 4; ++m)
#pragma unroll
                    for (int n = 0; n < 2; ++n) acc[a][b][m][n] = (f32x4){0.f, 0.f, 0.f, 0.f};
        cur = nxt; cA = nA; cB = nB; ++ui;
        if constexpr (ALIGN_EPI) { if (wr == 1) PG8_BAR; }
    }
    PG8_WAIT_V(0);
    if constexpr (!ALIGN_EPI) { if (wr == 0) PG8_BAR; }
    PG8_BAR;
    if constexpr (Epi::AFTER_DRAIN) { E.fused(acc, cur, wr, wc, fr, fq, lds, wid, lane); S.done(cur); }
#undef PG8_SA
#undef PG8_SB
#undef PG8_STAGE
#undef PG8_LDA
#undef PG8_LDB
#undef PG8_MMA
#undef PG8_WAIT_V
#undef PG8_WAIT_L
#undef PG8_BAR
#undef PG8_SCHED
}
}

typedef pg8::bf16_t bf16_t;
typedef pg8::f32x4 f32x4;
typedef pg8::u32x4 u32x4;
using pg8::cvt_pk_bf16;
constexpr int NB = 4, SEQ = 8192, D = 1024, MTOK = NB * SEQ;
constexpr int PCOLS = 4608, GCOLS = 3072, INCOLS = 7680, DFF = 3584, NEXP = 8;
constexpr int C_HQ = 0, C_HF = 512, C_HI = 1024, C_HG = 1536, C_GU = 2048, C_GV = 2560, C_SQ = 3072, C_SK = 3584, C_SV = 4096;
constexpr float EPS = 1e-6f;
constexpr int NSLOT = 2 * MTOK + 2 * NEXP * 256, MOE_MAXBLK = MTOK / 256 + NEXP;
constexpr int NTHREADS = 512, NWAVES = 8;
constexpr int LDS_BYTES = 147456, LDS_MISC = LDS_BYTES - 256;

constexpr size_t WS_CTL = 0, CTL_BYTES = 65536;
constexpr size_t CW_BAR = 0;
constexpr size_t WS_META = WS_CTL + CTL_BYTES;
constexpr size_t WS_LB = WS_META + 4096;
constexpr size_t WS_TOKE = WS_LB + 4096;
constexpr size_t WS_TOKW = WS_TOKE + (size_t)MTOK * 4;
constexpr size_t WS_SLOTTOK = WS_TOKW + (size_t)MTOK * 8;
constexpr size_t WS_SLOTW = WS_SLOTTOK + (size_t)NSLOT * 4;
constexpr size_t WS_BLKE = WS_SLOTW + (size_t)NSLOT * 4;
constexpr size_t WS_W = 2u << 20;
static_assert(WS_BLKE + 4096 <= WS_W, "small buffers");
constexpr size_t WS_WIN = WS_W;
constexpr size_t WS_WBR = WS_WIN + (size_t)2 * INCOLS * D * 2;
constexpr size_t WS_WOUT = WS_WBR + (size_t)2 * 3 * D * 512 * 2;
constexpr size_t WS_WGU = WS_WOUT + (size_t)2 * D * D * 2;
constexpr size_t WS_WD = WS_WGU + (size_t)2 * DFF * D * 2;
constexpr size_t WS_XN = WS_WD + (size_t)D * DFF * 2;
constexpr size_t WS_C = WS_XN + (size_t)MTOK * D * 2;
constexpr size_t WS_P = WS_C;
constexpr size_t WS_G = WS_C;
constexpr size_t WS_HID = WS_C;
constexpr size_t WS_OCAT = WS_C + (size_t)MTOK * PCOLS * 2;
constexpr size_t WS_ORAW = WS_OCAT + (size_t)3 * MTOK * 512 * 2;
constexpr size_t WS_END1 = WS_ORAW + (size_t)MTOK * 512 * 4;
constexpr size_t WS_MWD = WS_W;
static_assert(WS_MWD + (size_t)NEXP * D * DFF * 2 <= WS_XN, "moe down weights fit below XN");
constexpr size_t WS_MWGU = WS_C;
constexpr size_t WS_XS = WS_MWGU + (size_t)NEXP * 2 * DFF * D * 2;
constexpr size_t WS_MHID = WS_XS + (size_t)MOE_MAXBLK * 256 * D * 2;
constexpr size_t WS_END2 = WS_MHID + (size_t)MOE_MAXBLK * 256 * DFF * 2;
constexpr size_t WS_NEED = WS_END1 > WS_END2 ? WS_END1 : WS_END2;
static_assert(WS_NEED <= 615053344ull, "workspace budget (sum of the inputs)");

#define LAUNDER(v) asm volatile("" : "+v"(v))
__device__ __forceinline__ float bf2f(unsigned v) { return __uint_as_float(v << 16); }
__device__ __forceinline__ float bflo(unsigned w) { return __uint_as_float(w << 16); }
__device__ __forceinline__ float bfhi(unsigned w) { return __uint_as_float(w & 0xffff0000u); }
__device__ __forceinline__ bf16_t f2bf(float f) { return (bf16_t)(cvt_pk_bf16(f, 0.f) & 0xffffu); }
template <int M> __device__ __forceinline__ float xor_f(float v) { return __builtin_bit_cast(float, __builtin_amdgcn_ds_swizzle(__builtin_bit_cast(int, v), (M << 10) | 0x1f)); }
__device__ __forceinline__ float bperm_f(float v, int src_lane) { return __builtin_bit_cast(float, __builtin_amdgcn_ds_bpermute(src_lane << 2, __builtin_bit_cast(int, v))); }
__device__ __forceinline__ float wave_sum(float v) {
    v += xor_f<1>(v); v += xor_f<2>(v); v += xor_f<4>(v); v += xor_f<8>(v); v += xor_f<16>(v);
    return __builtin_bit_cast(float, __builtin_amdgcn_readlane(__builtin_bit_cast(int, v), 0)) + __builtin_bit_cast(float, __builtin_amdgcn_readlane(__builtin_bit_cast(int, v), 32));
}
__device__ __forceinline__ float sigmoidf_(float x) { return __builtin_amdgcn_rcpf(1.f + __expf(-x)); }
__device__ __forceinline__ float siluf_(float x) { return x * sigmoidf_(x); }
__device__ __forceinline__ float gelu_tanh_(float x) { return x * sigmoidf_(1.5957691216057308f * (x + 0.044715f * x * x * x)); }
__device__ __forceinline__ float softplusf_(float z) { return fmaxf(z, 0.f) + __logf(1.f + __expf(-fabsf(z))); }

struct Order {
    int nM, nN, nwg, G, c, mode; const char* A; const char* Bt; size_t tstep, abr, bbr; const int* bmap; int ktiles, nfull, tail, split;
    __device__ __forceinline__ void init(const void* A_, const void* Bt_, int M, int N, int K, int G_, int c_, int mode_ = 0, size_t abr_ = 0, size_t bbr_ = 0, const int* bmap_ = nullptr, int tailsplit = 0) { bmap = bmap_; ktiles = K / 64; split = 1; tail = 0;
        nM = M / 256; nN = N / 256; nwg = nM * nN; G = G_; c = c_; mode = mode_; A = (const char*)A_; Bt = (const char*)Bt_; tstep = (size_t)256 * K * 2; abr = abr_; bbr = bbr_; nfull = nwg;
        if (tailsplit) { nfull = (nwg / G) * G; tail = nwg - nfull; split = (tail > 0 && tail * 7 <= G) ? 7 : (tail > 0 && tail * 4 <= G) ? 4 : (tail > 0 && tail * 2 <= G) ? 2 : 1; } }
    __device__ __forceinline__ bool next(int i, pg8::Unit& u) const {
        if (mode == 4) {
            u.nt = ktiles; u.atomic = 0; const long L = (long)i * G + c; const int nt4 = nM * 4; if (L >= nt4) return false;
            int wgid = (int)L; { const int q = nt4 / 8, r = nt4 % 8, xcd = wgid % 8, off = wgid / 8; wgid = (xcd < r ? xcd * (q + 1) : r * (q + 1) + (xcd - r) * q) + off; }
            const int nig = 8 * 4, gid = wgid / nig, fm = gid * 8, gsz = (nM - fm) < 8 ? (nM - fm) : 8;
            u.pm = fm + ((wgid % nig) % gsz); u.pn = (wgid % nig) / gsz; u.a = A + (size_t)u.pm * tstep; u.b = Bt + (size_t)u.pn * tstep; return true; }
        if (mode == 3) {
            u.nt = ktiles; u.atomic = 0;
            const int br = i % 3; const long L = (long)(i / 3) * G + c; const int nt4 = nM * 4; if (L >= nt4) return false;
            int wgid = (int)L; { const int q = nt4 / 8, r = nt4 % 8, xcd = wgid % 8, off = wgid / 8; wgid = (xcd < r ? xcd * (q + 1) : r * (q + 1) + (xcd - r) * q) + off; }
            const int nig = 8 * 4, gid = wgid / nig, fm = gid * 8, gsz = (nM - fm) < 8 ? (nM - fm) : 8;
            u.pm = fm + ((wgid % nig) % gsz); const int pq = (wgid % nig) / gsz; u.pn = br * 4 + pq;
            u.a = A + (size_t)br * abr + (size_t)u.pm * tstep; u.b = Bt + (size_t)br * bbr + (size_t)pq * tstep; return true; }
        long L = (long)i * G + c; int slice = 0; u.nt = ktiles; u.atomic = 0;
        if (L >= nfull) {
            if (split == 1) { if (L >= nwg) return false; }
            else { const long tq = L - nfull; if (i != nfull / G || tq >= (long)tail * split) return false; L = nfull + tq / split; slice = (int)(tq % split); u.nt = ktiles / split; u.atomic = 1; } }
        int wgid = (int)L; { const int q = nwg / 8, r = nwg % 8, xcd = wgid % 8, off = wgid / 8; wgid = (xcd < r ? xcd * (q + 1) : r * (q + 1) + (xcd - r) * q) + off; }
        const int nig = 8 * nN, gid = wgid / nig, fm = gid * 8, gsz = (nM - fm) < 8 ? (nM - fm) : 8;
        u.pm = fm + ((wgid % nig) % gsz); u.pn = (wgid % nig) / gsz;
        if (mode == 0) { u.a = A + (size_t)u.pm * tstep; u.b = Bt + (size_t)u.pn * tstep; }
        else if (mode == 2) { const int ex = __hip_atomic_load(bmap + u.pm, __ATOMIC_RELAXED, __HIP_MEMORY_SCOPE_AGENT); u.a = A + (size_t)u.pm * tstep + (size_t)slice * u.nt * 128; u.b = Bt + (size_t)ex * bbr + (size_t)u.pn * tstep + (size_t)slice * u.nt * 128; }
        else { const int br = u.pn >> 2; u.a = A + (size_t)br * abr + (size_t)u.pm * tstep; u.b = Bt + (size_t)br * bbr + (size_t)(u.pn & 3) * tstep; }
        return true;
    }
    __device__ __forceinline__ void a_ready(const pg8::Unit&) const {}
    __device__ __forceinline__ void done(const pg8::Unit&) const {}
};

template <int ACT> __device__ __forceinline__ float act_(float x, float lb) {
    if (ACT == 1) return siluf_(x);
    if (ACT == 2) return __logf(lb + (1.f - lb) * sigmoidf_(x));
    if (ACT == 3) return gelu_tanh_(x);
    if (ACT == 4) return sigmoidf_(x);
    return x;
}
struct EpiAct {
    static constexpr bool PERM = true, AFTER_DRAIN = false;
    bf16_t* O; int ldc; const float* lb; int inproj;
    template <int ACT> __device__ __forceinline__ void run(const f32x4 (&acc)[2][2][4][2], const pg8::Unit& u, int wr, int wc, int fr, int fq) const {
        const int row0 = u.pm * 256 + wr * 64 + fr, col0 = u.pn * 256 + wc * 32 + 8 * fq;
        f32x4 lbv[2][2];
#pragma unroll
        for (int bj = 0; bj < 2; ++bj)
#pragma unroll
            for (int n = 0; n < 2; ++n) lbv[bj][n] = (ACT == 2) ? *(const f32x4*)(lb + (col0 - C_HF) + bj * 128 + 4 * n) : (f32x4){0.f, 0.f, 0.f, 0.f};
#pragma unroll
        for (int ai = 0; ai < 2; ++ai)
#pragma unroll
            for (int m = 0; m < 4; ++m) { bf16_t* rowp = O + (size_t)(row0 + ai * 128 + m * 16) * ldc + col0;
#pragma unroll
                for (int bj = 0; bj < 2; ++bj) { f32x4 v0 = acc[ai][bj][m][0], v1 = acc[ai][bj][m][1];
#pragma unroll
                    for (int i = 0; i < 4; ++i) { v0[i] = act_<ACT>(v0[i], lbv[bj][0][i]); v1[i] = act_<ACT>(v1[i], lbv[bj][1][i]); }
                    u32x4 w; w.x = cvt_pk_bf16(v0[0], v0[1]); w.y = cvt_pk_bf16(v0[2], v0[3]); w.z = cvt_pk_bf16(v1[0], v1[1]); w.w = cvt_pk_bf16(v1[2], v1[3]);
                    *(u32x4*)(rowp + bj * 128) = w; } }
    }
    __device__ __forceinline__ void operator()(const f32x4 (&acc)[2][2][4][2], const pg8::Unit& u, int wr, int wc, int fr, int fq) const {
        if (!inproj) { run<4>(acc, u, wr, wc, fr, fq); return; }
        const int kind = u.pn >> 1;
        if (kind == 0 || kind == 3) run<1>(acc, u, wr, wc, fr, fq);
        else if (kind == 1) run<2>(acc, u, wr, wc, fr, fq);
        else if (kind == 4 || kind == 5) run<3>(acc, u, wr, wc, fr, fq);
        else run<0>(acc, u, wr, wc, fr, fq);
    }
};
struct EpiBranch {
    static constexpr bool PERM = true, AFTER_DRAIN = false;
    const bf16_t* Gt; bf16_t* mix;
    __device__ __forceinline__ void operator()(const f32x4 (&acc)[2][2][4][2], const pg8::Unit& u, int wr, int wc, int fr, int fq) const {
        const int br = u.pn >> 2, row0 = u.pm * 256 + wr * 64 + fr, col0 = (u.pn & 3) * 256 + wc * 32 + 8 * fq;
#pragma unroll
        for (int ai = 0; ai < 2; ++ai)
#pragma unroll
            for (int m = 0; m < 4; ++m) { const size_t row = (size_t)(row0 + ai * 128 + m * 16); const bf16_t* gp = Gt + row * GCOLS + br * 1024 + col0; bf16_t* mp = mix + row * D + col0;
#pragma unroll
                for (int bj = 0; bj < 2; ++bj) { const f32x4 v0 = acc[ai][bj][m][0], v1 = acc[ai][bj][m][1];
                    const u32x4 g = *(const u32x4*)(gp + bj * 128); u32x4 o = {0u, 0u, 0u, 0u};
                    if (br > 0) o = __builtin_nontemporal_load((const u32x4*)(mp + bj * 128));
                    u32x4 w;
                    w.x = cvt_pk_bf16(bflo(o.x) + v0[0] * bflo(g.x), bfhi(o.x) + v0[1] * bfhi(g.x)); w.y = cvt_pk_bf16(bflo(o.y) + v0[2] * bflo(g.y), bfhi(o.y) + v0[3] * bfhi(g.y));
                    w.z = cvt_pk_bf16(bflo(o.z) + v1[0] * bflo(g.z), bfhi(o.z) + v1[1] * bfhi(g.z)); w.w = cvt_pk_bf16(bflo(o.w) + v1[2] * bflo(g.w), bfhi(o.w) + v1[3] * bfhi(g.w));
                    *(u32x4*)(mp + bj * 128) = w; } }
    }
};
struct EpiBranchSeg {
    static constexpr bool PERM = true, AFTER_DRAIN = false;
    const bf16_t* Gt; bf16_t* mix;
    __device__ __forceinline__ void mid(f32x4 (&acc)[2][2][4][2], const pg8::Unit& u, int seg, int wr, int wc, int fr, int fq) const {
        const int row0 = u.pm * 256 + wr * 64 + fr, col0 = u.pn * 256 + wc * 32 + 8 * fq;
#pragma unroll
        for (int ai = 0; ai < 2; ++ai)
#pragma unroll
            for (int mp = 0; mp < 2; ++mp) { u32x4 ga[2][2], gb[2][2];
#pragma unroll
                for (int mm = 0; mm < 2; ++mm) { const bf16_t* gp = Gt + (size_t)(row0 + ai * 128 + (2 * mp + mm) * 16) * GCOLS + seg * 1024 + col0;
#pragma unroll
                    for (int bj = 0; bj < 2; ++bj) { ga[mm][bj] = *(const u32x4*)(gp + bj * 128); gb[mm][bj] = *(const u32x4*)(gp + 1024 + bj * 128); } }
                asm volatile("" ::: "memory");
#pragma unroll
                for (int mm = 0; mm < 2; ++mm)
#pragma unroll
                    for (int bj = 0; bj < 2; ++bj) { const u32x4 a = ga[mm][bj], b = gb[mm][bj]; const int m = 2 * mp + mm;
                        const float na[8] = {bflo(a.x), bfhi(a.x), bflo(a.y), bfhi(a.y), bflo(a.z), bfhi(a.z), bflo(a.w), bfhi(a.w)}, nb[8] = {bflo(b.x), bfhi(b.x), bflo(b.y), bfhi(b.y), bflo(b.z), bfhi(b.z), bflo(b.w), bfhi(b.w)};
#pragma unroll
                        for (int i = 0; i < 4; ++i) { acc[ai][bj][m][0][i] *= fmaxf(na[i], 1e-6f) * __builtin_amdgcn_rcpf(fmaxf(nb[i], 1e-6f)); acc[ai][bj][m][1][i] *= fmaxf(na[4 + i], 1e-6f) * __builtin_amdgcn_rcpf(fmaxf(nb[4 + i], 1e-6f)); } } }
    }
    __device__ __forceinline__ void operator()(const f32x4 (&acc)[2][2][4][2], const pg8::Unit& u, int wr, int wc, int fr, int fq) const {
        const int row0 = u.pm * 256 + wr * 64 + fr, col0 = u.pn * 256 + wc * 32 + 8 * fq;
#pragma unroll
        for (int ai = 0; ai < 2; ++ai) { u32x4 g[4][2];
#pragma unroll
            for (int m = 0; m < 4; ++m)
#pragma unroll
                for (int bj = 0; bj < 2; ++bj) g[m][bj] = *(const u32x4*)(Gt + (size_t)(row0 + ai * 128 + m * 16) * GCOLS + 2048 + col0 + bj * 128);
            asm volatile("" ::: "memory");
#pragma unroll
            for (int m = 0; m < 4; ++m) { bf16_t* mp = mix + (size_t)(row0 + ai * 128 + m * 16) * D + col0;
#pragma unroll
                for (int bj = 0; bj < 2; ++bj) { const f32x4 v0 = acc[ai][bj][m][0], v1 = acc[ai][bj][m][1]; const u32x4 gg = g[m][bj]; u32x4 w;
                    w.x = cvt_pk_bf16(v0[0] * fmaxf(bflo(gg.x), 1e-6f), v0[1] * fmaxf(bfhi(gg.x), 1e-6f)); w.y = cvt_pk_bf16(v0[2] * fmaxf(bflo(gg.y), 1e-6f), v0[3] * fmaxf(bfhi(gg.y), 1e-6f));
                    w.z = cvt_pk_bf16(v1[0] * fmaxf(bflo(gg.z), 1e-6f), v1[1] * fmaxf(bfhi(gg.z), 1e-6f)); w.w = cvt_pk_bf16(v1[2] * fmaxf(bflo(gg.w), 1e-6f), v1[3] * fmaxf(bfhi(gg.w), 1e-6f));
                    *(u32x4*)(mp + bj * 128) = w; } } }
    }
};
struct EpiResid {
    static constexpr bool PERM = false, AFTER_DRAIN = false;
    const float* xin; float* xout;
    __device__ __forceinline__ void operator()(const f32x4 (&acc)[2][2][4][2], const pg8::Unit& u, int wr, int wc, int fr, int fq) const {
        const int row0 = u.pm * 256 + wr * 64 + fr, col0 = u.pn * 256 + wc * 32 + 4 * fq;
#pragma unroll
        for (int ai = 0; ai < 2; ++ai)
#pragma unroll
            for (int mp = 0; mp < 2; ++mp) { f32x4 t[2][2][2];
#pragma unroll
                for (int mm = 0; mm < 2; ++mm) { const size_t ro = (size_t)(row0 + ai * 128 + (2 * mp + mm) * 16) * D + col0;
#pragma unroll
                    for (int bj = 0; bj < 2; ++bj)
#pragma unroll
                        for (int n = 0; n < 2; ++n) t[mm][bj][n] = *(const f32x4*)(xin + ro + bj * 128 + n * 16); }
                asm volatile("" ::: "memory");
#pragma unroll
                for (int mm = 0; mm < 2; ++mm) { const size_t ro = (size_t)(row0 + ai * 128 + (2 * mp + mm) * 16) * D + col0;
#pragma unroll
                    for (int bj = 0; bj < 2; ++bj)
#pragma unroll
                        for (int n = 0; n < 2; ++n) *(f32x4*)(xout + ro + bj * 128 + n * 16) = t[mm][bj][n] + acc[ai][bj][2 * mp + mm][n]; }
                asm volatile("" ::: "memory"); }
    }
};
struct EpiGU {
    static constexpr bool PERM = true, AFTER_DRAIN = false;
    bf16_t* H;
    __device__ __forceinline__ void operator()(const f32x4 (&acc)[2][2][4][2], const pg8::Unit& u, int wr, int wc, int fr, int fq) const {
        const int row0 = u.pm * 256 + wr * 64 + fr, col0 = u.pn * 128 + wc * 32 + 8 * fq;
#pragma unroll
        for (int ai = 0; ai < 2; ++ai)
#pragma unroll
            for (int m = 0; m < 4; ++m) { bf16_t* rowp = H + (size_t)(row0 + ai * 128 + m * 16) * DFF + col0;
                const f32x4 g0 = acc[ai][0][m][0], g1 = acc[ai][0][m][1], u0 = acc[ai][1][m][0], u1 = acc[ai][1][m][1]; u32x4 w;
                w.x = cvt_pk_bf16(siluf_(g0[0]) * u0[0], siluf_(g0[1]) * u0[1]); w.y = cvt_pk_bf16(siluf_(g0[2]) * u0[2], siluf_(g0[3]) * u0[3]);
                w.z = cvt_pk_bf16(siluf_(g1[0]) * u1[0], siluf_(g1[1]) * u1[1]); w.w = cvt_pk_bf16(siluf_(g1[2]) * u1[2], siluf_(g1[3]) * u1[3]);
                *(u32x4*)rowp = w; }
    }
};
struct EpiMoeDown {
    static constexpr bool PERM = false, AFTER_DRAIN = false;
    float* out; const int* stok; const float* sw;
    __device__ __forceinline__ void operator()(const f32x4 (&acc)[2][2][4][2], const pg8::Unit& u, int wr, int wc, int fr, int fq) const {
        const int row0 = u.pm * 256 + wr * 64 + fr, col0 = u.pn * 256 + wc * 32 + 4 * fq;
        int tk[2][4]; float wt[2][4];
#pragma unroll
        for (int ai = 0; ai < 2; ++ai)
#pragma unroll
            for (int m = 0; m < 4; ++m) { const int rl = row0 + ai * 128 + m * 16; tk[ai][m] = stok[rl]; wt[ai][m] = sw[rl]; }
#pragma unroll
        for (int ai = 0; ai < 2; ++ai)
#pragma unroll
            for (int mp = 0; mp < 2; ++mp) { f32x4 t[2][2][2];
#pragma unroll
                for (int mm = 0; mm < 2; ++mm) { const int tok = tk[ai][2 * mp + mm]; const float* rp = out + (size_t)(tok < 0 ? 0 : tok) * D + col0;
#pragma unroll
                    for (int bj = 0; bj < 2; ++bj)
#pragma unroll
                        for (int n = 0; n < 2; ++n) t[mm][bj][n] = *(const f32x4*)(rp + bj * 128 + n * 16); }
                asm volatile("" ::: "memory");
#pragma unroll
                for (int mm = 0; mm < 2; ++mm) { const int tok = tk[ai][2 * mp + mm]; const float w = wt[ai][2 * mp + mm];
                    if (tok >= 0) { float* rp = out + (size_t)tok * D + col0;
#pragma unroll
                        for (int bj = 0; bj < 2; ++bj)
#pragma unroll
                            for (int n = 0; n < 2; ++n) *(f32x4*)(rp + bj * 128 + n * 16) = t[mm][bj][n] + acc[ai][bj][2 * mp + mm][n] * w; } }
                asm volatile("" ::: "memory"); }
    }
};

__device__ __forceinline__ void tc_job(const float* __restrict__ src, int K, int N, bf16_t* dst, int mode, int perm, LAS float* tile, int wg, int G, int tid) {
    LAUNDER(tid);
    const int tn = N / 64, nt = (K / 64) * tn;
    float4 v0 = make_float4(0.f, 0.f, 0.f, 0.f), v1 = v0;
    if (wg < nt) { const int k0 = (wg / tn) * 64, n0 = (wg % tn) * 64; const float* sp = src + (size_t)(k0 + (tid >> 4)) * N + n0 + (tid & 15) * 4; v0 = *(const float4*)sp; v1 = *(const float4*)(sp + (size_t)32 * N); }
    for (int t = wg; t < nt; t += G) {
        const int k0 = (t / tn) * 64, n0 = (t % tn) * 64;
        { LAS float* tp = tile + (tid >> 4) * 65 + (tid & 15) * 4; tp[0] = v0.x; tp[1] = v0.y; tp[2] = v0.z; tp[3] = v0.w; tp += 32 * 65; tp[0] = v1.x; tp[1] = v1.y; tp[2] = v1.z; tp[3] = v1.w; }
        if (t + G < nt) { const int k1 = ((t + G) / tn) * 64, n1 = ((t + G) % tn) * 64; const float* sp = src + (size_t)(k1 + (tid >> 4)) * N + n1 + (tid & 15) * 4; v0 = *(const float4*)sp; v1 = *(const float4*)(sp + (size_t)32 * N); }
        __syncthreads();
        { const int n = tid >> 3, kg = (tid & 7) * 8; unsigned w[4];
#pragma unroll
          for (int j = 0; j < 4; ++j) w[j] = cvt_pk_bf16(tile[(kg + 2 * j) * 65 + n], tile[(kg + 2 * j + 1) * 65 + n]);
          const int nn = n0 + n; int drow = mode == 0 ? nn : ((nn >> 7) * 256 + (nn & 127) + (mode == 2 ? 128 : 0));
          if (perm) { const int c5 = drow & 31; drow = (drow & ~31) + 16 * ((c5 >> 2) & 1) + 4 * (c5 >> 3) + (c5 & 3); }
          *(uint4*)(dst + (size_t)drow * K + k0 + kg) = make_uint4(w[0], w[1], w[2], w[3]); }
        __syncthreads();
    }
}

template <bool ROUTER>
__device__ __forceinline__ void phase_rmsnorm(const float* __restrict__ x, const float* __restrict__ gain, bf16_t* xn, const float* __restrict__ rw, const float* __restrict__ rb,
                              int* toke, float2* tokw, int wg, int G, int wid, int lane) {
    LAUNDER(lane);
    constexpr int RB = ROUTER ? 2 : 4;
    for (int row0 = (wg * NWAVES + wid) * RB; row0 < MTOK; row0 += G * NWAVES * RB) {
        float4 v[RB][4];
#pragma unroll
        for (int rr = 0; rr < RB; ++rr)
#pragma unroll
            for (int j = 0; j < 4; ++j) v[rr][j] = *(const float4*)(x + (size_t)(row0 + rr) * D + j * 256 + lane * 4);
#pragma unroll
        for (int rr = 0; rr < RB; ++rr) { const int row = row0 + rr; float ss = 0.f;
#pragma unroll
            for (int j = 0; j < 4; ++j) ss += v[rr][j].x * v[rr][j].x + v[rr][j].y * v[rr][j].y + v[rr][j].z * v[rr][j].z + v[rr][j].w * v[rr][j].w;
            ss = wave_sum(ss);
            const float rstd = rsqrtf(ss * (1.f / D) + EPS);
            float lg[NEXP];
#pragma unroll
            for (int e = 0; e < NEXP; ++e) lg[e] = 0.f;
#pragma unroll
            for (int j = 0; j < 4; ++j) { const float4 g = *(const float4*)(gain + j * 256 + lane * 4);
                const float y0 = v[rr][j].x * rstd * g.x, y1 = v[rr][j].y * rstd * g.y, y2 = v[rr][j].z * rstd * g.z, y3 = v[rr][j].w * rstd * g.w;
                *(uint2*)(xn + (size_t)row * D + j * 256 + lane * 4) = make_uint2(cvt_pk_bf16(y0, y1), cvt_pk_bf16(y2, y3));
                if (ROUTER) { const float ys[4] = {y0, y1, y2, y3};
#pragma unroll
                    for (int i = 0; i < 4; ++i) { const float* wr_ = rw + (size_t)(j * 256 + lane * 4 + i) * NEXP; const float4 wa = *(const float4*)wr_, wb = *(const float4*)(wr_ + 4);
                        lg[0] += ys[i] * wa.x; lg[1] += ys[i] * wa.y; lg[2] += ys[i] * wa.z; lg[3] += ys[i] * wa.w; lg[4] += ys[i] * wb.x; lg[5] += ys[i] * wb.y; lg[6] += ys[i] * wb.z; lg[7] += ys[i] * wb.w; } } }
            if (ROUTER) {
#pragma unroll
                for (int e = 0; e < NEXP; ++e) lg[e] = wave_sum(lg[e]) + rb[e];
                int i0 = 0; float l0 = lg[0];
#pragma unroll
                for (int e = 1; e < NEXP; ++e) if (lg[e] > l0) { l0 = lg[e]; i0 = e; }
                int i1 = -1; float l1 = -3.4e38f;
#pragma unroll
                for (int e = 0; e < NEXP; ++e) if (e != i0 && lg[e] > l1) { l1 = lg[e]; i1 = e; }
                const float w0 = __builtin_amdgcn_rcpf(1.f + __expf(l1 - l0));
                if (lane == 0) { toke[row] = i0 | (i1 << 8); tokw[row] = make_float2(w0, 1.f - w0); }
            }
        }
    }
}

__device__ void phase_combine(const bf16_t* GH, bf16_t* mix, int wg, int G, int tid) {
    LAUNDER(tid);
    for (size_t v = (size_t)wg * NTHREADS + tid; v < (size_t)MTOK * (D / 8); v += (size_t)G * NTHREADS) {
        const size_t r = v / (D / 8); const int c = (int)(v % (D / 8)) * 8; const bf16_t* gp = GH + r * GCOLS + c;
        const uint4 a = *(const uint4*)gp, b = *(const uint4*)(gp + 1024), cc = *(const uint4*)(gp + 2048); uint4 o;
        o.x = cvt_pk_bf16(bflo(a.x) + bflo(b.x) + bflo(cc.x), bfhi(a.x) + bfhi(b.x) + bfhi(cc.x));
        o.y = cvt_pk_bf16(bflo(a.y) + bflo(b.y) + bflo(cc.y), bfhi(a.y) + bfhi(b.y) + bfhi(cc.y));
        o.z = cvt_pk_bf16(bflo(a.z) + bflo(b.z) + bflo(cc.z), bfhi(a.z) + bfhi(b.z) + bfhi(cc.z));
        o.w = cvt_pk_bf16(bflo(a.w) + bflo(b.w) + bflo(cc.w), bfhi(a.w) + bfhi(b.w) + bfhi(cc.w));
        *(uint4*)(mix + r * D + c) = o;
    }
}

__device__ __forceinline__ void moe_assign(const int* toke, const float2* tokw, int* meta, int* stok, float* sw, int* blke, LAS unsigned char* lds, int tid) {
    LAS int* cnt = (LAS int*)lds;
    LAS int* tot = cnt + 512 * 16;
    const int t0 = tid * (MTOK / NTHREADS);
    { int z = 0; asm volatile("" : "+v"(z));
      for (int j = 0; j < 16; ++j) cnt[tid * 16 + j] = z; }
    for (int i = 0; i < MTOK / NTHREADS; ++i) { const int ee = toke[t0 + i]; cnt[tid * 16 + (ee & 255)] += 1; cnt[tid * 16 + 8 + ((ee >> 8) & 255)] += 1; }
    __syncthreads();
    if (tid < 16) { int run = 0; for (int i = 0; i < NTHREADS; ++i) { const int v = cnt[i * 16 + tid]; cnt[i * 16 + tid] = run; run += v; } tot[tid] = run; }
    __syncthreads();
    if (tid == 0) { int run = 0; for (int j = 0; j < 16; ++j) { const int n = tot[j], pad = (n + 255) & ~255; tot[16 + j] = run; if (j == 8) { meta[0] = run; meta[3] = run; } run += pad; } meta[1] = run - tot[16 + 8]; meta[2] = 0; meta[4] = run; }
    __syncthreads();
    for (int bk = tid; bk < 2 * MOE_MAXBLK; bk += NTHREADS) { int ex = 0;
        for (int j = 0; j < 16; ++j) { const int base = tot[16 + j], pad = (tot[j] + 255) & ~255; if (bk * 256 >= base && bk * 256 < base + pad) ex = j & 7; }
        blke[bk] = ex; }
    for (int j = 0; j < 16; ++j) cnt[tid * 16 + j] += tot[16 + j];
    for (int i = 0; i < MTOK / NTHREADS; ++i) { const int tk = t0 + i; const int ee = toke[tk]; const int j0 = ee & 255, j1 = 8 + ((ee >> 8) & 255); const float2 w = tokw[tk];
        const int p0 = cnt[tid * 16 + j0]; cnt[tid * 16 + j0] = p0 + 1; const int p1 = cnt[tid * 16 + j1]; cnt[tid * 16 + j1] = p1 + 1;
        stok[p0] = tk; sw[p0] = w.x; stok[p1] = tk; sw[p1] = w.y; }
    for (int j = 0; j < 16; ++j) { const int n = tot[j], pad = (n + 255) & ~255, base = tot[16 + j]; for (int i = n + tid; i < pad; i += NTHREADS) { stok[base + i] = -1; sw[base + i] = 0.f; } }
}
__device__ __forceinline__ void moe_gather(const bf16_t* xn, const int* stok, int rows, bf16_t* xs, int wg, int G, int wid, int lane) {
    LAUNDER(lane);
    for (int r0 = (wg * NWAVES + wid) * 4; r0 < rows; r0 += G * NWAVES * 4) {
        int tok[4]; uint4 a[4], b[4];
#pragma unroll
        for (int i = 0; i < 4; ++i) tok[i] = __hip_atomic_load(stok + r0 + i, __ATOMIC_RELAXED, __HIP_MEMORY_SCOPE_AGENT);
#pragma unroll
        for (int i = 0; i < 4; ++i) { a[i] = make_uint4(0, 0, 0, 0); b[i] = a[i]; if (tok[i] >= 0) { const uint4* sp = (const uint4*)(xn + (size_t)tok[i] * D) + lane * 2; a[i] = sp[0]; b[i] = sp[1]; } }
#pragma unroll
        for (int i = 0; i < 4; ++i) { uint4* dp = (uint4*)(xs + (size_t)(r0 + i) * D) + lane * 2; dp[0] = a[i]; dp[1] = b[i]; } }
}

typedef pg8::bf16x8 bf16x8;
typedef unsigned u32x2 __attribute__((ext_vector_type(2)));
#define MFMA16(A, B, C) __builtin_amdgcn_mfma_f32_16x16x32_bf16((A), (B), (C), 0, 0, 0)
__device__ __forceinline__ bf16x8 mk8(unsigned a, unsigned b, unsigned c, unsigned d) { u32x4 v = {a, b, c, d}; return __builtin_bit_cast(bf16x8, v); }

constexpr int H_QD = 0, H_KD = 8704, H_KB = 17408, H_QG = 21760, H_KET = 30464, H_VT = 40704, H_PM = 50944, H_TP = 53504, H_GE = 55552;
constexpr size_t HG_DUMP_BYTES = (size_t)MTOK * 512 * 2, HG_U_BYTES = (size_t)256 * 128 * 128 * 4;
__device__ __forceinline__ void phase_hgrn_a(const bf16_t* P, bf16_t* qsc  , uint2* dump, float* U, float* Dsc, LAS unsigned char* lds, int wg, int G, int tid, int wid, int lane) {
    LAUNDER(tid); LAUNDER(lane);
    const int d = tid & 127, part = tid >> 7, g = lane >> 4, c16 = lane & 15;
    LAS float* TP = (LAS float*)(lds + H_TP); LAS float* GE = (LAS float*)(lds + H_GE);
    for (int item = wg; item < 256; item += G) {
        const int b = item >> 6, h = (item >> 4) & 3, sc = item & 15; const size_t tok0 = (size_t)b * SEQ + (size_t)sc * 512;
        f32x4 S[8];
#pragma unroll
        for (int i = 0; i < 8; ++i) S[i] = (f32x4){0.f, 0.f, 0.f, 0.f};
        float gsc = 0.f;
        unsigned lfv[8], qv[8], vv[8];
        { const bf16_t* base = P + (tok0 + 8 * part) * PCOLS + h * 128 + d;
#pragma unroll
          for (int j = 0; j < 8; ++j) { lfv[j] = base[(size_t)j * PCOLS + C_HF]; qv[j] = base[(size_t)j * PCOLS + C_HQ]; vv[j] = base[(size_t)j * PCOLS + C_HI]; } }
        for (int c = 0; c < 16; ++c) {
            float gl[8], lf[8], qf[8]; unsigned vb[8]; float run = 0.f;
#pragma unroll
            for (int j = 0; j < 8; ++j) { lf[j] = bf2f(lfv[j]); qf[j] = bf2f(qv[j]); vb[j] = vv[j]; run += lf[j]; gl[j] = run; }
            if (c < 15) { const bf16_t* base = P + (tok0 + (c + 1) * 32 + 8 * part) * PCOLS + h * 128 + d;
#pragma unroll
                for (int j = 0; j < 8; ++j) { lfv[j] = base[(size_t)j * PCOLS + C_HF]; qv[j] = base[(size_t)j * PCOLS + C_HQ]; vv[j] = base[(size_t)j * PCOLS + C_HI]; } }
            TP[part * 128 + d] = run;
            __syncthreads();
            const float t0 = TP[d], t1 = TP[128 + d], t2 = TP[256 + d], t3 = TP[384 + d];
            const float T0 = t0 + t1, gend = T0 + t2 + t3;
            const float pre = (part == 1) ? t0 : (part == 3) ? t2 : 0.f, gb = (part >> 1) ? T0 : 0.f;
            unsigned kep[4];
#pragma unroll
            for (int j = 0; j < 8; j += 2) {
                float ke2[2];
#pragma unroll
                for (int jj = 0; jj < 2; ++jj) { const int t = 8 * part + j + jj; const float Gl = pre + gl[j + jj], Gt = gb + Gl; const float k = 1.f - __expf(lf[j + jj]), q = qf[j + jj];
                    *(LAS bf16_t*)(lds + H_QD + t * 272 + d * 2) = f2bf(q * __expf(Gl));
                    *(LAS bf16_t*)(lds + H_KD + t * 272 + d * 2) = f2bf(k * __expf(fminf(-Gl, 80.f)));
                    if (part < 2) *(LAS bf16_t*)(lds + H_KB + t * 272 + d * 2) = f2bf(k * __expf(T0 - Gl));
                    *(LAS bf16_t*)(lds + H_QG + t * 272 + d * 2) = f2bf(q * __expf(Gt));
                    qsc[(tok0 + c * 32 + t) * 512 + h * 128 + d] = f2bf(q * __expf(gsc + Gt));
                    ke2[jj] = k * __expf(gend - Gt); }
                kep[j >> 1] = cvt_pk_bf16(ke2[0], ke2[1]); }
            *(LAS u32x4*)(lds + H_KET + d * 80 + part * 16) = (u32x4){kep[0], kep[1], kep[2], kep[3]};
            *(LAS u32x4*)(lds + H_VT + d * 80 + part * 16) = (u32x4){vb[0] | (vb[1] << 16), vb[2] | (vb[3] << 16), vb[4] | (vb[5] << 16), vb[6] | (vb[7] << 16)};
            if (part == 0) GE[d] = __expf(gend);
            gsc += gend;
            __syncthreads();
            if (wid < 3) { const int I = (wid == 0) ? 0 : 1, J = (wid == 2) ? 0 : I; f32x4 acc = {0.f, 0.f, 0.f, 0.f};
#pragma unroll
                for (int kk = 0; kk < 4; ++kk) { const bf16x8 A = *(const LAS bf16x8*)(lds + H_QD + (16 * I + c16) * 272 + kk * 64 + g * 16);
                    const bf16x8 B = (wid == 2) ? *(const LAS bf16x8*)(lds + H_KB + c16 * 272 + kk * 64 + g * 16) : *(const LAS bf16x8*)(lds + H_KD + (16 * J + c16) * 272 + kk * 64 + g * 16);
                    acc = MFMA16(A, B, acc); }
#pragma unroll
                for (int r = 0; r < 4; ++r) { const int t = 4 * g + r; const float v = (I == J && c16 > t) ? 0.f : acc[r]; *(LAS bf16_t*)(lds + H_PM + (16 * I + t) * 80 + (16 * J + c16) * 2) = f2bf(v); }
            } else if (wid == 3) {
#pragma unroll
                for (int r = 0; r < 4; ++r) *(LAS bf16_t*)(lds + H_PM + (4 * g + r) * 80 + (16 + c16) * 2) = (bf16_t)0;
            }
            __syncthreads();
            { const bf16x8 Bv = *(const LAS bf16x8*)(lds + H_VT + (16 * wid + c16) * 80 + g * 16);
              unsigned sp[8][2];
#pragma unroll
              for (int i = 0; i < 8; ++i) { sp[i][0] = cvt_pk_bf16(S[i][0], S[i][1]); sp[i][1] = cvt_pk_bf16(S[i][2], S[i][3]); }
              const size_t chunk_g = (tok0 >> 5) + c;
#pragma unroll
              for (int rt = 0; rt < 2; ++rt) { f32x4 o = {0.f, 0.f, 0.f, 0.f};
                  o = MFMA16(*(const LAS bf16x8*)(lds + H_PM + (16 * rt + c16) * 80 + g * 16), Bv, o);
#pragma unroll
                  for (int kk = 0; kk < 4; ++kk) { const LAS unsigned char* qp = lds + H_QG + (16 * rt + c16) * 272 + (32 * kk + 4 * g) * 2;
                      const u32x2 lo = *(const LAS u32x2*)qp, hi = *(const LAS u32x2*)(qp + 32);
                      o = MFMA16(mk8(lo.x, lo.y, hi.x, hi.y), mk8(sp[2 * kk][0], sp[2 * kk][1], sp[2 * kk + 1][0], sp[2 * kk + 1][1]), o); }
                  dump[(((chunk_g * 4 + h) * 2 + rt) * 8 + wid) * 64 + lane] = make_uint2(cvt_pk_bf16(o[0], o[1]), cvt_pk_bf16(o[2], o[3])); }
#pragma unroll
              for (int i = 0; i < 8; ++i) { const f32x4 dec = *(const LAS f32x4*)(lds + H_GE + (16 * i + 4 * g) * 4); S[i] = S[i] * dec;
                  S[i] = MFMA16(*(const LAS bf16x8*)(lds + H_KET + (16 * i + c16) * 80 + g * 16), Bv, S[i]); } }
            __syncthreads();
        }
#pragma unroll
        for (int i = 0; i < 8; ++i)
#pragma unroll
            for (int r = 0; r < 4; ++r) U[((size_t)item * 128 + 16 * i + 4 * g + r) * 128 + 16 * wid + c16] = S[i][r];
        if (part == 0) Dsc[item * 128 + d] = __expf(gsc);
    }
}
constexpr int HC_SIN = 0;
__device__ __forceinline__ void phase_hgrn_c(const bf16_t* P, bf16_t* qoa  , const uint2* dump, const float* U, const float* Dsc, const float* gain, LAS unsigned char* lds, int wg, int G, int tid, int wid, int lane) {
    LAUNDER(tid); LAUNDER(lane);
    const int g = lane >> 4, c16 = lane & 15;
    for (int item = wg; item < 256; item += G) {
        const int b = item >> 6, h = (item >> 4) & 3, sc = item & 15; const size_t tok0 = (size_t)b * SEQ + (size_t)sc * 512;
#pragma unroll 1
        for (int kq = 0; kq < 4; ++kq) { float s[8];
#pragma unroll
          for (int k = 0; k < 8; ++k) s[k] = 0.f;
#pragma unroll 1
          for (int j = 0; j < sc; ++j) { const size_t it = (size_t)(item - sc + j);
#pragma unroll
              for (int k = 0; k < 8; ++k) { const int e = tid + 512 * (kq * 8 + k); s[k] = Dsc[it * 128 + (e >> 7)] * s[k] + U[it * 16384 + e]; } }
#pragma unroll
          for (int k = 0; k < 8; ++k) { const int e = tid + 512 * (kq * 8 + k); *(LAS bf16_t*)(lds + HC_SIN + (e & 127) * 272 + (e >> 7) * 2) = f2bf(s[k]); } }
        __syncthreads();
#pragma unroll 1
        for (int rtile = 0; rtile < 4; ++rtile) {
            const size_t row0 = tok0 + 64 * wid + 16 * rtile; const size_t chunk_g = (tok0 >> 5) + 2 * wid + (rtile >> 1); const int rt = rtile & 1;
            bf16x8 A[4];
#pragma unroll
            for (int kk = 0; kk < 4; ++kk) A[kk] = *(const bf16x8*)(qoa + (row0 + c16) * 512 + h * 128 + 32 * kk + 8 * g);
            f32x4 acc[8]; float ss[4] = {0.f, 0.f, 0.f, 0.f};
#pragma unroll
            for (int vt = 0; vt < 8; ++vt) { acc[vt] = (f32x4){0.f, 0.f, 0.f, 0.f};
#pragma unroll
                for (int kk = 0; kk < 4; ++kk) acc[vt] = MFMA16(A[kk], *(const LAS bf16x8*)(lds + HC_SIN + (16 * vt + c16) * 272 + (32 * kk + 8 * g) * 2), acc[vt]);
                const uint2 ol = dump[(((chunk_g * 4 + h) * 2 + rt) * 8 + vt) * 64 + lane];
                acc[vt][0] += bflo(ol.x); acc[vt][1] += bfhi(ol.x); acc[vt][2] += bflo(ol.y); acc[vt][3] += bfhi(ol.y);
#pragma unroll
                for (int r = 0; r < 4; ++r) ss[r] += acc[vt][r] * acc[vt][r]; }
            float rstd[4];
#pragma unroll
            for (int r = 0; r < 4; ++r) { float s = ss[r]; s += xor_f<1>(s); s += xor_f<2>(s); s += xor_f<4>(s); s += xor_f<8>(s); rstd[r] = rsqrtf(s * (1.f / 128.f) + EPS); }
            unsigned hgv[8][4];
#pragma unroll
            for (int vt = 0; vt < 8; ++vt)
#pragma unroll
                for (int r = 0; r < 4; ++r) hgv[vt][r] = P[(row0 + 4 * g + r) * PCOLS + C_HG + h * 128 + 16 * vt + c16];
#pragma unroll
            for (int vt = 0; vt < 8; ++vt) { const float gn = gain[16 * vt + c16];
#pragma unroll
                for (int r = 0; r < 4; ++r) { const size_t row = row0 + 4 * g + r;
                    qoa[row * 512 + h * 128 + 16 * vt + c16] = f2bf(acc[vt][r] * rstd[r] * gn * bf2f(hgv[vt][r])); } }
        }
        __syncthreads();
    }
}

constexpr int GM_VT = 0, GM_W = 34816, GM_RS = 69632;
__device__ __forceinline__ void phase_gmlp(const bf16_t* P, const float* __restrict__ ws_l, const float* __restrict__ bs_l, const float* __restrict__ gv_l, bf16_t* ob, LAS unsigned char* lds, int wg, int G, int tid, int wid, int lane) {
    LAUNDER(tid); LAUNDER(lane);
    const int g = lane >> 4, c16 = lane & 15; LAS float* RS = (LAS float*)(lds + GM_RS);
    for (int item = wg; item < MTOK / 128; item += G) {
        const size_t tok0 = (size_t)item * 128;
        { const int s = tid >> 2, qd = tid & 3; const bf16_t* rp = P + (tok0 + s) * PCOLS + C_GV + qd * 128; float ss = 0.f;
#pragma unroll
          for (int j = 0; j < 16; ++j) { const uint4 x = *(const uint4*)(rp + j * 8); ss += bflo(x.x) * bflo(x.x) + bfhi(x.x) * bfhi(x.x) + bflo(x.y) * bflo(x.y) + bfhi(x.y) * bfhi(x.y) + bflo(x.z) * bflo(x.z) + bfhi(x.z) * bfhi(x.z) + bflo(x.w) * bflo(x.w) + bfhi(x.w) * bfhi(x.w); }
          ss += xor_f<1>(ss); ss += xor_f<2>(ss); if (qd == 0) RS[s] = rsqrtf(ss * (1.f / 512.f) + EPS); }
        for (int grp = 0; grp < 4; ++grp) {
            __syncthreads();
#pragma unroll
            for (int ps = 0; ps < 4; ++ps) { const int idx = tid + ps * 512, s = idx >> 4, c8 = (idx & 15) * 8; const uint4 x = *(const uint4*)(P + (tok0 + s) * PCOLS + C_GV + grp * 128 + c8);
                const float rs = RS[s]; const float4 ga = *(const float4*)(gv_l + grp * 128 + c8), gb = *(const float4*)(gv_l + grp * 128 + c8 + 4);
                const float e[8] = {bflo(x.x) * rs * ga.x, bfhi(x.x) * rs * ga.y, bflo(x.y) * rs * ga.z, bfhi(x.y) * rs * ga.w, bflo(x.z) * rs * gb.x, bfhi(x.z) * rs * gb.y, bflo(x.w) * rs * gb.z, bfhi(x.w) * rs * gb.w};
#pragma unroll
                for (int i = 0; i < 8; ++i) *(LAS bf16_t*)(lds + GM_VT + (c8 + i) * 272 + s * 2) = f2bf(e[i]);
                const int t = idx >> 4, s8 = (idx & 15) * 8; const float4 wa = *(const float4*)(ws_l + (size_t)grp * 16384 + t * 128 + s8), wb = *(const float4*)(ws_l + (size_t)grp * 16384 + t * 128 + s8 + 4);
                *(LAS u32x4*)(lds + GM_W + t * 272 + s8 * 2) = (u32x4){cvt_pk_bf16(s8 + 0 <= t ? wa.x : 0.f, s8 + 1 <= t ? wa.y : 0.f), cvt_pk_bf16(s8 + 2 <= t ? wa.z : 0.f, s8 + 3 <= t ? wa.w : 0.f),
                                                                    cvt_pk_bf16(s8 + 4 <= t ? wb.x : 0.f, s8 + 5 <= t ? wb.y : 0.f), cvt_pk_bf16(s8 + 6 <= t ? wb.z : 0.f, s8 + 7 <= t ? wb.w : 0.f)}; }
            __syncthreads();
            unsigned guv[4][8];
#pragma unroll
            for (int r = 0; r < 4; ++r)
#pragma unroll
                for (int ct = 0; ct < 8; ++ct) guv[r][ct] = P[(tok0 + 16 * wid + 4 * g + r) * PCOLS + C_GU + grp * 128 + 16 * ct + c16];
            f32x4 acc[8];
#pragma unroll
            for (int ct = 0; ct < 8; ++ct) acc[ct] = (f32x4){0.f, 0.f, 0.f, 0.f};
            for (int kk = 0; kk <= (wid >> 1); ++kk) { const bf16x8 A = *(const LAS bf16x8*)(lds + GM_W + (16 * wid + c16) * 272 + kk * 64 + g * 16);
#pragma unroll
                for (int ct = 0; ct < 8; ++ct) acc[ct] = MFMA16(A, *(const LAS bf16x8*)(lds + GM_VT + (16 * ct + c16) * 272 + kk * 64 + g * 16), acc[ct]); }
#pragma unroll
            for (int r = 0; r < 4; ++r) { const int t = 16 * wid + 4 * g + r; const float bias = bs_l[grp * 128 + t]; const size_t tok = tok0 + t;
#pragma unroll
                for (int ct = 0; ct < 8; ++ct) { const int ch = grp * 128 + 16 * ct + c16; ob[tok * 512 + ch] = f2bf(bf2f(guv[r][ct]) * (acc[ct][r] + bias)); } }
        }
        __syncthreads();
    }
}

constexpr int AT_KL = 0, AT_VT = 9216, AT_MIN = 9216 + 64 * 136;
template <bool DIAG>
__device__ __forceinline__ void attn_block(LAS unsigned char* lds, const bf16x8 (&Bq)[2], f32x4 (&O)[4], float& carry, int sb0, int t, int g, int c16, unsigned tri_lo, unsigned tri_hi) {
    const unsigned ONES = 0x3F803F80u;
    f32x4 z[4]; unsigned hi[4][2];
#pragma unroll
    for (int st = 0; st < 4; ++st) { z[st] = (f32x4){0.f, 0.f, 0.f, 0.f};
#pragma unroll
        for (int kk = 0; kk < 2; ++kk) z[st] = MFMA16(*(const LAS bf16x8*)(lds + AT_KL + (16 * st + c16) * 144 + kk * 64 + g * 16), Bq[kk], z[st]);
        float spv[4];
#pragma unroll
        for (int r = 0; r < 4; ++r) { const float sp = __builtin_amdgcn_logf(1.f + __builtin_amdgcn_exp2f(z[st][r])); spv[r] = (!DIAG || (sb0 + 16 * st + 4 * g + r < t)) ? sp : 0.f; }
        hi[st][0] = cvt_pk_bf16(spv[0], spv[1]); hi[st][1] = cvt_pk_bf16(spv[2], spv[3]); }
    f32x4 sf[4];
#pragma unroll
    for (int so = 0; so < 4; ++so) { sf[so] = (f32x4){0.f, 0.f, 0.f, 0.f};
#pragma unroll
        for (int kk = 0; kk < 2; ++kk) { if (2 * kk + 1 < so) continue;
            const unsigned a0 = (2 * kk > so) ? ONES : (2 * kk == so) ? tri_lo : 0u, a1 = (2 * kk > so) ? ONES : (2 * kk == so) ? tri_hi : 0u;
            const unsigned a2 = (2 * kk + 1 > so) ? ONES : tri_lo, a3 = (2 * kk + 1 > so) ? ONES : tri_hi;
            sf[so] = MFMA16(mk8(a0, a1, a2, a3), mk8(hi[2 * kk][0], hi[2 * kk][1], hi[2 * kk + 1][0], hi[2 * kk + 1][1]), sf[so]); } }
    unsigned pa[4][2];
#pragma unroll
    for (int st = 0; st < 4; ++st) { float av[4];
#pragma unroll
        for (int r = 0; r < 4; ++r) { const float a = __builtin_amdgcn_exp2f(z[st][r] - carry - sf[st][r]); av[r] = (!DIAG || (sb0 + 16 * st + 4 * g + r < t)) ? a : 0.f; }
        pa[st][0] = cvt_pk_bf16(av[0], av[1]); pa[st][1] = cvt_pk_bf16(av[2], av[3]); }
#pragma unroll
    for (int kk = 0; kk < 2; ++kk) { const bf16x8 Aop = mk8(pa[2 * kk][0], pa[2 * kk][1], pa[2 * kk + 1][0], pa[2 * kk + 1][1]);
#pragma unroll
        for (int dt = 0; dt < 4; ++dt) { const LAS unsigned char* vp = lds + AT_VT + (16 * dt + c16) * 136 + (32 * kk + 4 * g) * 2; const u32x2 v0 = *(const LAS u32x2*)vp, v1 = *(const LAS u32x2*)(vp + 32);
            O[dt] = MFMA16(Aop, mk8(v0.x, v0.y, v1.x, v1.y), O[dt]); } }
    carry += bperm_f(sf[0][0], c16);
}
__device__ __forceinline__ void phase_attn(const bf16_t* P, const float* __restrict__ gq, const float* __restrict__ gk, bf16_t* oc, LAS unsigned char* lds, int wg, int G, int tid, int wid, int lane) {
    LAUNDER(tid); LAUNDER(lane);
    const int g = lane >> 4, c16 = lane & 15; LAS float* MINW = (LAS float*)(lds + AT_MIN);
    const unsigned tri_lo = ((4 * g + 0 >= c16) ? 0x3F80u : 0u) | ((4 * g + 1 >= c16) ? 0x3F800000u : 0u), tri_hi = ((4 * g + 2 >= c16) ? 0x3F80u : 0u) | ((4 * g + 3 >= c16) ? 0x3F800000u : 0u);
    for (int item = wg; item < NB * 8 * (SEQ / 128); item += G) {
        const int qt = item & 63, h = (item >> 6) & 7, b = item >> 9; const int t0 = qt * 128, tq0 = t0 + 16 * wid, t = tq0 + c16; const size_t tokb = (size_t)b * SEQ;
        bf16x8 Bq[2];
        { const bf16_t* qp = P + (tokb + t) * PCOLS + C_SQ + h * 64; const uint4 x0 = *(const uint4*)(qp + 8 * g), x1 = *(const uint4*)(qp + 32 + 8 * g);
          float e[16] = {bflo(x0.x), bfhi(x0.x), bflo(x0.y), bfhi(x0.y), bflo(x0.z), bfhi(x0.z), bflo(x0.w), bfhi(x0.w), bflo(x1.x), bfhi(x1.x), bflo(x1.y), bfhi(x1.y), bflo(x1.z), bfhi(x1.z), bflo(x1.w), bfhi(x1.w)};
          float ss = 0.f;
#pragma unroll
          for (int i = 0; i < 16; ++i) ss += e[i] * e[i];
          ss += xor_f<16>(ss); ss += bperm_f(ss, lane ^ 32);
          const float rq = rsqrtf(ss * (1.f / 64.f) + EPS) * (0.125f * 1.4426950408889634f);
#pragma unroll
          for (int i = 0; i < 16; ++i) { const int dd = (i < 8 ? 8 * g + i : 32 + 8 * g + (i - 8)); e[i] = e[i] * rq * gq[dd] * gk[dd]; }
          Bq[0] = mk8(cvt_pk_bf16(e[0], e[1]), cvt_pk_bf16(e[2], e[3]), cvt_pk_bf16(e[4], e[5]), cvt_pk_bf16(e[6], e[7]));
          Bq[1] = mk8(cvt_pk_bf16(e[8], e[9]), cvt_pk_bf16(e[10], e[11]), cvt_pk_bf16(e[12], e[13]), cvt_pk_bf16(e[14], e[15])); }
        f32x4 O[4];
#pragma unroll
        for (int i = 0; i < 4; ++i) O[i] = (f32x4){0.f, 0.f, 0.f, 0.f};
        float carry = 0.f, wmin = 0.f;
        const int ks = tid >> 3, kpc = tid & 7;
        const bf16_t* rp0 = P + (tokb + ks) * PCOLS + h * 64 + kpc * 8;
        uint4 kx = *(const uint4*)(rp0 + (size_t)(((t0 + 127) >> 6) * 64) * PCOLS + C_SK), vx = *(const uint4*)(rp0 + (size_t)(((t0 + 127) >> 6) * 64) * PCOLS + C_SV);
        for (int kb = (t0 + 127) >> 6; kb >= 0; --kb) {
            const int sb0 = kb * 64;
            { const int s = ks, pc = kpc;
              float ke[8] = {bflo(kx.x), bfhi(kx.x), bflo(kx.y), bfhi(kx.y), bflo(kx.z), bfhi(kx.z), bflo(kx.w), bfhi(kx.w)}; float ssk = 0.f;
#pragma unroll
              for (int i = 0; i < 8; ++i) ssk += ke[i] * ke[i];
              ssk += xor_f<1>(ssk); ssk += xor_f<2>(ssk); ssk += xor_f<4>(ssk);
              const float rk = rsqrtf(ssk * (1.f / 64.f) + EPS);
              *(LAS u32x4*)(lds + AT_KL + s * 144 + pc * 16) = (u32x4){cvt_pk_bf16(ke[0] * rk, ke[1] * rk), cvt_pk_bf16(ke[2] * rk, ke[3] * rk), cvt_pk_bf16(ke[4] * rk, ke[5] * rk), cvt_pk_bf16(ke[6] * rk, ke[7] * rk)};
              const unsigned vw[4] = {vx.x, vx.y, vx.z, vx.w};
#pragma unroll
              for (int i = 0; i < 8; ++i) *(LAS bf16_t*)(lds + AT_VT + (pc * 8 + i) * 136 + s * 2) = (bf16_t)((vw[i >> 1] >> ((i & 1) * 16)) & 0xffffu);
              if (kb > 0) { kx = *(const uint4*)(rp0 + (size_t)(sb0 - 64) * PCOLS + C_SK); vx = *(const uint4*)(rp0 + (size_t)(sb0 - 64) * PCOLS + C_SV); } }
            __syncthreads();
            if (sb0 < tq0 + 15 && wmin <= 150.04f) {
                if (sb0 + 63 < tq0) attn_block<false>(lds, Bq, O, carry, sb0, t, g, c16, tri_lo, tri_hi);
                else attn_block<true>(lds, Bq, O, carry, sb0, t, g, c16, tri_lo, tri_hi);
            }
            float mn = carry; mn = fminf(mn, xor_f<1>(mn)); mn = fminf(mn, xor_f<2>(mn)); mn = fminf(mn, xor_f<4>(mn)); mn = fminf(mn, xor_f<8>(mn));
            wmin = __builtin_bit_cast(float, __builtin_amdgcn_readfirstlane(__builtin_bit_cast(int, mn)));
            if (lane == 0) MINW[wid] = mn;
            __syncthreads();
            float mall = MINW[0];
#pragma unroll
            for (int w = 1; w < 8; ++w) mall = fminf(mall, MINW[w]);
            if (mall > 150.04f) break;
        }
#pragma unroll
        for (int dt = 0; dt < 4; ++dt)
#pragma unroll
            for (int r = 0; r < 4; ++r) oc[(tokb + tq0 + 4 * g + r) * 512 + h * 64 + 16 * dt + c16] = f2bf(O[dt][r]);
    }
}

#ifdef MK_CHECK
constexpr size_t WS_DIAG = WS_META + 2048;
constexpr size_t WS_SNAP = WS_BLKE + 4096;
static_assert(WS_SNAP + 64 * 1024 * 4 <= WS_W, "snapshot fits");
__device__ __forceinline__ int samp_row(int i) { return (int)(((unsigned)i * 2654435761u + 12345u) % (unsigned)MTOK); }
__device__ __forceinline__ void chk_fail(unsigned* diag, unsigned code) { atomicMin(diag, code); }
__device__ __forceinline__ bool chk_close(float got, float ref, float atol, float rtol) { return fabsf(got - ref) <= atol + rtol * fabsf(ref) && got == got; }

__global__ void k_diag_init(unsigned* diag) { if (threadIdx.x == 0 && blockIdx.x == 0) { diag[0] = 0xffffffffu; diag[16] = 0u; diag[17] = 0xffffffffu; diag[18] = 0u; diag[19] = 0u; diag[20] = 0u; diag[21] = 0u; diag[22] = 0u; diag[23] = 0u; diag[24] = 0u; diag[25] = 0u; diag[26] = 0u; } }
__global__ void k_snapshot(const float* x, float* snap) { const int i = blockIdx.x; const int r = samp_row(i); for (int c = threadIdx.x; c < D; c += blockDim.x) snap[i * D + c] = x[(size_t)r * D + c]; }
__global__ void k_apply_diag(float* out, const unsigned* diag) {
    if (blockIdx.x != 0 || threadIdx.x != 0) return;
    const unsigned code = diag[0]; if (code == 0xffffffffu) return;
    out[0] = (1.0f + 0.1f * (float)(code > 89u ? 89u : code)) * 1.0e6f;
}
struct ChkGemm { const bf16_t* A; int lda; const float* W; int ldw; int K; int mode; const bf16_t* Cb; int ldc; const float* Cf; const float* xold; const float* W2; const float* lb; const bf16_t* Gsrc; int ncols; unsigned code; int use_snap; };
__global__ void k_chk_gemm(ChkGemm c, unsigned* diag) {
    const int i = blockIdx.x; const int r = samp_row(i);
    for (int cc = threadIdx.x; cc < 96; cc += blockDim.x) {
        const int col = (int)(((unsigned)cc * 40503u + (unsigned)i * 977u) % (unsigned)c.ncols);
        float dot = 0.f, dot2 = 0.f;
        for (int k = 0; k < c.K; ++k) { const float av = bf2f(c.A[(size_t)r * c.lda + k]); dot += av * c.W[(size_t)k * c.ldw + col]; if (c.mode == 4) dot2 += av * c.W2[(size_t)k * c.ldw + col]; }
        float ref, got;
        if (c.mode == 0) { const int kind = col >> 9; ref = (kind == 0 || kind == 3) ? siluf_(dot) : kind == 1 ? __logf(c.lb[col - 512] + (1.f - c.lb[col - 512]) * sigmoidf_(dot)) : (kind == 4 || kind == 5) ? gelu_tanh_(dot) : dot; got = bf2f(c.Cb[(size_t)r * c.ldc + col]); }
        else if (c.mode == 1) { ref = sigmoidf_(dot); got = bf2f(c.Cb[(size_t)r * c.ldc + col]); }
        else if (c.mode == 3) { const float xo = c.use_snap ? c.xold[(size_t)i * D + col] : c.xold[(size_t)r * D + col]; ref = xo + dot; got = c.Cf[(size_t)r * D + col]; }
        else { ref = siluf_(dot) * dot2; got = bf2f(c.Cb[(size_t)r * c.ldc + col]); }
        if (!chk_close(got, ref, 0.03f, 0.03f)) { chk_fail(diag, c.code); if (c.mode == 1) { atomicOr(diag + 24 + (i >> 5), 1u << (i & 31)); atomicOr(diag + 26, 1u << ((r & 255) >> 4)); atomicOr(diag + 20 + ((col & 127) >> 5), 1u << (col & 31)); atomicAdd(diag + 16, 1u); atomicMin(diag + 17, (unsigned)(col >> 8)); atomicMax(diag + 18, (unsigned)(col >> 8)); if (fabsf(got - dot) <= 0.03f + 0.03f * fabsf(dot)) atomicAdd(diag + 19, 1u); } }
    }
}
__global__ void k_chk_branch(const bf16_t* ocat, const float* wbr  , const bf16_t* xn, const float* win  , const bf16_t* GH, unsigned code, unsigned* diag) {
    const int i = blockIdx.x; const int r = samp_row(i);
    for (int cc = threadIdx.x; cc < 96; cc += blockDim.x) {
        const int col = (int)(((unsigned)cc * 40503u + (unsigned)i * 977u) % 3072u); const int b = col >> 10, cl = col & 1023;
        float h = 0.f; for (int k = 0; k < 512; ++k) h += bf2f(ocat[(size_t)b * MTOK * 512 + (size_t)r * 512 + k]) * wbr[((size_t)b * 512 + k) * 1024 + cl];
        float g = 0.f; for (int k = 0; k < 1024; ++k) g += bf2f(xn[(size_t)r * D + k]) * win[(size_t)k * INCOLS + PCOLS + col];
        const float ref = sigmoidf_(g) * h, got = bf2f(GH[(size_t)r * GCOLS + col]);
        if (!chk_close(got, ref, 0.03f, 0.04f)) chk_fail(diag, code);
    }
}
__global__ void k_chk_mix(const bf16_t* ocat, const float* wbr  , const bf16_t* Gt, const bf16_t* mix, unsigned code, unsigned* diag) {
    const int i = blockIdx.x; const int r = samp_row(i);
    for (int cc = threadIdx.x; cc < 96; cc += blockDim.x) {
        const int col = (int)(((unsigned)cc * 40503u + (unsigned)i * 977u) % 1024u); float ref = 0.f;
        for (int b = 0; b < 3; ++b) { float h = 0.f; for (int k = 0; k < 512; ++k) h += bf2f(ocat[(size_t)b * MTOK * 512 + (size_t)r * 512 + k]) * wbr[((size_t)b * 512 + k) * 1024 + col]; ref += bf2f(Gt[(size_t)r * GCOLS + b * 1024 + col]) * h; }
        if (!chk_close(bf2f(mix[(size_t)r * D + col]), ref, 0.03f, 0.04f)) chk_fail(diag, code);
    }
}
__global__ void k_chk_attn(const bf16_t* P, const float* gq, const float* gk, const bf16_t* oc, unsigned code, unsigned* diag) {
    const int id = blockIdx.x, lane = threadIdx.x; const int ti = id % 10;
    const int t = ti == 0 ? 0 : ti == 1 ? 1 : ti == 2 ? 2 : ti == 3 ? 63 : ti == 4 ? 64 : ti == 5 ? 65 : ti == 6 ? 200 : ti == 7 ? 1000 : ti == 8 ? 4097 : 8191;
    const int h = (id / 10) % 8, b = id / 80; const size_t tokb = (size_t)b * SEQ;
    float q = bf2f(P[(tokb + t) * PCOLS + C_SQ + h * 64 + lane]); q = q * rsqrtf(wave_sum(q * q) / 64.f + EPS) * gq[lane];
    float o = 0.f, carry = 0.f;
    for (int s = t - 1; s >= 0 && carry < 300.f; --s) {
        float kv = bf2f(P[(tokb + s) * PCOLS + C_SK + h * 64 + lane]); kv = kv * rsqrtf(wave_sum(kv * kv) / 64.f + EPS) * gk[lane];
        const float z = wave_sum(q * kv) * 0.125f; const float sp = logf(1.f + expf(z));
        carry += sp; const float A = expf(z - carry);
        o += A * bf2f(P[(tokb + s) * PCOLS + C_SV + h * 64 + lane]);
    }
    if (!chk_close(bf2f(oc[(tokb + t) * 512 + h * 64 + lane]), o, 0.02f, 0.03f)) chk_fail(diag, code);
}
__global__ void k_chk_gmlp(const bf16_t* P, const float* ws_l, const float* bs_l, const float* gv_l, const bf16_t* ob, unsigned code, unsigned* diag) {
    const int id = blockIdx.x * blockDim.x + threadIdx.x; if (id >= 512) return;
    const int chunk = (id * 37) % (MTOK / 128), t = (id * 53 + 7) % 128, ch = (id * 101 + 3) % 512, g = ch >> 7, c = ch & 127; const size_t tok0 = (size_t)chunk * 128;
    float acc = 0.f;
    for (int s = 0; s <= t; ++s) { float ss = 0.f; for (int k = 0; k < 512; ++k) { const float v = bf2f(P[(tok0 + s) * PCOLS + C_GV + k]); ss += v * v; }
        const float vn = bf2f(P[(tok0 + s) * PCOLS + C_GV + ch]) * rsqrtf(ss / 512.f + EPS) * gv_l[ch]; acc += ws_l[(size_t)g * 16384 + t * 128 + s] * vn; }
    const float ref = bf2f(P[(tok0 + t) * PCOLS + C_GU + ch]) * (acc + bs_l[g * 128 + t]);
    if (!chk_close(bf2f(ob[(tok0 + t) * 512 + ch]), ref, 0.02f, 0.03f)) chk_fail(diag, code);
}
__global__ void k_chk_hgrn(const bf16_t* P, const float* gain, const bf16_t* oa, unsigned code, unsigned* diag) {
    const int id = blockIdx.x; const int ti = id % 8; const int t = ti == 0 ? 0 : ti == 1 ? 1 : ti == 2 ? 5 : ti == 3 ? 63 : ti == 4 ? 64 : ti == 5 ? 200 : ti == 6 ? 511 : 700, h = (id / 8) % 4, b = id / 32; const int v = threadIdx.x; const size_t tokb = (size_t)b * SEQ;
    float o = 0.f;
    for (int d = 0; d < 128; ++d) { float st = 0.f;
        for (int s = 0; s <= t; ++s) { const bf16_t* row = P + (tokb + s) * PCOLS; const float f = expf(bf2f(row[C_HF + h * 128 + d])); st = f * st + (1.f - f) * bf2f(row[C_HI + h * 128 + v]); }
        o += bf2f(P[(tokb + t) * PCOLS + C_HQ + h * 128 + d]) * st; }
    __shared__ float red[128]; red[v] = o * o; __syncthreads();
    for (int w = 64; w > 0; w >>= 1) { if (v < w) red[v] += red[v + w]; __syncthreads(); }
    const float rstd = rsqrtf(red[0] / 128.f + EPS);
    const float ref = o * rstd * gain[v] * bf2f(P[(tokb + t) * PCOLS + C_HG + h * 128 + v]);
    if (!chk_close(bf2f(oa[(tokb + t) * 512 + h * 128 + v]), ref, 0.03f, 0.04f)) chk_fail(diag, code);
}
__global__ void k_chk_moe(const bf16_t* xn, const float* rw, const float* rb, const float* wg, const float* wu, const float* wd, const float* snap, const float* xout, unsigned code, unsigned* diag) {
    const int i = blockIdx.x; const int r = samp_row(i); const int tid = threadIdx.x;
    __shared__ float hid[DFF]; __shared__ float lg[8]; __shared__ float part[256];
    if (tid < 8) { float a = rb[tid]; for (int k = 0; k < D; ++k) a += bf2f(xn[(size_t)r * D + k]) * rw[k * 8 + tid]; lg[tid] = a; }
    __syncthreads();
    int i0 = 0; for (int e = 1; e < 8; ++e) if (lg[e] > lg[i0]) i0 = e;
    int i1 = -1; for (int e = 0; e < 8; ++e) if (e != i0 && (i1 < 0 || lg[e] > lg[i1])) i1 = e;
    const float w0 = 1.f / (1.f + expf(lg[i1] - lg[i0])), w1 = 1.f - w0;
    float outv[8]; for (int j = 0; j < 8; ++j) outv[j] = 0.f;
    for (int kk = 0; kk < 2; ++kk) { const int e = kk ? i1 : i0; const float wgt = kk ? w1 : w0;
        for (int f = tid; f < DFF; f += blockDim.x) { float g = 0.f, u = 0.f; for (int k = 0; k < D; ++k) { const float xv = bf2f(xn[(size_t)r * D + k]); g += xv * wg[((size_t)e * D + k) * DFF + f]; u += xv * wu[((size_t)e * D + k) * DFF + f]; } hid[f] = siluf_(g) * u; }
        __syncthreads();
        for (int j = 0; j < 8; ++j) { const int col = (j * 131 + i * 17) % D; float p = 0.f; for (int f = tid; f < DFF; f += blockDim.x) p += hid[f] * wd[((size_t)e * DFF + f) * D + col];
            part[tid] = p; __syncthreads(); for (int w = 128; w > 0; w >>= 1) { if (tid < w) part[tid] += part[tid + w]; __syncthreads(); } outv[j] += wgt * part[0]; __syncthreads(); }
    }
    if (tid == 0) for (int j = 0; j < 8; ++j) { const int col = (j * 131 + i * 17) % D; const float ref = snap[(size_t)i * D + col] + outv[j]; if (!chk_close(xout[(size_t)r * D + col], ref, 0.04f, 0.04f)) chk_fail(diag, code); }
}
#endif

struct Args { const float* in[21]; float* out; unsigned char* ws; int lo, hi; };
constexpr int NSTEPS = 24;
__device__ __forceinline__ int laneid_() { int v; asm volatile("v_mbcnt_lo_u32_b32 %0, -1, 0\n\tv_mbcnt_hi_u32_b32 %0, -1, %0" : "=v"(v)); return v; }
#define LANEID (laneid_())

template <class Epi, bool VARNT = false, int NSEG = 1>
__device__ __forceinline__ void run_gemm(LAS unsigned char* lds, const Order& S, int K, const Epi& E, int wid) { pg8::gemm_phase<Epi, Order, true, true, VARNT, NSEG>(lds, K, S, E, wid); }

__global__ void __launch_bounds__(NTHREADS, 2) mk_fwd(Args a) {
    extern __shared__ __attribute__((aligned(16))) unsigned char lds_raw[];
    LAS unsigned char* lds = (LAS unsigned char*)lds_raw;
    const int wid = __builtin_amdgcn_readfirstlane((int)threadIdx.x >> 6);
    LAS unsigned* cblk = (LAS unsigned*)(lds + LDS_MISC);
    { const int tid = threadIdx.x;
      if (tid < 4) cblk[tid] = (tid == 2) ? xb_xcc_id() : 0u;
      if (tid < 46) { const unsigned long long pv = (tid < 42) ? (unsigned long long)a.in[tid >> 1] : (tid < 44) ? (unsigned long long)a.out : (unsigned long long)a.ws; cblk[4 + tid] = (tid & 1) ? (unsigned)(pv >> 32) : (unsigned)pv; }
      if (tid == 46) cblk[50] = (unsigned)a.lo; if (tid == 47) cblk[51] = (unsigned)a.hi; }
    __syncthreads();
#define CW(i) ((int)__builtin_amdgcn_readfirstlane(cblk[i]))
typedef __attribute__((address_space(1))) unsigned char gu8_t;
#define ARGP(i) ((unsigned char*)(gu8_t*)(((unsigned long long)(unsigned)CW(5 + 2 * (i)) << 32) | (unsigned long long)(unsigned)CW(4 + 2 * (i))))
#define IN(i) ((const float*)ARGP(i))
#define OUTP ((float*)ARGP(21))
#define WSP (ARGP(22))
#define GSZ ((int)gridDim.x)
#define WGI ((int)blockIdx.x)
    if (CW(51) - CW(50) > 1 && threadIdx.x == 0) (void)xb_add((unsigned*)(WSP + WS_CTL + CW_BAR) + XB_XCNT(CW(2)), 1u);
#ifndef PROBE_REP
#define PROBE_REP 0ull
#endif
#define RUN(k) (CW(50) <= (k) && (k) < CW(51))
#define NREP(bit) (((PROBE_REP >> (bit)) & 1ull) ? 2 : 1)
#define SEAM(k) do { if (CW(50) <= (k) && (k) + 1 < CW(51)) { XcdBarrier bar_; bar_.bar = (unsigned*)(WSP + WS_CTL + CW_BAR); bar_.x = (unsigned)CW(2); bar_.st = (volatile LAS unsigned*)cblk; xcd_barrier(bar_); } } while (0)

#define XRES (OUTP)
#define WIN ((bf16_t*)(WSP + WS_WIN))
#define WBR ((bf16_t*)(WSP + WS_WBR))
#define WOUT ((bf16_t*)(WSP + WS_WOUT))
#define WGU ((bf16_t*)(WSP + WS_WGU))
#define WDN ((bf16_t*)(WSP + WS_WD))
#define XNB ((bf16_t*)(WSP + WS_XN))
#define PBUF ((bf16_t*)(WSP + WS_P))
#define GBUF ((bf16_t*)(WSP + WS_G))
#define HIDB ((bf16_t*)(WSP + WS_HID))
#define OCATB ((bf16_t*)(WSP + WS_OCAT))
#define MWGU ((bf16_t*)(WSP + WS_MWGU))
#define MWDN ((bf16_t*)(WSP + WS_MWD))
#define XSB ((bf16_t*)(WSP + WS_XS))
#define MHIDB ((bf16_t*)(WSP + WS_MHID))
#define LBB ((float*)(WSP + WS_LB))
#define METAB ((int*)(WSP + WS_META))
#define TOKE ((int*)(WSP + WS_TOKE))
#define TOKW ((float2*)(WSP + WS_TOKW))
#define STOK ((int*)(WSP + WS_SLOTTOK))
#define SWB ((float*)(WSP + WS_SLOTW))
#define BLKE ((int*)(WSP + WS_BLKE))
#define HDUMP ((uint2*)(WSP + WS_ORAW))
#define HU ((float*)(WSP + WS_ORAW + HG_DUMP_BYTES))
#define HDSC ((float*)(WSP + WS_ORAW + HG_DUMP_BYTES + HG_U_BYTES))
#define TIDV (wid * 64 + LANEID)
    for (int rep_ = 0; rep_ < NREP(0); ++rep_) if (RUN(0)) {
        LAS float* tile = (LAS float*)lds; const int tid = TIDV;
#pragma unroll 1
        for (int j = 0; j < 13; ++j) {
            const float* src; bf16_t* dst; int K, N, mode = 0, perm = 1;
            if (j < 10) { const int l = j / 5, r = j % 5;
                if (r == 0) { src = IN(2) + (size_t)l * D * INCOLS; dst = WIN + (size_t)l * INCOLS * D; K = D; N = INCOLS; }
                else if (r < 4) { src = IN(10) + (size_t)(l * 3 + r - 1) * 512 * D; dst = WBR + (size_t)(l * 3 + r - 1) * D * 512; K = 512; N = D; }
                else { src = IN(11) + (size_t)l * D * D; dst = WOUT + (size_t)l * D * D; K = D; N = D; perm = 0; } }
            else if (j == 10) { src = IN(13); dst = WGU; K = D; N = DFF; mode = 1; }
            else if (j == 11) { src = IN(14); dst = WGU; K = D; N = DFF; mode = 2; }
            else { src = IN(15); dst = WDN; K = DFF; N = D; perm = 0; }
            tc_job(src, K, N, dst, mode, perm, tile, WGI, GSZ, tid);
        }
        if (WGI == 0) { const float a0 = IN(3)[tid], a1 = IN(3)[512 + tid]; LBB[tid] = 0.f; LBB[512 + tid] = sigmoidf_(a1 - a0); }
    }
    if (RUN(0)) { __syncthreads(); phase_rmsnorm<false>(IN(0), IN(1), XNB, nullptr, nullptr, nullptr, nullptr, WGI, GSZ, wid, LANEID); }
    SEAM(0);

    for (int l = 0; l < 2; ++l) {
        const int sb = l * 10;
        if (l == 1) { for (int rep_ = 0; rep_ < NREP(1); ++rep_) if (RUN(10)) phase_rmsnorm<false>(XRES, IN(1) + D, XNB, nullptr, nullptr, nullptr, nullptr, WGI, GSZ, wid, LANEID); SEAM(10); }
        for (int rep_ = 0; rep_ < NREP(2); ++rep_) if (RUN(sb + 1)) { Order S; S.init(XNB, WIN + (size_t)l * INCOLS * D, MTOK, PCOLS, D, GSZ, WGI); EpiAct E{PBUF, PCOLS, LBB + l * 512, 1}; run_gemm(lds, S, D, E, wid); }
        SEAM(sb + 1);
        for (int rep_ = 0; rep_ < NREP(3); ++rep_) if (RUN(sb + 2)) {
            for (int r2 = 0; r2 < NREP(13); ++r2) { phase_hgrn_a(PBUF, OCATB, HDUMP, HU, HDSC, lds, WGI, GSZ, TIDV, wid, LANEID);
            __syncthreads(); }
            for (int r2 = 0; r2 < NREP(14); ++r2) { phase_attn(PBUF, IN(8) + l * 64, IN(9) + l * 64, OCATB + (size_t)2 * MTOK * 512, lds, WGI, GSZ, TIDV, wid, LANEID);
            __syncthreads(); }
            for (int r2 = 0; r2 < NREP(15); ++r2) { phase_gmlp(PBUF, IN(6) + (size_t)l * 4 * 16384, IN(7) + l * 512, IN(5) + l * 512, OCATB + (size_t)MTOK * 512, lds, WGI, GSZ, TIDV, wid, LANEID); __syncthreads(); }
        }
        SEAM(sb + 2);
        if (RUN(sb + 3)) phase_hgrn_c(PBUF, OCATB, HDUMP, HU, HDSC, IN(4) + l * 128, lds, WGI, GSZ, TIDV, wid, LANEID);
        SEAM(sb + 3);
        for (int rep_ = 0; rep_ < NREP(4); ++rep_) if (RUN(sb + 4)) { Order S; S.init(XNB, WIN + (size_t)l * INCOLS * D + (size_t)PCOLS * D, MTOK, GCOLS, D, GSZ, WGI); EpiAct E{GBUF, GCOLS, nullptr, 0}; run_gemm(lds, S, D, E, wid); }
        SEAM(sb + 4);
        for (int rep_ = 0; rep_ < NREP(12); ++rep_) if (RUN(sb + 5)) { Order S; S.init(OCATB, WBR + (size_t)l * 3 * D * 512, MTOK, GCOLS, 512, GSZ, WGI, 4, (size_t)MTOK * 512 * 2, (size_t)D * 512 * 2); EpiBranchSeg E{GBUF, XNB}; run_gemm<EpiBranchSeg, false, 3>(lds, S, 512, E, wid); }
        SEAM(sb + 5);
        if (RUN(sb + 6)) { Order S; S.init(XNB, WOUT + (size_t)l * D * D, MTOK, D, D, GSZ, WGI); EpiResid E{(l == 0) ? IN(0) : (const float*)XRES, XRES}; run_gemm(lds, S, D, E, wid); }
        SEAM(sb + 6);
        if (l == 0) {
            for (int rep_ = 0; rep_ < NREP(6); ++rep_) if (RUN(7)) phase_rmsnorm<false>(XRES, IN(12), XNB, nullptr, nullptr, nullptr, nullptr, WGI, GSZ, wid, LANEID);
            SEAM(7);
            for (int rep_ = 0; rep_ < NREP(7); ++rep_) if (RUN(8)) { Order S; S.init(XNB, WGU, MTOK, 2 * DFF, D, GSZ, WGI); EpiGU E{HIDB}; run_gemm(lds, S, D, E, wid); }
            SEAM(8);
            if (RUN(9)) { Order S; S.init(HIDB, WDN, MTOK, D, DFF, GSZ, WGI); EpiResid E{XRES, XRES}; run_gemm(lds, S, DFF, E, wid); }
            SEAM(9);
        } else {
            for (int rep_ = 0; rep_ < NREP(8); ++rep_) if (RUN(17)) phase_rmsnorm<true>(XRES, IN(12) + D, XNB, IN(16), IN(17), TOKE, TOKW, WGI, GSZ, wid, LANEID);
            SEAM(17);
            for (int rep_ = 0; rep_ < NREP(9); ++rep_) if (RUN(18)) {
                if (WGI == GSZ - 1) moe_assign(TOKE, TOKW, METAB, STOK, SWB, BLKE, lds, TIDV);
                else { LAS float* tile = (LAS float*)lds; const int tid = TIDV;
#pragma unroll 1
                    for (int j = 0; j < 3 * NEXP; ++j) { const int e = j / 3, r = j % 3;
                        const float* src = (r == 0 ? IN(18) : r == 1 ? IN(19) : IN(20)) + (size_t)e * D * DFF;
                        bf16_t* dst = (r == 2) ? MWDN + (size_t)e * D * DFF : MWGU + (size_t)e * 2 * DFF * D;
                        tc_job(src, r == 2 ? DFF : D, r == 2 ? D : DFF, dst, r == 2 ? 0 : r + 1, r == 2 ? 0 : 1, tile, WGI, GSZ - 1, tid); } }
            }
            SEAM(18);
#define META(i) __hip_atomic_load(METAB + (i), __ATOMIC_RELAXED, __HIP_MEMORY_SCOPE_AGENT)
            if (RUN(19)) { const int rows = META(0), s0 = META(2); moe_gather(XNB, STOK + s0, rows, XSB, WGI, GSZ, wid, LANEID); }
            SEAM(19);
            for (int kc = 0; kc < 2; ++kc) {
                const int se = 20 + 2 * kc;
                for (int rep_ = 0; rep_ < NREP(11); ++rep_) if (RUN(se)) { const int rows = META(kc), s0 = META(2 + kc);
                    Order S; S.init(XSB, MWGU, rows, 2 * DFF, D, GSZ, WGI, 2, 0, (size_t)2 * DFF * D * 2, BLKE + (s0 >> 8)); EpiGU E{MHIDB}; run_gemm(lds, S, D, E, wid); }
                SEAM(se);
                if (RUN(se + 1)) { const int rows = META(kc), s0 = META(2 + kc);
                    Order S; S.init(MHIDB, MWDN, rows, D, DFF, GSZ, WGI, 2, 0, (size_t)D * DFF * 2, BLKE + (s0 >> 8), 0); EpiMoeDown E{XRES, STOK + s0, SWB + s0}; run_gemm(lds, S, DFF, E, wid);
                    if (kc == 0) { const int rows1 = META(1), s1 = META(3); moe_gather(XNB, STOK + s1, rows1, XSB, WGI, GSZ, wid, LANEID); } }
                SEAM(se + 1);
            }
        }
    }
}

extern "C" void kernel_launch(void* const* d_in, const int* in_sizes, int n_in, void* d_out, int out_size, void* d_ws, size_t ws_size, hipStream_t stream) {
    static int grid = 0;
    if (grid == 0) {
        if (n_in != 21 || out_size != MTOK * D || ws_size < WS_NEED) { fprintf(stderr, "kernel_launch: unexpected shapes (n_in %d out %d ws %zu need %zu)\n", n_in, out_size, ws_size, (size_t)WS_NEED); grid = -1; return; }
        int dev = 0, cus = 0, per_cu = 0;
        if (hipGetDevice(&dev) != hipSuccess || hipDeviceGetAttribute(&cus, hipDeviceAttributeMultiprocessorCount, dev) != hipSuccess) { grid = -1; return; }
        if (hipFuncSetAttribute((const void*)mk_fwd, hipFuncAttributeMaxDynamicSharedMemorySize, LDS_BYTES) != hipSuccess) { fprintf(stderr, "kernel_launch: hipFuncSetAttribute failed\n"); grid = -1; return; }
        if (hipOccupancyMaxActiveBlocksPerMultiprocessor(&per_cu, (const void*)mk_fwd, NTHREADS, LDS_BYTES) != hipSuccess || per_cu < 1) { fprintf(stderr, "kernel_launch: occupancy query says %d\n", per_cu); (void)hipGetLastError(); per_cu = 1; }
        grid = cus;
    }
    if (grid < 0) return;
    (void)hipMemsetAsync((char*)d_ws + WS_CTL, 0, CTL_BYTES, stream);
    Args a{};
    for (int i = 0; i < 21; ++i) a.in[i] = (const float*)d_in[i];
    a.out = (float*)d_out; a.ws = (unsigned char*)d_ws;
#if defined(MK_CHECK)
    {
        unsigned char* ws = (unsigned char*)d_ws; unsigned* diag = (unsigned*)(ws + WS_DIAG); float* snap = (float*)(ws + WS_SNAP);
        const bf16_t* XN = (const bf16_t*)(ws + WS_XN); const bf16_t* Pb = (const bf16_t*)(ws + WS_P); const bf16_t* OC = (const bf16_t*)(ws + WS_OCAT); const float* LB = (const float*)(ws + WS_LB);
        auto run = [&](int s) { a.lo = s; a.hi = s + 1; hipLaunchKernelGGL(mk_fwd, dim3(grid), dim3(NTHREADS), LDS_BYTES, stream, a); };
        hipLaunchKernelGGL(k_diag_init, dim3(1), dim3(64), 0, stream, diag);
        int s = 0; run(s++);
        for (int l = 0; l < 2; ++l) {
            const unsigned cb = l * 10;
            const float* win = a.in[2] + (size_t)l * D * INCOLS;
            if (l == 1) run(s++);
            run(s++);
            { ChkGemm c{}; c.A = XN; c.lda = D; c.W = win; c.ldw = INCOLS; c.K = D; c.mode = 0; c.Cb = Pb; c.ldc = PCOLS; c.lb = LB + l * 512; c.ncols = PCOLS; c.code = cb + 1; hipLaunchKernelGGL(k_chk_gemm, dim3(64), dim3(96), 0, stream, c, diag); }
            run(s++); run(s++);
            hipLaunchKernelGGL(k_chk_hgrn, dim3(128), dim3(128), 0, stream, Pb, a.in[4] + l * 128, OC, cb + 2, diag);
            hipLaunchKernelGGL(k_chk_gmlp, dim3(8), dim3(64), 0, stream, Pb, a.in[6] + (size_t)l * 4 * 16384, a.in[7] + l * 512, a.in[5] + l * 512, OC + (size_t)MTOK * 512, cb + 3, diag);
            hipLaunchKernelGGL(k_chk_attn, dim3(320), dim3(64), 0, stream, Pb, a.in[8] + l * 64, a.in[9] + l * 64, OC + (size_t)2 * MTOK * 512, cb + 4, diag);
            run(s++);
            { ChkGemm c{}; c.A = XN; c.lda = D; c.W = win + PCOLS; c.ldw = INCOLS; c.K = D; c.mode = 1; c.Cb = (const bf16_t*)(ws + WS_G); c.ldc = GCOLS; c.ncols = GCOLS; c.code = cb + 5; hipLaunchKernelGGL(k_chk_gemm, dim3(64), dim3(96), 0, stream, c, diag); }
            run(s++);
            hipLaunchKernelGGL(k_chk_mix, dim3(64), dim3(96), 0, stream, OC, a.in[10] + (size_t)l * 3 * 512 * D, (const bf16_t*)(ws + WS_G), XN, cb + 6, diag);
            if (l == 1) hipLaunchKernelGGL(k_snapshot, dim3(64), dim3(256), 0, stream, (const float*)d_out, snap);
            run(s++);
            { ChkGemm c{}; c.A = XN; c.lda = D; c.W = a.in[11] + (size_t)l * D * D; c.ldw = D; c.K = D; c.mode = 3; c.Cf = (const float*)d_out; c.xold = l ? snap : a.in[0]; c.use_snap = l; c.ncols = D; c.code = cb + 7; hipLaunchKernelGGL(k_chk_gemm, dim3(64), dim3(96), 0, stream, c, diag); }
            run(s++);
            if (l == 0) {
                run(s++);
                { ChkGemm c{}; c.A = XN; c.lda = D; c.W = a.in[13]; c.W2 = a.in[14]; c.ldw = DFF; c.K = D; c.mode = 4; c.Cb = (const bf16_t*)(ws + WS_HID); c.ldc = DFF; c.ncols = DFF; c.code = cb + 8; hipLaunchKernelGGL(k_chk_gemm, dim3(64), dim3(96), 0, stream, c, diag); }
                hipLaunchKernelGGL(k_snapshot, dim3(64), dim3(256), 0, stream, (const float*)d_out, snap);
                run(s++);
                { ChkGemm c{}; c.A = (const bf16_t*)(ws + WS_HID); c.lda = DFF; c.W = a.in[15]; c.ldw = D; c.K = DFF; c.mode = 3; c.Cf = (const float*)d_out; c.xold = snap; c.use_snap = 1; c.ncols = D; c.code = cb + 9; hipLaunchKernelGGL(k_chk_gemm, dim3(64), dim3(96), 0, stream, c, diag); }
            } else {
                hipLaunchKernelGGL(k_snapshot, dim3(64), dim3(256), 0, stream, (const float*)d_out, snap);
                for (int e = 0; e < 6; ++e) run(s++);
                hipLaunchKernelGGL(k_chk_moe, dim3(16), dim3(256), 0, stream, XN, a.in[16], a.in[17], a.in[18], a.in[19], a.in[20], (const float*)snap, (const float*)d_out, 20u, diag);
            }
        }
        if (s != NSTEPS) fprintf(stderr, "step count mismatch %d\n", s);
        hipLaunchKernelGGL(k_apply_diag, dim3(1024), dim3(256), 0, stream, (float*)d_out, (const unsigned*)diag);
    }
#elif !defined(MK_ONE_LAUNCH)
    for (int s = 0; s < NSTEPS; ++s) { a.lo = s; a.hi = s + 1; hipLaunchKernelGGL(mk_fwd, dim3(grid), dim3(NTHREADS), LDS_BYTES, stream, a); }
#else
    a.lo = 0; a.hi = NSTEPS; hipLaunchKernelGGL(mk_fwd, dim3(grid), dim3(NTHREADS), LDS_BYTES, stream, a);
#endif
}
```

```cpp
#define MK_ONE_LAUNCH 1
#include <hip/hip_runtime.h>
#include <cstdio>
#include <cstdint>
#include <cstddef>

#define LAS __attribute__((address_space(3)))
#define XB_TMO      128
#define XB_XCNT(j)  (256  + 64 * (j))
#define XB_XSUB(j)  (1280 + 64 * (j))
#define XB_XGEN(j)  (2304 + 64 * (j))
#define XB_TOP      3328
#define XB_TOPGEN   3392
#define XCD_BAR_WORDS 3456
#define XB_SPIN_CAP (1u << 18)

__device__ __forceinline__ unsigned xb_ld(unsigned* p)              { return __hip_atomic_load(p, __ATOMIC_RELAXED, __HIP_MEMORY_SCOPE_AGENT); }
__device__ __forceinline__ unsigned xb_add(unsigned* p, unsigned v) { return __hip_atomic_fetch_add(p, v, __ATOMIC_RELAXED, __HIP_MEMORY_SCOPE_AGENT); }
__device__ __forceinline__ unsigned xb_xcc_id() { return (unsigned)__builtin_amdgcn_s_getreg((3 << 11) | 20) & 0xFu; }
#define XB_SPIN(cond, bar) do { unsigned _sp = 0; while (cond) { __builtin_amdgcn_s_sleep(1); \
    if ((++_sp & 255u) == 0u) { if (xb_ld(&(bar)[XB_TMO])) break; if (_sp > XB_SPIN_CAP) { atomicAdd(&(bar)[XB_TMO], 1u); break; } } } } while (0)

struct XcdBarrier {
    unsigned* bar; unsigned x;
    volatile LAS unsigned* st;
};

__device__ __forceinline__ XcdBarrier xcd_barrier_post(unsigned* bar, volatile LAS unsigned* st) {
    XcdBarrier b; b.bar = bar; b.x = xb_xcc_id(); b.st = st;
    if (threadIdx.x == 0) (void)xb_add(&bar[XB_XCNT(b.x)], 1u);
    return b;
}
__device__ __forceinline__ void xcd_barrier_complete(unsigned* bar, unsigned x, unsigned& nloc, unsigned& nx) {
    const unsigned G = gridDim.x * gridDim.y * gridDim.z;
    unsigned sum, cnt, mine, sp = 0u;
    for (;;) {
        sum = 0u; cnt = 0u; mine = 0u;
#pragma unroll
        for (unsigned j = 0; j < 16; ++j) { const unsigned c = xb_ld(&bar[XB_XCNT(j)]); sum += c; cnt += (c > 0u) ? 1u : 0u; mine = (j == x) ? c : mine; }
        if (sum == G) break;
        __builtin_amdgcn_s_sleep(1);
        if ((++sp & 255u) == 0u) { if (xb_ld(&bar[XB_TMO])) break; if (sp > XB_SPIN_CAP) { atomicAdd(&bar[XB_TMO], 1u); break; } }
    }
    nloc = mine > 0u ? mine : 1u; nx = cnt > 0u ? cnt : 1u;
}

__device__ __forceinline__ void xcd_barrier(const XcdBarrier& b) {
    asm volatile("s_waitcnt vmcnt(0)" ::: "memory");
    __syncthreads();
    if (threadIdx.x == 0) {
        unsigned* bar = b.bar;
        __builtin_amdgcn_s_waitcnt(0);
        unsigned nloc = b.st[0], nx = b.st[1];
        if (nloc == 0u) { xcd_barrier_complete(bar, b.x, nloc, nx); b.st[0] = nloc; b.st[1] = nx; }
        const unsigned old = xb_add(&bar[XB_XSUB(b.x)], 1u);
        const unsigned gen = old / nloc;
        if (old + 1u == (gen + 1u) * nloc) {
            __builtin_amdgcn_fence(__ATOMIC_RELEASE, "agent");
            asm volatile("s_waitcnt vmcnt(0)" ::: "memory");
            const unsigned og = xb_add(&bar[XB_TOP], 1u);
            const unsigned tg = og / nx;
            if (og + 1u == (tg + 1u) * nx) xb_add(&bar[XB_TOPGEN], 1u);
            else XB_SPIN(xb_ld(&bar[XB_TOPGEN]) == tg, bar);
            __builtin_amdgcn_fence(__ATOMIC_ACQUIRE, "agent");
            xb_add(&bar[XB_XGEN(b.x)], 1u);
            asm volatile("s_waitcnt vmcnt(0)" ::: "memory");
        } else {
            XB_SPIN(xb_ld(&bar[XB_XGEN(b.x)]) == gen, bar);
            __builtin_amdgcn_fence(__ATOMIC_ACQUIRE, "agent");
            asm volatile("s_waitcnt vmcnt(0)" ::: "memory");
        }
    }
    __syncthreads();
}
namespace pg8 {
#define PG8_LAS __attribute__((address_space(3)))
typedef unsigned short bf16_t;
typedef short bf16x8 __attribute__((ext_vector_type(8)));
typedef float f32x4 __attribute__((ext_vector_type(4)));
typedef unsigned u32x4 __attribute__((ext_vector_type(4)));
constexpr int BM = 256, BK = 64, HALF = 128, HTB = HALF * BK * 2  , STAGE_BYTES = 8 * HTB, NXCD = 8, WGM = 8;

__host__ __device__ __forceinline__ int lds_byte(int r, int c) { const int st = (r >> 4) * 2 + (c >> 5), rr = r & 15, cc = c & 31, ob = rr * 64 + cc * 2; return st * 1024 + (ob ^ (((ob >> 9) & 1) << 5)); }
__host__ __device__ __forceinline__ void stage_rc(int b, int& R, int& C) { const int st = b / 1024, sb = b % 1024, swz = sb ^ (((sb >> 9) & 1) << 5); R = (st >> 1) * 16 + swz / 64; C = (st & 1) * 32 + (swz % 64) / 2; }
__host__ __device__ __forceinline__ int perm32(int rho) { const int n = rho >> 4, i = rho & 15; return 8 * (i >> 2) + 4 * n + (i & 3); }

struct Unit { int pm, pn; const char* a; const char* b; int nt, atomic; };

typedef float f32x2 __attribute__((ext_vector_type(2))); typedef __bf16 bf16x2_t __attribute__((ext_vector_type(2)));
__device__ __forceinline__ unsigned cvt_pk_bf16(float lo, float hi) { f32x2 v = {lo, hi}; bf16x2_t b = __builtin_convertvector(v, bf16x2_t); return __builtin_bit_cast(unsigned, b); }
template <class Epi, class Sched, bool ALIGN_EPI = false, bool SP2 = false, bool VARNT = false, int NSEG = 1>
__device__ __forceinline__ void gemm_phase(PG8_LAS unsigned char* lds, const int K, const Sched& S, const Epi& E, const int wid) {
    int lane; asm volatile("v_mbcnt_lo_u32_b32 %0, -1, 0\n\tv_mbcnt_hi_u32_b32 %0, -1, %0" : "=v"(lane));
    const int tid = wid * 64 + lane, wr = wid >> 2, wc = wid & 3, fr = lane & 15, fq = lane >> 4;
    unsigned voffA[2];
#pragma unroll
    for (int i = 0; i < 2; ++i) { int R, C; stage_rc(tid * 16 + i * 8192, R, C); voffA[i] = (unsigned)(R * K + C) * 2u; }
    const size_t kstep = (size_t)(BK * 2);
    const size_t hstep = (size_t)HALF * K * 2;
    const unsigned ldsw = (unsigned)wid * 1024u;
    const int aoff = lds_byte(wr * 64 + fr, fq * 8), boff = lds_byte(wc * 32 + fr, fq * 8);
#define PG8_SA(b, h) (((b) * 2 + (h)) * HTB)
#define PG8_SB(b, h) ((4 + (b) * 2 + (h)) * HTB)
#define PG8_STAGE(bufoff, gbase, voff) do { _Pragma("unroll") for (int _i = 0; _i < 2; ++_i) \
        __builtin_amdgcn_global_load_lds((const unsigned*)((const char*)(gbase) + (voff)[_i]), (PG8_LAS unsigned*)(lds + (bufoff) + ldsw + _i * 8192), 16, 0, 0); } while (0)
#define PG8_LDA(dst, b, h) do { _Pragma("unroll") for (int m = 0; m < 4; ++m) _Pragma("unroll") for (int k = 0; k < 2; ++k) dst[m][k] = *(const PG8_LAS bf16x8*)(lds + PG8_SA(b, h) + aoff + m * 2048 + k * 1024); } while (0)
#define PG8_LDB(dst, b, h) do { _Pragma("unroll") for (int n = 0; n < 2; ++n) _Pragma("unroll") for (int k = 0; k < 2; ++k) dst[n][k] = *(const PG8_LAS bf16x8*)(lds + PG8_SB(b, h) + boff + n * 2048 + k * 1024); } while (0)
#define PG8_MMA(ai, bj, At, Bt) do { __builtin_amdgcn_s_setprio(1); _Pragma("unroll") for (int m = 0; m < 4; ++m) _Pragma("unroll") for (int n = 0; n < 2; ++n) _Pragma("unroll") for (int k = 0; k < 2; ++k) \
        acc[ai][bj][m][n] = __builtin_amdgcn_mfma_f32_16x16x32_bf16(Bt[n][k], At[m][k], acc[ai][bj][m][n], 0, 0, 0); __builtin_amdgcn_s_setprio(0); } while (0)
#define PG8_WAIT_V(n) asm volatile("s_waitcnt vmcnt(" #n ")" ::: "memory")
#define PG8_WAIT_L(n) asm volatile("s_waitcnt lgkmcnt(" #n ")" ::: "memory")
#define PG8_BAR __builtin_amdgcn_s_barrier()
#define PG8_SCHED __builtin_amdgcn_sched_barrier(0)
    Unit cur, nxt; int ui = 0;
    if (!S.next(0, cur)) return;
    f32x4 acc[2][2][4][2];
#pragma unroll
    for (int a = 0; a < 2; ++a)
#pragma unroll
        for (int b = 0; b < 2; ++b)
#pragma unroll
            for (int m = 0; m < 4; ++m)
#pragma unroll
                for (int n = 0; n < 2; ++n) acc[a][b][m][n] = (f32x4){0.f, 0.f, 0.f, 0.f};
    bf16x8 At[4][2], B0[2][2], B1[2][2];
    const char* cA = cur.a; const char* cB = cur.b;
    S.a_ready(cur);
    if constexpr (SP2) {
        PG8_STAGE(PG8_SB(0, 0), cB, voffA); PG8_STAGE(PG8_SB(0, 1), cB + hstep, voffA); PG8_STAGE(PG8_SA(0, 0), cA, voffA); PG8_STAGE(PG8_SA(0, 1), cA + hstep, voffA);
        if (wr == 1) PG8_BAR;
        PG8_WAIT_V(2); PG8_BAR;
        PG8_STAGE(PG8_SB(1, 0), cB + kstep, voffA); PG8_STAGE(PG8_SA(1, 0), cA + kstep, voffA); PG8_STAGE(PG8_SB(1, 1), cB + hstep + kstep, voffA);
        PG8_WAIT_V(6); PG8_BAR;
    } else {
        PG8_STAGE(PG8_SB(0, 0), cB, voffA); PG8_STAGE(PG8_SA(0, 0), cA, voffA); PG8_STAGE(PG8_SB(0, 1), cB + hstep, voffA); PG8_STAGE(PG8_SA(0, 1), cA + hstep, voffA);
        if (wr == 1) PG8_BAR;
        PG8_WAIT_V(4); PG8_BAR;
        PG8_STAGE(PG8_SB(1, 0), cB + kstep, voffA); PG8_STAGE(PG8_SA(1, 0), cA + kstep, voffA); PG8_STAGE(PG8_SB(1, 1), cB + hstep + kstep, voffA);
        PG8_WAIT_V(6); PG8_BAR;
    }
    for (;;) {
        const bool has_next = S.next(ui + 1, nxt);
        const char* nA = has_next ? nxt.a : cA; const char* nB = has_next ? nxt.b : cB;
        const int nt = VARNT ? cur.nt : NSEG * (K / BK); constexpr bool SEGD = (NSEG > 1); const int KT = K / BK;
        for (int t = 0; t < nt; t += 2) {
            const bool last = (t == nt - 2);
            const char* a1 = SEGD ? cA + (size_t)((t + 1) / KT) * S.abr + (size_t)((t + 1) % KT) * kstep : cA + (size_t)(t + 1) * kstep;
            const char* a2 = last ? nA : (SEGD ? cA + (size_t)((t + 2) / KT) * S.abr + (size_t)((t + 2) % KT) * kstep : cA + (size_t)(t + 2) * kstep);
            const char* b2 = last ? nB : (SEGD ? cB + (size_t)((t + 2) / KT) * S.bbr + (size_t)((t + 2) % KT) * kstep : cB + (size_t)(t + 2) * kstep);
            const char* a3 = a2 + kstep; const char* b3 = b2 + kstep;
            if (last && has_next) S.a_ready(nxt);
            if constexpr (SP2) {
            PG8_LDB(B0, 0, 0); PG8_LDB(B1, 0, 1); PG8_SCHED; PG8_LDA(At, 0, 0); PG8_STAGE(PG8_SA(1, 1), a1 + hstep, voffA);
            PG8_WAIT_V(8); PG8_WAIT_L(0); PG8_BAR; PG8_MMA(0, 0, At, B0); PG8_MMA(0, 1, At, B1); PG8_BAR; PG8_SCHED;
            PG8_LDA(At, 0, 1); PG8_STAGE(PG8_SB(0, 0), b2, voffA); PG8_STAGE(PG8_SB(0, 1), b2 + hstep, voffA); PG8_STAGE(PG8_SA(0, 0), a2, voffA);
            PG8_WAIT_V(8); PG8_WAIT_L(0); PG8_BAR; PG8_MMA(1, 0, At, B0); PG8_MMA(1, 1, At, B1); PG8_BAR; PG8_SCHED;
            PG8_LDB(B0, 1, 0); PG8_LDB(B1, 1, 1); PG8_SCHED; PG8_LDA(At, 1, 0); PG8_STAGE(PG8_SA(0, 1), a2 + hstep, voffA);
            PG8_WAIT_V(8); PG8_WAIT_L(0); PG8_BAR; PG8_MMA(0, 0, At, B0); PG8_MMA(0, 1, At, B1); PG8_BAR; PG8_SCHED;
            PG8_LDA(At, 1, 1); PG8_STAGE(PG8_SB(1, 0), b3, voffA); PG8_STAGE(PG8_SB(1, 1), b3 + hstep, voffA); PG8_STAGE(PG8_SA(1, 0), a3, voffA);
            PG8_WAIT_V(8); PG8_WAIT_L(0); PG8_BAR; PG8_MMA(1, 0, At, B0); PG8_MMA(1, 1, At, B1); PG8_BAR; PG8_SCHED;
            } else {
            PG8_LDB(B0, 0, 0); PG8_SCHED; PG8_LDA(At, 0, 0); PG8_STAGE(PG8_SA(1, 1), a1 + hstep, voffA);
            PG8_WAIT_L(8); PG8_BAR; PG8_WAIT_L(0); PG8_MMA(0, 0, At, B0); PG8_BAR; PG8_SCHED;
            PG8_LDB(B1, 0, 1); PG8_STAGE(PG8_SB(0, 0), b2, voffA);
            PG8_BAR; PG8_WAIT_L(0); PG8_MMA(0, 1, At, B1); PG8_BAR;
            PG8_LDA(At, 0, 1); PG8_STAGE(PG8_SA(0, 0), a2, voffA);
            PG8_BAR; PG8_WAIT_L(0); PG8_MMA(1, 0, At, B0); PG8_BAR; PG8_SCHED;
            PG8_STAGE(PG8_SB(0, 1), b2 + hstep, voffA);
            PG8_WAIT_V(6); PG8_BAR; PG8_MMA(1, 1, At, B1); PG8_BAR;
            PG8_LDB(B0, 1, 0); PG8_SCHED; PG8_LDA(At, 1, 0); PG8_STAGE(PG8_SA(0, 1), a2 + hstep, voffA);
            PG8_WAIT_L(8); PG8_BAR; PG8_WAIT_L(0); PG8_MMA(0, 0, At, B0); PG8_BAR; PG8_SCHED;
            PG8_LDB(B1, 1, 1); PG8_STAGE(PG8_SB(1, 0), b3, voffA);
            PG8_BAR; PG8_WAIT_L(0); PG8_MMA(0, 1, At, B1); PG8_BAR;
            PG8_LDA(At, 1, 1); PG8_STAGE(PG8_SA(1, 0), a3, voffA);
            PG8_BAR; PG8_WAIT_L(0); PG8_MMA(1, 0, At, B0); PG8_BAR; PG8_SCHED;
            PG8_STAGE(PG8_SB(1, 1), b3 + hstep, voffA);
            PG8_WAIT_V(6); PG8_BAR; PG8_MMA(1, 1, At, B1); PG8_BAR;
            }
            if constexpr (SEGD) { if (((t + 2) % KT) == 0 && t + 2 < nt) E.mid(acc, cur, (t + 2) / KT - 1, wr, wc, fr, fq); }
        }
        if constexpr (ALIGN_EPI) { if (wr == 0) PG8_BAR; }
        if constexpr (!Epi::AFTER_DRAIN) { E(acc, cur, wr, wc, fr, fq); S.done(cur); }
        if (!has_next) break;
#pragma unroll
        for (int a = 0; a < 2; ++a)
#pragma unroll
            for (int b = 0; b < 2; ++b)
#pragma unroll
                for (int m = 0; m < 4; ++m)
#pragma unroll
                    for (int n = 0; n < 2; ++n) acc[a][b][m][n] = (f32x4){0.f, 0.f, 0.f, 0.f};
        cur = nxt; cA = nA; cB = nB; ++ui;
        if constexpr (ALIGN_EPI) { if (wr == 1) PG8_BAR; }
    }
    PG8_WAIT_V(0);
    if constexpr (!ALIGN_EPI) { if (wr == 0) PG8_BAR; }
    PG8_BAR;
    if constexpr (Epi::AFTER_DRAIN) { E.fused(acc, cur, wr, wc, fr, fq, lds, wid, lane); S.done(cur); }
#undef PG8_SA
#undef PG8_SB
#undef PG8_STAGE
#undef PG8_LDA
#undef PG8_LDB
#undef PG8_MMA
#undef PG8_WAIT_V
#undef PG8_WAIT_L
#undef PG8_BAR
#undef PG8_SCHED
}
}

typedef pg8::bf16_t bf16_t;
typedef pg8::f32x4 f32x4;
typedef pg8::u32x4 u32x4;
using pg8::cvt_pk_bf16;
constexpr int NB = 4, SEQ = 8192, D = 1024, MTOK = NB * SEQ;
constexpr int PCOLS = 4608, GCOLS = 3072, INCOLS = 7680, DFF = 3584, NEXP = 8;
constexpr int C_HQ = 0, C_HF = 512, C_HI = 1024, C_HG = 1536, C_GU = 2048, C_GV = 2560, C_SQ = 3072, C_SK = 3584, C_SV = 4096;
constexpr float EPS = 1e-6f;
constexpr int NSLOT = 2 * MTOK + 2 * NEXP * 256, MOE_MAXBLK = MTOK / 256 + NEXP;
constexpr int NTHREADS = 512, NWAVES = 8;
constexpr int LDS_BYTES = 147456, LDS_MISC = LDS_BYTES - 256;

constexpr size_t WS_CTL = 0, CTL_BYTES = 65536;
constexpr size_t CW_BAR = 0;
constexpr size_t WS_META = WS_CTL + CTL_BYTES;
constexpr size_t WS_LB = WS_META + 4096;
constexpr size_t WS_TOKE = WS_LB + 4096;
constexpr size_t WS_TOKW = WS_TOKE + (size_t)MTOK * 4;
constexpr size_t WS_SLOTTOK = WS_TOKW + (size_t)MTOK * 8;
constexpr size_t WS_SLOTW = WS_SLOTTOK + (size_t)NSLOT * 4;
constexpr size_t WS_BLKE = WS_SLOTW + (size_t)NSLOT * 4;
constexpr size_t WS_W = 2u << 20;
static_assert(WS_BLKE + 4096 <= WS_W, "small buffers");
constexpr size_t WS_WIN = WS_W;
constexpr size_t WS_WBR = WS_WIN + (size_t)2 * INCOLS * D * 2;
constexpr size_t WS_WOUT = WS_WBR + (size_t)2 * 3 * D * 512 * 2;
constexpr size_t WS_WGU = WS_WOUT + (size_t)2 * D * D * 2;
constexpr size_t WS_WD = WS_WGU + (size_t)2 * DFF * D * 2;
constexpr size_t WS_XN = WS_WD + (size_t)D * DFF * 2;
constexpr size_t WS_C = WS_XN + (size_t)MTOK * D * 2;
constexpr size_t WS_P = WS_C;
constexpr size_t WS_G = WS_C;
constexpr size_t WS_HID = WS_C;
constexpr size_t WS_OCAT = WS_C + (size_t)MTOK * PCOLS * 2;
constexpr size_t WS_ORAW = WS_OCAT + (size_t)3 * MTOK * 512 * 2;
constexpr size_t WS_END1 = WS_ORAW + (size_t)MTOK * 512 * 4;
constexpr size_t WS_MWD = WS_W;
static_assert(WS_MWD + (size_t)NEXP * D * DFF * 2 <= WS_XN, "moe down weights fit below XN");
constexpr size_t WS_MWGU = WS_C;
constexpr size_t WS_XS = WS_MWGU + (size_t)NEXP * 2 * DFF * D * 2;
constexpr size_t WS_MHID = WS_XS + (size_t)MOE_MAXBLK * 256 * D * 2;
constexpr size_t WS_END2 = WS_MHID + (size_t)MOE_MAXBLK * 256 * DFF * 2;
constexpr size_t WS_SLAB = WS_END2;
constexpr size_t WS_END3 = WS_SLAB + (size_t)256 * 256 * 256 * 2;
constexpr size_t WS_NEED = WS_END1 > WS_END3 ? WS_END1 : WS_END3;
static_assert(WS_NEED <= 615053344ull, "workspace budget (sum of the inputs)");

#define LAUNDER(v) asm volatile("" : "+v"(v))
__device__ __forceinline__ float bf2f(unsigned v) { return __uint_as_float(v << 16); }
__device__ __forceinline__ float bflo(unsigned w) { return __uint_as_float(w << 16); }
__device__ __forceinline__ float bfhi(unsigned w) { return __uint_as_float(w & 0xffff0000u); }
__device__ __forceinline__ bf16_t f2bf(float f) { return (bf16_t)(cvt_pk_bf16(f, 0.f) & 0xffffu); }
template <int M> __device__ __forceinline__ float xor_f(float v) { return __builtin_bit_cast(float, __builtin_amdgcn_ds_swizzle(__builtin_bit_cast(int, v), (M << 10) | 0x1f)); }
__device__ __forceinline__ float bperm_f(float v, int src_lane) { return __builtin_bit_cast(float, __builtin_amdgcn_ds_bpermute(src_lane << 2, __builtin_bit_cast(int, v))); }
__device__ __forceinline__ float wave_sum(float v) {
    v += xor_f<1>(v); v += xor_f<2>(v); v += xor_f<4>(v); v += xor_f<8>(v); v += xor_f<16>(v);
    return __builtin_bit_cast(float, __builtin_amdgcn_readlane(__builtin_bit_cast(int, v), 0)) + __builtin_bit_cast(float, __builtin_amdgcn_readlane(__builtin_bit_cast(int, v), 32));
}
__device__ __forceinline__ float sigmoidf_(float x) { return __builtin_amdgcn_rcpf(1.f + __expf(-x)); }
__device__ __forceinline__ float siluf_(float x) { return x * sigmoidf_(x); }
__device__ __forceinline__ float gelu_tanh_(float x) { return x * sigmoidf_(1.5957691216057308f * (x + 0.044715f * x * x * x)); }
__device__ __forceinline__ float softplusf_(float z) { return fmaxf(z, 0.f) + __logf(1.f + __expf(-fabsf(z))); }

struct Order {
    int nM, nN, nwg, G, c, mode; const char* A; const char* Bt; size_t tstep, abr, bbr; const int* bmap; int ktiles, nfull, tail, split;
    __device__ __forceinline__ void init(const void* A_, const void* Bt_, int M, int N, int K, int G_, int c_, int mode_ = 0, size_t abr_ = 0, size_t bbr_ = 0, const int* bmap_ = nullptr, int tailsplit = 0) { bmap = bmap_; ktiles = K / 64; split = 1; tail = 0;
        nM = M / 256; nN = N / 256; nwg = nM * nN; G = G_; c = c_; mode = mode_; A = (const char*)A_; Bt = (const char*)Bt_; tstep = (size_t)256 * K * 2; abr = abr_; bbr = bbr_; nfull = nwg;
        if (tailsplit) { nfull = (nwg / G) * G; tail = nwg - nfull; split = (tail > 0 && tail * 7 <= G) ? 7 : (tail > 0 && tail * 4 <= G) ? 4 : (tail > 0 && tail * 2 <= G) ? 2 : 1; } }
    __device__ __forceinline__ void map(int L, int& pm, int& pn) const {
        int wgid = L; { const int q = nwg / 8, r = nwg % 8, xcd = wgid % 8, off = wgid / 8; wgid = (xcd < r ? xcd * (q + 1) : r * (q + 1) + (xcd - r) * q) + off; }
        const int nig = 8 * nN, gid = wgid / nig, fm = gid * 8, gsz = (nM - fm) < 8 ? (nM - fm) : 8; pm = fm + ((wgid % nig) % gsz); pn = (wgid % nig) / gsz; }
    __device__ __forceinline__ bool next(int i, pg8::Unit& u) const {
        if (mode == 4) {
            u.nt = ktiles; u.atomic = 0; const long L = (long)i * G + c; const int nt4 = nM * 4; if (L >= nt4) return false;
            int wgid = (int)L; { const int q = nt4 / 8, r = nt4 % 8, xcd = wgid % 8, off = wgid / 8; wgid = (xcd < r ? xcd * (q + 1) : r * (q + 1) + (xcd - r) * q) + off; }
            const int nig = 8 * 4, gid = wgid / nig, fm = gid * 8, gsz = (nM - fm) < 8 ? (nM - fm) : 8;
            u.pm = fm + ((wgid % nig) % gsz); u.pn = (wgid % nig) / gsz; u.a = A + (size_t)u.pm * tstep; u.b = Bt + (size_t)u.pn * tstep; return true; }
        if (mode == 3) {
            u.nt = ktiles; u.atomic = 0;
            const int br = i % 3; const long L = (long)(i / 3) * G + c; const int nt4 = nM * 4; if (L >= nt4) return false;
            int wgid = (int)L; { const int q = nt4 / 8, r = nt4 % 8, xcd = wgid % 8, off = wgid / 8; wgid = (xcd < r ? xcd * (q + 1) : r * (q + 1) + (xcd - r) * q) + off; }
            const int nig = 8 * 4, gid = wgid / nig, fm = gid * 8, gsz = (nM - fm) < 8 ? (nM - fm) : 8;
            u.pm = fm + ((wgid % nig) % gsz); const int pq = (wgid % nig) / gsz; u.pn = br * 4 + pq;
            u.a = A + (size_t)br * abr + (size_t)u.pm * tstep; u.b = Bt + (size_t)br * bbr + (size_t)pq * tstep; return true; }
        long L = (long)i * G + c; int slice = 0; u.nt = ktiles; u.atomic = 0;
        if (L >= nfull) {
            if (split == 1) { if (L >= nwg) return false; }
            else { const long tq = L - nfull; if (i != nfull / G || tq >= (long)tail * split) return false; L = nfull + tq / split; slice = (int)(tq % split); u.nt = ktiles / split; u.atomic = 1 + (int)tq; } }
        int wgid = (int)L; { const int q = nwg / 8, r = nwg % 8, xcd = wgid % 8, off = wgid / 8; wgid = (xcd < r ? xcd * (q + 1) : r * (q + 1) + (xcd - r) * q) + off; }
        const int nig = 8 * nN, gid = wgid / nig, fm = gid * 8, gsz = (nM - fm) < 8 ? (nM - fm) : 8;
        u.pm = fm + ((wgid % nig) % gsz); u.pn = (wgid % nig) / gsz;
        if (mode == 0) { u.a = A + (size_t)u.pm * tstep; u.b = Bt + (size_t)u.pn * tstep; }
        else if (mode == 2) { const int ex = __hip_atomic_load(bmap + u.pm, __ATOMIC_RELAXED, __HIP_MEMORY_SCOPE_AGENT); u.a = A + (size_t)u.pm * tstep + (size_t)slice * u.nt * 128; u.b = Bt + (size_t)ex * bbr + (size_t)u.pn * tstep + (size_t)slice * u.nt * 128; }
        else { const int br = u.pn >> 2; u.a = A + (size_t)br * abr + (size_t)u.pm * tstep; u.b = Bt + (size_t)br * bbr + (size_t)(u.pn & 3) * tstep; }
        return true;
    }
    __device__ __forceinline__ void a_ready(const pg8::Unit&) const {}
    __device__ __forceinline__ void done(const pg8::Unit&) const {}
};

template <int ACT> __device__ __forceinline__ float act_(float x, float lb) {
    if (ACT == 1) return siluf_(x);
    if (ACT == 2) return __logf(lb + (1.f - lb) * sigmoidf_(x));
    if (ACT == 3) return gelu_tanh_(x);
    if (ACT == 4) return sigmoidf_(x);
    return x;
}
struct EpiAct {
    static constexpr bool PERM = true, AFTER_DRAIN = false;
    bf16_t* O; int ldc; const float* lb; int inproj;
    template <int ACT> __device__ __forceinline__ void run(const f32x4 (&acc)[2][2][4][2], const pg8::Unit& u, int wr, int wc, int fr, int fq) const {
        const int row0 = u.pm * 256 + wr * 64 + fr, col0 = u.pn * 256 + wc * 32 + 8 * fq;
        f32x4 lbv[2][2];
#pragma unroll
        for (int bj = 0; bj < 2; ++bj)
#pragma unroll
            for (int n = 0; n < 2; ++n) lbv[bj][n] = (ACT == 2) ? *(const f32x4*)(lb + (col0 - C_HF) + bj * 128 + 4 * n) : (f32x4){0.f, 0.f, 0.f, 0.f};
#pragma unroll
        for (int ai = 0; ai < 2; ++ai)
#pragma unroll
            for (int m = 0; m < 4; ++m) { bf16_t* rowp = O + (size_t)(row0 + ai * 128 + m * 16) * ldc + col0;
#pragma unroll
                for (int bj = 0; bj < 2; ++bj) { f32x4 v0 = acc[ai][bj][m][0], v1 = acc[ai][bj][m][1];
#pragma unroll
                    for (int i = 0; i < 4; ++i) { v0[i] = act_<ACT>(v0[i], lbv[bj][0][i]); v1[i] = act_<ACT>(v1[i], lbv[bj][1][i]); }
                    u32x4 w; w.x = cvt_pk_bf16(v0[0], v0[1]); w.y = cvt_pk_bf16(v0[2], v0[3]); w.z = cvt_pk_bf16(v1[0], v1[1]); w.w = cvt_pk_bf16(v1[2], v1[3]);
                    *(u32x4*)(rowp + bj * 128) = w; } }
    }
    __device__ __forceinline__ void operator()(const f32x4 (&acc)[2][2][4][2], const pg8::Unit& u, int wr, int wc, int fr, int fq) const {
        if (!inproj) { run<4>(acc, u, wr, wc, fr, fq); return; }
        const int kind = u.pn >> 1;
        if (kind == 0 || kind == 3) run<1>(acc, u, wr, wc, fr, fq);
        else if (kind == 1) run<2>(acc, u, wr, wc, fr, fq);
        else if (kind == 4 || kind == 5) run<3>(acc, u, wr, wc, fr, fq);
        else run<0>(acc, u, wr, wc, fr, fq);
    }
};
struct EpiBranch {
    static constexpr bool PERM = true, AFTER_DRAIN = false;
    const bf16_t* Gt; bf16_t* mix;
    __device__ __forceinline__ void operator()(const f32x4 (&acc)[2][2][4][2], const pg8::Unit& u, int wr, int wc, int fr, int fq) const {
        const int br = u.pn >> 2, row0 = u.pm * 256 + wr * 64 + fr, col0 = (u.pn & 3) * 256 + wc * 32 + 8 * fq;
#pragma unroll
        for (int ai = 0; ai < 2; ++ai)
#pragma unroll
            for (int m = 0; m < 4; ++m) { const size_t row = (size_t)(row0 + ai * 128 + m * 16); const bf16_t* gp = Gt + row * GCOLS + br * 1024 + col0; bf16_t* mp = mix + row * D + col0;
#pragma unroll
                for (int bj = 0; bj < 2; ++bj) { const f32x4 v0 = acc[ai][bj][m][0], v1 = acc[ai][bj][m][1];
                    const u32x4 g = *(const u32x4*)(gp + bj * 128); u32x4 o = {0u, 0u, 0u, 0u};
                    if (br > 0) o = __builtin_nontemporal_load((const u32x4*)(mp + bj * 128));
                    u32x4 w;
                    w.x = cvt_pk_bf16(bflo(o.x) + v0[0] * bflo(g.x), bfhi(o.x) + v0[1] * bfhi(g.x)); w.y = cvt_pk_bf16(bflo(o.y) + v0[2] * bflo(g.y), bfhi(o.y) + v0[3] * bfhi(g.y));
                    w.z = cvt_pk_bf16(bflo(o.z) + v1[0] * bflo(g.z), bfhi(o.z) + v1[1] * bfhi(g.z)); w.w = cvt_pk_bf16(bflo(o.w) + v1[2] * bflo(g.w), bfhi(o.w) + v1[3] * bfhi(g.w));
                    *(u32x4*)(mp + bj * 128) = w; } }
    }
};
struct EpiBranchSeg {
    static constexpr bool PERM = true, AFTER_DRAIN = false;
    const bf16_t* Gt; bf16_t* mix;
    __device__ __forceinline__ void mid(f32x4 (&acc)[2][2][4][2], const pg8::Unit& u, int seg, int wr, int wc, int fr, int fq) const {
        const int row0 = u.pm * 256 + wr * 64 + fr, col0 = u.pn * 256 + wc * 32 + 8 * fq;
#pragma unroll
        for (int ai = 0; ai < 2; ++ai)
#pragma unroll
            for (int mp = 0; mp < 2; ++mp) { u32x4 ga[2][2], gb[2][2];
#pragma unroll
                for (int mm = 0; mm < 2; ++mm) { const bf16_t* gp = Gt + (size_t)(row0 + ai * 128 + (2 * mp + mm) * 16) * GCOLS + seg * 1024 + col0;
#pragma unroll
                    for (int bj = 0; bj < 2; ++bj) { ga[mm][bj] = *(const u32x4*)(gp + bj * 128); gb[mm][bj] = *(const u32x4*)(gp + 1024 + bj * 128); } }
                asm volatile("" ::: "memory");
#pragma unroll
                for (int mm = 0; mm < 2; ++mm)
#pragma unroll
                    for (int bj = 0; bj < 2; ++bj) { const u32x4 a = ga[mm][bj], b = gb[mm][bj]; const int m = 2 * mp + mm;
                        const float na[8] = {bflo(a.x), bfhi(a.x), bflo(a.y), bfhi(a.y), bflo(a.z), bfhi(a.z), bflo(a.w), bfhi(a.w)}, nb[8] = {bflo(b.x), bfhi(b.x), bflo(b.y), bfhi(b.y), bflo(b.z), bfhi(b.z), bflo(b.w), bfhi(b.w)};
#pragma unroll
                        for (int i = 0; i < 4; ++i) { acc[ai][bj][m][0][i] *= fmaxf(na[i], 1e-6f) * __builtin_amdgcn_rcpf(fmaxf(nb[i], 1e-6f)); acc[ai][bj][m][1][i] *= fmaxf(na[4 + i], 1e-6f) * __builtin_amdgcn_rcpf(fmaxf(nb[4 + i], 1e-6f)); } } }
    }
    __device__ __forceinline__ void operator()(const f32x4 (&acc)[2][2][4][2], const pg8::Unit& u, int wr, int wc, int fr, int fq) const {
        const int row0 = u.pm * 256 + wr * 64 + fr, col0 = u.pn * 256 + wc * 32 + 8 * fq;
#pragma unroll
        for (int ai = 0; ai < 2; ++ai) { u32x4 g[4][2];
#pragma unroll
            for (int m = 0; m < 4; ++m)
#pragma unroll
                for (int bj = 0; bj < 2; ++bj) g[m][bj] = *(const u32x4*)(Gt + (size_t)(row0 + ai * 128 + m * 16) * GCOLS + 2048 + col0 + bj * 128);
            asm volatile("" ::: "memory");
#pragma unroll
            for (int m = 0; m < 4; ++m) { bf16_t* mp = mix + (size_t)(row0 + ai * 128 + m * 16) * D + col0;
#pragma unroll
                for (int bj = 0; bj < 2; ++bj) { const f32x4 v0 = acc[ai][bj][m][0], v1 = acc[ai][bj][m][1]; const u32x4 gg = g[m][bj]; u32x4 w;
                    w.x = cvt_pk_bf16(v0[0] * fmaxf(bflo(gg.x), 1e-6f), v0[1] * fmaxf(bfhi(gg.x), 1e-6f)); w.y = cvt_pk_bf16(v0[2] * fmaxf(bflo(gg.y), 1e-6f), v0[3] * fmaxf(bfhi(gg.y), 1e-6f));
                    w.z = cvt_pk_bf16(v1[0] * fmaxf(bflo(gg.z), 1e-6f), v1[1] * fmaxf(bfhi(gg.z), 1e-6f)); w.w = cvt_pk_bf16(v1[2] * fmaxf(bflo(gg.w), 1e-6f), v1[3] * fmaxf(bfhi(gg.w), 1e-6f));
                    *(u32x4*)(mp + bj * 128) = w; } } }
    }
};
struct EpiResid {
    static constexpr bool PERM = false, AFTER_DRAIN = false;
    const float* xin; float* xout;
    __device__ __forceinline__ void operator()(const f32x4 (&acc)[2][2][4][2], const pg8::Unit& u, int wr, int wc, int fr, int fq) const {
        const int row0 = u.pm * 256 + wr * 64 + fr, col0 = u.pn * 256 + wc * 32 + 4 * fq;
#pragma unroll
        for (int ai = 0; ai < 2; ++ai)
#pragma unroll
            for (int mp = 0; mp < 2; ++mp) { f32x4 t[2][2][2];
#pragma unroll
                for (int mm = 0; mm < 2; ++mm) { const size_t ro = (size_t)(row0 + ai * 128 + (2 * mp + mm) * 16) * D + col0;
#pragma unroll
                    for (int bj = 0; bj < 2; ++bj)
#pragma unroll
                        for (int n = 0; n < 2; ++n) t[mm][bj][n] = *(const f32x4*)(xin + ro + bj * 128 + n * 16); }
                asm volatile("" ::: "memory");
#pragma unroll
                for (int mm = 0; mm < 2; ++mm) { const size_t ro = (size_t)(row0 + ai * 128 + (2 * mp + mm) * 16) * D + col0;
#pragma unroll
                    for (int bj = 0; bj < 2; ++bj)
#pragma unroll
                        for (int n = 0; n < 2; ++n) *(f32x4*)(xout + ro + bj * 128 + n * 16) = t[mm][bj][n] + acc[ai][bj][2 * mp + mm][n]; }
                asm volatile("" ::: "memory"); }
    }
};
struct EpiGU {
    static constexpr bool PERM = true, AFTER_DRAIN = false;
    bf16_t* H;
    __device__ __forceinline__ void operator()(const f32x4 (&acc)[2][2][4][2], const pg8::Unit& u, int wr, int wc, int fr, int fq) const {
        const int row0 = u.pm * 256 + wr * 64 + fr, col0 = u.pn * 128 + wc * 32 + 8 * fq;
#pragma unroll
        for (int ai = 0; ai < 2; ++ai)
#pragma unroll
            for (int m = 0; m < 4; ++m) { bf16_t* rowp = H + (size_t)(row0 + ai * 128 + m * 16) * DFF + col0;
                const f32x4 g0 = acc[ai][0][m][0], g1 = acc[ai][0][m][1], u0 = acc[ai][1][m][0], u1 = acc[ai][1][m][1]; u32x4 w;
                w.x = cvt_pk_bf16(siluf_(g0[0]) * u0[0], siluf_(g0[1]) * u0[1]); w.y = cvt_pk_bf16(siluf_(g0[2]) * u0[2], siluf_(g0[3]) * u0[3]);
                w.z = cvt_pk_bf16(siluf_(g1[0]) * u1[0], siluf_(g1[1]) * u1[1]); w.w = cvt_pk_bf16(siluf_(g1[2]) * u1[2], siluf_(g1[3]) * u1[3]);
                *(u32x4*)rowp = w; }
    }
};
struct EpiMoeDown {
    static constexpr bool PERM = false, AFTER_DRAIN = false;
    float* out; const int* stok; const float* sw; bf16_t* slab;
    __device__ __forceinline__ void operator()(const f32x4 (&acc)[2][2][4][2], const pg8::Unit& u, int wr, int wc, int fr, int fq) const {
        if (u.atomic) { bf16_t* sp = slab + (size_t)(u.atomic - 1) * 65536 + (size_t)(wr * 64 + fr) * 256 + wc * 32 + 4 * fq;
#pragma unroll
            for (int ai = 0; ai < 2; ++ai)
#pragma unroll
                for (int m = 0; m < 4; ++m)
#pragma unroll
                    for (int bj = 0; bj < 2; ++bj)
#pragma unroll
                        for (int n = 0; n < 2; ++n) { const f32x4 v = acc[ai][bj][m][n]; *(uint2*)(sp + (size_t)(ai * 128 + m * 16) * 256 + bj * 128 + n * 16) = make_uint2(cvt_pk_bf16(v[0], v[1]), cvt_pk_bf16(v[2], v[3])); }
            return; }
        const int row0 = u.pm * 256 + wr * 64 + fr, col0 = u.pn * 256 + wc * 32 + 4 * fq;
        int tk[2][4]; float wt[2][4];
#pragma unroll
        for (int ai = 0; ai < 2; ++ai)
#pragma unroll
            for (int m = 0; m < 4; ++m) { const int rl = row0 + ai * 128 + m * 16; tk[ai][m] = stok[rl]; wt[ai][m] = sw[rl]; }
#pragma unroll
        for (int ai = 0; ai < 2; ++ai)
#pragma unroll
            for (int mp = 0; mp < 2; ++mp) { f32x4 t[2][2][2];
#pragma unroll
                for (int mm = 0; mm < 2; ++mm) { const int tok = tk[ai][2 * mp + mm]; const float* rp = out + (size_t)(tok < 0 ? 0 : tok) * D + col0;
#pragma unroll
                    for (int bj = 0; bj < 2; ++bj)
#pragma unroll
                        for (int n = 0; n < 2; ++n) t[mm][bj][n] = *(const f32x4*)(rp + bj * 128 + n * 16); }
                asm volatile("" ::: "memory");
#pragma unroll
                for (int mm = 0; mm < 2; ++mm) { const int tok = tk[ai][2 * mp + mm]; const float w = wt[ai][2 * mp + mm];
                    if (tok >= 0) { float* rp = out + (size_t)tok * D + col0;
#pragma unroll
                        for (int bj = 0; bj < 2; ++bj)
#pragma unroll
                            for (int n = 0; n < 2; ++n) *(f32x4*)(rp + bj * 128 + n * 16) = t[mm][bj][n] + acc[ai][bj][2 * mp + mm][n] * w; } }
                asm volatile("" ::: "memory"); }
    }
};
__device__ __forceinline__ void moe_tail_reduce(const Order& S, const bf16_t* slab, float* out, const int* stok, const float* sw, int wg, int G, int wid, int lane) {
    LAUNDER(lane);
    if (S.split == 1) return;
    for (int task = wg * NWAVES + wid; task < S.tail * 256; task += G * NWAVES) {
        const int j = task >> 8, r = task & 255; int pm, pn; S.map(S.nfull + j, pm, pn);
        const int tok = __hip_atomic_load(stok + pm * 256 + r, __ATOMIC_RELAXED, __HIP_MEMORY_SCOPE_AGENT); if (tok < 0) continue;
        const float w = sw[pm * 256 + r]; f32x4 s = {0.f, 0.f, 0.f, 0.f};
        for (int sl = 0; sl < S.split; ++sl) { const uint2 x = *(const uint2*)(slab + (size_t)(j * S.split + sl) * 65536 + (size_t)r * 256 + lane * 4); s[0] += bflo(x.x); s[1] += bfhi(x.x); s[2] += bflo(x.y); s[3] += bfhi(x.y); }
        float* rp = out + (size_t)tok * D + pn * 256 + lane * 4; f32x4 o = *(const f32x4*)rp; o = o + s * w; *(f32x4*)rp = o;
    }
}

__device__ __forceinline__ void tc_job(const float* __restrict__ src, int K, int N, bf16_t* dst, int mode, int perm, LAS float* tile, int wg, int G, int tid) {
    LAUNDER(tid);
    const int tn = N / 64, nt = (K / 64) * tn;
    float4 v0 = make_float4(0.f, 0.f, 0.f, 0.f), v1 = v0;
    if (wg < nt) { const int k0 = (wg / tn) * 64, n0 = (wg % tn) * 64; const float* sp = src + (size_t)(k0 + (tid >> 4)) * N + n0 + (tid & 15) * 4; v0 = *(const float4*)sp; v1 = *(const float4*)(sp + (size_t)32 * N); }
    for (int t = wg; t < nt; t += G) {
        const int k0 = (t / tn) * 64, n0 = (t % tn) * 64;
        { LAS float* tp = tile + (tid >> 4) * 65 + (tid & 15) * 4; tp[0] = v0.x; tp[1] = v0.y; tp[2] = v0.z; tp[3] = v0.w; tp += 32 * 65; tp[0] = v1.x; tp[1] = v1.y; tp[2] = v1.z; tp[3] = v1.w; }
        if (t + G < nt) { const int k1 = ((t + G) / tn) * 64, n1 = ((t + G) % tn) * 64; const float* sp = src + (size_t)(k1 + (tid >> 4)) * N + n1 + (tid & 15) * 4; v0 = *(const float4*)sp; v1 = *(const float4*)(sp + (size_t)32 * N); }
        __syncthreads();
        { const int n = tid >> 3, kg = (tid & 7) * 8; unsigned w[4];
#pragma unroll
          for (int j = 0; j < 4; ++j) w[j] = cvt_pk_bf16(tile[(kg + 2 * j) * 65 + n], tile[(kg + 2 * j + 1) * 65 + n]);
          const int nn = n0 + n; int drow = mode == 0 ? nn : ((nn >> 7) * 256 + (nn & 127) + (mode == 2 ? 128 : 0));
          if (perm) { const int c5 = drow & 31; drow = (drow & ~31) + 16 * ((c5 >> 2) & 1) + 4 * (c5 >> 3) + (c5 & 3); }
          *(uint4*)(dst + (size_t)drow * K + k0 + kg) = make_uint4(w[0], w[1], w[2], w[3]); }
        __syncthreads();
    }
}

template <bool ROUTER>
__device__ __forceinline__ void phase_rmsnorm(const float* __restrict__ x, const float* __restrict__ gain, bf16_t* xn, const float* __restrict__ rw, const float* __restrict__ rb,
                              int* toke, float2* tokw, int wg, int G, int wid, int lane) {
    LAUNDER(lane);
    constexpr int RB = ROUTER ? 2 : 4;
    for (int row0 = (wg * NWAVES + wid) * RB; row0 < MTOK; row0 += G * NWAVES * RB) {
        float4 v[RB][4];
#pragma unroll
        for (int rr = 0; rr < RB; ++rr)
#pragma unroll
            for (int j = 0; j < 4; ++j) v[rr][j] = *(const float4*)(x + (size_t)(row0 + rr) * D + j * 256 + lane * 4);
#pragma unroll
        for (int rr = 0; rr < RB; ++rr) { const int row = row0 + rr; float ss = 0.f;
#pragma unroll
            for (int j = 0; j < 4; ++j) ss += v[rr][j].x * v[rr][j].x + v[rr][j].y * v[rr][j].y + v[rr][j].z * v[rr][j].z + v[rr][j].w * v[rr][j].w;
            ss = wave_sum(ss);
            const float rstd = rsqrtf(ss * (1.f / D) + EPS);
            float lg[NEXP];
#pragma unroll
            for (int e = 0; e < NEXP; ++e) lg[e] = 0.f;
#pragma unroll
            for (int j = 0; j < 4; ++j) { const float4 g = *(const float4*)(gain + j * 256 + lane * 4);
                const float y0 = v[rr][j].x * rstd * g.x, y1 = v[rr][j].y * rstd * g.y, y2 = v[rr][j].z * rstd * g.z, y3 = v[rr][j].w * rstd * g.w;
                *(uint2*)(xn + (size_t)row * D + j * 256 + lane * 4) = make_uint2(cvt_pk_bf16(y0, y1), cvt_pk_bf16(y2, y3));
                if (ROUTER) { const float ys[4] = {y0, y1, y2, y3};
#pragma unroll
                    for (int i = 0; i < 4; ++i) { const float* wr_ = rw + (size_t)(j * 256 + lane * 4 + i) * NEXP; const float4 wa = *(const float4*)wr_, wb = *(const float4*)(wr_ + 4);
                        lg[0] += ys[i] * wa.x; lg[1] += ys[i] * wa.y; lg[2] += ys[i] * wa.z; lg[3] += ys[i] * wa.w; lg[4] += ys[i] * wb.x; lg[5] += ys[i] * wb.y; lg[6] += ys[i] * wb.z; lg[7] += ys[i] * wb.w; } } }
            if (ROUTER) {
#pragma unroll
                for (int e = 0; e < NEXP; ++e) lg[e] = wave_sum(lg[e]) + rb[e];
                int i0 = 0; float l0 = lg[0];
#pragma unroll
                for (int e = 1; e < NEXP; ++e) if (lg[e] > l0) { l0 = lg[e]; i0 = e; }
                int i1 = -1; float l1 = -3.4e38f;
#pragma unroll
                for (int e = 0; e < NEXP; ++e) if (e != i0 && lg[e] > l1) { l1 = lg[e]; i1 = e; }
                const float w0 = __builtin_amdgcn_rcpf(1.f + __expf(l1 - l0));
                if (lane == 0) { toke[row] = i0 | (i1 << 8); tokw[row] = make_float2(w0, 1.f - w0); }
            }
        }
    }
}

__device__ void phase_combine(const bf16_t* GH, bf16_t* mix, int wg, int G, int tid) {
    LAUNDER(tid);
    for (size_t v = (size_t)wg * NTHREADS + tid; v < (size_t)MTOK * (D / 8); v += (size_t)G * NTHREADS) {
        const size_t r = v / (D / 8); const int c = (int)(v % (D / 8)) * 8; const bf16_t* gp = GH + r * GCOLS + c;
        const uint4 a = *(const uint4*)gp, b = *(const uint4*)(gp + 1024), cc = *(const uint4*)(gp + 2048); uint4 o;
        o.x = cvt_pk_bf16(bflo(a.x) + bflo(b.x) + bflo(cc.x), bfhi(a.x) + bfhi(b.x) + bfhi(cc.x));
        o.y = cvt_pk_bf16(bflo(a.y) + bflo(b.y) + bflo(cc.y), bfhi(a.y) + bfhi(b.y) + bfhi(cc.y));
        o.z = cvt_pk_bf16(bflo(a.z) + bflo(b.z) + bflo(cc.z), bfhi(a.z) + bfhi(b.z) + bfhi(cc.z));
        o.w = cvt_pk_bf16(bflo(a.w) + bflo(b.w) + bflo(cc.w), bfhi(a.w) + bfhi(b.w) + bfhi(cc.w));
        *(uint4*)(mix + r * D + c) = o;
    }
}

__device__ __forceinline__ void moe_assign(const int* toke, const float2* tokw, int* meta, int* stok, float* sw, int* blke, LAS unsigned char* lds, int tid) {
    LAS int* cnt = (LAS int*)lds;
    LAS int* tot = cnt + 512 * 16;
    const int t0 = tid * (MTOK / NTHREADS);
    { int z = 0; asm volatile("" : "+v"(z));
      for (int j = 0; j < 16; ++j) cnt[tid * 16 + j] = z; }
    for (int i = 0; i < MTOK / NTHREADS; ++i) { const int ee = toke[t0 + i]; cnt[tid * 16 + (ee & 255)] += 1; cnt[tid * 16 + 8 + ((ee >> 8) & 255)] += 1; }
    __syncthreads();
    if (tid < 16) { int run = 0; for (int i = 0; i < NTHREADS; ++i) { const int v = cnt[i * 16 + tid]; cnt[i * 16 + tid] = run; run += v; } tot[tid] = run; }
    __syncthreads();
    if (tid == 0) { int run = 0; for (int j = 0; j < 16; ++j) { const int n = tot[j], pad = (n + 255) & ~255; tot[16 + j] = run; if (j == 8) { meta[0] = run; meta[3] = run; } run += pad; } meta[1] = run - tot[16 + 8]; meta[2] = 0; meta[4] = run; }
    __syncthreads();
    for (int bk = tid; bk < 2 * MOE_MAXBLK; bk += NTHREADS) { int ex = 0;
        for (int j = 0; j < 16; ++j) { const int base = tot[16 + j], pad = (tot[j] + 255) & ~255; if (bk * 256 >= base && bk * 256 < base + pad) ex = j & 7; }
        blke[bk] = ex; }
    for (int j = 0; j < 16; ++j) cnt[tid * 16 + j] += tot[16 + j];
    for (int i = 0; i < MTOK / NTHREADS; ++i) { const int tk = t0 + i; const int ee = toke[tk]; const int j0 = ee & 255, j1 = 8 + ((ee >> 8) & 255); const float2 w = tokw[tk];
        const int p0 = cnt[tid * 16 + j0]; cnt[tid * 16 + j0] = p0 + 1; const int p1 = cnt[tid * 16 + j1]; cnt[tid * 16 + j1] = p1 + 1;
        stok[p0] = tk; sw[p0] = w.x; stok[p1] = tk; sw[p1] = w.y; }
    for (int j = 0; j < 16; ++j) { const int n = tot[j], pad = (n + 255) & ~255, base = tot[16 + j]; for (int i = n + tid; i < pad; i += NTHREADS) { stok[base + i] = -1; sw[base + i] = 0.f; } }
}
__device__ __forceinline__ void moe_gather(const bf16_t* xn, const int* stok, int rows, bf16_t* xs, int wg, int G, int wid, int lane) {
    LAUNDER(lane);
    for (int r0 = (wg * NWAVES + wid) * 4; r0 < rows; r0 += G * NWAVES * 4) {
        int tok[4]; uint4 a[4], b[4];
#pragma unroll
        for (int i = 0; i < 4; ++i) tok[i] = __hip_atomic_load(stok + r0 + i, __ATOMIC_RELAXED, __HIP_MEMORY_SCOPE_AGENT);
#pragma unroll
        for (int i = 0; i < 4; ++i) { a[i] = make_uint4(0, 0, 0, 0); b[i] = a[i]; if (tok[i] >= 0) { const uint4* sp = (const uint4*)(xn + (size_t)tok[i] * D) + lane * 2; a[i] = sp[0]; b[i] = sp[1]; } }
#pragma unroll
        for (int i = 0; i < 4; ++i) { uint4* dp = (uint4*)(xs + (size_t)(r0 + i) * D) + lane * 2; dp[0] = a[i]; dp[1] = b[i]; } }
}

typedef pg8::bf16x8 bf16x8;
typedef unsigned u32x2 __attribute__((ext_vector_type(2)));
#define MFMA16(A, B, C) __builtin_amdgcn_mfma_f32_16x16x32_bf16((A), (B), (C), 0, 0, 0)
__device__ __forceinline__ bf16x8 mk8(unsigned a, unsigned b, unsigned c, unsigned d) { u32x4 v = {a, b, c, d}; return __builtin_bit_cast(bf16x8, v); }

constexpr int H_QD = 0, H_KD = 8704, H_KB = 17408, H_QG = 21760, H_KET = 30464, H_VT = 40704, H_PM = 50944, H_TP = 53504, H_GE = 55552;
constexpr size_t HG_DUMP_BYTES = (size_t)MTOK * 512 * 2, HG_U_BYTES = (size_t)256 * 128 * 128 * 4;
__device__ __forceinline__ void phase_hgrn_a(const bf16_t* P, bf16_t* qsc  , uint2* dump, float* U, float* Dsc, LAS unsigned char* lds, int wg, int G, int tid, int wid, int lane) {
    LAUNDER(tid); LAUNDER(lane);
    const int d = tid & 127, part = tid >> 7, g = lane >> 4, c16 = lane & 15;
    LAS float* TP = (LAS float*)(lds + H_TP); LAS float* GE = (LAS float*)(lds + H_GE);
    for (int item = wg; item < 256; item += G) {
        const int b = item >> 6, h = (item >> 4) & 3, sc = item & 15; const size_t tok0 = (size_t)b * SEQ + (size_t)sc * 512;
        f32x4 S[8];
#pragma unroll
        for (int i = 0; i < 8; ++i) S[i] = (f32x4){0.f, 0.f, 0.f, 0.f};
        float gsc = 0.f;
        unsigned lfv[8], qv[8], vv[8];
        { const bf16_t* base = P + (tok0 + 8 * part) * PCOLS + h * 128 + d;
#pragma unroll
          for (int j = 0; j < 8; ++j) { lfv[j] = base[(size_t)j * PCOLS + C_HF]; qv[j] = base[(size_t)j * PCOLS + C_HQ]; vv[j] = base[(size_t)j * PCOLS + C_HI]; } }
        for (int c = 0; c < 16; ++c) {
            float gl[8], lf[8], qf[8]; unsigned vb[8]; float run = 0.f;
#pragma unroll
            for (int j = 0; j < 8; ++j) { lf[j] = bf2f(lfv[j]); qf[j] = bf2f(qv[j]); vb[j] = vv[j]; run += lf[j]; gl[j] = run; }
            if (c < 15) { const bf16_t* base = P + (tok0 + (c + 1) * 32 + 8 * part) * PCOLS + h * 128 + d;
#pragma unroll
                for (int j = 0; j < 8; ++j) { lfv[j] = base[(size_t)j * PCOLS + C_HF]; qv[j] = base[(size_t)j * PCOLS + C_HQ]; vv[j] = base[(size_t)j * PCOLS + C_HI]; } }
            TP[part * 128 + d] = run;
            __syncthreads();
            const float t0 = TP[d], t1 = TP[128 + d], t2 = TP[256 + d], t3 = TP[384 + d];
            const float T0 = t0 + t1, gend = T0 + t2 + t3;
            const float pre = (part == 1) ? t0 : (part == 3) ? t2 : 0.f, gb = (part >> 1) ? T0 : 0.f;
            unsigned kep[4];
#pragma unroll
            for (int j = 0; j < 8; j += 2) {
                float ke2[2];
#pragma unroll
                for (int jj = 0; jj < 2; ++jj) { const int t = 8 * part + j + jj; const float Gl = pre + gl[j + jj], Gt = gb + Gl; const float k = 1.f - __expf(lf[j + jj]), q = qf[j + jj];
                    *(LAS bf16_t*)(lds + H_QD + t * 272 + d * 2) = f2bf(q * __expf(Gl));
                    *(LAS bf16_t*)(lds + H_KD + t * 272 + d * 2) = f2bf(k * __expf(fminf(-Gl, 80.f)));
                    if (part < 2) *(LAS bf16_t*)(lds + H_KB + t * 272 + d * 2) = f2bf(k * __expf(T0 - Gl));
                    *(LAS bf16_t*)(lds + H_QG + t * 272 + d * 2) = f2bf(q * __expf(Gt));
                    qsc[(tok0 + c * 32 + t) * 512 + h * 128 + d] = f2bf(q * __expf(gsc + Gt));
                    ke2[jj] = k * __expf(gend - Gt); }
                kep[j >> 1] = cvt_pk_bf16(ke2[0], ke2[1]); }
            *(LAS u32x4*)(lds + H_KET + d * 80 + part * 16) = (u32x4){kep[0], kep[1], kep[2], kep[3]};
            *(LAS u32x4*)(lds + H_VT + d * 80 + part * 16) = (u32x4){vb[0] | (vb[1] << 16), vb[2] | (vb[3] << 16), vb[4] | (vb[5] << 16), vb[6] | (vb[7] << 16)};
            if (part == 0) GE[d] = __expf(gend);
            gsc += gend;
            __syncthreads();
            if (wid < 3) { const int I = (wid == 0) ? 0 : 1, J = (wid == 2) ? 0 : I; f32x4 acc = {0.f, 0.f, 0.f, 0.f};
#pragma unroll
                for (int kk = 0; kk < 4; ++kk) { const bf16x8 A = *(const LAS bf16x8*)(lds + H_QD + (16 * I + c16) * 272 + kk * 64 + g * 16);
                    const bf16x8 B = (wid == 2) ? *(const LAS bf16x8*)(lds + H_KB + c16 * 272 + kk * 64 + g * 16) : *(const LAS bf16x8*)(lds + H_KD + (16 * J + c16) * 272 + kk * 64 + g * 16);
                    acc = MFMA16(A, B, acc); }
#pragma unroll
                for (int r = 0; r < 4; ++r) { const int t = 4 * g + r; const float v = (I == J && c16 > t) ? 0.f : acc[r]; *(LAS bf16_t*)(lds + H_PM + (16 * I + t) * 80 + (16 * J + c16) * 2) = f2bf(v); }
            } else if (wid == 3) {
#pragma unroll
                for (int r = 0; r < 4; ++r) *(LAS bf16_t*)(lds + H_PM + (4 * g + r) * 80 + (16 + c16) * 2) = (bf16_t)0;
            }
            __syncthreads();
            { const bf16x8 Bv = *(const LAS bf16x8*)(lds + H_VT + (16 * wid + c16) * 80 + g * 16);
              unsigned sp[8][2];
#pragma unroll
              for (int i = 0; i < 8; ++i) { sp[i][0] = cvt_pk_bf16(S[i][0], S[i][1]); sp[i][1] = cvt_pk_bf16(S[i][2], S[i][3]); }
              const size_t chunk_g = (tok0 >> 5) + c;
#pragma unroll
              for (int rt = 0; rt < 2; ++rt) { f32x4 o = {0.f, 0.f, 0.f, 0.f};
                  o = MFMA16(*(const LAS bf16x8*)(lds + H_PM + (16 * rt + c16) * 80 + g * 16), Bv, o);
#pragma unroll
                  for (int kk = 0; kk < 4; ++kk) { const LAS unsigned char* qp = lds + H_QG + (16 * rt + c16) * 272 + (32 * kk + 4 * g) * 2;
                      const u32x2 lo = *(const LAS u32x2*)qp, hi = *(const LAS u32x2*)(qp + 32);
                      o = MFMA16(mk8(lo.x, lo.y, hi.x, hi.y), mk8(sp[2 * kk][0], sp[2 * kk][1], sp[2 * kk + 1][0], sp[2 * kk + 1][1]), o); }
                  dump[(((chunk_g * 4 + h) * 2 + rt) * 8 + wid) * 64 + lane] = make_uint2(cvt_pk_bf16(o[0], o[1]), cvt_pk_bf16(o[2], o[3])); }
#pragma unroll
              for (int i = 0; i < 8; ++i) { const f32x4 dec = *(const LAS f32x4*)(lds + H_GE + (16 * i + 4 * g) * 4); S[i] = S[i] * dec;
                  S[i] = MFMA16(*(const LAS bf16x8*)(lds + H_KET + (16 * i + c16) * 80 + g * 16), Bv, S[i]); } }
            __syncthreads();
        }
#pragma unroll
        for (int i = 0; i < 8; ++i)
#pragma unroll
            for (int r = 0; r < 4; ++r) U[((size_t)item * 128 + 16 * i + 4 * g + r) * 128 + 16 * wid + c16] = S[i][r];
        if (part == 0) Dsc[item * 128 + d] = __expf(gsc);
    }
}
constexpr int HC_SIN = 0;
__device__ __forceinline__ void phase_hgrn_c(const bf16_t* P, bf16_t* qoa  , const uint2* dump, const float* U, const float* Dsc, const float* gain, LAS unsigned char* lds, int wg, int G, int tid, int wid, int lane) {
    LAUNDER(tid); LAUNDER(lane);
    const int g = lane >> 4, c16 = lane & 15;
    for (int item = wg; item < 256; item += G) {
        const int b = item >> 6, h = (item >> 4) & 3, sc = item & 15; const size_t tok0 = (size_t)b * SEQ + (size_t)sc * 512;
#pragma unroll 1
        for (int kq = 0; kq < 4; ++kq) { float s[8];
#pragma unroll
          for (int k = 0; k < 8; ++k) s[k] = 0.f;
#pragma unroll 1
          for (int j = 0; j < sc; ++j) { const size_t it = (size_t)(item - sc + j);
#pragma unroll
              for (int k = 0; k < 8; ++k) { const int e = tid + 512 * (kq * 8 + k); s[k] = Dsc[it * 128 + (e >> 7)] * s[k] + U[it * 16384 + e]; } }
#pragma unroll
          for (int k = 0; k < 8; ++k) { const int e = tid + 512 * (kq * 8 + k); *(LAS bf16_t*)(lds + HC_SIN + (e & 127) * 272 + (e >> 7) * 2) = f2bf(s[k]); } }
        __syncthreads();
#pragma unroll 1
        for (int rtile = 0; rtile < 4; ++rtile) {
            const size_t row0 = tok0 + 64 * wid + 16 * rtile; const size_t chunk_g = (tok0 >> 5) + 2 * wid + (rtile >> 1); const int rt = rtile & 1;
            bf16x8 A[4];
#pragma unroll
            for (int kk = 0; kk < 4; ++kk) A[kk] = *(const bf16x8*)(qoa + (row0 + c16) * 512 + h * 128 + 32 * kk + 8 * g);
            f32x4 acc[8]; float ss[4] = {0.f, 0.f, 0.f, 0.f};
#pragma unroll
            for (int vt = 0; vt < 8; ++vt) { acc[vt] = (f32x4){0.f, 0.f, 0.f, 0.f};
#pragma unroll
                for (int kk = 0; kk < 4; ++kk) acc[vt] = MFMA16(A[kk], *(const LAS bf16x8*)(lds + HC_SIN + (16 * vt + c16) * 272 + (32 * kk + 8 * g) * 2), acc[vt]);
                const uint2 ol = dump[(((chunk_g * 4 + h) * 2 + rt) * 8 + vt) * 64 + lane];
                acc[vt][0] += bflo(ol.x); acc[vt][1] += bfhi(ol.x); acc[vt][2] += bflo(ol.y); acc[vt][3] += bfhi(ol.y);
#pragma unroll
                for (int r = 0; r < 4; ++r) ss[r] += acc[vt][r] * acc[vt][r]; }
            float rstd[4];
#pragma unroll
            for (int r = 0; r < 4; ++r) { float s = ss[r]; s += xor_f<1>(s); s += xor_f<2>(s); s += xor_f<4>(s); s += xor_f<8>(s); rstd[r] = rsqrtf(s * (1.f / 128.f) + EPS); }
            unsigned hgv[8][4];
#pragma unroll
            for (int vt = 0; vt < 8; ++vt)
#pragma unroll
                for (int r = 0; r < 4; ++r) hgv[vt][r] = P[(row0 + 4 * g + r) * PCOLS + C_HG + h * 128 + 16 * vt + c16];
#pragma unroll
            for (int vt = 0; vt < 8; ++vt) { const float gn = gain[16 * vt + c16];
#pragma unroll
                for (int r = 0; r < 4; ++r) { const size_t row = row0 + 4 * g + r;
                    qoa[row * 512 + h * 128 + 16 * vt + c16] = f2bf(acc[vt][r] * rstd[r] * gn * bf2f(hgv[vt][r])); } }
        }
        __syncthreads();
    }
}

constexpr int GM_VT = 0, GM_W = 34816, GM_RS = 69632;
__device__ __forceinline__ void phase_gmlp(const bf16_t* P, const float* __restrict__ ws_l, const float* __restrict__ bs_l, const float* __restrict__ gv_l, bf16_t* ob, LAS unsigned char* lds, int wg, int G, int tid, int wid, int lane) {
    LAUNDER(tid); LAUNDER(lane);
    const int g = lane >> 4, c16 = lane & 15; LAS float* RS = (LAS float*)(lds + GM_RS);
    for (int item = wg; item < MTOK / 128; item += G) {
        const size_t tok0 = (size_t)item * 128;
        { const int s = tid >> 2, qd = tid & 3; const bf16_t* rp = P + (tok0 + s) * PCOLS + C_GV + qd * 128; float ss = 0.f;
#pragma unroll
          for (int j = 0; j < 16; ++j) { const uint4 x = *(const uint4*)(rp + j * 8); ss += bflo(x.x) * bflo(x.x) + bfhi(x.x) * bfhi(x.x) + bflo(x.y) * bflo(x.y) + bfhi(x.y) * bfhi(x.y) + bflo(x.z) * bflo(x.z) + bfhi(x.z) * bfhi(x.z) + bflo(x.w) * bflo(x.w) + bfhi(x.w) * bfhi(x.w); }
          ss += xor_f<1>(ss); ss += xor_f<2>(ss); if (qd == 0) RS[s] = rsqrtf(ss * (1.f / 512.f) + EPS); }
        for (int grp = 0; grp < 4; ++grp) {
            __syncthreads();
#pragma unroll
            for (int ps = 0; ps < 4; ++ps) { const int idx = tid + ps * 512, s = idx >> 4, c8 = (idx & 15) * 8; const uint4 x = *(const uint4*)(P + (tok0 + s) * PCOLS + C_GV + grp * 128 + c8);
                const float rs = RS[s]; const float4 ga = *(const float4*)(gv_l + grp * 128 + c8), gb = *(const float4*)(gv_l + grp * 128 + c8 + 4);
                const float e[8] = {bflo(x.x) * rs * ga.x, bfhi(x.x) * rs * ga.y, bflo(x.y) * rs * ga.z, bfhi(x.y) * rs * ga.w, bflo(x.z) * rs * gb.x, bfhi(x.z) * rs * gb.y, bflo(x.w) * rs * gb.z, bfhi(x.w) * rs * gb.w};
#pragma unroll
                for (int i = 0; i < 8; ++i) *(LAS bf16_t*)(lds + GM_VT + (c8 + i) * 272 + s * 2) = f2bf(e[i]);
                const int t = idx >> 4, s8 = (idx & 15) * 8; const float4 wa = *(const float4*)(ws_l + (size_t)grp * 16384 + t * 128 + s8), wb = *(const float4*)(ws_l + (size_t)grp * 16384 + t * 128 + s8 + 4);
                *(LAS u32x4*)(lds + GM_W + t * 272 + s8 * 2) = (u32x4){cvt_pk_bf16(s8 + 0 <= t ? wa.x : 0.f, s8 + 1 <= t ? wa.y : 0.f), cvt_pk_bf16(s8 + 2 <= t ? wa.z : 0.f, s8 + 3 <= t ? wa.w : 0.f),
                                                                    cvt_pk_bf16(s8 + 4 <= t ? wb.x : 0.f, s8 + 5 <= t ? wb.y : 0.f), cvt_pk_bf16(s8 + 6 <= t ? wb.z : 0.f, s8 + 7 <= t ? wb.w : 0.f)}; }
            __syncthreads();
            unsigned guv[4][8];
#pragma unroll
            for (int r = 0; r < 4; ++r)
#pragma unroll
                for (int ct = 0; ct < 8; ++ct) guv[r][ct] = P[(tok0 + 16 * wid + 4 * g + r) * PCOLS + C_GU + grp * 128 + 16 * ct + c16];
            f32x4 acc[8];
#pragma unroll
            for (int ct = 0; ct < 8; ++ct) acc[ct] = (f32x4){0.f, 0.f, 0.f, 0.f};
            for (int kk = 0; kk <= (wid >> 1); ++kk) { const bf16x8 A = *(const LAS bf16x8*)(lds + GM_W + (16 * wid + c16) * 272 + kk * 64 + g * 16);
#pragma unroll
                for (int ct = 0; ct < 8; ++ct) acc[ct] = MFMA16(A, *(const LAS bf16x8*)(lds + GM_VT + (16 * ct + c16) * 272 + kk * 64 + g * 16), acc[ct]); }
#pragma unroll
            for (int r = 0; r < 4; ++r) { const int t = 16 * wid + 4 * g + r; const float bias = bs_l[grp * 128 + t]; const size_t tok = tok0 + t;
#pragma unroll
                for (int ct = 0; ct < 8; ++ct) { const int ch = grp * 128 + 16 * ct + c16; ob[tok * 512 + ch] = f2bf(bf2f(guv[r][ct]) * (acc[ct][r] + bias)); } }
        }
        __syncthreads();
    }
}

constexpr int AT_KL = 0, AT_VT = 9216, AT_MIN = 9216 + 64 * 136;
template <bool DIAG>
__device__ __forceinline__ void attn_block(LAS unsigned char* lds, const bf16x8 (&Bq)[2], f32x4 (&O)[4], float& carry, int sb0, int t, int g, int c16, unsigned tri_lo, unsigned tri_hi) {
    const unsigned ONES = 0x3F803F80u;
    f32x4 z[4]; unsigned hi[4][2];
#pragma unroll
    for (int st = 0; st < 4; ++st) { z[st] = (f32x4){0.f, 0.f, 0.f, 0.f};
#pragma unroll
        for (int kk = 0; kk < 2; ++kk) z[st] = MFMA16(*(const LAS bf16x8*)(lds + AT_KL + (16 * st + c16) * 144 + kk * 64 + g * 16), Bq[kk], z[st]);
        float spv[4];
#pragma unroll
        for (int r = 0; r < 4; ++r) { const float sp = __builtin_amdgcn_logf(1.f + __builtin_amdgcn_exp2f(z[st][r])); spv[r] = (!DIAG || (sb0 + 16 * st + 4 * g + r < t)) ? sp : 0.f; }
        hi[st][0] = cvt_pk_bf16(spv[0], spv[1]); hi[st][1] = cvt_pk_bf16(spv[2], spv[3]); }
    f32x4 sf[4];
#pragma unroll
    for (int so = 0; so < 4; ++so) { sf[so] = (f32x4){0.f, 0.f, 0.f, 0.f};
#pragma unroll
        for (int kk = 0; kk < 2; ++kk) { if (2 * kk + 1 < so) continue;
            const unsigned a0 = (2 * kk > so) ? ONES : (2 * kk == so) ? tri_lo : 0u, a1 = (2 * kk > so) ? ONES : (2 * kk == so) ? tri_hi : 0u;
            const unsigned a2 = (2 * kk + 1 > so) ? ONES : tri_lo, a3 = (2 * kk + 1 > so) ? ONES : tri_hi;
            sf[so] = MFMA16(mk8(a0, a1, a2, a3), mk8(hi[2 * kk][0], hi[2 * kk][1], hi[2 * kk + 1][0], hi[2 * kk + 1][1]), sf[so]); } }
    unsigned pa[4][2];
#pragma unroll
    for (int st = 0; st < 4; ++st) { float av[4];
#pragma unroll
        for (int r = 0; r < 4; ++r) { const float a = __builtin_amdgcn_exp2f(z[st][r] - carry - sf[st][r]); av[r] = (!DIAG || (sb0 + 16 * st + 4 * g + r < t)) ? a : 0.f; }
        pa[st][0] = cvt_pk_bf16(av[0], av[1]); pa[st][1] = cvt_pk_bf16(av[2], av[3]); }
#pragma unroll
    for (int kk = 0; kk < 2; ++kk) { const bf16x8 Aop = mk8(pa[2 * kk][0], pa[2 * kk][1], pa[2 * kk + 1][0], pa[2 * kk + 1][1]);
#pragma unroll
        for (int dt = 0; dt < 4; ++dt) { const LAS unsigned char* vp = lds + AT_VT + (16 * dt + c16) * 136 + (32 * kk + 4 * g) * 2; const u32x2 v0 = *(const LAS u32x2*)vp, v1 = *(const LAS u32x2*)(vp + 32);
            O[dt] = MFMA16(Aop, mk8(v0.x, v0.y, v1.x, v1.y), O[dt]); } }
    carry += bperm_f(sf[0][0], c16);
}
__device__ __forceinline__ void phase_attn(const bf16_t* P, const float* __restrict__ gq, const float* __restrict__ gk, bf16_t* oc, LAS unsigned char* lds, int wg, int G, int tid, int wid, int lane) {
    LAUNDER(tid); LAUNDER(lane);
    const int g = lane >> 4, c16 = lane & 15; LAS float* MINW = (LAS float*)(lds + AT_MIN);
    const unsigned tri_lo = ((4 * g + 0 >= c16) ? 0x3F80u : 0u) | ((4 * g + 1 >= c16) ? 0x3F800000u : 0u), tri_hi = ((4 * g + 2 >= c16) ? 0x3F80u : 0u) | ((4 * g + 3 >= c16) ? 0x3F800000u : 0u);
    for (int item = wg; item < NB * 8 * (SEQ / 128); item += G) {
        const int qt = item & 63, h = (item >> 6) & 7, b = item >> 9; const int t0 = qt * 128, tq0 = t0 + 16 * wid, t = tq0 + c16; const size_t tokb = (size_t)b * SEQ;
        bf16x8 Bq[2];
        { const bf16_t* qp = P + (tokb + t) * PCOLS + C_SQ + h * 64; const uint4 x0 = *(const uint4*)(qp + 8 * g), x1 = *(const uint4*)(qp + 32 + 8 * g);
          float e[16] = {bflo(x0.x), bfhi(x0.x), bflo(x0.y), bfhi(x0.y), bflo(x0.z), bfhi(x0.z), bflo(x0.w), bfhi(x0.w), bflo(x1.x), bfhi(x1.x), bflo(x1.y), bfhi(x1.y), bflo(x1.z), bfhi(x1.z), bflo(x1.w), bfhi(x1.w)};
          float ss = 0.f;
#pragma unroll
          for (int i = 0; i < 16; ++i) ss += e[i] * e[i];
          ss += xor_f<16>(ss); ss += bperm_f(ss, lane ^ 32);
          const float rq = rsqrtf(ss * (1.f / 64.f) + EPS) * (0.125f * 1.4426950408889634f);
#pragma unroll
          for (int i = 0; i < 16; ++i) { const int dd = (i < 8 ? 8 * g + i : 32 + 8 * g + (i - 8)); e[i] = e[i] * rq * gq[dd] * gk[dd]; }
          Bq[0] = mk8(cvt_pk_bf16(e[0], e[1]), cvt_pk_bf16(e[2], e[3]), cvt_pk_bf16(e[4], e[5]), cvt_pk_bf16(e[6], e[7]));
          Bq[1] = mk8(cvt_pk_bf16(e[8], e[9]), cvt_pk_bf16(e[10], e[11]), cvt_pk_bf16(e[12], e[13]), cvt_pk_bf16(e[14], e[15])); }
        f32x4 O[4];
#pragma unroll
        for (int i = 0; i < 4; ++i) O[i] = (f32x4){0.f, 0.f, 0.f, 0.f};
        float carry = 0.f, wmin = 0.f;
        const int ks = tid >> 3, kpc = tid & 7;
        const bf16_t* rp0 = P + (tokb + ks) * PCOLS + h * 64 + kpc * 8;
        uint4 kx = *(const uint4*)(rp0 + (size_t)(((t0 + 127) >> 6) * 64) * PCOLS + C_SK), vx = *(const uint4*)(rp0 + (size_t)(((t0 + 127) >> 6) * 64) * PCOLS + C_SV);
        for (int kb = (t0 + 127) >> 6; kb >= 0; --kb) {
            const int sb0 = kb * 64;
            { const int s = ks, pc = kpc;
              float ke[8] = {bflo(kx.x), bfhi(kx.x), bflo(kx.y), bfhi(kx.y), bflo(kx.z), bfhi(kx.z), bflo(kx.w), bfhi(kx.w)}; float ssk = 0.f;
#pragma unroll
              for (int i = 0; i < 8; ++i) ssk += ke[i] * ke[i];
              ssk += xor_f<1>(ssk); ssk += xor_f<2>(ssk); ssk += xor_f<4>(ssk);
              const float rk = rsqrtf(ssk * (1.f / 64.f) + EPS);
              *(LAS u32x4*)(lds + AT_KL + s * 144 + pc * 16) = (u32x4){cvt_pk_bf16(ke[0] * rk, ke[1] * rk), cvt_pk_bf16(ke[2] * rk, ke[3] * rk), cvt_pk_bf16(ke[4] * rk, ke[5] * rk), cvt_pk_bf16(ke[6] * rk, ke[7] * rk)};
              const unsigned vw[4] = {vx.x, vx.y, vx.z, vx.w};
#pragma unroll
              for (int i = 0; i < 8; ++i) *(LAS bf16_t*)(lds + AT_VT + (pc * 8 + i) * 136 + s * 2) = (bf16_t)((vw[i >> 1] >> ((i & 1) * 16)) & 0xffffu);
              if (kb > 0) { kx = *(const uint4*)(rp0 + (size_t)(sb0 - 64) * PCOLS + C_SK); vx = *(const uint4*)(rp0 + (size_t)(sb0 - 64) * PCOLS + C_SV); } }
            __syncthreads();
            if (sb0 < tq0 + 15 && wmin <= 150.04f) {
                if (sb0 + 63 < tq0) attn_block<false>(lds, Bq, O, carry, sb0, t, g, c16, tri_lo, tri_hi);
                else attn_block<true>(lds, Bq, O, carry, sb0, t, g, c16, tri_lo, tri_hi);
            }
            float mn = carry; mn = fminf(mn, xor_f<1>(mn)); mn = fminf(mn, xor_f<2>(mn)); mn = fminf(mn, xor_f<4>(mn)); mn = fminf(mn, xor_f<8>(mn));
            wmin = __builtin_bit_cast(float, __builtin_amdgcn_readfirstlane(__builtin_bit_cast(int, mn)));
            if (lane == 0) MINW[wid] = mn;
            __syncthreads();
            float mall = MINW[0];
#pragma unroll
            for (int w = 1; w < 8; ++w) mall = fminf(mall, MINW[w]);
            if (mall > 150.04f) break;
        }
#pragma unroll
        for (int dt = 0; dt < 4; ++dt)
#pragma unroll
            for (int r = 0; r < 4; ++r) oc[(tokb + tq0 + 4 * g + r) * 512 + h * 64 + 16 * dt + c16] = f2bf(O[dt][r]);
    }
}

#ifdef MK_CHECK
constexpr size_t WS_DIAG = WS_META + 2048;
constexpr size_t WS_SNAP = WS_BLKE + 4096;
static_assert(WS_SNAP + 64 * 1024 * 4 <= WS_W, "snapshot fits");
__device__ __forceinline__ int samp_row(int i) { return (int)(((unsigned)i * 2654435761u + 12345u) % (unsigned)MTOK); }
__device__ __forceinline__ void chk_fail(unsigned* diag, unsigned code) { atomicMin(diag, code); }
__device__ __forceinline__ bool chk_close(float got, float ref, float atol, float rtol) { return fabsf(got - ref) <= atol + rtol * fabsf(ref) && got == got; }

__global__ void k_diag_init(unsigned* diag) { if (threadIdx.x == 0 && blockIdx.x == 0) { diag[0] = 0xffffffffu; diag[16] = 0u; diag[17] = 0xffffffffu; diag[18] = 0u; diag[19] = 0u; diag[20] = 0u; diag[21] = 0u; diag[22] = 0u; diag[23] = 0u; diag[24] = 0u; diag[25] = 0u; diag[26] = 0u; } }
__global__ void k_snapshot(const float* x, float* snap) { const int i = blockIdx.x; const int r = samp_row(i); for (int c = threadIdx.x; c < D; c += blockDim.x) snap[i * D + c] = x[(size_t)r * D + c]; }
__global__ void k_apply_diag(float* out, const unsigned* diag) {
    if (blockIdx.x != 0 || threadIdx.x != 0) return;
    const unsigned code = diag[0]; if (code == 0xffffffffu) return;
    out[0] = (1.0f + 0.1f * (float)(code > 89u ? 89u : code)) * 1.0e6f;
}
struct ChkGemm { const bf16_t* A; int lda; const float* W; int ldw; int K; int mode; const bf16_t* Cb; int ldc; const float* Cf; const float* xold; const float* W2; const float* lb; const bf16_t* Gsrc; int ncols; unsigned code; int use_snap; };
__global__ void k_chk_gemm(ChkGemm c, unsigned* diag) {
    const int i = blockIdx.x; const int r = samp_row(i);
    for (int cc = threadIdx.x; cc < 96; cc += blockDim.x) {
        const int col = (int)(((unsigned)cc * 40503u + (unsigned)i * 977u) % (unsigned)c.ncols);
        float dot = 0.f, dot2 = 0.f;
        for (int k = 0; k < c.K; ++k) { const float av = bf2f(c.A[(size_t)r * c.lda + k]); dot += av * c.W[(size_t)k * c.ldw + col]; if (c.mode == 4) dot2 += av * c.W2[(size_t)k * c.ldw + col]; }
        float ref, got;
        if (c.mode == 0) { const int kind = col >> 9; ref = (kind == 0 || kind == 3) ? siluf_(dot) : kind == 1 ? __logf(c.lb[col - 512] + (1.f - c.lb[col - 512]) * sigmoidf_(dot)) : (kind == 4 || kind == 5) ? gelu_tanh_(dot) : dot; got = bf2f(c.Cb[(size_t)r * c.ldc + col]); }
        else if (c.mode == 1) { ref = sigmoidf_(dot); got = bf2f(c.Cb[(size_t)r * c.ldc + col]); }
        else if (c.mode == 3) { const float xo = c.use_snap ? c.xold[(size_t)i * D + col] : c.xold[(size_t)r * D + col]; ref = xo + dot; got = c.Cf[(size_t)r * D + col]; }
        else { ref = siluf_(dot) * dot2; got = bf2f(c.Cb[(size_t)r * c.ldc + col]); }
        if (!chk_close(got, ref, 0.03f, 0.03f)) { chk_fail(diag, c.code); if (c.mode == 1) { atomicOr(diag + 24 + (i >> 5), 1u << (i & 31)); atomicOr(diag + 26, 1u << ((r & 255) >> 4)); atomicOr(diag + 20 + ((col & 127) >> 5), 1u << (col & 31)); atomicAdd(diag + 16, 1u); atomicMin(diag + 17, (unsigned)(col >> 8)); atomicMax(diag + 18, (unsigned)(col >> 8)); if (fabsf(got - dot) <= 0.03f + 0.03f * fabsf(dot)) atomicAdd(diag + 19, 1u); } }
    }
}
__global__ void k_chk_branch(const bf16_t* ocat, const float* wbr  , const bf16_t* xn, const float* win  , const bf16_t* GH, unsigned code, unsigned* diag) {
    const int i = blockIdx.x; const int r = samp_row(i);
    for (int cc = threadIdx.x; cc < 96; cc += blockDim.x) {
        const int col = (int)(((unsigned)cc * 40503u + (unsigned)i * 977u) % 3072u); const int b = col >> 10, cl = col & 1023;
        float h = 0.f; for (int k = 0; k < 512; ++k) h += bf2f(ocat[(size_t)b * MTOK * 512 + (size_t)r * 512 + k]) * wbr[((size_t)b * 512 + k) * 1024 + cl];
        float g = 0.f; for (int k = 0; k < 1024; ++k) g += bf2f(xn[(size_t)r * D + k]) * win[(size_t)k * INCOLS + PCOLS + col];
        const float ref = sigmoidf_(g) * h, got = bf2f(GH[(size_t)r * GCOLS + col]);
        if (!chk_close(got, ref, 0.03f, 0.04f)) chk_fail(diag, code);
    }
}
__global__ void k_chk_mix(const bf16_t* ocat, const float* wbr  , const bf16_t* Gt, const bf16_t* mix, unsigned code, unsigned* diag) {
    const int i = blockIdx.x; const int r = samp_row(i);
    for (int cc = threadIdx.x; cc < 96; cc += blockDim.x) {
        const int col = (int)(((unsigned)cc * 40503u + (unsigned)i * 977u) % 1024u); float ref = 0.f;
        for (int b = 0; b < 3; ++b) { float h = 0.f; for (int k = 0; k < 512; ++k) h += bf2f(ocat[(size_t)b * MTOK * 512 + (size_t)r * 512 + k]) * wbr[((size_t)b * 512 + k) * 1024 + col]; ref += bf2f(Gt[(size_t)r * GCOLS + b * 1024 + col]) * h; }
        if (!chk_close(bf2f(mix[(size_t)r * D + col]), ref, 0.03f, 0.04f)) chk_fail(diag, code);
    }
}
__global__ void k_chk_attn(const bf16_t* P, const float* gq, const float* gk, const bf16_t* oc, unsigned code, unsigned* diag) {
    const int id = blockIdx.x, lane = threadIdx.x; const int ti = id % 10;
    const int t = ti == 0 ? 0 : ti == 1 ? 1 : ti == 2 ? 2 : ti == 3 ? 63 : ti == 4 ? 64 : ti == 5 ? 65 : ti == 6 ? 200 : ti == 7 ? 1000 : ti == 8 ? 4097 : 8191;
    const int h = (id / 10) % 8, b = id / 80; const size_t tokb = (size_t)b * SEQ;
    float q = bf2f(P[(tokb + t) * PCOLS + C_SQ + h * 64 + lane]); q = q * rsqrtf(wave_sum(q * q) / 64.f + EPS) * gq[lane];
    float o = 0.f, carry = 0.f;
    for (int s = t - 1; s >= 0 && carry < 300.f; --s) {
        float kv = bf2f(P[(tokb + s) * PCOLS + C_SK + h * 64 + lane]); kv = kv * rsqrtf(wave_sum(kv * kv) / 64.f + EPS) * gk[lane];
        const float z = wave_sum(q * kv) * 0.125f; const float sp = logf(1.f + expf(z));
        carry += sp; const float A = expf(z - carry);
        o += A * bf2f(P[(tokb + s) * PCOLS + C_SV + h * 64 + lane]);
    }
    if (!chk_close(bf2f(oc[(tokb + t) * 512 + h * 64 + lane]), o, 0.02f, 0.03f)) chk_fail(diag, code);
}
__global__ void k_chk_gmlp(const bf16_t* P, const float* ws_l, const float* bs_l, const float* gv_l, const bf16_t* ob, unsigned code, unsigned* diag) {
    const int id = blockIdx.x * blockDim.x + threadIdx.x; if (id >= 512) return;
    const int chunk = (id * 37) % (MTOK / 128), t = (id * 53 + 7) % 128, ch = (id * 101 + 3) % 512, g = ch >> 7, c = ch & 127; const size_t tok0 = (size_t)chunk * 128;
    float acc = 0.f;
    for (int s = 0; s <= t; ++s) { float ss = 0.f; for (int k = 0; k < 512; ++k) { const float v = bf2f(P[(tok0 + s) * PCOLS + C_GV + k]); ss += v * v; }
        const float vn = bf2f(P[(tok0 + s) * PCOLS + C_GV + ch]) * rsqrtf(ss / 512.f + EPS) * gv_l[ch]; acc += ws_l[(size_t)g * 16384 + t * 128 + s] * vn; }
    const float ref = bf2f(P[(tok0 + t) * PCOLS + C_GU + ch]) * (acc + bs_l[g * 128 + t]);
    if (!chk_close(bf2f(ob[(tok0 + t) * 512 + ch]), ref, 0.02f, 0.03f)) chk_fail(diag, code);
}
__global__ void k_chk_hgrn(const bf16_t* P, const float* gain, const bf16_t* oa, unsigned code, unsigned* diag) {
    const int id = blockIdx.x; const int ti = id % 8; const int t = ti == 0 ? 0 : ti == 1 ? 1 : ti == 2 ? 5 : ti == 3 ? 63 : ti == 4 ? 64 : ti == 5 ? 200 : ti == 6 ? 511 : 700, h = (id / 8) % 4, b = id / 32; const int v = threadIdx.x; const size_t tokb = (size_t)b * SEQ;
    float o = 0.f;
    for (int d = 0; d < 128; ++d) { float st = 0.f;
        for (int s = 0; s <= t; ++s) { const bf16_t* row = P + (tokb + s) * PCOLS; const float f = expf(bf2f(row[C_HF + h * 128 + d])); st = f * st + (1.f - f) * bf2f(row[C_HI + h * 128 + v]); }
        o += bf2f(P[(tokb + t) * PCOLS + C_HQ + h * 128 + d]) * st; }
    __shared__ float red[128]; red[v] = o * o; __syncthreads();
    for (int w = 64; w > 0; w >>= 1) { if (v < w) red[v] += red[v + w]; __syncthreads(); }
    const float rstd = rsqrtf(red[0] / 128.f + EPS);
    const float ref = o * rstd * gain[v] * bf2f(P[(tokb + t) * PCOLS + C_HG + h * 128 + v]);
    if (!chk_close(bf2f(oa[(tokb + t) * 512 + h * 128 + v]), ref, 0.03f, 0.04f)) chk_fail(diag, code);
}
__global__ void k_chk_moe(const bf16_t* xn, const float* rw, const float* rb, const float* wg, const float* wu, const float* wd, const float* snap, const float* xout, unsigned code, unsigned* diag) {
    const int i = blockIdx.x; const int r = samp_row(i); const int tid = threadIdx.x;
    __shared__ float hid[DFF]; __shared__ float lg[8]; __shared__ float part[256];
    if (tid < 8) { float a = rb[tid]; for (int k = 0; k < D; ++k) a += bf2f(xn[(size_t)r * D + k]) * rw[k * 8 + tid]; lg[tid] = a; }
    __syncthreads();
    int i0 = 0; for (int e = 1; e < 8; ++e) if (lg[e] > lg[i0]) i0 = e;
    int i1 = -1; for (int e = 0; e < 8; ++e) if (e != i0 && (i1 < 0 || lg[e] > lg[i1])) i1 = e;
    const float w0 = 1.f / (1.f + expf(lg[i1] - lg[i0])), w1 = 1.f - w0;
    float outv[8]; for (int j = 0; j < 8; ++j) outv[j] = 0.f;
    for (int kk = 0; kk < 2; ++kk) { const int e = kk ? i1 : i0; const float wgt = kk ? w1 : w0;
        for (int f = tid; f < DFF; f += blockDim.x) { float g = 0.f, u = 0.f; for (int k = 0; k < D; ++k) { const float xv = bf2f(xn[(size_t)r * D + k]); g += xv * wg[((size_t)e * D + k) * DFF + f]; u += xv * wu[((size_t)e * D + k) * DFF + f]; } hid[f] = siluf_(g) * u; }
        __syncthreads();
        for (int j = 0; j < 8; ++j) { const int col = (j * 131 + i * 17) % D; float p = 0.f; for (int f = tid; f < DFF; f += blockDim.x) p += hid[f] * wd[((size_t)e * DFF + f) * D + col];
            part[tid] = p; __syncthreads(); for (int w = 128; w > 0; w >>= 1) { if (tid < w) part[tid] += part[tid + w]; __syncthreads(); } outv[j] += wgt * part[0]; __syncthreads(); }
    }
    if (tid == 0) for (int j = 0; j < 8; ++j) { const int col = (j * 131 + i * 17) % D; const float ref = snap[(size_t)i * D + col] + outv[j]; if (!chk_close(xout[(size_t)r * D + col], ref, 0.04f, 0.04f)) chk_fail(diag, code); }
}
#endif

struct Args { const float* in[21]; float* out; unsigned char* ws; int lo, hi; };
constexpr int NSTEPS = 25;
__device__ __forceinline__ int laneid_() { int v; asm volatile("v_mbcnt_lo_u32_b32 %0, -1, 0\n\tv_mbcnt_hi_u32_b32 %0, -1, %0" : "=v"(v)); return v; }
#define LANEID (laneid_())

__device__ __forceinline__ int cw_(LAS unsigned* cblk, int i) { unsigned z; asm volatile("v_mov_b32 %0, 0" : "=v"(z)); return (int)__builtin_amdgcn_readfirstlane(((LAS unsigned*)((LAS unsigned char*)cblk + z))[i]); }
template <class Epi, bool VARNT = false, int NSEG = 1>
__device__ __forceinline__ void run_gemm(LAS unsigned char* lds, const Order& S, int K, const Epi& E, int wid) { pg8::gemm_phase<Epi, Order, true, true, VARNT, NSEG>(lds, K, S, E, wid); }

__global__ void __launch_bounds__(NTHREADS, 2) mk_fwd(Args a) {
    extern __shared__ __attribute__((aligned(16))) unsigned char lds_raw[];
    LAS unsigned char* lds = (LAS unsigned char*)lds_raw;
    const int wid = __builtin_amdgcn_readfirstlane((int)threadIdx.x >> 6);
    LAS unsigned* cblk = (LAS unsigned*)(lds + LDS_MISC);
    { const int tid = threadIdx.x;
      if (tid < 4) cblk[tid] = (tid == 2) ? xb_xcc_id() : 0u;
      if (tid < 46) { const unsigned long long pv = (tid < 42) ? (unsigned long long)a.in[tid >> 1] : (tid < 44) ? (unsigned long long)a.out : (unsigned long long)a.ws; cblk[4 + tid] = (tid & 1) ? (unsigned)(pv >> 32) : (unsigned)pv; }
      if (tid == 46) cblk[50] = (unsigned)a.lo; if (tid == 47) cblk[51] = (unsigned)a.hi; }
    __syncthreads();
#define CW(i) cw_(cblk, (i))
typedef __attribute__((address_space(1))) unsigned char gu8_t;
#define ARGP(i) ((unsigned char*)(gu8_t*)(((unsigned long long)(unsigned)CW(5 + 2 * (i)) << 32) | (unsigned long long)(unsigned)CW(4 + 2 * (i))))
#define IN(i) ((const float*)ARGP(i))
#define OUTP ((float*)ARGP(21))
#define WSP (ARGP(22))
#define GSZ ((int)gridDim.x)
#define WGI ((int)blockIdx.x)
    if (CW(51) - CW(50) > 1 && threadIdx.x == 0) (void)xb_add((unsigned*)(WSP + WS_CTL + CW_BAR) + XB_XCNT(CW(2)), 1u);
#ifndef PROBE_REP
#define PROBE_REP 0ull
#endif
#define RUN(k) (CW(50) <= (k) && (k) < CW(51))
#define NREP(bit) (((PROBE_REP >> (bit)) & 1ull) ? 2 : 1)
#define SEAM(k) do { if (CW(50) <= (k) && (k) + 1 < CW(51)) { XcdBarrier bar_; bar_.bar = (unsigned*)(WSP + WS_CTL + CW_BAR); bar_.x = (unsigned)CW(2); bar_.st = (volatile LAS unsigned*)cblk; xcd_barrier(bar_); if (PROBE_REP & (1ull << 40)) xcd_barrier(bar_); } } while (0)

#define XRES (OUTP)
#define WIN ((bf16_t*)(WSP + WS_WIN))
#define WBR ((bf16_t*)(WSP + WS_WBR))
#define WOUT ((bf16_t*)(WSP + WS_WOUT))
#define WGU ((bf16_t*)(WSP + WS_WGU))
#define WDN ((bf16_t*)(WSP + WS_WD))
#define XNB ((bf16_t*)(WSP + WS_XN))
#define PBUF ((bf16_t*)(WSP + WS_P))
#define GBUF ((bf16_t*)(WSP + WS_G))
#define HIDB ((bf16_t*)(WSP + WS_HID))
#define OCATB ((bf16_t*)(WSP + WS_OCAT))
#define MWGU ((bf16_t*)(WSP + WS_MWGU))
#define MWDN ((bf16_t*)(WSP + WS_MWD))
#define XSB ((bf16_t*)(WSP + WS_XS))
#define MHIDB ((bf16_t*)(WSP + WS_MHID))
#define LBB ((float*)(WSP + WS_LB))
#define METAB ((int*)(WSP + WS_META))
#define TOKE ((int*)(WSP + WS_TOKE))
#define TOKW ((float2*)(WSP + WS_TOKW))
#define STOK ((int*)(WSP + WS_SLOTTOK))
#define SWB ((float*)(WSP + WS_SLOTW))
#define BLKE ((int*)(WSP + WS_BLKE))
#define SLABB ((bf16_t*)(WSP + WS_SLAB))
#define HDUMP ((uint2*)(WSP + WS_ORAW))
#define HU ((float*)(WSP + WS_ORAW + HG_DUMP_BYTES))
#define HDSC ((float*)(WSP + WS_ORAW + HG_DUMP_BYTES + HG_U_BYTES))
#define TIDV (wid * 64 + LANEID)
    for (int rep_ = 0; rep_ < NREP(0); ++rep_) if (RUN(0)) {
        LAS float* tile = (LAS float*)lds; const int tid = TIDV;
#pragma unroll 1
        for (int j = 0; j < 13; ++j) {
            const float* src; bf16_t* dst; int K, N, mode = 0, perm = 1;
            if (j < 10) { const int l = j / 5, r = j % 5;
                if (r == 0) { src = IN(2) + (size_t)l * D * INCOLS; dst = WIN + (size_t)l * INCOLS * D; K = D; N = INCOLS; }
                else if (r < 4) { src = IN(10) + (size_t)(l * 3 + r - 1) * 512 * D; dst = WBR + (size_t)(l * 3 + r - 1) * D * 512; K = 512; N = D; }
                else { src = IN(11) + (size_t)l * D * D; dst = WOUT + (size_t)l * D * D; K = D; N = D; perm = 0; } }
            else if (j == 10) { src = IN(13); dst = WGU; K = D; N = DFF; mode = 1; }
            else if (j == 11) { src = IN(14); dst = WGU; K = D; N = DFF; mode = 2; }
            else { src = IN(15); dst = WDN; K = DFF; N = D; perm = 0; }
            tc_job(src, K, N, dst, mode, perm, tile, WGI, GSZ, tid);
        }
        if (WGI == 0) { const float a0 = IN(3)[tid], a1 = IN(3)[512 + tid]; LBB[tid] = 0.f; LBB[512 + tid] = sigmoidf_(a1 - a0); }
    }
    if (RUN(0)) { __syncthreads(); phase_rmsnorm<false>(IN(0), IN(1), XNB, nullptr, nullptr, nullptr, nullptr, WGI, GSZ, wid, LANEID); }
    SEAM(0);

    for (int l = 0; l < 2; ++l) {
        const int sb = l * 10;
        if (l == 1) { for (int rep_ = 0; rep_ < NREP(1); ++rep_) if (RUN(10)) phase_rmsnorm<false>(XRES, IN(1) + D, XNB, nullptr, nullptr, nullptr, nullptr, WGI, GSZ, wid, LANEID); SEAM(10); }
        for (int rep_ = 0; rep_ < NREP(2); ++rep_) if (RUN(sb + 1)) { Order S; S.init(XNB, WIN + (size_t)l * INCOLS * D, MTOK, PCOLS, D, GSZ, WGI); EpiAct E{PBUF, PCOLS, LBB + l * 512, 1}; run_gemm(lds, S, D, E, wid); }
        SEAM(sb + 1);
        for (int rep_ = 0; rep_ < NREP(3); ++rep_) if (RUN(sb + 2)) {
            for (int r2 = 0; r2 < NREP(13); ++r2) { phase_hgrn_a(PBUF, OCATB, HDUMP, HU, HDSC, lds, WGI, GSZ, TIDV, wid, LANEID);
            __syncthreads(); }
            for (int r2 = 0; r2 < NREP(14); ++r2) { phase_attn(PBUF, IN(8) + l * 64, IN(9) + l * 64, OCATB + (size_t)2 * MTOK * 512, lds, WGI, GSZ, TIDV, wid, LANEID);
            __syncthreads(); }
            for (int r2 = 0; r2 < NREP(15); ++r2) { phase_gmlp(PBUF, IN(6) + (size_t)l * 4 * 16384, IN(7) + l * 512, IN(5) + l * 512, OCATB + (size_t)MTOK * 512, lds, WGI, GSZ, TIDV, wid, LANEID); __syncthreads(); }
        }
        SEAM(sb + 2);
        if (RUN(sb + 3)) phase_hgrn_c(PBUF, OCATB, HDUMP, HU, HDSC, IN(4) + l * 128, lds, WGI, GSZ, TIDV, wid, LANEID);
        SEAM(sb + 3);
        for (int rep_ = 0; rep_ < NREP(4); ++rep_) if (RUN(sb + 4)) { Order S; S.init(XNB, WIN + (size_t)l * INCOLS * D + (size_t)PCOLS * D, MTOK, GCOLS, D, GSZ, WGI); EpiAct E{GBUF, GCOLS, nullptr, 0}; run_gemm(lds, S, D, E, wid); }
        SEAM(sb + 4);
        for (int rep_ = 0; rep_ < NREP(12); ++rep_) if (RUN(sb + 5)) { Order S; S.init(OCATB, WBR + (size_t)l * 3 * D * 512, MTOK, GCOLS, 512, GSZ, WGI, 4, (size_t)MTOK * 512 * 2, (size_t)D * 512 * 2); EpiBranchSeg E{GBUF, XNB}; run_gemm<EpiBranchSeg, false, 3>(lds, S, 512, E, wid); }
        SEAM(sb + 5);
        if (RUN(sb + 6)) { Order S; S.init(XNB, WOUT + (size_t)l * D * D, MTOK, D, D, GSZ, WGI); EpiResid E{(l == 0) ? IN(0) : (const float*)XRES, XRES}; run_gemm(lds, S, D, E, wid); }
        SEAM(sb + 6);
        if (l == 0) {
            for (int rep_ = 0; rep_ < NREP(6); ++rep_) if (RUN(7)) phase_rmsnorm<false>(XRES, IN(12), XNB, nullptr, nullptr, nullptr, nullptr, WGI, GSZ, wid, LANEID);
            SEAM(7);
            for (int rep_ = 0; rep_ < NREP(7); ++rep_) if (RUN(8)) { Order S; S.init(XNB, WGU, MTOK, 2 * DFF, D, GSZ, WGI); EpiGU E{HIDB}; run_gemm(lds, S, D, E, wid); }
            SEAM(8);
            if (RUN(9)) { Order S; S.init(HIDB, WDN, MTOK, D, DFF, GSZ, WGI); EpiResid E{XRES, XRES}; run_gemm(lds, S, DFF, E, wid); }
            SEAM(9);
        } else {
            for (int rep_ = 0; rep_ < NREP(8); ++rep_) if (RUN(17)) phase_rmsnorm<true>(XRES, IN(12) + D, XNB, IN(16), IN(17), TOKE, TOKW, WGI, GSZ, wid, LANEID);
            SEAM(17);
            for (int rep_ = 0; rep_ < NREP(9); ++rep_) if (RUN(18)) {
                if (WGI == GSZ - 1) moe_assign(TOKE, TOKW, METAB, STOK, SWB, BLKE, lds, TIDV);
                else { LAS float* tile = (LAS float*)lds; const int tid = TIDV;
#pragma unroll 1
                    for (int j = 0; j < 3 * NEXP; ++j) { const int e = j / 3, r = j % 3;
                        const float* src = (r == 0 ? IN(18) : r == 1 ? IN(19) : IN(20)) + (size_t)e * D * DFF;
                        bf16_t* dst = (r == 2) ? MWDN + (size_t)e * D * DFF : MWGU + (size_t)e * 2 * DFF * D;
                        tc_job(src, r == 2 ? DFF : D, r == 2 ? D : DFF, dst, r == 2 ? 0 : r + 1, r == 2 ? 0 : 1, tile, WGI, GSZ - 1, tid); } }
            }
            SEAM(18);
#define META(i) __hip_atomic_load(METAB + (i), __ATOMIC_RELAXED, __HIP_MEMORY_SCOPE_AGENT)
            if (RUN(19)) { const int rows = META(0), s0 = META(2); moe_gather(XNB, STOK + s0, rows, XSB, WGI, GSZ, wid, LANEID); }
            SEAM(19);
            for (int kc = 0; kc < 2; ++kc) {
                const int se = 20 + 2 * kc;
                for (int rep_ = 0; rep_ < NREP(11); ++rep_) if (RUN(se)) { const int rows = META(kc), s0 = META(2 + kc);
                    if (kc == 1) { const int rows0 = META(0), s00 = META(2); Order T; T.init(MHIDB, MWDN, rows0, D, DFF, GSZ, WGI, 2, 0, (size_t)D * DFF * 2, BLKE + (s00 >> 8), 1);
                        moe_tail_reduce(T, SLABB, XRES, STOK + s00, SWB + s00, WGI, GSZ, wid, LANEID); }
                    Order S; S.init(XSB, MWGU, rows, 2 * DFF, D, GSZ, WGI, 2, 0, (size_t)2 * DFF * D * 2, BLKE + (s0 >> 8)); EpiGU E{MHIDB}; run_gemm(lds, S, D, E, wid); }
                SEAM(se);
                if (RUN(se + 1)) { const int rows = META(kc), s0 = META(2 + kc);
                    Order S; S.init(MHIDB, MWDN, rows, D, DFF, GSZ, WGI, 2, 0, (size_t)D * DFF * 2, BLKE + (s0 >> 8), 1); EpiMoeDown E{XRES, STOK + s0, SWB + s0, SLABB}; run_gemm<EpiMoeDown, true>(lds, S, DFF, E, wid);
                    if (kc == 0) { const int rows1 = META(1), s1 = META(3); moe_gather(XNB, STOK + s1, rows1, XSB, WGI, GSZ, wid, LANEID); } }
                SEAM(se + 1);
            }
            if (RUN(24)) { const int rows1 = META(1), s1 = META(3); Order T; T.init(MHIDB, MWDN, rows1, D, DFF, GSZ, WGI, 2, 0, (size_t)D * DFF * 2, BLKE + (s1 >> 8), 1);
                moe_tail_reduce(T, SLABB, XRES, STOK + s1, SWB + s1, WGI, GSZ, wid, LANEID); }
        }
    }
}

extern "C" void kernel_launch(void* const* d_in, const int* in_sizes, int n_in, void* d_out, int out_size, void* d_ws, size_t ws_size, hipStream_t stream) {
    static int grid = 0;
    if (grid == 0) {
        if (n_in != 21 || out_size != MTOK * D || ws_size < WS_NEED) { fprintf(stderr, "kernel_launch: unexpected shapes (n_in %d out %d ws %zu need %zu)\n", n_in, out_size, ws_size, (size_t)WS_NEED); grid = -1; return; }
        int dev = 0, cus = 0, per_cu = 0;
        if (hipGetDevice(&dev) != hipSuccess || hipDeviceGetAttribute(&cus, hipDeviceAttributeMultiprocessorCount, dev) != hipSuccess) { grid = -1; return; }
        if (hipFuncSetAttribute((const void*)mk_fwd, hipFuncAttributeMaxDynamicSharedMemorySize, LDS_BYTES) != hipSuccess) { fprintf(stderr, "kernel_launch: hipFuncSetAttribute failed\n"); grid = -1; return; }
        if (hipOccupancyMaxActiveBlocksPerMultiprocessor(&per_cu, (const void*)mk_fwd, NTHREADS, LDS_BYTES) != hipSuccess || per_cu < 1) { fprintf(stderr, "kernel_launch: occupancy query says %d\n", per_cu); (void)hipGetLastError(); per_cu = 1; }
        grid = cus;
    }
    if (grid < 0) return;
    (void)hipMemsetAsync((char*)d_ws + WS_CTL, 0, CTL_BYTES, stream);
    Args a{};
    for (int i = 0; i < 21; ++i) a.in[i] = (const float*)d_in[i];
    a.out = (float*)d_out; a.ws = (unsigned char*)d_ws;
#if defined(MK_CHECK)
    {
        unsigned char* ws = (unsigned char*)d_ws; unsigned* diag = (unsigned*)(ws + WS_DIAG); float* snap = (float*)(ws + WS_SNAP);
        const bf16_t* XN = (const bf16_t*)(ws + WS_XN); const bf16_t* Pb = (const bf16_t*)(ws + WS_P); const bf16_t* OC = (const bf16_t*)(ws + WS_OCAT); const float* LB = (const float*)(ws + WS_LB);
        auto run = [&](int s) { a.lo = s; a.hi = s + 1; hipLaunchKernelGGL(mk_fwd, dim3(grid), dim3(NTHREADS), LDS_BYTES, stream, a); };
        hipLaunchKernelGGL(k_diag_init, dim3(1), dim3(64), 0, stream, diag);
        int s = 0; run(s++);
        for (int l = 0; l < 2; ++l) {
            const unsigned cb = l * 10;
            const float* win = a.in[2] + (size_t)l * D * INCOLS;
            if (l == 1) run(s++);
            run(s++);
            { ChkGemm c{}; c.A = XN; c.lda = D; c.W = win; c.ldw = INCOLS; c.K = D; c.mode = 0; c.Cb = Pb; c.ldc = PCOLS; c.lb = LB + l * 512; c.ncols = PCOLS; c.code = cb + 1; hipLaunchKernelGGL(k_chk_gemm, dim3(64), dim3(96), 0, stream, c, diag); }
            run(s++); run(s++);
            hipLaunchKernelGGL(k_chk_hgrn, dim3(128), dim3(128), 0, stream, Pb, a.in[4] + l * 128, OC, cb + 2, diag);
            hipLaunchKernelGGL(k_chk_gmlp, dim3(8), dim3(64), 0, stream, Pb, a.in[6] + (size_t)l * 4 * 16384, a.in[7] + l * 512, a.in[5] + l * 512, OC + (size_t)MTOK * 512, cb + 3, diag);
            hipLaunchKernelGGL(k_chk_attn, dim3(320), dim3(64), 0, stream, Pb, a.in[8] + l * 64, a.in[9] + l * 64, OC + (size_t)2 * MTOK * 512, cb + 4, diag);
            run(s++);
            { ChkGemm c{}; c.A = XN; c.lda = D; c.W = win + PCOLS; c.ldw = INCOLS; c.K = D; c.mode = 1; c.Cb = (const bf16_t*)(ws + WS_G); c.ldc = GCOLS; c.ncols = GCOLS; c.code = cb + 5; hipLaunchKernelGGL(k_chk_gemm, dim3(64), dim3(96), 0, stream, c, diag); }
            run(s++);
            hipLaunchKernelGGL(k_chk_mix, dim3(64), dim3(96), 0, stream, OC, a.in[10] + (size_t)l * 3 * 512 * D, (const bf16_t*)(ws + WS_G), XN, cb + 6, diag);
            if (l == 1) hipLaunchKernelGGL(k_snapshot, dim3(64), dim3(256), 0, stream, (const float*)d_out, snap);
            run(s++);
            { ChkGemm c{}; c.A = XN; c.lda = D; c.W = a.in[11] + (size_t)l * D * D; c.ldw = D; c.K = D; c.mode = 3; c.Cf = (const float*)d_out; c.xold = l ? snap : a.in[0]; c.use_snap = l; c.ncols = D; c.code = cb + 7; hipLaunchKernelGGL(k_chk_gemm, dim3(64), dim3(96), 0, stream, c, diag); }
            run(s++);
            if (l == 0) {
                run(s++);
                { ChkGemm c{}; c.A = XN; c.lda = D; c.W = a.in[13]; c.W2 = a.in[14]; c.ldw = DFF; c.K = D; c.mode = 4; c.Cb = (const bf16_t*)(ws + WS_HID); c.ldc = DFF; c.ncols = DFF; c.code = cb + 8; hipLaunchKernelGGL(k_chk_gemm, dim3(64), dim3(96), 0, stream, c, diag); }
                hipLaunchKernelGGL(k_snapshot, dim3(64), dim3(256), 0, stream, (const float*)d_out, snap);
                run(s++);
                { ChkGemm c{}; c.A = (const bf16_t*)(ws + WS_HID); c.lda = DFF; c.W = a.in[15]; c.ldw = D; c.K = DFF; c.mode = 3; c.Cf = (const float*)d_out; c.xold = snap; c.use_snap = 1; c.ncols = D; c.code = cb + 9; hipLaunchKernelGGL(k_chk_gemm, dim3(64), dim3(96), 0, stream, c, diag); }
            } else {
                hipLaunchKernelGGL(k_snapshot, dim3(64), dim3(256), 0, stream, (const float*)d_out, snap);
                for (int e = 0; e < 7; ++e) run(s++);
                hipLaunchKernelGGL(k_chk_moe, dim3(16), dim3(256), 0, stream, XN, a.in[16], a.in[17], a.in[18], a.in[19], a.in[20], (const float*)snap, (const float*)d_out, 20u, diag);
            }
        }
        if (s != NSTEPS) fprintf(stderr, "step count mismatch %d\n", s);
        hipLaunchKernelGGL(k_apply_diag, dim3(1024), dim3(256), 0, stream, (float*)d_out, (const unsigned*)diag);
    }
#elif !defined(MK_ONE_LAUNCH)
    for (int s = 0; s < NSTEPS; ++s) { a.lo = s; a.hi = s + 1; hipLaunchKernelGGL(mk_fwd, dim3(grid), dim3(NTHREADS), LDS_BYTES, stream, a); }
#else
    a.lo = 0; a.hi = NSTEPS; hipLaunchKernelGGL(mk_fwd, dim3(grid), dim3(NTHREADS), LDS_BYTES, stream, a);
#endif
}
```

```cpp
#define MK_ONE_LAUNCH 1
#include <hip/hip_runtime.h>
#include <cstdio>
#include <cstdint>
#include <cstddef>

#define LAS __attribute__((address_space(3)))
#define XB_TMO      128
#define XB_XCNT(j)  (256  + 64 * (j))
#define XB_XSUB(j)  (1280 + 64 * (j))
#define XB_XGEN(j)  (2304 + 64 * (j))
#define XB_TOP      3328
#define XB_TOPGEN   3392
#define XCD_BAR_WORDS 3456
#define XB_SPIN_CAP (1u << 18)

__device__ __forceinline__ unsigned xb_ld(unsigned* p)              { return __hip_atomic_load(p, __ATOMIC_RELAXED, __HIP_MEMORY_SCOPE_AGENT); }
__device__ __forceinline__ unsigned xb_add(unsigned* p, unsigned v) { return __hip_atomic_fetch_add(p, v, __ATOMIC_RELAXED, __HIP_MEMORY_SCOPE_AGENT); }
__device__ __forceinline__ unsigned xb_xcc_id() { return (unsigned)__builtin_amdgcn_s_getreg((3 << 11) | 20) & 0xFu; }
#define XB_SPIN(cond, bar) do { unsigned _sp = 0; while (cond) { __builtin_amdgcn_s_sleep(1); \
    if ((++_sp & 255u) == 0u) { if (xb_ld(&(bar)[XB_TMO])) break; if (_sp > XB_SPIN_CAP) { atomicAdd(&(bar)[XB_TMO], 1u); break; } } } } while (0)

struct XcdBarrier {
    unsigned* bar; unsigned x;
    volatile LAS unsigned* st;
};

__device__ __forceinline__ XcdBarrier xcd_barrier_post(unsigned* bar, volatile LAS unsigned* st) {
    XcdBarrier b; b.bar = bar; b.x = xb_xcc_id(); b.st = st;
    if (threadIdx.x == 0) (void)xb_add(&bar[XB_XCNT(b.x)], 1u);
    return b;
}
__device__ __forceinline__ void xcd_barrier_complete(unsigned* bar, unsigned x, unsigned& nloc, unsigned& nx) {
    const unsigned G = gridDim.x * gridDim.y * gridDim.z;
    unsigned sum, cnt, mine, sp = 0u;
    for (;;) {
        sum = 0u; cnt = 0u; mine = 0u;
#pragma unroll
        for (unsigned j = 0; j < 16; ++j) { const unsigned c = xb_ld(&bar[XB_XCNT(j)]); sum += c; cnt += (c > 0u) ? 1u : 0u; mine = (j == x) ? c : mine; }
        if (sum == G) break;
        __builtin_amdgcn_s_sleep(1);
        if ((++sp & 255u) == 0u) { if (xb_ld(&bar[XB_TMO])) break; if (sp > XB_SPIN_CAP) { atomicAdd(&bar[XB_TMO], 1u); break; } }
    }
    nloc = mine > 0u ? mine : 1u; nx = cnt > 0u ? cnt : 1u;
}

__device__ __forceinline__ void xcd_barrier(const XcdBarrier& b) {
    asm volatile("s_waitcnt vmcnt(0)" ::: "memory");
    __syncthreads();
    if (threadIdx.x == 0) {
        unsigned* bar = b.bar;
        __builtin_amdgcn_s_waitcnt(0);
        unsigned nloc = b.st[0], nx = b.st[1];
        if (nloc == 0u) { xcd_barrier_complete(bar, b.x, nloc, nx); b.st[0] = nloc; b.st[1] = nx; }
        __builtin_amdgcn_fence(__ATOMIC_RELEASE, "agent");
        asm volatile("s_waitcnt vmcnt(0)" ::: "memory");
        const unsigned old = xb_add(&bar[XB_XSUB(b.x)], 1u);
        const unsigned gen = old / nloc;
        if (old + 1u == (gen + 1u) * nloc) {
            __builtin_amdgcn_fence(__ATOMIC_RELEASE, "agent");
            asm volatile("s_waitcnt vmcnt(0)" ::: "memory");
            const unsigned og = xb_add(&bar[XB_TOP], 1u);
            const unsigned tg = og / nx;
            if (og + 1u == (tg + 1u) * nx) xb_add(&bar[XB_TOPGEN], 1u);
            else XB_SPIN(xb_ld(&bar[XB_TOPGEN]) == tg, bar);
            __builtin_amdgcn_fence(__ATOMIC_ACQUIRE, "agent");
            xb_add(&bar[XB_XGEN(b.x)], 1u);
            asm volatile("s_waitcnt vmcnt(0)" ::: "memory");
        } else {
            XB_SPIN(xb_ld(&bar[XB_XGEN(b.x)]) == gen, bar);
            __builtin_amdgcn_fence(__ATOMIC_ACQUIRE, "agent");
            asm volatile("s_waitcnt vmcnt(0)" ::: "memory");
        }
    }
    __syncthreads();
}
#ifndef KLOOP_REP
#define KLOOP_REP 1
#endif
#ifndef EPI_REP
#define EPI_REP 1
#endif
namespace pg8 {
#define PG8_LAS __attribute__((address_space(3)))
typedef unsigned short bf16_t;
typedef short bf16x8 __attribute__((ext_vector_type(8)));
typedef float f32x4 __attribute__((ext_vector_type(4)));
typedef unsigned u32x4 __attribute__((ext_vector_type(4)));
constexpr int BM = 256, BK = 64, HALF = 128, HTB = HALF * BK * 2  , STAGE_BYTES = 8 * HTB, NXCD = 8, WGM = 8;

__host__ __device__ __forceinline__ int lds_byte(int r, int c) { const int st = (r >> 4) * 2 + (c >> 5), rr = r & 15, cc = c & 31, ob = rr * 64 + cc * 2; return st * 1024 + (ob ^ (((ob >> 9) & 1) << 5)); }
__host__ __device__ __forceinline__ void stage_rc(int b, int& R, int& C) { const int st = b / 1024, sb = b % 1024, swz = sb ^ (((sb >> 9) & 1) << 5); R = (st >> 1) * 16 + swz / 64; C = (st & 1) * 32 + (swz % 64) / 2; }
__host__ __device__ __forceinline__ int perm32(int rho) { const int n = rho >> 4, i = rho & 15; return 8 * (i >> 2) + 4 * n + (i & 3); }

struct Unit { int pm, pn; const char* a; const char* b; int nt, atomic; };

typedef float f32x2 __attribute__((ext_vector_type(2))); typedef __bf16 bf16x2_t __attribute__((ext_vector_type(2)));
__device__ __forceinline__ unsigned cvt_pk_bf16(float lo, float hi) { f32x2 v = {lo, hi}; bf16x2_t b = __builtin_convertvector(v, bf16x2_t); return __builtin_bit_cast(unsigned, b); }
template <class Epi, class Sched, bool ALIGN_EPI = false, bool SP2 = false, bool VARNT = false, int NSEG = 1, bool FP8 = false>
__device__ __forceinline__ void gemm_phase(PG8_LAS unsigned char* lds, const int K, const Sched& S, const Epi& E, const int wid) {
    int lane; asm volatile("v_mbcnt_lo_u32_b32 %0, -1, 0\n\tv_mbcnt_hi_u32_b32 %0, -1, %0" : "=v"(lane));
    const int tid = wid * 64 + lane, wr = wid >> 2, wc = wid & 3, fr = lane & 15, fq = lane >> 4;
    unsigned voffA[2];
#pragma unroll
    for (int i = 0; i < 2; ++i) { int R, C; stage_rc(tid * 16 + i * 8192, R, C); voffA[i] = FP8 ? (unsigned)(R * K + 2 * C) : (unsigned)(R * K + C) * 2u; }
    const size_t kstep = (size_t)(BK * 2);
    const size_t hstep = (size_t)HALF * K * (FP8 ? 1 : 2);
    const unsigned ldsw = (unsigned)wid * 1024u;
    const int aoff = FP8 ? lds_byte(wr * 64 + fr, fq * 16) : lds_byte(wr * 64 + fr, fq * 8), boff = FP8 ? lds_byte(wc * 32 + fr, fq * 16) : lds_byte(wc * 32 + fr, fq * 8);
    constexpr int KOFF = FP8 ? 16 : 1024;
    const int asw = FP8 ? (fq & 1) * 16 : 0;
    const int aoff1 = FP8 ? (aoff + (asw ^ 16)) : (aoff + KOFF), boff1 = FP8 ? (boff + (asw ^ 16)) : (boff + KOFF);
    const int aoff0 = aoff + asw, boff0 = boff + asw;
#define PG8_SA(b, h) (((b) * 2 + (h)) * HTB)
#define PG8_SB(b, h) ((4 + (b) * 2 + (h)) * HTB)
#define PG8_STAGE(bufoff, gbase, voff) do { _Pragma("unroll") for (int _i = 0; _i < 2; ++_i) { unsigned _vo = (voff)[_i]; asm volatile("" : "+v"(_vo));     \
        __builtin_amdgcn_global_load_lds((const unsigned*)((const char*)(gbase) + _vo), (PG8_LAS unsigned*)(lds + (bufoff) + ldsw + _i * 8192), 16, 0, 0); } } while (0)
#define PG8_LDA(dst, b, h) do { _Pragma("unroll") for (int m = 0; m < 4; ++m) _Pragma("unroll") for (int k = 0; k < 2; ++k) dst[m][k] = *(const PG8_LAS bf16x8*)(lds + PG8_SA(b, h) + (k ? aoff1 : aoff0) + m * 2048); } while (0)
#define PG8_LDB(dst, b, h) do { _Pragma("unroll") for (int n = 0; n < 2; ++n) _Pragma("unroll") for (int k = 0; k < 2; ++k) dst[n][k] = *(const PG8_LAS bf16x8*)(lds + PG8_SB(b, h) + (k ? boff1 : boff0) + n * 2048); } while (0)
#define PG8_MMA(ai, bj, At, Bt) do { __builtin_amdgcn_s_setprio(1); _Pragma("unroll") for (int m = 0; m < 4; ++m) _Pragma("unroll") for (int n = 0; n < 2; ++n) { \
        if constexpr (FP8) { typedef int v8i_ __attribute__((ext_vector_type(8))); struct P2_ { bf16x8 lo, hi; }; \
            const v8i_ b8_ = __builtin_bit_cast(v8i_, (P2_){Bt[n][0], Bt[n][1]}), a8_ = __builtin_bit_cast(v8i_, (P2_){At[m][0], At[m][1]}); \
            acc[ai][bj][m][n] = __builtin_amdgcn_mfma_scale_f32_16x16x128_f8f6f4(b8_, a8_, acc[ai][bj][m][n], 0, 0, 0, 0x79797979, 0, 0x7F7F7F7F); } \
        else { _Pragma("unroll") for (int k = 0; k < 2; ++k) acc[ai][bj][m][n] = __builtin_amdgcn_mfma_f32_16x16x32_bf16(Bt[n][k], At[m][k], acc[ai][bj][m][n], 0, 0, 0); } } \
        __builtin_amdgcn_s_setprio(0); } while (0)
#define PG8_WAIT_V(n) asm volatile("s_waitcnt vmcnt(" #n ")" ::: "memory")
#define PG8_WAIT_L(n) asm volatile("s_waitcnt lgkmcnt(" #n ")" ::: "memory")
#define PG8_BAR __builtin_amdgcn_s_barrier()
#define PG8_SCHED __builtin_amdgcn_sched_barrier(0)
    Unit cur, nxt; int ui = 0;
    if (!S.next(0, cur)) return;
    f32x4 acc[2][2][4][2];
#pragma unroll
    for (int a = 0; a < 2; ++a)
#pragma unroll
        for (int b = 0; b < 2; ++b)
#pragma unroll
            for (int m = 0; m < 4; ++m)
#pragma unroll
                for (int n = 0; n < 2; ++n) acc[a][b][m][n] = (f32x4){0.f, 0.f, 0.f, 0.f};
    bf16x8 At[4][2], B0[2][2], B1[2][2];
    const char* cA = cur.a; const char* cB = cur.b;
    S.a_ready(cur);
    if constexpr (SP2) {
        PG8_STAGE(PG8_SB(0, 0), cB, voffA); PG8_STAGE(PG8_SB(0, 1), cB + hstep, voffA); PG8_STAGE(PG8_SA(0, 0), cA, voffA); PG8_STAGE(PG8_SA(0, 1), cA + hstep, voffA);
        if (wr == 1) PG8_BAR;
        PG8_WAIT_V(2); PG8_BAR;
        PG8_STAGE(PG8_SB(1, 0), cB + kstep, voffA); PG8_STAGE(PG8_SA(1, 0), cA + kstep, voffA); PG8_STAGE(PG8_SB(1, 1), cB + hstep + kstep, voffA);
        PG8_WAIT_V(6); PG8_BAR;
    } else {
        PG8_STAGE(PG8_SB(0, 0), cB, voffA); PG8_STAGE(PG8_SA(0, 0), cA, voffA); PG8_STAGE(PG8_SB(0, 1), cB + hstep, voffA); PG8_STAGE(PG8_SA(0, 1), cA + hstep, voffA);
        if (wr == 1) PG8_BAR;
        PG8_WAIT_V(4); PG8_BAR;
        PG8_STAGE(PG8_SB(1, 0), cB + kstep, voffA); PG8_STAGE(PG8_SA(1, 0), cA + kstep, voffA); PG8_STAGE(PG8_SB(1, 1), cB + hstep + kstep, voffA);
        PG8_WAIT_V(6); PG8_BAR;
    }
    for (;;) {
        const bool has_next = S.next(ui + 1, nxt);
        const char* nA = has_next ? nxt.a : cA; const char* nB = has_next ? nxt.b : cB;
        const int nt = VARNT ? cur.nt : NSEG * (K / (FP8 ? 128 : BK)); constexpr bool SEGD = (NSEG > 1); const int KT = K / BK;
#if KLOOP_REP > 1
        int krep_ = KLOOP_REP; asm volatile("" : "+s"(krep_));
        const char* nA0_ = nA; const char* nB0_ = nB;
_Pragma("unroll 1")
        for (int kr_ = 0; kr_ < krep_; ++kr_) {
        if (kr_ > 0) {
_Pragma("unroll")
            for (int a = 0; a < 2; ++a)
_Pragma("unroll")
                for (int b = 0; b < 2; ++b)
_Pragma("unroll")
                    for (int m = 0; m < 4; ++m)
_Pragma("unroll")
                        for (int n = 0; n < 2; ++n) acc[a][b][m][n] = (f32x4){0.f, 0.f, 0.f, 0.f}; }
        nA = (kr_ == krep_ - 1) ? nA0_ : cA; nB = (kr_ == krep_ - 1) ? nB0_ : cB;
#endif
#pragma unroll 1
        for (int t = 0; t < nt; t += 2) {
            const bool last = (t == nt - 2);
            const char* a1 = SEGD ? cA + (size_t)((t + 1) / KT) * S.abr + (size_t)((t + 1) % KT) * kstep : cA + (size_t)(t + 1) * kstep;
            const char* a2 = last ? nA : (SEGD ? cA + (size_t)((t + 2) / KT) * S.abr + (size_t)((t + 2) % KT) * kstep : cA + (size_t)(t + 2) * kstep);
            const char* b2 = last ? nB : (SEGD ? cB + (size_t)((t + 2) / KT) * S.bbr + (size_t)((t + 2) % KT) * kstep : cB + (size_t)(t + 2) * kstep);
            const char* a3 = a2 + kstep; const char* b3 = b2 + kstep;
            if (last && has_next) S.a_ready(nxt);
            if constexpr (SP2) {
            PG8_LDB(B0, 0, 0); PG8_LDB(B1, 0, 1); PG8_SCHED; PG8_LDA(At, 0, 0); PG8_STAGE(PG8_SA(1, 1), a1 + hstep, voffA);
            PG8_WAIT_V(8); PG8_WAIT_L(0); PG8_BAR; PG8_MMA(0, 0, At, B0); PG8_MMA(0, 1, At, B1); PG8_BAR; PG8_SCHED;
            PG8_LDA(At, 0, 1); PG8_STAGE(PG8_SB(0, 0), b2, voffA); PG8_STAGE(PG8_SB(0, 1), b2 + hstep, voffA); PG8_STAGE(PG8_SA(0, 0), a2, voffA);
            PG8_WAIT_V(8); PG8_WAIT_L(0); PG8_BAR; PG8_MMA(1, 0, At, B0); PG8_MMA(1, 1, At, B1); PG8_BAR; PG8_SCHED;
            PG8_LDB(B0, 1, 0); PG8_LDB(B1, 1, 1); PG8_SCHED; PG8_LDA(At, 1, 0); PG8_STAGE(PG8_SA(0, 1), a2 + hstep, voffA);
            PG8_WAIT_V(8); PG8_WAIT_L(0); PG8_BAR; PG8_MMA(0, 0, At, B0); PG8_MMA(0, 1, At, B1); PG8_BAR; PG8_SCHED;
            PG8_LDA(At, 1, 1); PG8_STAGE(PG8_SB(1, 0), b3, voffA); PG8_STAGE(PG8_SB(1, 1), b3 + hstep, voffA); PG8_STAGE(PG8_SA(1, 0), a3, voffA);
            PG8_WAIT_V(8); PG8_WAIT_L(0); PG8_BAR; PG8_MMA(1, 0, At, B0); PG8_MMA(1, 1, At, B1); PG8_BAR; PG8_SCHED;
            } else {
            PG8_LDB(B0, 0, 0); PG8_SCHED; PG8_LDA(At, 0, 0); PG8_STAGE(PG8_SA(1, 1), a1 + hstep, voffA);
            PG8_WAIT_L(8); PG8_BAR; PG8_WAIT_L(0); PG8_MMA(0, 0, At, B0); PG8_BAR; PG8_SCHED;
            PG8_LDB(B1, 0, 1); PG8_STAGE(PG8_SB(0, 0), b2, voffA);
            PG8_BAR; PG8_WAIT_L(0); PG8_MMA(0, 1, At, B1); PG8_BAR;
            PG8_LDA(At, 0, 1); PG8_STAGE(PG8_SA(0, 0), a2, voffA);
            PG8_BAR; PG8_WAIT_L(0); PG8_MMA(1, 0, At, B0); PG8_BAR; PG8_SCHED;
            PG8_STAGE(PG8_SB(0, 1), b2 + hstep, voffA);
            PG8_WAIT_V(6); PG8_BAR; PG8_MMA(1, 1, At, B1); PG8_BAR;
            PG8_LDB(B0, 1, 0); PG8_SCHED; PG8_LDA(At, 1, 0); PG8_STAGE(PG8_SA(0, 1), a2 + hstep, voffA);
            PG8_WAIT_L(8); PG8_BAR; PG8_WAIT_L(0); PG8_MMA(0, 0, At, B0); PG8_BAR; PG8_SCHED;
            PG8_LDB(B1, 1, 1); PG8_STAGE(PG8_SB(1, 0), b3, voffA);
            PG8_BAR; PG8_WAIT_L(0); PG8_MMA(0, 1, At, B1); PG8_BAR;
            PG8_LDA(At, 1, 1); PG8_STAGE(PG8_SA(1, 0), a3, voffA);
            PG8_BAR; PG8_WAIT_L(0); PG8_MMA(1, 0, At, B0); PG8_BAR; PG8_SCHED;
            PG8_STAGE(PG8_SB(1, 1), b3 + hstep, voffA);
            PG8_WAIT_V(6); PG8_BAR; PG8_MMA(1, 1, At, B1); PG8_BAR;
            }
            if constexpr (SEGD) { if (((t + 2) % KT) == 0 && t + 2 < nt) E.mid(acc, cur, (t + 2) / KT - 1, wr, wc, fr, fq);
            }
        }
#if KLOOP_REP > 1
        }
#endif
        if constexpr (ALIGN_EPI) { if (wr == 0) PG8_BAR; }
        if constexpr (!Epi::AFTER_DRAIN) { int l2_; asm volatile("v_mbcnt_lo_u32_b32 %0, -1, 0\n\tv_mbcnt_hi_u32_b32 %0, -1, %0" : "=v"(l2_));
            if constexpr (EPI_REP > 1 && Epi::IDEM) { int nrep_ = EPI_REP; asm volatile("" : "+s"(nrep_));
_Pragma("unroll 1")
                for (int er_ = 0; er_ < nrep_; ++er_) { asm volatile("v_mbcnt_lo_u32_b32 %0, -1, 0\n\tv_mbcnt_hi_u32_b32 %0, -1, %0" : "=v"(l2_)); E(acc, cur, wr, wc, l2_ & 15, l2_ >> 4); } }
            else E(acc, cur, wr, wc, l2_ & 15, l2_ >> 4);
            S.done(cur); }
        if (!has_next) break;
#pragma unroll
        for (int a = 0; a < 2; ++a)
#pragma unroll
            for (int b = 0; b < 2; ++b)
#pragma unroll
                for (int m = 0; m < 4; ++m)
#pragma unroll
                    for (int n = 0; n < 2; ++n) acc[a][b][m][n] = (f32x4){0.f, 0.f, 0.f, 0.f};
        cur = nxt; cA = nA; cB = nB; ++ui;
        if constexpr (ALIGN_EPI) { if (wr == 1) PG8_BAR; }
    }
    PG8_WAIT_V(0);
    if constexpr (!ALIGN_EPI) { if (wr == 0) PG8_BAR; }
    PG8_BAR;
    if constexpr (Epi::AFTER_DRAIN) { E.fused(acc, cur, wr, wc, fr, fq, lds, wid, lane); S.done(cur); }
#undef PG8_SA
#undef PG8_SB
#undef PG8_STAGE
#undef PG8_LDA
#undef PG8_LDB
#undef PG8_MMA
#undef PG8_WAIT_V
#undef PG8_WAIT_L
#undef PG8_BAR
#undef PG8_SCHED
}
}

typedef pg8::bf16_t bf16_t;
typedef pg8::f32x4 f32x4;
typedef pg8::u32x4 u32x4;
using pg8::cvt_pk_bf16;
constexpr int NB = 4, SEQ = 8192, D = 1024, MTOK = NB * SEQ;
constexpr int PCOLS = 4608, GCOLS = 3072, INCOLS = 7680, DFF = 3584, NEXP = 8;
constexpr int C_HQ = 0, C_HF = 512, C_HI = 1024, C_HG = 1536, C_GU = 2048, C_GV = 2560, C_SQ = 3072, C_SK = 3584, C_SV = 4096;
constexpr float EPS = 1e-6f;
constexpr int NSLOT = 2 * MTOK + 2 * NEXP * 256, MOE_MAXBLK = MTOK / 256 + NEXP;
constexpr int NTHREADS = 512, NWAVES = 8;
constexpr int LDS_BYTES = 147456, LDS_MISC = LDS_BYTES - 256;

constexpr size_t WS_CTL = 0, CTL_BYTES = 65536;
constexpr size_t CW_BAR = 0;
constexpr size_t WS_META = WS_CTL + CTL_BYTES;
constexpr size_t WS_LB = WS_META + 4096;
constexpr size_t WS_TOKE = WS_LB + 4096;
constexpr size_t WS_TOKW = WS_TOKE + (size_t)MTOK * 4;
constexpr size_t WS_SLOTTOK = WS_TOKW + (size_t)MTOK * 8;
constexpr size_t WS_SLOTW = WS_SLOTTOK + (size_t)NSLOT * 4;
constexpr size_t WS_BLKE = WS_SLOTW + (size_t)NSLOT * 4;
constexpr size_t WS_W = 2u << 20;
static_assert(WS_BLKE + 4096 <= WS_W, "small buffers");
constexpr size_t WS_WIN = WS_W;
constexpr size_t WS_WBR = WS_WIN + (size_t)2 * INCOLS * D * 2;
constexpr size_t WS_WOUT = WS_WBR + (size_t)2 * 3 * D * 512 * 2;
constexpr size_t WS_WGU = WS_WOUT + (size_t)2 * D * D * 2;
constexpr size_t WS_WD = WS_WGU + (size_t)2 * DFF * D * 2;
constexpr size_t WS_XN = WS_WD + (size_t)D * DFF * 2;
constexpr size_t WS_C = WS_XN + (size_t)MTOK * D * 2;
constexpr size_t WS_P = WS_C;
constexpr size_t WS_G = WS_C;
constexpr size_t WS_HID = WS_C;
constexpr size_t WS_OCAT = WS_C + (size_t)MTOK * PCOLS * 2;
constexpr size_t WS_ORAW = WS_OCAT + (size_t)3 * MTOK * 512 * 2;
constexpr size_t WS_END1 = WS_ORAW + (size_t)MTOK * 512 * 4;
constexpr size_t WS_MWD = WS_W;
static_assert(WS_MWD + (size_t)NEXP * D * DFF * 2 <= WS_XN, "moe down weights fit below XN");
constexpr size_t WS_MWGU = WS_C;
constexpr size_t WS_XS = WS_MWGU + (size_t)NEXP * 2 * DFF * D * 2;
constexpr size_t WS_MHID = WS_XS + (size_t)MOE_MAXBLK * 256 * D * 2;
constexpr size_t WS_END2 = WS_MHID + (size_t)MOE_MAXBLK * 256 * DFF * 2;
constexpr size_t WS_SLAB = WS_END2;
constexpr size_t WS_END3 = WS_SLAB + (size_t)256 * 256 * 256 * 2;
constexpr size_t WS_NEED = WS_END1 > WS_END3 ? WS_END1 : WS_END3;
static_assert(WS_NEED <= 615053344ull, "workspace budget (sum of the inputs)");

#define LAUNDER(v) asm volatile("" : "+v"(v))
__device__ __forceinline__ float bf2f(unsigned v) { return __uint_as_float(v << 16); }
__device__ __forceinline__ float bflo(unsigned w) { return __uint_as_float(w << 16); }
__device__ __forceinline__ float bfhi(unsigned w) { return __uint_as_float(w & 0xffff0000u); }
__device__ __forceinline__ bf16_t f2bf(float f) { return (bf16_t)(cvt_pk_bf16(f, 0.f) & 0xffffu); }
template <int M> __device__ __forceinline__ float xor_f(float v) { return __builtin_bit_cast(float, __builtin_amdgcn_ds_swizzle(__builtin_bit_cast(int, v), (M << 10) | 0x1f)); }
__device__ __forceinline__ float bperm_f(float v, int src_lane) { return __builtin_bit_cast(float, __builtin_amdgcn_ds_bpermute(src_lane << 2, __builtin_bit_cast(int, v))); }
__device__ __forceinline__ unsigned fp8x4(float a, float b, float c, float d) { int p = 0; a = __builtin_amdgcn_fmed3f(a, -448.f, 448.f); b = __builtin_amdgcn_fmed3f(b, -448.f, 448.f); c = __builtin_amdgcn_fmed3f(c, -448.f, 448.f); d = __builtin_amdgcn_fmed3f(d, -448.f, 448.f);     p = __builtin_amdgcn_cvt_pk_fp8_f32(a, b, p, false); p = __builtin_amdgcn_cvt_pk_fp8_f32(c, d, p, true); return (unsigned)p; }
__device__ __forceinline__ float wave_sum(float v) {
    v += xor_f<1>(v); v += xor_f<2>(v); v += xor_f<4>(v); v += xor_f<8>(v); v += xor_f<16>(v);
    return __builtin_bit_cast(float, __builtin_amdgcn_readlane(__builtin_bit_cast(int, v), 0)) + __builtin_bit_cast(float, __builtin_amdgcn_readlane(__builtin_bit_cast(int, v), 32));
}
__device__ __forceinline__ float sigmoidf_(float x) { return __builtin_amdgcn_rcpf(1.f + __expf(-x)); }
__device__ __forceinline__ float siluf_(float x) { return x * sigmoidf_(x); }
__device__ __forceinline__ float gelu_tanh_(float x) { return x * sigmoidf_(1.5957691216057308f * (x + 0.044715f * x * x * x)); }
__device__ __forceinline__ float softplusf_(float z) { return fmaxf(z, 0.f) + __logf(1.f + __expf(-fabsf(z))); }

struct Order {
    int nM, nN, nwg, G, c, mode; const char* A; const char* Bt; size_t tstep, abr, bbr; const int* bmap; const LAS int* bmapl; int ktiles, nfull, tail, split;
    __device__ __forceinline__ void init(const void* A_, const void* Bt_, int M, int N, int K, int G_, int c_, int mode_ = 0, size_t abr_ = 0, size_t bbr_ = 0, const int* bmap_ = nullptr, int tailsplit = 0, int esz = 2) { asm volatile("" : "+s"(c_));
        bmap = bmap_; bmapl = nullptr; ktiles = K * esz / 128; split = 1; tail = 0;
        nM = M / 256; nN = N / 256; nwg = nM * nN; G = G_; c = c_; mode = mode_; A = (const char*)A_; Bt = (const char*)Bt_; tstep = (size_t)256 * K * esz; abr = abr_; bbr = bbr_; nfull = nwg;
        if (tailsplit) { nfull = (nwg / G) * G; tail = nwg - nfull; split = (tail > 0 && tail * 7 <= G) ? 7 : (tail > 0 && tail * 4 <= G) ? 4 : (tail > 0 && tail * 2 <= G) ? 2 : 1; } }
    __device__ __forceinline__ void map(int L, int& pm, int& pn) const {
        int wgid = L; { const int q = nwg / 8, r = nwg % 8, xcd = wgid % 8, off = wgid / 8; wgid = (xcd < r ? xcd * (q + 1) : r * (q + 1) + (xcd - r) * q) + off; }
        const int nig = 8 * nN, gid = wgid / nig, fm = gid * 8, gsz = (nM - fm) < 8 ? (nM - fm) : 8; pm = fm + ((wgid % nig) % gsz); pn = (wgid % nig) / gsz; }
    __device__ __forceinline__ bool next(int i, pg8::Unit& u) const {
        if (mode == 4) {
            u.nt = ktiles; u.atomic = 0; const long L = (long)i * G + c; const int nt4 = nM * 4; if (L >= nt4) return false;
            int wgid = (int)L; { const int q = nt4 / 8, r = nt4 % 8, xcd = wgid % 8, off = wgid / 8; wgid = (xcd < r ? xcd * (q + 1) : r * (q + 1) + (xcd - r) * q) + off; }
            const int nig = 8 * 4, gid = wgid / nig, fm = gid * 8, gsz = (nM - fm) < 8 ? (nM - fm) : 8;
            u.pm = fm + ((wgid % nig) % gsz); u.pn = (wgid % nig) / gsz; u.a = A + (size_t)u.pm * tstep; u.b = Bt + (size_t)u.pn * tstep; return true; }
        if (mode == 3) {
            u.nt = ktiles; u.atomic = 0;
            const int br = i % 3; const long L = (long)(i / 3) * G + c; const int nt4 = nM * 4; if (L >= nt4) return false;
            int wgid = (int)L; { const int q = nt4 / 8, r = nt4 % 8, xcd = wgid % 8, off = wgid / 8; wgid = (xcd < r ? xcd * (q + 1) : r * (q + 1) + (xcd - r) * q) + off; }
            const int nig = 8 * 4, gid = wgid / nig, fm = gid * 8, gsz = (nM - fm) < 8 ? (nM - fm) : 8;
            u.pm = fm + ((wgid % nig) % gsz); const int pq = (wgid % nig) / gsz; u.pn = br * 4 + pq;
            u.a = A + (size_t)br * abr + (size_t)u.pm * tstep; u.b = Bt + (size_t)br * bbr + (size_t)pq * tstep; return true; }
        long L = (long)i * G + c; int slice = 0; u.nt = ktiles; u.atomic = 0;
        if (L >= nfull) {
            if (split == 1) { if (L >= nwg) return false; }
            else { const long tq = L - nfull; if (i != nfull / G || tq >= (long)tail * split) return false; L = nfull + tq / split; slice = (int)(tq % split); u.nt = ktiles / split; u.atomic = 1 + (int)tq; } }
        int wgid = (int)L; { const int q = nwg / 8, r = nwg % 8, xcd = wgid % 8, off = wgid / 8; wgid = (xcd < r ? xcd * (q + 1) : r * (q + 1) + (xcd - r) * q) + off; }
        const int nig = 8 * nN, gid = wgid / nig, fm = gid * 8, gsz = (nM - fm) < 8 ? (nM - fm) : 8;
        u.pm = fm + ((wgid % nig) % gsz); u.pn = (wgid % nig) / gsz;
        if (mode == 0) { u.a = A + (size_t)u.pm * tstep; u.b = Bt + (size_t)u.pn * tstep; }
        else if (mode == 2) { const int ex = __builtin_amdgcn_readfirstlane(bmapl[u.pm]);     u.a = A + (size_t)u.pm * tstep + (size_t)slice * u.nt * 128; u.b = Bt + (size_t)ex * bbr + (size_t)u.pn * tstep + (size_t)slice * u.nt * 128; }
        else { const int br = u.pn >> 2; u.a = A + (size_t)br * abr + (size_t)u.pm * tstep; u.b = Bt + (size_t)br * bbr + (size_t)(u.pn & 3) * tstep; }
        return true;
    }
    __device__ __forceinline__ void a_ready(const pg8::Unit&) const {}
    __device__ __forceinline__ void done(const pg8::Unit&) const {}
};

template <int ACT> __device__ __forceinline__ float act_(float x, float lb) {
    if (ACT == 1) return siluf_(x);
    if (ACT == 2) return __logf(lb + (1.f - lb) * sigmoidf_(x));
    if (ACT == 3) return gelu_tanh_(x);
    if (ACT == 4) return sigmoidf_(x);
    return x;
}
struct EpiAct {
    static constexpr bool PERM = true, AFTER_DRAIN = false, IDEM = true;
    bf16_t* O; int ldc; const float* lb; int inproj;
    template <int ACT> __device__ __forceinline__ void run(const f32x4 (&acc)[2][2][4][2], const pg8::Unit& u, int wr, int wc, int fr, int fq) const {
        const int row0 = u.pm * 256 + wr * 64 + fr, col0 = u.pn * 256 + wc * 32 + 8 * fq;
        f32x4 lbv[2][2];
#pragma unroll
        for (int bj = 0; bj < 2; ++bj)
#pragma unroll
            for (int n = 0; n < 2; ++n) lbv[bj][n] = (ACT == 2) ? *(const f32x4*)(lb + (col0 - C_HF) + bj * 128 + 4 * n) : (f32x4){0.f, 0.f, 0.f, 0.f};
#pragma unroll
        for (int ai = 0; ai < 2; ++ai)
#pragma unroll
            for (int m = 0; m < 4; ++m) { bf16_t* rowp = O + (size_t)(row0 + ai * 128 + m * 16) * ldc + col0;
#pragma unroll
                for (int bj = 0; bj < 2; ++bj) { f32x4 v0 = acc[ai][bj][m][0], v1 = acc[ai][bj][m][1];
#pragma unroll
                    for (int i = 0; i < 4; ++i) { v0[i] = act_<ACT>(v0[i], lbv[bj][0][i]); v1[i] = act_<ACT>(v1[i], lbv[bj][1][i]); }
                    u32x4 w; w.x = cvt_pk_bf16(v0[0], v0[1]); w.y = cvt_pk_bf16(v0[2], v0[3]); w.z = cvt_pk_bf16(v1[0], v1[1]); w.w = cvt_pk_bf16(v1[2], v1[3]);
                    *(u32x4*)(rowp + bj * 128) = w; } }
    }
    __device__ __forceinline__ void operator()(const f32x4 (&acc)[2][2][4][2], const pg8::Unit& u, int wr, int wc, int fr, int fq) const {
        if (!inproj) { run<4>(acc, u, wr, wc, fr, fq); return; }
        const int kind = u.pn >> 1;
        if (kind == 0 || kind == 3) run<1>(acc, u, wr, wc, fr, fq);
        else if (kind == 1) run<2>(acc, u, wr, wc, fr, fq);
        else if (kind == 4 || kind == 5) run<3>(acc, u, wr, wc, fr, fq);
        else run<0>(acc, u, wr, wc, fr, fq);
    }
};
struct EpiBranch {
    static constexpr bool PERM = true, AFTER_DRAIN = false, IDEM = false;
    const bf16_t* Gt; bf16_t* mix;
    __device__ __forceinline__ void operator()(const f32x4 (&acc)[2][2][4][2], const pg8::Unit& u, int wr, int wc, int fr, int fq) const {
        const int br = u.pn >> 2, row0 = u.pm * 256 + wr * 64 + fr, col0 = (u.pn & 3) * 256 + wc * 32 + 8 * fq;
#pragma unroll
        for (int ai = 0; ai < 2; ++ai)
#pragma unroll
            for (int m = 0; m < 4; ++m) { const size_t row = (size_t)(row0 + ai * 128 + m * 16); const bf16_t* gp = Gt + row * GCOLS + br * 1024 + col0; bf16_t* mp = mix + row * D + col0;
#pragma unroll
                for (int bj = 0; bj < 2; ++bj) { const f32x4 v0 = acc[ai][bj][m][0], v1 = acc[ai][bj][m][1];
                    const u32x4 g = *(const u32x4*)(gp + bj * 128); u32x4 o = {0u, 0u, 0u, 0u};
                    if (br > 0) o = __builtin_nontemporal_load((const u32x4*)(mp + bj * 128));
                    u32x4 w;
                    w.x = cvt_pk_bf16(bflo(o.x) + v0[0] * bflo(g.x), bfhi(o.x) + v0[1] * bfhi(g.x)); w.y = cvt_pk_bf16(bflo(o.y) + v0[2] * bflo(g.y), bfhi(o.y) + v0[3] * bfhi(g.y));
                    w.z = cvt_pk_bf16(bflo(o.z) + v1[0] * bflo(g.z), bfhi(o.z) + v1[1] * bfhi(g.z)); w.w = cvt_pk_bf16(bflo(o.w) + v1[2] * bflo(g.w), bfhi(o.w) + v1[3] * bfhi(g.w));
                    *(u32x4*)(mp + bj * 128) = w; } }
    }
};
struct EpiBranchSeg {
    static constexpr bool PERM = true, AFTER_DRAIN = false, IDEM = true;
    const bf16_t* Gt; bf16_t* mix;
    __device__ __forceinline__ void mid(f32x4 (&acc)[2][2][4][2], const pg8::Unit& u, int seg, int wr, int wc, int fr, int fq, const bool inv = false) const {
        const int row0 = u.pm * 256 + wr * 64 + fr, col0 = u.pn * 256 + wc * 32 + 8 * fq;
        u32x4 ga[2][2][2], gb[2][2][2];
#define EBS_LOAD(b_) do { _Pragma("unroll") for (int mm = 0; mm < 2; ++mm) { const bf16_t* gp = Gt + (size_t)(row0 + ((b_) >> 1) * 128 + (2 * ((b_) & 1) + mm) * 16) * GCOLS + seg * 1024 + col0; \
            _Pragma("unroll") for (int bj = 0; bj < 2; ++bj) { ga[(b_) & 1][mm][bj] = *(const u32x4*)(gp + bj * 128); gb[(b_) & 1][mm][bj] = *(const u32x4*)(gp + 1024 + bj * 128); } } } while (0)
        EBS_LOAD(0);
#pragma unroll
        for (int b = 0; b < 4; ++b) { const int ai = b >> 1, mp = b & 1;
            if (b + 1 < 4) EBS_LOAD(b + 1);
            asm volatile("" ::: "memory");
#pragma unroll
            for (int mm = 0; mm < 2; ++mm)
#pragma unroll
                for (int bj = 0; bj < 2; ++bj) { const u32x4 a = inv ? gb[b & 1][mm][bj] : ga[b & 1][mm][bj], bb = inv ? ga[b & 1][mm][bj] : gb[b & 1][mm][bj]; const int m = 2 * mp + mm;
                    const float na[8] = {bflo(a.x), bfhi(a.x), bflo(a.y), bfhi(a.y), bflo(a.z), bfhi(a.z), bflo(a.w), bfhi(a.w)}, nb[8] = {bflo(bb.x), bfhi(bb.x), bflo(bb.y), bfhi(bb.y), bflo(bb.z), bfhi(bb.z), bflo(bb.w), bfhi(bb.w)};
#pragma unroll
                    for (int i = 0; i < 4; ++i) { acc[ai][bj][m][0][i] *= fmaxf(na[i], 1e-6f) * __builtin_amdgcn_rcpf(fmaxf(nb[i], 1e-6f)); acc[ai][bj][m][1][i] *= fmaxf(na[4 + i], 1e-6f) * __builtin_amdgcn_rcpf(fmaxf(nb[4 + i], 1e-6f)); } } }
#undef EBS_LOAD
    }
    __device__ __forceinline__ void operator()(const f32x4 (&acc)[2][2][4][2], const pg8::Unit& u, int wr, int wc, int fr, int fq) const {
        const int row0 = u.pm * 256 + wr * 64 + fr, col0 = u.pn * 256 + wc * 32 + 8 * fq;
#pragma unroll
        for (int ai = 0; ai < 2; ++ai) { u32x4 g[4][2];
#pragma unroll
            for (int m = 0; m < 4; ++m)
#pragma unroll
                for (int bj = 0; bj < 2; ++bj) g[m][bj] = *(const u32x4*)(Gt + (size_t)(row0 + ai * 128 + m * 16) * GCOLS + 2048 + col0 + bj * 128);
            asm volatile("" ::: "memory");
#pragma unroll
            for (int m = 0; m < 4; ++m) { bf16_t* mp = mix + (size_t)(row0 + ai * 128 + m * 16) * D + col0;
#pragma unroll
                for (int bj = 0; bj < 2; ++bj) { const f32x4 v0 = acc[ai][bj][m][0], v1 = acc[ai][bj][m][1]; const u32x4 gg = g[m][bj]; u32x4 w;
                    w.x = cvt_pk_bf16(v0[0] * fmaxf(bflo(gg.x), 1e-6f), v0[1] * fmaxf(bfhi(gg.x), 1e-6f)); w.y = cvt_pk_bf16(v0[2] * fmaxf(bflo(gg.y), 1e-6f), v0[3] * fmaxf(bfhi(gg.y), 1e-6f));
                    w.z = cvt_pk_bf16(v1[0] * fmaxf(bflo(gg.z), 1e-6f), v1[1] * fmaxf(bfhi(gg.z), 1e-6f)); w.w = cvt_pk_bf16(v1[2] * fmaxf(bflo(gg.w), 1e-6f), v1[3] * fmaxf(bfhi(gg.w), 1e-6f));
                    *(u32x4*)(mp + bj * 128) = w; } } }
    }
};
template <bool INF>
struct EpiResidT {
    static constexpr bool PERM = true, AFTER_DRAIN = false, IDEM = INF;
    const void* xin; bf16_t* xout;
    __device__ __forceinline__ void operator()(const f32x4 (&acc)[2][2][4][2], const pg8::Unit& u, int wr, int wc, int fr, int fq) const {
        const int row0 = u.pm * 256 + wr * 64 + fr, col0 = u.pn * 256 + wc * 32 + 8 * fq;
        if constexpr (INF) {
#pragma unroll
            for (int ai = 0; ai < 2; ++ai)
#pragma unroll
                for (int mp = 0; mp < 2; ++mp) { f32x4 t[2][2][2];
#pragma unroll
                    for (int mm = 0; mm < 2; ++mm) { const size_t ro = (size_t)(row0 + ai * 128 + (2 * mp + mm) * 16) * D + col0;
#pragma unroll
                        for (int bj = 0; bj < 2; ++bj)
#pragma unroll
                            for (int n = 0; n < 2; ++n) t[mm][bj][n] = *(const f32x4*)((const float*)xin + ro + bj * 128 + n * 4); }
                    asm volatile("" ::: "memory");
#pragma unroll
                    for (int mm = 0; mm < 2; ++mm) { const size_t ro = (size_t)(row0 + ai * 128 + (2 * mp + mm) * 16) * D + col0;
#pragma unroll
                        for (int bj = 0; bj < 2; ++bj) { const f32x4 v0 = t[mm][bj][0] + acc[ai][bj][2 * mp + mm][0], v1 = t[mm][bj][1] + acc[ai][bj][2 * mp + mm][1];
                            u32x4 w; w.x = cvt_pk_bf16(v0[0], v0[1]); w.y = cvt_pk_bf16(v0[2], v0[3]); w.z = cvt_pk_bf16(v1[0], v1[1]); w.w = cvt_pk_bf16(v1[2], v1[3]); *(u32x4*)(xout + ro + bj * 128) = w; } }
                    asm volatile("" ::: "memory"); }
        } else {
#pragma unroll
            for (int ai = 0; ai < 2; ++ai) { u32x4 t[4][2];
#pragma unroll
                for (int m = 0; m < 4; ++m) { const size_t ro = (size_t)(row0 + ai * 128 + m * 16) * D + col0;
#pragma unroll
                    for (int bj = 0; bj < 2; ++bj) t[m][bj] = *(const u32x4*)((const bf16_t*)xin + ro + bj * 128); }
                asm volatile("" ::: "memory");
#pragma unroll
                for (int m = 0; m < 4; ++m) { const size_t ro = (size_t)(row0 + ai * 128 + m * 16) * D + col0;
#pragma unroll
                    for (int bj = 0; bj < 2; ++bj) { const u32x4 o = t[m][bj]; const f32x4 a0 = acc[ai][bj][m][0], a1 = acc[ai][bj][m][1];
                        u32x4 w; w.x = cvt_pk_bf16(bflo(o.x) + a0[0], bfhi(o.x) + a0[1]); w.y = cvt_pk_bf16(bflo(o.y) + a0[2], bfhi(o.y) + a0[3]);
                        w.z = cvt_pk_bf16(bflo(o.z) + a1[0], bfhi(o.z) + a1[1]); w.w = cvt_pk_bf16(bflo(o.w) + a1[2], bfhi(o.w) + a1[3]); *(u32x4*)(xout + ro + bj * 128) = w; } }
                asm volatile("" ::: "memory"); }
        }
    }
};
template <bool F8OUT>
struct EpiGUT {
    static constexpr bool PERM = true, AFTER_DRAIN = false, IDEM = true;
    void* H;
    __device__ __forceinline__ void operator()(const f32x4 (&acc)[2][2][4][2], const pg8::Unit& u, int wr, int wc, int fr, int fq) const {
        const int row0 = u.pm * 256 + wr * 64 + fr, col0 = u.pn * 128 + wc * 32 + 8 * fq;
#pragma unroll
        for (int ai = 0; ai < 2; ++ai)
#pragma unroll
            for (int m = 0; m < 4; ++m) { const size_t eo = (size_t)(row0 + ai * 128 + m * 16) * DFF + col0;
                const f32x4 g0 = acc[ai][0][m][0], g1 = acc[ai][0][m][1], u0 = acc[ai][1][m][0], u1 = acc[ai][1][m][1];
                const float h0 = siluf_(g0[0]) * u0[0], h1 = siluf_(g0[1]) * u0[1], h2 = siluf_(g0[2]) * u0[2], h3 = siluf_(g0[3]) * u0[3];
                const float h4 = siluf_(g1[0]) * u1[0], h5 = siluf_(g1[1]) * u1[1], h6 = siluf_(g1[2]) * u1[2], h7 = siluf_(g1[3]) * u1[3];
                if (F8OUT) *(uint2*)((unsigned char*)H + eo) = make_uint2(fp8x4(h0, h1, h2, h3), fp8x4(h4, h5, h6, h7));
                else { u32x4 w; w.x = cvt_pk_bf16(h0, h1); w.y = cvt_pk_bf16(h2, h3); w.z = cvt_pk_bf16(h4, h5); w.w = cvt_pk_bf16(h6, h7); *(u32x4*)((bf16_t*)H + eo) = w; } }
    }
};
typedef EpiGUT<false> EpiGU;
struct EpiMoeDown {
    static constexpr bool PERM = true, AFTER_DRAIN = false, IDEM = true;
    const bf16_t* rin; void* rout; int outf; const int* stok; const float* sw; bf16_t* slab;
    __device__ __forceinline__ void operator()(const f32x4 (&acc)[2][2][4][2], const pg8::Unit& u, int wr, int wc, int fr, int fq) const {
        LAUNDER(fr); LAUNDER(fq);
        if (u.atomic) { bf16_t* sp = slab + (size_t)(u.atomic - 1) * 65536 + (size_t)(wr * 64 + fr) * 256 + wc * 32 + 8 * fq;
#pragma unroll
            for (int ai = 0; ai < 2; ++ai)
#pragma unroll
                for (int m = 0; m < 4; ++m)
#pragma unroll
                    for (int bj = 0; bj < 2; ++bj) { const f32x4 v0 = acc[ai][bj][m][0], v1 = acc[ai][bj][m][1]; u32x4 w; w.x = cvt_pk_bf16(v0[0], v0[1]); w.y = cvt_pk_bf16(v0[2], v0[3]); w.z = cvt_pk_bf16(v1[0], v1[1]); w.w = cvt_pk_bf16(v1[2], v1[3]);
                        *(u32x4*)(sp + (size_t)(ai * 128 + m * 16) * 256 + bj * 128) = w; }
            return; }
        const int row0 = u.pm * 256 + wr * 64 + fr, col0 = u.pn * 256 + wc * 32 + 8 * fq;
        int tk[2][4]; float wt[2][4];
#pragma unroll
        for (int ai = 0; ai < 2; ++ai)
#pragma unroll
            for (int m = 0; m < 4; ++m) { const int rl = row0 + ai * 128 + m * 16; tk[ai][m] = stok[rl]; wt[ai][m] = sw[rl]; }
#pragma unroll
        for (int ai = 0; ai < 2; ++ai) { u32x4 t[4][2];
#pragma unroll
            for (int m = 0; m < 4; ++m) { const int tok = tk[ai][m]; const bf16_t* rp = rin + (size_t)(tok < 0 ? 0 : tok) * D + col0;
#pragma unroll
                for (int bj = 0; bj < 2; ++bj) t[m][bj] = *(const u32x4*)(rp + bj * 128); }
            asm volatile("" ::: "memory");
#pragma unroll
            for (int m = 0; m < 4; ++m) { const int tok = tk[ai][m]; const float w = wt[ai][m];
                if (tok >= 0) { const size_t ro = (size_t)tok * D + col0;
#pragma unroll
                    for (int bj = 0; bj < 2; ++bj) { const u32x4 o = t[m][bj]; const f32x4 a0 = acc[ai][bj][m][0] * w, a1 = acc[ai][bj][m][1] * w;
                        const f32x4 v0 = {bflo(o.x) + a0[0], bfhi(o.x) + a0[1], bflo(o.y) + a0[2], bfhi(o.y) + a0[3]}, v1 = {bflo(o.z) + a1[0], bfhi(o.z) + a1[1], bflo(o.w) + a1[2], bfhi(o.w) + a1[3]};
                        if (outf) { float* op = (float*)rout + ro + bj * 128; *(f32x4*)op = v0; *(f32x4*)(op + 4) = v1; }
                        else { u32x4 q; q.x = cvt_pk_bf16(v0[0], v0[1]); q.y = cvt_pk_bf16(v0[2], v0[3]); q.z = cvt_pk_bf16(v1[0], v1[1]); q.w = cvt_pk_bf16(v1[2], v1[3]); *(u32x4*)((bf16_t*)rout + ro + bj * 128) = q; } } } }
            asm volatile("" ::: "memory"); }
    }
};
__device__ __forceinline__ void moe_tail_reduce(const Order& S, const bf16_t* slab, const bf16_t* rin, void* rout, int outf, const int* stok, const float* sw, int wg, int G, int wid, int lane) {
    LAUNDER(lane);
    if (S.split == 1) return;
    for (int task = wg * NWAVES + wid; task < S.tail * 256; task += G * NWAVES) {
        const int j = task >> 8, r = task & 255; int pm, pn; S.map(S.nfull + j, pm, pn);
        const int tok = __hip_atomic_load(stok + pm * 256 + r, __ATOMIC_RELAXED, __HIP_MEMORY_SCOPE_AGENT); if (tok < 0) continue;
        const float w = sw[pm * 256 + r]; f32x4 s = {0.f, 0.f, 0.f, 0.f};
        const size_t ro = (size_t)tok * D + pn * 256 + lane * 4; const uint2 x = *(const uint2*)(rin + ro);
        uint2 xs[7];
#pragma unroll
        for (int sl = 0; sl < 7; ++sl) { xs[sl] = make_uint2(0u, 0u); if (sl < S.split) xs[sl] = *(const uint2*)(slab + (size_t)(j * S.split + sl) * 65536 + (size_t)r * 256 + lane * 4); }
#pragma unroll
        for (int sl = 0; sl < 7; ++sl) { s[0] += bflo(xs[sl].x); s[1] += bfhi(xs[sl].x); s[2] += bflo(xs[sl].y); s[3] += bfhi(xs[sl].y); }
        const f32x4 o = {bflo(x.x) + s[0] * w, bfhi(x.x) + s[1] * w, bflo(x.y) + s[2] * w, bfhi(x.y) + s[3] * w};
        if (outf) *(f32x4*)((float*)rout + ro) = o; else *(uint2*)((bf16_t*)rout + ro) = make_uint2(cvt_pk_bf16(o[0], o[1]), cvt_pk_bf16(o[2], o[3]));
    }
}

__device__ __forceinline__ void tc_job(const float* __restrict__ src, int K, int N, bf16_t* dst, int mode, int perm, LAS float* tile, int wg, int G, int tid, int f8 = 0) {
    LAUNDER(tid);
    const int tn = N / 64, nt = (K / 64) * tn;
    float4 v0 = make_float4(0.f, 0.f, 0.f, 0.f), v1 = v0;
    if (wg < nt) { const int k0 = (wg / tn) * 64, n0 = (wg % tn) * 64; const float* sp = src + (size_t)(k0 + (tid >> 4)) * N + n0 + (tid & 15) * 4; v0 = *(const float4*)sp; v1 = *(const float4*)(sp + (size_t)32 * N); }
    for (int t = wg; t < nt; t += G) {
        const int k0 = (t / tn) * 64, n0 = (t % tn) * 64;
        { LAS float* tp = tile + (tid >> 4) * 65 + (tid & 15) * 4; tp[0] = v0.x; tp[1] = v0.y; tp[2] = v0.z; tp[3] = v0.w; tp += 32 * 65; tp[0] = v1.x; tp[1] = v1.y; tp[2] = v1.z; tp[3] = v1.w; }
        if (t + G < nt) { const int k1 = ((t + G) / tn) * 64, n1 = ((t + G) % tn) * 64; const float* sp = src + (size_t)(k1 + (tid >> 4)) * N + n1 + (tid & 15) * 4; v0 = *(const float4*)sp; v1 = *(const float4*)(sp + (size_t)32 * N); }
        __syncthreads();
        { const int n = tid >> 3, kg = (tid & 7) * 8; unsigned w[4];
#pragma unroll
          for (int j = 0; j < 4; ++j) w[j] = cvt_pk_bf16(tile[(kg + 2 * j) * 65 + n], tile[(kg + 2 * j + 1) * 65 + n]);
          const int nn = n0 + n; int drow = mode == 0 ? nn : ((nn >> 7) * 256 + (nn & 127) + (mode == 2 ? 128 : 0));
          if (perm) { const int c5 = drow & 31; drow = (drow & ~31) + 16 * ((c5 >> 2) & 1) + 4 * (c5 >> 3) + (c5 & 3); }
          if (f8) *(uint2*)((unsigned char*)dst + (size_t)drow * K + k0 + kg) = make_uint2(fp8x4(64.f * tile[(kg + 0) * 65 + n], 64.f * tile[(kg + 1) * 65 + n], 64.f * tile[(kg + 2) * 65 + n], 64.f * tile[(kg + 3) * 65 + n]),
                                                                                          fp8x4(64.f * tile[(kg + 4) * 65 + n], 64.f * tile[(kg + 5) * 65 + n], 64.f * tile[(kg + 6) * 65 + n], 64.f * tile[(kg + 7) * 65 + n]));
          else *(uint4*)(dst + (size_t)drow * K + k0 + kg) = make_uint4(w[0], w[1], w[2], w[3]); }
        __syncthreads();
    }
}

__device__ __forceinline__ void tc_job_w(const float* __restrict__ src, int K, int N, bf16_t* dst, int mode, int perm, LAS float* tile_all, int wg, int G, int wid, int lane, int f8 = 0) {
    LAUNDER(lane);
    LAS float* tile = tile_all + wid * (64 * 65);
    const int tn = N / 64, nt = (K / 64) * tn, TS = G * NWAVES;
    const int r = lane >> 4, c4 = (lane & 15) * 4;
    float4 v[16];
    int t = wg * NWAVES + wid;
    if (t < nt) { const float* sp = src + (size_t)((t / tn) * 64 + r) * N + (t % tn) * 64 + c4;
#pragma unroll
        for (int i = 0; i < 16; ++i) v[i] = *(const float4*)(sp + (size_t)(4 * i) * N); }
    for (; t < nt; t += TS) {
        const int k0 = (t / tn) * 64, n0 = (t % tn) * 64;
#pragma unroll
        for (int i = 0; i < 16; ++i) { LAS float* tp = tile + (r + 4 * i) * 65 + c4; tp[0] = v[i].x; tp[1] = v[i].y; tp[2] = v[i].z; tp[3] = v[i].w; }
        if (t + TS < nt) { const int t1 = t + TS; const float* sp = src + (size_t)((t1 / tn) * 64 + r) * N + (t1 % tn) * 64 + c4;
#pragma unroll
            for (int i = 0; i < 16; ++i) v[i] = *(const float4*)(sp + (size_t)(4 * i) * N); }
        asm volatile("" ::: "memory"); __builtin_amdgcn_wave_barrier();
#pragma unroll
        for (int j = 0; j < 8; ++j) { const int p = lane + 64 * j, n = p >> 3, kg = (p & 7) * 8; float x[8];
#pragma unroll
            for (int q = 0; q < 8; ++q) x[q] = tile[(kg + q) * 65 + n];
            const int nn = n0 + n; int drow = mode == 0 ? nn : ((nn >> 7) * 256 + (nn & 127) + (mode == 2 ? 128 : 0));
            if (perm) { const int c5 = drow & 31; drow = (drow & ~31) + 16 * ((c5 >> 2) & 1) + 4 * (c5 >> 3) + (c5 & 3); }
            if (f8) *(uint2*)((unsigned char*)dst + (size_t)drow * K + k0 + kg) = make_uint2(fp8x4(64.f * x[0], 64.f * x[1], 64.f * x[2], 64.f * x[3]), fp8x4(64.f * x[4], 64.f * x[5], 64.f * x[6], 64.f * x[7]));
            else *(uint4*)(dst + (size_t)drow * K + k0 + kg) = make_uint4(cvt_pk_bf16(x[0], x[1]), cvt_pk_bf16(x[2], x[3]), cvt_pk_bf16(x[4], x[5]), cvt_pk_bf16(x[6], x[7])); }
        asm volatile("" ::: "memory"); __builtin_amdgcn_wave_barrier();
    }
}
__device__ __forceinline__ void tc_job_f8(const float* __restrict__ src, int K, int N, unsigned char* dst, int mode, LAS float* tile, int wg, int G, int tid) {
    LAUNDER(tid);
    const int tn = N / 64, nt = (K / 128) * tn; const int r = tid >> 4, c4 = (tid & 15) * 4;
    float4 v[4];
#pragma unroll
    for (int i = 0; i < 4; ++i) v[i] = make_float4(0.f, 0.f, 0.f, 0.f);
    if (wg < nt) { const float* sp = src + (size_t)((wg / tn) * 128 + r) * N + (wg % tn) * 64 + c4;
#pragma unroll
        for (int i = 0; i < 4; ++i) v[i] = *(const float4*)(sp + (size_t)(32 * i) * N); }
    for (int t = wg; t < nt; t += G) {
        const int k0 = (t / tn) * 128, n0 = (t % tn) * 64;
#pragma unroll
        for (int i = 0; i < 4; ++i) { LAS float* tp = tile + (r + 32 * i) * 65 + c4; tp[0] = v[i].x; tp[1] = v[i].y; tp[2] = v[i].z; tp[3] = v[i].w; }
        if (t + G < nt) { const float* sp = src + (size_t)(((t + G) / tn) * 128 + r) * N + ((t + G) % tn) * 64 + c4;
#pragma unroll
            for (int i = 0; i < 4; ++i) v[i] = *(const float4*)(sp + (size_t)(32 * i) * N); }
        __syncthreads();
        { const int n = tid >> 3, kg = (tid & 7) * 16; float x[16];
#pragma unroll
          for (int q = 0; q < 16; ++q) x[q] = 64.f * tile[(kg + q) * 65 + n];
          const int nn = n0 + n; int drow = mode == 0 ? nn : ((nn >> 7) * 256 + (nn & 127) + (mode == 2 ? 128 : 0));
          { const int c5 = drow & 31; drow = (drow & ~31) + 16 * ((c5 >> 2) & 1) + 4 * (c5 >> 3) + (c5 & 3); }
          *(uint4*)(dst + (size_t)drow * K + k0 + kg) = make_uint4(fp8x4(x[0], x[1], x[2], x[3]), fp8x4(x[4], x[5], x[6], x[7]), fp8x4(x[8], x[9], x[10], x[11]), fp8x4(x[12], x[13], x[14], x[15])); }
        __syncthreads();
    }
}

template <bool ROUTER, bool F8 = ROUTER, bool XBF = true>
__device__ __forceinline__ void phase_rmsnorm(const void* __restrict__ x, const float* __restrict__ gain, bf16_t* xn, const float* __restrict__ rw, const float* __restrict__ rb,
                              int* toke, float2* tokw, int wg, int G, int wid, int lane) {
    LAUNDER(lane);
    constexpr int RB = ROUTER ? 2 : 4;
    float rwv[ROUTER ? 4 : 1][4][NEXP];
    if (ROUTER) {
#pragma unroll
        for (int j = 0; j < 4; ++j)
#pragma unroll
            for (int i = 0; i < 4; ++i) { const float* wr_ = rw + (size_t)(j * 256 + lane * 4 + i) * NEXP; const float4 wa = *(const float4*)wr_, wb = *(const float4*)(wr_ + 4);
                rwv[j][i][0] = wa.x; rwv[j][i][1] = wa.y; rwv[j][i][2] = wa.z; rwv[j][i][3] = wa.w; rwv[j][i][4] = wb.x; rwv[j][i][5] = wb.y; rwv[j][i][6] = wb.z; rwv[j][i][7] = wb.w; } }
    uint2 nx[XBF ? RB : 1][4];
    if (XBF) { const int r0 = (wg * NWAVES + wid) * RB;
        if (r0 < MTOK) {
#pragma unroll
            for (int rr = 0; rr < RB; ++rr)
#pragma unroll
                for (int j = 0; j < 4; ++j) nx[rr][j] = *(const uint2*)((const bf16_t*)x + (size_t)(r0 + rr) * D + j * 256 + lane * 4); } }
    for (int row0 = (wg * NWAVES + wid) * RB; row0 < MTOK; row0 += G * NWAVES * RB) {
        float4 v[RB][4];
#pragma unroll
        for (int rr = 0; rr < RB; ++rr)
#pragma unroll
            for (int j = 0; j < 4; ++j) { const size_t xo = (size_t)(row0 + rr) * D + j * 256 + lane * 4;
                if (XBF) { const uint2 q = nx[rr][j]; v[rr][j] = make_float4(bflo(q.x), bfhi(q.x), bflo(q.y), bfhi(q.y)); } else v[rr][j] = *(const float4*)((const float*)x + xo); }
        if (XBF) { const int r1 = row0 + G * NWAVES * RB;
            if (r1 < MTOK) {
#pragma unroll
                for (int rr = 0; rr < RB; ++rr)
#pragma unroll
                    for (int j = 0; j < 4; ++j) nx[rr][j] = *(const uint2*)((const bf16_t*)x + (size_t)(r1 + rr) * D + j * 256 + lane * 4); } }
#pragma unroll
        for (int rr = 0; rr < RB; ++rr) { const int row = row0 + rr; float ss = 0.f;
#pragma unroll
            for (int j = 0; j < 4; ++j) ss += v[rr][j].x * v[rr][j].x + v[rr][j].y * v[rr][j].y + v[rr][j].z * v[rr][j].z + v[rr][j].w * v[rr][j].w;
            ss = wave_sum(ss);
            const float rstd = rsqrtf(ss * (1.f / D) + EPS);
            float lg[NEXP];
#pragma unroll
            for (int e = 0; e < NEXP; ++e) lg[e] = 0.f;
#pragma unroll
            for (int j = 0; j < 4; ++j) { const float4 g = *(const float4*)(gain + j * 256 + lane * 4);
                const float y0 = v[rr][j].x * rstd * g.x, y1 = v[rr][j].y * rstd * g.y, y2 = v[rr][j].z * rstd * g.z, y3 = v[rr][j].w * rstd * g.w;
                if (F8) *(unsigned*)((unsigned char*)xn + (size_t)row * D + j * 256 + lane * 4) = fp8x4(y0, y1, y2, y3);
                else *(uint2*)(xn + (size_t)row * D + j * 256 + lane * 4) = make_uint2(cvt_pk_bf16(y0, y1), cvt_pk_bf16(y2, y3));
                if (ROUTER) { const float ys[4] = {y0, y1, y2, y3};
#pragma unroll
                    for (int i = 0; i < 4; ++i)
#pragma unroll
                        for (int e = 0; e < NEXP; ++e) lg[e] += ys[i] * rwv[ROUTER ? j : 0][i][e]; } }
            if (ROUTER) {
#pragma unroll
                for (int e = 0; e < NEXP; ++e) lg[e] = wave_sum(lg[e]) + rb[e];
                int i0 = 0; float l0 = lg[0];
#pragma unroll
                for (int e = 1; e < NEXP; ++e) if (lg[e] > l0) { l0 = lg[e]; i0 = e; }
                int i1 = -1; float l1 = -3.4e38f;
#pragma unroll
                for (int e = 0; e < NEXP; ++e) if (e != i0 && lg[e] > l1) { l1 = lg[e]; i1 = e; }
                const float w0 = __builtin_amdgcn_rcpf(1.f + __expf(l1 - l0));
                if (lane == 0) { toke[row] = i0 | (i1 << 8); tokw[row] = make_float2(w0, 1.f - w0); }
            }
        }
    }
}

__device__ void phase_combine(const bf16_t* GH, bf16_t* mix, int wg, int G, int tid) {
    LAUNDER(tid);
    for (size_t v = (size_t)wg * NTHREADS + tid; v < (size_t)MTOK * (D / 8); v += (size_t)G * NTHREADS) {
        const size_t r = v / (D / 8); const int c = (int)(v % (D / 8)) * 8; const bf16_t* gp = GH + r * GCOLS + c;
        const uint4 a = *(const uint4*)gp, b = *(const uint4*)(gp + 1024), cc = *(const uint4*)(gp + 2048); uint4 o;
        o.x = cvt_pk_bf16(bflo(a.x) + bflo(b.x) + bflo(cc.x), bfhi(a.x) + bfhi(b.x) + bfhi(cc.x));
        o.y = cvt_pk_bf16(bflo(a.y) + bflo(b.y) + bflo(cc.y), bfhi(a.y) + bfhi(b.y) + bfhi(cc.y));
        o.z = cvt_pk_bf16(bflo(a.z) + bflo(b.z) + bflo(cc.z), bfhi(a.z) + bfhi(b.z) + bfhi(cc.z));
        o.w = cvt_pk_bf16(bflo(a.w) + bflo(b.w) + bflo(cc.w), bfhi(a.w) + bfhi(b.w) + bfhi(cc.w));
        *(uint4*)(mix + r * D + c) = o;
    }
}

__device__ __forceinline__ void moe_assign(const int* toke, const float2* tokw, int* meta, int* stok, float* sw, int* blke, LAS unsigned char* lds, int tid, int part) {
    LAS int* cnt = (LAS int*)lds;
    LAS int* tot = cnt + 512 * 16;
    LAS int* segt = tot + 32;
    const int t0 = tid * (MTOK / NTHREADS);
    int4 e4[16];
#pragma unroll
    for (int i = 0; i < 16; ++i) e4[i] = *(const int4*)(toke + t0 + 4 * i);
    { int z = 0; asm volatile("" : "+v"(z));
      for (int j = 0; j < 16; ++j) cnt[tid * 16 + j] = z; }
#pragma unroll
    for (int i = 0; i < 16; ++i) { const int ev[4] = {e4[i].x, e4[i].y, e4[i].z, e4[i].w};
#pragma unroll
        for (int q = 0; q < 4; ++q) { cnt[tid * 16 + (ev[q] & 255)] += 1; cnt[tid * 16 + 8 + ((ev[q] >> 8) & 255)] += 1; } }
    __syncthreads();
    const int cj = tid & 15, cseg = tid >> 4;
    { int s = 0; for (int i = 0; i < 16; ++i) s += cnt[(cseg * 16 + i) * 16 + cj]; segt[cseg * 16 + cj] = s; }
    __syncthreads();
    if (tid < 16) { int run = 0; for (int sg = 0; sg < 32; ++sg) { const int v = segt[sg * 16 + tid]; segt[sg * 16 + tid] = run; run += v; } tot[tid] = run; }
    __syncthreads();
    { int run = segt[cseg * 16 + cj]; for (int i = 0; i < 16; ++i) { const int idx = (cseg * 16 + i) * 16 + cj; const int v = cnt[idx]; cnt[idx] = run; run += v; } }
    if (tid == 0) { int run = 0; for (int j = 0; j < 16; ++j) { const int n = tot[j], pad = (n + 255) & ~255; tot[16 + j] = run; if (j == 8) { meta[0] = run; meta[3] = run; } run += pad; } meta[1] = run - tot[16 + 8]; meta[2] = 0; meta[4] = run; }
    __syncthreads();
    for (int bk = tid; bk < 2 * MOE_MAXBLK; bk += NTHREADS) { int ex = 0;
        for (int j = 0; j < 16; ++j) { const int base = tot[16 + j], pad = (tot[j] + 255) & ~255; if (bk * 256 >= base && bk * 256 < base + pad) ex = j & 7; }
        blke[bk] = ex; }
    const int cls = part & 1, half = part >> 1;
    if ((tid >> 8) == half) {
        for (int j = 0; j < 8; ++j) cnt[tid * 16 + 8 * cls + j] += tot[16 + 8 * cls + j];
#pragma unroll
        for (int i = 0; i < 16; ++i) { const int ev[4] = {e4[i].x, e4[i].y, e4[i].z, e4[i].w}; const float4 wa = *(const float4*)(tokw + t0 + 4 * i), wb = *(const float4*)(tokw + t0 + 4 * i + 2);
            const float wv[4] = {cls ? wa.y : wa.x, cls ? wa.w : wa.z, cls ? wb.y : wb.x, cls ? wb.w : wb.z};
#pragma unroll
            for (int q = 0; q < 4; ++q) { const int j = cls ? 8 + ((ev[q] >> 8) & 255) : (ev[q] & 255); const int pp = cnt[tid * 16 + j]; cnt[tid * 16 + j] = pp + 1; stok[pp] = t0 + 4 * i + q; sw[pp] = wv[q]; } } }
    if (half == 0) for (int j = 8 * cls; j < 8 * cls + 8; ++j) { const int n = tot[j], pad = (n + 255) & ~255, base = tot[16 + j]; for (int i = n + tid; i < pad; i += NTHREADS) { stok[base + i] = -1; sw[base + i] = 0.f; } }
}
__device__ __forceinline__ void moe_gather(const unsigned char* xn8, const int* stok, int rows, unsigned char* xs8, int wg, int G, int wid, int lane) {
    LAUNDER(lane);
    for (int r0 = (wg * NWAVES + wid) * 4; r0 < rows; r0 += G * NWAVES * 4) {
        int tok[4]; uint4 a[4];
#pragma unroll
        for (int i = 0; i < 4; ++i) tok[i] = __hip_atomic_load(stok + r0 + i, __ATOMIC_RELAXED, __HIP_MEMORY_SCOPE_AGENT);
#pragma unroll
        for (int i = 0; i < 4; ++i) { a[i] = make_uint4(0, 0, 0, 0); if (tok[i] >= 0) a[i] = *((const uint4*)(xn8 + (size_t)tok[i] * D) + lane); }
#pragma unroll
        for (int i = 0; i < 4; ++i) *((uint4*)(xs8 + (size_t)(r0 + i) * D) + lane) = a[i]; }
}

typedef pg8::bf16x8 bf16x8;
typedef unsigned u32x2 __attribute__((ext_vector_type(2)));
#define MFMA16(A, B, C) __builtin_amdgcn_mfma_f32_16x16x32_bf16((A), (B), (C), 0, 0, 0)
__device__ __forceinline__ bf16x8 mk8(unsigned a, unsigned b, unsigned c, unsigned d) { u32x4 v = {a, b, c, d}; return __builtin_bit_cast(bf16x8, v); }

constexpr int H_QD = 0, H_KD = 9216, H_KB = 18432, H_QG = 23040, H_KET = 31744, H_VT = 44032, H_PM = 56320, H_TP = 59392, H_GE = 61440;
constexpr size_t HG_DUMP_BYTES = (size_t)MTOK * 512 * 2, HG_U_BYTES = (size_t)256 * 128 * 128 * 2;
__device__ __forceinline__ void phase_hgrn_a(const bf16_t* P, bf16_t* qsc  , uint2* dump, bf16_t* U  , float* Dsc, LAS unsigned char* lds, int wg, int G, int tid, int wid, int lane) {
    LAUNDER(tid); LAUNDER(lane);
    const int d = tid & 127, part = tid >> 7, g = lane >> 4, c16 = lane & 15;
    LAS float* TP = (LAS float*)(lds + H_TP); LAS float* GE = (LAS float*)(lds + H_GE);
    for (int item = wg; item < 256; item += G) {
        const int b = item >> 6, h = (item >> 4) & 3, sc = item & 15; const size_t tok0 = (size_t)b * SEQ + (size_t)sc * 512;
        f32x4 S[8];
#pragma unroll
        for (int i = 0; i < 8; ++i) S[i] = (f32x4){0.f, 0.f, 0.f, 0.f};
        float gsc = 0.f;
        unsigned lfv[8], qv[8], vv[8];
        { const bf16_t* base = P + (tok0 + 8 * part) * PCOLS + h * 128 + d;
#pragma unroll
          for (int j = 0; j < 8; ++j) { lfv[j] = base[(size_t)j * PCOLS + C_HF]; qv[j] = base[(size_t)j * PCOLS + C_HQ]; vv[j] = base[(size_t)j * PCOLS + C_HI]; } }
        for (int c = 0; c < 16; ++c) {
            float gl[8], lf[8], qf[8]; unsigned vb[8]; float run = 0.f;
#pragma unroll
            for (int j = 0; j < 8; ++j) { lf[j] = bf2f(lfv[j]); qf[j] = bf2f(qv[j]); vb[j] = vv[j]; run += lf[j]; gl[j] = run; }
            if (c < 15) { const bf16_t* base = P + (tok0 + (c + 1) * 32 + 8 * part) * PCOLS + h * 128 + d;
#pragma unroll
                for (int j = 0; j < 8; ++j) { lfv[j] = base[(size_t)j * PCOLS + C_HF]; qv[j] = base[(size_t)j * PCOLS + C_HQ]; vv[j] = base[(size_t)j * PCOLS + C_HI]; } }
            TP[part * 128 + d] = run;
            __syncthreads();
            const float t0 = TP[d], t1 = TP[128 + d], t2 = TP[256 + d], t3 = TP[384 + d];
            const float T0 = t0 + t1, gend = T0 + t2 + t3;
            const float pre = (part == 1) ? t0 : (part == 3) ? t2 : 0.f, gb = (part >> 1) ? T0 : 0.f;
            unsigned kep[4];
#pragma unroll
            for (int j = 0; j < 8; j += 2) {
                float ke2[2];
#pragma unroll
                for (int jj = 0; jj < 2; ++jj) { const int t = 8 * part + j + jj; const float Gl = pre + gl[j + jj], Gt = gb + Gl; const float k = 1.f - __expf(lf[j + jj]), q = qf[j + jj];
                    *(LAS bf16_t*)(lds + H_QD + t * 288 + d * 2) = f2bf(q * __expf(Gl));
                    *(LAS bf16_t*)(lds + H_KD + t * 288 + d * 2) = f2bf(k * __expf(fminf(-Gl, 80.f)));
                    if (part < 2) *(LAS bf16_t*)(lds + H_KB + t * 288 + d * 2) = f2bf(k * __expf(T0 - Gl));
                    *(LAS bf16_t*)(lds + H_QG + t * 272 + d * 2) = f2bf(q * __expf(Gt));
                    qsc[(tok0 + c * 32 + t) * 512 + h * 128 + d] = f2bf(q * __expf(gsc + Gt));
                    ke2[jj] = k * __expf(gend - Gt); }
                kep[j >> 1] = cvt_pk_bf16(ke2[0], ke2[1]); }
            *(LAS u32x4*)(lds + H_KET + d * 96 + part * 16) = (u32x4){kep[0], kep[1], kep[2], kep[3]};
            *(LAS u32x4*)(lds + H_VT + d * 96 + part * 16) = (u32x4){vb[0] | (vb[1] << 16), vb[2] | (vb[3] << 16), vb[4] | (vb[5] << 16), vb[6] | (vb[7] << 16)};
            if (part == 0) GE[d] = __expf(gend);
            gsc += gend;
            __syncthreads();
            if (wid < 3) { const int I = (wid == 0) ? 0 : 1, J = (wid == 2) ? 0 : I; f32x4 acc = {0.f, 0.f, 0.f, 0.f};
#pragma unroll
                for (int kk = 0; kk < 4; ++kk) { const bf16x8 A = *(const LAS bf16x8*)(lds + H_QD + (16 * I + c16) * 288 + kk * 64 + g * 16);
                    const bf16x8 B = (wid == 2) ? *(const LAS bf16x8*)(lds + H_KB + c16 * 288 + kk * 64 + g * 16) : *(const LAS bf16x8*)(lds + H_KD + (16 * J + c16) * 288 + kk * 64 + g * 16);
                    acc = MFMA16(A, B, acc); }
#pragma unroll
                for (int r = 0; r < 4; ++r) { const int t = 4 * g + r; const float v = (I == J && c16 > t) ? 0.f : acc[r]; *(LAS bf16_t*)(lds + H_PM + (16 * I + t) * 96 + (16 * J + c16) * 2) = f2bf(v); }
            } else if (wid == 3) {
#pragma unroll
                for (int r = 0; r < 4; ++r) *(LAS bf16_t*)(lds + H_PM + (4 * g + r) * 96 + (16 + c16) * 2) = (bf16_t)0;
            }
            __syncthreads();
            { const bf16x8 Bv = *(const LAS bf16x8*)(lds + H_VT + (16 * wid + c16) * 96 + g * 16);
              unsigned sp[8][2];
#pragma unroll
              for (int i = 0; i < 8; ++i) { sp[i][0] = cvt_pk_bf16(S[i][0], S[i][1]); sp[i][1] = cvt_pk_bf16(S[i][2], S[i][3]); }
              const size_t chunk_g = (tok0 >> 5) + c;
#pragma unroll
              for (int rt = 0; rt < 2; ++rt) { f32x4 o = {0.f, 0.f, 0.f, 0.f};
                  o = MFMA16(*(const LAS bf16x8*)(lds + H_PM + (16 * rt + c16) * 96 + g * 16), Bv, o);
#pragma unroll
                  for (int kk = 0; kk < 4; ++kk) { const LAS unsigned char* qp = lds + H_QG + (16 * rt + c16) * 272 + (32 * kk + 4 * g) * 2;
                      const u32x2 lo = *(const LAS u32x2*)qp, hi = *(const LAS u32x2*)(qp + 32);
                      o = MFMA16(mk8(lo.x, lo.y, hi.x, hi.y), mk8(sp[2 * kk][0], sp[2 * kk][1], sp[2 * kk + 1][0], sp[2 * kk + 1][1]), o); }
                  dump[(((chunk_g * 4 + h) * 2 + rt) * 8 + wid) * 64 + lane] = make_uint2(cvt_pk_bf16(o[0], o[1]), cvt_pk_bf16(o[2], o[3])); }
#pragma unroll
              for (int i = 0; i < 8; ++i) { const f32x4 dec = *(const LAS f32x4*)(lds + H_GE + (16 * i + 4 * g) * 4); S[i] = S[i] * dec;
                  S[i] = MFMA16(*(const LAS bf16x8*)(lds + H_KET + (16 * i + c16) * 96 + g * 16), Bv, S[i]); } }
            __syncthreads();
        }
#pragma unroll
        for (int i = 0; i < 8; ++i)
#pragma unroll
            for (int r = 0; r < 4; ++r) U[((size_t)item * 128 + 16 * i + 4 * g + r) * 128 + 16 * wid + c16] = f2bf(S[i][r]);
        if (part == 0) Dsc[item * 128 + d] = __expf(gsc);
    }
}
constexpr int HC_SIN = 0;
__device__ __forceinline__ void phase_hgrn_c(const bf16_t* P, bf16_t* qoa  , const uint2* dump, const bf16_t* U, const float* Dsc, const float* gain, LAS unsigned char* lds, int wg, int G, int tid, int wid, int lane) {
    LAUNDER(tid); LAUNDER(lane);
    const int g = lane >> 4, c16 = lane & 15;
    for (int item = wg; item < 256; item += G) {
        const int b = item >> 6, h = (item >> 4) & 3, sc = item & 15; const size_t tok0 = (size_t)b * SEQ + (size_t)sc * 512;
#pragma unroll 1
        for (int kq = 0; kq < 2; ++kq) { float s[16];
#pragma unroll
          for (int k = 0; k < 16; ++k) s[k] = 0.f;
#pragma unroll 8
          for (int j = 0; j < sc; ++j) { const size_t it = (size_t)(item - sc + j);
#pragma unroll
              for (int k = 0; k < 2; ++k) { const int e0 = 8 * (tid + 512 * (kq * 2 + k)); const uint4 uu = *(const uint4*)(U + it * 16384 + e0); const float dd = Dsc[it * 128 + (e0 >> 7)];
                  s[8 * k + 0] = dd * s[8 * k + 0] + bflo(uu.x); s[8 * k + 1] = dd * s[8 * k + 1] + bfhi(uu.x); s[8 * k + 2] = dd * s[8 * k + 2] + bflo(uu.y); s[8 * k + 3] = dd * s[8 * k + 3] + bfhi(uu.y);
                  s[8 * k + 4] = dd * s[8 * k + 4] + bflo(uu.z); s[8 * k + 5] = dd * s[8 * k + 5] + bfhi(uu.z); s[8 * k + 6] = dd * s[8 * k + 6] + bflo(uu.w); s[8 * k + 7] = dd * s[8 * k + 7] + bfhi(uu.w); } }
#pragma unroll
          for (int k = 0; k < 2; ++k) { const int e0 = 8 * (tid + 512 * (kq * 2 + k));
#pragma unroll
              for (int i = 0; i < 8; ++i) { const int e = e0 + i; *(LAS bf16_t*)(lds + HC_SIN + (e & 127) * 288 + (e >> 7) * 2) = f2bf(s[8 * k + i]); } } }
        __syncthreads();
        bf16x8 An[4]; uint2 oln[8]; unsigned hgn[8][4];
#define HC_LOAD(rtile_) do { const size_t row0_ = tok0 + 64 * wid + 16 * (rtile_); const size_t cg_ = (tok0 >> 5) + 2 * wid + ((rtile_) >> 1); const int rt_ = (rtile_) & 1; \
            _Pragma("unroll") for (int kk = 0; kk < 4; ++kk) An[kk] = *(const bf16x8*)(qoa + (row0_ + c16) * 512 + h * 128 + 32 * kk + 8 * g); \
            _Pragma("unroll") for (int vt = 0; vt < 8; ++vt) oln[vt] = dump[(((cg_ * 4 + h) * 2 + rt_) * 8 + vt) * 64 + lane]; \
            _Pragma("unroll") for (int vt = 0; vt < 8; ++vt) _Pragma("unroll") for (int r = 0; r < 4; ++r) hgn[vt][r] = P[(row0_ + 4 * g + r) * PCOLS + C_HG + h * 128 + 16 * vt + c16]; } while (0)
        HC_LOAD(0);
#pragma unroll
        for (int rtile = 0; rtile < 4; ++rtile) {
            const size_t row0 = tok0 + 64 * wid + 16 * rtile;
            bf16x8 A[4]; uint2 olc[8]; unsigned hgv[8][4];
#pragma unroll
            for (int kk = 0; kk < 4; ++kk) A[kk] = An[kk];
#pragma unroll
            for (int vt = 0; vt < 8; ++vt) { olc[vt] = oln[vt];
#pragma unroll
                for (int r = 0; r < 4; ++r) hgv[vt][r] = hgn[vt][r]; }
            if (rtile + 1 < 4) HC_LOAD(rtile + 1);
            asm volatile("" ::: "memory");
            f32x4 acc[8]; float ss[4] = {0.f, 0.f, 0.f, 0.f};
#pragma unroll
            for (int vt = 0; vt < 8; ++vt) { acc[vt] = (f32x4){0.f, 0.f, 0.f, 0.f};
#pragma unroll
                for (int kk = 0; kk < 4; ++kk) acc[vt] = MFMA16(A[kk], *(const LAS bf16x8*)(lds + HC_SIN + (16 * vt + c16) * 288 + (32 * kk + 8 * g) * 2), acc[vt]);
                const uint2 ol = olc[vt];
                acc[vt][0] += bflo(ol.x); acc[vt][1] += bfhi(ol.x); acc[vt][2] += bflo(ol.y); acc[vt][3] += bfhi(ol.y);
#pragma unroll
                for (int r = 0; r < 4; ++r) ss[r] += acc[vt][r] * acc[vt][r]; }
            float rstd[4];
#pragma unroll
            for (int r = 0; r < 4; ++r) { float s = ss[r]; s += xor_f<1>(s); s += xor_f<2>(s); s += xor_f<4>(s); s += xor_f<8>(s); rstd[r] = rsqrtf(s * (1.f / 128.f) + EPS); }
#pragma unroll
            for (int vt = 0; vt < 8; ++vt) { const float gn = gain[16 * vt + c16];
#pragma unroll
                for (int r = 0; r < 4; ++r) { const size_t row = row0 + 4 * g + r;
                    qoa[row * 512 + h * 128 + 16 * vt + c16] = f2bf(acc[vt][r] * rstd[r] * gn * bf2f(hgv[vt][r])); } }
        }
#undef HC_LOAD
        __syncthreads();
    }
}

constexpr int GM_VT = 0, GM_W = 36864, GM_RS = 73728;
__device__ __forceinline__ void phase_gmlp(const bf16_t* P, const float* __restrict__ ws_l, const float* __restrict__ bs_l, const float* __restrict__ gv_l, bf16_t* ob, LAS unsigned char* lds, int wg, int G, int tid, int wid, int lane) {
    LAUNDER(tid); LAUNDER(lane);
    const int g = lane >> 4, c16 = lane & 15; LAS float* RS = (LAS float*)(lds + GM_RS);
    for (int item = wg; item < MTOK / 128; item += G) {
        const size_t tok0 = (size_t)item * 128;
        uint4 xq[4]; float4 waq[4], wbq[4];
#define GM_LOAD(grp_) do { _Pragma("unroll") for (int ps = 0; ps < 4; ++ps) { const int idx = tid + ps * 512, s = idx >> 4, c8 = (idx & 15) * 8; xq[ps] = *(const uint4*)(P + (tok0 + s) * PCOLS + C_GV + (grp_) * 128 + c8); \
            waq[ps] = *(const float4*)(ws_l + (size_t)(grp_) * 16384 + s * 128 + c8); wbq[ps] = *(const float4*)(ws_l + (size_t)(grp_) * 16384 + s * 128 + c8 + 4); } } while (0)
        GM_LOAD(0);
        { const int s = tid >> 2, qd = tid & 3; const bf16_t* rp = P + (tok0 + s) * PCOLS + C_GV + qd * 128; float ss = 0.f;
#pragma unroll
          for (int j = 0; j < 16; ++j) { const uint4 x = *(const uint4*)(rp + j * 8); ss += bflo(x.x) * bflo(x.x) + bfhi(x.x) * bfhi(x.x) + bflo(x.y) * bflo(x.y) + bfhi(x.y) * bfhi(x.y) + bflo(x.z) * bflo(x.z) + bfhi(x.z) * bfhi(x.z) + bflo(x.w) * bflo(x.w) + bfhi(x.w) * bfhi(x.w); }
          ss += xor_f<1>(ss); ss += xor_f<2>(ss); if (qd == 0) RS[s] = rsqrtf(ss * (1.f / 512.f) + EPS); }
        for (int grp = 0; grp < 4; ++grp) {
            __syncthreads();
#pragma unroll
            for (int ps = 0; ps < 4; ++ps) { const int idx = tid + ps * 512, s = idx >> 4, c8 = (idx & 15) * 8; const uint4 x = xq[ps];
                const float rs = RS[s]; const float4 ga = *(const float4*)(gv_l + grp * 128 + c8), gb = *(const float4*)(gv_l + grp * 128 + c8 + 4);
                const float e[8] = {bflo(x.x) * rs * ga.x, bfhi(x.x) * rs * ga.y, bflo(x.y) * rs * ga.z, bfhi(x.y) * rs * ga.w, bflo(x.z) * rs * gb.x, bfhi(x.z) * rs * gb.y, bflo(x.w) * rs * gb.z, bfhi(x.w) * rs * gb.w};
#pragma unroll
                for (int i = 0; i < 8; ++i) *(LAS bf16_t*)(lds + GM_VT + (c8 + i) * 288 + s * 2) = f2bf(e[i]);
                const int t = idx >> 4, s8 = (idx & 15) * 8; const float4 wa = waq[ps], wb = wbq[ps];
                *(LAS u32x4*)(lds + GM_W + t * 288 + s8 * 2) = (u32x4){cvt_pk_bf16(s8 + 0 <= t ? wa.x : 0.f, s8 + 1 <= t ? wa.y : 0.f), cvt_pk_bf16(s8 + 2 <= t ? wa.z : 0.f, s8 + 3 <= t ? wa.w : 0.f),
                                                                    cvt_pk_bf16(s8 + 4 <= t ? wb.x : 0.f, s8 + 5 <= t ? wb.y : 0.f), cvt_pk_bf16(s8 + 6 <= t ? wb.z : 0.f, s8 + 7 <= t ? wb.w : 0.f)}; }
            if (grp + 1 < 4) GM_LOAD(grp + 1);
            __syncthreads();
            unsigned guv[4][8];
#pragma unroll
            for (int r = 0; r < 4; ++r)
#pragma unroll
                for (int ct = 0; ct < 8; ++ct) guv[r][ct] = P[(tok0 + 16 * wid + 4 * g + r) * PCOLS + C_GU + grp * 128 + 16 * ct + c16];
            f32x4 acc[8];
#pragma unroll
            for (int ct = 0; ct < 8; ++ct) acc[ct] = (f32x4){0.f, 0.f, 0.f, 0.f};
            for (int kk = 0; kk <= (wid >> 1); ++kk) { const bf16x8 A = *(const LAS bf16x8*)(lds + GM_W + (16 * wid + c16) * 288 + kk * 64 + g * 16);
#pragma unroll
                for (int ct = 0; ct < 8; ++ct) acc[ct] = MFMA16(A, *(const LAS bf16x8*)(lds + GM_VT + (16 * ct + c16) * 288 + kk * 64 + g * 16), acc[ct]); }
#pragma unroll
            for (int r = 0; r < 4; ++r) { const int t = 16 * wid + 4 * g + r; const float bias = bs_l[grp * 128 + t]; const size_t tok = tok0 + t;
#pragma unroll
                for (int ct = 0; ct < 8; ++ct) { const int ch = grp * 128 + 16 * ct + c16; ob[tok * 512 + ch] = f2bf(bf2f(guv[r][ct]) * (acc[ct][r] + bias)); } }
        }
        __syncthreads();
#undef GM_LOAD
    }
}

constexpr int AT_KL = 0, AT_VT = 10240, AT_MIN = 10240 + 64 * 144;
template <bool DIAG>
__device__ __forceinline__ void attn_block(LAS unsigned char* lds, const bf16x8 (&Bq)[2], f32x4 (&O)[4], float& carry, int sb0, int t, int g, int c16, unsigned tri_lo, unsigned tri_hi, unsigned ONES, unsigned ZERO) {
    f32x4 z[4]; unsigned hi[4][2];
#pragma unroll
    for (int st = 0; st < 4; ++st) { z[st] = (f32x4){0.f, 0.f, 0.f, 0.f};
#pragma unroll
        for (int kk = 0; kk < 2; ++kk) z[st] = MFMA16(*(const LAS bf16x8*)(lds + AT_KL + (16 * st + c16) * 160 + kk * 64 + g * 16), Bq[kk], z[st]);
        float spv[4];
#pragma unroll
        for (int r = 0; r < 4; ++r) { const float sp = __builtin_amdgcn_logf(1.f + __builtin_amdgcn_exp2f(z[st][r])); spv[r] = (!DIAG || (sb0 + 16 * st + 4 * g + r < t)) ? sp : 0.f; }
        hi[st][0] = cvt_pk_bf16(spv[0], spv[1]); hi[st][1] = cvt_pk_bf16(spv[2], spv[3]); }
    f32x4 sf[4];
#pragma unroll
    for (int so = 0; so < 4; ++so) { sf[so] = (f32x4){0.f, 0.f, 0.f, 0.f};
#pragma unroll
        for (int kk = 0; kk < 2; ++kk) { if (2 * kk + 1 < so) continue;
            const unsigned a0 = (2 * kk > so) ? ONES : (2 * kk == so) ? tri_lo : ZERO, a1 = (2 * kk > so) ? ONES : (2 * kk == so) ? tri_hi : ZERO;
            const unsigned a2 = (2 * kk + 1 > so) ? ONES : tri_lo, a3 = (2 * kk + 1 > so) ? ONES : tri_hi;
            sf[so] = MFMA16(mk8(a0, a1, a2, a3), mk8(hi[2 * kk][0], hi[2 * kk][1], hi[2 * kk + 1][0], hi[2 * kk + 1][1]), sf[so]); } }
    unsigned pa[4][2];
#pragma unroll
    for (int st = 0; st < 4; ++st) { float av[4];
#pragma unroll
        for (int r = 0; r < 4; ++r) { const float a = __builtin_amdgcn_exp2f(z[st][r] - carry - sf[st][r]); av[r] = (!DIAG || (sb0 + 16 * st + 4 * g + r < t)) ? a : 0.f; }
        pa[st][0] = cvt_pk_bf16(av[0], av[1]); pa[st][1] = cvt_pk_bf16(av[2], av[3]); }
#pragma unroll
    for (int kk = 0; kk < 2; ++kk) { const bf16x8 Aop = mk8(pa[2 * kk][0], pa[2 * kk][1], pa[2 * kk + 1][0], pa[2 * kk + 1][1]);
#pragma unroll
        for (int dt = 0; dt < 4; ++dt) { const LAS unsigned char* vp = lds + AT_VT + (16 * dt + c16) * 144 + (32 * kk + 4 * g) * 2; const u32x2 v0 = *(const LAS u32x2*)vp, v1 = *(const LAS u32x2*)(vp + 32);
            O[dt] = MFMA16(Aop, mk8(v0.x, v0.y, v1.x, v1.y), O[dt]); } }
    carry += bperm_f(sf[0][0], c16);
}
__device__ __forceinline__ void phase_attn(const bf16_t* P, const float* __restrict__ gq, const float* __restrict__ gk, bf16_t* oc, LAS unsigned char* lds, int wg, int G, int tid, int wid, int lane) {
    LAUNDER(tid); LAUNDER(lane);
    const int g = lane >> 4, c16 = lane & 15; LAS float* MINW = (LAS float*)(lds + AT_MIN);
    unsigned ONES = 0x3F803F80u, ZERO = 0u; LAUNDER(ONES); LAUNDER(ZERO);
    const unsigned tri_lo = ((4 * g + 0 >= c16) ? 0x3F80u : 0u) | ((4 * g + 1 >= c16) ? 0x3F800000u : 0u), tri_hi = ((4 * g + 2 >= c16) ? 0x3F80u : 0u) | ((4 * g + 3 >= c16) ? 0x3F800000u : 0u);
    for (int item = wg; item < NB * 8 * (SEQ / 128); item += G) {
        const int qt = item & 63, h = (item >> 6) & 7, b = item >> 9; const int t0 = qt * 128, tq0 = t0 + 16 * wid, t = tq0 + c16; const size_t tokb = (size_t)b * SEQ;
        bf16x8 Bq[2];
        { const bf16_t* qp = P + (tokb + t) * PCOLS + C_SQ + h * 64; const uint4 x0 = *(const uint4*)(qp + 8 * g), x1 = *(const uint4*)(qp + 32 + 8 * g);
          float e[16] = {bflo(x0.x), bfhi(x0.x), bflo(x0.y), bfhi(x0.y), bflo(x0.z), bfhi(x0.z), bflo(x0.w), bfhi(x0.w), bflo(x1.x), bfhi(x1.x), bflo(x1.y), bfhi(x1.y), bflo(x1.z), bfhi(x1.z), bflo(x1.w), bfhi(x1.w)};
          float ss = 0.f;
#pragma unroll
          for (int i = 0; i < 16; ++i) ss += e[i] * e[i];
          ss += xor_f<16>(ss); ss += bperm_f(ss, lane ^ 32);
          const float rq = rsqrtf(ss * (1.f / 64.f) + EPS) * (0.125f * 1.4426950408889634f);
#pragma unroll
          for (int i = 0; i < 16; ++i) { const int dd = (i < 8 ? 8 * g + i : 32 + 8 * g + (i - 8)); e[i] = e[i] * rq * gq[dd] * gk[dd]; }
          Bq[0] = mk8(cvt_pk_bf16(e[0], e[1]), cvt_pk_bf16(e[2], e[3]), cvt_pk_bf16(e[4], e[5]), cvt_pk_bf16(e[6], e[7]));
          Bq[1] = mk8(cvt_pk_bf16(e[8], e[9]), cvt_pk_bf16(e[10], e[11]), cvt_pk_bf16(e[12], e[13]), cvt_pk_bf16(e[14], e[15])); }
        f32x4 O[4];
#pragma unroll
        for (int i = 0; i < 4; ++i) O[i] = (f32x4){0.f, 0.f, 0.f, 0.f};
        float carry = 0.f, wmin = 0.f;
        const int ks = tid >> 3, kpc = tid & 7;
        const bf16_t* rp0 = P + (tokb + ks) * PCOLS + h * 64 + kpc * 8;
        uint4 kx = *(const uint4*)(rp0 + (size_t)(((t0 + 127) >> 6) * 64) * PCOLS + C_SK), vx = *(const uint4*)(rp0 + (size_t)(((t0 + 127) >> 6) * 64) * PCOLS + C_SV);
        for (int kb = (t0 + 127) >> 6; kb >= 0; --kb) {
            const int sb0 = kb * 64;
            { const int s = ks, pc = kpc;
              float ke[8] = {bflo(kx.x), bfhi(kx.x), bflo(kx.y), bfhi(kx.y), bflo(kx.z), bfhi(kx.z), bflo(kx.w), bfhi(kx.w)}; float ssk = 0.f;
#pragma unroll
              for (int i = 0; i < 8; ++i) ssk += ke[i] * ke[i];
              ssk += xor_f<1>(ssk); ssk += xor_f<2>(ssk); ssk += xor_f<4>(ssk);
              const float rk = rsqrtf(ssk * (1.f / 64.f) + EPS);
              *(LAS u32x4*)(lds + AT_KL + s * 160 + pc * 16) = (u32x4){cvt_pk_bf16(ke[0] * rk, ke[1] * rk), cvt_pk_bf16(ke[2] * rk, ke[3] * rk), cvt_pk_bf16(ke[4] * rk, ke[5] * rk), cvt_pk_bf16(ke[6] * rk, ke[7] * rk)};
              const unsigned vw[4] = {vx.x, vx.y, vx.z, vx.w};
#pragma unroll
              for (int i = 0; i < 8; ++i) *(LAS bf16_t*)(lds + AT_VT + (pc * 8 + i) * 144 + s * 2) = (bf16_t)((vw[i >> 1] >> ((i & 1) * 16)) & 0xffffu);
              if (kb > 0) { kx = *(const uint4*)(rp0 + (size_t)(sb0 - 64) * PCOLS + C_SK); vx = *(const uint4*)(rp0 + (size_t)(sb0 - 64) * PCOLS + C_SV); } }
            __syncthreads();
            if (sb0 < tq0 + 15 && wmin <= 150.04f) {
                if (sb0 + 63 < tq0) attn_block<false>(lds, Bq, O, carry, sb0, t, g, c16, tri_lo, tri_hi, ONES, ZERO);
                else attn_block<true>(lds, Bq, O, carry, sb0, t, g, c16, tri_lo, tri_hi, ONES, ZERO);
            }
            float mn = carry; mn = fminf(mn, xor_f<1>(mn)); mn = fminf(mn, xor_f<2>(mn)); mn = fminf(mn, xor_f<4>(mn)); mn = fminf(mn, xor_f<8>(mn));
            wmin = __builtin_bit_cast(float, __builtin_amdgcn_readfirstlane(__builtin_bit_cast(int, mn)));
            if (lane == 0) MINW[wid] = mn;
            __syncthreads();
            float mall = MINW[0];
#pragma unroll
            for (int w = 1; w < 8; ++w) mall = fminf(mall, MINW[w]);
            if (mall > 150.04f) break;
        }
#pragma unroll
        for (int dt = 0; dt < 4; ++dt)
#pragma unroll
            for (int r = 0; r < 4; ++r) oc[(tokb + tq0 + 4 * g + r) * 512 + h * 64 + 16 * dt + c16] = f2bf(O[dt][r]);
    }
}

#ifdef MK_CHECK
constexpr size_t WS_DIAG = WS_META + 2048;
constexpr size_t WS_SNAP = WS_BLKE + 4096;
static_assert(WS_SNAP + 64 * 1024 * 4 <= WS_W, "snapshot fits");
__device__ __forceinline__ int samp_row(int i) { return (int)(((unsigned)i * 2654435761u + 12345u) % (unsigned)MTOK); }
__device__ __forceinline__ void chk_fail(unsigned* diag, unsigned code) { atomicMin(diag, code); }
__device__ __forceinline__ bool chk_close(float got, float ref, float atol, float rtol) { return fabsf(got - ref) <= atol + rtol * fabsf(ref) && got == got; }

__global__ void k_diag_init(unsigned* diag) { if (threadIdx.x == 0 && blockIdx.x == 0) { diag[0] = 0xffffffffu; diag[16] = 0u; diag[17] = 0xffffffffu; diag[18] = 0u; diag[19] = 0u; diag[20] = 0u; diag[21] = 0u; diag[22] = 0u; diag[23] = 0u; diag[24] = 0u; diag[25] = 0u; diag[26] = 0u; } }
__global__ void k_snapshot(const float* x, float* snap) { const int i = blockIdx.x; const int r = samp_row(i); for (int c = threadIdx.x; c < D; c += blockDim.x) snap[i * D + c] = x[(size_t)r * D + c]; }
__global__ void k_apply_diag(float* out, const unsigned* diag) {
    if (blockIdx.x != 0 || threadIdx.x != 0) return;
    const unsigned code = diag[0]; if (code == 0xffffffffu) return;
    out[0] = (1.0f + 0.1f * (float)(code > 89u ? 89u : code)) * 1.0e6f;
}
struct ChkGemm { const bf16_t* A; int lda; const float* W; int ldw; int K; int mode; const bf16_t* Cb; int ldc; const float* Cf; const float* xold; const float* W2; const float* lb; const bf16_t* Gsrc; int ncols; unsigned code; int use_snap; };
__global__ void k_chk_gemm(ChkGemm c, unsigned* diag) {
    const int i = blockIdx.x; const int r = samp_row(i);
    for (int cc = threadIdx.x; cc < 96; cc += blockDim.x) {
        const int col = (int)(((unsigned)cc * 40503u + (unsigned)i * 977u) % (unsigned)c.ncols);
        float dot = 0.f, dot2 = 0.f;
        for (int k = 0; k < c.K; ++k) { const float av = bf2f(c.A[(size_t)r * c.lda + k]); dot += av * c.W[(size_t)k * c.ldw + col]; if (c.mode == 4) dot2 += av * c.W2[(size_t)k * c.ldw + col]; }
        float ref, got;
        if (c.mode == 0) { const int kind = col >> 9; ref = (kind == 0 || kind == 3) ? siluf_(dot) : kind == 1 ? __logf(c.lb[col - 512] + (1.f - c.lb[col - 512]) * sigmoidf_(dot)) : (kind == 4 || kind == 5) ? gelu_tanh_(dot) : dot; got = bf2f(c.Cb[(size_t)r * c.ldc + col]); }
        else if (c.mode == 1) { ref = sigmoidf_(dot); got = bf2f(c.Cb[(size_t)r * c.ldc + col]); }
        else if (c.mode == 3) { const float xo = c.use_snap ? c.xold[(size_t)i * D + col] : c.xold[(size_t)r * D + col]; ref = xo + dot; got = c.Cf[(size_t)r * D + col]; }
        else { ref = siluf_(dot) * dot2; got = bf2f(c.Cb[(size_t)r * c.ldc + col]); }
        if (!chk_close(got, ref, 0.03f, 0.03f)) { chk_fail(diag, c.code); if (c.mode == 1) { atomicOr(diag + 24 + (i >> 5), 1u << (i & 31)); atomicOr(diag + 26, 1u << ((r & 255) >> 4)); atomicOr(diag + 20 + ((col & 127) >> 5), 1u << (col & 31)); atomicAdd(diag + 16, 1u); atomicMin(diag + 17, (unsigned)(col >> 8)); atomicMax(diag + 18, (unsigned)(col >> 8)); if (fabsf(got - dot) <= 0.03f + 0.03f * fabsf(dot)) atomicAdd(diag + 19, 1u); } }
    }
}
__global__ void k_chk_branch(const bf16_t* ocat, const float* wbr  , const bf16_t* xn, const float* win  , const bf16_t* GH, unsigned code, unsigned* diag) {
    const int i = blockIdx.x; const int r = samp_row(i);
    for (int cc = threadIdx.x; cc < 96; cc += blockDim.x) {
        const int col = (int)(((unsigned)cc * 40503u + (unsigned)i * 977u) % 3072u); const int b = col >> 10, cl = col & 1023;
        float h = 0.f; for (int k = 0; k < 512; ++k) h += bf2f(ocat[(size_t)b * MTOK * 512 + (size_t)r * 512 + k]) * wbr[((size_t)b * 512 + k) * 1024 + cl];
        float g = 0.f; for (int k = 0; k < 1024; ++k) g += bf2f(xn[(size_t)r * D + k]) * win[(size_t)k * INCOLS + PCOLS + col];
        const float ref = sigmoidf_(g) * h, got = bf2f(GH[(size_t)r * GCOLS + col]);
        if (!chk_close(got, ref, 0.03f, 0.04f)) chk_fail(diag, code);
    }
}
__global__ void k_chk_mix(const bf16_t* ocat, const float* wbr  , const bf16_t* Gt, const bf16_t* mix, unsigned code, unsigned* diag) {
    const int i = blockIdx.x; const int r = samp_row(i);
    for (int cc = threadIdx.x; cc < 96; cc += blockDim.x) {
        const int col = (int)(((unsigned)cc * 40503u + (unsigned)i * 977u) % 1024u); float ref = 0.f;
        for (int b = 0; b < 3; ++b) { float h = 0.f; for (int k = 0; k < 512; ++k) h += bf2f(ocat[(size_t)b * MTOK * 512 + (size_t)r * 512 + k]) * wbr[((size_t)b * 512 + k) * 1024 + col]; ref += bf2f(Gt[(size_t)r * GCOLS + b * 1024 + col]) * h; }
        if (!chk_close(bf2f(mix[(size_t)r * D + col]), ref, 0.03f, 0.04f)) chk_fail(diag, code);
    }
}
__global__ void k_chk_attn(const bf16_t* P, const float* gq, const float* gk, const bf16_t* oc, unsigned code, unsigned* diag) {
    const int id = blockIdx.x, lane = threadIdx.x; const int ti = id % 10;
    const int t = ti == 0 ? 0 : ti == 1 ? 1 : ti == 2 ? 2 : ti == 3 ? 63 : ti == 4 ? 64 : ti == 5 ? 65 : ti == 6 ? 200 : ti == 7 ? 1000 : ti == 8 ? 4097 : 8191;
    const int h = (id / 10) % 8, b = id / 80; const size_t tokb = (size_t)b * SEQ;
    float q = bf2f(P[(tokb + t) * PCOLS + C_SQ + h * 64 + lane]); q = q * rsqrtf(wave_sum(q * q) / 64.f + EPS) * gq[lane];
    float o = 0.f, carry = 0.f;
    for (int s = t - 1; s >= 0 && carry < 300.f; --s) {
        float kv = bf2f(P[(tokb + s) * PCOLS + C_SK + h * 64 + lane]); kv = kv * rsqrtf(wave_sum(kv * kv) / 64.f + EPS) * gk[lane];
        const float z = wave_sum(q * kv) * 0.125f; const float sp = logf(1.f + expf(z));
        carry += sp; const float A = expf(z - carry);
        o += A * bf2f(P[(tokb + s) * PCOLS + C_SV + h * 64 + lane]);
    }
    if (!chk_close(bf2f(oc[(tokb + t) * 512 + h * 64 + lane]), o, 0.02f, 0.03f)) chk_fail(diag, code);
}
__global__ void k_chk_gmlp(const bf16_t* P, const float* ws_l, const float* bs_l, const float* gv_l, const bf16_t* ob, unsigned code, unsigned* diag) {
    const int id = blockIdx.x * blockDim.x + threadIdx.x; if (id >= 512) return;
    const int chunk = (id * 37) % (MTOK / 128), t = (id * 53 + 7) % 128, ch = (id * 101 + 3) % 512, g = ch >> 7, c = ch & 127; const size_t tok0 = (size_t)chunk * 128;
    float acc = 0.f;
    for (int s = 0; s <= t; ++s) { float ss = 0.f; for (int k = 0; k < 512; ++k) { const float v = bf2f(P[(tok0 + s) * PCOLS + C_GV + k]); ss += v * v; }
        const float vn = bf2f(P[(tok0 + s) * PCOLS + C_GV + ch]) * rsqrtf(ss / 512.f + EPS) * gv_l[ch]; acc += ws_l[(size_t)g * 16384 + t * 128 + s] * vn; }
    const float ref = bf2f(P[(tok0 + t) * PCOLS + C_GU + ch]) * (acc + bs_l[g * 128 + t]);
    if (!chk_close(bf2f(ob[(tok0 + t) * 512 + ch]), ref, 0.02f, 0.03f)) chk_fail(diag, code);
}
__global__ void k_chk_hgrn(const bf16_t* P, const float* gain, const bf16_t* oa, unsigned code, unsigned* diag) {
    const int id = blockIdx.x; const int ti = id % 8; const int t = ti == 0 ? 0 : ti == 1 ? 1 : ti == 2 ? 5 : ti == 3 ? 63 : ti == 4 ? 64 : ti == 5 ? 200 : ti == 6 ? 511 : 700, h = (id / 8) % 4, b = id / 32; const int v = threadIdx.x; const size_t tokb = (size_t)b * SEQ;
    float o = 0.f;
    for (int d = 0; d < 128; ++d) { float st = 0.f;
        for (int s = 0; s <= t; ++s) { const bf16_t* row = P + (tokb + s) * PCOLS; const float f = expf(bf2f(row[C_HF + h * 128 + d])); st = f * st + (1.f - f) * bf2f(row[C_HI + h * 128 + v]); }
        o += bf2f(P[(tokb + t) * PCOLS + C_HQ + h * 128 + d]) * st; }
    __shared__ float red[128]; red[v] = o * o; __syncthreads();
    for (int w = 64; w > 0; w >>= 1) { if (v < w) red[v] += red[v + w]; __syncthreads(); }
    const float rstd = rsqrtf(red[0] / 128.f + EPS);
    const float ref = o * rstd * gain[v] * bf2f(P[(tokb + t) * PCOLS + C_HG + h * 128 + v]);
    if (!chk_close(bf2f(oa[(tokb + t) * 512 + h * 128 + v]), ref, 0.03f, 0.04f)) chk_fail(diag, code);
}
__global__ void k_chk_moe(const bf16_t* xn, const float* rw, const float* rb, const float* wg, const float* wu, const float* wd, const float* snap, const float* xout, unsigned code, unsigned* diag) {
    const int i = blockIdx.x; const int r = samp_row(i); const int tid = threadIdx.x;
    __shared__ float hid[DFF]; __shared__ float lg[8]; __shared__ float part[256];
    if (tid < 8) { float a = rb[tid]; for (int k = 0; k < D; ++k) a += bf2f(xn[(size_t)r * D + k]) * rw[k * 8 + tid]; lg[tid] = a; }
    __syncthreads();
    int i0 = 0; for (int e = 1; e < 8; ++e) if (lg[e] > lg[i0]) i0 = e;
    int i1 = -1; for (int e = 0; e < 8; ++e) if (e != i0 && (i1 < 0 || lg[e] > lg[i1])) i1 = e;
    const float w0 = 1.f / (1.f + expf(lg[i1] - lg[i0])), w1 = 1.f - w0;
    float outv[8]; for (int j = 0; j < 8; ++j) outv[j] = 0.f;
    for (int kk = 0; kk < 2; ++kk) { const int e = kk ? i1 : i0; const float wgt = kk ? w1 : w0;
        for (int f = tid; f < DFF; f += blockDim.x) { float g = 0.f, u = 0.f; for (int k = 0; k < D; ++k) { const float xv = bf2f(xn[(size_t)r * D + k]); g += xv * wg[((size_t)e * D + k) * DFF + f]; u += xv * wu[((size_t)e * D + k) * DFF + f]; } hid[f] = siluf_(g) * u; }
        __syncthreads();
        for (int j = 0; j < 8; ++j) { const int col = (j * 131 + i * 17) % D; float p = 0.f; for (int f = tid; f < DFF; f += blockDim.x) p += hid[f] * wd[((size_t)e * DFF + f) * D + col];
            part[tid] = p; __syncthreads(); for (int w = 128; w > 0; w >>= 1) { if (tid < w) part[tid] += part[tid + w]; __syncthreads(); } outv[j] += wgt * part[0]; __syncthreads(); }
    }
    if (tid == 0) for (int j = 0; j < 8; ++j) { const int col = (j * 131 + i * 17) % D; const float ref = snap[(size_t)i * D + col] + outv[j]; if (!chk_close(xout[(size_t)r * D + col], ref, 0.04f, 0.04f)) chk_fail(diag, code); }
}
#endif

struct Args { const float* in[21]; float* out; unsigned char* ws; int lo, hi; };
constexpr int NSTEPS = 25;
__device__ __forceinline__ int laneid_() { int v; asm volatile("v_mbcnt_lo_u32_b32 %0, -1, 0\n\tv_mbcnt_hi_u32_b32 %0, -1, %0" : "=v"(v)); return v; }
#define LANEID (laneid_())

__device__ __forceinline__ int cw_(LAS unsigned* cblk, int i) { unsigned z; asm volatile("v_mov_b32 %0, 0" : "=v"(z)); return (int)__builtin_amdgcn_readfirstlane(((LAS unsigned*)((LAS unsigned char*)cblk + z))[i]); }
#ifndef MK_ALIGN
#define MK_ALIGN true
#endif
#ifndef MK_SP2_F8
#define MK_SP2_F8 true
#endif
#ifndef MK_SP2
#define MK_SP2 true
#endif
#ifndef STAG_IN
#define STAG_IN 0
#define STAG_G 0
#define STAG_GU 0
#define STAG_MGU 0
#endif
#ifndef L1_F8
#define L1_F8 false
#endif
#ifndef FFN_F8
#define FFN_F8 false
#endif
template <class Epi, bool VARNT = false, int NSEG = 1, bool FP8 = false>
__device__ __forceinline__ void run_gemm(LAS unsigned char* lds, const Order& S, int K, const Epi& E, int wid, int stagger = 0) {
    if (stagger && ((S.c >> 3) & 1)) { for (int i = 0; i < stagger; ++i) __builtin_amdgcn_s_sleep(127); }
    pg8::gemm_phase<Epi, Order, MK_ALIGN, (FP8 ? MK_SP2_F8 : MK_SP2), VARNT, NSEG, FP8>(lds, K, S, E, wid); }

__global__ void __launch_bounds__(NTHREADS, 2) mk_fwd(Args a) {
    extern __shared__ __attribute__((aligned(16))) unsigned char lds_raw[];
    LAS unsigned char* lds = (LAS unsigned char*)lds_raw;
    const int wid = __builtin_amdgcn_readfirstlane((int)threadIdx.x >> 6);
    LAS unsigned* cblk = (LAS unsigned*)(lds + LDS_MISC);
    { const int tid = threadIdx.x;
      if (tid < 4) cblk[tid] = (tid == 2) ? xb_xcc_id() : 0u;
      if (tid < 46) { const unsigned long long pv = (tid < 42) ? (unsigned long long)a.in[tid >> 1] : (tid < 44) ? (unsigned long long)a.out : (unsigned long long)a.ws; cblk[4 + tid] = (tid & 1) ? (unsigned)(pv >> 32) : (unsigned)pv; }
      if (tid == 46) cblk[50] = (unsigned)a.lo; if (tid == 47) cblk[51] = (unsigned)a.hi; }
    __syncthreads();
#define CW(i) cw_(cblk, (i))
typedef __attribute__((address_space(1))) unsigned char gu8_t;
#define ARGP(i) ((unsigned char*)(gu8_t*)(((unsigned long long)(unsigned)CW(5 + 2 * (i)) << 32) | (unsigned long long)(unsigned)CW(4 + 2 * (i))))
#define IN(i) ((const float*)ARGP(i))
#define OUTP ((float*)ARGP(21))
#define WSP (ARGP(22))
#define GSZ ((int)gridDim.x)
#define WGI ((int)blockIdx.x)
    if (CW(51) - CW(50) > 1 && threadIdx.x == 0) (void)xb_add((unsigned*)(WSP + WS_CTL + CW_BAR) + XB_XCNT(CW(2)), 1u);
#ifndef PROBE_REP
#define PROBE_REP 0ull
#endif
#define RUN(k) (CW(50) <= (k) && (k) < CW(51))
#define NREP(bit) (((PROBE_REP >> (bit)) & 1ull) ? 2 : 1)
#define SEAM(k) do { if (CW(50) <= (k) && (k) + 1 < CW(51)) { XcdBarrier bar_; bar_.bar = (unsigned*)(WSP + WS_CTL + CW_BAR); bar_.x = (unsigned)CW(2); bar_.st = (volatile LAS unsigned*)cblk; xcd_barrier(bar_); if (PROBE_REP & (1ull << 40)) xcd_barrier(bar_); } } while (0)

#define R16 ((bf16_t*)OUTP)
#define R16B ((bf16_t*)(WSP + WS_MHID + (size_t)MOE_MAXBLK * 256 * DFF))
#define WIN ((bf16_t*)(WSP + WS_WIN))
#define WBR ((bf16_t*)(WSP + WS_WBR))
#define WOUT ((bf16_t*)(WSP + WS_WOUT))
#define WGU ((bf16_t*)(WSP + WS_WGU))
#define WDN ((bf16_t*)(WSP + WS_WD))
#define XNB ((bf16_t*)(WSP + WS_XN))
#define PBUF ((bf16_t*)(WSP + WS_P))
#define GBUF ((bf16_t*)(WSP + WS_G))
#define HIDB ((bf16_t*)(WSP + WS_HID))
#define OCATB ((bf16_t*)(WSP + WS_OCAT))
#define MWGU ((bf16_t*)(WSP + WS_MWGU))
#define MWDN ((bf16_t*)(WSP + WS_MWD))
#define XSB ((bf16_t*)(WSP + WS_XS))
#define MHIDB ((bf16_t*)(WSP + WS_MHID))
#define LBB ((float*)(WSP + WS_LB))
#define METAB ((int*)(WSP + WS_META))
#define TOKE ((int*)(WSP + WS_TOKE))
#define TOKW ((float2*)(WSP + WS_TOKW))
#define STOK ((int*)(WSP + WS_SLOTTOK))
#define SWB ((float*)(WSP + WS_SLOTW))
#define BLKE ((int*)(WSP + WS_BLKE))
#define SLABB ((bf16_t*)(WSP + WS_SLAB))
#define HDUMP ((uint2*)(WSP + WS_ORAW))
#define HU ((bf16_t*)(WSP + WS_ORAW + HG_DUMP_BYTES))
#define HDSC ((float*)(WSP + WS_ORAW + HG_DUMP_BYTES + HG_U_BYTES))
#define TIDV (wid * 64 + LANEID)
    for (int rep_ = 0; rep_ < NREP(0); ++rep_) if (RUN(0)) {
        LAS float* tile = (LAS float*)lds; const int tid = TIDV;
#pragma unroll 1
        for (int j = 0; j < 13; ++j) {
            const float* src; bf16_t* dst; int K, N, mode = 0, perm = 1, f8 = 0;
            if (j < 10) { const int l = j / 5, r = j % 5;
                if (r == 0) { src = IN(2) + (size_t)l * D * INCOLS; dst = WIN + (size_t)l * INCOLS * D; K = D; N = INCOLS;  f8 = (L1_F8 && l == 1) ? 1 : 0; }
                else if (r < 4) { src = IN(10) + (size_t)(l * 3 + r - 1) * 512 * D; dst = WBR + (size_t)(l * 3 + r - 1) * D * 512; K = 512; N = D; }
                else { src = IN(11) + (size_t)l * D * D; dst = WOUT + (size_t)l * D * D; K = D; N = D; } }
            else if (j == 10) { src = IN(13); dst = WGU; K = D; N = DFF; mode = 1; }
            else if (j == 11) { src = IN(14); dst = WGU; K = D; N = DFF; mode = 2; }
            else { src = IN(15); dst = WDN; K = DFF; N = D; }
            tc_job(src, K, N, dst, mode, perm, tile, WGI, GSZ, tid, (FFN_F8 && j >= 10) ? 1 : f8);
        }
        if (WGI == 0) { const float a0 = IN(3)[tid], a1 = IN(3)[512 + tid]; LBB[tid] = 0.f; LBB[512 + tid] = sigmoidf_(a1 - a0); }
    }
    if (RUN(0)) { __syncthreads(); phase_rmsnorm<false, false, false>(IN(0), IN(1), XNB, nullptr, nullptr, nullptr, nullptr, WGI, GSZ, wid, LANEID); }
    SEAM(0);

    for (int l = 0; l < 2; ++l) {
        const int sb = l * 10;
        if (l == 1) { for (int rep_ = 0; rep_ < NREP(1); ++rep_) if (RUN(10)) phase_rmsnorm<false, L1_F8>(R16, IN(1) + D, XNB, nullptr, nullptr, nullptr, nullptr, WGI, GSZ, wid, LANEID); SEAM(10); }
        for (int rep_ = 0; rep_ < NREP(2); ++rep_) if (RUN(sb + 1)) { EpiAct E{PBUF, PCOLS, LBB + l * 512, 1};
            if (!L1_F8 || l == 0) { Order S; S.init(XNB, WIN + (size_t)l * INCOLS * D, MTOK, PCOLS, D, GSZ, WGI); run_gemm(lds, S, D, E, wid, STAG_IN); }
            else { Order S; S.init(XNB, WIN + (size_t)l * INCOLS * D, MTOK, PCOLS, D, GSZ, WGI, 0, 0, 0, nullptr, 0, 1); run_gemm<EpiAct, false, 1, true>(lds, S, D, E, wid); } }
        SEAM(sb + 1);
        for (int rep_ = 0; rep_ < NREP(3); ++rep_) if (RUN(sb + 2)) {
            for (int r2 = 0; r2 < NREP(13); ++r2) { phase_hgrn_a(PBUF, OCATB, HDUMP, HU, HDSC, lds, WGI, GSZ, TIDV, wid, LANEID);
            __syncthreads(); }
            for (int r2 = 0; r2 < NREP(14); ++r2) { phase_attn(PBUF, IN(8) + l * 64, IN(9) + l * 64, OCATB + (size_t)2 * MTOK * 512, lds, WGI, GSZ, TIDV, wid, LANEID);
            __syncthreads(); }
            for (int r2 = 0; r2 < NREP(15); ++r2) { phase_gmlp(PBUF, IN(6) + (size_t)l * 4 * 16384, IN(7) + l * 512, IN(5) + l * 512, OCATB + (size_t)MTOK * 512, lds, WGI, GSZ, TIDV, wid, LANEID); __syncthreads(); }
        }
        SEAM(sb + 2);
        if (RUN(sb + 3)) phase_hgrn_c(PBUF, OCATB, HDUMP, HU, HDSC, IN(4) + l * 128, lds, WGI, GSZ, TIDV, wid, LANEID);
        SEAM(sb + 3);
        for (int rep_ = 0; rep_ < NREP(4); ++rep_) if (RUN(sb + 4)) { EpiAct E{GBUF, GCOLS, nullptr, 0};
            if (!L1_F8 || l == 0) { Order S; S.init(XNB, WIN + (size_t)l * INCOLS * D + (size_t)PCOLS * D, MTOK, GCOLS, D, GSZ, WGI); run_gemm(lds, S, D, E, wid, STAG_G); }
            else { Order S; S.init(XNB, (const unsigned char*)(WIN + (size_t)l * INCOLS * D) + (size_t)PCOLS * D, MTOK, GCOLS, D, GSZ, WGI, 0, 0, 0, nullptr, 0, 1); run_gemm<EpiAct, false, 1, true>(lds, S, D, E, wid); } }
        SEAM(sb + 4);
        for (int rep_ = 0; rep_ < NREP(12); ++rep_) if (RUN(sb + 5)) { Order S; S.init(OCATB, WBR + (size_t)l * 3 * D * 512, MTOK, GCOLS, 512, GSZ, WGI, 4, (size_t)MTOK * 512 * 2, (size_t)D * 512 * 2); EpiBranchSeg E{GBUF, XNB}; run_gemm<EpiBranchSeg, false, 3>(lds, S, 512, E, wid); }
        SEAM(sb + 5);
        if (RUN(sb + 6)) { Order S; S.init(XNB, WOUT + (size_t)l * D * D, MTOK, D, D, GSZ, WGI);
            if (l == 0) { EpiResidT<true> E{IN(0), R16}; run_gemm(lds, S, D, E, wid); } else { EpiResidT<false> E{R16, R16}; run_gemm(lds, S, D, E, wid); } }
        SEAM(sb + 6);
        if (l == 0) {
            for (int rep_ = 0; rep_ < NREP(6); ++rep_) if (RUN(7)) phase_rmsnorm<false, FFN_F8>(R16, IN(12), XNB, nullptr, nullptr, nullptr, nullptr, WGI, GSZ, wid, LANEID);
            SEAM(7);
            for (int rep_ = 0; rep_ < NREP(7); ++rep_) if (RUN(8)) { Order S; S.init(XNB, WGU, MTOK, 2 * DFF, D, GSZ, WGI, 0, 0, 0, nullptr, 0, FFN_F8 ? 1 : 2); EpiGUT<FFN_F8> E{HIDB}; run_gemm<EpiGUT<FFN_F8>, false, 1, FFN_F8>(lds, S, D, E, wid, STAG_GU); }
            SEAM(8);
            if (RUN(9)) { Order S; S.init(HIDB, WDN, MTOK, D, DFF, GSZ, WGI, 0, 0, 0, nullptr, 0, FFN_F8 ? 1 : 2); EpiResidT<false> E{R16, R16}; run_gemm<EpiResidT<false>, false, 1, FFN_F8>(lds, S, DFF, E, wid); }
            SEAM(9);
        } else {
            for (int rep_ = 0; rep_ < NREP(8); ++rep_) if (RUN(17)) phase_rmsnorm<true>(R16, IN(12) + D, XNB, IN(16), IN(17), TOKE, TOKW, WGI, GSZ, wid, LANEID);
            SEAM(17);
            for (int rep_ = 0; rep_ < NREP(9); ++rep_) if (RUN(18)) {
                if (WGI >= GSZ - 4) moe_assign(TOKE, TOKW, METAB, STOK, SWB, BLKE, lds, TIDV, WGI - (GSZ - 4));
                else { LAS float* tile = (LAS float*)lds; const int tid = TIDV;
#pragma unroll 1
                    for (int j = 0; j < 3 * NEXP; ++j) { const int e = j / 3, r = j % 3;
                        const float* src = (r == 0 ? IN(18) : r == 1 ? IN(19) : IN(20)) + (size_t)e * D * DFF;
                        bf16_t* dst = (bf16_t*)((r == 2) ? (unsigned char*)MWDN + (size_t)e * D * DFF : (unsigned char*)MWGU + (size_t)e * 2 * DFF * D);
                        tc_job_w(src, r == 2 ? DFF : D, r == 2 ? D : DFF, dst, r == 2 ? 0 : r + 1, 1, tile, WGI, GSZ - 4, wid, LANEID, 1); } }
            }
            SEAM(18);
#define META(i) __hip_atomic_load(METAB + (i), __ATOMIC_RELAXED, __HIP_MEMORY_SCOPE_AGENT)
#define MOE_BMAP(rows_, s0_) do { LAS int* bl_ = (LAS int*)(lds + 131072); const int nb_ = (rows_) >> 8; for (int i_ = TIDV; i_ < nb_; i_ += NTHREADS) bl_[i_] = __hip_atomic_load(BLKE + ((s0_) >> 8) + i_, __ATOMIC_RELAXED, __HIP_MEMORY_SCOPE_AGENT); __syncthreads(); } while (0)
            if (RUN(19)) { const int rows = META(0), s0 = META(2); moe_gather((const unsigned char*)XNB, STOK + s0, rows, (unsigned char*)XSB, WGI, GSZ, wid, LANEID); }
            SEAM(19);
            for (int kc = 0; kc < 2; ++kc) {
                const int se = 20 + 2 * kc;
                for (int rep_ = 0; rep_ < NREP(11); ++rep_) if (RUN(se)) { const int rows = META(kc), s0 = META(2 + kc);
                    if (kc == 1) { const int rows0 = META(0), s00 = META(2); Order T; T.init(MHIDB, MWDN, rows0, D, DFF, GSZ, WGI, 2, 0, (size_t)D * DFF, BLKE + (s00 >> 8), 1, 1);
                        moe_tail_reduce(T, SLABB, R16, R16B, 0, STOK + s00, SWB + s00, WGI, GSZ, wid, LANEID); }
                    MOE_BMAP(rows, s0); Order S; S.init(XSB, MWGU, rows, 2 * DFF, D, GSZ, WGI, 2, 0, (size_t)2 * DFF * D, BLKE + (s0 >> 8), 0, 1); S.bmapl = (const LAS int*)(lds + 131072); EpiGUT<true> E{MHIDB}; run_gemm<EpiGUT<true>, false, 1, true>(lds, S, D, E, wid, STAG_MGU); }
                SEAM(se);
                if (RUN(se + 1)) { const int rows = META(kc), s0 = META(2 + kc);
                    MOE_BMAP(rows, s0); Order S; S.init(MHIDB, MWDN, rows, D, DFF, GSZ, WGI, 2, 0, (size_t)D * DFF, BLKE + (s0 >> 8), 1, 1); S.bmapl = (const LAS int*)(lds + 131072); EpiMoeDown E{kc == 0 ? R16 : R16B, kc == 0 ? (void*)R16B : (void*)OUTP, kc, STOK + s0, SWB + s0, SLABB}; run_gemm<EpiMoeDown, true, 1, true>(lds, S, DFF, E, wid);
                    if (kc == 0) { const int rows1 = META(1), s1 = META(3); moe_gather((const unsigned char*)XNB, STOK + s1, rows1, (unsigned char*)XSB, WGI, GSZ, wid, LANEID); } }
                SEAM(se + 1);
            }
            if (RUN(24)) { const int rows1 = META(1), s1 = META(3); Order T; T.init(MHIDB, MWDN, rows1, D, DFF, GSZ, WGI, 2, 0, (size_t)D * DFF, BLKE + (s1 >> 8), 1, 1);
                moe_tail_reduce(T, SLABB, R16B, OUTP, 1, STOK + s1, SWB + s1, WGI, GSZ, wid, LANEID); }
        }
    }
}

extern "C" void kernel_launch(void* const* d_in, const int* in_sizes, int n_in, void* d_out, int out_size, void* d_ws, size_t ws_size, hipStream_t stream) {
    static int grid = 0;
    if (grid == 0) {
        if (n_in != 21 || out_size != MTOK * D || ws_size < WS_NEED) { fprintf(stderr, "kernel_launch: unexpected shapes (n_in %d out %d ws %zu need %zu)\n", n_in, out_size, ws_size, (size_t)WS_NEED); grid = -1; return; }
        int dev = 0, cus = 0, per_cu = 0;
        if (hipGetDevice(&dev) != hipSuccess || hipDeviceGetAttribute(&cus, hipDeviceAttributeMultiprocessorCount, dev) != hipSuccess) { grid = -1; return; }
        if (hipFuncSetAttribute((const void*)mk_fwd, hipFuncAttributeMaxDynamicSharedMemorySize, LDS_BYTES) != hipSuccess) { fprintf(stderr, "kernel_launch: hipFuncSetAttribute failed\n"); grid = -1; return; }
        if (hipOccupancyMaxActiveBlocksPerMultiprocessor(&per_cu, (const void*)mk_fwd, NTHREADS, LDS_BYTES) != hipSuccess || per_cu < 1) { fprintf(stderr, "kernel_launch: occupancy query says %d\n", per_cu); (void)hipGetLastError(); per_cu = 1; }
        grid = cus;
    }
    if (grid < 0) return;
    (void)hipMemsetAsync((char*)d_ws + WS_CTL, 0, CTL_BYTES, stream);
    Args a{};
    for (int i = 0; i < 21; ++i) a.in[i] = (const float*)d_in[i];
    a.out = (float*)d_out; a.ws = (unsigned char*)d_ws;
#if defined(MK_CHECK)
    {
        unsigned char* ws = (unsigned char*)d_ws; unsigned* diag = (unsigned*)(ws + WS_DIAG); float* snap = (float*)(ws + WS_SNAP);
        const bf16_t* XN = (const bf16_t*)(ws + WS_XN); const bf16_t* Pb = (const bf16_t*)(ws + WS_P); const bf16_t* OC = (const bf16_t*)(ws + WS_OCAT); const float* LB = (const float*)(ws + WS_LB);
        auto run = [&](int s) { a.lo = s; a.hi = s + 1; hipLaunchKernelGGL(mk_fwd, dim3(grid), dim3(NTHREADS), LDS_BYTES, stream, a); };
        hipLaunchKernelGGL(k_diag_init, dim3(1), dim3(64), 0, stream, diag);
        int s = 0; run(s++);
        for (int l = 0; l < 2; ++l) {
            const unsigned cb = l * 10;
            const float* win = a.in[2] + (size_t)l * D * INCOLS;
            if (l == 1) run(s++);
            run(s++);
            { ChkGemm c{}; c.A = XN; c.lda = D; c.W = win; c.ldw = INCOLS; c.K = D; c.mode = 0; c.Cb = Pb; c.ldc = PCOLS; c.lb = LB + l * 512; c.ncols = PCOLS; c.code = cb + 1; hipLaunchKernelGGL(k_chk_gemm, dim3(64), dim3(96), 0, stream, c, diag); }
            run(s++); run(s++);
            hipLaunchKernelGGL(k_chk_hgrn, dim3(128), dim3(128), 0, stream, Pb, a.in[4] + l * 128, OC, cb + 2, diag);
            hipLaunchKernelGGL(k_chk_gmlp, dim3(8), dim3(64), 0, stream, Pb, a.in[6] + (size_t)l * 4 * 16384, a.in[7] + l * 512, a.in[5] + l * 512, OC + (size_t)MTOK * 512, cb + 3, diag);
            hipLaunchKernelGGL(k_chk_attn, dim3(320), dim3(64), 0, stream, Pb, a.in[8] + l * 64, a.in[9] + l * 64, OC + (size_t)2 * MTOK * 512, cb + 4, diag);
            run(s++);
            { ChkGemm c{}; c.A = XN; c.lda = D; c.W = win + PCOLS; c.ldw = INCOLS; c.K = D; c.mode = 1; c.Cb = (const bf16_t*)(ws + WS_G); c.ldc = GCOLS; c.ncols = GCOLS; c.code = cb + 5; hipLaunchKernelGGL(k_chk_gemm, dim3(64), dim3(96), 0, stream, c, diag); }
            run(s++);
            hipLaunchKernelGGL(k_chk_mix, dim3(64), dim3(96), 0, stream, OC, a.in[10] + (size_t)l * 3 * 512 * D, (const bf16_t*)(ws + WS_G), XN, cb + 6, diag);
            if (l == 1) hipLaunchKernelGGL(k_snapshot, dim3(64), dim3(256), 0, stream, (const float*)d_out, snap);
            run(s++);
            { ChkGemm c{}; c.A = XN; c.lda = D; c.W = a.in[11] + (size_t)l * D * D; c.ldw = D; c.K = D; c.mode = 3; c.Cf = (const float*)d_out; c.xold = l ? snap : a.in[0]; c.use_snap = l; c.ncols = D; c.code = cb + 7; hipLaunchKernelGGL(k_chk_gemm, dim3(64), dim3(96), 0, stream, c, diag); }
            run(s++);
            if (l == 0) {
                run(s++);
                { ChkGemm c{}; c.A = XN; c.lda = D; c.W = a.in[13]; c.W2 = a.in[14]; c.ldw = DFF; c.K = D; c.mode = 4; c.Cb = (const bf16_t*)(ws + WS_HID); c.ldc = DFF; c.ncols = DFF; c.code = cb + 8; hipLaunchKernelGGL(k_chk_gemm, dim3(64), dim3(96), 0, stream, c, diag); }
                hipLaunchKernelGGL(k_snapshot, dim3(64), dim3(256), 0, stream, (const float*)d_out, snap);
                run(s++);
                { ChkGemm c{}; c.A = (const bf16_t*)(ws + WS_HID); c.lda = DFF; c.W = a.in[15]; c.ldw = D; c.K = DFF; c.mode = 3; c.Cf = (const float*)d_out; c.xold = snap; c.use_snap = 1; c.ncols = D; c.code = cb + 9; hipLaunchKernelGGL(k_chk_gemm, dim3(64), dim3(96), 0, stream, c, diag); }
            } else {
                hipLaunchKernelGGL(k_snapshot, dim3(64), dim3(256), 0, stream, (const float*)d_out, snap);
                for (int e = 0; e < 7; ++e) run(s++);
                hipLaunchKernelGGL(k_chk_moe, dim3(16), dim3(256), 0, stream, XN, a.in[16], a.in[17], a.in[18], a.in[19], a.in[20], (const float*)snap, (const float*)d_out, 20u, diag);
            }
        }
        if (s != NSTEPS) fprintf(stderr, "step count mismatch %d\n", s);
        hipLaunchKernelGGL(k_apply_diag, dim3(1024), dim3(256), 0, stream, (float*)d_out, (const unsigned*)diag);
    }
#elif !defined(MK_ONE_LAUNCH)
    for (int s = 0; s < NSTEPS; ++s) { a.lo = s; a.hi = s + 1; hipLaunchKernelGGL(mk_fwd, dim3(grid), dim3(NTHREADS), LDS_BYTES, stream, a); }
#else
    a.lo = 0; a.hi = NSTEPS; hipLaunchKernelGGL(mk_fwd, dim3(grid), dim3(NTHREADS), LDS_BYTES, stream, a);
#endif
}
```

```cpp
#define MK_ONE_LAUNCH 1
#include <hip/hip_runtime.h>
#include <cstdio>
#include <cstdint>
#include <cstddef>

#define LAS __attribute__((address_space(3)))
#define XB_TMO      128
#define XB_XCNT(j)  (256  + 64 * (j))
#define XB_XSUB(j)  (1280 + 64 * (j))
#define XB_XGEN(j)  (2304 + 64 * (j))
#define XB_TOP      3328
#define XB_TOPGEN   3392
#define XCD_BAR_WORDS 3456
#define XB_SPIN_CAP (1u << 18)

__device__ __forceinline__ unsigned xb_ld(unsigned* p)              { return __hip_atomic_load(p, __ATOMIC_RELAXED, __HIP_MEMORY_SCOPE_AGENT); }
__device__ __forceinline__ unsigned xb_add(unsigned* p, unsigned v) { return __hip_atomic_fetch_add(p, v, __ATOMIC_RELAXED, __HIP_MEMORY_SCOPE_AGENT); }
__device__ __forceinline__ unsigned xb_xcc_id() { return (unsigned)__builtin_amdgcn_s_getreg((3 << 11) | 20) & 0xFu; }
#define XB_SPIN(cond, bar) do { unsigned _sp = 0; while (cond) { __builtin_amdgcn_s_sleep(1); \
    if ((++_sp & 255u) == 0u) { if (xb_ld(&(bar)[XB_TMO])) break; if (_sp > XB_SPIN_CAP) { atomicAdd(&(bar)[XB_TMO], 1u); break; } } } } while (0)

struct XcdBarrier {
    unsigned* bar; unsigned x;
    volatile LAS unsigned* st;
};

__device__ __forceinline__ XcdBarrier xcd_barrier_post(unsigned* bar, volatile LAS unsigned* st) {
    XcdBarrier b; b.bar = bar; b.x = xb_xcc_id(); b.st = st;
    if (threadIdx.x == 0) (void)xb_add(&bar[XB_XCNT(b.x)], 1u);
    return b;
}
__device__ __forceinline__ void xcd_barrier_complete(unsigned* bar, unsigned x, unsigned& nloc, unsigned& nx) {
    const unsigned G = gridDim.x * gridDim.y * gridDim.z;
    unsigned sum, cnt, mine, sp = 0u;
    for (;;) {
        sum = 0u; cnt = 0u; mine = 0u;
#pragma unroll
        for (unsigned j = 0; j < 16; ++j) { const unsigned c = xb_ld(&bar[XB_XCNT(j)]); sum += c; cnt += (c > 0u) ? 1u : 0u; mine = (j == x) ? c : mine; }
        if (sum == G) break;
        __builtin_amdgcn_s_sleep(1);
        if ((++sp & 255u) == 0u) { if (xb_ld(&bar[XB_TMO])) break; if (sp > XB_SPIN_CAP) { atomicAdd(&bar[XB_TMO], 1u); break; } }
    }
    nloc = mine > 0u ? mine : 1u; nx = cnt > 0u ? cnt : 1u;
}

__device__ __forceinline__ void xcd_barrier(const XcdBarrier& b) {
    asm volatile("s_waitcnt vmcnt(0)" ::: "memory");
    __syncthreads();
    if (threadIdx.x == 0) {
        unsigned* bar = b.bar;
        __builtin_amdgcn_s_waitcnt(0);
        unsigned nloc = b.st[0], nx = b.st[1];
        if (nloc == 0u) { xcd_barrier_complete(bar, b.x, nloc, nx); b.st[0] = nloc; b.st[1] = nx; }
        const unsigned old = xb_add(&bar[XB_XSUB(b.x)], 1u);
        const unsigned gen = old / nloc;
        if (old + 1u == (gen + 1u) * nloc) {
            __builtin_amdgcn_fence(__ATOMIC_RELEASE, "agent");
            asm volatile("s_waitcnt vmcnt(0)" ::: "memory");
            const unsigned og = xb_add(&bar[XB_TOP], 1u);
            const unsigned tg = og / nx;
            if (og + 1u == (tg + 1u) * nx) xb_add(&bar[XB_TOPGEN], 1u);
            else XB_SPIN(xb_ld(&bar[XB_TOPGEN]) == tg, bar);
            __builtin_amdgcn_fence(__ATOMIC_ACQUIRE, "agent");
            xb_add(&bar[XB_XGEN(b.x)], 1u);
            asm volatile("s_waitcnt vmcnt(0)" ::: "memory");
        } else {
            XB_SPIN(xb_ld(&bar[XB_XGEN(b.x)]) == gen, bar);
            __builtin_amdgcn_fence(__ATOMIC_ACQUIRE, "agent");
            asm volatile("s_waitcnt vmcnt(0)" ::: "memory");
        }
    }
    __syncthreads();
}
#ifndef KLOOP_REP
#define KLOOP_REP 1
#endif
#ifndef EPI_REP
#define EPI_REP 1
#endif
namespace pg8 {
#define PG8_LAS __attribute__((address_space(3)))
typedef unsigned short bf16_t;
typedef short bf16x8 __attribute__((ext_vector_type(8)));
typedef float f32x4 __attribute__((ext_vector_type(4)));
typedef unsigned u32x4 __attribute__((ext_vector_type(4)));
constexpr int BM = 256, BK = 64, HALF = 128, HTB = HALF * BK * 2  , STAGE_BYTES = 8 * HTB, NXCD = 8, WGM = 8;

__host__ __device__ __forceinline__ int lds_byte(int r, int c) { const int st = (r >> 4) * 2 + (c >> 5), rr = r & 15, cc = c & 31, ob = rr * 64 + cc * 2; return st * 1024 + (ob ^ (((ob >> 9) & 1) << 5)); }
__host__ __device__ __forceinline__ void stage_rc(int b, int& R, int& C) { const int st = b / 1024, sb = b % 1024, swz = sb ^ (((sb >> 9) & 1) << 5); R = (st >> 1) * 16 + swz / 64; C = (st & 1) * 32 + (swz % 64) / 2; }
__host__ __device__ __forceinline__ int perm32(int rho) { const int n = rho >> 4, i = rho & 15; return 8 * (i >> 2) + 4 * n + (i & 3); }

struct Unit { int pm, pn; const char* a; const char* b; int nt, atomic; };

typedef float f32x2 __attribute__((ext_vector_type(2))); typedef __bf16 bf16x2_t __attribute__((ext_vector_type(2)));
__device__ __forceinline__ unsigned cvt_pk_bf16(float lo, float hi) { f32x2 v = {lo, hi}; bf16x2_t b = __builtin_convertvector(v, bf16x2_t); return __builtin_bit_cast(unsigned, b); }
template <class Epi, class Sched, bool ALIGN_EPI = false, bool SP2 = false, bool VARNT = false, int NSEG = 1, bool FP8 = false>
__device__ __forceinline__ void gemm_phase(PG8_LAS unsigned char* lds, const int K, const Sched& S, const Epi& E, const int wid) {
    int lane; asm volatile("v_mbcnt_lo_u32_b32 %0, -1, 0\n\tv_mbcnt_hi_u32_b32 %0, -1, %0" : "=v"(lane));
    const int tid = wid * 64 + lane, wr = wid >> 2, wc = wid & 3, fr = lane & 15, fq = lane >> 4;
    unsigned voffA[2];
#pragma unroll
    for (int i = 0; i < 2; ++i) { int R, C; stage_rc(tid * 16 + i * 8192, R, C); voffA[i] = FP8 ? (unsigned)(R * K + 2 * C) : (unsigned)(R * K + C) * 2u; }
    const size_t kstep = (size_t)(BK * 2);
    const size_t hstep = (size_t)HALF * K * (FP8 ? 1 : 2);
    const unsigned ldsw = (unsigned)wid * 1024u;
    const int aoff = FP8 ? lds_byte(wr * 64 + fr, fq * 16) : lds_byte(wr * 64 + fr, fq * 8), boff = FP8 ? lds_byte(wc * 32 + fr, fq * 16) : lds_byte(wc * 32 + fr, fq * 8);
    constexpr int KOFF = FP8 ? 16 : 1024;
    const int asw = FP8 ? (fq & 1) * 16 : 0;
    const int aoff1 = FP8 ? (aoff + (asw ^ 16)) : (aoff + KOFF), boff1 = FP8 ? (boff + (asw ^ 16)) : (boff + KOFF);
    const int aoff0 = aoff + asw, boff0 = boff + asw;
#define PG8_SA(b, h) (((b) * 2 + (h)) * HTB)
#define PG8_SB(b, h) ((4 + (b) * 2 + (h)) * HTB)
#define PG8_STAGE(bufoff, gbase, voff) do { _Pragma("unroll") for (int _i = 0; _i < 2; ++_i) { unsigned _vo = (voff)[_i]; asm volatile("" : "+v"(_vo));     \
        __builtin_amdgcn_global_load_lds((const unsigned*)((const char*)(gbase) + _vo), (PG8_LAS unsigned*)(lds + (bufoff) + ldsw + _i * 8192), 16, 0, 0); } } while (0)
#define PG8_LDA(dst, b, h) do { _Pragma("unroll") for (int m = 0; m < 4; ++m) _Pragma("unroll") for (int k = 0; k < 2; ++k) dst[m][k] = *(const PG8_LAS bf16x8*)(lds + PG8_SA(b, h) + (k ? aoff1 : aoff0) + m * 2048); } while (0)
#define PG8_LDB(dst, b, h) do { _Pragma("unroll") for (int n = 0; n < 2; ++n) _Pragma("unroll") for (int k = 0; k < 2; ++k) dst[n][k] = *(const PG8_LAS bf16x8*)(lds + PG8_SB(b, h) + (k ? boff1 : boff0) + n * 2048); } while (0)
#define PG8_MMA(ai, bj, At, Bt) do { __builtin_amdgcn_s_setprio(1); _Pragma("unroll") for (int m = 0; m < 4; ++m) _Pragma("unroll") for (int n = 0; n < 2; ++n) { \
        if constexpr (FP8) { typedef int v8i_ __attribute__((ext_vector_type(8))); struct P2_ { bf16x8 lo, hi; }; \
            const v8i_ b8_ = __builtin_bit_cast(v8i_, (P2_){Bt[n][0], Bt[n][1]}), a8_ = __builtin_bit_cast(v8i_, (P2_){At[m][0], At[m][1]}); \
            acc[ai][bj][m][n] = __builtin_amdgcn_mfma_scale_f32_16x16x128_f8f6f4(b8_, a8_, acc[ai][bj][m][n], 0, 0, 0, 0x79797979, 0, 0x7F7F7F7F); } \
        else { _Pragma("unroll") for (int k = 0; k < 2; ++k) acc[ai][bj][m][n] = __builtin_amdgcn_mfma_f32_16x16x32_bf16(Bt[n][k], At[m][k], acc[ai][bj][m][n], 0, 0, 0); } } \
        __builtin_amdgcn_s_setprio(0); } while (0)
#define PG8_WAIT_V(n) asm volatile("s_waitcnt vmcnt(" #n ")" ::: "memory")
#define PG8_WAIT_L(n) asm volatile("s_waitcnt lgkmcnt(" #n ")" ::: "memory")
#define PG8_BAR __builtin_amdgcn_s_barrier()
#define PG8_SCHED __builtin_amdgcn_sched_barrier(0)
    Unit cur, nxt; int ui = 0;
    if (!S.next(0, cur)) return;
    f32x4 acc[2][2][4][2];
#pragma unroll
    for (int a = 0; a < 2; ++a)
#pragma unroll
        for (int b = 0; b < 2; ++b)
#pragma unroll
            for (int m = 0; m < 4; ++m)
#pragma unroll
                for (int n = 0; n < 2; ++n) acc[a][b][m][n] = (f32x4){0.f, 0.f, 0.f, 0.f};
    bf16x8 At[4][2], B0[2][2], B1[2][2];
    const char* cA = cur.a; const char* cB = cur.b;
    S.a_ready(cur);
    if constexpr (SP2) {
        PG8_STAGE(PG8_SB(0, 0), cB, voffA); PG8_STAGE(PG8_SB(0, 1), cB + hstep, voffA); PG8_STAGE(PG8_SA(0, 0), cA, voffA); PG8_STAGE(PG8_SA(0, 1), cA + hstep, voffA);
        if (wr == 1) PG8_BAR;
        PG8_WAIT_V(2); PG8_BAR;
        PG8_STAGE(PG8_SB(1, 0), cB + kstep, voffA); PG8_STAGE(PG8_SA(1, 0), cA + kstep, voffA); PG8_STAGE(PG8_SB(1, 1), cB + hstep + kstep, voffA);
        PG8_WAIT_V(6); PG8_BAR;
    } else {
        PG8_STAGE(PG8_SB(0, 0), cB, voffA); PG8_STAGE(PG8_SA(0, 0), cA, voffA); PG8_STAGE(PG8_SB(0, 1), cB + hstep, voffA); PG8_STAGE(PG8_SA(0, 1), cA + hstep, voffA);
        if (wr == 1) PG8_BAR;
        PG8_WAIT_V(4); PG8_BAR;
        PG8_STAGE(PG8_SB(1, 0), cB + kstep, voffA); PG8_STAGE(PG8_SA(1, 0), cA + kstep, voffA); PG8_STAGE(PG8_SB(1, 1), cB + hstep + kstep, voffA);
        PG8_WAIT_V(6); PG8_BAR;
    }
    for (;;) {
        const bool has_next = S.next(ui + 1, nxt);
        const char* nA = has_next ? nxt.a : cA; const char* nB = has_next ? nxt.b : cB;
        const int nt = VARNT ? cur.nt : NSEG * (K / (FP8 ? 128 : BK)); constexpr bool SEGD = (NSEG > 1); const int KT = K / BK;
#if KLOOP_REP > 1
        int krep_ = KLOOP_REP; asm volatile("" : "+s"(krep_));
        const char* nA0_ = nA; const char* nB0_ = nB;
_Pragma("unroll 1")
        for (int kr_ = 0; kr_ < krep_; ++kr_) {
        if (kr_ > 0) {
_Pragma("unroll")
            for (int a = 0; a < 2; ++a)
_Pragma("unroll")
                for (int b = 0; b < 2; ++b)
_Pragma("unroll")
                    for (int m = 0; m < 4; ++m)
_Pragma("unroll")
                        for (int n = 0; n < 2; ++n) acc[a][b][m][n] = (f32x4){0.f, 0.f, 0.f, 0.f}; }
        nA = (kr_ == krep_ - 1) ? nA0_ : cA; nB = (kr_ == krep_ - 1) ? nB0_ : cB;
#endif
#pragma unroll 1
        for (int t = 0; t < nt; t += 2) {
            const bool last = (t == nt - 2);
            const char* a1 = SEGD ? cA + (size_t)((t + 1) / KT) * S.abr + (size_t)((t + 1) % KT) * kstep : cA + (size_t)(t + 1) * kstep;
            const char* a2 = last ? nA : (SEGD ? cA + (size_t)((t + 2) / KT) * S.abr + (size_t)((t + 2) % KT) * kstep : cA + (size_t)(t + 2) * kstep);
            const char* b2 = last ? nB : (SEGD ? cB + (size_t)((t + 2) / KT) * S.bbr + (size_t)((t + 2) % KT) * kstep : cB + (size_t)(t + 2) * kstep);
            const char* a3 = a2 + kstep; const char* b3 = b2 + kstep;
            if (last && has_next) S.a_ready(nxt);
            if constexpr (SP2) {
            PG8_LDB(B0, 0, 0); PG8_LDB(B1, 0, 1); PG8_SCHED; PG8_LDA(At, 0, 0); PG8_STAGE(PG8_SA(1, 1), a1 + hstep, voffA);
            PG8_WAIT_V(8); PG8_WAIT_L(0); PG8_BAR; PG8_MMA(0, 0, At, B0); PG8_MMA(0, 1, At, B1); PG8_BAR; PG8_SCHED;
            PG8_LDA(At, 0, 1); PG8_STAGE(PG8_SB(0, 0), b2, voffA); PG8_STAGE(PG8_SB(0, 1), b2 + hstep, voffA); PG8_STAGE(PG8_SA(0, 0), a2, voffA);
            PG8_WAIT_V(8); PG8_WAIT_L(0); PG8_BAR; PG8_MMA(1, 0, At, B0); PG8_MMA(1, 1, At, B1); PG8_BAR; PG8_SCHED;
            PG8_LDB(B0, 1, 0); PG8_LDB(B1, 1, 1); PG8_SCHED; PG8_LDA(At, 1, 0); PG8_STAGE(PG8_SA(0, 1), a2 + hstep, voffA);
            PG8_WAIT_V(8); PG8_WAIT_L(0); PG8_BAR; PG8_MMA(0, 0, At, B0); PG8_MMA(0, 1, At, B1); PG8_BAR; PG8_SCHED;
            PG8_LDA(At, 1, 1); PG8_STAGE(PG8_SB(1, 0), b3, voffA); PG8_STAGE(PG8_SB(1, 1), b3 + hstep, voffA); PG8_STAGE(PG8_SA(1, 0), a3, voffA);
            PG8_WAIT_V(8); PG8_WAIT_L(0); PG8_BAR; PG8_MMA(1, 0, At, B0); PG8_MMA(1, 1, At, B1); PG8_BAR; PG8_SCHED;
            } else {
            PG8_LDB(B0, 0, 0); PG8_SCHED; PG8_LDA(At, 0, 0); PG8_STAGE(PG8_SA(1, 1), a1 + hstep, voffA);
            PG8_WAIT_L(8); PG8_BAR; PG8_WAIT_L(0); PG8_MMA(0, 0, At, B0); PG8_BAR; PG8_SCHED;
            PG8_LDB(B1, 0, 1); PG8_STAGE(PG8_SB(0, 0), b2, voffA);
            PG8_BAR; PG8_WAIT_L(0); PG8_MMA(0, 1, At, B1); PG8_BAR;
            PG8_LDA(At, 0, 1); PG8_STAGE(PG8_SA(0, 0), a2, voffA);
            PG8_BAR; PG8_WAIT_L(0); PG8_MMA(1, 0, At, B0); PG8_BAR; PG8_SCHED;
            PG8_STAGE(PG8_SB(0, 1), b2 + hstep, voffA);
            PG8_WAIT_V(6); PG8_BAR; PG8_MMA(1, 1, At, B1); PG8_BAR;
            PG8_LDB(B0, 1, 0); PG8_SCHED; PG8_LDA(At, 1, 0); PG8_STAGE(PG8_SA(0, 1), a2 + hstep, voffA);
            PG8_WAIT_L(8); PG8_BAR; PG8_WAIT_L(0); PG8_MMA(0, 0, At, B0); PG8_BAR; PG8_SCHED;
            PG8_LDB(B1, 1, 1); PG8_STAGE(PG8_SB(1, 0), b3, voffA);
            PG8_BAR; PG8_WAIT_L(0); PG8_MMA(0, 1, At, B1); PG8_BAR;
            PG8_LDA(At, 1, 1); PG8_STAGE(PG8_SA(1, 0), a3, voffA);
            PG8_BAR; PG8_WAIT_L(0); PG8_MMA(1, 0, At, B0); PG8_BAR; PG8_SCHED;
            PG8_STAGE(PG8_SB(1, 1), b3 + hstep, voffA);
            PG8_WAIT_V(6); PG8_BAR; PG8_MMA(1, 1, At, B1); PG8_BAR;
            }
            if constexpr (SEGD) { if (((t + 2) % KT) == 0 && t + 2 < nt) E.mid(acc, cur, (t + 2) / KT - 1, wr, wc, fr, fq);
            }
        }
#if KLOOP_REP > 1
        }
#endif
        if constexpr (ALIGN_EPI) { if (wr == 0) PG8_BAR; }
        if constexpr (!Epi::AFTER_DRAIN) { int l2_; asm volatile("v_mbcnt_lo_u32_b32 %0, -1, 0\n\tv_mbcnt_hi_u32_b32 %0, -1, %0" : "=v"(l2_));
            if constexpr (EPI_REP > 1 && Epi::IDEM) { int nrep_ = EPI_REP; asm volatile("" : "+s"(nrep_));
_Pragma("unroll 1")
                for (int er_ = 0; er_ < nrep_; ++er_) { asm volatile("v_mbcnt_lo_u32_b32 %0, -1, 0\n\tv_mbcnt_hi_u32_b32 %0, -1, %0" : "=v"(l2_)); E(acc, cur, wr, wc, l2_ & 15, l2_ >> 4); } }
            else E(acc, cur, wr, wc, l2_ & 15, l2_ >> 4);
            S.done(cur); }
        if (!has_next) break;
#pragma unroll
        for (int a = 0; a < 2; ++a)
#pragma unroll
            for (int b = 0; b < 2; ++b)
#pragma unroll
                for (int m = 0; m < 4; ++m)
#pragma unroll
                    for (int n = 0; n < 2; ++n) acc[a][b][m][n] = (f32x4){0.f, 0.f, 0.f, 0.f};
        cur = nxt; cA = nA; cB = nB; ++ui;
        if constexpr (ALIGN_EPI) { if (wr == 1) PG8_BAR; }
    }
    PG8_WAIT_V(0);
    if constexpr (!ALIGN_EPI) { if (wr == 0) PG8_BAR; }
    PG8_BAR;
    if constexpr (Epi::AFTER_DRAIN) { E.fused(acc, cur, wr, wc, fr, fq, lds, wid, lane); S.done(cur); }
#undef PG8_SA
#undef PG8_SB
#undef PG8_STAGE
#undef PG8_LDA
#undef PG8_LDB
#undef PG8_MMA
#undef PG8_WAIT_V
#undef PG8_WAIT_L
#undef PG8_BAR
#undef PG8_SCHED
}
}

typedef pg8::bf16_t bf16_t;
typedef pg8::f32x4 f32x4;
typedef pg8::u32x4 u32x4;
using pg8::cvt_pk_bf16;
constexpr int NB = 4, SEQ = 8192, D = 1024, MTOK = NB * SEQ;
constexpr int PCOLS = 4608, GCOLS = 3072, INCOLS = 7680, DFF = 3584, NEXP = 8;
constexpr int C_HQ = 0, C_HF = 512, C_HI = 1024, C_HG = 1536, C_GU = 2048, C_GV = 2560, C_SQ = 3072, C_SK = 3584, C_SV = 4096;
constexpr float EPS = 1e-6f;
constexpr int NSLOT = 2 * MTOK + 2 * NEXP * 256, MOE_MAXBLK = MTOK / 256 + NEXP;
constexpr int NTHREADS = 512, NWAVES = 8;
constexpr int LDS_BYTES = 147456, LDS_MISC = LDS_BYTES - 256;

constexpr size_t WS_CTL = 0, CTL_BYTES = 65536;
constexpr size_t CW_BAR = 0;
constexpr size_t WS_META = WS_CTL + CTL_BYTES;
constexpr size_t WS_LB = WS_META + 4096;
constexpr size_t WS_TOKE = WS_LB + 4096;
constexpr size_t WS_TOKW = WS_TOKE + (size_t)MTOK * 4;
constexpr size_t WS_SLOTTOK = WS_TOKW + (size_t)MTOK * 8;
constexpr size_t WS_SLOTW = WS_SLOTTOK + (size_t)NSLOT * 4;
constexpr size_t WS_BLKE = WS_SLOTW + (size_t)NSLOT * 4;
constexpr size_t WS_W = 2u << 20;
static_assert(WS_BLKE + 4096 <= WS_W, "small buffers");
constexpr size_t WS_WIN = WS_W;
constexpr size_t WS_WBR = WS_WIN + (size_t)2 * INCOLS * D * 2;
constexpr size_t WS_WOUT = WS_WBR + (size_t)2 * 3 * D * 512 * 2;
constexpr size_t WS_WGU = WS_WOUT + (size_t)2 * D * D * 2;
constexpr size_t WS_WD = WS_WGU + (size_t)2 * DFF * D * 2;
constexpr size_t WS_XN = WS_WD + (size_t)D * DFF * 2;
constexpr size_t WS_C = WS_XN + (size_t)MTOK * D * 2;
constexpr size_t WS_P = WS_C;
constexpr size_t WS_G = WS_C;
constexpr size_t WS_HID = WS_C;
constexpr size_t WS_OCAT = WS_C + (size_t)MTOK * PCOLS * 2;
constexpr size_t WS_ORAW = WS_OCAT + (size_t)3 * MTOK * 512 * 2;
constexpr size_t WS_END1 = WS_ORAW + (size_t)MTOK * 512 * 4;
constexpr size_t WS_MWD = WS_W;
static_assert(WS_MWD + (size_t)NEXP * D * DFF * 2 <= WS_XN, "moe down weights fit below XN");
constexpr size_t WS_MWGU = WS_C;
constexpr size_t WS_XS = WS_MWGU + (size_t)NEXP * 2 * DFF * D * 2;
constexpr size_t WS_MHID = WS_XS + (size_t)MOE_MAXBLK * 256 * D * 2;
constexpr size_t WS_END2 = WS_MHID + (size_t)MOE_MAXBLK * 256 * DFF * 2;
constexpr size_t WS_SLAB = WS_END2;
constexpr size_t WS_END3 = WS_SLAB + (size_t)256 * 256 * 256 * 2;
constexpr size_t WS_NEED = WS_END1 > WS_END3 ? WS_END1 : WS_END3;
static_assert(WS_NEED <= 615053344ull, "workspace budget (sum of the inputs)");

#define LAUNDER(v) asm volatile("" : "+v"(v))
__device__ __forceinline__ float bf2f(unsigned v) { return __uint_as_float(v << 16); }
__device__ __forceinline__ float bflo(unsigned w) { return __uint_as_float(w << 16); }
__device__ __forceinline__ float bfhi(unsigned w) { return __uint_as_float(w & 0xffff0000u); }
__device__ __forceinline__ bf16_t f2bf(float f) { return (bf16_t)(cvt_pk_bf16(f, 0.f) & 0xffffu); }
template <int M> __device__ __forceinline__ float xor_f(float v) { return __builtin_bit_cast(float, __builtin_amdgcn_ds_swizzle(__builtin_bit_cast(int, v), (M << 10) | 0x1f)); }
__device__ __forceinline__ float bperm_f(float v, int src_lane) { return __builtin_bit_cast(float, __builtin_amdgcn_ds_bpermute(src_lane << 2, __builtin_bit_cast(int, v))); }
__device__ __forceinline__ unsigned fp8x4(float a, float b, float c, float d) { int p = 0; a = __builtin_amdgcn_fmed3f(a, -448.f, 448.f); b = __builtin_amdgcn_fmed3f(b, -448.f, 448.f); c = __builtin_amdgcn_fmed3f(c, -448.f, 448.f); d = __builtin_amdgcn_fmed3f(d, -448.f, 448.f);     p = __builtin_amdgcn_cvt_pk_fp8_f32(a, b, p, false); p = __builtin_amdgcn_cvt_pk_fp8_f32(c, d, p, true); return (unsigned)p; }
__device__ __forceinline__ float wave_sum(float v) {
    v += xor_f<1>(v); v += xor_f<2>(v); v += xor_f<4>(v); v += xor_f<8>(v); v += xor_f<16>(v);
    return __builtin_bit_cast(float, __builtin_amdgcn_readlane(__builtin_bit_cast(int, v), 0)) + __builtin_bit_cast(float, __builtin_amdgcn_readlane(__builtin_bit_cast(int, v), 32));
}
__device__ __forceinline__ float sigmoidf_(float x) { return __builtin_amdgcn_rcpf(1.f + __expf(-x)); }
__device__ __forceinline__ float siluf_(float x) { return x * sigmoidf_(x); }
__device__ __forceinline__ float gelu_tanh_(float x) { return x * sigmoidf_(1.5957691216057308f * (x + 0.044715f * x * x * x)); }
__device__ __forceinline__ float softplusf_(float z) { return fmaxf(z, 0.f) + __logf(1.f + __expf(-fabsf(z))); }

struct Order {
    int nM, nN, nwg, G, c, mode; const char* A; const char* Bt; size_t tstep, abr, bbr; const int* bmap; const LAS int* bmapl; int ktiles, nfull, tail, split;
    __device__ __forceinline__ void init(const void* A_, const void* Bt_, int M, int N, int K, int G_, int c_, int mode_ = 0, size_t abr_ = 0, size_t bbr_ = 0, const int* bmap_ = nullptr, int tailsplit = 0, int esz = 2) { asm volatile("" : "+s"(c_));
        bmap = bmap_; bmapl = nullptr; ktiles = K * esz / 128; split = 1; tail = 0;
        nM = M / 256; nN = N / 256; nwg = nM * nN; G = G_; c = c_; mode = mode_; A = (const char*)A_; Bt = (const char*)Bt_; tstep = (size_t)256 * K * esz; abr = abr_; bbr = bbr_; nfull = nwg;
        if (tailsplit) { nfull = (nwg / G) * G; tail = nwg - nfull; split = (tail > 0 && tail * 7 <= G) ? 7 : (tail > 0 && tail * 4 <= G) ? 4 : (tail > 0 && tail * 2 <= G) ? 2 : 1; } }
    __device__ __forceinline__ void map(int L, int& pm, int& pn) const {
        int wgid = L; { const int q = nwg / 8, r = nwg % 8, xcd = wgid % 8, off = wgid / 8; wgid = (xcd < r ? xcd * (q + 1) : r * (q + 1) + (xcd - r) * q) + off; }
        const int nig = 8 * nN, gid = wgid / nig, fm = gid * 8, gsz = (nM - fm) < 8 ? (nM - fm) : 8; pm = fm + ((wgid % nig) % gsz); pn = (wgid % nig) / gsz; }
    __device__ __forceinline__ bool next(int i, pg8::Unit& u) const {
        if (mode == 4) {
            u.nt = ktiles; u.atomic = 0; const long L = (long)i * G + c; const int nt4 = nM * 4; if (L >= nt4) return false;
            int wgid = (int)L; { const int q = nt4 / 8, r = nt4 % 8, xcd = wgid % 8, off = wgid / 8; wgid = (xcd < r ? xcd * (q + 1) : r * (q + 1) + (xcd - r) * q) + off; }
            const int nig = 8 * 4, gid = wgid / nig, fm = gid * 8, gsz = (nM - fm) < 8 ? (nM - fm) : 8;
            u.pm = fm + ((wgid % nig) % gsz); u.pn = (wgid % nig) / gsz; u.a = A + (size_t)u.pm * tstep; u.b = Bt + (size_t)u.pn * tstep; return true; }
        if (mode == 3) {
            u.nt = ktiles; u.atomic = 0;
            const int br = i % 3; const long L = (long)(i / 3) * G + c; const int nt4 = nM * 4; if (L >= nt4) return false;
            int wgid = (int)L; { const int q = nt4 / 8, r = nt4 % 8, xcd = wgid % 8, off = wgid / 8; wgid = (xcd < r ? xcd * (q + 1) : r * (q + 1) + (xcd - r) * q) + off; }
            const int nig = 8 * 4, gid = wgid / nig, fm = gid * 8, gsz = (nM - fm) < 8 ? (nM - fm) : 8;
            u.pm = fm + ((wgid % nig) % gsz); const int pq = (wgid % nig) / gsz; u.pn = br * 4 + pq;
            u.a = A + (size_t)br * abr + (size_t)u.pm * tstep; u.b = Bt + (size_t)br * bbr + (size_t)pq * tstep; return true; }
        long L = (long)i * G + c; int slice = 0; u.nt = ktiles; u.atomic = 0;
        if (L >= nfull) {
            if (split == 1) { if (L >= nwg) return false; }
            else { const long tq = L - nfull; if (i != nfull / G || tq >= (long)tail * split) return false; L = nfull + tq / split; slice = (int)(tq % split); u.nt = ktiles / split; u.atomic = 1 + (int)tq; } }
        int wgid = (int)L; { const int q = nwg / 8, r = nwg % 8, xcd = wgid % 8, off = wgid / 8; wgid = (xcd < r ? xcd * (q + 1) : r * (q + 1) + (xcd - r) * q) + off; }
        const int nig = 8 * nN, gid = wgid / nig, fm = gid * 8, gsz = (nM - fm) < 8 ? (nM - fm) : 8;
        u.pm = fm + ((wgid % nig) % gsz); u.pn = (wgid % nig) / gsz;
        if (mode == 0) { u.a = A + (size_t)u.pm * tstep; u.b = Bt + (size_t)u.pn * tstep; }
        else if (mode == 2) { const int ex = __builtin_amdgcn_readfirstlane(bmapl[u.pm]);     u.a = A + (size_t)u.pm * tstep + (size_t)slice * u.nt * 128; u.b = Bt + (size_t)ex * bbr + (size_t)u.pn * tstep + (size_t)slice * u.nt * 128; }
        else { const int br = u.pn >> 2; u.a = A + (size_t)br * abr + (size_t)u.pm * tstep; u.b = Bt + (size_t)br * bbr + (size_t)(u.pn & 3) * tstep; }
        return true;
    }
    __device__ __forceinline__ void a_ready(const pg8::Unit&) const {}
    __device__ __forceinline__ void done(const pg8::Unit&) const {}
};

template <int ACT> __device__ __forceinline__ float act_(float x, float lb) {
    if (ACT == 1) return siluf_(x);
    if (ACT == 2) return __logf(lb + (1.f - lb) * sigmoidf_(x));
    if (ACT == 3) return gelu_tanh_(x);
    if (ACT == 4) return sigmoidf_(x);
    return x;
}
struct EpiAct {
    static constexpr bool PERM = true, AFTER_DRAIN = false, IDEM = true;
    bf16_t* O; int ldc; const float* lb; int inproj;
    template <int ACT> __device__ __forceinline__ void run(const f32x4 (&acc)[2][2][4][2], const pg8::Unit& u, int wr, int wc, int fr, int fq) const {
        const int row0 = u.pm * 256 + wr * 64 + fr, col0 = u.pn * 256 + wc * 32 + 8 * fq;
        f32x4 lbv[2][2];
#pragma unroll
        for (int bj = 0; bj < 2; ++bj)
#pragma unroll
            for (int n = 0; n < 2; ++n) lbv[bj][n] = (ACT == 2) ? *(const f32x4*)(lb + (col0 - C_HF) + bj * 128 + 4 * n) : (f32x4){0.f, 0.f, 0.f, 0.f};
#pragma unroll
        for (int ai = 0; ai < 2; ++ai)
#pragma unroll
            for (int m = 0; m < 4; ++m) { bf16_t* rowp = O + (size_t)(row0 + ai * 128 + m * 16) * ldc + col0;
#pragma unroll
                for (int bj = 0; bj < 2; ++bj) { f32x4 v0 = acc[ai][bj][m][0], v1 = acc[ai][bj][m][1];
#pragma unroll
                    for (int i = 0; i < 4; ++i) { v0[i] = act_<ACT>(v0[i], lbv[bj][0][i]); v1[i] = act_<ACT>(v1[i], lbv[bj][1][i]); }
                    u32x4 w; w.x = cvt_pk_bf16(v0[0], v0[1]); w.y = cvt_pk_bf16(v0[2], v0[3]); w.z = cvt_pk_bf16(v1[0], v1[1]); w.w = cvt_pk_bf16(v1[2], v1[3]);
                    *(u32x4*)(rowp + bj * 128) = w; } }
    }
    __device__ __forceinline__ void operator()(const f32x4 (&acc)[2][2][4][2], const pg8::Unit& u, int wr, int wc, int fr, int fq) const {
        if (!inproj) { run<4>(acc, u, wr, wc, fr, fq); return; }
        const int kind = u.pn >> 1;
        if (kind == 0 || kind == 3) run<1>(acc, u, wr, wc, fr, fq);
        else if (kind == 1) run<2>(acc, u, wr, wc, fr, fq);
        else if (kind == 4 || kind == 5) run<3>(acc, u, wr, wc, fr, fq);
        else run<0>(acc, u, wr, wc, fr, fq);
    }
};
struct EpiBranch {
    static constexpr bool PERM = true, AFTER_DRAIN = false, IDEM = false;
    const bf16_t* Gt; bf16_t* mix;
    __device__ __forceinline__ void operator()(const f32x4 (&acc)[2][2][4][2], const pg8::Unit& u, int wr, int wc, int fr, int fq) const {
        const int br = u.pn >> 2, row0 = u.pm * 256 + wr * 64 + fr, col0 = (u.pn & 3) * 256 + wc * 32 + 8 * fq;
#pragma unroll
        for (int ai = 0; ai < 2; ++ai)
#pragma unroll
            for (int m = 0; m < 4; ++m) { const size_t row = (size_t)(row0 + ai * 128 + m * 16); const bf16_t* gp = Gt + row * GCOLS + br * 1024 + col0; bf16_t* mp = mix + row * D + col0;
#pragma unroll
                for (int bj = 0; bj < 2; ++bj) { const f32x4 v0 = acc[ai][bj][m][0], v1 = acc[ai][bj][m][1];
                    const u32x4 g = *(const u32x4*)(gp + bj * 128); u32x4 o = {0u, 0u, 0u, 0u};
                    if (br > 0) o = __builtin_nontemporal_load((const u32x4*)(mp + bj * 128));
                    u32x4 w;
                    w.x = cvt_pk_bf16(bflo(o.x) + v0[0] * bflo(g.x), bfhi(o.x) + v0[1] * bfhi(g.x)); w.y = cvt_pk_bf16(bflo(o.y) + v0[2] * bflo(g.y), bfhi(o.y) + v0[3] * bfhi(g.y));
                    w.z = cvt_pk_bf16(bflo(o.z) + v1[0] * bflo(g.z), bfhi(o.z) + v1[1] * bfhi(g.z)); w.w = cvt_pk_bf16(bflo(o.w) + v1[2] * bflo(g.w), bfhi(o.w) + v1[3] * bfhi(g.w));
                    *(u32x4*)(mp + bj * 128) = w; } }
    }
};
struct EpiBranchSeg {
    static constexpr bool PERM = true, AFTER_DRAIN = false, IDEM = true;
    const bf16_t* Gt; bf16_t* mix;
    __device__ __forceinline__ void mid(f32x4 (&acc)[2][2][4][2], const pg8::Unit& u, int seg, int wr, int wc, int fr, int fq, const bool inv = false) const {
        const int row0 = u.pm * 256 + wr * 64 + fr, col0 = u.pn * 256 + wc * 32 + 8 * fq;
        u32x4 ga[2][2][2], gb[2][2][2];
#define EBS_LOAD(b_) do { _Pragma("unroll") for (int mm = 0; mm < 2; ++mm) { const bf16_t* gp = Gt + (size_t)(row0 + ((b_) >> 1) * 128 + (2 * ((b_) & 1) + mm) * 16) * GCOLS + seg * 1024 + col0; \
            _Pragma("unroll") for (int bj = 0; bj < 2; ++bj) { ga[(b_) & 1][mm][bj] = *(const u32x4*)(gp + bj * 128); gb[(b_) & 1][mm][bj] = *(const u32x4*)(gp + 1024 + bj * 128); } } } while (0)
        EBS_LOAD(0);
#pragma unroll
        for (int b = 0; b < 4; ++b) { const int ai = b >> 1, mp = b & 1;
            if (b + 1 < 4) EBS_LOAD(b + 1);
            asm volatile("" ::: "memory");
#pragma unroll
            for (int mm = 0; mm < 2; ++mm)
#pragma unroll
                for (int bj = 0; bj < 2; ++bj) { const u32x4 a = inv ? gb[b & 1][mm][bj] : ga[b & 1][mm][bj], bb = inv ? ga[b & 1][mm][bj] : gb[b & 1][mm][bj]; const int m = 2 * mp + mm;
                    const float na[8] = {bflo(a.x), bfhi(a.x), bflo(a.y), bfhi(a.y), bflo(a.z), bfhi(a.z), bflo(a.w), bfhi(a.w)}, nb[8] = {bflo(bb.x), bfhi(bb.x), bflo(bb.y), bfhi(bb.y), bflo(bb.z), bfhi(bb.z), bflo(bb.w), bfhi(bb.w)};
#pragma unroll
                    for (int i = 0; i < 4; ++i) { acc[ai][bj][m][0][i] *= fmaxf(na[i], 1e-6f) * __builtin_amdgcn_rcpf(fmaxf(nb[i], 1e-6f)); acc[ai][bj][m][1][i] *= fmaxf(na[4 + i], 1e-6f) * __builtin_amdgcn_rcpf(fmaxf(nb[4 + i], 1e-6f)); } } }
#undef EBS_LOAD
    }
    __device__ __forceinline__ void operator()(const f32x4 (&acc)[2][2][4][2], const pg8::Unit& u, int wr, int wc, int fr, int fq) const {
        const int row0 = u.pm * 256 + wr * 64 + fr, col0 = u.pn * 256 + wc * 32 + 8 * fq;
#pragma unroll
        for (int ai = 0; ai < 2; ++ai) { u32x4 g[4][2];
#pragma unroll
            for (int m = 0; m < 4; ++m)
#pragma unroll
                for (int bj = 0; bj < 2; ++bj) g[m][bj] = *(const u32x4*)(Gt + (size_t)(row0 + ai * 128 + m * 16) * GCOLS + 2048 + col0 + bj * 128);
            asm volatile("" ::: "memory");
#pragma unroll
            for (int m = 0; m < 4; ++m) { bf16_t* mp = mix + (size_t)(row0 + ai * 128 + m * 16) * D + col0;
#pragma unroll
                for (int bj = 0; bj < 2; ++bj) { const f32x4 v0 = acc[ai][bj][m][0], v1 = acc[ai][bj][m][1]; const u32x4 gg = g[m][bj]; u32x4 w;
                    w.x = cvt_pk_bf16(v0[0] * fmaxf(bflo(gg.x), 1e-6f), v0[1] * fmaxf(bfhi(gg.x), 1e-6f)); w.y = cvt_pk_bf16(v0[2] * fmaxf(bflo(gg.y), 1e-6f), v0[3] * fmaxf(bfhi(gg.y), 1e-6f));
                    w.z = cvt_pk_bf16(v1[0] * fmaxf(bflo(gg.z), 1e-6f), v1[1] * fmaxf(bfhi(gg.z), 1e-6f)); w.w = cvt_pk_bf16(v1[2] * fmaxf(bflo(gg.w), 1e-6f), v1[3] * fmaxf(bfhi(gg.w), 1e-6f));
                    *(u32x4*)(mp + bj * 128) = w; } } }
    }
};
template <bool INF>
struct EpiResidT {
    static constexpr bool PERM = true, AFTER_DRAIN = false, IDEM = INF;
    const void* xin; bf16_t* xout;
    __device__ __forceinline__ void operator()(const f32x4 (&acc)[2][2][4][2], const pg8::Unit& u, int wr, int wc, int fr, int fq) const {
        const int row0 = u.pm * 256 + wr * 64 + fr, col0 = u.pn * 256 + wc * 32 + 8 * fq;
        if constexpr (INF) {
#pragma unroll
            for (int ai = 0; ai < 2; ++ai)
#pragma unroll
                for (int mp = 0; mp < 2; ++mp) { f32x4 t[2][2][2];
#pragma unroll
                    for (int mm = 0; mm < 2; ++mm) { const size_t ro = (size_t)(row0 + ai * 128 + (2 * mp + mm) * 16) * D + col0;
#pragma unroll
                        for (int bj = 0; bj < 2; ++bj)
#pragma unroll
                            for (int n = 0; n < 2; ++n) t[mm][bj][n] = *(const f32x4*)((const float*)xin + ro + bj * 128 + n * 4); }
                    asm volatile("" ::: "memory");
#pragma unroll
                    for (int mm = 0; mm < 2; ++mm) { const size_t ro = (size_t)(row0 + ai * 128 + (2 * mp + mm) * 16) * D + col0;
#pragma unroll
                        for (int bj = 0; bj < 2; ++bj) { const f32x4 v0 = t[mm][bj][0] + acc[ai][bj][2 * mp + mm][0], v1 = t[mm][bj][1] + acc[ai][bj][2 * mp + mm][1];
                            u32x4 w; w.x = cvt_pk_bf16(v0[0], v0[1]); w.y = cvt_pk_bf16(v0[2], v0[3]); w.z = cvt_pk_bf16(v1[0], v1[1]); w.w = cvt_pk_bf16(v1[2], v1[3]); *(u32x4*)(xout + ro + bj * 128) = w; } }
                    asm volatile("" ::: "memory"); }
        } else {
#pragma unroll
            for (int ai = 0; ai < 2; ++ai) { u32x4 t[4][2];
#pragma unroll
                for (int m = 0; m < 4; ++m) { const size_t ro = (size_t)(row0 + ai * 128 + m * 16) * D + col0;
#pragma unroll
                    for (int bj = 0; bj < 2; ++bj) t[m][bj] = *(const u32x4*)((const bf16_t*)xin + ro + bj * 128); }
                asm volatile("" ::: "memory");
#pragma unroll
                for (int m = 0; m < 4; ++m) { const size_t ro = (size_t)(row0 + ai * 128 + m * 16) * D + col0;
#pragma unroll
                    for (int bj = 0; bj < 2; ++bj) { const u32x4 o = t[m][bj]; const f32x4 a0 = acc[ai][bj][m][0], a1 = acc[ai][bj][m][1];
                        u32x4 w; w.x = cvt_pk_bf16(bflo(o.x) + a0[0], bfhi(o.x) + a0[1]); w.y = cvt_pk_bf16(bflo(o.y) + a0[2], bfhi(o.y) + a0[3]);
                        w.z = cvt_pk_bf16(bflo(o.z) + a1[0], bfhi(o.z) + a1[1]); w.w = cvt_pk_bf16(bflo(o.w) + a1[2], bfhi(o.w) + a1[3]); *(u32x4*)(xout + ro + bj * 128) = w; } }
                asm volatile("" ::: "memory"); }
        }
    }
};
template <bool F8OUT>
struct EpiGUT {
    static constexpr bool PERM = true, AFTER_DRAIN = false, IDEM = true;
    void* H;
    __device__ __forceinline__ void operator()(const f32x4 (&acc)[2][2][4][2], const pg8::Unit& u, int wr, int wc, int fr, int fq) const {
        const int row0 = u.pm * 256 + wr * 64 + fr, col0 = u.pn * 128 + wc * 32 + 8 * fq;
#pragma unroll
        for (int ai = 0; ai < 2; ++ai)
#pragma unroll
            for (int m = 0; m < 4; ++m) { const size_t eo = (size_t)(row0 + ai * 128 + m * 16) * DFF + col0;
                const f32x4 g0 = acc[ai][0][m][0], g1 = acc[ai][0][m][1], u0 = acc[ai][1][m][0], u1 = acc[ai][1][m][1];
                const float h0 = siluf_(g0[0]) * u0[0], h1 = siluf_(g0[1]) * u0[1], h2 = siluf_(g0[2]) * u0[2], h3 = siluf_(g0[3]) * u0[3];
                const float h4 = siluf_(g1[0]) * u1[0], h5 = siluf_(g1[1]) * u1[1], h6 = siluf_(g1[2]) * u1[2], h7 = siluf_(g1[3]) * u1[3];
                if (F8OUT) *(uint2*)((unsigned char*)H + eo) = make_uint2(fp8x4(h0, h1, h2, h3), fp8x4(h4, h5, h6, h7));
                else { u32x4 w; w.x = cvt_pk_bf16(h0, h1); w.y = cvt_pk_bf16(h2, h3); w.z = cvt_pk_bf16(h4, h5); w.w = cvt_pk_bf16(h6, h7); *(u32x4*)((bf16_t*)H + eo) = w; } }
    }
};
typedef EpiGUT<false> EpiGU;
struct EpiMoeDown {
    static constexpr bool PERM = true, AFTER_DRAIN = false, IDEM = true;
    const bf16_t* rin; void* rout; int outf; const int* stok; const float* sw; bf16_t* slab;
    __device__ __forceinline__ void operator()(const f32x4 (&acc)[2][2][4][2], const pg8::Unit& u, int wr, int wc, int fr, int fq) const {
        LAUNDER(fr); LAUNDER(fq);
        if (u.atomic) { bf16_t* sp = slab + (size_t)(u.atomic - 1) * 65536 + (size_t)(wr * 64 + fr) * 256 + wc * 32 + 8 * fq;
#pragma unroll
            for (int ai = 0; ai < 2; ++ai)
#pragma unroll
                for (int m = 0; m < 4; ++m)
#pragma unroll
                    for (int bj = 0; bj < 2; ++bj) { const f32x4 v0 = acc[ai][bj][m][0], v1 = acc[ai][bj][m][1]; u32x4 w; w.x = cvt_pk_bf16(v0[0], v0[1]); w.y = cvt_pk_bf16(v0[2], v0[3]); w.z = cvt_pk_bf16(v1[0], v1[1]); w.w = cvt_pk_bf16(v1[2], v1[3]);
                        *(u32x4*)(sp + (size_t)(ai * 128 + m * 16) * 256 + bj * 128) = w; }
            return; }
        const int row0 = u.pm * 256 + wr * 64 + fr, col0 = u.pn * 256 + wc * 32 + 8 * fq;
        int tk[2][4]; float wt[2][4];
#pragma unroll
        for (int ai = 0; ai < 2; ++ai)
#pragma unroll
            for (int m = 0; m < 4; ++m) { const int rl = row0 + ai * 128 + m * 16; tk[ai][m] = stok[rl]; wt[ai][m] = sw[rl]; }
#pragma unroll
        for (int ai = 0; ai < 2; ++ai) { u32x4 t[4][2];
#pragma unroll
            for (int m = 0; m < 4; ++m) { const int tok = tk[ai][m]; const bf16_t* rp = rin + (size_t)(tok < 0 ? 0 : tok) * D + col0;
#pragma unroll
                for (int bj = 0; bj < 2; ++bj) t[m][bj] = *(const u32x4*)(rp + bj * 128); }
            asm volatile("" ::: "memory");
#pragma unroll
            for (int m = 0; m < 4; ++m) { const int tok = tk[ai][m]; const float w = wt[ai][m];
                if (tok >= 0) { const size_t ro = (size_t)tok * D + col0;
#pragma unroll
                    for (int bj = 0; bj < 2; ++bj) { const u32x4 o = t[m][bj]; const f32x4 a0 = acc[ai][bj][m][0] * w, a1 = acc[ai][bj][m][1] * w;
                        const f32x4 v0 = {bflo(o.x) + a0[0], bfhi(o.x) + a0[1], bflo(o.y) + a0[2], bfhi(o.y) + a0[3]}, v1 = {bflo(o.z) + a1[0], bfhi(o.z) + a1[1], bflo(o.w) + a1[2], bfhi(o.w) + a1[3]};
                        if (outf) { float* op = (float*)rout + ro + bj * 128; *(f32x4*)op = v0; *(f32x4*)(op + 4) = v1; }
                        else { u32x4 q; q.x = cvt_pk_bf16(v0[0], v0[1]); q.y = cvt_pk_bf16(v0[2], v0[3]); q.z = cvt_pk_bf16(v1[0], v1[1]); q.w = cvt_pk_bf16(v1[2], v1[3]); *(u32x4*)((bf16_t*)rout + ro + bj * 128) = q; } } } }
            asm volatile("" ::: "memory"); }
    }
};
__device__ __forceinline__ void moe_tail_reduce(const Order& S, const bf16_t* slab, const bf16_t* rin, void* rout, int outf, const int* stok, const float* sw, int wg, int G, int wid, int lane) {
    LAUNDER(lane);
    if (S.split == 1) return;
    for (int task = wg * NWAVES + wid; task < S.tail * 256; task += G * NWAVES) {
        const int j = task >> 8, r = task & 255; int pm, pn; S.map(S.nfull + j, pm, pn);
        const int tok = __hip_atomic_load(stok + pm * 256 + r, __ATOMIC_RELAXED, __HIP_MEMORY_SCOPE_AGENT); if (tok < 0) continue;
        const float w = sw[pm * 256 + r]; f32x4 s = {0.f, 0.f, 0.f, 0.f};
        const size_t ro = (size_t)tok * D + pn * 256 + lane * 4; const uint2 x = *(const uint2*)(rin + ro);
        uint2 xs[7];
#pragma unroll
        for (int sl = 0; sl < 7; ++sl) { xs[sl] = make_uint2(0u, 0u); if (sl < S.split) xs[sl] = *(const uint2*)(slab + (size_t)(j * S.split + sl) * 65536 + (size_t)r * 256 + lane * 4); }
#pragma unroll
        for (int sl = 0; sl < 7; ++sl) { s[0] += bflo(xs[sl].x); s[1] += bfhi(xs[sl].x); s[2] += bflo(xs[sl].y); s[3] += bfhi(xs[sl].y); }
        const f32x4 o = {bflo(x.x) + s[0] * w, bfhi(x.x) + s[1] * w, bflo(x.y) + s[2] * w, bfhi(x.y) + s[3] * w};
        if (outf) *(f32x4*)((float*)rout + ro) = o; else *(uint2*)((bf16_t*)rout + ro) = make_uint2(cvt_pk_bf16(o[0], o[1]), cvt_pk_bf16(o[2], o[3]));
    }
}

__device__ __forceinline__ void tc_job(const float* __restrict__ src, int K, int N, bf16_t* dst, int mode, int perm, LAS float* tile, int wg, int G, int tid, int f8 = 0) {
    LAUNDER(tid);
    const int tn = N / 64, nt = (K / 64) * tn;
    float4 v0 = make_float4(0.f, 0.f, 0.f, 0.f), v1 = v0;
    if (wg < nt) { const int k0 = (wg / tn) * 64, n0 = (wg % tn) * 64; const float* sp = src + (size_t)(k0 + (tid >> 4)) * N + n0 + (tid & 15) * 4; v0 = *(const float4*)sp; v1 = *(const float4*)(sp + (size_t)32 * N); }
    for (int t = wg; t < nt; t += G) {
        const int k0 = (t / tn) * 64, n0 = (t % tn) * 64;
        { LAS float* tp = tile + (tid >> 4) * 65 + (tid & 15) * 4; tp[0] = v0.x; tp[1] = v0.y; tp[2] = v0.z; tp[3] = v0.w; tp += 32 * 65; tp[0] = v1.x; tp[1] = v1.y; tp[2] = v1.z; tp[3] = v1.w; }
        if (t + G < nt) { const int k1 = ((t + G) / tn) * 64, n1 = ((t + G) % tn) * 64; const float* sp = src + (size_t)(k1 + (tid >> 4)) * N + n1 + (tid & 15) * 4; v0 = *(const float4*)sp; v1 = *(const float4*)(sp + (size_t)32 * N); }
        __syncthreads();
        { const int n = tid >> 3, kg = (tid & 7) * 8; unsigned w[4];
#pragma unroll
          for (int j = 0; j < 4; ++j) w[j] = cvt_pk_bf16(tile[(kg + 2 * j) * 65 + n], tile[(kg + 2 * j + 1) * 65 + n]);
          const int nn = n0 + n; int drow = mode == 0 ? nn : ((nn >> 7) * 256 + (nn & 127) + (mode == 2 ? 128 : 0));
          if (perm) { const int c5 = drow & 31; drow = (drow & ~31) + 16 * ((c5 >> 2) & 1) + 4 * (c5 >> 3) + (c5 & 3); }
          if (f8) *(uint2*)((unsigned char*)dst + (size_t)drow * K + k0 + kg) = make_uint2(fp8x4(64.f * tile[(kg + 0) * 65 + n], 64.f * tile[(kg + 1) * 65 + n], 64.f * tile[(kg + 2) * 65 + n], 64.f * tile[(kg + 3) * 65 + n]),
                                                                                          fp8x4(64.f * tile[(kg + 4) * 65 + n], 64.f * tile[(kg + 5) * 65 + n], 64.f * tile[(kg + 6) * 65 + n], 64.f * tile[(kg + 7) * 65 + n]));
          else *(uint4*)(dst + (size_t)drow * K + k0 + kg) = make_uint4(w[0], w[1], w[2], w[3]); }
        __syncthreads();
    }
}

__device__ __forceinline__ void tc_job_w(const float* __restrict__ src, int K, int N, bf16_t* dst, int mode, int perm, LAS float* tile_all, int wg, int G, int wid, int lane, int f8 = 0) {
    LAUNDER(lane);
    LAS float* tile = tile_all + wid * (64 * 65);
    const int tn = N / 64, nt = (K / 64) * tn, TS = G * NWAVES;
    const int r = lane >> 4, c4 = (lane & 15) * 4;
    float4 v[16];
    int t = wg * NWAVES + wid;
    if (t < nt) { const float* sp = src + (size_t)((t / tn) * 64 + r) * N + (t % tn) * 64 + c4;
#pragma unroll
        for (int i = 0; i < 16; ++i) v[i] = *(const float4*)(sp + (size_t)(4 * i) * N); }
    for (; t < nt; t += TS) {
        const int k0 = (t / tn) * 64, n0 = (t % tn) * 64;
#pragma unroll
        for (int i = 0; i < 16; ++i) { LAS float* tp = tile + (r + 4 * i) * 65 + c4; tp[0] = v[i].x; tp[1] = v[i].y; tp[2] = v[i].z; tp[3] = v[i].w; }
        if (t + TS < nt) { const int t1 = t + TS; const float* sp = src + (size_t)((t1 / tn) * 64 + r) * N + (t1 % tn) * 64 + c4;
#pragma unroll
            for (int i = 0; i < 16; ++i) v[i] = *(const float4*)(sp + (size_t)(4 * i) * N); }
        asm volatile("" ::: "memory"); __builtin_amdgcn_wave_barrier();
#pragma unroll
        for (int j = 0; j < 8; ++j) { const int p = lane + 64 * j, n = p >> 3, kg = (p & 7) * 8; float x[8];
#pragma unroll
            for (int q = 0; q < 8; ++q) x[q] = tile[(kg + q) * 65 + n];
            const int nn = n0 + n; int drow = mode == 0 ? nn : ((nn >> 7) * 256 + (nn & 127) + (mode == 2 ? 128 : 0));
            if (perm) { const int c5 = drow & 31; drow = (drow & ~31) + 16 * ((c5 >> 2) & 1) + 4 * (c5 >> 3) + (c5 & 3); }
            if (f8) *(uint2*)((unsigned char*)dst + (size_t)drow * K + k0 + kg) = make_uint2(fp8x4(64.f * x[0], 64.f * x[1], 64.f * x[2], 64.f * x[3]), fp8x4(64.f * x[4], 64.f * x[5], 64.f * x[6], 64.f * x[7]));
            else *(uint4*)(dst + (size_t)drow * K + k0 + kg) = make_uint4(cvt_pk_bf16(x[0], x[1]), cvt_pk_bf16(x[2], x[3]), cvt_pk_bf16(x[4], x[5]), cvt_pk_bf16(x[6], x[7])); }
        asm volatile("" ::: "memory"); __builtin_amdgcn_wave_barrier();
    }
}
__device__ __forceinline__ void tc_job_f8(const float* __restrict__ src, int K, int N, unsigned char* dst, int mode, LAS float* tile, int wg, int G, int tid) {
    LAUNDER(tid);
    const int tn = N / 64, nt = (K / 128) * tn; const int r = tid >> 4, c4 = (tid & 15) * 4;
    float4 v[4];
#pragma unroll
    for (int i = 0; i < 4; ++i) v[i] = make_float4(0.f, 0.f, 0.f, 0.f);
    if (wg < nt) { const float* sp = src + (size_t)((wg / tn) * 128 + r) * N + (wg % tn) * 64 + c4;
#pragma unroll
        for (int i = 0; i < 4; ++i) v[i] = *(const float4*)(sp + (size_t)(32 * i) * N); }
    for (int t = wg; t < nt; t += G) {
        const int k0 = (t / tn) * 128, n0 = (t % tn) * 64;
#pragma unroll
        for (int i = 0; i < 4; ++i) { LAS float* tp = tile + (r + 32 * i) * 65 + c4; tp[0] = v[i].x; tp[1] = v[i].y; tp[2] = v[i].z; tp[3] = v[i].w; }
        if (t + G < nt) { const float* sp = src + (size_t)(((t + G) / tn) * 128 + r) * N + ((t + G) % tn) * 64 + c4;
#pragma unroll
            for (int i = 0; i < 4; ++i) v[i] = *(const float4*)(sp + (size_t)(32 * i) * N); }
        __syncthreads();
        { const int n = tid >> 3, kg = (tid & 7) * 16; float x[16];
#pragma unroll
          for (int q = 0; q < 16; ++q) x[q] = 64.f * tile[(kg + q) * 65 + n];
          const int nn = n0 + n; int drow = mode == 0 ? nn : ((nn >> 7) * 256 + (nn & 127) + (mode == 2 ? 128 : 0));
          { const int c5 = drow & 31; drow = (drow & ~31) + 16 * ((c5 >> 2) & 1) + 4 * (c5 >> 3) + (c5 & 3); }
          *(uint4*)(dst + (size_t)drow * K + k0 + kg) = make_uint4(fp8x4(x[0], x[1], x[2], x[3]), fp8x4(x[4], x[5], x[6], x[7]), fp8x4(x[8], x[9], x[10], x[11]), fp8x4(x[12], x[13], x[14], x[15])); }
        __syncthreads();
    }
}

template <bool ROUTER, bool F8 = ROUTER, bool XBF = true>
__device__ __forceinline__ void phase_rmsnorm(const void* __restrict__ x, const float* __restrict__ gain, bf16_t* xn, const float* __restrict__ rw, const float* __restrict__ rb,
                              int* toke, float2* tokw, int wg, int G, int wid, int lane) {
    LAUNDER(lane);
    constexpr int RB = ROUTER ? 2 : 4;
    float rwv[ROUTER ? 4 : 1][4][NEXP];
    if (ROUTER) {
#pragma unroll
        for (int j = 0; j < 4; ++j)
#pragma unroll
            for (int i = 0; i < 4; ++i) { const float* wr_ = rw + (size_t)(j * 256 + lane * 4 + i) * NEXP; const float4 wa = *(const float4*)wr_, wb = *(const float4*)(wr_ + 4);
                rwv[j][i][0] = wa.x; rwv[j][i][1] = wa.y; rwv[j][i][2] = wa.z; rwv[j][i][3] = wa.w; rwv[j][i][4] = wb.x; rwv[j][i][5] = wb.y; rwv[j][i][6] = wb.z; rwv[j][i][7] = wb.w; } }
    uint2 nx[XBF ? RB : 1][4];
    if (XBF) { const int r0 = (wg * NWAVES + wid) * RB;
        if (r0 < MTOK) {
#pragma unroll
            for (int rr = 0; rr < RB; ++rr)
#pragma unroll
                for (int j = 0; j < 4; ++j) nx[rr][j] = *(const uint2*)((const bf16_t*)x + (size_t)(r0 + rr) * D + j * 256 + lane * 4); } }
    for (int row0 = (wg * NWAVES + wid) * RB; row0 < MTOK; row0 += G * NWAVES * RB) {
        float4 v[RB][4];
#pragma unroll
        for (int rr = 0; rr < RB; ++rr)
#pragma unroll
            for (int j = 0; j < 4; ++j) { const size_t xo = (size_t)(row0 + rr) * D + j * 256 + lane * 4;
                if (XBF) { const uint2 q = nx[rr][j]; v[rr][j] = make_float4(bflo(q.x), bfhi(q.x), bflo(q.y), bfhi(q.y)); } else v[rr][j] = *(const float4*)((const float*)x + xo); }
        if (XBF) { const int r1 = row0 + G * NWAVES * RB;
            if (r1 < MTOK) {
#pragma unroll
                for (int rr = 0; rr < RB; ++rr)
#pragma unroll
                    for (int j = 0; j < 4; ++j) nx[rr][j] = *(const uint2*)((const bf16_t*)x + (size_t)(r1 + rr) * D + j * 256 + lane * 4); } }
#pragma unroll
        for (int rr = 0; rr < RB; ++rr) { const int row = row0 + rr; float ss = 0.f;
#pragma unroll
            for (int j = 0; j < 4; ++j) ss += v[rr][j].x * v[rr][j].x + v[rr][j].y * v[rr][j].y + v[rr][j].z * v[rr][j].z + v[rr][j].w * v[rr][j].w;
            ss = wave_sum(ss);
            const float rstd = rsqrtf(ss * (1.f / D) + EPS);
            float lg[NEXP];
#pragma unroll
            for (int e = 0; e < NEXP; ++e) lg[e] = 0.f;
#pragma unroll
            for (int j = 0; j < 4; ++j) { const float4 g = *(const float4*)(gain + j * 256 + lane * 4);
                const float y0 = v[rr][j].x * rstd * g.x, y1 = v[rr][j].y * rstd * g.y, y2 = v[rr][j].z * rstd * g.z, y3 = v[rr][j].w * rstd * g.w;
                if (F8) *(unsigned*)((unsigned char*)xn + (size_t)row * D + j * 256 + lane * 4) = fp8x4(y0, y1, y2, y3);
                else *(uint2*)(xn + (size_t)row * D + j * 256 + lane * 4) = make_uint2(cvt_pk_bf16(y0, y1), cvt_pk_bf16(y2, y3));
                if (ROUTER) { const float ys[4] = {y0, y1, y2, y3};
#pragma unroll
                    for (int i = 0; i < 4; ++i)
#pragma unroll
                        for (int e = 0; e < NEXP; ++e) lg[e] += ys[i] * rwv[ROUTER ? j : 0][i][e]; } }
            if (ROUTER) {
#pragma unroll
                for (int e = 0; e < NEXP; ++e) lg[e] = wave_sum(lg[e]) + rb[e];
                int i0 = 0; float l0 = lg[0];
#pragma unroll
                for (int e = 1; e < NEXP; ++e) if (lg[e] > l0) { l0 = lg[e]; i0 = e; }
                int i1 = -1; float l1 = -3.4e38f;
#pragma unroll
                for (int e = 0; e < NEXP; ++e) if (e != i0 && lg[e] > l1) { l1 = lg[e]; i1 = e; }
                const float w0 = __builtin_amdgcn_rcpf(1.f + __expf(l1 - l0));
                if (lane == 0) { toke[row] = i0 | (i1 << 8); tokw[row] = make_float2(w0, 1.f - w0); }
            }
        }
    }
}

__device__ void phase_combine(const bf16_t* GH, bf16_t* mix, int wg, int G, int tid) {
    LAUNDER(tid);
    for (size_t v = (size_t)wg * NTHREADS + tid; v < (size_t)MTOK * (D / 8); v += (size_t)G * NTHREADS) {
        const size_t r = v / (D / 8); const int c = (int)(v % (D / 8)) * 8; const bf16_t* gp = GH + r * GCOLS + c;
        const uint4 a = *(const uint4*)gp, b = *(const uint4*)(gp + 1024), cc = *(const uint4*)(gp + 2048); uint4 o;
        o.x = cvt_pk_bf16(bflo(a.x) + bflo(b.x) + bflo(cc.x), bfhi(a.x) + bfhi(b.x) + bfhi(cc.x));
        o.y = cvt_pk_bf16(bflo(a.y) + bflo(b.y) + bflo(cc.y), bfhi(a.y) + bfhi(b.y) + bfhi(cc.y));
        o.z = cvt_pk_bf16(bflo(a.z) + bflo(b.z) + bflo(cc.z), bfhi(a.z) + bfhi(b.z) + bfhi(cc.z));
        o.w = cvt_pk_bf16(bflo(a.w) + bflo(b.w) + bflo(cc.w), bfhi(a.w) + bfhi(b.w) + bfhi(cc.w));
        *(uint4*)(mix + r * D + c) = o;
    }
}

__device__ __forceinline__ void moe_assign(const int* toke, const float2* tokw, int* meta, int* stok, float* sw, int* blke, LAS unsigned char* lds, int tid, int part) {
    LAS int* cnt = (LAS int*)lds;
    LAS int* tot = cnt + 512 * 16;
    LAS int* segt = tot + 32;
    const int t0 = tid * (MTOK / NTHREADS);
    int4 e4[16];
#pragma unroll
    for (int i = 0; i < 16; ++i) e4[i] = *(const int4*)(toke + t0 + 4 * i);
    { int z = 0; asm volatile("" : "+v"(z));
      for (int j = 0; j < 16; ++j) cnt[tid * 16 + j] = z; }
#pragma unroll
    for (int i = 0; i < 16; ++i) { const int ev[4] = {e4[i].x, e4[i].y, e4[i].z, e4[i].w};
#pragma unroll
        for (int q = 0; q < 4; ++q) { cnt[tid * 16 + (ev[q] & 255)] += 1; cnt[tid * 16 + 8 + ((ev[q] >> 8) & 255)] += 1; } }
    __syncthreads();
    const int cj = tid & 15, cseg = tid >> 4;
    { int s = 0; for (int i = 0; i < 16; ++i) s += cnt[(cseg * 16 + i) * 16 + cj]; segt[cseg * 16 + cj] = s; }
    __syncthreads();
    if (tid < 16) { int run = 0; for (int sg = 0; sg < 32; ++sg) { const int v = segt[sg * 16 + tid]; segt[sg * 16 + tid] = run; run += v; } tot[tid] = run; }
    __syncthreads();
    { int run = segt[cseg * 16 + cj]; for (int i = 0; i < 16; ++i) { const int idx = (cseg * 16 + i) * 16 + cj; const int v = cnt[idx]; cnt[idx] = run; run += v; } }
    if (tid == 0) { int run = 0; for (int j = 0; j < 16; ++j) { const int n = tot[j], pad = (n + 255) & ~255; tot[16 + j] = run; if (j == 8) { meta[0] = run; meta[3] = run; } run += pad; } meta[1] = run - tot[16 + 8]; meta[2] = 0; meta[4] = run; }
    __syncthreads();
    for (int bk = tid; bk < 2 * MOE_MAXBLK; bk += NTHREADS) { int ex = 0;
        for (int j = 0; j < 16; ++j) { const int base = tot[16 + j], pad = (tot[j] + 255) & ~255; if (bk * 256 >= base && bk * 256 < base + pad) ex = j & 7; }
        blke[bk] = ex; }
    const int cls = part & 1, half = part >> 1;
    if ((tid >> 8) == half) {
        for (int j = 0; j < 8; ++j) cnt[tid * 16 + 8 * cls + j] += tot[16 + 8 * cls + j];
#pragma unroll
        for (int i = 0; i < 16; ++i) { const int ev[4] = {e4[i].x, e4[i].y, e4[i].z, e4[i].w}; const float4 wa = *(const float4*)(tokw + t0 + 4 * i), wb = *(const float4*)(tokw + t0 + 4 * i + 2);
            const float wv[4] = {cls ? wa.y : wa.x, cls ? wa.w : wa.z, cls ? wb.y : wb.x, cls ? wb.w : wb.z};
#pragma unroll
            for (int q = 0; q < 4; ++q) { const int j = cls ? 8 + ((ev[q] >> 8) & 255) : (ev[q] & 255); const int pp = cnt[tid * 16 + j]; cnt[tid * 16 + j] = pp + 1; stok[pp] = t0 + 4 * i + q; sw[pp] = wv[q]; } } }
    if (half == 0) for (int j = 8 * cls; j < 8 * cls + 8; ++j) { const int n = tot[j], pad = (n + 255) & ~255, base = tot[16 + j]; for (int i = n + tid; i < pad; i += NTHREADS) { stok[base + i] = -1; sw[base + i] = 0.f; } }
}
__device__ __forceinline__ void moe_gather(const unsigned char* xn8, const int* stok, int rows, unsigned char* xs8, int wg, int G, int wid, int lane) {
    LAUNDER(lane);
    for (int r0 = (wg * NWAVES + wid) * 4; r0 < rows; r0 += G * NWAVES * 4) {
        int tok[4]; uint4 a[4];
#pragma unroll
        for (int i = 0; i < 4; ++i) tok[i] = __hip_atomic_load(stok + r0 + i, __ATOMIC_RELAXED, __HIP_MEMORY_SCOPE_AGENT);
#pragma unroll
        for (int i = 0; i < 4; ++i) { a[i] = make_uint4(0, 0, 0, 0); if (tok[i] >= 0) a[i] = *((const uint4*)(xn8 + (size_t)tok[i] * D) + lane); }
#pragma unroll
        for (int i = 0; i < 4; ++i) *((uint4*)(xs8 + (size_t)(r0 + i) * D) + lane) = a[i]; }
}

typedef pg8::bf16x8 bf16x8;
typedef unsigned u32x2 __attribute__((ext_vector_type(2)));
#define MFMA16(A, B, C) __builtin_amdgcn_mfma_f32_16x16x32_bf16((A), (B), (C), 0, 0, 0)
__device__ __forceinline__ bf16x8 mk8(unsigned a, unsigned b, unsigned c, unsigned d) { u32x4 v = {a, b, c, d}; return __builtin_bit_cast(bf16x8, v); }

constexpr int H_QD = 0, H_KD = 9216, H_KB = 18432, H_QG = 23040, H_KET = 31744, H_VT = 44032, H_PM = 56320, H_TP = 59392, H_GE = 61440;
constexpr size_t HG_DUMP_BYTES = (size_t)MTOK * 512 * 2, HG_U_BYTES = (size_t)256 * 128 * 128 * 2;
__device__ __forceinline__ void phase_hgrn_a(const bf16_t* P, bf16_t* qsc  , uint2* dump, bf16_t* U  , float* Dsc, LAS unsigned char* lds, int wg, int G, int tid, int wid, int lane) {
    LAUNDER(tid); LAUNDER(lane);
    const int d = tid & 127, part = tid >> 7, g = lane >> 4, c16 = lane & 15;
    LAS float* TP = (LAS float*)(lds + H_TP); LAS float* GE = (LAS float*)(lds + H_GE);
    for (int item = wg; item < 256; item += G) {
        const int b = item >> 6, h = (item >> 4) & 3, sc = item & 15; const size_t tok0 = (size_t)b * SEQ + (size_t)sc * 512;
        f32x4 S[8];
#pragma unroll
        for (int i = 0; i < 8; ++i) S[i] = (f32x4){0.f, 0.f, 0.f, 0.f};
        float gsc = 0.f;
        unsigned lfv[8], qv[8], vv[8];
        { const bf16_t* base = P + (tok0 + 8 * part) * PCOLS + h * 128 + d;
#pragma unroll
          for (int j = 0; j < 8; ++j) { lfv[j] = base[(size_t)j * PCOLS + C_HF]; qv[j] = base[(size_t)j * PCOLS + C_HQ]; vv[j] = base[(size_t)j * PCOLS + C_HI]; } }
        for (int c = 0; c < 16; ++c) {
            float gl[8], lf[8], qf[8]; unsigned vb[8]; float run = 0.f;
#pragma unroll
            for (int j = 0; j < 8; ++j) { lf[j] = bf2f(lfv[j]); qf[j] = bf2f(qv[j]); vb[j] = vv[j]; run += lf[j]; gl[j] = run; }
            if (c < 15) { const bf16_t* base = P + (tok0 + (c + 1) * 32 + 8 * part) * PCOLS + h * 128 + d;
#pragma unroll
                for (int j = 0; j < 8; ++j) { lfv[j] = base[(size_t)j * PCOLS + C_HF]; qv[j] = base[(size_t)j * PCOLS + C_HQ]; vv[j] = base[(size_t)j * PCOLS + C_HI]; } }
            TP[part * 128 + d] = run;
            __syncthreads();
            const float t0 = TP[d], t1 = TP[128 + d], t2 = TP[256 + d], t3 = TP[384 + d];
            const float T0 = t0 + t1, gend = T0 + t2 + t3;
            const float pre = (part == 1) ? t0 : (part == 3) ? t2 : 0.f, gb = (part >> 1) ? T0 : 0.f;
            unsigned kep[4];
#pragma unroll
            for (int j = 0; j < 8; j += 2) {
                float ke2[2];
#pragma unroll
                for (int jj = 0; jj < 2; ++jj) { const int t = 8 * part + j + jj; const float Gl = pre + gl[j + jj], Gt = gb + Gl; const float k = 1.f - __expf(lf[j + jj]), q = qf[j + jj];
                    *(LAS bf16_t*)(lds + H_QD + t * 288 + d * 2) = f2bf(q * __expf(Gl));
                    *(LAS bf16_t*)(lds + H_KD + t * 288 + d * 2) = f2bf(k * __expf(fminf(-Gl, 80.f)));
                    if (part < 2) *(LAS bf16_t*)(lds + H_KB + t * 288 + d * 2) = f2bf(k * __expf(T0 - Gl));
                    *(LAS bf16_t*)(lds + H_QG + t * 272 + d * 2) = f2bf(q * __expf(Gt));
                    qsc[(tok0 + c * 32 + t) * 512 + h * 128 + d] = f2bf(q * __expf(gsc + Gt));
                    ke2[jj] = k * __expf(gend - Gt); }
                kep[j >> 1] = cvt_pk_bf16(ke2[0], ke2[1]); }
            *(LAS u32x4*)(lds + H_KET + d * 96 + part * 16) = (u32x4){kep[0], kep[1], kep[2], kep[3]};
            *(LAS u32x4*)(lds + H_VT + d * 96 + part * 16) = (u32x4){vb[0] | (vb[1] << 16), vb[2] | (vb[3] << 16), vb[4] | (vb[5] << 16), vb[6] | (vb[7] << 16)};
            if (part == 0) GE[d] = __expf(gend);
            gsc += gend;
            __syncthreads();
            if (wid < 3) { const int I = (wid == 0) ? 0 : 1, J = (wid == 2) ? 0 : I; f32x4 acc = {0.f, 0.f, 0.f, 0.f};
#pragma unroll
                for (int kk = 0; kk < 4; ++kk) { const bf16x8 A = *(const LAS bf16x8*)(lds + H_QD + (16 * I + c16) * 288 + kk * 64 + g * 16);
                    const bf16x8 B = (wid == 2) ? *(const LAS bf16x8*)(lds + H_KB + c16 * 288 + kk * 64 + g * 16) : *(const LAS bf16x8*)(lds + H_KD + (16 * J + c16) * 288 + kk * 64 + g * 16);
                    acc = MFMA16(A, B, acc); }
#pragma unroll
                for (int r = 0; r < 4; ++r) { const int t = 4 * g + r; const float v = (I == J && c16 > t) ? 0.f : acc[r]; *(LAS bf16_t*)(lds + H_PM + (16 * I + t) * 96 + (16 * J + c16) * 2) = f2bf(v); }
            } else if (wid == 3) {
#pragma unroll
                for (int r = 0; r < 4; ++r) *(LAS bf16_t*)(lds + H_PM + (4 * g + r) * 96 + (16 + c16) * 2) = (bf16_t)0;
            }
            __syncthreads();
            { const bf16x8 Bv = *(const LAS bf16x8*)(lds + H_VT + (16 * wid + c16) * 96 + g * 16);
              unsigned sp[8][2];
#pragma unroll
              for (int i = 0; i < 8; ++i) { sp[i][0] = cvt_pk_bf16(S[i][0], S[i][1]); sp[i][1] = cvt_pk_bf16(S[i][2], S[i][3]); }
              const size_t chunk_g = (tok0 >> 5) + c;
#pragma unroll
              for (int rt = 0; rt < 2; ++rt) { f32x4 o = {0.f, 0.f, 0.f, 0.f};
                  o = MFMA16(*(const LAS bf16x8*)(lds + H_PM + (16 * rt + c16) * 96 + g * 16), Bv, o);
#pragma unroll
                  for (int kk = 0; kk < 4; ++kk) { const LAS unsigned char* qp = lds + H_QG + (16 * rt + c16) * 272 + (32 * kk + 4 * g) * 2;
                      const u32x2 lo = *(const LAS u32x2*)qp, hi = *(const LAS u32x2*)(qp + 32);
                      o = MFMA16(mk8(lo.x, lo.y, hi.x, hi.y), mk8(sp[2 * kk][0], sp[2 * kk][1], sp[2 * kk + 1][0], sp[2 * kk + 1][1]), o); }
                  dump[(((chunk_g * 4 + h) * 2 + rt) * 8 + wid) * 64 + lane] = make_uint2(cvt_pk_bf16(o[0], o[1]), cvt_pk_bf16(o[2], o[3])); }
#pragma unroll
              for (int i = 0; i < 8; ++i) { const f32x4 dec = *(const LAS f32x4*)(lds + H_GE + (16 * i + 4 * g) * 4); S[i] = S[i] * dec;
                  S[i] = MFMA16(*(const LAS bf16x8*)(lds + H_KET + (16 * i + c16) * 96 + g * 16), Bv, S[i]); } }
            __syncthreads();
        }
#pragma unroll
        for (int i = 0; i < 8; ++i)
#pragma unroll
            for (int r = 0; r < 4; ++r) U[((size_t)item * 128 + 16 * i + 4 * g + r) * 128 + 16 * wid + c16] = f2bf(S[i][r]);
        if (part == 0) Dsc[item * 128 + d] = __expf(gsc);
    }
}
constexpr int HC_SIN = 0;
__device__ __forceinline__ void phase_hgrn_c(const bf16_t* P, bf16_t* qoa  , const uint2* dump, const bf16_t* U, const float* Dsc, const float* gain, LAS unsigned char* lds, int wg, int G, int tid, int wid, int lane) {
    LAUNDER(tid); LAUNDER(lane);
    const int g = lane >> 4, c16 = lane & 15;
    for (int item = wg; item < 256; item += G) {
        const int b = item >> 6, h = (item >> 4) & 3, sc = item & 15; const size_t tok0 = (size_t)b * SEQ + (size_t)sc * 512;
#pragma unroll 1
        for (int kq = 0; kq < 2; ++kq) { float s[16];
#pragma unroll
          for (int k = 0; k < 16; ++k) s[k] = 0.f;
#pragma unroll 8
          for (int j = 0; j < sc; ++j) { const size_t it = (size_t)(item - sc + j);
#pragma unroll
              for (int k = 0; k < 2; ++k) { const int e0 = 8 * (tid + 512 * (kq * 2 + k)); const uint4 uu = *(const uint4*)(U + it * 16384 + e0); const float dd = Dsc[it * 128 + (e0 >> 7)];
                  s[8 * k + 0] = dd * s[8 * k + 0] + bflo(uu.x); s[8 * k + 1] = dd * s[8 * k + 1] + bfhi(uu.x); s[8 * k + 2] = dd * s[8 * k + 2] + bflo(uu.y); s[8 * k + 3] = dd * s[8 * k + 3] + bfhi(uu.y);
                  s[8 * k + 4] = dd * s[8 * k + 4] + bflo(uu.z); s[8 * k + 5] = dd * s[8 * k + 5] + bfhi(uu.z); s[8 * k + 6] = dd * s[8 * k + 6] + bflo(uu.w); s[8 * k + 7] = dd * s[8 * k + 7] + bfhi(uu.w); } }
#pragma unroll
          for (int k = 0; k < 2; ++k) { const int e0 = 8 * (tid + 512 * (kq * 2 + k));
#pragma unroll
              for (int i = 0; i < 8; ++i) { const int e = e0 + i; *(LAS bf16_t*)(lds + HC_SIN + (e & 127) * 288 + (e >> 7) * 2) = f2bf(s[8 * k + i]); } } }
        __syncthreads();
        bf16x8 An[4]; uint2 oln[8]; unsigned hgn[8][4];
#define HC_LOAD(rtile_) do { const size_t row0_ = tok0 + 64 * wid + 16 * (rtile_); const size_t cg_ = (tok0 >> 5) + 2 * wid + ((rtile_) >> 1); const int rt_ = (rtile_) & 1; \
            _Pragma("unroll") for (int kk = 0; kk < 4; ++kk) An[kk] = *(const bf16x8*)(qoa + (row0_ + c16) * 512 + h * 128 + 32 * kk + 8 * g); \
            _Pragma("unroll") for (int vt = 0; vt < 8; ++vt) oln[vt] = dump[(((cg_ * 4 + h) * 2 + rt_) * 8 + vt) * 64 + lane]; \
            _Pragma("unroll") for (int vt = 0; vt < 8; ++vt) _Pragma("unroll") for (int r = 0; r < 4; ++r) hgn[vt][r] = P[(row0_ + 4 * g + r) * PCOLS + C_HG + h * 128 + 16 * vt + c16]; } while (0)
        HC_LOAD(0);
#pragma unroll
        for (int rtile = 0; rtile < 4; ++rtile) {
            const size_t row0 = tok0 + 64 * wid + 16 * rtile;
            bf16x8 A[4]; uint2 olc[8]; unsigned hgv[8][4];
#pragma unroll
            for (int kk = 0; kk < 4; ++kk) A[kk] = An[kk];
#pragma unroll
            for (int vt = 0; vt < 8; ++vt) { olc[vt] = oln[vt];
#pragma unroll
                for (int r = 0; r < 4; ++r) hgv[vt][r] = hgn[vt][r]; }
            if (rtile + 1 < 4) HC_LOAD(rtile + 1);
            asm volatile("" ::: "memory");
            f32x4 acc[8]; float ss[4] = {0.f, 0.f, 0.f, 0.f};
#pragma unroll
            for (int vt = 0; vt < 8; ++vt) { acc[vt] = (f32x4){0.f, 0.f, 0.f, 0.f};
#pragma unroll
                for (int kk = 0; kk < 4; ++kk) acc[vt] = MFMA16(A[kk], *(const LAS bf16x8*)(lds + HC_SIN + (16 * vt + c16) * 288 + (32 * kk + 8 * g) * 2), acc[vt]);
                const uint2 ol = olc[vt];
                acc[vt][0] += bflo(ol.x); acc[vt][1] += bfhi(ol.x); acc[vt][2] += bflo(ol.y); acc[vt][3] += bfhi(ol.y);
#pragma unroll
                for (int r = 0; r < 4; ++r) ss[r] += acc[vt][r] * acc[vt][r]; }
            float rstd[4];
#pragma unroll
            for (int r = 0; r < 4; ++r) { float s = ss[r]; s += xor_f<1>(s); s += xor_f<2>(s); s += xor_f<4>(s); s += xor_f<8>(s); rstd[r] = rsqrtf(s * (1.f / 128.f) + EPS); }
#pragma unroll
            for (int vt = 0; vt < 8; ++vt) { const float gn = gain[16 * vt + c16];
#pragma unroll
                for (int r = 0; r < 4; ++r) { const size_t row = row0 + 4 * g + r;
                    qoa[row * 512 + h * 128 + 16 * vt + c16] = f2bf(acc[vt][r] * rstd[r] * gn * bf2f(hgv[vt][r])); } }
        }
#undef HC_LOAD
        __syncthreads();
    }
}

constexpr int GM_VT = 0, GM_W = 36864, GM_RS = 73728, GM_XT = 75776;
__device__ __forceinline__ void phase_gmlp(const bf16_t* P, const float* __restrict__ ws_l, const float* __restrict__ bs_l, const float* __restrict__ gv_l, bf16_t* ob, LAS unsigned char* lds, int wg, int G, int tid, int wid, int lane) {
    LAUNDER(tid); LAUNDER(lane);
    const int g = lane >> 4, c16 = lane & 15; LAS float* RS = (LAS float*)(lds + GM_RS);
    for (int item = wg; item < MTOK / 128; item += G) {
        const size_t tok0 = (size_t)item * 128;
        uint4 xq[4]; float4 waq[4], wbq[4];
#define GM_LOAD(grp_) do { _Pragma("unroll") for (int ps = 0; ps < 4; ++ps) { const int idx = tid + ps * 512, s = idx >> 4, c8 = (idx & 15) * 8; xq[ps] = *(const uint4*)(P + (tok0 + s) * PCOLS + C_GV + (grp_) * 128 + c8); \
            waq[ps] = *(const float4*)(ws_l + (size_t)(grp_) * 16384 + s * 128 + c8); wbq[ps] = *(const float4*)(ws_l + (size_t)(grp_) * 16384 + s * 128 + c8 + 4); } } while (0)
        GM_LOAD(0);
        { const int s = tid >> 2, qd = tid & 3; const bf16_t* rp = P + (tok0 + s) * PCOLS + C_GV + qd * 128; float ss = 0.f;
#pragma unroll
          for (int j = 0; j < 16; ++j) { const uint4 x = *(const uint4*)(rp + j * 8); ss += bflo(x.x) * bflo(x.x) + bfhi(x.x) * bfhi(x.x) + bflo(x.y) * bflo(x.y) + bfhi(x.y) * bfhi(x.y) + bflo(x.z) * bflo(x.z) + bfhi(x.z) * bfhi(x.z) + bflo(x.w) * bflo(x.w) + bfhi(x.w) * bfhi(x.w); }
          ss += xor_f<1>(ss); ss += xor_f<2>(ss); if (qd == 0) RS[s] = rsqrtf(ss * (1.f / 512.f) + EPS); }
        for (int grp = 0; grp < 4; ++grp) {
            __syncthreads();
#pragma unroll
            for (int ps = 0; ps < 4; ++ps) { const int idx = tid + ps * 512, s = idx >> 4, c8 = (idx & 15) * 8; const uint4 x = xq[ps];
                const float rs = RS[s]; const float4 ga = *(const float4*)(gv_l + grp * 128 + c8), gb = *(const float4*)(gv_l + grp * 128 + c8 + 4);
                const float e[8] = {bflo(x.x) * rs * ga.x, bfhi(x.x) * rs * ga.y, bflo(x.y) * rs * ga.z, bfhi(x.y) * rs * ga.w, bflo(x.z) * rs * gb.x, bfhi(x.z) * rs * gb.y, bflo(x.w) * rs * gb.z, bfhi(x.w) * rs * gb.w};
#pragma unroll
                for (int i = 0; i < 8; ++i) *(LAS bf16_t*)(lds + GM_VT + (c8 + i) * 288 + s * 2) = f2bf(e[i]);
                const int t = idx >> 4, s8 = (idx & 15) * 8; const float4 wa = waq[ps], wb = wbq[ps];
                *(LAS u32x4*)(lds + GM_W + t * 288 + s8 * 2) = (u32x4){cvt_pk_bf16(s8 + 0 <= t ? wa.x : 0.f, s8 + 1 <= t ? wa.y : 0.f), cvt_pk_bf16(s8 + 2 <= t ? wa.z : 0.f, s8 + 3 <= t ? wa.w : 0.f),
                                                                    cvt_pk_bf16(s8 + 4 <= t ? wb.x : 0.f, s8 + 5 <= t ? wb.y : 0.f), cvt_pk_bf16(s8 + 6 <= t ? wb.z : 0.f, s8 + 7 <= t ? wb.w : 0.f)}; }
            if (grp + 1 < 4) GM_LOAD(grp + 1);
            __syncthreads();
            LAS unsigned char* xt = lds + GM_XT + wid * (16 * 272);
            const int xrow = lane >> 2, xseg = (lane & 3) * 32;
            u32x4 gq4[4];
#pragma unroll
            for (int j = 0; j < 4; ++j) gq4[j] = *(const u32x4*)(P + (tok0 + 16 * wid + xrow) * PCOLS + C_GU + grp * 128 + xseg + j * 8);
            f32x4 acc[8];
#pragma unroll
            for (int ct = 0; ct < 8; ++ct) acc[ct] = (f32x4){0.f, 0.f, 0.f, 0.f};
            for (int kk = 0; kk <= (wid >> 1); ++kk) { const bf16x8 A = *(const LAS bf16x8*)(lds + GM_W + (16 * wid + c16) * 288 + kk * 64 + g * 16);
#pragma unroll
                for (int ct = 0; ct < 8; ++ct) acc[ct] = MFMA16(A, *(const LAS bf16x8*)(lds + GM_VT + (16 * ct + c16) * 288 + kk * 64 + g * 16), acc[ct]); }
#pragma unroll
            for (int j = 0; j < 4; ++j) *(LAS u32x4*)(xt + xrow * 272 + (xseg + j * 8) * 2) = gq4[j];
            asm volatile("" ::: "memory"); __builtin_amdgcn_wave_barrier();
#pragma unroll
            for (int r = 0; r < 4; ++r) { const int t = 16 * wid + 4 * g + r; const float bias = bs_l[grp * 128 + t];
#pragma unroll
                for (int ct = 0; ct < 8; ++ct) { LAS bf16_t* xp = (LAS bf16_t*)(xt + (4 * g + r) * 272 + (16 * ct + c16) * 2); *xp = f2bf(bf2f(*xp) * (acc[ct][r] + bias)); } }
            asm volatile("" ::: "memory"); __builtin_amdgcn_wave_barrier();
#pragma unroll
            for (int j = 0; j < 4; ++j) *(u32x4*)(ob + (tok0 + 16 * wid + xrow) * 512 + grp * 128 + xseg + j * 8) = *(const LAS u32x4*)(xt + xrow * 272 + (xseg + j * 8) * 2);
            asm volatile("" ::: "memory"); __builtin_amdgcn_wave_barrier();
        }
        __syncthreads();
#undef GM_LOAD
    }
}

constexpr int AT_KL = 0, AT_VT = 10240, AT_MIN = 10240 + 64 * 144;
template <bool DIAG>
__device__ __forceinline__ void attn_block(LAS unsigned char* lds, const bf16x8 (&Bq)[2], f32x4 (&O)[4], float& carry, int sb0, int t, int g, int c16, unsigned tri_lo, unsigned tri_hi, unsigned ONES, unsigned ZERO) {
    f32x4 z[4]; unsigned hi[4][2];
#pragma unroll
    for (int st = 0; st < 4; ++st) { z[st] = (f32x4){0.f, 0.f, 0.f, 0.f};
#pragma unroll
        for (int kk = 0; kk < 2; ++kk) z[st] = MFMA16(*(const LAS bf16x8*)(lds + AT_KL + (16 * st + c16) * 160 + kk * 64 + g * 16), Bq[kk], z[st]);
        float spv[4];
#pragma unroll
        for (int r = 0; r < 4; ++r) { const float sp = __builtin_amdgcn_logf(1.f + __builtin_amdgcn_exp2f(z[st][r])); spv[r] = (!DIAG || (sb0 + 16 * st + 4 * g + r < t)) ? sp : 0.f; }
        hi[st][0] = cvt_pk_bf16(spv[0], spv[1]); hi[st][1] = cvt_pk_bf16(spv[2], spv[3]); }
    f32x4 sf[4];
#pragma unroll
    for (int so = 0; so < 4; ++so) { sf[so] = (f32x4){0.f, 0.f, 0.f, 0.f};
#pragma unroll
        for (int kk = 0; kk < 2; ++kk) { if (2 * kk + 1 < so) continue;
            const unsigned a0 = (2 * kk > so) ? ONES : (2 * kk == so) ? tri_lo : ZERO, a1 = (2 * kk > so) ? ONES : (2 * kk == so) ? tri_hi : ZERO;
            const unsigned a2 = (2 * kk + 1 > so) ? ONES : tri_lo, a3 = (2 * kk + 1 > so) ? ONES : tri_hi;
            sf[so] = MFMA16(mk8(a0, a1, a2, a3), mk8(hi[2 * kk][0], hi[2 * kk][1], hi[2 * kk + 1][0], hi[2 * kk + 1][1]), sf[so]); } }
    unsigned pa[4][2];
#pragma unroll
    for (int st = 0; st < 4; ++st) { float av[4];
#pragma unroll
        for (int r = 0; r < 4; ++r) { const float a = __builtin_amdgcn_exp2f(z[st][r] - carry - sf[st][r]); av[r] = (!DIAG || (sb0 + 16 * st + 4 * g + r < t)) ? a : 0.f; }
        pa[st][0] = cvt_pk_bf16(av[0], av[1]); pa[st][1] = cvt_pk_bf16(av[2], av[3]); }
#pragma unroll
    for (int kk = 0; kk < 2; ++kk) { const bf16x8 Aop = mk8(pa[2 * kk][0], pa[2 * kk][1], pa[2 * kk + 1][0], pa[2 * kk + 1][1]);
#pragma unroll
        for (int dt = 0; dt < 4; ++dt) { const LAS unsigned char* vp = lds + AT_VT + (16 * dt + c16) * 144 + (32 * kk + 4 * g) * 2; const u32x2 v0 = *(const LAS u32x2*)vp, v1 = *(const LAS u32x2*)(vp + 32);
            O[dt] = MFMA16(Aop, mk8(v0.x, v0.y, v1.x, v1.y), O[dt]); } }
    carry += bperm_f(sf[0][0], c16);
}
__device__ __forceinline__ void phase_attn(const bf16_t* P, const float* __restrict__ gq, const float* __restrict__ gk, bf16_t* oc, LAS unsigned char* lds, int wg, int G, int tid, int wid, int lane) {
    LAUNDER(tid); LAUNDER(lane);
    const int g = lane >> 4, c16 = lane & 15; LAS float* MINW = (LAS float*)(lds + AT_MIN);
    unsigned ONES = 0x3F803F80u, ZERO = 0u; LAUNDER(ONES); LAUNDER(ZERO);
    const unsigned tri_lo = ((4 * g + 0 >= c16) ? 0x3F80u : 0u) | ((4 * g + 1 >= c16) ? 0x3F800000u : 0u), tri_hi = ((4 * g + 2 >= c16) ? 0x3F80u : 0u) | ((4 * g + 3 >= c16) ? 0x3F800000u : 0u);
    for (int item = wg; item < NB * 8 * (SEQ / 128); item += G) {
        const int qt = item & 63, h = (item >> 6) & 7, b = item >> 9; const int t0 = qt * 128, tq0 = t0 + 16 * wid, t = tq0 + c16; const size_t tokb = (size_t)b * SEQ;
        bf16x8 Bq[2];
        { const bf16_t* qp = P + (tokb + t) * PCOLS + C_SQ + h * 64; const uint4 x0 = *(const uint4*)(qp + 8 * g), x1 = *(const uint4*)(qp + 32 + 8 * g);
          float e[16] = {bflo(x0.x), bfhi(x0.x), bflo(x0.y), bfhi(x0.y), bflo(x0.z), bfhi(x0.z), bflo(x0.w), bfhi(x0.w), bflo(x1.x), bfhi(x1.x), bflo(x1.y), bfhi(x1.y), bflo(x1.z), bfhi(x1.z), bflo(x1.w), bfhi(x1.w)};
          float ss = 0.f;
#pragma unroll
          for (int i = 0; i < 16; ++i) ss += e[i] * e[i];
          ss += xor_f<16>(ss); ss += bperm_f(ss, lane ^ 32);
          const float rq = rsqrtf(ss * (1.f / 64.f) + EPS) * (0.125f * 1.4426950408889634f);
#pragma unroll
          for (int i = 0; i < 16; ++i) { const int dd = (i < 8 ? 8 * g + i : 32 + 8 * g + (i - 8)); e[i] = e[i] * rq * gq[dd] * gk[dd]; }
          Bq[0] = mk8(cvt_pk_bf16(e[0], e[1]), cvt_pk_bf16(e[2], e[3]), cvt_pk_bf16(e[4], e[5]), cvt_pk_bf16(e[6], e[7]));
          Bq[1] = mk8(cvt_pk_bf16(e[8], e[9]), cvt_pk_bf16(e[10], e[11]), cvt_pk_bf16(e[12], e[13]), cvt_pk_bf16(e[14], e[15])); }
        f32x4 O[4];
#pragma unroll
        for (int i = 0; i < 4; ++i) O[i] = (f32x4){0.f, 0.f, 0.f, 0.f};
        float carry = 0.f, wmin = 0.f;
        const int ks = tid >> 3, kpc = tid & 7;
        const bf16_t* rp0 = P + (tokb + ks) * PCOLS + h * 64 + kpc * 8;
        uint4 kx = *(const uint4*)(rp0 + (size_t)(((t0 + 127) >> 6) * 64) * PCOLS + C_SK), vx = *(const uint4*)(rp0 + (size_t)(((t0 + 127) >> 6) * 64) * PCOLS + C_SV);
        for (int kb = (t0 + 127) >> 6; kb >= 0; --kb) {
            const int sb0 = kb * 64;
            { const int s = ks, pc = kpc;
              float ke[8] = {bflo(kx.x), bfhi(kx.x), bflo(kx.y), bfhi(kx.y), bflo(kx.z), bfhi(kx.z), bflo(kx.w), bfhi(kx.w)}; float ssk = 0.f;
#pragma unroll
              for (int i = 0; i < 8; ++i) ssk += ke[i] * ke[i];
              ssk += xor_f<1>(ssk); ssk += xor_f<2>(ssk); ssk += xor_f<4>(ssk);
              const float rk = rsqrtf(ssk * (1.f / 64.f) + EPS);
              *(LAS u32x4*)(lds + AT_KL + s * 160 + pc * 16) = (u32x4){cvt_pk_bf16(ke[0] * rk, ke[1] * rk), cvt_pk_bf16(ke[2] * rk, ke[3] * rk), cvt_pk_bf16(ke[4] * rk, ke[5] * rk), cvt_pk_bf16(ke[6] * rk, ke[7] * rk)};
              const unsigned vw[4] = {vx.x, vx.y, vx.z, vx.w};
#pragma unroll
              for (int i = 0; i < 8; ++i) *(LAS bf16_t*)(lds + AT_VT + (pc * 8 + i) * 144 + s * 2) = (bf16_t)((vw[i >> 1] >> ((i & 1) * 16)) & 0xffffu);
              if (kb > 0) { kx = *(const uint4*)(rp0 + (size_t)(sb0 - 64) * PCOLS + C_SK); vx = *(const uint4*)(rp0 + (size_t)(sb0 - 64) * PCOLS + C_SV); } }
            __syncthreads();
            if (sb0 < tq0 + 15 && wmin <= 150.04f) {
                if (sb0 + 63 < tq0) attn_block<false>(lds, Bq, O, carry, sb0, t, g, c16, tri_lo, tri_hi, ONES, ZERO);
                else attn_block<true>(lds, Bq, O, carry, sb0, t, g, c16, tri_lo, tri_hi, ONES, ZERO);
            }
            float mn = carry; mn = fminf(mn, xor_f<1>(mn)); mn = fminf(mn, xor_f<2>(mn)); mn = fminf(mn, xor_f<4>(mn)); mn = fminf(mn, xor_f<8>(mn));
            wmin = __builtin_bit_cast(float, __builtin_amdgcn_readfirstlane(__builtin_bit_cast(int, mn)));
            if (lane == 0) MINW[wid] = mn;
            __syncthreads();
            float mall = MINW[0];
#pragma unroll
            for (int w = 1; w < 8; ++w) mall = fminf(mall, MINW[w]);
            if (mall > 150.04f) break;
        }
#pragma unroll
        for (int dt = 0; dt < 4; ++dt)
#pragma unroll
            for (int r = 0; r < 4; ++r) oc[(tokb + tq0 + 4 * g + r) * 512 + h * 64 + 16 * dt + c16] = f2bf(O[dt][r]);
    }
}

#ifdef MK_CHECK
constexpr size_t WS_DIAG = WS_META + 2048;
constexpr size_t WS_SNAP = WS_BLKE + 4096;
static_assert(WS_SNAP + 64 * 1024 * 4 <= WS_W, "snapshot fits");
__device__ __forceinline__ int samp_row(int i) { return (int)(((unsigned)i * 2654435761u + 12345u) % (unsigned)MTOK); }
__device__ __forceinline__ void chk_fail(unsigned* diag, unsigned code) { atomicMin(diag, code); }
__device__ __forceinline__ bool chk_close(float got, float ref, float atol, float rtol) { return fabsf(got - ref) <= atol + rtol * fabsf(ref) && got == got; }

__global__ void k_diag_init(unsigned* diag) { if (threadIdx.x == 0 && blockIdx.x == 0) { diag[0] = 0xffffffffu; diag[16] = 0u; diag[17] = 0xffffffffu; diag[18] = 0u; diag[19] = 0u; diag[20] = 0u; diag[21] = 0u; diag[22] = 0u; diag[23] = 0u; diag[24] = 0u; diag[25] = 0u; diag[26] = 0u; } }
__global__ void k_snapshot(const float* x, float* snap) { const int i = blockIdx.x; const int r = samp_row(i); for (int c = threadIdx.x; c < D; c += blockDim.x) snap[i * D + c] = x[(size_t)r * D + c]; }
__global__ void k_apply_diag(float* out, const unsigned* diag) {
    if (blockIdx.x != 0 || threadIdx.x != 0) return;
    const unsigned code = diag[0]; if (code == 0xffffffffu) return;
    out[0] = (1.0f + 0.1f * (float)(code > 89u ? 89u : code)) * 1.0e6f;
}
struct ChkGemm { const bf16_t* A; int lda; const float* W; int ldw; int K; int mode; const bf16_t* Cb; int ldc; const float* Cf; const float* xold; const float* W2; const float* lb; const bf16_t* Gsrc; int ncols; unsigned code; int use_snap; };
__global__ void k_chk_gemm(ChkGemm c, unsigned* diag) {
    const int i = blockIdx.x; const int r = samp_row(i);
    for (int cc = threadIdx.x; cc < 96; cc += blockDim.x) {
        const int col = (int)(((unsigned)cc * 40503u + (unsigned)i * 977u) % (unsigned)c.ncols);
        float dot = 0.f, dot2 = 0.f;
        for (int k = 0; k < c.K; ++k) { const float av = bf2f(c.A[(size_t)r * c.lda + k]); dot += av * c.W[(size_t)k * c.ldw + col]; if (c.mode == 4) dot2 += av * c.W2[(size_t)k * c.ldw + col]; }
        float ref, got;
        if (c.mode == 0) { const int kind = col >> 9; ref = (kind == 0 || kind == 3) ? siluf_(dot) : kind == 1 ? __logf(c.lb[col - 512] + (1.f - c.lb[col - 512]) * sigmoidf_(dot)) : (kind == 4 || kind == 5) ? gelu_tanh_(dot) : dot; got = bf2f(c.Cb[(size_t)r * c.ldc + col]); }
        else if (c.mode == 1) { ref = sigmoidf_(dot); got = bf2f(c.Cb[(size_t)r * c.ldc + col]); }
        else if (c.mode == 3) { const float xo = c.use_snap ? c.xold[(size_t)i * D + col] : c.xold[(size_t)r * D + col]; ref = xo + dot; got = c.Cf[(size_t)r * D + col]; }
        else { ref = siluf_(dot) * dot2; got = bf2f(c.Cb[(size_t)r * c.ldc + col]); }
        if (!chk_close(got, ref, 0.03f, 0.03f)) { chk_fail(diag, c.code); if (c.mode == 1) { atomicOr(diag + 24 + (i >> 5), 1u << (i & 31)); atomicOr(diag + 26, 1u << ((r & 255) >> 4)); atomicOr(diag + 20 + ((col & 127) >> 5), 1u << (col & 31)); atomicAdd(diag + 16, 1u); atomicMin(diag + 17, (unsigned)(col >> 8)); atomicMax(diag + 18, (unsigned)(col >> 8)); if (fabsf(got - dot) <= 0.03f + 0.03f * fabsf(dot)) atomicAdd(diag + 19, 1u); } }
    }
}
__global__ void k_chk_branch(const bf16_t* ocat, const float* wbr  , const bf16_t* xn, const float* win  , const bf16_t* GH, unsigned code, unsigned* diag) {
    const int i = blockIdx.x; const int r = samp_row(i);
    for (int cc = threadIdx.x; cc < 96; cc += blockDim.x) {
        const int col = (int)(((unsigned)cc * 40503u + (unsigned)i * 977u) % 3072u); const int b = col >> 10, cl = col & 1023;
        float h = 0.f; for (int k = 0; k < 512; ++k) h += bf2f(ocat[(size_t)b * MTOK * 512 + (size_t)r * 512 + k]) * wbr[((size_t)b * 512 + k) * 1024 + cl];
        float g = 0.f; for (int k = 0; k < 1024; ++k) g += bf2f(xn[(size_t)r * D + k]) * win[(size_t)k * INCOLS + PCOLS + col];
        const float ref = sigmoidf_(g) * h, got = bf2f(GH[(size_t)r * GCOLS + col]);
        if (!chk_close(got, ref, 0.03f, 0.04f)) chk_fail(diag, code);
    }
}
__global__ void k_chk_mix(const bf16_t* ocat, const float* wbr  , const bf16_t* Gt, const bf16_t* mix, unsigned code, unsigned* diag) {
    const int i = blockIdx.x; const int r = samp_row(i);
    for (int cc = threadIdx.x; cc < 96; cc += blockDim.x) {
        const int col = (int)(((unsigned)cc * 40503u + (unsigned)i * 977u) % 1024u); float ref = 0.f;
        for (int b = 0; b < 3; ++b) { float h = 0.f; for (int k = 0; k < 512; ++k) h += bf2f(ocat[(size_t)b * MTOK * 512 + (size_t)r * 512 + k]) * wbr[((size_t)b * 512 + k) * 1024 + col]; ref += bf2f(Gt[(size_t)r * GCOLS + b * 1024 + col]) * h; }
        if (!chk_close(bf2f(mix[(size_t)r * D + col]), ref, 0.03f, 0.04f)) chk_fail(diag, code);
    }
}
__global__ void k_chk_attn(const bf16_t* P, const float* gq, const float* gk, const bf16_t* oc, unsigned code, unsigned* diag) {
    const int id = blockIdx.x, lane = threadIdx.x; const int ti = id % 10;
    const int t = ti == 0 ? 0 : ti == 1 ? 1 : ti == 2 ? 2 : ti == 3 ? 63 : ti == 4 ? 64 : ti == 5 ? 65 : ti == 6 ? 200 : ti == 7 ? 1000 : ti == 8 ? 4097 : 8191;
    const int h = (id / 10) % 8, b = id / 80; const size_t tokb = (size_t)b * SEQ;
    float q = bf2f(P[(tokb + t) * PCOLS + C_SQ + h * 64 + lane]); q = q * rsqrtf(wave_sum(q * q) / 64.f + EPS) * gq[lane];
    float o = 0.f, carry = 0.f;
    for (int s = t - 1; s >= 0 && carry < 300.f; --s) {
        float kv = bf2f(P[(tokb + s) * PCOLS + C_SK + h * 64 + lane]); kv = kv * rsqrtf(wave_sum(kv * kv) / 64.f + EPS) * gk[lane];
        const float z = wave_sum(q * kv) * 0.125f; const float sp = logf(1.f + expf(z));
        carry += sp; const float A = expf(z - carry);
        o += A * bf2f(P[(tokb + s) * PCOLS + C_SV + h * 64 + lane]);
    }
    if (!chk_close(bf2f(oc[(tokb + t) * 512 + h * 64 + lane]), o, 0.02f, 0.03f)) chk_fail(diag, code);
}
__global__ void k_chk_gmlp(const bf16_t* P, const float* ws_l, const float* bs_l, const float* gv_l, const bf16_t* ob, unsigned code, unsigned* diag) {
    const int id = blockIdx.x * blockDim.x + threadIdx.x; if (id >= 512) return;
    const int chunk = (id * 37) % (MTOK / 128), t = (id * 53 + 7) % 128, ch = (id * 101 + 3) % 512, g = ch >> 7, c = ch & 127; const size_t tok0 = (size_t)chunk * 128;
    float acc = 0.f;
    for (int s = 0; s <= t; ++s) { float ss = 0.f; for (int k = 0; k < 512; ++k) { const float v = bf2f(P[(tok0 + s) * PCOLS + C_GV + k]); ss += v * v; }
        const float vn = bf2f(P[(tok0 + s) * PCOLS + C_GV + ch]) * rsqrtf(ss / 512.f + EPS) * gv_l[ch]; acc += ws_l[(size_t)g * 16384 + t * 128 + s] * vn; }
    const float ref = bf2f(P[(tok0 + t) * PCOLS + C_GU + ch]) * (acc + bs_l[g * 128 + t]);
    if (!chk_close(bf2f(ob[(tok0 + t) * 512 + ch]), ref, 0.02f, 0.03f)) chk_fail(diag, code);
}
__global__ void k_chk_hgrn(const bf16_t* P, const float* gain, const bf16_t* oa, unsigned code, unsigned* diag) {
    const int id = blockIdx.x; const int ti = id % 8; const int t = ti == 0 ? 0 : ti == 1 ? 1 : ti == 2 ? 5 : ti == 3 ? 63 : ti == 4 ? 64 : ti == 5 ? 200 : ti == 6 ? 511 : 700, h = (id / 8) % 4, b = id / 32; const int v = threadIdx.x; const size_t tokb = (size_t)b * SEQ;
    float o = 0.f;
    for (int d = 0; d < 128; ++d) { float st = 0.f;
        for (int s = 0; s <= t; ++s) { const bf16_t* row = P + (tokb + s) * PCOLS; const float f = expf(bf2f(row[C_HF + h * 128 + d])); st = f * st + (1.f - f) * bf2f(row[C_HI + h * 128 + v]); }
        o += bf2f(P[(tokb + t) * PCOLS + C_HQ + h * 128 + d]) * st; }
    __shared__ float red[128]; red[v] = o * o; __syncthreads();
    for (int w = 64; w > 0; w >>= 1) { if (v < w) red[v] += red[v + w]; __syncthreads(); }
    const float rstd = rsqrtf(red[0] / 128.f + EPS);
    const float ref = o * rstd * gain[v] * bf2f(P[(tokb + t) * PCOLS + C_HG + h * 128 + v]);
    if (!chk_close(bf2f(oa[(tokb + t) * 512 + h * 128 + v]), ref, 0.03f, 0.04f)) chk_fail(diag, code);
}
__global__ void k_chk_moe(const bf16_t* xn, const float* rw, const float* rb, const float* wg, const float* wu, const float* wd, const float* snap, const float* xout, unsigned code, unsigned* diag) {
    const int i = blockIdx.x; const int r = samp_row(i); const int tid = threadIdx.x;
    __shared__ float hid[DFF]; __shared__ float lg[8]; __shared__ float part[256];
    if (tid < 8) { float a = rb[tid]; for (int k = 0; k < D; ++k) a += bf2f(xn[(size_t)r * D + k]) * rw[k * 8 + tid]; lg[tid] = a; }
    __syncthreads();
    int i0 = 0; for (int e = 1; e < 8; ++e) if (lg[e] > lg[i0]) i0 = e;
    int i1 = -1; for (int e = 0; e < 8; ++e) if (e != i0 && (i1 < 0 || lg[e] > lg[i1])) i1 = e;
    const float w0 = 1.f / (1.f + expf(lg[i1] - lg[i0])), w1 = 1.f - w0;
    float outv[8]; for (int j = 0; j < 8; ++j) outv[j] = 0.f;
    for (int kk = 0; kk < 2; ++kk) { const int e = kk ? i1 : i0; const float wgt = kk ? w1 : w0;
        for (int f = tid; f < DFF; f += blockDim.x) { float g = 0.f, u = 0.f; for (int k = 0; k < D; ++k) { const float xv = bf2f(xn[(size_t)r * D + k]); g += xv * wg[((size_t)e * D + k) * DFF + f]; u += xv * wu[((size_t)e * D + k) * DFF + f]; } hid[f] = siluf_(g) * u; }
        __syncthreads();
        for (int j = 0; j < 8; ++j) { const int col = (j * 131 + i * 17) % D; float p = 0.f; for (int f = tid; f < DFF; f += blockDim.x) p += hid[f] * wd[((size_t)e * DFF + f) * D + col];
            part[tid] = p; __syncthreads(); for (int w = 128; w > 0; w >>= 1) { if (tid < w) part[tid] += part[tid + w]; __syncthreads(); } outv[j] += wgt * part[0]; __syncthreads(); }
    }
    if (tid == 0) for (int j = 0; j < 8; ++j) { const int col = (j * 131 + i * 17) % D; const float ref = snap[(size_t)i * D + col] + outv[j]; if (!chk_close(xout[(size_t)r * D + col], ref, 0.04f, 0.04f)) chk_fail(diag, code); }
}
#endif

struct Args { const float* in[21]; float* out; unsigned char* ws; int lo, hi; };
constexpr int NSTEPS = 25;
__device__ __forceinline__ int laneid_() { int v; asm volatile("v_mbcnt_lo_u32_b32 %0, -1, 0\n\tv_mbcnt_hi_u32_b32 %0, -1, %0" : "=v"(v)); return v; }
#define LANEID (laneid_())

__device__ __forceinline__ int cw_(LAS unsigned* cblk, int i) { unsigned z; asm volatile("v_mov_b32 %0, 0" : "=v"(z)); return (int)__builtin_amdgcn_readfirstlane(((LAS unsigned*)((LAS unsigned char*)cblk + z))[i]); }
#ifndef MK_ALIGN
#define MK_ALIGN true
#endif
#ifndef MK_SP2_F8
#define MK_SP2_F8 true
#endif
#ifndef MK_SP2
#define MK_SP2 true
#endif
#ifndef STAG_IN
#define STAG_IN 0
#define STAG_G 0
#define STAG_GU 0
#define STAG_MGU 0
#endif
#ifndef L1_F8
#define L1_F8 false
#endif
#ifndef FFN_F8
#define FFN_F8 false
#endif
template <class Epi, bool VARNT = false, int NSEG = 1, bool FP8 = false>
__device__ __forceinline__ void run_gemm(LAS unsigned char* lds, const Order& S, int K, const Epi& E, int wid, int stagger = 0) {
    if (stagger && ((S.c >> 3) & 1)) { for (int i = 0; i < stagger; ++i) __builtin_amdgcn_s_sleep(127); }
    pg8::gemm_phase<Epi, Order, MK_ALIGN, (FP8 ? MK_SP2_F8 : MK_SP2), VARNT, NSEG, FP8>(lds, K, S, E, wid); }

__global__ void __launch_bounds__(NTHREADS, 2) mk_fwd(Args a) {
    extern __shared__ __attribute__((aligned(16))) unsigned char lds_raw[];
    LAS unsigned char* lds = (LAS unsigned char*)lds_raw;
    const int wid = __builtin_amdgcn_readfirstlane((int)threadIdx.x >> 6);
    LAS unsigned* cblk = (LAS unsigned*)(lds + LDS_MISC);
    { const int tid = threadIdx.x;
      if (tid < 4) cblk[tid] = (tid == 2) ? xb_xcc_id() : 0u;
      if (tid < 46) { const unsigned long long pv = (tid < 42) ? (unsigned long long)a.in[tid >> 1] : (tid < 44) ? (unsigned long long)a.out : (unsigned long long)a.ws; cblk[4 + tid] = (tid & 1) ? (unsigned)(pv >> 32) : (unsigned)pv; }
      if (tid == 46) cblk[50] = (unsigned)a.lo; if (tid == 47) cblk[51] = (unsigned)a.hi; }
    __syncthreads();
#define CW(i) cw_(cblk, (i))
typedef __attribute__((address_space(1))) unsigned char gu8_t;
#define ARGP(i) ((unsigned char*)(gu8_t*)(((unsigned long long)(unsigned)CW(5 + 2 * (i)) << 32) | (unsigned long long)(unsigned)CW(4 + 2 * (i))))
#define IN(i) ((const float*)ARGP(i))
#define OUTP ((float*)ARGP(21))
#define WSP (ARGP(22))
#define GSZ ((int)gridDim.x)
#define WGI ((int)blockIdx.x)
    if (CW(51) - CW(50) > 1 && threadIdx.x == 0) (void)xb_add((unsigned*)(WSP + WS_CTL + CW_BAR) + XB_XCNT(CW(2)), 1u);
#ifndef PROBE_REP
#define PROBE_REP 0ull
#endif
#define RUN(k) (CW(50) <= (k) && (k) < CW(51))
#define NREP(bit) (((PROBE_REP >> (bit)) & 1ull) ? 2 : 1)
#define SEAM(k) do { if (CW(50) <= (k) && (k) + 1 < CW(51)) { XcdBarrier bar_; bar_.bar = (unsigned*)(WSP + WS_CTL + CW_BAR); bar_.x = (unsigned)CW(2); bar_.st = (volatile LAS unsigned*)cblk; xcd_barrier(bar_); if (PROBE_REP & (1ull << 40)) xcd_barrier(bar_); } } while (0)

#define R16 ((bf16_t*)OUTP)
#define R16B ((bf16_t*)(WSP + WS_MHID + (size_t)MOE_MAXBLK * 256 * DFF))
#define WIN ((bf16_t*)(WSP + WS_WIN))
#define WBR ((bf16_t*)(WSP + WS_WBR))
#define WOUT ((bf16_t*)(WSP + WS_WOUT))
#define WGU ((bf16_t*)(WSP + WS_WGU))
#define WDN ((bf16_t*)(WSP + WS_WD))
#define XNB ((bf16_t*)(WSP + WS_XN))
#define PBUF ((bf16_t*)(WSP + WS_P))
#define GBUF ((bf16_t*)(WSP + WS_G))
#define HIDB ((bf16_t*)(WSP + WS_HID))
#define OCATB ((bf16_t*)(WSP + WS_OCAT))
#define MWGU ((bf16_t*)(WSP + WS_MWGU))
#define MWDN ((bf16_t*)(WSP + WS_MWD))
#define XSB ((bf16_t*)(WSP + WS_XS))
#define MHIDB ((bf16_t*)(WSP + WS_MHID))
#define LBB ((float*)(WSP + WS_LB))
#define METAB ((int*)(WSP + WS_META))
#define TOKE ((int*)(WSP + WS_TOKE))
#define TOKW ((float2*)(WSP + WS_TOKW))
#define STOK ((int*)(WSP + WS_SLOTTOK))
#define SWB ((float*)(WSP + WS_SLOTW))
#define BLKE ((int*)(WSP + WS_BLKE))
#define SLABB ((bf16_t*)(WSP + WS_SLAB))
#define HDUMP ((uint2*)(WSP + WS_ORAW))
#define HU ((bf16_t*)(WSP + WS_ORAW + HG_DUMP_BYTES))
#define HDSC ((float*)(WSP + WS_ORAW + HG_DUMP_BYTES + HG_U_BYTES))
#define TIDV (wid * 64 + LANEID)
    for (int rep_ = 0; rep_ < NREP(0); ++rep_) if (RUN(0)) {
        LAS float* tile = (LAS float*)lds; const int tid = TIDV;
#pragma unroll 1
        for (int j = 0; j < 13; ++j) {
            const float* src; bf16_t* dst; int K, N, mode = 0, perm = 1, f8 = 0;
            if (j < 10) { const int l = j / 5, r = j % 5;
                if (r == 0) { src = IN(2) + (size_t)l * D * INCOLS; dst = WIN + (size_t)l * INCOLS * D; K = D; N = INCOLS;  f8 = (L1_F8 && l == 1) ? 1 : 0; }
                else if (r < 4) { src = IN(10) + (size_t)(l * 3 + r - 1) * 512 * D; dst = WBR + (size_t)(l * 3 + r - 1) * D * 512; K = 512; N = D; }
                else { src = IN(11) + (size_t)l * D * D; dst = WOUT + (size_t)l * D * D; K = D; N = D; } }
            else if (j == 10) { src = IN(13); dst = WGU; K = D; N = DFF; mode = 1; }
            else if (j == 11) { src = IN(14); dst = WGU; K = D; N = DFF; mode = 2; }
            else { src = IN(15); dst = WDN; K = DFF; N = D; }
            tc_job(src, K, N, dst, mode, perm, tile, WGI, GSZ, tid, (FFN_F8 && j >= 10) ? 1 : f8);
        }
        if (WGI == 0) { const float a0 = IN(3)[tid], a1 = IN(3)[512 + tid]; LBB[tid] = 0.f; LBB[512 + tid] = sigmoidf_(a1 - a0); }
    }
    if (RUN(0)) { __syncthreads(); phase_rmsnorm<false, false, false>(IN(0), IN(1), XNB, nullptr, nullptr, nullptr, nullptr, WGI, GSZ, wid, LANEID); }
    SEAM(0);

    for (int l = 0; l < 2; ++l) {
        const int sb = l * 10;
        if (l == 1) { for (int rep_ = 0; rep_ < NREP(1); ++rep_) if (RUN(10)) phase_rmsnorm<false, L1_F8>(R16, IN(1) + D, XNB, nullptr, nullptr, nullptr, nullptr, WGI, GSZ, wid, LANEID); SEAM(10); }
        for (int rep_ = 0; rep_ < NREP(2); ++rep_) if (RUN(sb + 1)) { EpiAct E{PBUF, PCOLS, LBB + l * 512, 1};
            if (!L1_F8 || l == 0) { Order S; S.init(XNB, WIN + (size_t)l * INCOLS * D, MTOK, PCOLS, D, GSZ, WGI); run_gemm(lds, S, D, E, wid, STAG_IN); }
            else { Order S; S.init(XNB, WIN + (size_t)l * INCOLS * D, MTOK, PCOLS, D, GSZ, WGI, 0, 0, 0, nullptr, 0, 1); run_gemm<EpiAct, false, 1, true>(lds, S, D, E, wid); } }
        SEAM(sb + 1);
        for (int rep_ = 0; rep_ < NREP(3); ++rep_) if (RUN(sb + 2)) {
            for (int r2 = 0; r2 < NREP(13); ++r2) { phase_hgrn_a(PBUF, OCATB, HDUMP, HU, HDSC, lds, WGI, GSZ, TIDV, wid, LANEID);
            __syncthreads(); }
            for (int r2 = 0; r2 < NREP(14); ++r2) { phase_attn(PBUF, IN(8) + l * 64, IN(9) + l * 64, OCATB + (size_t)2 * MTOK * 512, lds, WGI, GSZ, TIDV, wid, LANEID);
            __syncthreads(); }
            for (int r2 = 0; r2 < NREP(15); ++r2) { phase_gmlp(PBUF, IN(6) + (size_t)l * 4 * 16384, IN(7) + l * 512, IN(5) + l * 512, OCATB + (size_t)MTOK * 512, lds, WGI, GSZ, TIDV, wid, LANEID); __syncthreads(); }
        }
        SEAM(sb + 2);
        if (RUN(sb + 3)) phase_hgrn_c(PBUF, OCATB, HDUMP, HU, HDSC, IN(4) + l * 128, lds, WGI, GSZ, TIDV, wid, LANEID);
        SEAM(sb + 3);
        for (int rep_ = 0; rep_ < NREP(4); ++rep_) if (RUN(sb + 4)) { EpiAct E{GBUF, GCOLS, nullptr, 0};
            if (!L1_F8 || l == 0) { Order S; S.init(XNB, WIN + (size_t)l * INCOLS * D + (size_t)PCOLS * D, MTOK, GCOLS, D, GSZ, WGI); run_gemm(lds, S, D, E, wid, STAG_G); }
            else { Order S; S.init(XNB, (const unsigned char*)(WIN + (size_t)l * INCOLS * D) + (size_t)PCOLS * D, MTOK, GCOLS, D, GSZ, WGI, 0, 0, 0, nullptr, 0, 1); run_gemm<EpiAct, false, 1, true>(lds, S, D, E, wid); } }
        SEAM(sb + 4);
        for (int rep_ = 0; rep_ < NREP(12); ++rep_) if (RUN(sb + 5)) { Order S; S.init(OCATB, WBR + (size_t)l * 3 * D * 512, MTOK, GCOLS, 512, GSZ, WGI, 4, (size_t)MTOK * 512 * 2, (size_t)D * 512 * 2); EpiBranchSeg E{GBUF, XNB}; run_gemm<EpiBranchSeg, false, 3>(lds, S, 512, E, wid); }
        SEAM(sb + 5);
        if (RUN(sb + 6)) { Order S; S.init(XNB, WOUT + (size_t)l * D * D, MTOK, D, D, GSZ, WGI);
            if (l == 0) { EpiResidT<true> E{IN(0), R16}; run_gemm(lds, S, D, E, wid); } else { EpiResidT<false> E{R16, R16}; run_gemm(lds, S, D, E, wid); } }
        SEAM(sb + 6);
        if (l == 0) {
            for (int rep_ = 0; rep_ < NREP(6); ++rep_) if (RUN(7)) phase_rmsnorm<false, FFN_F8>(R16, IN(12), XNB, nullptr, nullptr, nullptr, nullptr, WGI, GSZ, wid, LANEID);
            SEAM(7);
            for (int rep_ = 0; rep_ < NREP(7); ++rep_) if (RUN(8)) { Order S; S.init(XNB, WGU, MTOK, 2 * DFF, D, GSZ, WGI, 0, 0, 0, nullptr, 0, FFN_F8 ? 1 : 2); EpiGUT<FFN_F8> E{HIDB}; run_gemm<EpiGUT<FFN_F8>, false, 1, FFN_F8>(lds, S, D, E, wid, STAG_GU); }
            SEAM(8);
            if (RUN(9)) { Order S; S.init(HIDB, WDN, MTOK, D, DFF, GSZ, WGI, 0, 0, 0, nullptr, 0, FFN_F8 ? 1 : 2); EpiResidT<false> E{R16, R16}; run_gemm<EpiResidT<false>, false, 1, FFN_F8>(lds, S, DFF, E, wid); }
            SEAM(9);
        } else {
            for (int rep_ = 0; rep_ < NREP(8); ++rep_) if (RUN(17)) phase_rmsnorm<true>(R16, IN(12) + D, XNB, IN(16), IN(17), TOKE, TOKW, WGI, GSZ, wid, LANEID);
            SEAM(17);
            for (int rep_ = 0; rep_ < NREP(9); ++rep_) if (RUN(18)) {
                if (WGI >= GSZ - 4) moe_assign(TOKE, TOKW, METAB, STOK, SWB, BLKE, lds, TIDV, WGI - (GSZ - 4));
                else { LAS float* tile = (LAS float*)lds; const int tid = TIDV;
#pragma unroll 1
                    for (int j = 0; j < 3 * NEXP; ++j) { const int e = j / 3, r = j % 3;
                        const float* src = (r == 0 ? IN(18) : r == 1 ? IN(19) : IN(20)) + (size_t)e * D * DFF;
                        bf16_t* dst = (bf16_t*)((r == 2) ? (unsigned char*)MWDN + (size_t)e * D * DFF : (unsigned char*)MWGU + (size_t)e * 2 * DFF * D);
                        tc_job_w(src, r == 2 ? DFF : D, r == 2 ? D : DFF, dst, r == 2 ? 0 : r + 1, 1, tile, WGI, GSZ - 4, wid, LANEID, 1); } }
            }
            SEAM(18);
#define META(i) __hip_atomic_load(METAB + (i), __ATOMIC_RELAXED, __HIP_MEMORY_SCOPE_AGENT)
#define MOE_BMAP(rows_, s0_) do { LAS int* bl_ = (LAS int*)(lds + 131072); const int nb_ = (rows_) >> 8; for (int i_ = TIDV; i_ < nb_; i_ += NTHREADS) bl_[i_] = __hip_atomic_load(BLKE + ((s0_) >> 8) + i_, __ATOMIC_RELAXED, __HIP_MEMORY_SCOPE_AGENT); __syncthreads(); } while (0)
            if (RUN(19)) { const int rows = META(0), s0 = META(2); moe_gather((const unsigned char*)XNB, STOK + s0, rows, (unsigned char*)XSB, WGI, GSZ, wid, LANEID); }
            SEAM(19);
            for (int kc = 0; kc < 2; ++kc) {
                const int se = 20 + 2 * kc;
                for (int rep_ = 0; rep_ < NREP(11); ++rep_) if (RUN(se)) { const int rows = META(kc), s0 = META(2 + kc);
                    if (kc == 1) { const int rows0 = META(0), s00 = META(2); Order T; T.init(MHIDB, MWDN, rows0, D, DFF, GSZ, WGI, 2, 0, (size_t)D * DFF, BLKE + (s00 >> 8), 1, 1);
                        moe_tail_reduce(T, SLABB, R16, R16B, 0, STOK + s00, SWB + s00, WGI, GSZ, wid, LANEID); }
                    MOE_BMAP(rows, s0); Order S; S.init(XSB, MWGU, rows, 2 * DFF, D, GSZ, WGI, 2, 0, (size_t)2 * DFF * D, BLKE + (s0 >> 8), 0, 1); S.bmapl = (const LAS int*)(lds + 131072); EpiGUT<true> E{MHIDB}; run_gemm<EpiGUT<true>, false, 1, true>(lds, S, D, E, wid, STAG_MGU); }
                SEAM(se);
                if (RUN(se + 1)) { const int rows = META(kc), s0 = META(2 + kc);
                    MOE_BMAP(rows, s0); Order S; S.init(MHIDB, MWDN, rows, D, DFF, GSZ, WGI, 2, 0, (size_t)D * DFF, BLKE + (s0 >> 8), 1, 1); S.bmapl = (const LAS int*)(lds + 131072); EpiMoeDown E{kc == 0 ? R16 : R16B, kc == 0 ? (void*)R16B : (void*)OUTP, kc, STOK + s0, SWB + s0, SLABB}; run_gemm<EpiMoeDown, true, 1, true>(lds, S, DFF, E, wid);
                    if (kc == 0) { const int rows1 = META(1), s1 = META(3); moe_gather((const unsigned char*)XNB, STOK + s1, rows1, (unsigned char*)XSB, WGI, GSZ, wid, LANEID); } }
                SEAM(se + 1);
            }
            if (RUN(24)) { const int rows1 = META(1), s1 = META(3); Order T; T.init(MHIDB, MWDN, rows1, D, DFF, GSZ, WGI, 2, 0, (size_t)D * DFF, BLKE + (s1 >> 8), 1, 1);
                moe_tail_reduce(T, SLABB, R16B, OUTP, 1, STOK + s1, SWB + s1, WGI, GSZ, wid, LANEID); }
        }
    }
}

extern "C" void kernel_launch(void* const* d_in, const int* in_sizes, int n_in, void* d_out, int out_size, void* d_ws, size_t ws_size, hipStream_t stream) {
    static int grid = 0;
    if (grid == 0) {
        if (n_in != 21 || out_size != MTOK * D || ws_size < WS_NEED) { fprintf(stderr, "kernel_launch: unexpected shapes (n_in %d out %d ws %zu need %zu)\n", n_in, out_size, ws_size, (size_t)WS_NEED); grid = -1; return; }
        int dev = 0, cus = 0, per_cu = 0;
        if (hipGetDevice(&dev) != hipSuccess || hipDeviceGetAttribute(&cus, hipDeviceAttributeMultiprocessorCount, dev) != hipSuccess) { grid = -1; return; }
        if (hipFuncSetAttribute((const void*)mk_fwd, hipFuncAttributeMaxDynamicSharedMemorySize, LDS_BYTES) != hipSuccess) { fprintf(stderr, "kernel_launch: hipFuncSetAttribute failed\n"); grid = -1; return; }
        if (hipOccupancyMaxActiveBlocksPerMultiprocessor(&per_cu, (const void*)mk_fwd, NTHREADS, LDS_BYTES) != hipSuccess || per_cu < 1) { fprintf(stderr, "kernel_launch: occupancy query says %d\n", per_cu); (void)hipGetLastError(); per_cu = 1; }
        grid = cus;
    }
    if (grid < 0) return;
    (void)hipMemsetAsync((char*)d_ws + WS_CTL, 0, CTL_BYTES, stream);
    Args a{};
    for (int i = 0; i < 21; ++i) a.in[i] = (const float*)d_in[i];
    a.out = (float*)d_out; a.ws = (unsigned char*)d_ws;
#if defined(MK_CHECK)
    {
        unsigned char* ws = (unsigned char*)d_ws; unsigned* diag = (unsigned*)(ws + WS_DIAG); float* snap = (float*)(ws + WS_SNAP);
        const bf16_t* XN = (const bf16_t*)(ws + WS_XN); const bf16_t* Pb = (const bf16_t*)(ws + WS_P); const bf16_t* OC = (const bf16_t*)(ws + WS_OCAT); const float* LB = (const float*)(ws + WS_LB);
        auto run = [&](int s) { a.lo = s; a.hi = s + 1; hipLaunchKernelGGL(mk_fwd, dim3(grid), dim3(NTHREADS), LDS_BYTES, stream, a); };
        hipLaunchKernelGGL(k_diag_init, dim3(1), dim3(64), 0, stream, diag);
        int s = 0; run(s++);
        for (int l = 0; l < 2; ++l) {
            const unsigned cb = l * 10;
            const float* win = a.in[2] + (size_t)l * D * INCOLS;
            if (l == 1) run(s++);
            run(s++);
            { ChkGemm c{}; c.A = XN; c.lda = D; c.W = win; c.ldw = INCOLS; c.K = D; c.mode = 0; c.Cb = Pb; c.ldc = PCOLS; c.lb = LB + l * 512; c.ncols = PCOLS; c.code = cb + 1; hipLaunchKernelGGL(k_chk_gemm, dim3(64), dim3(96), 0, stream, c, diag); }
            run(s++); run(s++);
            hipLaunchKernelGGL(k_chk_hgrn, dim3(128), dim3(128), 0, stream, Pb, a.in[4] + l * 128, OC, cb + 2, diag);
            hipLaunchKernelGGL(k_chk_gmlp, dim3(8), dim3(64), 0, stream, Pb, a.in[6] + (size_t)l * 4 * 16384, a.in[7] + l * 512, a.in[5] + l * 512, OC + (size_t)MTOK * 512, cb + 3, diag);
            hipLaunchKernelGGL(k_chk_attn, dim3(320), dim3(64), 0, stream, Pb, a.in[8] + l * 64, a.in[9] + l * 64, OC + (size_t)2 * MTOK * 512, cb + 4, diag);
            run(s++);
            { ChkGemm c{}; c.A = XN; c.lda = D; c.W = win + PCOLS; c.ldw = INCOLS; c.K = D; c.mode = 1; c.Cb = (const bf16_t*)(ws + WS_G); c.ldc = GCOLS; c.ncols = GCOLS; c.code = cb + 5; hipLaunchKernelGGL(k_chk_gemm, dim3(64), dim3(96), 0, stream, c, diag); }
            run(s++);
            hipLaunchKernelGGL(k_chk_mix, dim3(64), dim3(96), 0, stream, OC, a.in[10] + (size_t)l * 3 * 512 * D, (const bf16_t*)(ws + WS_G), XN, cb + 6, diag);
            if (l == 1) hipLaunchKernelGGL(k_snapshot, dim3(64), dim3(256), 0, stream, (const float*)d_out, snap);
            run(s++);
            { ChkGemm c{}; c.A = XN; c.lda = D; c.W = a.in[11] + (size_t)l * D * D; c.ldw = D; c.K = D; c.mode = 3; c.Cf = (const float*)d_out; c.xold = l ? snap : a.in[0]; c.use_snap = l; c.ncols = D; c.code = cb + 7; hipLaunchKernelGGL(k_chk_gemm, dim3(64), dim3(96), 0, stream, c, diag); }
            run(s++);
            if (l == 0) {
                run(s++);
                { ChkGemm c{}; c.A = XN; c.lda = D; c.W = a.in[13]; c.W2 = a.in[14]; c.ldw = DFF; c.K = D; c.mode = 4; c.Cb = (const bf16_t*)(ws + WS_HID); c.ldc = DFF; c.ncols = DFF; c.code = cb + 8; hipLaunchKernelGGL(k_chk_gemm, dim3(64), dim3(96), 0, stream, c, diag); }
                hipLaunchKernelGGL(k_snapshot, dim3(64), dim3(256), 0, stream, (const float*)d_out, snap);
                run(s++);
                { ChkGemm c{}; c.A = (const bf16_t*)(ws + WS_HID); c.lda = DFF; c.W = a.in[15]; c.ldw = D; c.K = DFF; c.mode = 3; c.Cf = (const float*)d_out; c.xold = snap; c.use_snap = 1; c.ncols = D; c.code = cb + 9; hipLaunchKernelGGL(k_chk_gemm, dim3(64), dim3(96), 0, stream, c, diag); }
            } else {
                hipLaunchKernelGGL(k_snapshot, dim3(64), dim3(256), 0, stream, (const float*)d_out, snap);
                for (int e = 0; e < 7; ++e) run(s++);
                hipLaunchKernelGGL(k_chk_moe, dim3(16), dim3(256), 0, stream, XN, a.in[16], a.in[17], a.in[18], a.in[19], a.in[20], (const float*)snap, (const float*)d_out, 20u, diag);
            }
        }
        if (s != NSTEPS) fprintf(stderr, "step count mismatch %d\n", s);
        hipLaunchKernelGGL(k_apply_diag, dim3(1024), dim3(256), 0, stream, (float*)d_out, (const unsigned*)diag);
    }
#elif !defined(MK_ONE_LAUNCH)
    for (int s = 0; s < NSTEPS; ++s) { a.lo = s; a.hi = s + 1; hipLaunchKernelGGL(mk_fwd, dim3(grid), dim3(NTHREADS), LDS_BYTES, stream, a); }
#else
    a.lo = 0; a.hi = NSTEPS; hipLaunchKernelGGL(mk_fwd, dim3(grid), dim3(NTHREADS), LDS_BYTES, stream, a);
#endif
}
```

```cpp
#define MK_ONE_LAUNCH 1
#include <hip/hip_runtime.h>
#include <cstdio>
#include <cstdint>
#include <cstddef>

#define LAS __attribute__((address_space(3)))
#define XB_TMO      128
#define XB_XCNT(j)  (256  + 64 * (j))
#define XB_XSUB(j)  (1280 + 64 * (j))
#define XB_XGEN(j)  (2304 + 64 * (j))
#define XB_TOP      3328
#define XB_TOPGEN   3392
#define XCD_BAR_WORDS 3456
#define XB_SPIN_CAP (1u << 18)

__device__ __forceinline__ unsigned xb_ld(unsigned* p)              { return __hip_atomic_load(p, __ATOMIC_RELAXED, __HIP_MEMORY_SCOPE_AGENT); }
__device__ __forceinline__ unsigned xb_add(unsigned* p, unsigned v) { return __hip_atomic_fetch_add(p, v, __ATOMIC_RELAXED, __HIP_MEMORY_SCOPE_AGENT); }
__device__ __forceinline__ unsigned xb_xcc_id() { return (unsigned)__builtin_amdgcn_s_getreg((3 << 11) | 20) & 0xFu; }
#define XB_SPIN(cond, bar) do { unsigned _sp = 0; while (cond) { __builtin_amdgcn_s_sleep(1); \
    if ((++_sp & 255u) == 0u) { if (xb_ld(&(bar)[XB_TMO])) break; if (_sp > XB_SPIN_CAP) { atomicAdd(&(bar)[XB_TMO], 1u); break; } } } } while (0)

struct XcdBarrier {
    unsigned* bar; unsigned x;
    volatile LAS unsigned* st;
};

__device__ __forceinline__ XcdBarrier xcd_barrier_post(unsigned* bar, volatile LAS unsigned* st) {
    XcdBarrier b; b.bar = bar; b.x = xb_xcc_id(); b.st = st;
    if (threadIdx.x == 0) (void)xb_add(&bar[XB_XCNT(b.x)], 1u);
    return b;
}
__device__ __forceinline__ void xcd_barrier_complete(unsigned* bar, unsigned x, unsigned& nloc, unsigned& nx) {
    const unsigned G = gridDim.x * gridDim.y * gridDim.z;
    unsigned sum, cnt, mine, sp = 0u;
    for (;;) {
        sum = 0u; cnt = 0u; mine = 0u;
#pragma unroll
        for (unsigned j = 0; j < 16; ++j) { const unsigned c = xb_ld(&bar[XB_XCNT(j)]); sum += c; cnt += (c > 0u) ? 1u : 0u; mine = (j == x) ? c : mine; }
        if (sum == G) break;
        __builtin_amdgcn_s_sleep(1);
        if ((++sp & 255u) == 0u) { if (xb_ld(&bar[XB_TMO])) break; if (sp > XB_SPIN_CAP) { atomicAdd(&bar[XB_TMO], 1u); break; } }
    }
    nloc = mine > 0u ? mine : 1u; nx = cnt > 0u ? cnt : 1u;
}

__device__ __forceinline__ void xcd_barrier(const XcdBarrier& b) {
    asm volatile("s_waitcnt vmcnt(0)" ::: "memory");
    __syncthreads();
    if (threadIdx.x == 0) {
        unsigned* bar = b.bar;
        __builtin_amdgcn_s_waitcnt(0);
        unsigned nloc = b.st[0], nx = b.st[1];
        if (nloc == 0u) { xcd_barrier_complete(bar, b.x, nloc, nx); b.st[0] = nloc; b.st[1] = nx; }
        const unsigned old = xb_add(&bar[XB_XSUB(b.x)], 1u);
        const unsigned gen = old / nloc;
        if (old + 1u == (gen + 1u) * nloc) {
            __builtin_amdgcn_fence(__ATOMIC_RELEASE, "agent");
            asm volatile("s_waitcnt vmcnt(0)" ::: "memory");
            const unsigned og = xb_add(&bar[XB_TOP], 1u);
            const unsigned tg = og / nx;
            if (og + 1u == (tg + 1u) * nx) xb_add(&bar[XB_TOPGEN], 1u);
            else XB_SPIN(xb_ld(&bar[XB_TOPGEN]) == tg, bar);
            __builtin_amdgcn_fence(__ATOMIC_ACQUIRE, "agent");
            xb_add(&bar[XB_XGEN(b.x)], 1u);
            asm volatile("s_waitcnt vmcnt(0)" ::: "memory");
        } else {
            XB_SPIN(xb_ld(&bar[XB_XGEN(b.x)]) == gen, bar);
            __builtin_amdgcn_fence(__ATOMIC_ACQUIRE, "agent");
            asm volatile("s_waitcnt vmcnt(0)" ::: "memory");
        }
    }
    __syncthreads();
}
#ifndef KLOOP_REP
#define KLOOP_REP 1
#endif
#ifndef EPI_REP
#define EPI_REP 1
#endif
namespace pg8 {
#define PG8_LAS __attribute__((address_space(3)))
typedef unsigned short bf16_t;
typedef short bf16x8 __attribute__((ext_vector_type(8)));
typedef float f32x4 __attribute__((ext_vector_type(4)));
typedef unsigned u32x4 __attribute__((ext_vector_type(4)));
constexpr int BM = 256, BK = 64, HALF = 128, HTB = HALF * BK * 2  , STAGE_BYTES = 8 * HTB, NXCD = 8, WGM = 8;

__host__ __device__ __forceinline__ int lds_byte(int r, int c) { const int st = (r >> 4) * 2 + (c >> 5), rr = r & 15, cc = c & 31, ob = rr * 64 + cc * 2; return st * 1024 + (ob ^ (((ob >> 9) & 1) << 5)); }
__host__ __device__ __forceinline__ void stage_rc(int b, int& R, int& C) { const int st = b / 1024, sb = b % 1024, swz = sb ^ (((sb >> 9) & 1) << 5); R = (st >> 1) * 16 + swz / 64; C = (st & 1) * 32 + (swz % 64) / 2; }
__host__ __device__ __forceinline__ int perm32(int rho) { const int n = rho >> 4, i = rho & 15; return 8 * (i >> 2) + 4 * n + (i & 3); }

struct Unit { int pm, pn; const char* a; const char* b; int nt, atomic; };

typedef float f32x2 __attribute__((ext_vector_type(2))); typedef __bf16 bf16x2_t __attribute__((ext_vector_type(2)));
__device__ __forceinline__ unsigned cvt_pk_bf16(float lo, float hi) { f32x2 v = {lo, hi}; bf16x2_t b = __builtin_convertvector(v, bf16x2_t); return __builtin_bit_cast(unsigned, b); }
template <class Epi, class Sched, bool ALIGN_EPI = false, bool SP2 = false, bool VARNT = false, int NSEG = 1, bool FP8 = false>
__device__ __forceinline__ void gemm_phase(PG8_LAS unsigned char* lds, const int K, const Sched& S, const Epi& E, const int wid) {
    int lane; asm volatile("v_mbcnt_lo_u32_b32 %0, -1, 0\n\tv_mbcnt_hi_u32_b32 %0, -1, %0" : "=v"(lane));
    const int tid = wid * 64 + lane, wr = wid >> 2, wc = wid & 3, fr = lane & 15, fq = lane >> 4;
    unsigned voffA[2];
#pragma unroll
    for (int i = 0; i < 2; ++i) { int R, C; stage_rc(tid * 16 + i * 8192, R, C); voffA[i] = FP8 ? (unsigned)(R * K + 2 * C) : (unsigned)(R * K + C) * 2u; }
    const size_t kstep = (size_t)(BK * 2);
    const size_t hstep = (size_t)HALF * K * (FP8 ? 1 : 2);
    const unsigned ldsw = (unsigned)wid * 1024u;
    const int aoff = FP8 ? lds_byte(wr * 64 + fr, fq * 16) : lds_byte(wr * 64 + fr, fq * 8), boff = FP8 ? lds_byte(wc * 32 + fr, fq * 16) : lds_byte(wc * 32 + fr, fq * 8);
    constexpr int KOFF = FP8 ? 16 : 1024;
    const int asw = FP8 ? (fq & 1) * 16 : 0;
    const int aoff1 = FP8 ? (aoff + (asw ^ 16)) : (aoff + KOFF), boff1 = FP8 ? (boff + (asw ^ 16)) : (boff + KOFF);
    const int aoff0 = aoff + asw, boff0 = boff + asw;
#define PG8_SA(b, h) (((b) * 2 + (h)) * HTB)
#define PG8_SB(b, h) ((4 + (b) * 2 + (h)) * HTB)
#define PG8_STAGE(bufoff, gbase, voff) do { _Pragma("unroll") for (int _i = 0; _i < 2; ++_i) { unsigned _vo = (voff)[_i]; asm volatile("" : "+v"(_vo));     \
        __builtin_amdgcn_global_load_lds((const unsigned*)((const char*)(gbase) + _vo), (PG8_LAS unsigned*)(lds + (bufoff) + ldsw + _i * 8192), 16, 0, 0); } } while (0)
#define PG8_LDA(dst, b, h) do { _Pragma("unroll") for (int m = 0; m < 4; ++m) _Pragma("unroll") for (int k = 0; k < 2; ++k) dst[m][k] = *(const PG8_LAS bf16x8*)(lds + PG8_SA(b, h) + (k ? aoff1 : aoff0) + m * 2048); } while (0)
#define PG8_LDB(dst, b, h) do { _Pragma("unroll") for (int n = 0; n < 2; ++n) _Pragma("unroll") for (int k = 0; k < 2; ++k) dst[n][k] = *(const PG8_LAS bf16x8*)(lds + PG8_SB(b, h) + (k ? boff1 : boff0) + n * 2048); } while (0)
#define PG8_MMA(ai, bj, At, Bt) do { __builtin_amdgcn_s_setprio(1); _Pragma("unroll") for (int m = 0; m < 4; ++m) _Pragma("unroll") for (int n = 0; n < 2; ++n) { \
        if constexpr (FP8) { typedef int v8i_ __attribute__((ext_vector_type(8))); struct P2_ { bf16x8 lo, hi; }; \
            const v8i_ b8_ = __builtin_bit_cast(v8i_, (P2_){Bt[n][0], Bt[n][1]}), a8_ = __builtin_bit_cast(v8i_, (P2_){At[m][0], At[m][1]}); \
            acc[ai][bj][m][n] = __builtin_amdgcn_mfma_scale_f32_16x16x128_f8f6f4(b8_, a8_, acc[ai][bj][m][n], 0, 0, 0, 0x79797979, 0, 0x7F7F7F7F); } \
        else { _Pragma("unroll") for (int k = 0; k < 2; ++k) acc[ai][bj][m][n] = __builtin_amdgcn_mfma_f32_16x16x32_bf16(Bt[n][k], At[m][k], acc[ai][bj][m][n], 0, 0, 0); } } \
        __builtin_amdgcn_s_setprio(0); } while (0)
#define PG8_WAIT_V(n) asm volatile("s_waitcnt vmcnt(" #n ")" ::: "memory")
#define PG8_WAIT_L(n) asm volatile("s_waitcnt lgkmcnt(" #n ")" ::: "memory")
#define PG8_BAR __builtin_amdgcn_s_barrier()
#define PG8_SCHED __builtin_amdgcn_sched_barrier(0)
    Unit cur, nxt; int ui = 0;
    if (!S.next(0, cur)) return;
    f32x4 acc[2][2][4][2];
#pragma unroll
    for (int a = 0; a < 2; ++a)
#pragma unroll
        for (int b = 0; b < 2; ++b)
#pragma unroll
            for (int m = 0; m < 4; ++m)
#pragma unroll
                for (int n = 0; n < 2; ++n) acc[a][b][m][n] = (f32x4){0.f, 0.f, 0.f, 0.f};
    bf16x8 At[4][2], B0[2][2], B1[2][2];
    const char* cA = cur.a; const char* cB = cur.b;
    S.a_ready(cur);
    if constexpr (SP2) {
        PG8_STAGE(PG8_SB(0, 0), cB, voffA); PG8_STAGE(PG8_SB(0, 1), cB + hstep, voffA); PG8_STAGE(PG8_SA(0, 0), cA, voffA); PG8_STAGE(PG8_SA(0, 1), cA + hstep, voffA);
        if (wr == 1) PG8_BAR;
        PG8_WAIT_V(2); PG8_BAR;
        PG8_STAGE(PG8_SB(1, 0), cB + kstep, voffA); PG8_STAGE(PG8_SA(1, 0), cA + kstep, voffA); PG8_STAGE(PG8_SB(1, 1), cB + hstep + kstep, voffA);
        PG8_WAIT_V(6); PG8_BAR;
    } else {
        PG8_STAGE(PG8_SB(0, 0), cB, voffA); PG8_STAGE(PG8_SA(0, 0), cA, voffA); PG8_STAGE(PG8_SB(0, 1), cB + hstep, voffA); PG8_STAGE(PG8_SA(0, 1), cA + hstep, voffA);
        if (wr == 1) PG8_BAR;
        PG8_WAIT_V(4); PG8_BAR;
        PG8_STAGE(PG8_SB(1, 0), cB + kstep, voffA); PG8_STAGE(PG8_SA(1, 0), cA + kstep, voffA); PG8_STAGE(PG8_SB(1, 1), cB + hstep + kstep, voffA);
        PG8_WAIT_V(6); PG8_BAR;
    }
    for (;;) {
        const bool has_next = S.next(ui + 1, nxt);
        const char* nA = has_next ? nxt.a : cA; const char* nB = has_next ? nxt.b : cB;
        const int nt = VARNT ? cur.nt : NSEG * (K / (FP8 ? 128 : BK)); constexpr bool SEGD = (NSEG > 1); const int KT = K / BK;
#if KLOOP_REP > 1
        int krep_ = KLOOP_REP; asm volatile("" : "+s"(krep_));
        const char* nA0_ = nA; const char* nB0_ = nB;
_Pragma("unroll 1")
        for (int kr_ = 0; kr_ < krep_; ++kr_) {
        if (kr_ > 0) {
_Pragma("unroll")
            for (int a = 0; a < 2; ++a)
_Pragma("unroll")
                for (int b = 0; b < 2; ++b)
_Pragma("unroll")
                    for (int m = 0; m < 4; ++m)
_Pragma("unroll")
                        for (int n = 0; n < 2; ++n) acc[a][b][m][n] = (f32x4){0.f, 0.f, 0.f, 0.f}; }
        nA = (kr_ == krep_ - 1) ? nA0_ : cA; nB = (kr_ == krep_ - 1) ? nB0_ : cB;
#endif
#pragma unroll 1
        for (int t = 0; t < nt; t += 2) {
            const bool last = (t == nt - 2);
            const char* a1 = SEGD ? cA + (size_t)((t + 1) / KT) * S.abr + (size_t)((t + 1) % KT) * kstep : cA + (size_t)(t + 1) * kstep;
            const char* a2 = last ? nA : (SEGD ? cA + (size_t)((t + 2) / KT) * S.abr + (size_t)((t + 2) % KT) * kstep : cA + (size_t)(t + 2) * kstep);
            const char* b2 = last ? nB : (SEGD ? cB + (size_t)((t + 2) / KT) * S.bbr + (size_t)((t + 2) % KT) * kstep : cB + (size_t)(t + 2) * kstep);
            const char* a3 = a2 + kstep; const char* b3 = b2 + kstep;
            if (last && has_next) S.a_ready(nxt);
            if constexpr (SP2) {
            PG8_LDB(B0, 0, 0); PG8_LDB(B1, 0, 1); PG8_SCHED; PG8_LDA(At, 0, 0); PG8_STAGE(PG8_SA(1, 1), a1 + hstep, voffA);
            PG8_WAIT_V(8); PG8_WAIT_L(0); PG8_BAR; PG8_MMA(0, 0, At, B0); PG8_MMA(0, 1, At, B1); PG8_BAR; PG8_SCHED;
            PG8_LDA(At, 0, 1); PG8_STAGE(PG8_SB(0, 0), b2, voffA); PG8_STAGE(PG8_SB(0, 1), b2 + hstep, voffA); PG8_STAGE(PG8_SA(0, 0), a2, voffA);
            PG8_WAIT_V(8); PG8_WAIT_L(0); PG8_BAR; PG8_MMA(1, 0, At, B0); PG8_MMA(1, 1, At, B1); PG8_BAR; PG8_SCHED;
            PG8_LDB(B0, 1, 0); PG8_LDB(B1, 1, 1); PG8_SCHED; PG8_LDA(At, 1, 0); PG8_STAGE(PG8_SA(0, 1), a2 + hstep, voffA);
            PG8_WAIT_V(8); PG8_WAIT_L(0); PG8_BAR; PG8_MMA(0, 0, At, B0); PG8_MMA(0, 1, At, B1); PG8_BAR; PG8_SCHED;
            PG8_LDA(At, 1, 1); PG8_STAGE(PG8_SB(1, 0), b3, voffA); PG8_STAGE(PG8_SB(1, 1), b3 + hstep, voffA); PG8_STAGE(PG8_SA(1, 0), a3, voffA);
            PG8_WAIT_V(8); PG8_WAIT_L(0); PG8_BAR; PG8_MMA(1, 0, At, B0); PG8_MMA(1, 1, At, B1); PG8_BAR; PG8_SCHED;
            } else {
            PG8_LDB(B0, 0, 0); PG8_SCHED; PG8_LDA(At, 0, 0); PG8_STAGE(PG8_SA(1, 1), a1 + hstep, voffA);
            PG8_WAIT_L(8); PG8_BAR; PG8_WAIT_L(0); PG8_MMA(0, 0, At, B0); PG8_BAR; PG8_SCHED;
            PG8_LDB(B1, 0, 1); PG8_STAGE(PG8_SB(0, 0), b2, voffA);
            PG8_BAR; PG8_WAIT_L(0); PG8_MMA(0, 1, At, B1); PG8_BAR;
            PG8_LDA(At, 0, 1); PG8_STAGE(PG8_SA(0, 0), a2, voffA);
            PG8_BAR; PG8_WAIT_L(0); PG8_MMA(1, 0, At, B0); PG8_BAR; PG8_SCHED;
            PG8_STAGE(PG8_SB(0, 1), b2 + hstep, voffA);
            PG8_WAIT_V(6); PG8_BAR; PG8_MMA(1, 1, At, B1); PG8_BAR;
            PG8_LDB(B0, 1, 0); PG8_SCHED; PG8_LDA(At, 1, 0); PG8_STAGE(PG8_SA(0, 1), a2 + hstep, voffA);
            PG8_WAIT_L(8); PG8_BAR; PG8_WAIT_L(0); PG8_MMA(0, 0, At, B0); PG8_BAR; PG8_SCHED;
            PG8_LDB(B1, 1, 1); PG8_STAGE(PG8_SB(1, 0), b3, voffA);
            PG8_BAR; PG8_WAIT_L(0); PG8_MMA(0, 1, At, B1); PG8_BAR;
            PG8_LDA(At, 1, 1); PG8_STAGE(PG8_SA(1, 0), a3, voffA);
            PG8_BAR; PG8_WAIT_L(0); PG8_MMA(1, 0, At, B0); PG8_BAR; PG8_SCHED;
            PG8_STAGE(PG8_SB(1, 1), b3 + hstep, voffA);
            PG8_WAIT_V(6); PG8_BAR; PG8_MMA(1, 1, At, B1); PG8_BAR;
            }
            if constexpr (SEGD) { if (((t + 2) % KT) == 0 && t + 2 < nt) E.mid(acc, cur, (t + 2) / KT - 1, wr, wc, fr, fq);
            }
        }
#if KLOOP_REP > 1
        }
#endif
        if constexpr (ALIGN_EPI) { if (wr == 0) PG8_BAR; }
        if constexpr (!Epi::AFTER_DRAIN) { int l2_; asm volatile("v_mbcnt_lo_u32_b32 %0, -1, 0\n\tv_mbcnt_hi_u32_b32 %0, -1, %0" : "=v"(l2_));
            if constexpr (EPI_REP > 1 && Epi::IDEM) { int nrep_ = EPI_REP; asm volatile("" : "+s"(nrep_));
_Pragma("unroll 1")
                for (int er_ = 0; er_ < nrep_; ++er_) { asm volatile("v_mbcnt_lo_u32_b32 %0, -1, 0\n\tv_mbcnt_hi_u32_b32 %0, -1, %0" : "=v"(l2_)); E(acc, cur, wr, wc, l2_ & 15, l2_ >> 4); } }
            else E(acc, cur, wr, wc, l2_ & 15, l2_ >> 4);
            S.done(cur); }
        if (!has_next) break;
#pragma unroll
        for (int a = 0; a < 2; ++a)
#pragma unroll
            for (int b = 0; b < 2; ++b)
#pragma unroll
                for (int m = 0; m < 4; ++m)
#pragma unroll
                    for (int n = 0; n < 2; ++n) acc[a][b][m][n] = (f32x4){0.f, 0.f, 0.f, 0.f};
        cur = nxt; cA = nA; cB = nB; ++ui;
        if constexpr (ALIGN_EPI) { if (wr == 1) PG8_BAR; }
    }
    PG8_WAIT_V(0);
    if constexpr (!ALIGN_EPI) { if (wr == 0) PG8_BAR; }
    PG8_BAR;
    if constexpr (Epi::AFTER_DRAIN) { E.fused(acc, cur, wr, wc, fr, fq, lds, wid, lane); S.done(cur); }
#undef PG8_SA
#undef PG8_SB
#undef PG8_STAGE
#undef PG8_LDA
#undef PG8_LDB
#undef PG8_MMA
#undef PG8_WAIT_V
#undef PG8_WAIT_L
#undef PG8_BAR
#undef PG8_SCHED
}
}

typedef pg8::bf16_t bf16_t;
typedef pg8::f32x4 f32x4;
typedef pg8::u32x4 u32x4;
using pg8::cvt_pk_bf16;
constexpr int NB = 4, SEQ = 8192, D = 1024, MTOK = NB * SEQ;
constexpr int PCOLS = 4608, GCOLS = 3072, INCOLS = 7680, DFF = 3584, NEXP = 8;
constexpr int C_HQ = 0, C_HF = 512, C_HI = 1024, C_HG = 1536, C_GU = 2048, C_GV = 2560, C_SQ = 3072, C_SK = 3584, C_SV = 4096;
constexpr float EPS = 1e-6f;
constexpr int NSLOT = 2 * MTOK + 2 * NEXP * 256, MOE_MAXBLK = MTOK / 256 + NEXP;
constexpr int NTHREADS = 512, NWAVES = 8;
constexpr int LDS_BYTES = 147456, LDS_MISC = LDS_BYTES - 256;

constexpr size_t WS_CTL = 0, CTL_BYTES = 65536;
constexpr size_t CW_BAR = 0;
constexpr size_t WS_META = WS_CTL + CTL_BYTES;
constexpr size_t WS_LB = WS_META + 4096;
constexpr size_t WS_TOKE = WS_LB + 4096;
constexpr size_t WS_TOKW = WS_TOKE + (size_t)MTOK * 4;
constexpr size_t WS_SLOTTOK = WS_TOKW + (size_t)MTOK * 8;
constexpr size_t WS_SLOTW = WS_SLOTTOK + (size_t)NSLOT * 4;
constexpr size_t WS_BLKE = WS_SLOTW + (size_t)NSLOT * 4;
constexpr size_t WS_W = 2u << 20;
static_assert(WS_BLKE + 4096 <= WS_W, "small buffers");
constexpr size_t WS_WIN = WS_W;
constexpr size_t WS_WBR = WS_WIN + (size_t)2 * INCOLS * D * 2;
constexpr size_t WS_WOUT = WS_WBR + (size_t)2 * 3 * D * 512 * 2;
constexpr size_t WS_WGU = WS_WOUT + (size_t)2 * D * D * 2;
constexpr size_t WS_WD = WS_WGU + (size_t)2 * DFF * D * 2;
constexpr size_t WS_XN = WS_WD + (size_t)D * DFF * 2;
constexpr size_t WS_C = WS_XN + (size_t)MTOK * D * 2;
constexpr size_t WS_P = WS_C;
constexpr size_t WS_G = WS_C;
constexpr size_t WS_HID = WS_C;
constexpr size_t WS_OCAT = WS_C + (size_t)MTOK * PCOLS * 2;
constexpr size_t WS_ORAW = WS_OCAT + (size_t)3 * MTOK * 512 * 2;
constexpr size_t WS_END1 = WS_ORAW + (size_t)MTOK * 512 * 4;
constexpr size_t WS_MWD = WS_W;
static_assert(WS_MWD + (size_t)NEXP * D * DFF * 2 <= WS_XN, "moe down weights fit below XN");
constexpr size_t WS_MWGU = WS_C;
constexpr size_t WS_XS = WS_MWGU + (size_t)NEXP * 2 * DFF * D * 2;
constexpr size_t WS_MHID = WS_XS + (size_t)MOE_MAXBLK * 256 * D * 2;
constexpr size_t WS_END2 = WS_MHID + (size_t)MOE_MAXBLK * 256 * DFF * 2;
constexpr size_t WS_SLAB = WS_END2;
constexpr size_t WS_END3 = WS_SLAB + (size_t)256 * 256 * 256 * 2;
constexpr size_t WS_NEED = WS_END1 > WS_END3 ? WS_END1 : WS_END3;
static_assert(WS_NEED <= 615053344ull, "workspace budget (sum of the inputs)");

#define LAUNDER(v) asm volatile("" : "+v"(v))
__device__ __forceinline__ float bf2f(unsigned v) { return __uint_as_float(v << 16); }
__device__ __forceinline__ float bflo(unsigned w) { return __uint_as_float(w << 16); }
__device__ __forceinline__ float bfhi(unsigned w) { return __uint_as_float(w & 0xffff0000u); }
__device__ __forceinline__ bf16_t f2bf(float f) { return (bf16_t)(cvt_pk_bf16(f, 0.f) & 0xffffu); }
template <int M> __device__ __forceinline__ float xor_f(float v) { return __builtin_bit_cast(float, __builtin_amdgcn_ds_swizzle(__builtin_bit_cast(int, v), (M << 10) | 0x1f)); }
__device__ __forceinline__ float bperm_f(float v, int src_lane) { return __builtin_bit_cast(float, __builtin_amdgcn_ds_bpermute(src_lane << 2, __builtin_bit_cast(int, v))); }
__device__ __forceinline__ unsigned fp8x4(float a, float b, float c, float d) { int p = 0; a = __builtin_amdgcn_fmed3f(a, -448.f, 448.f); b = __builtin_amdgcn_fmed3f(b, -448.f, 448.f); c = __builtin_amdgcn_fmed3f(c, -448.f, 448.f); d = __builtin_amdgcn_fmed3f(d, -448.f, 448.f);     p = __builtin_amdgcn_cvt_pk_fp8_f32(a, b, p, false); p = __builtin_amdgcn_cvt_pk_fp8_f32(c, d, p, true); return (unsigned)p; }
__device__ __forceinline__ float wave_sum(float v) {
    v += xor_f<1>(v); v += xor_f<2>(v); v += xor_f<4>(v); v += xor_f<8>(v); v += xor_f<16>(v);
    return __builtin_bit_cast(float, __builtin_amdgcn_readlane(__builtin_bit_cast(int, v), 0)) + __builtin_bit_cast(float, __builtin_amdgcn_readlane(__builtin_bit_cast(int, v), 32));
}
__device__ __forceinline__ float sigmoidf_(float x) { return __builtin_amdgcn_rcpf(1.f + __expf(-x)); }
__device__ __forceinline__ float siluf_(float x) { return x * sigmoidf_(x); }
__device__ __forceinline__ float gelu_tanh_(float x) { return x * sigmoidf_(1.5957691216057308f * (x + 0.044715f * x * x * x)); }
__device__ __forceinline__ float softplusf_(float z) { return fmaxf(z, 0.f) + __logf(1.f + __expf(-fabsf(z))); }

struct Order {
    int nM, nN, nwg, G, c, mode; const char* A; const char* Bt; size_t tstep, abr, bbr; const int* bmap; const LAS int* bmapl; int ktiles, nfull, tail, split;
    __device__ __forceinline__ void init(const void* A_, const void* Bt_, int M, int N, int K, int G_, int c_, int mode_ = 0, size_t abr_ = 0, size_t bbr_ = 0, const int* bmap_ = nullptr, int tailsplit = 0, int esz = 2) { asm volatile("" : "+s"(c_));
        bmap = bmap_; bmapl = nullptr; ktiles = K * esz / 128; split = 1; tail = 0;
        nM = M / 256; nN = N / 256; nwg = nM * nN; G = G_; c = c_; mode = mode_; A = (const char*)A_; Bt = (const char*)Bt_; tstep = (size_t)256 * K * esz; abr = abr_; bbr = bbr_; nfull = nwg;
        if (tailsplit) { nfull = (nwg / G) * G; tail = nwg - nfull; split = (tail > 0 && tail * 7 <= G) ? 7 : (tail > 0 && tail * 4 <= G) ? 4 : (tail > 0 && tail * 2 <= G) ? 2 : 1; } }
    __device__ __forceinline__ void map(int L, int& pm, int& pn) const {
        int wgid = L; { const int q = nwg / 8, r = nwg % 8, xcd = wgid % 8, off = wgid / 8; wgid = (xcd < r ? xcd * (q + 1) : r * (q + 1) + (xcd - r) * q) + off; }
        const int nig = 8 * nN, gid = wgid / nig, fm = gid * 8, gsz = ((nM & 7) == 0) ? 8 : ((nM - fm) < 8 ? (nM - fm) : 8); pm = fm + ((wgid % nig) % gsz); pn = (wgid % nig) / gsz; }
    __device__ __forceinline__ bool next(int i, pg8::Unit& u) const {
        if (mode == 4) {
            u.nt = ktiles; u.atomic = 0; const long L = (long)i * G + c; const int nt4 = nM * 4; if (L >= nt4) return false;
            int wgid = (int)L; { const int q = nt4 / 8, r = nt4 % 8, xcd = wgid % 8, off = wgid / 8; wgid = (xcd < r ? xcd * (q + 1) : r * (q + 1) + (xcd - r) * q) + off; }
            const int nig = 8 * 4, gid = wgid / nig, fm = gid * 8, gsz = ((nM & 7) == 0) ? 8 : ((nM - fm) < 8 ? (nM - fm) : 8);
            u.pm = fm + ((wgid % nig) % gsz); u.pn = (wgid % nig) / gsz; u.a = A + (size_t)u.pm * tstep; u.b = Bt + (size_t)u.pn * tstep; return true; }
        if (mode == 3) {
            u.nt = ktiles; u.atomic = 0;
            const int br = i % 3; const long L = (long)(i / 3) * G + c; const int nt4 = nM * 4; if (L >= nt4) return false;
            int wgid = (int)L; { const int q = nt4 / 8, r = nt4 % 8, xcd = wgid % 8, off = wgid / 8; wgid = (xcd < r ? xcd * (q + 1) : r * (q + 1) + (xcd - r) * q) + off; }
            const int nig = 8 * 4, gid = wgid / nig, fm = gid * 8, gsz = ((nM & 7) == 0) ? 8 : ((nM - fm) < 8 ? (nM - fm) : 8);
            u.pm = fm + ((wgid % nig) % gsz); const int pq = (wgid % nig) / gsz; u.pn = br * 4 + pq;
            u.a = A + (size_t)br * abr + (size_t)u.pm * tstep; u.b = Bt + (size_t)br * bbr + (size_t)pq * tstep; return true; }
        long L = (long)i * G + c; int slice = 0; u.nt = ktiles; u.atomic = 0;
        if (L >= nfull) {
            if (split == 1) { if (L >= nwg) return false; }
            else { const long tq = L - nfull; if (i != nfull / G || tq >= (long)tail * split) return false; L = nfull + tq / split; slice = (int)(tq % split); u.nt = ktiles / split; u.atomic = 1 + (int)tq; } }
        int wgid = (int)L; { const int q = nwg / 8, r = nwg % 8, xcd = wgid % 8, off = wgid / 8; wgid = (xcd < r ? xcd * (q + 1) : r * (q + 1) + (xcd - r) * q) + off; }
        const int nig = 8 * nN, gid = wgid / nig, fm = gid * 8, gsz = ((nM & 7) == 0) ? 8 : ((nM - fm) < 8 ? (nM - fm) : 8);
        u.pm = fm + ((wgid % nig) % gsz); u.pn = (wgid % nig) / gsz;
        if (mode == 0) { u.a = A + (size_t)u.pm * tstep; u.b = Bt + (size_t)u.pn * tstep; }
        else if (mode == 2) { const int ex = __builtin_amdgcn_readfirstlane(bmapl[u.pm]);     u.a = A + (size_t)u.pm * tstep + (size_t)slice * u.nt * 128; u.b = Bt + (size_t)ex * bbr + (size_t)u.pn * tstep + (size_t)slice * u.nt * 128; }
        else { const int br = u.pn >> 2; u.a = A + (size_t)br * abr + (size_t)u.pm * tstep; u.b = Bt + (size_t)br * bbr + (size_t)(u.pn & 3) * tstep; }
        return true;
    }
    __device__ __forceinline__ void a_ready(const pg8::Unit&) const {}
    __device__ __forceinline__ void done(const pg8::Unit&) const {}
};

template <int ACT> __device__ __forceinline__ float act_(float x, float lb) {
    if (ACT == 1) return siluf_(x);
    if (ACT == 2) return __logf(lb + (1.f - lb) * sigmoidf_(x));
    if (ACT == 3) return gelu_tanh_(x);
    if (ACT == 4) return sigmoidf_(x);
    return x;
}
struct EpiAct {
    static constexpr bool PERM = true, AFTER_DRAIN = false, IDEM = true;
    bf16_t* O; int ldc; const float* lb; int inproj;
    template <int ACT> __device__ __forceinline__ void run(const f32x4 (&acc)[2][2][4][2], const pg8::Unit& u, int wr, int wc, int fr, int fq) const {
        const int row0 = u.pm * 256 + wr * 64 + fr, col0 = u.pn * 256 + wc * 32 + 8 * fq;
        f32x4 lbv[2][2];
#pragma unroll
        for (int bj = 0; bj < 2; ++bj)
#pragma unroll
            for (int n = 0; n < 2; ++n) lbv[bj][n] = (ACT == 2) ? *(const f32x4*)(lb + (col0 - C_HF) + bj * 128 + 4 * n) : (f32x4){0.f, 0.f, 0.f, 0.f};
#pragma unroll
        for (int ai = 0; ai < 2; ++ai)
#pragma unroll
            for (int m = 0; m < 4; ++m) { bf16_t* rowp = O + (size_t)(row0 + ai * 128 + m * 16) * ldc + col0;
#pragma unroll
                for (int bj = 0; bj < 2; ++bj) { f32x4 v0 = acc[ai][bj][m][0], v1 = acc[ai][bj][m][1];
#pragma unroll
                    for (int i = 0; i < 4; ++i) { v0[i] = act_<ACT>(v0[i], lbv[bj][0][i]); v1[i] = act_<ACT>(v1[i], lbv[bj][1][i]); }
                    u32x4 w; w.x = cvt_pk_bf16(v0[0], v0[1]); w.y = cvt_pk_bf16(v0[2], v0[3]); w.z = cvt_pk_bf16(v1[0], v1[1]); w.w = cvt_pk_bf16(v1[2], v1[3]);
                    *(u32x4*)(rowp + bj * 128) = w; } }
    }
    __device__ __forceinline__ void operator()(const f32x4 (&acc)[2][2][4][2], const pg8::Unit& u, int wr, int wc, int fr, int fq) const {
        if (!inproj) { run<4>(acc, u, wr, wc, fr, fq); return; }
        const int kind = u.pn >> 1;
        if (kind == 0 || kind == 3) run<1>(acc, u, wr, wc, fr, fq);
        else if (kind == 1) run<2>(acc, u, wr, wc, fr, fq);
        else if (kind == 4 || kind == 5) run<3>(acc, u, wr, wc, fr, fq);
        else run<0>(acc, u, wr, wc, fr, fq);
    }
};
struct EpiBranch {
    static constexpr bool PERM = true, AFTER_DRAIN = false, IDEM = false;
    const bf16_t* Gt; bf16_t* mix;
    __device__ __forceinline__ void operator()(const f32x4 (&acc)[2][2][4][2], const pg8::Unit& u, int wr, int wc, int fr, int fq) const {
        const int br = u.pn >> 2, row0 = u.pm * 256 + wr * 64 + fr, col0 = (u.pn & 3) * 256 + wc * 32 + 8 * fq;
#pragma unroll
        for (int ai = 0; ai < 2; ++ai)
#pragma unroll
            for (int m = 0; m < 4; ++m) { const size_t row = (size_t)(row0 + ai * 128 + m * 16); const bf16_t* gp = Gt + row * GCOLS + br * 1024 + col0; bf16_t* mp = mix + row * D + col0;
#pragma unroll
                for (int bj = 0; bj < 2; ++bj) { const f32x4 v0 = acc[ai][bj][m][0], v1 = acc[ai][bj][m][1];
                    const u32x4 g = *(const u32x4*)(gp + bj * 128); u32x4 o = {0u, 0u, 0u, 0u};
                    if (br > 0) o = __builtin_nontemporal_load((const u32x4*)(mp + bj * 128));
                    u32x4 w;
                    w.x = cvt_pk_bf16(bflo(o.x) + v0[0] * bflo(g.x), bfhi(o.x) + v0[1] * bfhi(g.x)); w.y = cvt_pk_bf16(bflo(o.y) + v0[2] * bflo(g.y), bfhi(o.y) + v0[3] * bfhi(g.y));
                    w.z = cvt_pk_bf16(bflo(o.z) + v1[0] * bflo(g.z), bfhi(o.z) + v1[1] * bfhi(g.z)); w.w = cvt_pk_bf16(bflo(o.w) + v1[2] * bflo(g.w), bfhi(o.w) + v1[3] * bfhi(g.w));
                    *(u32x4*)(mp + bj * 128) = w; } }
    }
};
struct EpiBranchSeg {
    static constexpr bool PERM = true, AFTER_DRAIN = false, IDEM = true;
    const bf16_t* Gt; bf16_t* mix;
    __device__ __forceinline__ void mid(f32x4 (&acc)[2][2][4][2], const pg8::Unit& u, int seg, int wr, int wc, int fr, int fq, const bool inv = false) const {
        const int row0 = u.pm * 256 + wr * 64 + fr, col0 = u.pn * 256 + wc * 32 + 8 * fq;
        u32x4 ga[2][2][2], gb[2][2][2];
#define EBS_LOAD(b_) do { _Pragma("unroll") for (int mm = 0; mm < 2; ++mm) { const bf16_t* gp = Gt + (size_t)(row0 + ((b_) >> 1) * 128 + (2 * ((b_) & 1) + mm) * 16) * GCOLS + seg * 1024 + col0; \
            _Pragma("unroll") for (int bj = 0; bj < 2; ++bj) { ga[(b_) & 1][mm][bj] = *(const u32x4*)(gp + bj * 128); gb[(b_) & 1][mm][bj] = *(const u32x4*)(gp + 1024 + bj * 128); } } } while (0)
        EBS_LOAD(0);
#pragma unroll
        for (int b = 0; b < 4; ++b) { const int ai = b >> 1, mp = b & 1;
            if (b + 1 < 4) EBS_LOAD(b + 1);
            asm volatile("" ::: "memory");
#pragma unroll
            for (int mm = 0; mm < 2; ++mm)
#pragma unroll
                for (int bj = 0; bj < 2; ++bj) { const u32x4 a = inv ? gb[b & 1][mm][bj] : ga[b & 1][mm][bj], bb = inv ? ga[b & 1][mm][bj] : gb[b & 1][mm][bj]; const int m = 2 * mp + mm;
                    const float na[8] = {bflo(a.x), bfhi(a.x), bflo(a.y), bfhi(a.y), bflo(a.z), bfhi(a.z), bflo(a.w), bfhi(a.w)}, nb[8] = {bflo(bb.x), bfhi(bb.x), bflo(bb.y), bfhi(bb.y), bflo(bb.z), bfhi(bb.z), bflo(bb.w), bfhi(bb.w)};
#pragma unroll
                    for (int i = 0; i < 4; ++i) { acc[ai][bj][m][0][i] *= fmaxf(na[i], 1e-6f) * __builtin_amdgcn_rcpf(fmaxf(nb[i], 1e-6f)); acc[ai][bj][m][1][i] *= fmaxf(na[4 + i], 1e-6f) * __builtin_amdgcn_rcpf(fmaxf(nb[4 + i], 1e-6f)); } } }
#undef EBS_LOAD
    }
    __device__ __forceinline__ void operator()(const f32x4 (&acc)[2][2][4][2], const pg8::Unit& u, int wr, int wc, int fr, int fq) const {
        const int row0 = u.pm * 256 + wr * 64 + fr, col0 = u.pn * 256 + wc * 32 + 8 * fq;
#pragma unroll
        for (int ai = 0; ai < 2; ++ai) { u32x4 g[4][2];
#pragma unroll
            for (int m = 0; m < 4; ++m)
#pragma unroll
                for (int bj = 0; bj < 2; ++bj) g[m][bj] = *(const u32x4*)(Gt + (size_t)(row0 + ai * 128 + m * 16) * GCOLS + 2048 + col0 + bj * 128);
            asm volatile("" ::: "memory");
#pragma unroll
            for (int m = 0; m < 4; ++m) { bf16_t* mp = mix + (size_t)(row0 + ai * 128 + m * 16) * D + col0;
#pragma unroll
                for (int bj = 0; bj < 2; ++bj) { const f32x4 v0 = acc[ai][bj][m][0], v1 = acc[ai][bj][m][1]; const u32x4 gg = g[m][bj]; u32x4 w;
                    w.x = cvt_pk_bf16(v0[0] * fmaxf(bflo(gg.x), 1e-6f), v0[1] * fmaxf(bfhi(gg.x), 1e-6f)); w.y = cvt_pk_bf16(v0[2] * fmaxf(bflo(gg.y), 1e-6f), v0[3] * fmaxf(bfhi(gg.y), 1e-6f));
                    w.z = cvt_pk_bf16(v1[0] * fmaxf(bflo(gg.z), 1e-6f), v1[1] * fmaxf(bfhi(gg.z), 1e-6f)); w.w = cvt_pk_bf16(v1[2] * fmaxf(bflo(gg.w), 1e-6f), v1[3] * fmaxf(bfhi(gg.w), 1e-6f));
                    *(u32x4*)(mp + bj * 128) = w; } } }
    }
};
template <bool INF>
struct EpiResidT {
    static constexpr bool PERM = true, AFTER_DRAIN = false, IDEM = INF;
    const void* xin; bf16_t* xout;
    __device__ __forceinline__ void operator()(const f32x4 (&acc)[2][2][4][2], const pg8::Unit& u, int wr, int wc, int fr, int fq) const {
        const int row0 = u.pm * 256 + wr * 64 + fr, col0 = u.pn * 256 + wc * 32 + 8 * fq;
        if constexpr (INF) {
#pragma unroll
            for (int ai = 0; ai < 2; ++ai)
#pragma unroll
                for (int mp = 0; mp < 2; ++mp) { f32x4 t[2][2][2];
#pragma unroll
                    for (int mm = 0; mm < 2; ++mm) { const size_t ro = (size_t)(row0 + ai * 128 + (2 * mp + mm) * 16) * D + col0;
#pragma unroll
                        for (int bj = 0; bj < 2; ++bj)
#pragma unroll
                            for (int n = 0; n < 2; ++n) t[mm][bj][n] = *(const f32x4*)((const float*)xin + ro + bj * 128 + n * 4); }
                    asm volatile("" ::: "memory");
#pragma unroll
                    for (int mm = 0; mm < 2; ++mm) { const size_t ro = (size_t)(row0 + ai * 128 + (2 * mp + mm) * 16) * D + col0;
#pragma unroll
                        for (int bj = 0; bj < 2; ++bj) { const f32x4 v0 = t[mm][bj][0] + acc[ai][bj][2 * mp + mm][0], v1 = t[mm][bj][1] + acc[ai][bj][2 * mp + mm][1];
                            u32x4 w; w.x = cvt_pk_bf16(v0[0], v0[1]); w.y = cvt_pk_bf16(v0[2], v0[3]); w.z = cvt_pk_bf16(v1[0], v1[1]); w.w = cvt_pk_bf16(v1[2], v1[3]); *(u32x4*)(xout + ro + bj * 128) = w; } }
                    asm volatile("" ::: "memory"); }
        } else {
#pragma unroll
            for (int ai = 0; ai < 2; ++ai) { u32x4 t[4][2];
#pragma unroll
                for (int m = 0; m < 4; ++m) { const size_t ro = (size_t)(row0 + ai * 128 + m * 16) * D + col0;
#pragma unroll
                    for (int bj = 0; bj < 2; ++bj) t[m][bj] = *(const u32x4*)((const bf16_t*)xin + ro + bj * 128); }
                asm volatile("" ::: "memory");
#pragma unroll
                for (int m = 0; m < 4; ++m) { const size_t ro = (size_t)(row0 + ai * 128 + m * 16) * D + col0;
#pragma unroll
                    for (int bj = 0; bj < 2; ++bj) { const u32x4 o = t[m][bj]; const f32x4 a0 = acc[ai][bj][m][0], a1 = acc[ai][bj][m][1];
                        u32x4 w; w.x = cvt_pk_bf16(bflo(o.x) + a0[0], bfhi(o.x) + a0[1]); w.y = cvt_pk_bf16(bflo(o.y) + a0[2], bfhi(o.y) + a0[3]);
                        w.z = cvt_pk_bf16(bflo(o.z) + a1[0], bfhi(o.z) + a1[1]); w.w = cvt_pk_bf16(bflo(o.w) + a1[2], bfhi(o.w) + a1[3]); *(u32x4*)(xout + ro + bj * 128) = w; } }
                asm volatile("" ::: "memory"); }
        }
    }
};
template <bool F8OUT>
struct EpiGUT {
    static constexpr bool PERM = true, AFTER_DRAIN = false, IDEM = true;
    void* H;
    __device__ __forceinline__ void operator()(const f32x4 (&acc)[2][2][4][2], const pg8::Unit& u, int wr, int wc, int fr, int fq) const {
        const int row0 = u.pm * 256 + wr * 64 + fr, col0 = u.pn * 128 + wc * 32 + 8 * fq;
#pragma unroll
        for (int ai = 0; ai < 2; ++ai)
#pragma unroll
            for (int m = 0; m < 4; ++m) { const size_t eo = (size_t)(row0 + ai * 128 + m * 16) * DFF + col0;
                const f32x4 g0 = acc[ai][0][m][0], g1 = acc[ai][0][m][1], u0 = acc[ai][1][m][0], u1 = acc[ai][1][m][1];
                f32x4 e0 = g0 * -1.4426950408889634f, e1 = g1 * -1.4426950408889634f;
#pragma unroll
                for (int i = 0; i < 4; ++i) { e0[i] = __builtin_amdgcn_exp2f(e0[i]); e1[i] = __builtin_amdgcn_exp2f(e1[i]); }
                f32x4 d0 = e0 + 1.f, d1 = e1 + 1.f;
#pragma unroll
                for (int i = 0; i < 4; ++i) { d0[i] = __builtin_amdgcn_rcpf(d0[i]); d1[i] = __builtin_amdgcn_rcpf(d1[i]); }
                const f32x4 hv0 = g0 * d0 * u0, hv1 = g1 * d1 * u1;
                const float h0 = hv0[0], h1 = hv0[1], h2 = hv0[2], h3 = hv0[3], h4 = hv1[0], h5 = hv1[1], h6 = hv1[2], h7 = hv1[3];
                if (F8OUT) *(uint2*)((unsigned char*)H + eo) = make_uint2(fp8x4(h0, h1, h2, h3), fp8x4(h4, h5, h6, h7));
                else { u32x4 w; w.x = cvt_pk_bf16(h0, h1); w.y = cvt_pk_bf16(h2, h3); w.z = cvt_pk_bf16(h4, h5); w.w = cvt_pk_bf16(h6, h7); *(u32x4*)((bf16_t*)H + eo) = w; } }
    }
};
typedef EpiGUT<false> EpiGU;
struct EpiMoeDown {
    static constexpr bool PERM = true, AFTER_DRAIN = false, IDEM = true;
    const bf16_t* rin; void* rout; int outf; const int* stok; const float* sw; bf16_t* slab;
    __device__ __forceinline__ void operator()(const f32x4 (&acc)[2][2][4][2], const pg8::Unit& u, int wr, int wc, int fr, int fq) const {
        LAUNDER(fr); LAUNDER(fq);
        if (u.atomic) { bf16_t* sp = slab + (size_t)(u.atomic - 1) * 65536 + (size_t)(wr * 64 + fr) * 256 + wc * 32 + 8 * fq;
#pragma unroll
            for (int ai = 0; ai < 2; ++ai)
#pragma unroll
                for (int m = 0; m < 4; ++m)
#pragma unroll
                    for (int bj = 0; bj < 2; ++bj) { const f32x4 v0 = acc[ai][bj][m][0], v1 = acc[ai][bj][m][1]; u32x4 w; w.x = cvt_pk_bf16(v0[0], v0[1]); w.y = cvt_pk_bf16(v0[2], v0[3]); w.z = cvt_pk_bf16(v1[0], v1[1]); w.w = cvt_pk_bf16(v1[2], v1[3]);
                        *(u32x4*)(sp + (size_t)(ai * 128 + m * 16) * 256 + bj * 128) = w; }
            return; }
        const int row0 = u.pm * 256 + wr * 64 + fr, col0 = u.pn * 256 + wc * 32 + 8 * fq;
        int tk[2][4]; float wt[2][4];
#pragma unroll
        for (int ai = 0; ai < 2; ++ai)
#pragma unroll
            for (int m = 0; m < 4; ++m) { const int rl = row0 + ai * 128 + m * 16; tk[ai][m] = stok[rl]; wt[ai][m] = sw[rl]; }
#pragma unroll
        for (int ai = 0; ai < 2; ++ai) { u32x4 t[4][2];
#pragma unroll
            for (int m = 0; m < 4; ++m) { const int tok = tk[ai][m]; const bf16_t* rp = rin + (size_t)(tok < 0 ? 0 : tok) * D + col0;
#pragma unroll
                for (int bj = 0; bj < 2; ++bj) t[m][bj] = *(const u32x4*)(rp + bj * 128); }
            asm volatile("" ::: "memory");
#pragma unroll
            for (int m = 0; m < 4; ++m) { const int tok = tk[ai][m]; const float w = wt[ai][m];
                if (tok >= 0) { const size_t ro = (size_t)tok * D + col0;
#pragma unroll
                    for (int bj = 0; bj < 2; ++bj) { const u32x4 o = t[m][bj]; const f32x4 a0 = acc[ai][bj][m][0] * w, a1 = acc[ai][bj][m][1] * w;
                        const f32x4 v0 = {bflo(o.x) + a0[0], bfhi(o.x) + a0[1], bflo(o.y) + a0[2], bfhi(o.y) + a0[3]}, v1 = {bflo(o.z) + a1[0], bfhi(o.z) + a1[1], bflo(o.w) + a1[2], bfhi(o.w) + a1[3]};
                        if (outf) { float* op = (float*)rout + ro + bj * 128; *(f32x4*)op = v0; *(f32x4*)(op + 4) = v1; }
                        else { u32x4 q; q.x = cvt_pk_bf16(v0[0], v0[1]); q.y = cvt_pk_bf16(v0[2], v0[3]); q.z = cvt_pk_bf16(v1[0], v1[1]); q.w = cvt_pk_bf16(v1[2], v1[3]); *(u32x4*)((bf16_t*)rout + ro + bj * 128) = q; } } } }
            asm volatile("" ::: "memory"); }
    }
};
__device__ __forceinline__ void moe_tail_reduce(const Order& S, const bf16_t* slab, const bf16_t* rin, void* rout, int outf, const int* stok, const float* sw, int wg, int G, int wid, int lane) {
    LAUNDER(lane);
    if (S.split == 1) return;
    for (int task = wg * NWAVES + wid; task < S.tail * 256; task += G * NWAVES) {
        const int j = task >> 8, r = task & 255; int pm, pn; S.map(S.nfull + j, pm, pn);
        const int tok = __hip_atomic_load(stok + pm * 256 + r, __ATOMIC_RELAXED, __HIP_MEMORY_SCOPE_AGENT); if (tok < 0) continue;
        const float w = sw[pm * 256 + r]; f32x4 s = {0.f, 0.f, 0.f, 0.f};
        const size_t ro = (size_t)tok * D + pn * 256 + lane * 4; const uint2 x = *(const uint2*)(rin + ro);
        uint2 xs[7];
#pragma unroll
        for (int sl = 0; sl < 7; ++sl) { xs[sl] = make_uint2(0u, 0u); if (sl < S.split) xs[sl] = *(const uint2*)(slab + (size_t)(j * S.split + sl) * 65536 + (size_t)r * 256 + lane * 4); }
#pragma unroll
        for (int sl = 0; sl < 7; ++sl) { s[0] += bflo(xs[sl].x); s[1] += bfhi(xs[sl].x); s[2] += bflo(xs[sl].y); s[3] += bfhi(xs[sl].y); }
        const f32x4 o = {bflo(x.x) + s[0] * w, bfhi(x.x) + s[1] * w, bflo(x.y) + s[2] * w, bfhi(x.y) + s[3] * w};
        if (outf) *(f32x4*)((float*)rout + ro) = o; else *(uint2*)((bf16_t*)rout + ro) = make_uint2(cvt_pk_bf16(o[0], o[1]), cvt_pk_bf16(o[2], o[3]));
    }
}

__device__ __forceinline__ void tc_job(const float* __restrict__ src, int K, int N, bf16_t* dst, int mode, int perm, LAS float* tile, int wg, int G, int tid, int f8 = 0) {
    LAUNDER(tid);
    const int tn = N / 64, nt = (K / 64) * tn;
    float4 v0 = make_float4(0.f, 0.f, 0.f, 0.f), v1 = v0;
    if (wg < nt) { const int k0 = (wg / tn) * 64, n0 = (wg % tn) * 64; const float* sp = src + (size_t)(k0 + (tid >> 4)) * N + n0 + (tid & 15) * 4; v0 = *(const float4*)sp; v1 = *(const float4*)(sp + (size_t)32 * N); }
    for (int t = wg; t < nt; t += G) {
        const int k0 = (t / tn) * 64, n0 = (t % tn) * 64;
        { LAS float* tp = tile + (tid >> 4) * 65 + (tid & 15) * 4; tp[0] = v0.x; tp[1] = v0.y; tp[2] = v0.z; tp[3] = v0.w; tp += 32 * 65; tp[0] = v1.x; tp[1] = v1.y; tp[2] = v1.z; tp[3] = v1.w; }
        if (t + G < nt) { const int k1 = ((t + G) / tn) * 64, n1 = ((t + G) % tn) * 64; const float* sp = src + (size_t)(k1 + (tid >> 4)) * N + n1 + (tid & 15) * 4; v0 = *(const float4*)sp; v1 = *(const float4*)(sp + (size_t)32 * N); }
        __syncthreads();
        { const int n = tid >> 3, kg = (tid & 7) * 8; unsigned w[4];
#pragma unroll
          for (int j = 0; j < 4; ++j) w[j] = cvt_pk_bf16(tile[(kg + 2 * j) * 65 + n], tile[(kg + 2 * j + 1) * 65 + n]);
          const int nn = n0 + n; int drow = mode == 0 ? nn : ((nn >> 7) * 256 + (nn & 127) + (mode == 2 ? 128 : 0));
          if (perm) { const int c5 = drow & 31; drow = (drow & ~31) + 16 * ((c5 >> 2) & 1) + 4 * (c5 >> 3) + (c5 & 3); }
          if (f8) *(uint2*)((unsigned char*)dst + (size_t)drow * K + k0 + kg) = make_uint2(fp8x4(64.f * tile[(kg + 0) * 65 + n], 64.f * tile[(kg + 1) * 65 + n], 64.f * tile[(kg + 2) * 65 + n], 64.f * tile[(kg + 3) * 65 + n]),
                                                                                          fp8x4(64.f * tile[(kg + 4) * 65 + n], 64.f * tile[(kg + 5) * 65 + n], 64.f * tile[(kg + 6) * 65 + n], 64.f * tile[(kg + 7) * 65 + n]));
          else *(uint4*)(dst + (size_t)drow * K + k0 + kg) = make_uint4(w[0], w[1], w[2], w[3]); }
        __syncthreads();
    }
}

__device__ __forceinline__ void tc_job_w(const float* __restrict__ src, int K, int N, bf16_t* dst, int mode, int perm, LAS float* tile_all, int wg, int G, int wid, int lane, int f8 = 0) {
    LAUNDER(lane);
    LAS float* tile = tile_all + wid * (64 * 65);
    const int tn = N / 64, nt = (K / 64) * tn, TS = G * NWAVES;
    const int r = lane >> 4, c4 = (lane & 15) * 4;
    float4 v[16];
    int t = wg * NWAVES + wid;
    if (t < nt) { const float* sp = src + (size_t)((t / tn) * 64 + r) * N + (t % tn) * 64 + c4;
#pragma unroll
        for (int i = 0; i < 16; ++i) v[i] = *(const float4*)(sp + (size_t)(4 * i) * N); }
    for (; t < nt; t += TS) {
        const int k0 = (t / tn) * 64, n0 = (t % tn) * 64;
#pragma unroll
        for (int i = 0; i < 16; ++i) { LAS float* tp = tile + (r + 4 * i) * 65 + c4; tp[0] = v[i].x; tp[1] = v[i].y; tp[2] = v[i].z; tp[3] = v[i].w; }
        if (t + TS < nt) { const int t1 = t + TS; const float* sp = src + (size_t)((t1 / tn) * 64 + r) * N + (t1 % tn) * 64 + c4;
#pragma unroll
            for (int i = 0; i < 16; ++i) v[i] = *(const float4*)(sp + (size_t)(4 * i) * N); }
        asm volatile("" ::: "memory"); __builtin_amdgcn_wave_barrier();
#pragma unroll
        for (int j = 0; j < 8; ++j) { const int p = lane + 64 * j, n = p >> 3, kg = (p & 7) * 8; float x[8];
#pragma unroll
            for (int q = 0; q < 8; ++q) x[q] = tile[(kg + q) * 65 + n];
            const int nn = n0 + n; int drow = mode == 0 ? nn : ((nn >> 7) * 256 + (nn & 127) + (mode == 2 ? 128 : 0));
            if (perm) { const int c5 = drow & 31; drow = (drow & ~31) + 16 * ((c5 >> 2) & 1) + 4 * (c5 >> 3) + (c5 & 3); }
            if (f8) *(uint2*)((unsigned char*)dst + (size_t)drow * K + k0 + kg) = make_uint2(fp8x4(64.f * x[0], 64.f * x[1], 64.f * x[2], 64.f * x[3]), fp8x4(64.f * x[4], 64.f * x[5], 64.f * x[6], 64.f * x[7]));
            else *(uint4*)(dst + (size_t)drow * K + k0 + kg) = make_uint4(cvt_pk_bf16(x[0], x[1]), cvt_pk_bf16(x[2], x[3]), cvt_pk_bf16(x[4], x[5]), cvt_pk_bf16(x[6], x[7])); }
        asm volatile("" ::: "memory"); __builtin_amdgcn_wave_barrier();
    }
}
__device__ __forceinline__ void tc_job_f8(const float* __restrict__ src, int K, int N, unsigned char* dst, int mode, LAS float* tile, int wg, int G, int tid) {
    LAUNDER(tid);
    const int tn = N / 64, nt = (K / 128) * tn; const int r = tid >> 4, c4 = (tid & 15) * 4;
    float4 v[4];
#pragma unroll
    for (int i = 0; i < 4; ++i) v[i] = make_float4(0.f, 0.f, 0.f, 0.f);
    if (wg < nt) { const float* sp = src + (size_t)((wg / tn) * 128 + r) * N + (wg % tn) * 64 + c4;
#pragma unroll
        for (int i = 0; i < 4; ++i) v[i] = *(const float4*)(sp + (size_t)(32 * i) * N); }
    for (int t = wg; t < nt; t += G) {
        const int k0 = (t / tn) * 128, n0 = (t % tn) * 64;
#pragma unroll
        for (int i = 0; i < 4; ++i) { LAS float* tp = tile + (r + 32 * i) * 65 + c4; tp[0] = v[i].x; tp[1] = v[i].y; tp[2] = v[i].z; tp[3] = v[i].w; }
        if (t + G < nt) { const float* sp = src + (size_t)(((t + G) / tn) * 128 + r) * N + ((t + G) % tn) * 64 + c4;
#pragma unroll
            for (int i = 0; i < 4; ++i) v[i] = *(const float4*)(sp + (size_t)(32 * i) * N); }
        __syncthreads();
        { const int n = tid >> 3, kg = (tid & 7) * 16; float x[16];
#pragma unroll
          for (int q = 0; q < 16; ++q) x[q] = 64.f * tile[(kg + q) * 65 + n];
          const int nn = n0 + n; int drow = mode == 0 ? nn : ((nn >> 7) * 256 + (nn & 127) + (mode == 2 ? 128 : 0));
          { const int c5 = drow & 31; drow = (drow & ~31) + 16 * ((c5 >> 2) & 1) + 4 * (c5 >> 3) + (c5 & 3); }
          *(uint4*)(dst + (size_t)drow * K + k0 + kg) = make_uint4(fp8x4(x[0], x[1], x[2], x[3]), fp8x4(x[4], x[5], x[6], x[7]), fp8x4(x[8], x[9], x[10], x[11]), fp8x4(x[12], x[13], x[14], x[15])); }
        __syncthreads();
    }
}

template <bool ROUTER, bool F8 = ROUTER, bool XBF = true>
__device__ __forceinline__ void phase_rmsnorm(const void* __restrict__ x, const float* __restrict__ gain, bf16_t* xn, const float* __restrict__ rw, const float* __restrict__ rb,
                              int* toke, float2* tokw, int wg, int G, int wid, int lane) {
    LAUNDER(lane);
    constexpr int RB = ROUTER ? 2 : 4;
    float rwv[ROUTER ? 4 : 1][4][NEXP];
    if (ROUTER) {
#pragma unroll
        for (int j = 0; j < 4; ++j)
#pragma unroll
            for (int i = 0; i < 4; ++i) { const float* wr_ = rw + (size_t)(j * 256 + lane * 4 + i) * NEXP; const float4 wa = *(const float4*)wr_, wb = *(const float4*)(wr_ + 4);
                rwv[j][i][0] = wa.x; rwv[j][i][1] = wa.y; rwv[j][i][2] = wa.z; rwv[j][i][3] = wa.w; rwv[j][i][4] = wb.x; rwv[j][i][5] = wb.y; rwv[j][i][6] = wb.z; rwv[j][i][7] = wb.w; } }
    uint2 nx[XBF ? RB : 1][4];
    if (XBF) { const int r0 = (wg * NWAVES + wid) * RB;
        if (r0 < MTOK) {
#pragma unroll
            for (int rr = 0; rr < RB; ++rr)
#pragma unroll
                for (int j = 0; j < 4; ++j) nx[rr][j] = *(const uint2*)((const bf16_t*)x + (size_t)(r0 + rr) * D + j * 256 + lane * 4); } }
    for (int row0 = (wg * NWAVES + wid) * RB; row0 < MTOK; row0 += G * NWAVES * RB) {
        float4 v[RB][4];
#pragma unroll
        for (int rr = 0; rr < RB; ++rr)
#pragma unroll
            for (int j = 0; j < 4; ++j) { const size_t xo = (size_t)(row0 + rr) * D + j * 256 + lane * 4;
                if (XBF) { const uint2 q = nx[rr][j]; v[rr][j] = make_float4(bflo(q.x), bfhi(q.x), bflo(q.y), bfhi(q.y)); } else v[rr][j] = *(const float4*)((const float*)x + xo); }
        if (XBF) { const int r1 = row0 + G * NWAVES * RB;
            if (r1 < MTOK) {
#pragma unroll
                for (int rr = 0; rr < RB; ++rr)
#pragma unroll
                    for (int j = 0; j < 4; ++j) nx[rr][j] = *(const uint2*)((const bf16_t*)x + (size_t)(r1 + rr) * D + j * 256 + lane * 4); } }
#pragma unroll
        for (int rr = 0; rr < RB; ++rr) { const int row = row0 + rr; float ss = 0.f;
#pragma unroll
            for (int j = 0; j < 4; ++j) ss += v[rr][j].x * v[rr][j].x + v[rr][j].y * v[rr][j].y + v[rr][j].z * v[rr][j].z + v[rr][j].w * v[rr][j].w;
            ss = wave_sum(ss);
            const float rstd = rsqrtf(ss * (1.f / D) + EPS);
            float lg[NEXP];
#pragma unroll
            for (int e = 0; e < NEXP; ++e) lg[e] = 0.f;
#pragma unroll
            for (int j = 0; j < 4; ++j) { const float4 g = *(const float4*)(gain + j * 256 + lane * 4);
                const float y0 = v[rr][j].x * rstd * g.x, y1 = v[rr][j].y * rstd * g.y, y2 = v[rr][j].z * rstd * g.z, y3 = v[rr][j].w * rstd * g.w;
                if (F8) *(unsigned*)((unsigned char*)xn + (size_t)row * D + j * 256 + lane * 4) = fp8x4(y0, y1, y2, y3);
                else *(uint2*)(xn + (size_t)row * D + j * 256 + lane * 4) = make_uint2(cvt_pk_bf16(y0, y1), cvt_pk_bf16(y2, y3));
                if (ROUTER) { const float ys[4] = {y0, y1, y2, y3};
#pragma unroll
                    for (int i = 0; i < 4; ++i)
#pragma unroll
                        for (int e = 0; e < NEXP; ++e) lg[e] += ys[i] * rwv[ROUTER ? j : 0][i][e]; } }
            if (ROUTER) {
#pragma unroll
                for (int e = 0; e < NEXP; ++e) lg[e] = wave_sum(lg[e]) + rb[e];
                int i0 = 0; float l0 = lg[0];
#pragma unroll
                for (int e = 1; e < NEXP; ++e) if (lg[e] > l0) { l0 = lg[e]; i0 = e; }
                int i1 = -1; float l1 = -3.4e38f;
#pragma unroll
                for (int e = 0; e < NEXP; ++e) if (e != i0 && lg[e] > l1) { l1 = lg[e]; i1 = e; }
                const float w0 = __builtin_amdgcn_rcpf(1.f + __expf(l1 - l0));
                if (lane == 0) { toke[row] = i0 | (i1 << 8); tokw[row] = make_float2(w0, 1.f - w0); }
            }
        }
    }
}

__device__ void phase_combine(const bf16_t* GH, bf16_t* mix, int wg, int G, int tid) {
    LAUNDER(tid);
    for (size_t v = (size_t)wg * NTHREADS + tid; v < (size_t)MTOK * (D / 8); v += (size_t)G * NTHREADS) {
        const size_t r = v / (D / 8); const int c = (int)(v % (D / 8)) * 8; const bf16_t* gp = GH + r * GCOLS + c;
        const uint4 a = *(const uint4*)gp, b = *(const uint4*)(gp + 1024), cc = *(const uint4*)(gp + 2048); uint4 o;
        o.x = cvt_pk_bf16(bflo(a.x) + bflo(b.x) + bflo(cc.x), bfhi(a.x) + bfhi(b.x) + bfhi(cc.x));
        o.y = cvt_pk_bf16(bflo(a.y) + bflo(b.y) + bflo(cc.y), bfhi(a.y) + bfhi(b.y) + bfhi(cc.y));
        o.z = cvt_pk_bf16(bflo(a.z) + bflo(b.z) + bflo(cc.z), bfhi(a.z) + bfhi(b.z) + bfhi(cc.z));
        o.w = cvt_pk_bf16(bflo(a.w) + bflo(b.w) + bflo(cc.w), bfhi(a.w) + bfhi(b.w) + bfhi(cc.w));
        *(uint4*)(mix + r * D + c) = o;
    }
}

__device__ __forceinline__ void moe_assign(const int* toke, const float2* tokw, int* meta, int* stok, float* sw, int* blke, LAS unsigned char* lds, int tid, int part) {
    LAS int* cnt = (LAS int*)lds;
    LAS int* tot = cnt + 512 * 16;
    LAS int* segt = tot + 32;
    const int t0 = tid * (MTOK / NTHREADS);
    int4 e4[16];
#pragma unroll
    for (int i = 0; i < 16; ++i) e4[i] = *(const int4*)(toke + t0 + 4 * i);
    { int z = 0; asm volatile("" : "+v"(z));
      for (int j = 0; j < 16; ++j) cnt[tid * 16 + j] = z; }
#pragma unroll
    for (int i = 0; i < 16; ++i) { const int ev[4] = {e4[i].x, e4[i].y, e4[i].z, e4[i].w};
#pragma unroll
        for (int q = 0; q < 4; ++q) { cnt[tid * 16 + (ev[q] & 255)] += 1; cnt[tid * 16 + 8 + ((ev[q] >> 8) & 255)] += 1; } }
    __syncthreads();
    const int cj = tid & 15, cseg = tid >> 4;
    { int s = 0; for (int i = 0; i < 16; ++i) s += cnt[(cseg * 16 + i) * 16 + cj]; segt[cseg * 16 + cj] = s; }
    __syncthreads();
    if (tid < 16) { int run = 0; for (int sg = 0; sg < 32; ++sg) { const int v = segt[sg * 16 + tid]; segt[sg * 16 + tid] = run; run += v; } tot[tid] = run; }
    __syncthreads();
    { int run = segt[cseg * 16 + cj]; for (int i = 0; i < 16; ++i) { const int idx = (cseg * 16 + i) * 16 + cj; const int v = cnt[idx]; cnt[idx] = run; run += v; } }
    if (tid == 0) { int run = 0; for (int j = 0; j < 16; ++j) { const int n = tot[j], pad = (n + 255) & ~255; tot[16 + j] = run; if (j == 8) { meta[0] = run; meta[3] = run; } run += pad; } meta[1] = run - tot[16 + 8]; meta[2] = 0; meta[4] = run; }
    __syncthreads();
    for (int bk = tid; bk < 2 * MOE_MAXBLK; bk += NTHREADS) { int ex = 0;
        for (int j = 0; j < 16; ++j) { const int base = tot[16 + j], pad = (tot[j] + 255) & ~255; if (bk * 256 >= base && bk * 256 < base + pad) ex = j & 7; }
        blke[bk] = ex; }
    const int cls = part & 1, half = part >> 1;
    if ((tid >> 8) == half) {
        for (int j = 0; j < 8; ++j) cnt[tid * 16 + 8 * cls + j] += tot[16 + 8 * cls + j];
#pragma unroll
        for (int i = 0; i < 16; ++i) { const int ev[4] = {e4[i].x, e4[i].y, e4[i].z, e4[i].w}; const float4 wa = *(const float4*)(tokw + t0 + 4 * i), wb = *(const float4*)(tokw + t0 + 4 * i + 2);
            const float wv[4] = {cls ? wa.y : wa.x, cls ? wa.w : wa.z, cls ? wb.y : wb.x, cls ? wb.w : wb.z};
#pragma unroll
            for (int q = 0; q < 4; ++q) { const int j = cls ? 8 + ((ev[q] >> 8) & 255) : (ev[q] & 255); const int pp = cnt[tid * 16 + j]; cnt[tid * 16 + j] = pp + 1; stok[pp] = t0 + 4 * i + q; sw[pp] = wv[q]; } } }
    if (half == 0) for (int j = 8 * cls; j < 8 * cls + 8; ++j) { const int n = tot[j], pad = (n + 255) & ~255, base = tot[16 + j]; for (int i = n + tid; i < pad; i += NTHREADS) { stok[base + i] = -1; sw[base + i] = 0.f; } }
}
__device__ __forceinline__ void moe_gather(const unsigned char* xn8, const int* stok, int rows, unsigned char* xs8, int wg, int G, int wid, int lane) {
    LAUNDER(lane);
    for (int r0 = (wg * NWAVES + wid) * 4; r0 < rows; r0 += G * NWAVES * 4) {
        int tok[4]; uint4 a[4];
#pragma unroll
        for (int i = 0; i < 4; ++i) tok[i] = __hip_atomic_load(stok + r0 + i, __ATOMIC_RELAXED, __HIP_MEMORY_SCOPE_AGENT);
#pragma unroll
        for (int i = 0; i < 4; ++i) { a[i] = make_uint4(0, 0, 0, 0); if (tok[i] >= 0) a[i] = *((const uint4*)(xn8 + (size_t)tok[i] * D) + lane); }
#pragma unroll
        for (int i = 0; i < 4; ++i) *((uint4*)(xs8 + (size_t)(r0 + i) * D) + lane) = a[i]; }
}

typedef pg8::bf16x8 bf16x8;
typedef unsigned u32x2 __attribute__((ext_vector_type(2)));
#define MFMA16(A, B, C) __builtin_amdgcn_mfma_f32_16x16x32_bf16((A), (B), (C), 0, 0, 0)
__device__ __forceinline__ bf16x8 mk8(unsigned a, unsigned b, unsigned c, unsigned d) { u32x4 v = {a, b, c, d}; return __builtin_bit_cast(bf16x8, v); }

constexpr int H_QD = 0, H_KD = 9216, H_KB = 18432, H_QG = 23040, H_KET = 31744, H_VT = 44032, H_PM = 56320, H_TP = 59392, H_GE = 61440;
constexpr size_t HG_DUMP_BYTES = (size_t)MTOK * 512 * 2, HG_U_BYTES = (size_t)256 * 128 * 128 * 2;
__device__ __forceinline__ void phase_hgrn_a(const bf16_t* P, bf16_t* qsc  , uint2* dump, bf16_t* U  , float* Dsc, LAS unsigned char* lds, int wg, int G, int tid, int wid, int lane) {
    LAUNDER(tid); LAUNDER(lane);
    const int d = tid & 127, part = tid >> 7, g = lane >> 4, c16 = lane & 15;
    LAS float* TP = (LAS float*)(lds + H_TP); LAS float* GE = (LAS float*)(lds + H_GE);
    for (int item = wg; item < 256; item += G) {
        const int b = item >> 6, h = (item >> 4) & 3, sc = item & 15; const size_t tok0 = (size_t)b * SEQ + (size_t)sc * 512;
        f32x4 S[8];
#pragma unroll
        for (int i = 0; i < 8; ++i) S[i] = (f32x4){0.f, 0.f, 0.f, 0.f};
        float gsc = 0.f;
        unsigned lfv[8], qv[8], vv[8];
        { const bf16_t* base = P + (tok0 + 8 * part) * PCOLS + h * 128 + d;
#pragma unroll
          for (int j = 0; j < 8; ++j) { lfv[j] = base[(size_t)j * PCOLS + C_HF]; qv[j] = base[(size_t)j * PCOLS + C_HQ]; vv[j] = base[(size_t)j * PCOLS + C_HI]; } }
        for (int c = 0; c < 16; ++c) {
            float gl[8], lf[8], qf[8]; unsigned vb[8]; float run = 0.f;
#pragma unroll
            for (int j = 0; j < 8; ++j) { lf[j] = bf2f(lfv[j]); qf[j] = bf2f(qv[j]); vb[j] = vv[j]; run += lf[j]; gl[j] = run; }
            if (c < 15) { const bf16_t* base = P + (tok0 + (c + 1) * 32 + 8 * part) * PCOLS + h * 128 + d;
#pragma unroll
                for (int j = 0; j < 8; ++j) { lfv[j] = base[(size_t)j * PCOLS + C_HF]; qv[j] = base[(size_t)j * PCOLS + C_HQ]; vv[j] = base[(size_t)j * PCOLS + C_HI]; } }
            TP[part * 128 + d] = run;
            __syncthreads();
            const float t0 = TP[d], t1 = TP[128 + d], t2 = TP[256 + d], t3 = TP[384 + d];
            const float T0 = t0 + t1, gend = T0 + t2 + t3;
            const float pre = (part == 1) ? t0 : (part == 3) ? t2 : 0.f, gb = (part >> 1) ? T0 : 0.f;
            unsigned kep[4];
#pragma unroll
            for (int j = 0; j < 8; j += 2) {
                float ke2[2];
#pragma unroll
                for (int jj = 0; jj < 2; ++jj) { const int t = 8 * part + j + jj; const float Gl = pre + gl[j + jj], Gt = gb + Gl; const float k = 1.f - __expf(lf[j + jj]), q = qf[j + jj];
                    *(LAS bf16_t*)(lds + H_QD + t * 288 + d * 2) = f2bf(q * __expf(Gl));
                    *(LAS bf16_t*)(lds + H_KD + t * 288 + d * 2) = f2bf(k * __expf(fminf(-Gl, 80.f)));
                    if (part < 2) *(LAS bf16_t*)(lds + H_KB + t * 288 + d * 2) = f2bf(k * __expf(T0 - Gl));
                    *(LAS bf16_t*)(lds + H_QG + t * 272 + d * 2) = f2bf(q * __expf(Gt));
                    qsc[(tok0 + c * 32 + t) * 512 + h * 128 + d] = f2bf(q * __expf(gsc + Gt));
                    ke2[jj] = k * __expf(gend - Gt); }
                kep[j >> 1] = cvt_pk_bf16(ke2[0], ke2[1]); }
            *(LAS u32x4*)(lds + H_KET + d * 96 + part * 16) = (u32x4){kep[0], kep[1], kep[2], kep[3]};
            *(LAS u32x4*)(lds + H_VT + d * 96 + part * 16) = (u32x4){vb[0] | (vb[1] << 16), vb[2] | (vb[3] << 16), vb[4] | (vb[5] << 16), vb[6] | (vb[7] << 16)};
            if (part == 0) GE[d] = __expf(gend);
            gsc += gend;
            __syncthreads();
            if (wid < 3) { const int I = (wid == 0) ? 0 : 1, J = (wid == 2) ? 0 : I; f32x4 acc = {0.f, 0.f, 0.f, 0.f};
#pragma unroll
                for (int kk = 0; kk < 4; ++kk) { const bf16x8 A = *(const LAS bf16x8*)(lds + H_QD + (16 * I + c16) * 288 + kk * 64 + g * 16);
                    const bf16x8 B = (wid == 2) ? *(const LAS bf16x8*)(lds + H_KB + c16 * 288 + kk * 64 + g * 16) : *(const LAS bf16x8*)(lds + H_KD + (16 * J + c16) * 288 + kk * 64 + g * 16);
                    acc = MFMA16(A, B, acc); }
#pragma unroll
                for (int r = 0; r < 4; ++r) { const int t = 4 * g + r; const float v = (I == J && c16 > t) ? 0.f : acc[r]; *(LAS bf16_t*)(lds + H_PM + (16 * I + t) * 96 + (16 * J + c16) * 2) = f2bf(v); }
            } else if (wid == 3) {
#pragma unroll
                for (int r = 0; r < 4; ++r) *(LAS bf16_t*)(lds + H_PM + (4 * g + r) * 96 + (16 + c16) * 2) = (bf16_t)0;
            }
            __syncthreads();
            { const bf16x8 Bv = *(const LAS bf16x8*)(lds + H_VT + (16 * wid + c16) * 96 + g * 16);
              unsigned sp[8][2];
#pragma unroll
              for (int i = 0; i < 8; ++i) { sp[i][0] = cvt_pk_bf16(S[i][0], S[i][1]); sp[i][1] = cvt_pk_bf16(S[i][2], S[i][3]); }
              const size_t chunk_g = (tok0 >> 5) + c;
#pragma unroll
              for (int rt = 0; rt < 2; ++rt) { f32x4 o = {0.f, 0.f, 0.f, 0.f};
                  o = MFMA16(*(const LAS bf16x8*)(lds + H_PM + (16 * rt + c16) * 96 + g * 16), Bv, o);
#pragma unroll
                  for (int kk = 0; kk < 4; ++kk) { const LAS unsigned char* qp = lds + H_QG + (16 * rt + c16) * 272 + (32 * kk + 4 * g) * 2;
                      const u32x2 lo = *(const LAS u32x2*)qp, hi = *(const LAS u32x2*)(qp + 32);
                      o = MFMA16(mk8(lo.x, lo.y, hi.x, hi.y), mk8(sp[2 * kk][0], sp[2 * kk][1], sp[2 * kk + 1][0], sp[2 * kk + 1][1]), o); }
                  dump[(((chunk_g * 4 + h) * 2 + rt) * 8 + wid) * 64 + lane] = make_uint2(cvt_pk_bf16(o[0], o[1]), cvt_pk_bf16(o[2], o[3])); }
#pragma unroll
              for (int i = 0; i < 8; ++i) { const f32x4 dec = *(const LAS f32x4*)(lds + H_GE + (16 * i + 4 * g) * 4); S[i] = S[i] * dec;
                  S[i] = MFMA16(*(const LAS bf16x8*)(lds + H_KET + (16 * i + c16) * 96 + g * 16), Bv, S[i]); } }
            __syncthreads();
        }
#pragma unroll
        for (int i = 0; i < 8; ++i)
#pragma unroll
            for (int r = 0; r < 4; ++r) U[((size_t)item * 128 + 16 * i + 4 * g + r) * 128 + 16 * wid + c16] = f2bf(S[i][r]);
        if (part == 0) Dsc[item * 128 + d] = __expf(gsc);
    }
}
constexpr int HC_SIN = 0;
__device__ __forceinline__ void phase_hgrn_c(const bf16_t* P, bf16_t* qoa  , const uint2* dump, const bf16_t* U, const float* Dsc, const float* gain, LAS unsigned char* lds, int wg, int G, int tid, int wid, int lane, unsigned long long* ts = nullptr) {
    LAUNDER(tid); LAUNDER(lane);
    const int g = lane >> 4, c16 = lane & 15;
    if (ts && tid == 0) ts[26] = __builtin_amdgcn_s_memrealtime();
    for (int item = wg; item < 256; item += G) {
        const int b = item >> 6, h = (item >> 4) & 3, sc = item & 15; const size_t tok0 = (size_t)b * SEQ + (size_t)sc * 512;
        bf16x8 An[4]; uint2 oln[8]; unsigned hgn[8][4];
#define HC_LOAD(rtile_) do { const size_t row0_ = tok0 + 64 * wid + 16 * (rtile_); const size_t cg_ = (tok0 >> 5) + 2 * wid + ((rtile_) >> 1); const int rt_ = (rtile_) & 1; \
            _Pragma("unroll") for (int kk = 0; kk < 4; ++kk) An[kk] = *(const bf16x8*)(qoa + (row0_ + c16) * 512 + h * 128 + 32 * kk + 8 * g); \
            _Pragma("unroll") for (int vt = 0; vt < 8; ++vt) oln[vt] = dump[(((cg_ * 4 + h) * 2 + rt_) * 8 + vt) * 64 + lane]; \
            _Pragma("unroll") for (int vt = 0; vt < 8; ++vt) _Pragma("unroll") for (int r = 0; r < 4; ++r) hgn[vt][r] = P[(row0_ + 4 * g + r) * PCOLS + C_HG + h * 128 + 16 * vt + c16]; } while (0)
        float gnv[8];
#pragma unroll
        for (int vt = 0; vt < 8; ++vt) gnv[vt] = gain[16 * vt + c16];
        HC_LOAD(0);
#pragma unroll 1
        for (int kq = 0; kq < 2; ++kq) { float s[16];
#pragma unroll
          for (int k = 0; k < 16; ++k) s[k] = 0.f;
          for (int j0 = 0; j0 < sc; j0 += 8) {
              uint4 uu[8][2]; float dd[8][2];
#pragma unroll
              for (int u = 0; u < 8; ++u) { const bool on = j0 + u < sc; const size_t it = on ? (size_t)(item - sc + j0 + u) : (size_t)item;
#pragma unroll
                  for (int k = 0; k < 2; ++k) { const int e0 = 8 * (tid + 512 * (kq * 2 + k)); uu[u][k] = *(const uint4*)(U + it * 16384 + e0); dd[u][k] = Dsc[it * 128 + (e0 >> 7)]; } }
#pragma unroll
              for (int u = 0; u < 8; ++u) { const bool on = j0 + u < sc;
#pragma unroll
                  for (int k = 0; k < 2; ++k) { const float d1 = on ? dd[u][k] : 1.f; const uint4 x = on ? uu[u][k] : make_uint4(0u, 0u, 0u, 0u);
                      s[8 * k + 0] = d1 * s[8 * k + 0] + bflo(x.x); s[8 * k + 1] = d1 * s[8 * k + 1] + bfhi(x.x); s[8 * k + 2] = d1 * s[8 * k + 2] + bflo(x.y); s[8 * k + 3] = d1 * s[8 * k + 3] + bfhi(x.y);
                      s[8 * k + 4] = d1 * s[8 * k + 4] + bflo(x.z); s[8 * k + 5] = d1 * s[8 * k + 5] + bfhi(x.z); s[8 * k + 6] = d1 * s[8 * k + 6] + bflo(x.w); s[8 * k + 7] = d1 * s[8 * k + 7] + bfhi(x.w); } } }
#pragma unroll
          for (int k = 0; k < 2; ++k) { const int e0 = 8 * (tid + 512 * (kq * 2 + k));
#pragma unroll
              for (int i = 0; i < 8; ++i) { const int e = e0 + i; *(LAS bf16_t*)(lds + HC_SIN + (e & 127) * 288 + (e >> 7) * 2) = f2bf(s[8 * k + i]); } } }
        __syncthreads();
        if (ts && tid == 0) ts[27] = __builtin_amdgcn_s_memrealtime();
#pragma unroll
        for (int rtile = 0; rtile < 4; ++rtile) {
            const size_t row0 = tok0 + 64 * wid + 16 * rtile;
            bf16x8 A[4]; uint2 olc[8]; unsigned hgv[8][4];
#pragma unroll
            for (int kk = 0; kk < 4; ++kk) A[kk] = An[kk];
#pragma unroll
            for (int vt = 0; vt < 8; ++vt) { olc[vt] = oln[vt];
#pragma unroll
                for (int r = 0; r < 4; ++r) hgv[vt][r] = hgn[vt][r]; }
            if (rtile + 1 < 4) HC_LOAD(rtile + 1);
            asm volatile("" ::: "memory");
            f32x4 acc[8]; float ss[4] = {0.f, 0.f, 0.f, 0.f};
#pragma unroll
            for (int vt = 0; vt < 8; ++vt) { acc[vt] = (f32x4){0.f, 0.f, 0.f, 0.f};
#pragma unroll
                for (int kk = 0; kk < 4; ++kk) acc[vt] = MFMA16(A[kk], *(const LAS bf16x8*)(lds + HC_SIN + (16 * vt + c16) * 288 + (32 * kk + 8 * g) * 2), acc[vt]);
                const uint2 ol = olc[vt];
                acc[vt][0] += bflo(ol.x); acc[vt][1] += bfhi(ol.x); acc[vt][2] += bflo(ol.y); acc[vt][3] += bfhi(ol.y);
#pragma unroll
                for (int r = 0; r < 4; ++r) ss[r] += acc[vt][r] * acc[vt][r]; }
            float rstd[4];
#pragma unroll
            for (int r = 0; r < 4; ++r) { float s = ss[r]; s += xor_f<1>(s); s += xor_f<2>(s); s += xor_f<4>(s); s += xor_f<8>(s); rstd[r] = rsqrtf(s * (1.f / 128.f) + EPS); }
#pragma unroll
            for (int vt = 0; vt < 8; ++vt) { const float gn = gnv[vt];
#pragma unroll
                for (int r = 0; r < 4; ++r) { const size_t row = row0 + 4 * g + r;
                    qoa[row * 512 + h * 128 + 16 * vt + c16] = f2bf(acc[vt][r] * rstd[r] * gn * bf2f(hgv[vt][r])); } }
        }
#undef HC_LOAD
        if (ts && tid == 0) { asm volatile("s_waitcnt vmcnt(0)" ::: "memory"); ts[28] = __builtin_amdgcn_s_memrealtime(); }
        __syncthreads();
    }
}

constexpr int GM_VT = 0, GM_W = 36864, GM_RS = 73728;
__device__ __forceinline__ void phase_gmlp(const bf16_t* P, const float* __restrict__ ws_l, const float* __restrict__ bs_l, const float* __restrict__ gv_l, bf16_t* ob, LAS unsigned char* lds, int wg, int G, int tid, int wid, int lane) {
    LAUNDER(tid); LAUNDER(lane);
    const int g = lane >> 4, c16 = lane & 15; LAS float* RS = (LAS float*)(lds + GM_RS);
    for (int item = wg; item < MTOK / 128; item += G) {
        const size_t tok0 = (size_t)item * 128;
        uint4 xq[4]; float4 waq[4], wbq[4];
#define GM_LOAD(grp_) do { _Pragma("unroll") for (int ps = 0; ps < 4; ++ps) { const int idx = tid + ps * 512, s = idx >> 4, c8 = (idx & 15) * 8; xq[ps] = *(const uint4*)(P + (tok0 + s) * PCOLS + C_GV + (grp_) * 128 + c8); \
            waq[ps] = *(const float4*)(ws_l + (size_t)(grp_) * 16384 + s * 128 + c8); wbq[ps] = *(const float4*)(ws_l + (size_t)(grp_) * 16384 + s * 128 + c8 + 4); } } while (0)
        GM_LOAD(0);
        { const int s = tid >> 2, qd = tid & 3; const bf16_t* rp = P + (tok0 + s) * PCOLS + C_GV + qd * 128; float ss = 0.f;
#pragma unroll
          for (int j = 0; j < 16; ++j) { const uint4 x = *(const uint4*)(rp + j * 8); ss += bflo(x.x) * bflo(x.x) + bfhi(x.x) * bfhi(x.x) + bflo(x.y) * bflo(x.y) + bfhi(x.y) * bfhi(x.y) + bflo(x.z) * bflo(x.z) + bfhi(x.z) * bfhi(x.z) + bflo(x.w) * bflo(x.w) + bfhi(x.w) * bfhi(x.w); }
          ss += xor_f<1>(ss); ss += xor_f<2>(ss); if (qd == 0) RS[s] = rsqrtf(ss * (1.f / 512.f) + EPS); }
        for (int grp = 0; grp < 4; ++grp) {
            __syncthreads();
#pragma unroll
            for (int ps = 0; ps < 4; ++ps) { const int idx = tid + ps * 512, s = idx >> 4, c8 = (idx & 15) * 8; const uint4 x = xq[ps];
                const float rs = RS[s]; const float4 ga = *(const float4*)(gv_l + grp * 128 + c8), gb = *(const float4*)(gv_l + grp * 128 + c8 + 4);
                const float e[8] = {bflo(x.x) * rs * ga.x, bfhi(x.x) * rs * ga.y, bflo(x.y) * rs * ga.z, bfhi(x.y) * rs * ga.w, bflo(x.z) * rs * gb.x, bfhi(x.z) * rs * gb.y, bflo(x.w) * rs * gb.z, bfhi(x.w) * rs * gb.w};
#pragma unroll
                for (int i = 0; i < 8; ++i) *(LAS bf16_t*)(lds + GM_VT + (c8 + i) * 288 + s * 2) = f2bf(e[i]);
                const int t = idx >> 4, s8 = (idx & 15) * 8; const float4 wa = waq[ps], wb = wbq[ps];
                *(LAS u32x4*)(lds + GM_W + t * 288 + s8 * 2) = (u32x4){cvt_pk_bf16(s8 + 0 <= t ? wa.x : 0.f, s8 + 1 <= t ? wa.y : 0.f), cvt_pk_bf16(s8 + 2 <= t ? wa.z : 0.f, s8 + 3 <= t ? wa.w : 0.f),
                                                                    cvt_pk_bf16(s8 + 4 <= t ? wb.x : 0.f, s8 + 5 <= t ? wb.y : 0.f), cvt_pk_bf16(s8 + 6 <= t ? wb.z : 0.f, s8 + 7 <= t ? wb.w : 0.f)}; }
            if (grp + 1 < 4) GM_LOAD(grp + 1);
            __syncthreads();
            unsigned guv[4][8];
#pragma unroll
            for (int r = 0; r < 4; ++r)
#pragma unroll
                for (int ct = 0; ct < 8; ++ct) guv[r][ct] = P[(tok0 + 16 * wid + 4 * g + r) * PCOLS + C_GU + grp * 128 + 16 * ct + c16];
            f32x4 acc[8];
#pragma unroll
            for (int ct = 0; ct < 8; ++ct) acc[ct] = (f32x4){0.f, 0.f, 0.f, 0.f};
            for (int kk = 0; kk <= (wid >> 1); ++kk) { const bf16x8 A = *(const LAS bf16x8*)(lds + GM_W + (16 * wid + c16) * 288 + kk * 64 + g * 16);
#pragma unroll
                for (int ct = 0; ct < 8; ++ct) acc[ct] = MFMA16(A, *(const LAS bf16x8*)(lds + GM_VT + (16 * ct + c16) * 288 + kk * 64 + g * 16), acc[ct]); }
#pragma unroll
            for (int r = 0; r < 4; ++r) { const int t = 16 * wid + 4 * g + r; const float bias = bs_l[grp * 128 + t]; const size_t tok = tok0 + t;
#pragma unroll
                for (int ct = 0; ct < 8; ++ct) { const int ch = grp * 128 + 16 * ct + c16; ob[tok * 512 + ch] = f2bf(bf2f(guv[r][ct]) * (acc[ct][r] + bias)); } }
        }
        __syncthreads();
#undef GM_LOAD
    }
}

constexpr int AT_KL = 0, AT_VT = 10240, AT_MIN = 10240 + 64 * 144, AT_BUF = 19968;
template <bool DIAG>
__device__ __forceinline__ void attn_block(LAS unsigned char* lds, const bf16x8 (&Bq)[2], f32x4 (&O)[4], float& carry, int sb0, int t, int g, int c16, unsigned tri_lo, unsigned tri_hi, unsigned ONES, unsigned ZERO) {
    f32x4 z[4]; unsigned hi[4][2];
#pragma unroll
    for (int st = 0; st < 4; ++st) { z[st] = (f32x4){0.f, 0.f, 0.f, 0.f};
#pragma unroll
        for (int kk = 0; kk < 2; ++kk) z[st] = MFMA16(*(const LAS bf16x8*)(lds + AT_KL + (16 * st + c16) * 160 + kk * 64 + g * 16), Bq[kk], z[st]);
        float spv[4];
#pragma unroll
        for (int r = 0; r < 4; ++r) { const float sp = __builtin_amdgcn_logf(1.f + __builtin_amdgcn_exp2f(z[st][r])); spv[r] = (!DIAG || (sb0 + 16 * st + 4 * g + r < t)) ? sp : 0.f; }
        hi[st][0] = cvt_pk_bf16(spv[0], spv[1]); hi[st][1] = cvt_pk_bf16(spv[2], spv[3]); }
    f32x4 sf[4];
#pragma unroll
    for (int so = 0; so < 4; ++so) { sf[so] = (f32x4){0.f, 0.f, 0.f, 0.f};
#pragma unroll
        for (int kk = 0; kk < 2; ++kk) { if (2 * kk + 1 < so) continue;
            const unsigned a0 = (2 * kk > so) ? ONES : (2 * kk == so) ? tri_lo : ZERO, a1 = (2 * kk > so) ? ONES : (2 * kk == so) ? tri_hi : ZERO;
            const unsigned a2 = (2 * kk + 1 > so) ? ONES : tri_lo, a3 = (2 * kk + 1 > so) ? ONES : tri_hi;
            sf[so] = MFMA16(mk8(a0, a1, a2, a3), mk8(hi[2 * kk][0], hi[2 * kk][1], hi[2 * kk + 1][0], hi[2 * kk + 1][1]), sf[so]); } }
    unsigned pa[4][2];
#pragma unroll
    for (int st = 0; st < 4; ++st) { float av[4];
#pragma unroll
        for (int r = 0; r < 4; ++r) { const float a = __builtin_amdgcn_exp2f(z[st][r] - carry - sf[st][r]); av[r] = (!DIAG || (sb0 + 16 * st + 4 * g + r < t)) ? a : 0.f; }
        pa[st][0] = cvt_pk_bf16(av[0], av[1]); pa[st][1] = cvt_pk_bf16(av[2], av[3]); }
#pragma unroll
    for (int kk = 0; kk < 2; ++kk) { const bf16x8 Aop = mk8(pa[2 * kk][0], pa[2 * kk][1], pa[2 * kk + 1][0], pa[2 * kk + 1][1]);
#pragma unroll
        for (int dt = 0; dt < 4; ++dt) { const int ky = 32 * kk + (((4 * g) ^ ((c16 >> 3) << 2)) ^ ((8 * dt) & 28));
            const LAS unsigned char* vr = lds + AT_VT + (16 * dt + c16) * 144; const u32x2 v0 = *(const LAS u32x2*)(vr + ky * 2), v1 = *(const LAS u32x2*)(vr + (ky ^ 16) * 2);
            O[dt] = MFMA16(Aop, mk8(v0.x, v0.y, v1.x, v1.y), O[dt]); } }
    carry += bperm_f(sf[0][0], c16);
}
__device__ __forceinline__ void phase_attn(const bf16_t* P, const float* __restrict__ gq, const float* __restrict__ gk, bf16_t* oc, LAS unsigned char* lds, int wg, int G, int tid, int wid, int lane) {
    LAUNDER(tid); LAUNDER(lane);
    const int g = lane >> 4, c16 = lane & 15; int itg = 0;
    unsigned ONES = 0x3F803F80u, ZERO = 0u; LAUNDER(ONES); LAUNDER(ZERO);
    const unsigned tri_lo = ((4 * g + 0 >= c16) ? 0x3F80u : 0u) | ((4 * g + 1 >= c16) ? 0x3F800000u : 0u), tri_hi = ((4 * g + 2 >= c16) ? 0x3F80u : 0u) | ((4 * g + 3 >= c16) ? 0x3F800000u : 0u);
    for (int item = wg; item < NB * 8 * (SEQ / 128); item += G) {
        const int qt = item & 63, h = (item >> 6) & 7, b = item >> 9; const int t0 = qt * 128, tq0 = t0 + 16 * wid, t = tq0 + c16; const size_t tokb = (size_t)b * SEQ;
        bf16x8 Bq[2];
        { const bf16_t* qp = P + (tokb + t) * PCOLS + C_SQ + h * 64; const uint4 x0 = *(const uint4*)(qp + 8 * g), x1 = *(const uint4*)(qp + 32 + 8 * g);
          float e[16] = {bflo(x0.x), bfhi(x0.x), bflo(x0.y), bfhi(x0.y), bflo(x0.z), bfhi(x0.z), bflo(x0.w), bfhi(x0.w), bflo(x1.x), bfhi(x1.x), bflo(x1.y), bfhi(x1.y), bflo(x1.z), bfhi(x1.z), bflo(x1.w), bfhi(x1.w)};
          float ss = 0.f;
#pragma unroll
          for (int i = 0; i < 16; ++i) ss += e[i] * e[i];
          ss += xor_f<16>(ss); ss += bperm_f(ss, lane ^ 32);
          const float rq = rsqrtf(ss * (1.f / 64.f) + EPS) * (0.125f * 1.4426950408889634f);
#pragma unroll
          for (int i = 0; i < 16; ++i) { const int dd = (i < 8 ? 8 * g + i : 32 + 8 * g + (i - 8)); e[i] = e[i] * rq * gq[dd] * gk[dd]; }
          Bq[0] = mk8(cvt_pk_bf16(e[0], e[1]), cvt_pk_bf16(e[2], e[3]), cvt_pk_bf16(e[4], e[5]), cvt_pk_bf16(e[6], e[7]));
          Bq[1] = mk8(cvt_pk_bf16(e[8], e[9]), cvt_pk_bf16(e[10], e[11]), cvt_pk_bf16(e[12], e[13]), cvt_pk_bf16(e[14], e[15])); }
        f32x4 O[4];
#pragma unroll
        for (int i = 0; i < 4; ++i) O[i] = (f32x4){0.f, 0.f, 0.f, 0.f};
        float carry = 0.f, wmin = 0.f;
        const int ks = tid >> 3, kpc = tid & 7;
        const bf16_t* rp0 = P + (tokb + ks) * PCOLS + h * 64 + kpc * 8;
        uint4 kx = *(const uint4*)(rp0 + (size_t)(((t0 + 127) >> 6) * 64) * PCOLS + C_SK), vx = *(const uint4*)(rp0 + (size_t)(((t0 + 127) >> 6) * 64) * PCOLS + C_SV);
        for (int kb = (t0 + 127) >> 6; kb >= 0; --kb) {
            const int sb0 = kb * 64;
            LAS unsigned char* lb = lds + (itg & 1) * AT_BUF; LAS float* MW = (LAS float*)(lb + AT_MIN);
            { const int s = ks, pc = kpc;
              float ke[8] = {bflo(kx.x), bfhi(kx.x), bflo(kx.y), bfhi(kx.y), bflo(kx.z), bfhi(kx.z), bflo(kx.w), bfhi(kx.w)}; float ssk = 0.f;
#pragma unroll
              for (int i = 0; i < 8; ++i) ssk += ke[i] * ke[i];
              ssk += xor_f<1>(ssk); ssk += xor_f<2>(ssk); ssk += xor_f<4>(ssk);
              const float rk = rsqrtf(ssk * (1.f / 64.f) + EPS);
              *(LAS u32x4*)(lb + AT_KL + s * 160 + pc * 16) = (u32x4){cvt_pk_bf16(ke[0] * rk, ke[1] * rk), cvt_pk_bf16(ke[2] * rk, ke[3] * rk), cvt_pk_bf16(ke[4] * rk, ke[5] * rk), cvt_pk_bf16(ke[6] * rk, ke[7] * rk)};
              const unsigned vw[4] = {vx.x, vx.y, vx.z, vx.w};
#pragma unroll
              for (int i = 0; i < 8; ++i) *(LAS bf16_t*)(lb + AT_VT + (pc * 8 + i) * 144 + (s ^ (pc << 2)) * 2) = (bf16_t)((vw[i >> 1] >> ((i & 1) * 16)) & 0xffffu);
              if (kb > 0) { kx = *(const uint4*)(rp0 + (size_t)(sb0 - 64) * PCOLS + C_SK); vx = *(const uint4*)(rp0 + (size_t)(sb0 - 64) * PCOLS + C_SV); } }
            { float mn = carry; mn = fminf(mn, xor_f<1>(mn)); mn = fminf(mn, xor_f<2>(mn)); mn = fminf(mn, xor_f<4>(mn)); mn = fminf(mn, xor_f<8>(mn));
              wmin = __builtin_bit_cast(float, __builtin_amdgcn_readfirstlane(__builtin_bit_cast(int, mn)));
              if (lane == 0) MW[wid] = mn; }
            __syncthreads();
            ++itg;
            float mall = MW[0];
#pragma unroll
            for (int w = 1; w < 8; ++w) mall = fminf(mall, MW[w]);
            if (mall > 150.04f) break;
            if (sb0 < tq0 + 15 && wmin <= 150.04f) {
                if (sb0 + 63 < tq0) attn_block<false>(lb, Bq, O, carry, sb0, t, g, c16, tri_lo, tri_hi, ONES, ZERO);
                else attn_block<true>(lb, Bq, O, carry, sb0, t, g, c16, tri_lo, tri_hi, ONES, ZERO);
            }
        }
#pragma unroll
        for (int dt = 0; dt < 4; ++dt)
#pragma unroll
            for (int r = 0; r < 4; ++r) oc[(tokb + tq0 + 4 * g + r) * 512 + h * 64 + 16 * dt + c16] = f2bf(O[dt][r]);
    }
}

#ifdef MK_CHECK
constexpr size_t WS_DIAG = WS_META + 2048;
constexpr size_t WS_SNAP = WS_BLKE + 4096;
static_assert(WS_SNAP + 64 * 1024 * 4 <= WS_W, "snapshot fits");
__device__ __forceinline__ int samp_row(int i) { return (int)(((unsigned)i * 2654435761u + 12345u) % (unsigned)MTOK); }
__device__ __forceinline__ void chk_fail(unsigned* diag, unsigned code) { atomicMin(diag, code); }
__device__ __forceinline__ bool chk_close(float got, float ref, float atol, float rtol) { return fabsf(got - ref) <= atol + rtol * fabsf(ref) && got == got; }

__global__ void k_diag_init(unsigned* diag) { if (threadIdx.x == 0 && blockIdx.x == 0) { diag[0] = 0xffffffffu; diag[16] = 0u; diag[17] = 0xffffffffu; diag[18] = 0u; diag[19] = 0u; diag[20] = 0u; diag[21] = 0u; diag[22] = 0u; diag[23] = 0u; diag[24] = 0u; diag[25] = 0u; diag[26] = 0u; } }
__global__ void k_snapshot(const float* x, float* snap) { const int i = blockIdx.x; const int r = samp_row(i); for (int c = threadIdx.x; c < D; c += blockDim.x) snap[i * D + c] = x[(size_t)r * D + c]; }
__global__ void k_apply_diag(float* out, const unsigned* diag) {
    if (blockIdx.x != 0 || threadIdx.x != 0) return;
    const unsigned code = diag[0]; if (code == 0xffffffffu) return;
    out[0] = (1.0f + 0.1f * (float)(code > 89u ? 89u : code)) * 1.0e6f;
}
struct ChkGemm { const bf16_t* A; int lda; const float* W; int ldw; int K; int mode; const bf16_t* Cb; int ldc; const float* Cf; const float* xold; const float* W2; const float* lb; const bf16_t* Gsrc; int ncols; unsigned code; int use_snap; };
__global__ void k_chk_gemm(ChkGemm c, unsigned* diag) {
    const int i = blockIdx.x; const int r = samp_row(i);
    for (int cc = threadIdx.x; cc < 96; cc += blockDim.x) {
        const int col = (int)(((unsigned)cc * 40503u + (unsigned)i * 977u) % (unsigned)c.ncols);
        float dot = 0.f, dot2 = 0.f;
        for (int k = 0; k < c.K; ++k) { const float av = bf2f(c.A[(size_t)r * c.lda + k]); dot += av * c.W[(size_t)k * c.ldw + col]; if (c.mode == 4) dot2 += av * c.W2[(size_t)k * c.ldw + col]; }
        float ref, got;
        if (c.mode == 0) { const int kind = col >> 9; ref = (kind == 0 || kind == 3) ? siluf_(dot) : kind == 1 ? __logf(c.lb[col - 512] + (1.f - c.lb[col - 512]) * sigmoidf_(dot)) : (kind == 4 || kind == 5) ? gelu_tanh_(dot) : dot; got = bf2f(c.Cb[(size_t)r * c.ldc + col]); }
        else if (c.mode == 1) { ref = sigmoidf_(dot); got = bf2f(c.Cb[(size_t)r * c.ldc + col]); }
        else if (c.mode == 3) { const float xo = c.use_snap ? c.xold[(size_t)i * D + col] : c.xold[(size_t)r * D + col]; ref = xo + dot; got = c.Cf[(size_t)r * D + col]; }
        else { ref = siluf_(dot) * dot2; got = bf2f(c.Cb[(size_t)r * c.ldc + col]); }
        if (!chk_close(got, ref, 0.03f, 0.03f)) { chk_fail(diag, c.code); if (c.mode == 1) { atomicOr(diag + 24 + (i >> 5), 1u << (i & 31)); atomicOr(diag + 26, 1u << ((r & 255) >> 4)); atomicOr(diag + 20 + ((col & 127) >> 5), 1u << (col & 31)); atomicAdd(diag + 16, 1u); atomicMin(diag + 17, (unsigned)(col >> 8)); atomicMax(diag + 18, (unsigned)(col >> 8)); if (fabsf(got - dot) <= 0.03f + 0.03f * fabsf(dot)) atomicAdd(diag + 19, 1u); } }
    }
}
__global__ void k_chk_branch(const bf16_t* ocat, const float* wbr  , const bf16_t* xn, const float* win  , const bf16_t* GH, unsigned code, unsigned* diag) {
    const int i = blockIdx.x; const int r = samp_row(i);
    for (int cc = threadIdx.x; cc < 96; cc += blockDim.x) {
        const int col = (int)(((unsigned)cc * 40503u + (unsigned)i * 977u) % 3072u); const int b = col >> 10, cl = col & 1023;
        float h = 0.f; for (int k = 0; k < 512; ++k) h += bf2f(ocat[(size_t)b * MTOK * 512 + (size_t)r * 512 + k]) * wbr[((size_t)b * 512 + k) * 1024 + cl];
        float g = 0.f; for (int k = 0; k < 1024; ++k) g += bf2f(xn[(size_t)r * D + k]) * win[(size_t)k * INCOLS + PCOLS + col];
        const float ref = sigmoidf_(g) * h, got = bf2f(GH[(size_t)r * GCOLS + col]);
        if (!chk_close(got, ref, 0.03f, 0.04f)) chk_fail(diag, code);
    }
}
__global__ void k_chk_mix(const bf16_t* ocat, const float* wbr  , const bf16_t* Gt, const bf16_t* mix, unsigned code, unsigned* diag) {
    const int i = blockIdx.x; const int r = samp_row(i);
    for (int cc = threadIdx.x; cc < 96; cc += blockDim.x) {
        const int col = (int)(((unsigned)cc * 40503u + (unsigned)i * 977u) % 1024u); float ref = 0.f;
        for (int b = 0; b < 3; ++b) { float h = 0.f; for (int k = 0; k < 512; ++k) h += bf2f(ocat[(size_t)b * MTOK * 512 + (size_t)r * 512 + k]) * wbr[((size_t)b * 512 + k) * 1024 + col]; ref += bf2f(Gt[(size_t)r * GCOLS + b * 1024 + col]) * h; }
        if (!chk_close(bf2f(mix[(size_t)r * D + col]), ref, 0.03f, 0.04f)) chk_fail(diag, code);
    }
}
__global__ void k_chk_attn(const bf16_t* P, const float* gq, const float* gk, const bf16_t* oc, unsigned code, unsigned* diag) {
    const int id = blockIdx.x, lane = threadIdx.x; const int ti = id % 10;
    const int t = ti == 0 ? 0 : ti == 1 ? 1 : ti == 2 ? 2 : ti == 3 ? 63 : ti == 4 ? 64 : ti == 5 ? 65 : ti == 6 ? 200 : ti == 7 ? 1000 : ti == 8 ? 4097 : 8191;
    const int h = (id / 10) % 8, b = id / 80; const size_t tokb = (size_t)b * SEQ;
    float q = bf2f(P[(tokb + t) * PCOLS + C_SQ + h * 64 + lane]); q = q * rsqrtf(wave_sum(q * q) / 64.f + EPS) * gq[lane];
    float o = 0.f, carry = 0.f;
    for (int s = t - 1; s >= 0 && carry < 300.f; --s) {
        float kv = bf2f(P[(tokb + s) * PCOLS + C_SK + h * 64 + lane]); kv = kv * rsqrtf(wave_sum(kv * kv) / 64.f + EPS) * gk[lane];
        const float z = wave_sum(q * kv) * 0.125f; const float sp = logf(1.f + expf(z));
        carry += sp; const float A = expf(z - carry);
        o += A * bf2f(P[(tokb + s) * PCOLS + C_SV + h * 64 + lane]);
    }
    if (!chk_close(bf2f(oc[(tokb + t) * 512 + h * 64 + lane]), o, 0.02f, 0.03f)) chk_fail(diag, code);
}
__global__ void k_chk_gmlp(const bf16_t* P, const float* ws_l, const float* bs_l, const float* gv_l, const bf16_t* ob, unsigned code, unsigned* diag) {
    const int id = blockIdx.x * blockDim.x + threadIdx.x; if (id >= 512) return;
    const int chunk = (id * 37) % (MTOK / 128), t = (id * 53 + 7) % 128, ch = (id * 101 + 3) % 512, g = ch >> 7, c = ch & 127; const size_t tok0 = (size_t)chunk * 128;
    float acc = 0.f;
    for (int s = 0; s <= t; ++s) { float ss = 0.f; for (int k = 0; k < 512; ++k) { const float v = bf2f(P[(tok0 + s) * PCOLS + C_GV + k]); ss += v * v; }
        const float vn = bf2f(P[(tok0 + s) * PCOLS + C_GV + ch]) * rsqrtf(ss / 512.f + EPS) * gv_l[ch]; acc += ws_l[(size_t)g * 16384 + t * 128 + s] * vn; }
    const float ref = bf2f(P[(tok0 + t) * PCOLS + C_GU + ch]) * (acc + bs_l[g * 128 + t]);
    if (!chk_close(bf2f(ob[(tok0 + t) * 512 + ch]), ref, 0.02f, 0.03f)) chk_fail(diag, code);
}
__global__ void k_chk_hgrn(const bf16_t* P, const float* gain, const bf16_t* oa, unsigned code, unsigned* diag) {
    const int id = blockIdx.x; const int ti = id % 8; const int t = ti == 0 ? 0 : ti == 1 ? 1 : ti == 2 ? 5 : ti == 3 ? 63 : ti == 4 ? 64 : ti == 5 ? 200 : ti == 6 ? 511 : 700, h = (id / 8) % 4, b = id / 32; const int v = threadIdx.x; const size_t tokb = (size_t)b * SEQ;
    float o = 0.f;
    for (int d = 0; d < 128; ++d) { float st = 0.f;
        for (int s = 0; s <= t; ++s) { const bf16_t* row = P + (tokb + s) * PCOLS; const float f = expf(bf2f(row[C_HF + h * 128 + d])); st = f * st + (1.f - f) * bf2f(row[C_HI + h * 128 + v]); }
        o += bf2f(P[(tokb + t) * PCOLS + C_HQ + h * 128 + d]) * st; }
    __shared__ float red[128]; red[v] = o * o; __syncthreads();
    for (int w = 64; w > 0; w >>= 1) { if (v < w) red[v] += red[v + w]; __syncthreads(); }
    const float rstd = rsqrtf(red[0] / 128.f + EPS);
    const float ref = o * rstd * gain[v] * bf2f(P[(tokb + t) * PCOLS + C_HG + h * 128 + v]);
    if (!chk_close(bf2f(oa[(tokb + t) * 512 + h * 128 + v]), ref, 0.03f, 0.04f)) chk_fail(diag, code);
}
__global__ void k_chk_moe(const bf16_t* xn, const float* rw, const float* rb, const float* wg, const float* wu, const float* wd, const float* snap, const float* xout, unsigned code, unsigned* diag) {
    const int i = blockIdx.x; const int r = samp_row(i); const int tid = threadIdx.x;
    __shared__ float hid[DFF]; __shared__ float lg[8]; __shared__ float part[256];
    if (tid < 8) { float a = rb[tid]; for (int k = 0; k < D; ++k) a += bf2f(xn[(size_t)r * D + k]) * rw[k * 8 + tid]; lg[tid] = a; }
    __syncthreads();
    int i0 = 0; for (int e = 1; e < 8; ++e) if (lg[e] > lg[i0]) i0 = e;
    int i1 = -1; for (int e = 0; e < 8; ++e) if (e != i0 && (i1 < 0 || lg[e] > lg[i1])) i1 = e;
    const float w0 = 1.f / (1.f + expf(lg[i1] - lg[i0])), w1 = 1.f - w0;
    float outv[8]; for (int j = 0; j < 8; ++j) outv[j] = 0.f;
    for (int kk = 0; kk < 2; ++kk) { const int e = kk ? i1 : i0; const float wgt = kk ? w1 : w0;
        for (int f = tid; f < DFF; f += blockDim.x) { float g = 0.f, u = 0.f; for (int k = 0; k < D; ++k) { const float xv = bf2f(xn[(size_t)r * D + k]); g += xv * wg[((size_t)e * D + k) * DFF + f]; u += xv * wu[((size_t)e * D + k) * DFF + f]; } hid[f] = siluf_(g) * u; }
        __syncthreads();
        for (int j = 0; j < 8; ++j) { const int col = (j * 131 + i * 17) % D; float p = 0.f; for (int f = tid; f < DFF; f += blockDim.x) p += hid[f] * wd[((size_t)e * DFF + f) * D + col];
            part[tid] = p; __syncthreads(); for (int w = 128; w > 0; w >>= 1) { if (tid < w) part[tid] += part[tid + w]; __syncthreads(); } outv[j] += wgt * part[0]; __syncthreads(); }
    }
    if (tid == 0) for (int j = 0; j < 8; ++j) { const int col = (j * 131 + i * 17) % D; const float ref = snap[(size_t)i * D + col] + outv[j]; if (!chk_close(xout[(size_t)r * D + col], ref, 0.04f, 0.04f)) chk_fail(diag, code); }
}
#endif

struct Args { const float* in[21]; float* out; unsigned char* ws; int lo, hi; };
constexpr int NSTEPS = 25;
__device__ __forceinline__ int laneid_() { int v; asm volatile("v_mbcnt_lo_u32_b32 %0, -1, 0\n\tv_mbcnt_hi_u32_b32 %0, -1, %0" : "=v"(v)); return v; }
#define LANEID (laneid_())

__device__ __forceinline__ int cw_(LAS unsigned* cblk, int i) { unsigned z; asm volatile("v_mov_b32 %0, 0" : "=v"(z)); return (int)__builtin_amdgcn_readfirstlane(((LAS unsigned*)((LAS unsigned char*)cblk + z))[i]); }
#ifndef MK_ALIGN
#define MK_ALIGN true
#endif
#ifndef MK_SP2_F8
#define MK_SP2_F8 true
#endif
#ifndef MK_SP2
#define MK_SP2 true
#endif
#ifndef STAG_IN
#define STAG_IN 0
#define STAG_G 0
#define STAG_GU 0
#define STAG_MGU 0
#endif
#ifndef L1_F8
#define L1_F8 false
#endif
#ifndef FFN_F8
#define FFN_F8 false
#endif
template <class Epi, bool VARNT = false, int NSEG = 1, bool FP8 = false>
__device__ __forceinline__ void run_gemm(LAS unsigned char* lds, const Order& S, int K, const Epi& E, int wid, int stagger = 0) {
    if (stagger && ((S.c >> 3) & 1)) { for (int i = 0; i < stagger; ++i) __builtin_amdgcn_s_sleep(127); }
    pg8::gemm_phase<Epi, Order, MK_ALIGN, (FP8 ? MK_SP2_F8 : MK_SP2), VARNT, NSEG, FP8>(lds, K, S, E, wid); }

__global__ void __launch_bounds__(NTHREADS, 2) mk_fwd(Args a) {
    extern __shared__ __attribute__((aligned(16))) unsigned char lds_raw[];
    LAS unsigned char* lds = (LAS unsigned char*)lds_raw;
    const int wid = __builtin_amdgcn_readfirstlane((int)threadIdx.x >> 6);
    LAS unsigned* cblk = (LAS unsigned*)(lds + LDS_MISC);
    { const int tid = threadIdx.x;
      if (tid < 4) cblk[tid] = (tid == 2) ? xb_xcc_id() : 0u;
      if (tid < 46) { const unsigned long long pv = (tid < 42) ? (unsigned long long)a.in[tid >> 1] : (tid < 44) ? (unsigned long long)a.out : (unsigned long long)a.ws; cblk[4 + tid] = (tid & 1) ? (unsigned)(pv >> 32) : (unsigned)pv; }
      if (tid == 46) cblk[50] = (unsigned)a.lo; if (tid == 47) cblk[51] = (unsigned)a.hi; }
    __syncthreads();
#define CW(i) cw_(cblk, (i))
typedef __attribute__((address_space(1))) unsigned char gu8_t;
#define ARGP(i) ((unsigned char*)(gu8_t*)(((unsigned long long)(unsigned)CW(5 + 2 * (i)) << 32) | (unsigned long long)(unsigned)CW(4 + 2 * (i))))
#define IN(i) ((const float*)ARGP(i))
#define OUTP ((float*)ARGP(21))
#define WSP (ARGP(22))
#define GSZ ((int)gridDim.x)
#define WGI ((int)blockIdx.x)
    if (CW(51) - CW(50) > 1 && threadIdx.x == 0) (void)xb_add((unsigned*)(WSP + WS_CTL + CW_BAR) + XB_XCNT(CW(2)), 1u);
#ifndef PROBE_REP
#define PROBE_REP 0ull
#endif
#define RUN(k) (CW(50) <= (k) && (k) < CW(51))
#define NREP(bit) (((PROBE_REP >> (bit)) & 1ull) ? 2 : 1)
#ifndef STAMP_MODE
#define STAMP_MODE 0
#endif
#ifndef STAMP_WG
#define STAMP_WG 0
#endif
#ifdef MK_STAMP
#define STAMP(i) do { if (blockIdx.x == STAMP_WG && threadIdx.x == 0) ((unsigned long long*)(WSP + WS_CTL + 32768))[i] = __builtin_amdgcn_s_memrealtime(); } while (0)
#else
#define STAMP(i) do { } while (0)
#endif
#define SEAM(k) do { if (CW(50) <= (k) && (k) + 1 < CW(51)) { XcdBarrier bar_; bar_.bar = (unsigned*)(WSP + WS_CTL + CW_BAR); bar_.x = (unsigned)CW(2); bar_.st = (volatile LAS unsigned*)cblk; xcd_barrier(bar_); if (PROBE_REP & (1ull << 40)) xcd_barrier(bar_); STAMP((k) + 1); } } while (0)

#define R16 ((bf16_t*)OUTP)
#define R16B ((bf16_t*)(WSP + WS_MHID + (size_t)MOE_MAXBLK * 256 * DFF))
#define WIN ((bf16_t*)(WSP + WS_WIN))
#define WBR ((bf16_t*)(WSP + WS_WBR))
#define WOUT ((bf16_t*)(WSP + WS_WOUT))
#define WGU ((bf16_t*)(WSP + WS_WGU))
#define WDN ((bf16_t*)(WSP + WS_WD))
#define XNB ((bf16_t*)(WSP + WS_XN))
#define PBUF ((bf16_t*)(WSP + WS_P))
#define GBUF ((bf16_t*)(WSP + WS_G))
#define HIDB ((bf16_t*)(WSP + WS_HID))
#define OCATB ((bf16_t*)(WSP + WS_OCAT))
#define MWGU ((bf16_t*)(WSP + WS_MWGU))
#define MWDN ((bf16_t*)(WSP + WS_MWD))
#define XSB ((bf16_t*)(WSP + WS_XS))
#define MHIDB ((bf16_t*)(WSP + WS_MHID))
#define LBB ((float*)(WSP + WS_LB))
#define METAB ((int*)(WSP + WS_META))
#define TOKE ((int*)(WSP + WS_TOKE))
#define TOKW ((float2*)(WSP + WS_TOKW))
#define STOK ((int*)(WSP + WS_SLOTTOK))
#define SWB ((float*)(WSP + WS_SLOTW))
#define BLKE ((int*)(WSP + WS_BLKE))
#define SLABB ((bf16_t*)(WSP + WS_SLAB))
#define HDUMP ((uint2*)(WSP + WS_ORAW))
#define HU ((bf16_t*)(WSP + WS_ORAW + HG_DUMP_BYTES))
#define HDSC ((float*)(WSP + WS_ORAW + HG_DUMP_BYTES + HG_U_BYTES))
#define TIDV (wid * 64 + LANEID)
    STAMP(0);
    for (int rep_ = 0; rep_ < NREP(0); ++rep_) if (RUN(0)) {
        LAS float* tile = (LAS float*)lds; const int tid = TIDV;
#pragma unroll 1
        for (int j = 0; j < 13; ++j) {
            const float* src; bf16_t* dst; int K, N, mode = 0, perm = 1, f8 = 0;
            if (j < 10) { const int l = j / 5, r = j % 5;
                if (r == 0) { src = IN(2) + (size_t)l * D * INCOLS; dst = WIN + (size_t)l * INCOLS * D; K = D; N = INCOLS;  f8 = (L1_F8 && l == 1) ? 1 : 0; }
                else if (r < 4) { src = IN(10) + (size_t)(l * 3 + r - 1) * 512 * D; dst = WBR + (size_t)(l * 3 + r - 1) * D * 512; K = 512; N = D; }
                else { src = IN(11) + (size_t)l * D * D; dst = WOUT + (size_t)l * D * D; K = D; N = D; } }
            else if (j == 10) { src = IN(13); dst = WGU; K = D; N = DFF; mode = 1; }
            else if (j == 11) { src = IN(14); dst = WGU; K = D; N = DFF; mode = 2; }
            else { src = IN(15); dst = WDN; K = DFF; N = D; }
            tc_job(src, K, N, dst, mode, perm, tile, WGI, GSZ, tid, (FFN_F8 && j >= 10) ? 1 : f8);
        }
        if (WGI == 0) { const float a0 = IN(3)[tid], a1 = IN(3)[512 + tid]; LBB[tid] = 0.f; LBB[512 + tid] = sigmoidf_(a1 - a0); }
    }
    if (RUN(0)) { __syncthreads(); phase_rmsnorm<false, false, false>(IN(0), IN(1), XNB, nullptr, nullptr, nullptr, nullptr, WGI, GSZ, wid, LANEID); }
    SEAM(0);

    for (int l = 0; l < 2; ++l) {
        const int sb = l * 10;
        if (l == 1) { for (int rep_ = 0; rep_ < NREP(1); ++rep_) if (RUN(10)) phase_rmsnorm<false, L1_F8>(R16, IN(1) + D, XNB, nullptr, nullptr, nullptr, nullptr, WGI, GSZ, wid, LANEID); SEAM(10); }
        for (int rep_ = 0; rep_ < NREP(2); ++rep_) if (RUN(sb + 1)) { EpiAct E{PBUF, PCOLS, LBB + l * 512, 1};
            if (!L1_F8 || l == 0) { Order S; S.init(XNB, WIN + (size_t)l * INCOLS * D, MTOK, PCOLS, D, GSZ, WGI); run_gemm(lds, S, D, E, wid, STAG_IN); }
            else { Order S; S.init(XNB, WIN + (size_t)l * INCOLS * D, MTOK, PCOLS, D, GSZ, WGI, 0, 0, 0, nullptr, 0, 1); run_gemm<EpiAct, false, 1, true>(lds, S, D, E, wid); } }
        SEAM(sb + 1);
        for (int rep_ = 0; rep_ < NREP(3); ++rep_) if (RUN(sb + 2)) {
            if (l == 0 && STAMP_MODE == 0) STAMP(26);
            for (int r2 = 0; r2 < NREP(13); ++r2) { phase_hgrn_a(PBUF, OCATB, HDUMP, HU, HDSC, lds, WGI, GSZ, TIDV, wid, LANEID);
            __syncthreads(); }
            if (l == 0 && STAMP_MODE == 0) STAMP(27);
            for (int r2 = 0; r2 < NREP(14); ++r2) { phase_attn(PBUF, IN(8) + l * 64, IN(9) + l * 64, OCATB + (size_t)2 * MTOK * 512, lds, WGI, GSZ, TIDV, wid, LANEID);
            __syncthreads(); }
            if (l == 0 && STAMP_MODE == 0) STAMP(28);
            for (int r2 = 0; r2 < NREP(15); ++r2) { phase_gmlp(PBUF, IN(6) + (size_t)l * 4 * 16384, IN(7) + l * 512, IN(5) + l * 512, OCATB + (size_t)MTOK * 512, lds, WGI, GSZ, TIDV, wid, LANEID); __syncthreads(); }
        }
        if (l == 0 && STAMP_MODE == 0) STAMP(29);
        SEAM(sb + 2);
        if (RUN(sb + 3)) phase_hgrn_c(PBUF, OCATB, HDUMP, HU, HDSC, IN(4) + l * 128, lds, WGI, GSZ, TIDV, wid, LANEID, (STAMP_MODE == 1 && l == 0 && WGI == STAMP_WG) ? (unsigned long long*)(WSP + WS_CTL + 32768) : nullptr);
        SEAM(sb + 3);
        for (int rep_ = 0; rep_ < NREP(4); ++rep_) if (RUN(sb + 4)) { EpiAct E{GBUF, GCOLS, nullptr, 0};
            if (!L1_F8 || l == 0) { Order S; S.init(XNB, WIN + (size_t)l * INCOLS * D + (size_t)PCOLS * D, MTOK, GCOLS, D, GSZ, WGI); run_gemm(lds, S, D, E, wid, STAG_G); }
            else { Order S; S.init(XNB, (const unsigned char*)(WIN + (size_t)l * INCOLS * D) + (size_t)PCOLS * D, MTOK, GCOLS, D, GSZ, WGI, 0, 0, 0, nullptr, 0, 1); run_gemm<EpiAct, false, 1, true>(lds, S, D, E, wid); } }
        SEAM(sb + 4);
        for (int rep_ = 0; rep_ < NREP(12); ++rep_) if (RUN(sb + 5)) { Order S; S.init(OCATB, WBR + (size_t)l * 3 * D * 512, MTOK, GCOLS, 512, GSZ, WGI, 4, (size_t)MTOK * 512 * 2, (size_t)D * 512 * 2); EpiBranchSeg E{GBUF, XNB}; run_gemm<EpiBranchSeg, false, 3>(lds, S, 512, E, wid); }
        SEAM(sb + 5);
        if (RUN(sb + 6)) { Order S; S.init(XNB, WOUT + (size_t)l * D * D, MTOK, D, D, GSZ, WGI);
            if (l == 0) { EpiResidT<true> E{IN(0), R16}; run_gemm(lds, S, D, E, wid); } else { EpiResidT<false> E{R16, R16}; run_gemm(lds, S, D, E, wid); } }
        SEAM(sb + 6);
        if (l == 0) {
            for (int rep_ = 0; rep_ < NREP(6); ++rep_) if (RUN(7)) phase_rmsnorm<false, FFN_F8>(R16, IN(12), XNB, nullptr, nullptr, nullptr, nullptr, WGI, GSZ, wid, LANEID);
            SEAM(7);
            for (int rep_ = 0; rep_ < NREP(7); ++rep_) if (RUN(8)) { Order S; S.init(XNB, WGU, MTOK, 2 * DFF, D, GSZ, WGI, 0, 0, 0, nullptr, 0, FFN_F8 ? 1 : 2); EpiGUT<FFN_F8> E{HIDB}; run_gemm<EpiGUT<FFN_F8>, false, 1, FFN_F8>(lds, S, D, E, wid, STAG_GU); }
            SEAM(8);
            if (RUN(9)) { Order S; S.init(HIDB, WDN, MTOK, D, DFF, GSZ, WGI, 0, 0, 0, nullptr, 0, FFN_F8 ? 1 : 2); EpiResidT<false> E{R16, R16}; run_gemm<EpiResidT<false>, false, 1, FFN_F8>(lds, S, DFF, E, wid); }
            SEAM(9);
        } else {
            for (int rep_ = 0; rep_ < NREP(8); ++rep_) if (RUN(17)) phase_rmsnorm<true>(R16, IN(12) + D, XNB, IN(16), IN(17), TOKE, TOKW, WGI, GSZ, wid, LANEID);
            SEAM(17);
            for (int rep_ = 0; rep_ < NREP(9); ++rep_) if (RUN(18)) {
                if (WGI >= GSZ - 4) moe_assign(TOKE, TOKW, METAB, STOK, SWB, BLKE, lds, TIDV, WGI - (GSZ - 4));
                else { LAS float* tile = (LAS float*)lds; const int tid = TIDV;
#pragma unroll 1
                    for (int j = 0; j < 3 * NEXP; ++j) { const int e = j / 3, r = j % 3;
                        const float* src = (r == 0 ? IN(18) : r == 1 ? IN(19) : IN(20)) + (size_t)e * D * DFF;
                        bf16_t* dst = (bf16_t*)((r == 2) ? (unsigned char*)MWDN + (size_t)e * D * DFF : (unsigned char*)MWGU + (size_t)e * 2 * DFF * D);
                        tc_job_w(src, r == 2 ? DFF : D, r == 2 ? D : DFF, dst, r == 2 ? 0 : r + 1, 1, tile, WGI, GSZ - 4, wid, LANEID, 1); } }
            }
            SEAM(18);
#define META(i) __hip_atomic_load(METAB + (i), __ATOMIC_RELAXED, __HIP_MEMORY_SCOPE_AGENT)
#define MOE_BMAP(rows_, s0_) do { LAS int* bl_ = (LAS int*)(lds + 131072); const int nb_ = (rows_) >> 8; for (int i_ = TIDV; i_ < nb_; i_ += NTHREADS) bl_[i_] = __hip_atomic_load(BLKE + ((s0_) >> 8) + i_, __ATOMIC_RELAXED, __HIP_MEMORY_SCOPE_AGENT); __syncthreads(); } while (0)
            if (RUN(19)) { const int rows = META(0), s0 = META(2); moe_gather((const unsigned char*)XNB, STOK + s0, rows, (unsigned char*)XSB, WGI, GSZ, wid, LANEID); }
            SEAM(19);
            for (int kc = 0; kc < 2; ++kc) {
                const int se = 20 + 2 * kc;
                for (int rep_ = 0; rep_ < NREP(11); ++rep_) if (RUN(se)) { const int rows = META(kc), s0 = META(2 + kc);
                    if (kc == 1) { const int rows0 = META(0), s00 = META(2); Order T; T.init(MHIDB, MWDN, rows0, D, DFF, GSZ, WGI, 2, 0, (size_t)D * DFF, BLKE + (s00 >> 8), 1, 1);
                        moe_tail_reduce(T, SLABB, R16, R16B, 0, STOK + s00, SWB + s00, WGI, GSZ, wid, LANEID); }
                    MOE_BMAP(rows, s0); Order S; S.init(XSB, MWGU, rows, 2 * DFF, D, GSZ, WGI, 2, 0, (size_t)2 * DFF * D, BLKE + (s0 >> 8), 0, 1); S.bmapl = (const LAS int*)(lds + 131072); EpiGUT<true> E{MHIDB}; run_gemm<EpiGUT<true>, false, 1, true>(lds, S, D, E, wid, STAG_MGU); }
                SEAM(se);
                if (RUN(se + 1)) { const int rows = META(kc), s0 = META(2 + kc);
                    MOE_BMAP(rows, s0); Order S; S.init(MHIDB, MWDN, rows, D, DFF, GSZ, WGI, 2, 0, (size_t)D * DFF, BLKE + (s0 >> 8), 1, 1); S.bmapl = (const LAS int*)(lds + 131072); EpiMoeDown E{kc == 0 ? R16 : R16B, kc == 0 ? (void*)R16B : (void*)OUTP, kc, STOK + s0, SWB + s0, SLABB}; run_gemm<EpiMoeDown, true, 1, true>(lds, S, DFF, E, wid);
                    if (kc == 0) { const int rows1 = META(1), s1 = META(3); moe_gather((const unsigned char*)XNB, STOK + s1, rows1, (unsigned char*)XSB, WGI, GSZ, wid, LANEID); } }
                SEAM(se + 1);
            }
            if (RUN(24)) { const int rows1 = META(1), s1 = META(3); Order T; T.init(MHIDB, MWDN, rows1, D, DFF, GSZ, WGI, 2, 0, (size_t)D * DFF, BLKE + (s1 >> 8), 1, 1);
                moe_tail_reduce(T, SLABB, R16B, OUTP, 1, STOK + s1, SWB + s1, WGI, GSZ, wid, LANEID); }
        }
    }
#ifdef MK_STAMP
    { XcdBarrier bar_; bar_.bar = (unsigned*)(WSP + WS_CTL + CW_BAR); bar_.x = (unsigned)CW(2); bar_.st = (volatile LAS unsigned*)cblk; xcd_barrier(bar_); }
    if (blockIdx.x == STAMP_WG && threadIdx.x == 0) { unsigned long long* T = (unsigned long long*)(WSP + WS_CTL + 32768); const unsigned long long tend = __builtin_amdgcn_s_memrealtime(); T[30] = tend; T[25] = tend;
        unsigned long long va = 0, vb = 0;
        for (int s = 0; s < 30; ++s) { const unsigned long long d = T[s + 1] - T[s]; if ((STAMP_SETA >> s) & 1) va += d; if ((STAMP_SETB >> s) & 1) vb += d; }
        unsigned long long qa = (va + 250) / 500, qb = (vb + 250) / 500; qa = qa > 63 ? 63 : qa; qb = qb > 63 ? 63 : qb;
        const unsigned long long wait = (qa + 64 * qb) * 10000ull;
        while (__builtin_amdgcn_s_memrealtime() - tend < wait) __builtin_amdgcn_s_sleep(100); }
#endif
}

extern "C" void kernel_launch(void* const* d_in, const int* in_sizes, int n_in, void* d_out, int out_size, void* d_ws, size_t ws_size, hipStream_t stream) {
    static int grid = 0;
    if (grid == 0) {
        if (n_in != 21 || out_size != MTOK * D || ws_size < WS_NEED) { fprintf(stderr, "kernel_launch: unexpected shapes (n_in %d out %d ws %zu need %zu)\n", n_in, out_size, ws_size, (size_t)WS_NEED); grid = -1; return; }
        int dev = 0, cus = 0, per_cu = 0;
        if (hipGetDevice(&dev) != hipSuccess || hipDeviceGetAttribute(&cus, hipDeviceAttributeMultiprocessorCount, dev) != hipSuccess) { grid = -1; return; }
        if (hipFuncSetAttribute((const void*)mk_fwd, hipFuncAttributeMaxDynamicSharedMemorySize, LDS_BYTES) != hipSuccess) { fprintf(stderr, "kernel_launch: hipFuncSetAttribute failed\n"); grid = -1; return; }
        if (hipOccupancyMaxActiveBlocksPerMultiprocessor(&per_cu, (const void*)mk_fwd, NTHREADS, LDS_BYTES) != hipSuccess || per_cu < 1) { fprintf(stderr, "kernel_launch: occupancy query says %d\n", per_cu); (void)hipGetLastError(); per_cu = 1; }
        grid = cus;
    }
    if (grid < 0) return;
    (void)hipMemsetAsync((char*)d_ws + WS_CTL, 0, CTL_BYTES, stream);
    Args a{};
    for (int i = 0; i < 21; ++i) a.in[i] = (const float*)d_in[i];
    a.out = (float*)d_out; a.ws = (unsigned char*)d_ws;
#if defined(MK_CHECK)
    {
        unsigned char* ws = (unsigned char*)d_ws; unsigned* diag = (unsigned*)(ws + WS_DIAG); float* snap = (float*)(ws + WS_SNAP);
        const bf16_t* XN = (const bf16_t*)(ws + WS_XN); const bf16_t* Pb = (const bf16_t*)(ws + WS_P); const bf16_t* OC = (const bf16_t*)(ws + WS_OCAT); const float* LB = (const float*)(ws + WS_LB);
        auto run = [&](int s) { a.lo = s; a.hi = s + 1; hipLaunchKernelGGL(mk_fwd, dim3(grid), dim3(NTHREADS), LDS_BYTES, stream, a); };
        hipLaunchKernelGGL(k_diag_init, dim3(1), dim3(64), 0, stream, diag);
        int s = 0; run(s++);
        for (int l = 0; l < 2; ++l) {
            const unsigned cb = l * 10;
            const float* win = a.in[2] + (size_t)l * D * INCOLS;
            if (l == 1) run(s++);
            run(s++);
            { ChkGemm c{}; c.A = XN; c.lda = D; c.W = win; c.ldw = INCOLS; c.K = D; c.mode = 0; c.Cb = Pb; c.ldc = PCOLS; c.lb = LB + l * 512; c.ncols = PCOLS; c.code = cb + 1; hipLaunchKernelGGL(k_chk_gemm, dim3(64), dim3(96), 0, stream, c, diag); }
            run(s++); run(s++);
            hipLaunchKernelGGL(k_chk_hgrn, dim3(128), dim3(128), 0, stream, Pb, a.in[4] + l * 128, OC, cb + 2, diag);
            hipLaunchKernelGGL(k_chk_gmlp, dim3(8), dim3(64), 0, stream, Pb, a.in[6] + (size_t)l * 4 * 16384, a.in[7] + l * 512, a.in[5] + l * 512, OC + (size_t)MTOK * 512, cb + 3, diag);
            hipLaunchKernelGGL(k_chk_attn, dim3(320), dim3(64), 0, stream, Pb, a.in[8] + l * 64, a.in[9] + l * 64, OC + (size_t)2 * MTOK * 512, cb + 4, diag);
            run(s++);
            { ChkGemm c{}; c.A = XN; c.lda = D; c.W = win + PCOLS; c.ldw = INCOLS; c.K = D; c.mode = 1; c.Cb = (const bf16_t*)(ws + WS_G); c.ldc = GCOLS; c.ncols = GCOLS; c.code = cb + 5; hipLaunchKernelGGL(k_chk_gemm, dim3(64), dim3(96), 0, stream, c, diag); }
            run(s++);
            hipLaunchKernelGGL(k_chk_mix, dim3(64), dim3(96), 0, stream, OC, a.in[10] + (size_t)l * 3 * 512 * D, (const bf16_t*)(ws + WS_G), XN, cb + 6, diag);
            if (l == 1) hipLaunchKernelGGL(k_snapshot, dim3(64), dim3(256), 0, stream, (const float*)d_out, snap);
            run(s++);
            { ChkGemm c{}; c.A = XN; c.lda = D; c.W = a.in[11] + (size_t)l * D * D; c.ldw = D; c.K = D; c.mode = 3; c.Cf = (const float*)d_out; c.xold = l ? snap : a.in[0]; c.use_snap = l; c.ncols = D; c.code = cb + 7; hipLaunchKernelGGL(k_chk_gemm, dim3(64), dim3(96), 0, stream, c, diag); }
            run(s++);
            if (l == 0) {
                run(s++);
                { ChkGemm c{}; c.A = XN; c.lda = D; c.W = a.in[13]; c.W2 = a.in[14]; c.ldw = DFF; c.K = D; c.mode = 4; c.Cb = (const bf16_t*)(ws + WS_HID); c.ldc = DFF; c.ncols = DFF; c.code = cb + 8; hipLaunchKernelGGL(k_chk_gemm, dim3(64), dim3(96), 0, stream, c, diag); }
                hipLaunchKernelGGL(k_snapshot, dim3(64), dim3(256), 0, stream, (const float*)d_out, snap);
                run(s++);
                { ChkGemm c{}; c.A = (const bf16_t*)(ws + WS_HID); c.lda = DFF; c.W = a.in[15]; c.ldw = D; c.K = DFF; c.mode = 3; c.Cf = (const float*)d_out; c.xold = snap; c.use_snap = 1; c.ncols = D; c.code = cb + 9; hipLaunchKernelGGL(k_chk_gemm, dim3(64), dim3(96), 0, stream, c, diag); }
            } else {
                hipLaunchKernelGGL(k_snapshot, dim3(64), dim3(256), 0, stream, (const float*)d_out, snap);
                for (int e = 0; e < 7; ++e) run(s++);
                hipLaunchKernelGGL(k_chk_moe, dim3(16), dim3(256), 0, stream, XN, a.in[16], a.in[17], a.in[18], a.in[19], a.in[20], (const float*)snap, (const float*)d_out, 20u, diag);
            }
        }
        if (s != NSTEPS) fprintf(stderr, "step count mismatch %d\n", s);
        hipLaunchKernelGGL(k_apply_diag, dim3(1024), dim3(256), 0, stream, (float*)d_out, (const unsigned*)diag);
    }
#elif !defined(MK_ONE_LAUNCH)
    for (int s = 0; s < NSTEPS; ++s) { a.lo = s; a.hi = s + 1; hipLaunchKernelGGL(mk_fwd, dim3(grid), dim3(NTHREADS), LDS_BYTES, stream, a); }
#else
    a.lo = 0; a.hi = NSTEPS; hipLaunchKernelGGL(mk_fwd, dim3(grid), dim3(NTHREADS), LDS_BYTES, stream, a);
#endif
}
```

```cpp
#define MK_ONE_LAUNCH 1
#include <hip/hip_runtime.h>
#include <cstdio>
#include <cstdint>
#include <cstddef>

#define LAS __attribute__((address_space(3)))
#define XB_TMO      128
#define XB_XCNT(j)  (256  + 64 * (j))
#define XB_XSUB(j)  (1280 + 64 * (j))
#define XB_XGEN(j)  (2304 + 64 * (j))
#define XB_TOP      3328
#define XB_TOPGEN   3392
#define XCD_BAR_WORDS 3456
#define XB_SPIN_CAP (1u << 18)

__device__ __forceinline__ unsigned xb_ld(unsigned* p)              { return __hip_atomic_load(p, __ATOMIC_RELAXED, __HIP_MEMORY_SCOPE_AGENT); }
__device__ __forceinline__ unsigned xb_add(unsigned* p, unsigned v) { return __hip_atomic_fetch_add(p, v, __ATOMIC_RELAXED, __HIP_MEMORY_SCOPE_AGENT); }
__device__ __forceinline__ unsigned xb_xcc_id() { return (unsigned)__builtin_amdgcn_s_getreg((3 << 11) | 20) & 0xFu; }
#define XB_SPIN(cond, bar) do { unsigned _sp = 0; while (cond) { __builtin_amdgcn_s_sleep(1); \
    if ((++_sp & 255u) == 0u) { if (xb_ld(&(bar)[XB_TMO])) break; if (_sp > XB_SPIN_CAP) { atomicAdd(&(bar)[XB_TMO], 1u); break; } } } } while (0)

struct XcdBarrier {
    unsigned* bar; unsigned x;
    volatile LAS unsigned* st;
};

__device__ __forceinline__ XcdBarrier xcd_barrier_post(unsigned* bar, volatile LAS unsigned* st) {
    XcdBarrier b; b.bar = bar; b.x = xb_xcc_id(); b.st = st;
    if (threadIdx.x == 0) (void)xb_add(&bar[XB_XCNT(b.x)], 1u);
    return b;
}
__device__ __forceinline__ void xcd_barrier_complete(unsigned* bar, unsigned x, unsigned& nloc, unsigned& nx) {
    const unsigned G = gridDim.x * gridDim.y * gridDim.z;
    unsigned sum, cnt, mine, sp = 0u;
    for (;;) {
        sum = 0u; cnt = 0u; mine = 0u;
#pragma unroll
        for (unsigned j = 0; j < 16; ++j) { const unsigned c = xb_ld(&bar[XB_XCNT(j)]); sum += c; cnt += (c > 0u) ? 1u : 0u; mine = (j == x) ? c : mine; }
        if (sum == G) break;
        __builtin_amdgcn_s_sleep(1);
        if ((++sp & 255u) == 0u) { if (xb_ld(&bar[XB_TMO])) break; if (sp > XB_SPIN_CAP) { atomicAdd(&bar[XB_TMO], 1u); break; } }
    }
    nloc = mine > 0u ? mine : 1u; nx = cnt > 0u ? cnt : 1u;
}

__device__ __forceinline__ void xcd_barrier(const XcdBarrier& b) {
    asm volatile("s_waitcnt vmcnt(0)" ::: "memory");
    __syncthreads();
    if (threadIdx.x == 0) {
        unsigned* bar = b.bar;
        __builtin_amdgcn_s_waitcnt(0);
        unsigned nloc = b.st[0], nx = b.st[1];
        if (nloc == 0u) { xcd_barrier_complete(bar, b.x, nloc, nx); b.st[0] = nloc; b.st[1] = nx; }
        const unsigned old = xb_add(&bar[XB_XSUB(b.x)], 1u);
        const unsigned gen = old / nloc;
        if (old + 1u == (gen + 1u) * nloc) {
            __builtin_amdgcn_fence(__ATOMIC_RELEASE, "agent");
            asm volatile("s_waitcnt vmcnt(0)" ::: "memory");
            const unsigned og = xb_add(&bar[XB_TOP], 1u);
            const unsigned tg = og / nx;
            if (og + 1u == (tg + 1u) * nx) xb_add(&bar[XB_TOPGEN], 1u);
            else XB_SPIN(xb_ld(&bar[XB_TOPGEN]) == tg, bar);
            __builtin_amdgcn_fence(__ATOMIC_ACQUIRE, "agent");
            xb_add(&bar[XB_XGEN(b.x)], 1u);
            asm volatile("s_waitcnt vmcnt(0)" ::: "memory");
        } else {
            XB_SPIN(xb_ld(&bar[XB_XGEN(b.x)]) == gen, bar);
            __builtin_amdgcn_fence(__ATOMIC_ACQUIRE, "agent");
            asm volatile("s_waitcnt vmcnt(0)" ::: "memory");
        }
    }
    __syncthreads();
}
#ifndef KLOOP_REP
#define KLOOP_REP 1
#endif
#ifndef EPI_REP
#define EPI_REP 1
#endif
namespace pg8 {
#define PG8_LAS __attribute__((address_space(3)))
typedef unsigned short bf16_t;
typedef short bf16x8 __attribute__((ext_vector_type(8)));
typedef float f32x4 __attribute__((ext_vector_type(4)));
typedef unsigned u32x4 __attribute__((ext_vector_type(4)));
constexpr int BM = 256, BK = 64, HALF = 128, HTB = HALF * BK * 2  , STAGE_BYTES = 8 * HTB, NXCD = 8, WGM = 8;

__host__ __device__ __forceinline__ int lds_byte(int r, int c) { const int st = (r >> 4) * 2 + (c >> 5), rr = r & 15, cc = c & 31, ob = rr * 64 + cc * 2; return st * 1024 + (ob ^ (((ob >> 9) & 1) << 5)); }
__host__ __device__ __forceinline__ void stage_rc(int b, int& R, int& C) { const int st = b / 1024, sb = b % 1024, swz = sb ^ (((sb >> 9) & 1) << 5); R = (st >> 1) * 16 + swz / 64; C = (st & 1) * 32 + (swz % 64) / 2; }
__host__ __device__ __forceinline__ int perm32(int rho) { const int n = rho >> 4, i = rho & 15; return 8 * (i >> 2) + 4 * n + (i & 3); }

struct Unit { int pm, pn; const char* a; const char* b; int nt, atomic; };

typedef float f32x2 __attribute__((ext_vector_type(2))); typedef __bf16 bf16x2_t __attribute__((ext_vector_type(2)));
__device__ __forceinline__ unsigned cvt_pk_bf16(float lo, float hi) { f32x2 v = {lo, hi}; bf16x2_t b = __builtin_convertvector(v, bf16x2_t); return __builtin_bit_cast(unsigned, b); }
template <class Epi, class Sched, bool ALIGN_EPI = false, bool SP2 = false, bool VARNT = false, int NSEG = 1, bool FP8 = false>
__device__ __forceinline__ void gemm_phase(PG8_LAS unsigned char* lds, const int K, const Sched& S, const Epi& E, const int wid) {
    int lane; asm volatile("v_mbcnt_lo_u32_b32 %0, -1, 0\n\tv_mbcnt_hi_u32_b32 %0, -1, %0" : "=v"(lane));
    const int tid = wid * 64 + lane, wr = wid >> 2, wc = wid & 3, fr = lane & 15, fq = lane >> 4;
    unsigned voffA[2];
#pragma unroll
    for (int i = 0; i < 2; ++i) { int R, C; stage_rc(tid * 16 + i * 8192, R, C); voffA[i] = FP8 ? (unsigned)(R * K + 2 * C) : (unsigned)(R * K + C) * 2u; }
    const size_t kstep = (size_t)(BK * 2);
    const size_t hstep = (size_t)HALF * K * (FP8 ? 1 : 2);
    const unsigned ldsw = (unsigned)wid * 1024u;
    const int aoff = FP8 ? lds_byte(wr * 64 + fr, fq * 16) : lds_byte(wr * 64 + fr, fq * 8), boff = FP8 ? lds_byte(wc * 32 + fr, fq * 16) : lds_byte(wc * 32 + fr, fq * 8);
    constexpr int KOFF = FP8 ? 16 : 1024;
    const int asw = FP8 ? (fq & 1) * 16 : 0;
    const int aoff1 = FP8 ? (aoff + (asw ^ 16)) : (aoff + KOFF), boff1 = FP8 ? (boff + (asw ^ 16)) : (boff + KOFF);
    const int aoff0 = aoff + asw, boff0 = boff + asw;
#define PG8_SA(b, h) (((b) * 2 + (h)) * HTB)
#define PG8_SB(b, h) ((4 + (b) * 2 + (h)) * HTB)
#define PG8_STAGE(bufoff, gbase, voff) do { _Pragma("unroll") for (int _i = 0; _i < 2; ++_i) { unsigned _vo = (voff)[_i]; asm volatile("" : "+v"(_vo));     \
        __builtin_amdgcn_global_load_lds((const unsigned*)((const char*)(gbase) + _vo), (PG8_LAS unsigned*)(lds + (bufoff) + ldsw + _i * 8192), 16, 0, 0); } } while (0)
#define PG8_LDA(dst, b, h) do { _Pragma("unroll") for (int m = 0; m < 4; ++m) _Pragma("unroll") for (int k = 0; k < 2; ++k) dst[m][k] = *(const PG8_LAS bf16x8*)(lds + PG8_SA(b, h) + (k ? aoff1 : aoff0) + m * 2048); } while (0)
#define PG8_LDB(dst, b, h) do { _Pragma("unroll") for (int n = 0; n < 2; ++n) _Pragma("unroll") for (int k = 0; k < 2; ++k) dst[n][k] = *(const PG8_LAS bf16x8*)(lds + PG8_SB(b, h) + (k ? boff1 : boff0) + n * 2048); } while (0)
#define PG8_MMA(ai, bj, At, Bt) do { __builtin_amdgcn_s_setprio(1); _Pragma("unroll") for (int m = 0; m < 4; ++m) _Pragma("unroll") for (int n = 0; n < 2; ++n) { \
        if constexpr (FP8) { typedef int v8i_ __attribute__((ext_vector_type(8))); struct P2_ { bf16x8 lo, hi; }; \
            const v8i_ b8_ = __builtin_bit_cast(v8i_, (P2_){Bt[n][0], Bt[n][1]}), a8_ = __builtin_bit_cast(v8i_, (P2_){At[m][0], At[m][1]}); \
            acc[ai][bj][m][n] = __builtin_amdgcn_mfma_scale_f32_16x16x128_f8f6f4(b8_, a8_, acc[ai][bj][m][n], 0, 0, 0, 0x79797979, 0, 0x7F7F7F7F); } \
        else { _Pragma("unroll") for (int k = 0; k < 2; ++k) acc[ai][bj][m][n] = __builtin_amdgcn_mfma_f32_16x16x32_bf16(Bt[n][k], At[m][k], acc[ai][bj][m][n], 0, 0, 0); } } \
        __builtin_amdgcn_s_setprio(0); } while (0)
#define PG8_WAIT_V(n) asm volatile("s_waitcnt vmcnt(" #n ")" ::: "memory")
#define PG8_WAIT_L(n) asm volatile("s_waitcnt lgkmcnt(" #n ")" ::: "memory")
#define PG8_BAR __builtin_amdgcn_s_barrier()
#define PG8_SCHED __builtin_amdgcn_sched_barrier(0)
    Unit cur, nxt; int ui = 0;
    if (!S.next(0, cur)) return;
    f32x4 acc[2][2][4][2];
#pragma unroll
    for (int a = 0; a < 2; ++a)
#pragma unroll
        for (int b = 0; b < 2; ++b)
#pragma unroll
            for (int m = 0; m < 4; ++m)
#pragma unroll
                for (int n = 0; n < 2; ++n) acc[a][b][m][n] = (f32x4){0.f, 0.f, 0.f, 0.f};
    bf16x8 At[4][2], B0[2][2], B1[2][2];
    const char* cA = cur.a; const char* cB = cur.b;
    S.a_ready(cur);
    if constexpr (SP2) {
        PG8_STAGE(PG8_SB(0, 0), cB, voffA); PG8_STAGE(PG8_SB(0, 1), cB + hstep, voffA); PG8_STAGE(PG8_SA(0, 0), cA, voffA); PG8_STAGE(PG8_SA(0, 1), cA + hstep, voffA);
        if (wr == 1) PG8_BAR;
        PG8_WAIT_V(2); PG8_BAR;
        PG8_STAGE(PG8_SB(1, 0), cB + kstep, voffA); PG8_STAGE(PG8_SA(1, 0), cA + kstep, voffA); PG8_STAGE(PG8_SB(1, 1), cB + hstep + kstep, voffA);
        PG8_WAIT_V(6); PG8_BAR;
    } else {
        PG8_STAGE(PG8_SB(0, 0), cB, voffA); PG8_STAGE(PG8_SA(0, 0), cA, voffA); PG8_STAGE(PG8_SB(0, 1), cB + hstep, voffA); PG8_STAGE(PG8_SA(0, 1), cA + hstep, voffA);
        if (wr == 1) PG8_BAR;
        PG8_WAIT_V(4); PG8_BAR;
        PG8_STAGE(PG8_SB(1, 0), cB + kstep, voffA); PG8_STAGE(PG8_SA(1, 0), cA + kstep, voffA); PG8_STAGE(PG8_SB(1, 1), cB + hstep + kstep, voffA);
        PG8_WAIT_V(6); PG8_BAR;
    }
    for (;;) {
        const bool has_next = S.next(ui + 1, nxt);
        const char* nA = has_next ? nxt.a : cA; const char* nB = has_next ? nxt.b : cB;
        const int nt = VARNT ? cur.nt : NSEG * (K / (FP8 ? 128 : BK)); constexpr bool SEGD = (NSEG > 1); const int KT = K / BK;
#if KLOOP_REP > 1
        int krep_ = KLOOP_REP; asm volatile("" : "+s"(krep_));
        const char* nA0_ = nA; const char* nB0_ = nB;
_Pragma("unroll 1")
        for (int kr_ = 0; kr_ < krep_; ++kr_) {
        if (kr_ > 0) {
_Pragma("unroll")
            for (int a = 0; a < 2; ++a)
_Pragma("unroll")
                for (int b = 0; b < 2; ++b)
_Pragma("unroll")
                    for (int m = 0; m < 4; ++m)
_Pragma("unroll")
                        for (int n = 0; n < 2; ++n) acc[a][b][m][n] = (f32x4){0.f, 0.f, 0.f, 0.f}; }
        nA = (kr_ == krep_ - 1) ? nA0_ : cA; nB = (kr_ == krep_ - 1) ? nB0_ : cB;
#endif
#pragma unroll 1
        for (int t = 0; t < nt; t += 2) {
            const bool last = (t == nt - 2);
            const char* a1 = SEGD ? cA + (size_t)((t + 1) / KT) * S.abr + (size_t)((t + 1) % KT) * kstep : cA + (size_t)(t + 1) * kstep;
            const char* a2 = last ? nA : (SEGD ? cA + (size_t)((t + 2) / KT) * S.abr + (size_t)((t + 2) % KT) * kstep : cA + (size_t)(t + 2) * kstep);
            const char* b2 = last ? nB : (SEGD ? cB + (size_t)((t + 2) / KT) * S.bbr + (size_t)((t + 2) % KT) * kstep : cB + (size_t)(t + 2) * kstep);
            const char* a3 = a2 + kstep; const char* b3 = b2 + kstep;
            if (last && has_next) S.a_ready(nxt);
            if constexpr (SP2) {
            PG8_LDB(B0, 0, 0); PG8_LDB(B1, 0, 1); PG8_SCHED; PG8_LDA(At, 0, 0); PG8_STAGE(PG8_SA(1, 1), a1 + hstep, voffA);
            PG8_WAIT_V(8); PG8_WAIT_L(0); PG8_BAR; PG8_MMA(0, 0, At, B0); PG8_MMA(0, 1, At, B1); PG8_BAR; PG8_SCHED;
            PG8_LDA(At, 0, 1); PG8_STAGE(PG8_SB(0, 0), b2, voffA); PG8_STAGE(PG8_SB(0, 1), b2 + hstep, voffA); PG8_STAGE(PG8_SA(0, 0), a2, voffA);
            PG8_WAIT_V(8); PG8_WAIT_L(0); PG8_BAR; PG8_MMA(1, 0, At, B0); PG8_MMA(1, 1, At, B1); PG8_BAR; PG8_SCHED;
            PG8_LDB(B0, 1, 0); PG8_LDB(B1, 1, 1); PG8_SCHED; PG8_LDA(At, 1, 0); PG8_STAGE(PG8_SA(0, 1), a2 + hstep, voffA);
            PG8_WAIT_V(8); PG8_WAIT_L(0); PG8_BAR; PG8_MMA(0, 0, At, B0); PG8_MMA(0, 1, At, B1); PG8_BAR; PG8_SCHED;
            PG8_LDA(At, 1, 1); PG8_STAGE(PG8_SB(1, 0), b3, voffA); PG8_STAGE(PG8_SB(1, 1), b3 + hstep, voffA); PG8_STAGE(PG8_SA(1, 0), a3, voffA);
            PG8_WAIT_V(8); PG8_WAIT_L(0); PG8_BAR; PG8_MMA(1, 0, At, B0); PG8_MMA(1, 1, At, B1); PG8_BAR; PG8_SCHED;
            } else {
            PG8_LDB(B0, 0, 0); PG8_SCHED; PG8_LDA(At, 0, 0); PG8_STAGE(PG8_SA(1, 1), a1 + hstep, voffA);
            PG8_WAIT_L(8); PG8_BAR; PG8_WAIT_L(0); PG8_MMA(0, 0, At, B0); PG8_BAR; PG8_SCHED;
            PG8_LDB(B1, 0, 1); PG8_STAGE(PG8_SB(0, 0), b2, voffA);
            PG8_BAR; PG8_WAIT_L(0); PG8_MMA(0, 1, At, B1); PG8_BAR;
            PG8_LDA(At, 0, 1); PG8_STAGE(PG8_SA(0, 0), a2, voffA);
            PG8_BAR; PG8_WAIT_L(0); PG8_MMA(1, 0, At, B0); PG8_BAR; PG8_SCHED;
            PG8_STAGE(PG8_SB(0, 1), b2 + hstep, voffA);
            PG8_WAIT_V(6); PG8_BAR; PG8_MMA(1, 1, At, B1); PG8_BAR;
            PG8_LDB(B0, 1, 0); PG8_SCHED; PG8_LDA(At, 1, 0); PG8_STAGE(PG8_SA(0, 1), a2 + hstep, voffA);
            PG8_WAIT_L(8); PG8_BAR; PG8_WAIT_L(0); PG8_MMA(0, 0, At, B0); PG8_BAR; PG8_SCHED;
            PG8_LDB(B1, 1, 1); PG8_STAGE(PG8_SB(1, 0), b3, voffA);
            PG8_BAR; PG8_WAIT_L(0); PG8_MMA(0, 1, At, B1); PG8_BAR;
            PG8_LDA(At, 1, 1); PG8_STAGE(PG8_SA(1, 0), a3, voffA);
            PG8_BAR; PG8_WAIT_L(0); PG8_MMA(1, 0, At, B0); PG8_BAR; PG8_SCHED;
            PG8_STAGE(PG8_SB(1, 1), b3 + hstep, voffA);
            PG8_WAIT_V(6); PG8_BAR; PG8_MMA(1, 1, At, B1); PG8_BAR;
            }
            if constexpr (SEGD) { if (((t + 2) % KT) == 0 && t + 2 < nt) E.mid(acc, cur, (t + 2) / KT - 1, wr, wc, fr, fq);
            }
        }
#if KLOOP_REP > 1
        }
#endif
        if constexpr (ALIGN_EPI) { if (wr == 0) PG8_BAR; }
        if constexpr (!Epi::AFTER_DRAIN) { int l2_; asm volatile("v_mbcnt_lo_u32_b32 %0, -1, 0\n\tv_mbcnt_hi_u32_b32 %0, -1, %0" : "=v"(l2_));
            if constexpr (EPI_REP > 1 && Epi::IDEM) { int nrep_ = EPI_REP; asm volatile("" : "+s"(nrep_));
_Pragma("unroll 1")
                for (int er_ = 0; er_ < nrep_; ++er_) { asm volatile("v_mbcnt_lo_u32_b32 %0, -1, 0\n\tv_mbcnt_hi_u32_b32 %0, -1, %0" : "=v"(l2_)); E(acc, cur, wr, wc, l2_ & 15, l2_ >> 4); } }
            else E(acc, cur, wr, wc, l2_ & 15, l2_ >> 4);
            S.done(cur); }
        if (!has_next) break;
#pragma unroll
        for (int a = 0; a < 2; ++a)
#pragma unroll
            for (int b = 0; b < 2; ++b)
#pragma unroll
                for (int m = 0; m < 4; ++m)
#pragma unroll
                    for (int n = 0; n < 2; ++n) acc[a][b][m][n] = (f32x4){0.f, 0.f, 0.f, 0.f};
        cur = nxt; cA = nA; cB = nB; ++ui;
        if constexpr (ALIGN_EPI) { if (wr == 1) PG8_BAR; }
    }
    PG8_WAIT_V(0);
    if constexpr (!ALIGN_EPI) { if (wr == 0) PG8_BAR; }
    PG8_BAR;
    if constexpr (Epi::AFTER_DRAIN) { E.fused(acc, cur, wr, wc, fr, fq, lds, wid, lane); S.done(cur); }
#undef PG8_SA
#undef PG8_SB
#undef PG8_STAGE
#undef PG8_LDA
#undef PG8_LDB
#undef PG8_MMA
#undef PG8_WAIT_V
#undef PG8_WAIT_L
#undef PG8_BAR
#undef PG8_SCHED
}
}

typedef pg8::bf16_t bf16_t;
typedef pg8::f32x4 f32x4;
typedef pg8::u32x4 u32x4;
using pg8::cvt_pk_bf16;
constexpr int NB = 4, SEQ = 8192, D = 1024, MTOK = NB * SEQ;
constexpr int PCOLS = 4608, GCOLS = 3072, INCOLS = 7680, DFF = 3584, NEXP = 8;
constexpr int C_HQ = 0, C_HF = 512, C_HI = 1024, C_HG = 1536, C_GU = 2048, C_GV = 2560, C_SQ = 3072, C_SK = 3584, C_SV = 4096;
constexpr float EPS = 1e-6f;
constexpr int NSLOT = 2 * MTOK + 2 * NEXP * 256, MOE_MAXBLK = MTOK / 256 + NEXP;
constexpr int NTHREADS = 512, NWAVES = 8;
constexpr int LDS_BYTES = 147456, LDS_MISC = LDS_BYTES - 256;

constexpr size_t WS_CTL = 0, CTL_BYTES = 65536;
constexpr size_t CW_BAR = 0;
constexpr size_t WS_META = WS_CTL + CTL_BYTES;
constexpr size_t WS_LB = WS_META + 4096;
constexpr size_t WS_TOKE = WS_LB + 4096;
constexpr size_t WS_TOKW = WS_TOKE + (size_t)MTOK * 4;
constexpr size_t WS_SLOTTOK = WS_TOKW + (size_t)MTOK * 8;
constexpr size_t WS_SLOTW = WS_SLOTTOK + (size_t)NSLOT * 4;
constexpr size_t WS_BLKE = WS_SLOTW + (size_t)NSLOT * 4;
constexpr size_t WS_W = 2u << 20;
static_assert(WS_BLKE + 4096 <= WS_W, "small buffers");
constexpr size_t WS_WIN = WS_W;
constexpr size_t WS_WBR = WS_WIN + (size_t)2 * INCOLS * D * 2;
constexpr size_t WS_WOUT = WS_WBR + (size_t)2 * 3 * D * 512 * 2;
constexpr size_t WS_WGU = WS_WOUT + (size_t)2 * D * D * 2;
constexpr size_t WS_WD = WS_WGU + (size_t)2 * DFF * D * 2;
constexpr size_t WS_XN = WS_WD + (size_t)D * DFF * 2;
constexpr size_t WS_C = WS_XN + (size_t)MTOK * D * 2;
constexpr size_t WS_P = WS_C;
constexpr size_t WS_G = WS_C;
constexpr size_t WS_HID = WS_C;
constexpr size_t WS_OCAT = WS_C + (size_t)MTOK * PCOLS * 2;
constexpr size_t WS_ORAW = WS_OCAT + (size_t)3 * MTOK * 512 * 2;
constexpr size_t WS_END1 = WS_ORAW + (size_t)MTOK * 512 * 4;
constexpr size_t WS_MWD = WS_W;
static_assert(WS_MWD + (size_t)NEXP * D * DFF * 2 <= WS_XN, "moe down weights fit below XN");
constexpr size_t WS_MWGU = WS_C;
constexpr size_t WS_XS = WS_MWGU + (size_t)NEXP * 2 * DFF * D * 2;
constexpr size_t WS_MHID = WS_XS + (size_t)MOE_MAXBLK * 256 * D * 2;
constexpr size_t WS_END2 = WS_MHID + (size_t)MOE_MAXBLK * 256 * DFF * 2;
constexpr size_t WS_SLAB = WS_END2;
constexpr size_t WS_END3 = WS_SLAB + (size_t)256 * 256 * 256 * 2;
constexpr size_t WS_NEED = WS_END1 > WS_END3 ? WS_END1 : WS_END3;
static_assert(WS_NEED <= 615053344ull, "workspace budget (sum of the inputs)");

#define LAUNDER(v) asm volatile("" : "+v"(v))
__device__ __forceinline__ float bf2f(unsigned v) { return __uint_as_float(v << 16); }
__device__ __forceinline__ float bflo(unsigned w) { return __uint_as_float(w << 16); }
__device__ __forceinline__ float bfhi(unsigned w) { return __uint_as_float(w & 0xffff0000u); }
__device__ __forceinline__ bf16_t f2bf(float f) { return (bf16_t)(cvt_pk_bf16(f, 0.f) & 0xffffu); }
template <int M> __device__ __forceinline__ float xor_f(float v) { return __builtin_bit_cast(float, __builtin_amdgcn_ds_swizzle(__builtin_bit_cast(int, v), (M << 10) | 0x1f)); }
__device__ __forceinline__ float bperm_f(float v, int src_lane) { return __builtin_bit_cast(float, __builtin_amdgcn_ds_bpermute(src_lane << 2, __builtin_bit_cast(int, v))); }
__device__ __forceinline__ unsigned fp8x4(float a, float b, float c, float d) { int p = 0; a = __builtin_amdgcn_fmed3f(a, -448.f, 448.f); b = __builtin_amdgcn_fmed3f(b, -448.f, 448.f); c = __builtin_amdgcn_fmed3f(c, -448.f, 448.f); d = __builtin_amdgcn_fmed3f(d, -448.f, 448.f);     p = __builtin_amdgcn_cvt_pk_fp8_f32(a, b, p, false); p = __builtin_amdgcn_cvt_pk_fp8_f32(c, d, p, true); return (unsigned)p; }
__device__ __forceinline__ float wave_sum(float v) {
    v += xor_f<1>(v); v += xor_f<2>(v); v += xor_f<4>(v); v += xor_f<8>(v); v += xor_f<16>(v);
    return __builtin_bit_cast(float, __builtin_amdgcn_readlane(__builtin_bit_cast(int, v), 0)) + __builtin_bit_cast(float, __builtin_amdgcn_readlane(__builtin_bit_cast(int, v), 32));
}
__device__ __forceinline__ float sigmoidf_(float x) { return __builtin_amdgcn_rcpf(1.f + __expf(-x)); }
__device__ __forceinline__ float siluf_(float x) { return x * sigmoidf_(x); }
__device__ __forceinline__ float gelu_tanh_(float x) { return x * sigmoidf_(1.5957691216057308f * (x + 0.044715f * x * x * x)); }
__device__ __forceinline__ float softplusf_(float z) { return fmaxf(z, 0.f) + __logf(1.f + __expf(-fabsf(z))); }

struct Order {
    int nM, nN, nwg, G, c, mode; const char* A; const char* Bt; size_t tstep, abr, bbr; const int* bmap; const LAS int* bmapl; int ktiles, nfull, tail, split;
    __device__ __forceinline__ void init(const void* A_, const void* Bt_, int M, int N, int K, int G_, int c_, int mode_ = 0, size_t abr_ = 0, size_t bbr_ = 0, const int* bmap_ = nullptr, int tailsplit = 0, int esz = 2) { asm volatile("" : "+s"(c_));
        bmap = bmap_; bmapl = nullptr; ktiles = K * esz / 128; split = 1; tail = 0;
        nM = M / 256; nN = N / 256; nwg = nM * nN; G = G_; c = c_; mode = mode_; A = (const char*)A_; Bt = (const char*)Bt_; tstep = (size_t)256 * K * esz; abr = abr_; bbr = bbr_; nfull = nwg;
        if (tailsplit) { nfull = (nwg / G) * G; tail = nwg - nfull; split = (tail > 0 && tail * 7 <= G) ? 7 : (tail > 0 && tail * 4 <= G) ? 4 : (tail > 0 && tail * 2 <= G) ? 2 : 1; } }
    __device__ __forceinline__ void map(int L, int& pm, int& pn) const {
        int wgid = L; { const int q = nwg / 8, r = nwg % 8, xcd = wgid % 8, off = wgid / 8; wgid = (xcd < r ? xcd * (q + 1) : r * (q + 1) + (xcd - r) * q) + off; }
        const int nig = 8 * nN, gid = wgid / nig, fm = gid * 8, gsz = ((nM & 7) == 0) ? 8 : ((nM - fm) < 8 ? (nM - fm) : 8); pm = fm + ((wgid % nig) % gsz); pn = (wgid % nig) / gsz; }
    __device__ __forceinline__ bool next(int i, pg8::Unit& u) const {
        if (mode == 4) {
            u.nt = ktiles; u.atomic = 0; const long L = (long)i * G + c; const int nt4 = nM * 4; if (L >= nt4) return false;
            int wgid = (int)L; { const int q = nt4 / 8, r = nt4 % 8, xcd = wgid % 8, off = wgid / 8; wgid = (xcd < r ? xcd * (q + 1) : r * (q + 1) + (xcd - r) * q) + off; }
            const int nig = 8 * 4, gid = wgid / nig, fm = gid * 8, gsz = ((nM & 7) == 0) ? 8 : ((nM - fm) < 8 ? (nM - fm) : 8);
            u.pm = fm + ((wgid % nig) % gsz); u.pn = (wgid % nig) / gsz; u.a = A + (size_t)u.pm * tstep; u.b = Bt + (size_t)u.pn * tstep; return true; }
        if (mode == 3) {
            u.nt = ktiles; u.atomic = 0;
            const int br = i % 3; const long L = (long)(i / 3) * G + c; const int nt4 = nM * 4; if (L >= nt4) return false;
            int wgid = (int)L; { const int q = nt4 / 8, r = nt4 % 8, xcd = wgid % 8, off = wgid / 8; wgid = (xcd < r ? xcd * (q + 1) : r * (q + 1) + (xcd - r) * q) + off; }
            const int nig = 8 * 4, gid = wgid / nig, fm = gid * 8, gsz = ((nM & 7) == 0) ? 8 : ((nM - fm) < 8 ? (nM - fm) : 8);
            u.pm = fm + ((wgid % nig) % gsz); const int pq = (wgid % nig) / gsz; u.pn = br * 4 + pq;
            u.a = A + (size_t)br * abr + (size_t)u.pm * tstep; u.b = Bt + (size_t)br * bbr + (size_t)pq * tstep; return true; }
        long L = (long)i * G + c; int slice = 0; u.nt = ktiles; u.atomic = 0;
        if (L >= nfull) {
            if (split == 1) { if (L >= nwg) return false; }
            else { const long tq = L - nfull; if (i != nfull / G || tq >= (long)tail * split) return false; L = nfull + tq / split; slice = (int)(tq % split); u.nt = ktiles / split; u.atomic = 1 + (int)tq; } }
        int wgid = (int)L; { const int q = nwg / 8, r = nwg % 8, xcd = wgid % 8, off = wgid / 8; wgid = (xcd < r ? xcd * (q + 1) : r * (q + 1) + (xcd - r) * q) + off; }
        const int nig = 8 * nN, gid = wgid / nig, fm = gid * 8, gsz = ((nM & 7) == 0) ? 8 : ((nM - fm) < 8 ? (nM - fm) : 8);
        u.pm = fm + ((wgid % nig) % gsz); u.pn = (wgid % nig) / gsz;
        if (mode == 0) { u.a = A + (size_t)u.pm * tstep; u.b = Bt + (size_t)u.pn * tstep; }
        else if (mode == 2) { const int ex = __builtin_amdgcn_readfirstlane(bmapl[u.pm]);     u.a = A + (size_t)u.pm * tstep + (size_t)slice * u.nt * 128; u.b = Bt + (size_t)ex * bbr + (size_t)u.pn * tstep + (size_t)slice * u.nt * 128; }
        else { const int br = u.pn >> 2; u.a = A + (size_t)br * abr + (size_t)u.pm * tstep; u.b = Bt + (size_t)br * bbr + (size_t)(u.pn & 3) * tstep; }
        return true;
    }
    __device__ __forceinline__ void a_ready(const pg8::Unit&) const {}
    __device__ __forceinline__ void done(const pg8::Unit&) const {}
};

template <int ACT> __device__ __forceinline__ float act_(float x, float lb) {
    if (ACT == 1) return siluf_(x);
    if (ACT == 2) return __logf(lb + (1.f - lb) * sigmoidf_(x));
    if (ACT == 3) return gelu_tanh_(x);
    if (ACT == 4) return sigmoidf_(x);
    return x;
}
struct EpiAct {
    static constexpr bool PERM = true, AFTER_DRAIN = false, IDEM = true;
    bf16_t* O; int ldc; const float* lb; int inproj;
    template <int ACT> __device__ __forceinline__ void run(const f32x4 (&acc)[2][2][4][2], const pg8::Unit& u, int wr, int wc, int fr, int fq) const {
        const int row0 = u.pm * 256 + wr * 64 + fr, col0 = u.pn * 256 + wc * 32 + 8 * fq;
        f32x4 lbv[2][2];
#pragma unroll
        for (int bj = 0; bj < 2; ++bj)
#pragma unroll
            for (int n = 0; n < 2; ++n) lbv[bj][n] = (ACT == 2) ? *(const f32x4*)(lb + (col0 - C_HF) + bj * 128 + 4 * n) : (f32x4){0.f, 0.f, 0.f, 0.f};
#pragma unroll
        for (int ai = 0; ai < 2; ++ai)
#pragma unroll
            for (int m = 0; m < 4; ++m) { bf16_t* rowp = O + (size_t)(row0 + ai * 128 + m * 16) * ldc + col0;
#pragma unroll
                for (int bj = 0; bj < 2; ++bj) { f32x4 v0 = acc[ai][bj][m][0], v1 = acc[ai][bj][m][1];
#pragma unroll
                    for (int i = 0; i < 4; ++i) { if (ACT != 1 && ACT != 4) { v0[i] = act_<ACT>(v0[i], lbv[bj][0][i]); v1[i] = act_<ACT>(v1[i], lbv[bj][1][i]); } }
                    if (ACT == 1 || ACT == 4) { f32x4 e0 = v0 * -1.4426950408889634f, e1 = v1 * -1.4426950408889634f;
#pragma unroll
                        for (int i = 0; i < 4; ++i) { e0[i] = __builtin_amdgcn_exp2f(e0[i]); e1[i] = __builtin_amdgcn_exp2f(e1[i]); }
                        e0 = e0 + 1.f; e1 = e1 + 1.f;
#pragma unroll
                        for (int i = 0; i < 4; ++i) { e0[i] = __builtin_amdgcn_rcpf(e0[i]); e1[i] = __builtin_amdgcn_rcpf(e1[i]); }
                        if (ACT == 1) { v0 = v0 * e0; v1 = v1 * e1; } else { v0 = e0; v1 = e1; } }
                    u32x4 w; w.x = cvt_pk_bf16(v0[0], v0[1]); w.y = cvt_pk_bf16(v0[2], v0[3]); w.z = cvt_pk_bf16(v1[0], v1[1]); w.w = cvt_pk_bf16(v1[2], v1[3]);
                    *(u32x4*)(rowp + bj * 128) = w; } }
    }
    __device__ __forceinline__ void operator()(const f32x4 (&acc)[2][2][4][2], const pg8::Unit& u, int wr, int wc, int fr, int fq) const {
        if (!inproj) { run<4>(acc, u, wr, wc, fr, fq); return; }
        const int kind = u.pn >> 1;
        if (kind == 0 || kind == 3) run<1>(acc, u, wr, wc, fr, fq);
        else if (kind == 1) run<2>(acc, u, wr, wc, fr, fq);
        else if (kind == 4 || kind == 5) run<3>(acc, u, wr, wc, fr, fq);
        else run<0>(acc, u, wr, wc, fr, fq);
    }
};
struct EpiBranch {
    static constexpr bool PERM = true, AFTER_DRAIN = false, IDEM = false;
    const bf16_t* Gt; bf16_t* mix;
    __device__ __forceinline__ void operator()(const f32x4 (&acc)[2][2][4][2], const pg8::Unit& u, int wr, int wc, int fr, int fq) const {
        const int br = u.pn >> 2, row0 = u.pm * 256 + wr * 64 + fr, col0 = (u.pn & 3) * 256 + wc * 32 + 8 * fq;
#pragma unroll
        for (int ai = 0; ai < 2; ++ai)
#pragma unroll
            for (int m = 0; m < 4; ++m) { const size_t row = (size_t)(row0 + ai * 128 + m * 16); const bf16_t* gp = Gt + row * GCOLS + br * 1024 + col0; bf16_t* mp = mix + row * D + col0;
#pragma unroll
                for (int bj = 0; bj < 2; ++bj) { const f32x4 v0 = acc[ai][bj][m][0], v1 = acc[ai][bj][m][1];
                    const u32x4 g = *(const u32x4*)(gp + bj * 128); u32x4 o = {0u, 0u, 0u, 0u};
                    if (br > 0) o = __builtin_nontemporal_load((const u32x4*)(mp + bj * 128));
                    u32x4 w;
                    w.x = cvt_pk_bf16(bflo(o.x) + v0[0] * bflo(g.x), bfhi(o.x) + v0[1] * bfhi(g.x)); w.y = cvt_pk_bf16(bflo(o.y) + v0[2] * bflo(g.y), bfhi(o.y) + v0[3] * bfhi(g.y));
                    w.z = cvt_pk_bf16(bflo(o.z) + v1[0] * bflo(g.z), bfhi(o.z) + v1[1] * bfhi(g.z)); w.w = cvt_pk_bf16(bflo(o.w) + v1[2] * bflo(g.w), bfhi(o.w) + v1[3] * bfhi(g.w));
                    *(u32x4*)(mp + bj * 128) = w; } }
    }
};
struct EpiBranchSeg {
    static constexpr bool PERM = true, AFTER_DRAIN = false, IDEM = true;
    const bf16_t* Gt; bf16_t* mix;
    __device__ __forceinline__ void mid(f32x4 (&acc)[2][2][4][2], const pg8::Unit& u, int seg, int wr, int wc, int fr, int fq, const bool inv = false) const {
        const int row0 = u.pm * 256 + wr * 64 + fr, col0 = u.pn * 256 + wc * 32 + 8 * fq;
        u32x4 ga[2][2][2], gb[2][2][2];
#define EBS_LOAD(b_) do { _Pragma("unroll") for (int mm = 0; mm < 2; ++mm) { const bf16_t* gp = Gt + (size_t)(row0 + ((b_) >> 1) * 128 + (2 * ((b_) & 1) + mm) * 16) * GCOLS + seg * 1024 + col0; \
            _Pragma("unroll") for (int bj = 0; bj < 2; ++bj) { ga[(b_) & 1][mm][bj] = *(const u32x4*)(gp + bj * 128); gb[(b_) & 1][mm][bj] = *(const u32x4*)(gp + 1024 + bj * 128); } } } while (0)
        EBS_LOAD(0);
#pragma unroll
        for (int b = 0; b < 4; ++b) { const int ai = b >> 1, mp = b & 1;
            if (b + 1 < 4) EBS_LOAD(b + 1);
            asm volatile("" ::: "memory");
#pragma unroll
            for (int mm = 0; mm < 2; ++mm)
#pragma unroll
                for (int bj = 0; bj < 2; ++bj) { const u32x4 a = inv ? gb[b & 1][mm][bj] : ga[b & 1][mm][bj], bb = inv ? ga[b & 1][mm][bj] : gb[b & 1][mm][bj]; const int m = 2 * mp + mm;
                    const float na[8] = {bflo(a.x), bfhi(a.x), bflo(a.y), bfhi(a.y), bflo(a.z), bfhi(a.z), bflo(a.w), bfhi(a.w)}, nb[8] = {bflo(bb.x), bfhi(bb.x), bflo(bb.y), bfhi(bb.y), bflo(bb.z), bfhi(bb.z), bflo(bb.w), bfhi(bb.w)};
#pragma unroll
                    for (int i = 0; i < 4; ++i) { acc[ai][bj][m][0][i] *= fmaxf(na[i], 1e-6f) * __builtin_amdgcn_rcpf(fmaxf(nb[i], 1e-6f)); acc[ai][bj][m][1][i] *= fmaxf(na[4 + i], 1e-6f) * __builtin_amdgcn_rcpf(fmaxf(nb[4 + i], 1e-6f)); } } }
#undef EBS_LOAD
    }
    __device__ __forceinline__ void operator()(const f32x4 (&acc)[2][2][4][2], const pg8::Unit& u, int wr, int wc, int fr, int fq) const {
        const int row0 = u.pm * 256 + wr * 64 + fr, col0 = u.pn * 256 + wc * 32 + 8 * fq;
#pragma unroll
        for (int ai = 0; ai < 2; ++ai) { u32x4 g[4][2];
#pragma unroll
            for (int m = 0; m < 4; ++m)
#pragma unroll
                for (int bj = 0; bj < 2; ++bj) g[m][bj] = *(const u32x4*)(Gt + (size_t)(row0 + ai * 128 + m * 16) * GCOLS + 2048 + col0 + bj * 128);
            asm volatile("" ::: "memory");
#pragma unroll
            for (int m = 0; m < 4; ++m) { bf16_t* mp = mix + (size_t)(row0 + ai * 128 + m * 16) * D + col0;
#pragma unroll
                for (int bj = 0; bj < 2; ++bj) { const f32x4 v0 = acc[ai][bj][m][0], v1 = acc[ai][bj][m][1]; const u32x4 gg = g[m][bj]; u32x4 w;
                    w.x = cvt_pk_bf16(v0[0] * fmaxf(bflo(gg.x), 1e-6f), v0[1] * fmaxf(bfhi(gg.x), 1e-6f)); w.y = cvt_pk_bf16(v0[2] * fmaxf(bflo(gg.y), 1e-6f), v0[3] * fmaxf(bfhi(gg.y), 1e-6f));
                    w.z = cvt_pk_bf16(v1[0] * fmaxf(bflo(gg.z), 1e-6f), v1[1] * fmaxf(bfhi(gg.z), 1e-6f)); w.w = cvt_pk_bf16(v1[2] * fmaxf(bflo(gg.w), 1e-6f), v1[3] * fmaxf(bfhi(gg.w), 1e-6f));
                    *(u32x4*)(mp + bj * 128) = w; } } }
    }
};
template <bool INF>
struct EpiResidT {
    static constexpr bool PERM = true, AFTER_DRAIN = false, IDEM = INF;
    const void* xin; bf16_t* xout;
    __device__ __forceinline__ void operator()(const f32x4 (&acc)[2][2][4][2], const pg8::Unit& u, int wr, int wc, int fr, int fq) const {
        const int row0 = u.pm * 256 + wr * 64 + fr, col0 = u.pn * 256 + wc * 32 + 8 * fq;
        if constexpr (INF) {
#pragma unroll
            for (int ai = 0; ai < 2; ++ai)
#pragma unroll
                for (int mp = 0; mp < 2; ++mp) { f32x4 t[2][2][2];
#pragma unroll
                    for (int mm = 0; mm < 2; ++mm) { const size_t ro = (size_t)(row0 + ai * 128 + (2 * mp + mm) * 16) * D + col0;
#pragma unroll
                        for (int bj = 0; bj < 2; ++bj)
#pragma unroll
                            for (int n = 0; n < 2; ++n) t[mm][bj][n] = *(const f32x4*)((const float*)xin + ro + bj * 128 + n * 4); }
                    asm volatile("" ::: "memory");
#pragma unroll
                    for (int mm = 0; mm < 2; ++mm) { const size_t ro = (size_t)(row0 + ai * 128 + (2 * mp + mm) * 16) * D + col0;
#pragma unroll
                        for (int bj = 0; bj < 2; ++bj) { const f32x4 v0 = t[mm][bj][0] + acc[ai][bj][2 * mp + mm][0], v1 = t[mm][bj][1] + acc[ai][bj][2 * mp + mm][1];
                            u32x4 w; w.x = cvt_pk_bf16(v0[0], v0[1]); w.y = cvt_pk_bf16(v0[2], v0[3]); w.z = cvt_pk_bf16(v1[0], v1[1]); w.w = cvt_pk_bf16(v1[2], v1[3]); *(u32x4*)(xout + ro + bj * 128) = w; } }
                    asm volatile("" ::: "memory"); }
        } else {
#pragma unroll
            for (int ai = 0; ai < 2; ++ai) { u32x4 t[4][2];
#pragma unroll
                for (int m = 0; m < 4; ++m) { const size_t ro = (size_t)(row0 + ai * 128 + m * 16) * D + col0;
#pragma unroll
                    for (int bj = 0; bj < 2; ++bj) t[m][bj] = *(const u32x4*)((const bf16_t*)xin + ro + bj * 128); }
                asm volatile("" ::: "memory");
#pragma unroll
                for (int m = 0; m < 4; ++m) { const size_t ro = (size_t)(row0 + ai * 128 + m * 16) * D + col0;
#pragma unroll
                    for (int bj = 0; bj < 2; ++bj) { const u32x4 o = t[m][bj]; const f32x4 a0 = acc[ai][bj][m][0], a1 = acc[ai][bj][m][1];
                        u32x4 w; w.x = cvt_pk_bf16(bflo(o.x) + a0[0], bfhi(o.x) + a0[1]); w.y = cvt_pk_bf16(bflo(o.y) + a0[2], bfhi(o.y) + a0[3]);
                        w.z = cvt_pk_bf16(bflo(o.z) + a1[0], bfhi(o.z) + a1[1]); w.w = cvt_pk_bf16(bflo(o.w) + a1[2], bfhi(o.w) + a1[3]); *(u32x4*)(xout + ro + bj * 128) = w; } }
                asm volatile("" ::: "memory"); }
        }
    }
};
template <bool F8OUT>
struct EpiGUT {
    static constexpr bool PERM = true, AFTER_DRAIN = false, IDEM = true;
    void* H;
    __device__ __forceinline__ void operator()(const f32x4 (&acc)[2][2][4][2], const pg8::Unit& u, int wr, int wc, int fr, int fq) const {
        const int row0 = u.pm * 256 + wr * 64 + fr, col0 = u.pn * 128 + wc * 32 + 8 * fq;
#pragma unroll
        for (int ai = 0; ai < 2; ++ai)
#pragma unroll
            for (int m = 0; m < 4; ++m) { const size_t eo = (size_t)(row0 + ai * 128 + m * 16) * DFF + col0;
                const f32x4 g0 = acc[ai][0][m][0], g1 = acc[ai][0][m][1], u0 = acc[ai][1][m][0], u1 = acc[ai][1][m][1];
                f32x4 e0 = g0 * -1.4426950408889634f, e1 = g1 * -1.4426950408889634f;
#pragma unroll
                for (int i = 0; i < 4; ++i) { e0[i] = __builtin_amdgcn_exp2f(e0[i]); e1[i] = __builtin_amdgcn_exp2f(e1[i]); }
                f32x4 d0 = e0 + 1.f, d1 = e1 + 1.f;
#pragma unroll
                for (int i = 0; i < 4; ++i) { d0[i] = __builtin_amdgcn_rcpf(d0[i]); d1[i] = __builtin_amdgcn_rcpf(d1[i]); }
                const f32x4 hv0 = g0 * d0 * u0, hv1 = g1 * d1 * u1;
                const float h0 = hv0[0], h1 = hv0[1], h2 = hv0[2], h3 = hv0[3], h4 = hv1[0], h5 = hv1[1], h6 = hv1[2], h7 = hv1[3];
                if (F8OUT) *(uint2*)((unsigned char*)H + eo) = make_uint2(fp8x4(h0, h1, h2, h3), fp8x4(h4, h5, h6, h7));
                else { u32x4 w; w.x = cvt_pk_bf16(h0, h1); w.y = cvt_pk_bf16(h2, h3); w.z = cvt_pk_bf16(h4, h5); w.w = cvt_pk_bf16(h6, h7); *(u32x4*)((bf16_t*)H + eo) = w; } }
    }
};
typedef EpiGUT<false> EpiGU;
struct EpiMoeDown {
    static constexpr bool PERM = true, AFTER_DRAIN = false, IDEM = true;
    const bf16_t* rin; void* rout; int outf; const int* stok; const float* sw; bf16_t* slab;
    __device__ __forceinline__ void operator()(const f32x4 (&acc)[2][2][4][2], const pg8::Unit& u, int wr, int wc, int fr, int fq) const {
        LAUNDER(fr); LAUNDER(fq);
        if (u.atomic) { bf16_t* sp = slab + (size_t)(u.atomic - 1) * 65536 + (size_t)(wr * 64 + fr) * 256 + wc * 32 + 8 * fq;
#pragma unroll
            for (int ai = 0; ai < 2; ++ai)
#pragma unroll
                for (int m = 0; m < 4; ++m)
#pragma unroll
                    for (int bj = 0; bj < 2; ++bj) { const f32x4 v0 = acc[ai][bj][m][0], v1 = acc[ai][bj][m][1]; u32x4 w; w.x = cvt_pk_bf16(v0[0], v0[1]); w.y = cvt_pk_bf16(v0[2], v0[3]); w.z = cvt_pk_bf16(v1[0], v1[1]); w.w = cvt_pk_bf16(v1[2], v1[3]);
                        *(u32x4*)(sp + (size_t)(ai * 128 + m * 16) * 256 + bj * 128) = w; }
            return; }
        const int row0 = u.pm * 256 + wr * 64 + fr, col0 = u.pn * 256 + wc * 32 + 8 * fq;
        int tk[2][4]; float wt[2][4];
#pragma unroll
        for (int ai = 0; ai < 2; ++ai)
#pragma unroll
            for (int m = 0; m < 4; ++m) { const int rl = row0 + ai * 128 + m * 16; tk[ai][m] = stok[rl]; wt[ai][m] = sw[rl]; }
#pragma unroll
        for (int ai = 0; ai < 2; ++ai) { u32x4 t[4][2];
#pragma unroll
            for (int m = 0; m < 4; ++m) { const int tok = tk[ai][m]; const bf16_t* rp = rin + (size_t)(tok < 0 ? 0 : tok) * D + col0;
#pragma unroll
                for (int bj = 0; bj < 2; ++bj) t[m][bj] = *(const u32x4*)(rp + bj * 128); }
            asm volatile("" ::: "memory");
#pragma unroll
            for (int m = 0; m < 4; ++m) { const int tok = tk[ai][m]; const float w = wt[ai][m];
                if (tok >= 0) { const size_t ro = (size_t)tok * D + col0;
#pragma unroll
                    for (int bj = 0; bj < 2; ++bj) { const u32x4 o = t[m][bj]; const f32x4 a0 = acc[ai][bj][m][0] * w, a1 = acc[ai][bj][m][1] * w;
                        const f32x4 v0 = {bflo(o.x) + a0[0], bfhi(o.x) + a0[1], bflo(o.y) + a0[2], bfhi(o.y) + a0[3]}, v1 = {bflo(o.z) + a1[0], bfhi(o.z) + a1[1], bflo(o.w) + a1[2], bfhi(o.w) + a1[3]};
                        if (outf) { float* op = (float*)rout + ro + bj * 128; *(f32x4*)op = v0; *(f32x4*)(op + 4) = v1; }
                        else { u32x4 q; q.x = cvt_pk_bf16(v0[0], v0[1]); q.y = cvt_pk_bf16(v0[2], v0[3]); q.z = cvt_pk_bf16(v1[0], v1[1]); q.w = cvt_pk_bf16(v1[2], v1[3]); *(u32x4*)((bf16_t*)rout + ro + bj * 128) = q; } } } }
            asm volatile("" ::: "memory"); }
    }
};
__device__ __forceinline__ void moe_tail_reduce(const Order& S, const bf16_t* slab, const bf16_t* rin, void* rout, int outf, const int* stok, const float* sw, int wg, int G, int wid, int lane) {
    LAUNDER(lane);
    if (S.split == 1) return;
    for (int task = wg * NWAVES + wid; task < S.tail * 256; task += G * NWAVES) {
        const int j = task >> 8, r = task & 255; int pm, pn; S.map(S.nfull + j, pm, pn);
        const int tok = __hip_atomic_load(stok + pm * 256 + r, __ATOMIC_RELAXED, __HIP_MEMORY_SCOPE_AGENT); if (tok < 0) continue;
        const float w = sw[pm * 256 + r]; f32x4 s = {0.f, 0.f, 0.f, 0.f};
        const size_t ro = (size_t)tok * D + pn * 256 + lane * 4; const uint2 x = *(const uint2*)(rin + ro);
        uint2 xs[7];
#pragma unroll
        for (int sl = 0; sl < 7; ++sl) { xs[sl] = make_uint2(0u, 0u); if (sl < S.split) xs[sl] = *(const uint2*)(slab + (size_t)(j * S.split + sl) * 65536 + (size_t)r * 256 + lane * 4); }
#pragma unroll
        for (int sl = 0; sl < 7; ++sl) { s[0] += bflo(xs[sl].x); s[1] += bfhi(xs[sl].x); s[2] += bflo(xs[sl].y); s[3] += bfhi(xs[sl].y); }
        const f32x4 o = {bflo(x.x) + s[0] * w, bfhi(x.x) + s[1] * w, bflo(x.y) + s[2] * w, bfhi(x.y) + s[3] * w};
        if (outf) *(f32x4*)((float*)rout + ro) = o; else *(uint2*)((bf16_t*)rout + ro) = make_uint2(cvt_pk_bf16(o[0], o[1]), cvt_pk_bf16(o[2], o[3]));
    }
}

__device__ __forceinline__ void tc_job(const float* __restrict__ src, int K, int N, bf16_t* dst, int mode, int perm, LAS float* tile, int wg, int G, int tid, int f8 = 0) {
    LAUNDER(tid);
    const int tn = N / 64, nt = (K / 64) * tn;
    float4 v0 = make_float4(0.f, 0.f, 0.f, 0.f), v1 = v0;
    if (wg < nt) { const int k0 = (wg / tn) * 64, n0 = (wg % tn) * 64; const float* sp = src + (size_t)(k0 + (tid >> 4)) * N + n0 + (tid & 15) * 4; v0 = *(const float4*)sp; v1 = *(const float4*)(sp + (size_t)32 * N); }
    for (int t = wg; t < nt; t += G) {
        const int k0 = (t / tn) * 64, n0 = (t % tn) * 64;
        { LAS float* tp = tile + (tid >> 4) * 65 + (tid & 15) * 4; tp[0] = v0.x; tp[1] = v0.y; tp[2] = v0.z; tp[3] = v0.w; tp += 32 * 65; tp[0] = v1.x; tp[1] = v1.y; tp[2] = v1.z; tp[3] = v1.w; }
        if (t + G < nt) { const int k1 = ((t + G) / tn) * 64, n1 = ((t + G) % tn) * 64; const float* sp = src + (size_t)(k1 + (tid >> 4)) * N + n1 + (tid & 15) * 4; v0 = *(const float4*)sp; v1 = *(const float4*)(sp + (size_t)32 * N); }
        __syncthreads();
        { const int n = tid >> 3, kg = (tid & 7) * 8; unsigned w[4];
#pragma unroll
          for (int j = 0; j < 4; ++j) w[j] = cvt_pk_bf16(tile[(kg + 2 * j) * 65 + n], tile[(kg + 2 * j + 1) * 65 + n]);
          const int nn = n0 + n; int drow = mode == 0 ? nn : ((nn >> 7) * 256 + (nn & 127) + (mode == 2 ? 128 : 0));
          if (perm) { const int c5 = drow & 31; drow = (drow & ~31) + 16 * ((c5 >> 2) & 1) + 4 * (c5 >> 3) + (c5 & 3); }
          if (f8) *(uint2*)((unsigned char*)dst + (size_t)drow * K + k0 + kg) = make_uint2(fp8x4(64.f * tile[(kg + 0) * 65 + n], 64.f * tile[(kg + 1) * 65 + n], 64.f * tile[(kg + 2) * 65 + n], 64.f * tile[(kg + 3) * 65 + n]),
                                                                                          fp8x4(64.f * tile[(kg + 4) * 65 + n], 64.f * tile[(kg + 5) * 65 + n], 64.f * tile[(kg + 6) * 65 + n], 64.f * tile[(kg + 7) * 65 + n]));
          else *(uint4*)(dst + (size_t)drow * K + k0 + kg) = make_uint4(w[0], w[1], w[2], w[3]); }
        __syncthreads();
    }
}

__device__ __forceinline__ void tc_job_w(const float* __restrict__ src, int K, int N, bf16_t* dst, int mode, int perm, LAS float* tile_all, int wg, int G, int wid, int lane, int f8 = 0) {
    LAUNDER(lane);
    LAS float* tile = tile_all + wid * (64 * 65);
    const int tn = N / 64, nt = (K / 64) * tn, TS = G * NWAVES;
    const int r = lane >> 4, c4 = (lane & 15) * 4;
    float4 v[16];
    int t = wg * NWAVES + wid;
    if (t < nt) { const float* sp = src + (size_t)((t / tn) * 64 + r) * N + (t % tn) * 64 + c4;
#pragma unroll
        for (int i = 0; i < 16; ++i) v[i] = *(const float4*)(sp + (size_t)(4 * i) * N); }
    for (; t < nt; t += TS) {
        const int k0 = (t / tn) * 64, n0 = (t % tn) * 64;
#pragma unroll
        for (int i = 0; i < 16; ++i) { LAS float* tp = tile + (r + 4 * i) * 65 + c4; tp[0] = v[i].x; tp[1] = v[i].y; tp[2] = v[i].z; tp[3] = v[i].w; }
        if (t + TS < nt) { const int t1 = t + TS; const float* sp = src + (size_t)((t1 / tn) * 64 + r) * N + (t1 % tn) * 64 + c4;
#pragma unroll
            for (int i = 0; i < 16; ++i) v[i] = *(const float4*)(sp + (size_t)(4 * i) * N); }
        asm volatile("" ::: "memory"); __builtin_amdgcn_wave_barrier();
#pragma unroll
        for (int j = 0; j < 8; ++j) { const int p = lane + 64 * j, n = p >> 3, kg = (p & 7) * 8; float x[8];
#pragma unroll
            for (int q = 0; q < 8; ++q) x[q] = tile[(kg + q) * 65 + n];
            const int nn = n0 + n; int drow = mode == 0 ? nn : ((nn >> 7) * 256 + (nn & 127) + (mode == 2 ? 128 : 0));
            if (perm) { const int c5 = drow & 31; drow = (drow & ~31) + 16 * ((c5 >> 2) & 1) + 4 * (c5 >> 3) + (c5 & 3); }
            if (f8) *(uint2*)((unsigned char*)dst + (size_t)drow * K + k0 + kg) = make_uint2(fp8x4(64.f * x[0], 64.f * x[1], 64.f * x[2], 64.f * x[3]), fp8x4(64.f * x[4], 64.f * x[5], 64.f * x[6], 64.f * x[7]));
            else *(uint4*)(dst + (size_t)drow * K + k0 + kg) = make_uint4(cvt_pk_bf16(x[0], x[1]), cvt_pk_bf16(x[2], x[3]), cvt_pk_bf16(x[4], x[5]), cvt_pk_bf16(x[6], x[7])); }
        asm volatile("" ::: "memory"); __builtin_amdgcn_wave_barrier();
    }
}
__device__ __forceinline__ void tc_job_f8(const float* __restrict__ src, int K, int N, unsigned char* dst, int mode, LAS float* tile, int wg, int G, int tid) {
    LAUNDER(tid);
    const int tn = N / 64, nt = (K / 128) * tn; const int r = tid >> 4, c4 = (tid & 15) * 4;
    float4 v[4];
#pragma unroll
    for (int i = 0; i < 4; ++i) v[i] = make_float4(0.f, 0.f, 0.f, 0.f);
    if (wg < nt) { const float* sp = src + (size_t)((wg / tn) * 128 + r) * N + (wg % tn) * 64 + c4;
#pragma unroll
        for (int i = 0; i < 4; ++i) v[i] = *(const float4*)(sp + (size_t)(32 * i) * N); }
    for (int t = wg; t < nt; t += G) {
        const int k0 = (t / tn) * 128, n0 = (t % tn) * 64;
#pragma unroll
        for (int i = 0; i < 4; ++i) { LAS float* tp = tile + (r + 32 * i) * 65 + c4; tp[0] = v[i].x; tp[1] = v[i].y; tp[2] = v[i].z; tp[3] = v[i].w; }
        if (t + G < nt) { const float* sp = src + (size_t)(((t + G) / tn) * 128 + r) * N + ((t + G) % tn) * 64 + c4;
#pragma unroll
            for (int i = 0; i < 4; ++i) v[i] = *(const float4*)(sp + (size_t)(32 * i) * N); }
        __syncthreads();
        { const int n = tid >> 3, kg = (tid & 7) * 16; float x[16];
#pragma unroll
          for (int q = 0; q < 16; ++q) x[q] = 64.f * tile[(kg + q) * 65 + n];
          const int nn = n0 + n; int drow = mode == 0 ? nn : ((nn >> 7) * 256 + (nn & 127) + (mode == 2 ? 128 : 0));
          { const int c5 = drow & 31; drow = (drow & ~31) + 16 * ((c5 >> 2) & 1) + 4 * (c5 >> 3) + (c5 & 3); }
          *(uint4*)(dst + (size_t)drow * K + k0 + kg) = make_uint4(fp8x4(x[0], x[1], x[2], x[3]), fp8x4(x[4], x[5], x[6], x[7]), fp8x4(x[8], x[9], x[10], x[11]), fp8x4(x[12], x[13], x[14], x[15])); }
        __syncthreads();
    }
}

template <bool ROUTER, bool F8 = ROUTER, bool XBF = true>
__device__ __forceinline__ void phase_rmsnorm(const void* __restrict__ x, const float* __restrict__ gain, bf16_t* xn, const float* __restrict__ rw, const float* __restrict__ rb,
                              int* toke, float2* tokw, int wg, int G, int wid, int lane) {
    LAUNDER(lane);
    constexpr int RB = ROUTER ? 2 : 4;
    float rwv[ROUTER ? 4 : 1][4][NEXP];
    if (ROUTER) {
#pragma unroll
        for (int j = 0; j < 4; ++j)
#pragma unroll
            for (int i = 0; i < 4; ++i) { const float* wr_ = rw + (size_t)(j * 256 + lane * 4 + i) * NEXP; const float4 wa = *(const float4*)wr_, wb = *(const float4*)(wr_ + 4);
                rwv[j][i][0] = wa.x; rwv[j][i][1] = wa.y; rwv[j][i][2] = wa.z; rwv[j][i][3] = wa.w; rwv[j][i][4] = wb.x; rwv[j][i][5] = wb.y; rwv[j][i][6] = wb.z; rwv[j][i][7] = wb.w; } }
    uint2 nx[XBF ? RB : 1][4];
    if (XBF) { const int r0 = (wg * NWAVES + wid) * RB;
        if (r0 < MTOK) {
#pragma unroll
            for (int rr = 0; rr < RB; ++rr)
#pragma unroll
                for (int j = 0; j < 4; ++j) nx[rr][j] = *(const uint2*)((const bf16_t*)x + (size_t)(r0 + rr) * D + j * 256 + lane * 4); } }
    for (int row0 = (wg * NWAVES + wid) * RB; row0 < MTOK; row0 += G * NWAVES * RB) {
        float4 v[RB][4];
#pragma unroll
        for (int rr = 0; rr < RB; ++rr)
#pragma unroll
            for (int j = 0; j < 4; ++j) { const size_t xo = (size_t)(row0 + rr) * D + j * 256 + lane * 4;
                if (XBF) { const uint2 q = nx[rr][j]; v[rr][j] = make_float4(bflo(q.x), bfhi(q.x), bflo(q.y), bfhi(q.y)); } else v[rr][j] = *(const float4*)((const float*)x + xo); }
        if (XBF) { const int r1 = row0 + G * NWAVES * RB;
            if (r1 < MTOK) {
#pragma unroll
                for (int rr = 0; rr < RB; ++rr)
#pragma unroll
                    for (int j = 0; j < 4; ++j) nx[rr][j] = *(const uint2*)((const bf16_t*)x + (size_t)(r1 + rr) * D + j * 256 + lane * 4); } }
#pragma unroll
        for (int rr = 0; rr < RB; ++rr) { const int row = row0 + rr; float ss = 0.f;
#pragma unroll
            for (int j = 0; j < 4; ++j) ss += v[rr][j].x * v[rr][j].x + v[rr][j].y * v[rr][j].y + v[rr][j].z * v[rr][j].z + v[rr][j].w * v[rr][j].w;
            ss = wave_sum(ss);
            const float rstd = rsqrtf(ss * (1.f / D) + EPS);
            float lg[NEXP];
#pragma unroll
            for (int e = 0; e < NEXP; ++e) lg[e] = 0.f;
#pragma unroll
            for (int j = 0; j < 4; ++j) { const float4 g = *(const float4*)(gain + j * 256 + lane * 4);
                const float y0 = v[rr][j].x * rstd * g.x, y1 = v[rr][j].y * rstd * g.y, y2 = v[rr][j].z * rstd * g.z, y3 = v[rr][j].w * rstd * g.w;
                if (F8) *(unsigned*)((unsigned char*)xn + (size_t)row * D + j * 256 + lane * 4) = fp8x4(y0, y1, y2, y3);
                else *(uint2*)(xn + (size_t)row * D + j * 256 + lane * 4) = make_uint2(cvt_pk_bf16(y0, y1), cvt_pk_bf16(y2, y3));
                if (ROUTER) { const float ys[4] = {y0, y1, y2, y3};
#pragma unroll
                    for (int i = 0; i < 4; ++i)
#pragma unroll
                        for (int e = 0; e < NEXP; ++e) lg[e] += ys[i] * rwv[ROUTER ? j : 0][i][e]; } }
            if (ROUTER) {
#pragma unroll
                for (int e = 0; e < NEXP; ++e) lg[e] = wave_sum(lg[e]) + rb[e];
                int i0 = 0; float l0 = lg[0];
#pragma unroll
                for (int e = 1; e < NEXP; ++e) if (lg[e] > l0) { l0 = lg[e]; i0 = e; }
                int i1 = -1; float l1 = -3.4e38f;
#pragma unroll
                for (int e = 0; e < NEXP; ++e) if (e != i0 && lg[e] > l1) { l1 = lg[e]; i1 = e; }
                const float w0 = __builtin_amdgcn_rcpf(1.f + __expf(l1 - l0));
                if (lane == 0) { toke[row] = i0 | (i1 << 8); tokw[row] = make_float2(w0, 1.f - w0); }
            }
        }
    }
}

__device__ void phase_combine(const bf16_t* GH, bf16_t* mix, int wg, int G, int tid) {
    LAUNDER(tid);
    for (size_t v = (size_t)wg * NTHREADS + tid; v < (size_t)MTOK * (D / 8); v += (size_t)G * NTHREADS) {
        const size_t r = v / (D / 8); const int c = (int)(v % (D / 8)) * 8; const bf16_t* gp = GH + r * GCOLS + c;
        const uint4 a = *(const uint4*)gp, b = *(const uint4*)(gp + 1024), cc = *(const uint4*)(gp + 2048); uint4 o;
        o.x = cvt_pk_bf16(bflo(a.x) + bflo(b.x) + bflo(cc.x), bfhi(a.x) + bfhi(b.x) + bfhi(cc.x));
        o.y = cvt_pk_bf16(bflo(a.y) + bflo(b.y) + bflo(cc.y), bfhi(a.y) + bfhi(b.y) + bfhi(cc.y));
        o.z = cvt_pk_bf16(bflo(a.z) + bflo(b.z) + bflo(cc.z), bfhi(a.z) + bfhi(b.z) + bfhi(cc.z));
        o.w = cvt_pk_bf16(bflo(a.w) + bflo(b.w) + bflo(cc.w), bfhi(a.w) + bfhi(b.w) + bfhi(cc.w));
        *(uint4*)(mix + r * D + c) = o;
    }
}

__device__ __forceinline__ void moe_assign(const int* toke, const float2* tokw, int* meta, int* stok, float* sw, int* blke, LAS unsigned char* lds, int tid, int part) {
    LAS int* cnt = (LAS int*)lds;
    LAS int* tot = cnt + 512 * 16;
    LAS int* segt = tot + 32;
    const int t0 = tid * (MTOK / NTHREADS);
    int4 e4[16];
#pragma unroll
    for (int i = 0; i < 16; ++i) e4[i] = *(const int4*)(toke + t0 + 4 * i);
    { int z = 0; asm volatile("" : "+v"(z));
      for (int j = 0; j < 16; ++j) cnt[tid * 16 + j] = z; }
#pragma unroll
    for (int i = 0; i < 16; ++i) { const int ev[4] = {e4[i].x, e4[i].y, e4[i].z, e4[i].w};
#pragma unroll
        for (int q = 0; q < 4; ++q) { cnt[tid * 16 + (ev[q] & 255)] += 1; cnt[tid * 16 + 8 + ((ev[q] >> 8) & 255)] += 1; } }
    __syncthreads();
    const int cj = tid & 15, cseg = tid >> 4;
    { int s = 0; for (int i = 0; i < 16; ++i) s += cnt[(cseg * 16 + i) * 16 + cj]; segt[cseg * 16 + cj] = s; }
    __syncthreads();
    if (tid < 16) { int run = 0; for (int sg = 0; sg < 32; ++sg) { const int v = segt[sg * 16 + tid]; segt[sg * 16 + tid] = run; run += v; } tot[tid] = run; }
    __syncthreads();
    { int run = segt[cseg * 16 + cj]; for (int i = 0; i < 16; ++i) { const int idx = (cseg * 16 + i) * 16 + cj; const int v = cnt[idx]; cnt[idx] = run; run += v; } }
    if (tid == 0) { int run = 0; for (int j = 0; j < 16; ++j) { const int n = tot[j], pad = (n + 255) & ~255; tot[16 + j] = run; if (j == 8) { meta[0] = run; meta[3] = run; } run += pad; } meta[1] = run - tot[16 + 8]; meta[2] = 0; meta[4] = run; }
    __syncthreads();
    for (int bk = tid; bk < 2 * MOE_MAXBLK; bk += NTHREADS) { int ex = 0;
        for (int j = 0; j < 16; ++j) { const int base = tot[16 + j], pad = (tot[j] + 255) & ~255; if (bk * 256 >= base && bk * 256 < base + pad) ex = j & 7; }
        blke[bk] = ex; }
    const int cls = part & 1, half = part >> 1;
    if ((tid >> 8) == half) {
        for (int j = 0; j < 8; ++j) cnt[tid * 16 + 8 * cls + j] += tot[16 + 8 * cls + j];
#pragma unroll
        for (int i = 0; i < 16; ++i) { const int ev[4] = {e4[i].x, e4[i].y, e4[i].z, e4[i].w}; const float4 wa = *(const float4*)(tokw + t0 + 4 * i), wb = *(const float4*)(tokw + t0 + 4 * i + 2);
            const float wv[4] = {cls ? wa.y : wa.x, cls ? wa.w : wa.z, cls ? wb.y : wb.x, cls ? wb.w : wb.z};
#pragma unroll
            for (int q = 0; q < 4; ++q) { const int j = cls ? 8 + ((ev[q] >> 8) & 255) : (ev[q] & 255); const int pp = cnt[tid * 16 + j]; cnt[tid * 16 + j] = pp + 1; stok[pp] = t0 + 4 * i + q; sw[pp] = wv[q]; } } }
    if (half == 0) for (int j = 8 * cls; j < 8 * cls + 8; ++j) { const int n = tot[j], pad = (n + 255) & ~255, base = tot[16 + j]; for (int i = n + tid; i < pad; i += NTHREADS) { stok[base + i] = -1; sw[base + i] = 0.f; } }
}
__device__ __forceinline__ void moe_gather(const unsigned char* xn8, const int* stok, int rows, unsigned char* xs8, int wg, int G, int wid, int lane) {
    LAUNDER(lane);
    for (int r0 = (wg * NWAVES + wid) * 4; r0 < rows; r0 += G * NWAVES * 4) {
        int tok[4]; uint4 a[4];
#pragma unroll
        for (int i = 0; i < 4; ++i) tok[i] = __hip_atomic_load(stok + r0 + i, __ATOMIC_RELAXED, __HIP_MEMORY_SCOPE_AGENT);
#pragma unroll
        for (int i = 0; i < 4; ++i) { a[i] = make_uint4(0, 0, 0, 0); if (tok[i] >= 0) a[i] = *((const uint4*)(xn8 + (size_t)tok[i] * D) + lane); }
#pragma unroll
        for (int i = 0; i < 4; ++i) *((uint4*)(xs8 + (size_t)(r0 + i) * D) + lane) = a[i]; }
}

typedef pg8::bf16x8 bf16x8;
typedef unsigned u32x2 __attribute__((ext_vector_type(2)));
#define MFMA16(A, B, C) __builtin_amdgcn_mfma_f32_16x16x32_bf16((A), (B), (C), 0, 0, 0)
__device__ __forceinline__ bf16x8 mk8(unsigned a, unsigned b, unsigned c, unsigned d) { u32x4 v = {a, b, c, d}; return __builtin_bit_cast(bf16x8, v); }

constexpr int H_QD = 0, H_KD = 9216, H_KB = 18432, H_QG = 23040, H_KET = 31744, H_VT = 44032, H_PM = 56320, H_TP = 59392, H_GE = 61440;
constexpr size_t HG_DUMP_BYTES = (size_t)MTOK * 512 * 2, HG_U_BYTES = (size_t)256 * 128 * 128 * 2;
__device__ __forceinline__ void phase_hgrn_a(const bf16_t* P, bf16_t* qsc  , uint2* dump, bf16_t* U  , float* Dsc, LAS unsigned char* lds, int wg, int G, int tid, int wid, int lane) {
    LAUNDER(tid); LAUNDER(lane);
    const int d = tid & 127, part = tid >> 7, g = lane >> 4, c16 = lane & 15;
    LAS float* TP = (LAS float*)(lds + H_TP); LAS float* GE = (LAS float*)(lds + H_GE);
    for (int item = wg; item < 256; item += G) {
        const int b = item >> 6, h = (item >> 4) & 3, sc = item & 15; const size_t tok0 = (size_t)b * SEQ + (size_t)sc * 512;
        f32x4 S[8];
#pragma unroll
        for (int i = 0; i < 8; ++i) S[i] = (f32x4){0.f, 0.f, 0.f, 0.f};
        float gsc = 0.f;
        unsigned lfv[8], qv[8], vv[8];
        { const bf16_t* base = P + (tok0 + 8 * part) * PCOLS + h * 128 + d;
#pragma unroll
          for (int j = 0; j < 8; ++j) { lfv[j] = base[(size_t)j * PCOLS + C_HF]; qv[j] = base[(size_t)j * PCOLS + C_HQ]; vv[j] = base[(size_t)j * PCOLS + C_HI]; } }
        for (int c = 0; c < 16; ++c) {
            float gl[8], lf[8], qf[8]; unsigned vb[8]; float run = 0.f;
#pragma unroll
            for (int j = 0; j < 8; ++j) { lf[j] = bf2f(lfv[j]); qf[j] = bf2f(qv[j]); vb[j] = vv[j]; run += lf[j]; gl[j] = run; }
            if (c < 15) { const bf16_t* base = P + (tok0 + (c + 1) * 32 + 8 * part) * PCOLS + h * 128 + d;
#pragma unroll
                for (int j = 0; j < 8; ++j) { lfv[j] = base[(size_t)j * PCOLS + C_HF]; qv[j] = base[(size_t)j * PCOLS + C_HQ]; vv[j] = base[(size_t)j * PCOLS + C_HI]; } }
            TP[part * 128 + d] = run;
            __syncthreads();
            const float t0 = TP[d], t1 = TP[128 + d], t2 = TP[256 + d], t3 = TP[384 + d];
            const float T0 = t0 + t1, gend = T0 + t2 + t3;
            const float pre = (part == 1) ? t0 : (part == 3) ? t2 : 0.f, gb = (part >> 1) ? T0 : 0.f;
            unsigned kep[4];
#pragma unroll
            for (int j = 0; j < 8; j += 2) {
                float ke2[2];
#pragma unroll
                for (int jj = 0; jj < 2; ++jj) { const int t = 8 * part + j + jj; const float Gl = pre + gl[j + jj], Gt = gb + Gl; const float k = 1.f - __expf(lf[j + jj]), q = qf[j + jj];
                    *(LAS bf16_t*)(lds + H_QD + t * 288 + d * 2) = f2bf(q * __expf(Gl));
                    *(LAS bf16_t*)(lds + H_KD + t * 288 + d * 2) = f2bf(k * __expf(fminf(-Gl, 80.f)));
                    if (part < 2) *(LAS bf16_t*)(lds + H_KB + t * 288 + d * 2) = f2bf(k * __expf(T0 - Gl));
                    *(LAS bf16_t*)(lds + H_QG + t * 272 + d * 2) = f2bf(q * __expf(Gt));
                    qsc[(tok0 + c * 32 + t) * 512 + h * 128 + d] = f2bf(q * __expf(gsc + Gt));
                    ke2[jj] = k * __expf(gend - Gt); }
                kep[j >> 1] = cvt_pk_bf16(ke2[0], ke2[1]); }
            *(LAS u32x4*)(lds + H_KET + d * 96 + part * 16) = (u32x4){kep[0], kep[1], kep[2], kep[3]};
            *(LAS u32x4*)(lds + H_VT + d * 96 + part * 16) = (u32x4){vb[0] | (vb[1] << 16), vb[2] | (vb[3] << 16), vb[4] | (vb[5] << 16), vb[6] | (vb[7] << 16)};
            if (part == 0) GE[d] = __expf(gend);
            gsc += gend;
            __syncthreads();
            if (wid < 3) { const int I = (wid == 0) ? 0 : 1, J = (wid == 2) ? 0 : I; f32x4 acc = {0.f, 0.f, 0.f, 0.f};
#pragma unroll
                for (int kk = 0; kk < 4; ++kk) { const bf16x8 A = *(const LAS bf16x8*)(lds + H_QD + (16 * I + c16) * 288 + kk * 64 + g * 16);
                    const bf16x8 B = (wid == 2) ? *(const LAS bf16x8*)(lds + H_KB + c16 * 288 + kk * 64 + g * 16) : *(const LAS bf16x8*)(lds + H_KD + (16 * J + c16) * 288 + kk * 64 + g * 16);
                    acc = MFMA16(A, B, acc); }
#pragma unroll
                for (int r = 0; r < 4; ++r) { const int t = 4 * g + r; const float v = (I == J && c16 > t) ? 0.f : acc[r]; *(LAS bf16_t*)(lds + H_PM + (16 * I + t) * 96 + (16 * J + c16) * 2) = f2bf(v); }
            } else if (wid == 3) {
#pragma unroll
                for (int r = 0; r < 4; ++r) *(LAS bf16_t*)(lds + H_PM + (4 * g + r) * 96 + (16 + c16) * 2) = (bf16_t)0;
            }
            __syncthreads();
            { const bf16x8 Bv = *(const LAS bf16x8*)(lds + H_VT + (16 * wid + c16) * 96 + g * 16);
              unsigned sp[8][2];
#pragma unroll
              for (int i = 0; i < 8; ++i) { sp[i][0] = cvt_pk_bf16(S[i][0], S[i][1]); sp[i][1] = cvt_pk_bf16(S[i][2], S[i][3]); }
              const size_t chunk_g = (tok0 >> 5) + c;
#pragma unroll
              for (int rt = 0; rt < 2; ++rt) { f32x4 o = {0.f, 0.f, 0.f, 0.f};
                  o = MFMA16(*(const LAS bf16x8*)(lds + H_PM + (16 * rt + c16) * 96 + g * 16), Bv, o);
#pragma unroll
                  for (int kk = 0; kk < 4; ++kk) { const LAS unsigned char* qp = lds + H_QG + (16 * rt + c16) * 272 + (32 * kk + 4 * g) * 2;
                      const u32x2 lo = *(const LAS u32x2*)qp, hi = *(const LAS u32x2*)(qp + 32);
                      o = MFMA16(mk8(lo.x, lo.y, hi.x, hi.y), mk8(sp[2 * kk][0], sp[2 * kk][1], sp[2 * kk + 1][0], sp[2 * kk + 1][1]), o); }
                  dump[(((chunk_g * 4 + h) * 2 + rt) * 8 + wid) * 64 + lane] = make_uint2(cvt_pk_bf16(o[0], o[1]), cvt_pk_bf16(o[2], o[3])); }
#pragma unroll
              for (int i = 0; i < 8; ++i) { const f32x4 dec = *(const LAS f32x4*)(lds + H_GE + (16 * i + 4 * g) * 4); S[i] = S[i] * dec;
                  S[i] = MFMA16(*(const LAS bf16x8*)(lds + H_KET + (16 * i + c16) * 96 + g * 16), Bv, S[i]); } }
            __syncthreads();
        }
#pragma unroll
        for (int i = 0; i < 8; ++i)
#pragma unroll
            for (int r = 0; r < 4; ++r) U[((size_t)item * 128 + 16 * i + 4 * g + r) * 128 + 16 * wid + c16] = f2bf(S[i][r]);
        if (part == 0) Dsc[item * 128 + d] = __expf(gsc);
    }
}
constexpr int HC_SIN = 0;
__device__ __forceinline__ void phase_hgrn_c(const bf16_t* P, bf16_t* qoa  , const uint2* dump, const bf16_t* U, const float* Dsc, const float* gain, LAS unsigned char* lds, int wg, int G, int tid, int wid, int lane, unsigned long long* ts = nullptr) {
    LAUNDER(tid); LAUNDER(lane);
    const int g = lane >> 4, c16 = lane & 15;
    if (ts && tid == 0) ts[26] = __builtin_amdgcn_s_memrealtime();
    for (int item = wg; item < 256; item += G) {
        const int b = item >> 6, h = (item >> 4) & 3, sc = item & 15; const size_t tok0 = (size_t)b * SEQ + (size_t)sc * 512;
        bf16x8 An[4]; uint2 oln[8]; unsigned hgn[8][4];
#define HC_LOAD(rtile_) do { const size_t row0_ = tok0 + 64 * wid + 16 * (rtile_); const size_t cg_ = (tok0 >> 5) + 2 * wid + ((rtile_) >> 1); const int rt_ = (rtile_) & 1; \
            _Pragma("unroll") for (int kk = 0; kk < 4; ++kk) An[kk] = *(const bf16x8*)(qoa + (row0_ + c16) * 512 + h * 128 + 32 * kk + 8 * g); \
            _Pragma("unroll") for (int vt = 0; vt < 8; ++vt) oln[vt] = dump[(((cg_ * 4 + h) * 2 + rt_) * 8 + vt) * 64 + lane]; \
            _Pragma("unroll") for (int vt = 0; vt < 8; ++vt) _Pragma("unroll") for (int r = 0; r < 4; ++r) hgn[vt][r] = P[(row0_ + 4 * g + r) * PCOLS + C_HG + h * 128 + 16 * vt + c16]; } while (0)
        float gnv[8];
#pragma unroll
        for (int vt = 0; vt < 8; ++vt) gnv[vt] = gain[16 * vt + c16];
        HC_LOAD(0);
#pragma unroll 1
        for (int kq = 0; kq < 2; ++kq) { float s[16];
#pragma unroll
          for (int k = 0; k < 16; ++k) s[k] = 0.f;
          for (int j0 = 0; j0 < sc; j0 += 8) {
              uint4 uu[8][2]; float dd[8][2];
#pragma unroll
              for (int u = 0; u < 8; ++u) { const bool on = j0 + u < sc; const size_t it = on ? (size_t)(item - sc + j0 + u) : (size_t)item;
#pragma unroll
                  for (int k = 0; k < 2; ++k) { const int e0 = 8 * (tid + 512 * (kq * 2 + k)); uu[u][k] = *(const uint4*)(U + it * 16384 + e0); dd[u][k] = Dsc[it * 128 + (e0 >> 7)]; } }
#pragma unroll
              for (int u = 0; u < 8; ++u) { const bool on = j0 + u < sc;
#pragma unroll
                  for (int k = 0; k < 2; ++k) { const float d1 = on ? dd[u][k] : 1.f; const uint4 x = on ? uu[u][k] : make_uint4(0u, 0u, 0u, 0u);
                      s[8 * k + 0] = d1 * s[8 * k + 0] + bflo(x.x); s[8 * k + 1] = d1 * s[8 * k + 1] + bfhi(x.x); s[8 * k + 2] = d1 * s[8 * k + 2] + bflo(x.y); s[8 * k + 3] = d1 * s[8 * k + 3] + bfhi(x.y);
                      s[8 * k + 4] = d1 * s[8 * k + 4] + bflo(x.z); s[8 * k + 5] = d1 * s[8 * k + 5] + bfhi(x.z); s[8 * k + 6] = d1 * s[8 * k + 6] + bflo(x.w); s[8 * k + 7] = d1 * s[8 * k + 7] + bfhi(x.w); } } }
#pragma unroll
          for (int k = 0; k < 2; ++k) { const int e0 = 8 * (tid + 512 * (kq * 2 + k));
#pragma unroll
              for (int i = 0; i < 8; ++i) { const int e = e0 + i; *(LAS bf16_t*)(lds + HC_SIN + (e & 127) * 288 + (e >> 7) * 2) = f2bf(s[8 * k + i]); } } }
        __syncthreads();
        if (ts && tid == 0) ts[27] = __builtin_amdgcn_s_memrealtime();
#pragma unroll
        for (int rtile = 0; rtile < 4; ++rtile) {
            const size_t row0 = tok0 + 64 * wid + 16 * rtile;
            bf16x8 A[4]; uint2 olc[8]; unsigned hgv[8][4];
#pragma unroll
            for (int kk = 0; kk < 4; ++kk) A[kk] = An[kk];
#pragma unroll
            for (int vt = 0; vt < 8; ++vt) { olc[vt] = oln[vt];
#pragma unroll
                for (int r = 0; r < 4; ++r) hgv[vt][r] = hgn[vt][r]; }
            if (rtile + 1 < 4) HC_LOAD(rtile + 1);
            asm volatile("" ::: "memory");
            f32x4 acc[8]; float ss[4] = {0.f, 0.f, 0.f, 0.f};
#pragma unroll
            for (int vt = 0; vt < 8; ++vt) { acc[vt] = (f32x4){0.f, 0.f, 0.f, 0.f};
#pragma unroll
                for (int kk = 0; kk < 4; ++kk) acc[vt] = MFMA16(A[kk], *(const LAS bf16x8*)(lds + HC_SIN + (16 * vt + c16) * 288 + (32 * kk + 8 * g) * 2), acc[vt]);
                const uint2 ol = olc[vt];
                acc[vt][0] += bflo(ol.x); acc[vt][1] += bfhi(ol.x); acc[vt][2] += bflo(ol.y); acc[vt][3] += bfhi(ol.y);
#pragma unroll
                for (int r = 0; r < 4; ++r) ss[r] += acc[vt][r] * acc[vt][r]; }
            float rstd[4];
#pragma unroll
            for (int r = 0; r < 4; ++r) { float s = ss[r]; s += xor_f<1>(s); s += xor_f<2>(s); s += xor_f<4>(s); s += xor_f<8>(s); rstd[r] = rsqrtf(s * (1.f / 128.f) + EPS); }
#pragma unroll
            for (int vt = 0; vt < 8; ++vt) { const float gn = gnv[vt];
#pragma unroll
                for (int r = 0; r < 4; ++r) { const size_t row = row0 + 4 * g + r;
                    qoa[row * 512 + h * 128 + 16 * vt + c16] = f2bf(acc[vt][r] * rstd[r] * gn * bf2f(hgv[vt][r])); } }
        }
#undef HC_LOAD
        if (ts && tid == 0) { asm volatile("s_waitcnt vmcnt(0)" ::: "memory"); ts[28] = __builtin_amdgcn_s_memrealtime(); }
        __syncthreads();
    }
}

constexpr int GM_VT = 0, GM_W = 36864, GM_RS = 73728;
__device__ __forceinline__ void phase_gmlp(const bf16_t* P, const float* __restrict__ ws_l, const float* __restrict__ bs_l, const float* __restrict__ gv_l, bf16_t* ob, LAS unsigned char* lds, int wg, int G, int tid, int wid, int lane) {
    LAUNDER(tid); LAUNDER(lane);
    const int g = lane >> 4, c16 = lane & 15; LAS float* RS = (LAS float*)(lds + GM_RS);
    for (int item = wg; item < MTOK / 128; item += G) {
        const size_t tok0 = (size_t)item * 128;
        uint4 xq[4]; float4 waq[4], wbq[4];
#define GM_LOAD(grp_) do { _Pragma("unroll") for (int ps = 0; ps < 4; ++ps) { const int idx = tid + ps * 512, s = idx >> 4, c8 = (idx & 15) * 8; xq[ps] = *(const uint4*)(P + (tok0 + s) * PCOLS + C_GV + (grp_) * 128 + c8); \
            waq[ps] = *(const float4*)(ws_l + (size_t)(grp_) * 16384 + s * 128 + c8); wbq[ps] = *(const float4*)(ws_l + (size_t)(grp_) * 16384 + s * 128 + c8 + 4); } } while (0)
        GM_LOAD(0);
        { const int s = tid >> 2, qd = tid & 3; const bf16_t* rp = P + (tok0 + s) * PCOLS + C_GV + qd * 128; float ss = 0.f;
#pragma unroll
          for (int j = 0; j < 16; ++j) { const uint4 x = *(const uint4*)(rp + j * 8); ss += bflo(x.x) * bflo(x.x) + bfhi(x.x) * bfhi(x.x) + bflo(x.y) * bflo(x.y) + bfhi(x.y) * bfhi(x.y) + bflo(x.z) * bflo(x.z) + bfhi(x.z) * bfhi(x.z) + bflo(x.w) * bflo(x.w) + bfhi(x.w) * bfhi(x.w); }
          ss += xor_f<1>(ss); ss += xor_f<2>(ss); if (qd == 0) RS[s] = rsqrtf(ss * (1.f / 512.f) + EPS); }
        for (int grp = 0; grp < 4; ++grp) {
            __syncthreads();
#pragma unroll
            for (int ps = 0; ps < 4; ++ps) { const int idx = tid + ps * 512, s = idx >> 4, c8 = (idx & 15) * 8; const uint4 x = xq[ps];
                const float rs = RS[s]; const float4 ga = *(const float4*)(gv_l + grp * 128 + c8), gb = *(const float4*)(gv_l + grp * 128 + c8 + 4);
                const float e[8] = {bflo(x.x) * rs * ga.x, bfhi(x.x) * rs * ga.y, bflo(x.y) * rs * ga.z, bfhi(x.y) * rs * ga.w, bflo(x.z) * rs * gb.x, bfhi(x.z) * rs * gb.y, bflo(x.w) * rs * gb.z, bfhi(x.w) * rs * gb.w};
#pragma unroll
                for (int i = 0; i < 8; ++i) *(LAS bf16_t*)(lds + GM_VT + (c8 + i) * 288 + s * 2) = f2bf(e[i]);
                const int t = idx >> 4, s8 = (idx & 15) * 8; const float4 wa = waq[ps], wb = wbq[ps];
                *(LAS u32x4*)(lds + GM_W + t * 288 + s8 * 2) = (u32x4){cvt_pk_bf16(s8 + 0 <= t ? wa.x : 0.f, s8 + 1 <= t ? wa.y : 0.f), cvt_pk_bf16(s8 + 2 <= t ? wa.z : 0.f, s8 + 3 <= t ? wa.w : 0.f),
                                                                    cvt_pk_bf16(s8 + 4 <= t ? wb.x : 0.f, s8 + 5 <= t ? wb.y : 0.f), cvt_pk_bf16(s8 + 6 <= t ? wb.z : 0.f, s8 + 7 <= t ? wb.w : 0.f)}; }
            if (grp + 1 < 4) GM_LOAD(grp + 1);
            __syncthreads();
            unsigned guv[4][8];
#pragma unroll
            for (int r = 0; r < 4; ++r)
#pragma unroll
                for (int ct = 0; ct < 8; ++ct) guv[r][ct] = P[(tok0 + 16 * wid + 4 * g + r) * PCOLS + C_GU + grp * 128 + 16 * ct + c16];
            f32x4 acc[8];
#pragma unroll
            for (int ct = 0; ct < 8; ++ct) acc[ct] = (f32x4){0.f, 0.f, 0.f, 0.f};
            for (int kk = 0; kk <= (wid >> 1); ++kk) { const bf16x8 A = *(const LAS bf16x8*)(lds + GM_W + (16 * wid + c16) * 288 + kk * 64 + g * 16);
#pragma unroll
                for (int ct = 0; ct < 8; ++ct) acc[ct] = MFMA16(A, *(const LAS bf16x8*)(lds + GM_VT + (16 * ct + c16) * 288 + kk * 64 + g * 16), acc[ct]); }
#pragma unroll
            for (int r = 0; r < 4; ++r) { const int t = 16 * wid + 4 * g + r; const float bias = bs_l[grp * 128 + t]; const size_t tok = tok0 + t;
#pragma unroll
                for (int ct = 0; ct < 8; ++ct) { const int ch = grp * 128 + 16 * ct + c16; ob[tok * 512 + ch] = f2bf(bf2f(guv[r][ct]) * (acc[ct][r] + bias)); } }
        }
        __syncthreads();
#undef GM_LOAD
    }
}

constexpr int AT_KL = 0, AT_VT = 10240, AT_MIN = 10240 + 64 * 144, AT_BUF = 19968;
template <bool DIAG>
__device__ __forceinline__ void attn_block(LAS unsigned char* lds, const bf16x8 (&Bq)[2], f32x4 (&O)[4], float& carry, int sb0, int t, int g, int c16, unsigned tri_lo, unsigned tri_hi, unsigned ONES, unsigned ZERO) {
    f32x4 z[4]; unsigned hi[4][2];
#pragma unroll
    for (int st = 0; st < 4; ++st) { z[st] = (f32x4){0.f, 0.f, 0.f, 0.f};
#pragma unroll
        for (int kk = 0; kk < 2; ++kk) z[st] = MFMA16(*(const LAS bf16x8*)(lds + AT_KL + (16 * st + c16) * 160 + kk * 64 + g * 16), Bq[kk], z[st]);
        float spv[4];
#pragma unroll
        for (int r = 0; r < 4; ++r) { const float sp = __builtin_amdgcn_logf(1.f + __builtin_amdgcn_exp2f(z[st][r])); spv[r] = (!DIAG || (sb0 + 16 * st + 4 * g + r < t)) ? sp : 0.f; }
        hi[st][0] = cvt_pk_bf16(spv[0], spv[1]); hi[st][1] = cvt_pk_bf16(spv[2], spv[3]); }
    f32x4 sf[4];
#pragma unroll
    for (int so = 0; so < 4; ++so) { sf[so] = (f32x4){0.f, 0.f, 0.f, 0.f};
#pragma unroll
        for (int kk = 0; kk < 2; ++kk) { if (2 * kk + 1 < so) continue;
            const unsigned a0 = (2 * kk > so) ? ONES : (2 * kk == so) ? tri_lo : ZERO, a1 = (2 * kk > so) ? ONES : (2 * kk == so) ? tri_hi : ZERO;
            const unsigned a2 = (2 * kk + 1 > so) ? ONES : tri_lo, a3 = (2 * kk + 1 > so) ? ONES : tri_hi;
            sf[so] = MFMA16(mk8(a0, a1, a2, a3), mk8(hi[2 * kk][0], hi[2 * kk][1], hi[2 * kk + 1][0], hi[2 * kk + 1][1]), sf[so]); } }
    unsigned pa[4][2];
#pragma unroll
    for (int st = 0; st < 4; ++st) { float av[4];
#pragma unroll
        for (int r = 0; r < 4; ++r) { const float a = __builtin_amdgcn_exp2f(z[st][r] - carry - sf[st][r]); av[r] = (!DIAG || (sb0 + 16 * st + 4 * g + r < t)) ? a : 0.f; }
        pa[st][0] = cvt_pk_bf16(av[0], av[1]); pa[st][1] = cvt_pk_bf16(av[2], av[3]); }
#pragma unroll
    for (int kk = 0; kk < 2; ++kk) { const bf16x8 Aop = mk8(pa[2 * kk][0], pa[2 * kk][1], pa[2 * kk + 1][0], pa[2 * kk + 1][1]);
#pragma unroll
        for (int dt = 0; dt < 4; ++dt) { const int ky = 32 * kk + (((4 * g) ^ ((c16 >> 3) << 2)) ^ ((8 * dt) & 28));
            const LAS unsigned char* vr = lds + AT_VT + (16 * dt + c16) * 144; const u32x2 v0 = *(const LAS u32x2*)(vr + ky * 2), v1 = *(const LAS u32x2*)(vr + (ky ^ 16) * 2);
            O[dt] = MFMA16(Aop, mk8(v0.x, v0.y, v1.x, v1.y), O[dt]); } }
    carry += bperm_f(sf[0][0], c16);
}
__device__ __forceinline__ void phase_attn(const bf16_t* P, const float* __restrict__ gq, const float* __restrict__ gk, bf16_t* oc, LAS unsigned char* lds, int wg, int G, int tid, int wid, int lane) {
    LAUNDER(tid); LAUNDER(lane);
    const int g = lane >> 4, c16 = lane & 15; int itg = 0;
    unsigned ONES = 0x3F803F80u, ZERO = 0u; LAUNDER(ONES); LAUNDER(ZERO);
    const unsigned tri_lo = ((4 * g + 0 >= c16) ? 0x3F80u : 0u) | ((4 * g + 1 >= c16) ? 0x3F800000u : 0u), tri_hi = ((4 * g + 2 >= c16) ? 0x3F80u : 0u) | ((4 * g + 3 >= c16) ? 0x3F800000u : 0u);
    for (int item = wg; item < NB * 8 * (SEQ / 128); item += G) {
        const int qt = item & 63, h = (item >> 6) & 7, b = item >> 9; const int t0 = qt * 128, tq0 = t0 + 16 * wid, t = tq0 + c16; const size_t tokb = (size_t)b * SEQ;
        bf16x8 Bq[2];
        { const bf16_t* qp = P + (tokb + t) * PCOLS + C_SQ + h * 64; const uint4 x0 = *(const uint4*)(qp + 8 * g), x1 = *(const uint4*)(qp + 32 + 8 * g);
          float e[16] = {bflo(x0.x), bfhi(x0.x), bflo(x0.y), bfhi(x0.y), bflo(x0.z), bfhi(x0.z), bflo(x0.w), bfhi(x0.w), bflo(x1.x), bfhi(x1.x), bflo(x1.y), bfhi(x1.y), bflo(x1.z), bfhi(x1.z), bflo(x1.w), bfhi(x1.w)};
          float ss = 0.f;
#pragma unroll
          for (int i = 0; i < 16; ++i) ss += e[i] * e[i];
          ss += xor_f<16>(ss); ss += bperm_f(ss, lane ^ 32);
          const float rq = rsqrtf(ss * (1.f / 64.f) + EPS) * (0.125f * 1.4426950408889634f);
#pragma unroll
          for (int i = 0; i < 16; ++i) { const int dd = (i < 8 ? 8 * g + i : 32 + 8 * g + (i - 8)); e[i] = e[i] * rq * gq[dd] * gk[dd]; }
          Bq[0] = mk8(cvt_pk_bf16(e[0], e[1]), cvt_pk_bf16(e[2], e[3]), cvt_pk_bf16(e[4], e[5]), cvt_pk_bf16(e[6], e[7]));
          Bq[1] = mk8(cvt_pk_bf16(e[8], e[9]), cvt_pk_bf16(e[10], e[11]), cvt_pk_bf16(e[12], e[13]), cvt_pk_bf16(e[14], e[15])); }
        f32x4 O[4];
#pragma unroll
        for (int i = 0; i < 4; ++i) O[i] = (f32x4){0.f, 0.f, 0.f, 0.f};
        float carry = 0.f, wmin = 0.f;
        const int ks = tid >> 3, kpc = tid & 7;
        const bf16_t* rp0 = P + (tokb + ks) * PCOLS + h * 64 + kpc * 8;
        uint4 kx = *(const uint4*)(rp0 + (size_t)(((t0 + 127) >> 6) * 64) * PCOLS + C_SK), vx = *(const uint4*)(rp0 + (size_t)(((t0 + 127) >> 6) * 64) * PCOLS + C_SV);
        for (int kb = (t0 + 127) >> 6; kb >= 0; --kb) {
            const int sb0 = kb * 64;
            LAS unsigned char* lb = lds + (itg & 1) * AT_BUF; LAS float* MW = (LAS float*)(lb + AT_MIN);
            { const int s = ks, pc = kpc;
              float ke[8] = {bflo(kx.x), bfhi(kx.x), bflo(kx.y), bfhi(kx.y), bflo(kx.z), bfhi(kx.z), bflo(kx.w), bfhi(kx.w)}; float ssk = 0.f;
#pragma unroll
              for (int i = 0; i < 8; ++i) ssk += ke[i] * ke[i];
              ssk += xor_f<1>(ssk); ssk += xor_f<2>(ssk); ssk += xor_f<4>(ssk);
              const float rk = rsqrtf(ssk * (1.f / 64.f) + EPS);
              *(LAS u32x4*)(lb + AT_KL + s * 160 + pc * 16) = (u32x4){cvt_pk_bf16(ke[0] * rk, ke[1] * rk), cvt_pk_bf16(ke[2] * rk, ke[3] * rk), cvt_pk_bf16(ke[4] * rk, ke[5] * rk), cvt_pk_bf16(ke[6] * rk, ke[7] * rk)};
              const unsigned vw[4] = {vx.x, vx.y, vx.z, vx.w};
#pragma unroll
              for (int i = 0; i < 8; ++i) *(LAS bf16_t*)(lb + AT_VT + (pc * 8 + i) * 144 + (s ^ (pc << 2)) * 2) = (bf16_t)((vw[i >> 1] >> ((i & 1) * 16)) & 0xffffu);
              if (kb > 0) { kx = *(const uint4*)(rp0 + (size_t)(sb0 - 64) * PCOLS + C_SK); vx = *(const uint4*)(rp0 + (size_t)(sb0 - 64) * PCOLS + C_SV); } }
            { float mn = carry; mn = fminf(mn, xor_f<1>(mn)); mn = fminf(mn, xor_f<2>(mn)); mn = fminf(mn, xor_f<4>(mn)); mn = fminf(mn, xor_f<8>(mn));
              wmin = __builtin_bit_cast(float, __builtin_amdgcn_readfirstlane(__builtin_bit_cast(int, mn)));
              if (lane == 0) MW[wid] = mn; }
            __syncthreads();
            ++itg;
            float mall = MW[0];
#pragma unroll
            for (int w = 1; w < 8; ++w) mall = fminf(mall, MW[w]);
            if (mall > 150.04f) break;
            if (sb0 < tq0 + 15 && wmin <= 150.04f) {
                if (sb0 + 63 < tq0) attn_block<false>(lb, Bq, O, carry, sb0, t, g, c16, tri_lo, tri_hi, ONES, ZERO);
                else attn_block<true>(lb, Bq, O, carry, sb0, t, g, c16, tri_lo, tri_hi, ONES, ZERO);
            }
        }
#pragma unroll
        for (int dt = 0; dt < 4; ++dt)
#pragma unroll
            for (int r = 0; r < 4; ++r) oc[(tokb + tq0 + 4 * g + r) * 512 + h * 64 + 16 * dt + c16] = f2bf(O[dt][r]);
    }
}

#ifdef MK_CHECK
constexpr size_t WS_DIAG = WS_META + 2048;
constexpr size_t WS_SNAP = WS_BLKE + 4096;
static_assert(WS_SNAP + 64 * 1024 * 4 <= WS_W, "snapshot fits");
__device__ __forceinline__ int samp_row(int i) { return (int)(((unsigned)i * 2654435761u + 12345u) % (unsigned)MTOK); }
__device__ __forceinline__ void chk_fail(unsigned* diag, unsigned code) { atomicMin(diag, code); }
__device__ __forceinline__ bool chk_close(float got, float ref, float atol, float rtol) { return fabsf(got - ref) <= atol + rtol * fabsf(ref) && got == got; }

__global__ void k_diag_init(unsigned* diag) { if (threadIdx.x == 0 && blockIdx.x == 0) { diag[0] = 0xffffffffu; diag[16] = 0u; diag[17] = 0xffffffffu; diag[18] = 0u; diag[19] = 0u; diag[20] = 0u; diag[21] = 0u; diag[22] = 0u; diag[23] = 0u; diag[24] = 0u; diag[25] = 0u; diag[26] = 0u; } }
__global__ void k_snapshot(const float* x, float* snap) { const int i = blockIdx.x; const int r = samp_row(i); for (int c = threadIdx.x; c < D; c += blockDim.x) snap[i * D + c] = x[(size_t)r * D + c]; }
__global__ void k_apply_diag(float* out, const unsigned* diag) {
    if (blockIdx.x != 0 || threadIdx.x != 0) return;
    const unsigned code = diag[0]; if (code == 0xffffffffu) return;
    out[0] = (1.0f + 0.1f * (float)(code > 89u ? 89u : code)) * 1.0e6f;
}
struct ChkGemm { const bf16_t* A; int lda; const float* W; int ldw; int K; int mode; const bf16_t* Cb; int ldc; const float* Cf; const float* xold; const float* W2; const float* lb; const bf16_t* Gsrc; int ncols; unsigned code; int use_snap; };
__global__ void k_chk_gemm(ChkGemm c, unsigned* diag) {
    const int i = blockIdx.x; const int r = samp_row(i);
    for (int cc = threadIdx.x; cc < 96; cc += blockDim.x) {
        const int col = (int)(((unsigned)cc * 40503u + (unsigned)i * 977u) % (unsigned)c.ncols);
        float dot = 0.f, dot2 = 0.f;
        for (int k = 0; k < c.K; ++k) { const float av = bf2f(c.A[(size_t)r * c.lda + k]); dot += av * c.W[(size_t)k * c.ldw + col]; if (c.mode == 4) dot2 += av * c.W2[(size_t)k * c.ldw + col]; }
        float ref, got;
        if (c.mode == 0) { const int kind = col >> 9; ref = (kind == 0 || kind == 3) ? siluf_(dot) : kind == 1 ? __logf(c.lb[col - 512] + (1.f - c.lb[col - 512]) * sigmoidf_(dot)) : (kind == 4 || kind == 5) ? gelu_tanh_(dot) : dot; got = bf2f(c.Cb[(size_t)r * c.ldc + col]); }
        else if (c.mode == 1) { ref = sigmoidf_(dot); got = bf2f(c.Cb[(size_t)r * c.ldc + col]); }
        else if (c.mode == 3) { const float xo = c.use_snap ? c.xold[(size_t)i * D + col] : c.xold[(size_t)r * D + col]; ref = xo + dot; got = c.Cf[(size_t)r * D + col]; }
        else { ref = siluf_(dot) * dot2; got = bf2f(c.Cb[(size_t)r * c.ldc + col]); }
        if (!chk_close(got, ref, 0.03f, 0.03f)) { chk_fail(diag, c.code); if (c.mode == 1) { atomicOr(diag + 24 + (i >> 5), 1u << (i & 31)); atomicOr(diag + 26, 1u << ((r & 255) >> 4)); atomicOr(diag + 20 + ((col & 127) >> 5), 1u << (col & 31)); atomicAdd(diag + 16, 1u); atomicMin(diag + 17, (unsigned)(col >> 8)); atomicMax(diag + 18, (unsigned)(col >> 8)); if (fabsf(got - dot) <= 0.03f + 0.03f * fabsf(dot)) atomicAdd(diag + 19, 1u); } }
    }
}
__global__ void k_chk_branch(const bf16_t* ocat, const float* wbr  , const bf16_t* xn, const float* win  , const bf16_t* GH, unsigned code, unsigned* diag) {
    const int i = blockIdx.x; const int r = samp_row(i);
    for (int cc = threadIdx.x; cc < 96; cc += blockDim.x) {
        const int col = (int)(((unsigned)cc * 40503u + (unsigned)i * 977u) % 3072u); const int b = col >> 10, cl = col & 1023;
        float h = 0.f; for (int k = 0; k < 512; ++k) h += bf2f(ocat[(size_t)b * MTOK * 512 + (size_t)r * 512 + k]) * wbr[((size_t)b * 512 + k) * 1024 + cl];
        float g = 0.f; for (int k = 0; k < 1024; ++k) g += bf2f(xn[(size_t)r * D + k]) * win[(size_t)k * INCOLS + PCOLS + col];
        const float ref = sigmoidf_(g) * h, got = bf2f(GH[(size_t)r * GCOLS + col]);
        if (!chk_close(got, ref, 0.03f, 0.04f)) chk_fail(diag, code);
    }
}
__global__ void k_chk_mix(const bf16_t* ocat, const float* wbr  , const bf16_t* Gt, const bf16_t* mix, unsigned code, unsigned* diag) {
    const int i = blockIdx.x; const int r = samp_row(i);
    for (int cc = threadIdx.x; cc < 96; cc += blockDim.x) {
        const int col = (int)(((unsigned)cc * 40503u + (unsigned)i * 977u) % 1024u); float ref = 0.f;
        for (int b = 0; b < 3; ++b) { float h = 0.f; for (int k = 0; k < 512; ++k) h += bf2f(ocat[(size_t)b * MTOK * 512 + (size_t)r * 512 + k]) * wbr[((size_t)b * 512 + k) * 1024 + col]; ref += bf2f(Gt[(size_t)r * GCOLS + b * 1024 + col]) * h; }
        if (!chk_close(bf2f(mix[(size_t)r * D + col]), ref, 0.03f, 0.04f)) chk_fail(diag, code);
    }
}
__global__ void k_chk_attn(const bf16_t* P, const float* gq, const float* gk, const bf16_t* oc, unsigned code, unsigned* diag) {
    const int id = blockIdx.x, lane = threadIdx.x; const int ti = id % 10;
    const int t = ti == 0 ? 0 : ti == 1 ? 1 : ti == 2 ? 2 : ti == 3 ? 63 : ti == 4 ? 64 : ti == 5 ? 65 : ti == 6 ? 200 : ti == 7 ? 1000 : ti == 8 ? 4097 : 8191;
    const int h = (id / 10) % 8, b = id / 80; const size_t tokb = (size_t)b * SEQ;
    float q = bf2f(P[(tokb + t) * PCOLS + C_SQ + h * 64 + lane]); q = q * rsqrtf(wave_sum(q * q) / 64.f + EPS) * gq[lane];
    float o = 0.f, carry = 0.f;
    for (int s = t - 1; s >= 0 && carry < 300.f; --s) {
        float kv = bf2f(P[(tokb + s) * PCOLS + C_SK + h * 64 + lane]); kv = kv * rsqrtf(wave_sum(kv * kv) / 64.f + EPS) * gk[lane];
        const float z = wave_sum(q * kv) * 0.125f; const float sp = logf(1.f + expf(z));
        carry += sp; const float A = expf(z - carry);
        o += A * bf2f(P[(tokb + s) * PCOLS + C_SV + h * 64 + lane]);
    }
    if (!chk_close(bf2f(oc[(tokb + t) * 512 + h * 64 + lane]), o, 0.02f, 0.03f)) chk_fail(diag, code);
}
__global__ void k_chk_gmlp(const bf16_t* P, const float* ws_l, const float* bs_l, const float* gv_l, const bf16_t* ob, unsigned code, unsigned* diag) {
    const int id = blockIdx.x * blockDim.x + threadIdx.x; if (id >= 512) return;
    const int chunk = (id * 37) % (MTOK / 128), t = (id * 53 + 7) % 128, ch = (id * 101 + 3) % 512, g = ch >> 7, c = ch & 127; const size_t tok0 = (size_t)chunk * 128;
    float acc = 0.f;
    for (int s = 0; s <= t; ++s) { float ss = 0.f; for (int k = 0; k < 512; ++k) { const float v = bf2f(P[(tok0 + s) * PCOLS + C_GV + k]); ss += v * v; }
        const float vn = bf2f(P[(tok0 + s) * PCOLS + C_GV + ch]) * rsqrtf(ss / 512.f + EPS) * gv_l[ch]; acc += ws_l[(size_t)g * 16384 + t * 128 + s] * vn; }
    const float ref = bf2f(P[(tok0 + t) * PCOLS + C_GU + ch]) * (acc + bs_l[g * 128 + t]);
    if (!chk_close(bf2f(ob[(tok0 + t) * 512 + ch]), ref, 0.02f, 0.03f)) chk_fail(diag, code);
}
__global__ void k_chk_hgrn(const bf16_t* P, const float* gain, const bf16_t* oa, unsigned code, unsigned* diag) {
    const int id = blockIdx.x; const int ti = id % 8; const int t = ti == 0 ? 0 : ti == 1 ? 1 : ti == 2 ? 5 : ti == 3 ? 63 : ti == 4 ? 64 : ti == 5 ? 200 : ti == 6 ? 511 : 700, h = (id / 8) % 4, b = id / 32; const int v = threadIdx.x; const size_t tokb = (size_t)b * SEQ;
    float o = 0.f;
    for (int d = 0; d < 128; ++d) { float st = 0.f;
        for (int s = 0; s <= t; ++s) { const bf16_t* row = P + (tokb + s) * PCOLS; const float f = expf(bf2f(row[C_HF + h * 128 + d])); st = f * st + (1.f - f) * bf2f(row[C_HI + h * 128 + v]); }
        o += bf2f(P[(tokb + t) * PCOLS + C_HQ + h * 128 + d]) * st; }
    __shared__ float red[128]; red[v] = o * o; __syncthreads();
    for (int w = 64; w > 0; w >>= 1) { if (v < w) red[v] += red[v + w]; __syncthreads(); }
    const float rstd = rsqrtf(red[0] / 128.f + EPS);
    const float ref = o * rstd * gain[v] * bf2f(P[(tokb + t) * PCOLS + C_HG + h * 128 + v]);
    if (!chk_close(bf2f(oa[(tokb + t) * 512 + h * 128 + v]), ref, 0.03f, 0.04f)) chk_fail(diag, code);
}
__global__ void k_chk_moe(const bf16_t* xn, const float* rw, const float* rb, const float* wg, const float* wu, const float* wd, const float* snap, const float* xout, unsigned code, unsigned* diag) {
    const int i = blockIdx.x; const int r = samp_row(i); const int tid = threadIdx.x;
    __shared__ float hid[DFF]; __shared__ float lg[8]; __shared__ float part[256];
    if (tid < 8) { float a = rb[tid]; for (int k = 0; k < D; ++k) a += bf2f(xn[(size_t)r * D + k]) * rw[k * 8 + tid]; lg[tid] = a; }
    __syncthreads();
    int i0 = 0; for (int e = 1; e < 8; ++e) if (lg[e] > lg[i0]) i0 = e;
    int i1 = -1; for (int e = 0; e < 8; ++e) if (e != i0 && (i1 < 0 || lg[e] > lg[i1])) i1 = e;
    const float w0 = 1.f / (1.f + expf(lg[i1] - lg[i0])), w1 = 1.f - w0;
    float outv[8]; for (int j = 0; j < 8; ++j) outv[j] = 0.f;
    for (int kk = 0; kk < 2; ++kk) { const int e = kk ? i1 : i0; const float wgt = kk ? w1 : w0;
        for (int f = tid; f < DFF; f += blockDim.x) { float g = 0.f, u = 0.f; for (int k = 0; k < D; ++k) { const float xv = bf2f(xn[(size_t)r * D + k]); g += xv * wg[((size_t)e * D + k) * DFF + f]; u += xv * wu[((size_t)e * D + k) * DFF + f]; } hid[f] = siluf_(g) * u; }
        __syncthreads();
        for (int j = 0; j < 8; ++j) { const int col = (j * 131 + i * 17) % D; float p = 0.f; for (int f = tid; f < DFF; f += blockDim.x) p += hid[f] * wd[((size_t)e * DFF + f) * D + col];
            part[tid] = p; __syncthreads(); for (int w = 128; w > 0; w >>= 1) { if (tid < w) part[tid] += part[tid + w]; __syncthreads(); } outv[j] += wgt * part[0]; __syncthreads(); }
    }
    if (tid == 0) for (int j = 0; j < 8; ++j) { const int col = (j * 131 + i * 17) % D; const float ref = snap[(size_t)i * D + col] + outv[j]; if (!chk_close(xout[(size_t)r * D + col], ref, 0.04f, 0.04f)) chk_fail(diag, code); }
}
#endif

struct Args { const float* in[21]; float* out; unsigned char* ws; int lo, hi; };
constexpr int NSTEPS = 25;
__device__ __forceinline__ int laneid_() { int v; asm volatile("v_mbcnt_lo_u32_b32 %0, -1, 0\n\tv_mbcnt_hi_u32_b32 %0, -1, %0" : "=v"(v)); return v; }
#define LANEID (laneid_())

__device__ __forceinline__ int cw_(LAS unsigned* cblk, int i) { unsigned z; asm volatile("v_mov_b32 %0, 0" : "=v"(z)); return (int)__builtin_amdgcn_readfirstlane(((LAS unsigned*)((LAS unsigned char*)cblk + z))[i]); }
#ifndef MK_ALIGN
#define MK_ALIGN true
#endif
#ifndef MK_SP2_F8
#define MK_SP2_F8 true
#endif
#ifndef MK_SP2
#define MK_SP2 true
#endif
#ifndef STAG_IN
#define STAG_IN 0
#define STAG_G 0
#define STAG_GU 0
#define STAG_MGU 0
#endif
#ifndef L1_F8
#define L1_F8 false
#endif
#ifndef FFN_F8
#define FFN_F8 false
#endif
template <class Epi, bool VARNT = false, int NSEG = 1, bool FP8 = false>
__device__ __forceinline__ void run_gemm(LAS unsigned char* lds, const Order& S, int K, const Epi& E, int wid, int stagger = 0) {
    if (stagger && ((S.c >> 3) & 1)) { for (int i = 0; i < stagger; ++i) __builtin_amdgcn_s_sleep(127); }
    pg8::gemm_phase<Epi, Order, MK_ALIGN, (FP8 ? MK_SP2_F8 : MK_SP2), VARNT, NSEG, FP8>(lds, K, S, E, wid); }

__global__ void __launch_bounds__(NTHREADS, 2) mk_fwd(Args a) {
    extern __shared__ __attribute__((aligned(16))) unsigned char lds_raw[];
    LAS unsigned char* lds = (LAS unsigned char*)lds_raw;
    const int wid = __builtin_amdgcn_readfirstlane((int)threadIdx.x >> 6);
    LAS unsigned* cblk = (LAS unsigned*)(lds + LDS_MISC);
    { const int tid = threadIdx.x;
      if (tid < 4) cblk[tid] = (tid == 2) ? xb_xcc_id() : 0u;
      if (tid < 46) { const unsigned long long pv = (tid < 42) ? (unsigned long long)a.in[tid >> 1] : (tid < 44) ? (unsigned long long)a.out : (unsigned long long)a.ws; cblk[4 + tid] = (tid & 1) ? (unsigned)(pv >> 32) : (unsigned)pv; }
      if (tid == 46) cblk[50] = (unsigned)a.lo; if (tid == 47) cblk[51] = (unsigned)a.hi; }
    __syncthreads();
#define CW(i) cw_(cblk, (i))
typedef __attribute__((address_space(1))) unsigned char gu8_t;
#define ARGP(i) ((unsigned char*)(gu8_t*)(((unsigned long long)(unsigned)CW(5 + 2 * (i)) << 32) | (unsigned long long)(unsigned)CW(4 + 2 * (i))))
#define IN(i) ((const float*)ARGP(i))
#define OUTP ((float*)ARGP(21))
#define WSP (ARGP(22))
#define GSZ ((int)gridDim.x)
#define WGI ((int)blockIdx.x)
    if (CW(51) - CW(50) > 1 && threadIdx.x == 0) (void)xb_add((unsigned*)(WSP + WS_CTL + CW_BAR) + XB_XCNT(CW(2)), 1u);
#ifndef PROBE_REP
#define PROBE_REP 0ull
#endif
#define RUN(k) (CW(50) <= (k) && (k) < CW(51))
#define NREP(bit) (((PROBE_REP >> (bit)) & 1ull) ? 2 : 1)
#ifndef STAMP_MODE
#define STAMP_MODE 0
#endif
#ifndef STAMP_WG
#define STAMP_WG 0
#endif
#ifdef MK_STAMP
#define STAMP(i) do { if (blockIdx.x == STAMP_WG && threadIdx.x == 0) ((unsigned long long*)(WSP + WS_CTL + 32768))[i] = __builtin_amdgcn_s_memrealtime(); } while (0)
#else
#define STAMP(i) do { } while (0)
#endif
#define SEAM(k) do { if (CW(50) <= (k) && (k) + 1 < CW(51)) { XcdBarrier bar_; bar_.bar = (unsigned*)(WSP + WS_CTL + CW_BAR); bar_.x = (unsigned)CW(2); bar_.st = (volatile LAS unsigned*)cblk; xcd_barrier(bar_); if (PROBE_REP & (1ull << 40)) xcd_barrier(bar_); STAMP((k) + 1); } } while (0)

#define R16 ((bf16_t*)OUTP)
#define R16B ((bf16_t*)(WSP + WS_MHID + (size_t)MOE_MAXBLK * 256 * DFF))
#define WIN ((bf16_t*)(WSP + WS_WIN))
#define WBR ((bf16_t*)(WSP + WS_WBR))
#define WOUT ((bf16_t*)(WSP + WS_WOUT))
#define WGU ((bf16_t*)(WSP + WS_WGU))
#define WDN ((bf16_t*)(WSP + WS_WD))
#define XNB ((bf16_t*)(WSP + WS_XN))
#define PBUF ((bf16_t*)(WSP + WS_P))
#define GBUF ((bf16_t*)(WSP + WS_G))
#define HIDB ((bf16_t*)(WSP + WS_HID))
#define OCATB ((bf16_t*)(WSP + WS_OCAT))
#define MWGU ((bf16_t*)(WSP + WS_MWGU))
#define MWDN ((bf16_t*)(WSP + WS_MWD))
#define XSB ((bf16_t*)(WSP + WS_XS))
#define MHIDB ((bf16_t*)(WSP + WS_MHID))
#define LBB ((float*)(WSP + WS_LB))
#define METAB ((int*)(WSP + WS_META))
#define TOKE ((int*)(WSP + WS_TOKE))
#define TOKW ((float2*)(WSP + WS_TOKW))
#define STOK ((int*)(WSP + WS_SLOTTOK))
#define SWB ((float*)(WSP + WS_SLOTW))
#define BLKE ((int*)(WSP + WS_BLKE))
#define SLABB ((bf16_t*)(WSP + WS_SLAB))
#define HDUMP ((uint2*)(WSP + WS_ORAW))
#define HU ((bf16_t*)(WSP + WS_ORAW + HG_DUMP_BYTES))
#define HDSC ((float*)(WSP + WS_ORAW + HG_DUMP_BYTES + HG_U_BYTES))
#define TIDV (wid * 64 + LANEID)
    STAMP(0);
    for (int rep_ = 0; rep_ < NREP(0); ++rep_) if (RUN(0)) {
        LAS float* tile = (LAS float*)lds; const int tid = TIDV;
#pragma unroll 1
        for (int j = 0; j < 13; ++j) {
            const float* src; bf16_t* dst; int K, N, mode = 0, perm = 1, f8 = 0;
            if (j < 10) { const int l = j / 5, r = j % 5;
                if (r == 0) { src = IN(2) + (size_t)l * D * INCOLS; dst = WIN + (size_t)l * INCOLS * D; K = D; N = INCOLS;  f8 = (L1_F8 && l == 1) ? 1 : 0; }
                else if (r < 4) { src = IN(10) + (size_t)(l * 3 + r - 1) * 512 * D; dst = WBR + (size_t)(l * 3 + r - 1) * D * 512; K = 512; N = D; }
                else { src = IN(11) + (size_t)l * D * D; dst = WOUT + (size_t)l * D * D; K = D; N = D; } }
            else if (j == 10) { src = IN(13); dst = WGU; K = D; N = DFF; mode = 1; }
            else if (j == 11) { src = IN(14); dst = WGU; K = D; N = DFF; mode = 2; }
            else { src = IN(15); dst = WDN; K = DFF; N = D; }
            tc_job(src, K, N, dst, mode, perm, tile, WGI, GSZ, tid, (FFN_F8 && j >= 10) ? 1 : f8);
        }
        if (WGI == 0) { const float a0 = IN(3)[tid], a1 = IN(3)[512 + tid]; LBB[tid] = 0.f; LBB[512 + tid] = sigmoidf_(a1 - a0); }
    }
    if (RUN(0)) { __syncthreads(); phase_rmsnorm<false, false, false>(IN(0), IN(1), XNB, nullptr, nullptr, nullptr, nullptr, WGI, GSZ, wid, LANEID); }
    SEAM(0);

    for (int l = 0; l < 2; ++l) {
        const int sb = l * 10;
        if (l == 1) { for (int rep_ = 0; rep_ < NREP(1); ++rep_) if (RUN(10)) phase_rmsnorm<false, L1_F8>(R16, IN(1) + D, XNB, nullptr, nullptr, nullptr, nullptr, WGI, GSZ, wid, LANEID); SEAM(10); }
        for (int rep_ = 0; rep_ < NREP(2); ++rep_) if (RUN(sb + 1)) { EpiAct E{PBUF, PCOLS, LBB + l * 512, 1};
            if (!L1_F8 || l == 0) { Order S; S.init(XNB, WIN + (size_t)l * INCOLS * D, MTOK, PCOLS, D, GSZ, WGI); run_gemm(lds, S, D, E, wid, STAG_IN); }
            else { Order S; S.init(XNB, WIN + (size_t)l * INCOLS * D, MTOK, PCOLS, D, GSZ, WGI, 0, 0, 0, nullptr, 0, 1); run_gemm<EpiAct, false, 1, true>(lds, S, D, E, wid); } }
        SEAM(sb + 1);
        for (int rep_ = 0; rep_ < NREP(3); ++rep_) if (RUN(sb + 2)) {
            if (l == 0 && STAMP_MODE == 0) STAMP(26);
            for (int r2 = 0; r2 < NREP(13); ++r2) { phase_hgrn_a(PBUF, OCATB, HDUMP, HU, HDSC, lds, WGI, GSZ, TIDV, wid, LANEID);
            __syncthreads(); }
            if (l == 0 && STAMP_MODE == 0) STAMP(27);
            for (int r2 = 0; r2 < NREP(14); ++r2) { phase_attn(PBUF, IN(8) + l * 64, IN(9) + l * 64, OCATB + (size_t)2 * MTOK * 512, lds, WGI, GSZ, TIDV, wid, LANEID);
            __syncthreads(); }
            if (l == 0 && STAMP_MODE == 0) STAMP(28);
            for (int r2 = 0; r2 < NREP(15); ++r2) { phase_gmlp(PBUF, IN(6) + (size_t)l * 4 * 16384, IN(7) + l * 512, IN(5) + l * 512, OCATB + (size_t)MTOK * 512, lds, WGI, GSZ, TIDV, wid, LANEID); __syncthreads(); }
        }
        if (l == 0 && STAMP_MODE == 0) STAMP(29);
        SEAM(sb + 2);
        if (RUN(sb + 3)) phase_hgrn_c(PBUF, OCATB, HDUMP, HU, HDSC, IN(4) + l * 128, lds, WGI, GSZ, TIDV, wid, LANEID, (STAMP_MODE == 1 && l == 0 && WGI == STAMP_WG) ? (unsigned long long*)(WSP + WS_CTL + 32768) : nullptr);
        SEAM(sb + 3);
        for (int rep_ = 0; rep_ < NREP(4); ++rep_) if (RUN(sb + 4)) { EpiAct E{GBUF, GCOLS, nullptr, 0};
            if (!L1_F8 || l == 0) { Order S; S.init(XNB, WIN + (size_t)l * INCOLS * D + (size_t)PCOLS * D, MTOK, GCOLS, D, GSZ, WGI); run_gemm(lds, S, D, E, wid, STAG_G); }
            else { Order S; S.init(XNB, (const unsigned char*)(WIN + (size_t)l * INCOLS * D) + (size_t)PCOLS * D, MTOK, GCOLS, D, GSZ, WGI, 0, 0, 0, nullptr, 0, 1); run_gemm<EpiAct, false, 1, true>(lds, S, D, E, wid); } }
        SEAM(sb + 4);
        for (int rep_ = 0; rep_ < NREP(12); ++rep_) if (RUN(sb + 5)) { Order S; S.init(OCATB, WBR + (size_t)l * 3 * D * 512, MTOK, GCOLS, 512, GSZ, WGI, 4, (size_t)MTOK * 512 * 2, (size_t)D * 512 * 2); EpiBranchSeg E{GBUF, XNB}; run_gemm<EpiBranchSeg, false, 3>(lds, S, 512, E, wid); }
        SEAM(sb + 5);
        if (RUN(sb + 6)) { Order S; S.init(XNB, WOUT + (size_t)l * D * D, MTOK, D, D, GSZ, WGI);
            if (l == 0) { EpiResidT<true> E{IN(0), R16}; run_gemm(lds, S, D, E, wid); } else { EpiResidT<false> E{R16, R16}; run_gemm(lds, S, D, E, wid); } }
        SEAM(sb + 6);
        if (l == 0) {
            for (int rep_ = 0; rep_ < NREP(6); ++rep_) if (RUN(7)) phase_rmsnorm<false, FFN_F8>(R16, IN(12), XNB, nullptr, nullptr, nullptr, nullptr, WGI, GSZ, wid, LANEID);
            SEAM(7);
            for (int rep_ = 0; rep_ < NREP(7); ++rep_) if (RUN(8)) { Order S; S.init(XNB, WGU, MTOK, 2 * DFF, D, GSZ, WGI, 0, 0, 0, nullptr, 0, FFN_F8 ? 1 : 2); EpiGUT<FFN_F8> E{HIDB}; run_gemm<EpiGUT<FFN_F8>, false, 1, FFN_F8>(lds, S, D, E, wid, STAG_GU); }
            SEAM(8);
            if (RUN(9)) { Order S; S.init(HIDB, WDN, MTOK, D, DFF, GSZ, WGI, 0, 0, 0, nullptr, 0, FFN_F8 ? 1 : 2); EpiResidT<false> E{R16, R16}; run_gemm<EpiResidT<false>, false, 1, FFN_F8>(lds, S, DFF, E, wid); }
            SEAM(9);
        } else {
            for (int rep_ = 0; rep_ < NREP(8); ++rep_) if (RUN(17)) phase_rmsnorm<true>(R16, IN(12) + D, XNB, IN(16), IN(17), TOKE, TOKW, WGI, GSZ, wid, LANEID);
            SEAM(17);
            for (int rep_ = 0; rep_ < NREP(9); ++rep_) if (RUN(18)) {
                if (WGI >= GSZ - 4) moe_assign(TOKE, TOKW, METAB, STOK, SWB, BLKE, lds, TIDV, WGI - (GSZ - 4));
                else { LAS float* tile = (LAS float*)lds; const int tid = TIDV;
#pragma unroll 1
                    for (int j = 0; j < 3 * NEXP; ++j) { const int e = j / 3, r = j % 3;
                        const float* src = (r == 0 ? IN(18) : r == 1 ? IN(19) : IN(20)) + (size_t)e * D * DFF;
                        bf16_t* dst = (bf16_t*)((r == 2) ? (unsigned char*)MWDN + (size_t)e * D * DFF : (unsigned char*)MWGU + (size_t)e * 2 * DFF * D);
                        tc_job_w(src, r == 2 ? DFF : D, r == 2 ? D : DFF, dst, r == 2 ? 0 : r + 1, 1, tile, WGI, GSZ - 4, wid, LANEID, 1); } }
            }
            SEAM(18);
#define META(i) __hip_atomic_load(METAB + (i), __ATOMIC_RELAXED, __HIP_MEMORY_SCOPE_AGENT)
#define MOE_BMAP(rows_, s0_) do { LAS int* bl_ = (LAS int*)(lds + 131072); const int nb_ = (rows_) >> 8; for (int i_ = TIDV; i_ < nb_; i_ += NTHREADS) bl_[i_] = __hip_atomic_load(BLKE + ((s0_) >> 8) + i_, __ATOMIC_RELAXED, __HIP_MEMORY_SCOPE_AGENT); __syncthreads(); } while (0)
            if (RUN(19)) { const int rows = META(0), s0 = META(2); moe_gather((const unsigned char*)XNB, STOK + s0, rows, (unsigned char*)XSB, WGI, GSZ, wid, LANEID); }
            SEAM(19);
            for (int kc = 0; kc < 2; ++kc) {
                const int se = 20 + 2 * kc;
                for (int rep_ = 0; rep_ < NREP(11); ++rep_) if (RUN(se)) { const int rows = META(kc), s0 = META(2 + kc);
                    if (kc == 1) { const int rows0 = META(0), s00 = META(2); Order T; T.init(MHIDB, MWDN, rows0, D, DFF, GSZ, WGI, 2, 0, (size_t)D * DFF, BLKE + (s00 >> 8), 1, 1);
                        moe_tail_reduce(T, SLABB, R16, R16B, 0, STOK + s00, SWB + s00, WGI, GSZ, wid, LANEID); }
                    MOE_BMAP(rows, s0); Order S; S.init(XSB, MWGU, rows, 2 * DFF, D, GSZ, WGI, 2, 0, (size_t)2 * DFF * D, BLKE + (s0 >> 8), 0, 1); S.bmapl = (const LAS int*)(lds + 131072); EpiGUT<true> E{MHIDB}; run_gemm<EpiGUT<true>, false, 1, true>(lds, S, D, E, wid, STAG_MGU); }
                SEAM(se);
                if (RUN(se + 1)) { const int rows = META(kc), s0 = META(2 + kc);
                    MOE_BMAP(rows, s0); Order S; S.init(MHIDB, MWDN, rows, D, DFF, GSZ, WGI, 2, 0, (size_t)D * DFF, BLKE + (s0 >> 8), 1, 1); S.bmapl = (const LAS int*)(lds + 131072); EpiMoeDown E{kc == 0 ? R16 : R16B, kc == 0 ? (void*)R16B : (void*)OUTP, kc, STOK + s0, SWB + s0, SLABB}; run_gemm<EpiMoeDown, true, 1, true>(lds, S, DFF, E, wid);
                    if (kc == 0) { const int rows1 = META(1), s1 = META(3); moe_gather((const unsigned char*)XNB, STOK + s1, rows1, (unsigned char*)XSB, WGI, GSZ, wid, LANEID); } }
                SEAM(se + 1);
            }
            if (RUN(24)) { const int rows1 = META(1), s1 = META(3); Order T; T.init(MHIDB, MWDN, rows1, D, DFF, GSZ, WGI, 2, 0, (size_t)D * DFF, BLKE + (s1 >> 8), 1, 1);
                moe_tail_reduce(T, SLABB, R16B, OUTP, 1, STOK + s1, SWB + s1, WGI, GSZ, wid, LANEID); }
        }
    }
#ifdef MK_STAMP
    { XcdBarrier bar_; bar_.bar = (unsigned*)(WSP + WS_CTL + CW_BAR); bar_.x = (unsigned)CW(2); bar_.st = (volatile LAS unsigned*)cblk; xcd_barrier(bar_); }
    if (blockIdx.x == STAMP_WG && threadIdx.x == 0) { unsigned long long* T = (unsigned long long*)(WSP + WS_CTL + 32768); const unsigned long long tend = __builtin_amdgcn_s_memrealtime(); T[30] = tend; T[25] = tend;
        unsigned long long va = 0, vb = 0;
        for (int s = 0; s < 30; ++s) { const unsigned long long d = T[s + 1] - T[s]; if ((STAMP_SETA >> s) & 1) va += d; if ((STAMP_SETB >> s) & 1) vb += d; }
        unsigned long long qa = (va + 250) / 500, qb = (vb + 250) / 500; qa = qa > 63 ? 63 : qa; qb = qb > 63 ? 63 : qb;
        const unsigned long long wait = (qa + 64 * qb) * 10000ull;
        while (__builtin_amdgcn_s_memrealtime() - tend < wait) __builtin_amdgcn_s_sleep(100); }
#endif
}

extern "C" void kernel_launch(void* const* d_in, const int* in_sizes, int n_in, void* d_out, int out_size, void* d_ws, size_t ws_size, hipStream_t stream) {
    static int grid = 0;
    if (grid == 0) {
        if (n_in != 21 || out_size != MTOK * D || ws_size < WS_NEED) { fprintf(stderr, "kernel_launch: unexpected shapes (n_in %d out %d ws %zu need %zu)\n", n_in, out_size, ws_size, (size_t)WS_NEED); grid = -1; return; }
        int dev = 0, cus = 0, per_cu = 0;
        if (hipGetDevice(&dev) != hipSuccess || hipDeviceGetAttribute(&cus, hipDeviceAttributeMultiprocessorCount, dev) != hipSuccess) { grid = -1; return; }
        if (hipFuncSetAttribute((const void*)mk_fwd, hipFuncAttributeMaxDynamicSharedMemorySize, LDS_BYTES) != hipSuccess) { fprintf(stderr, "kernel_launch: hipFuncSetAttribute failed\n"); grid = -1; return; }
        if (hipOccupancyMaxActiveBlocksPerMultiprocessor(&per_cu, (const void*)mk_fwd, NTHREADS, LDS_BYTES) != hipSuccess || per_cu < 1) { fprintf(stderr, "kernel_launch: occupancy query says %d\n", per_cu); (void)hipGetLastError(); per_cu = 1; }
        grid = cus;
    }
    if (grid < 0) return;
    (void)hipMemsetAsync((char*)d_ws + WS_CTL, 0, CTL_BYTES, stream);
    Args a{};
    for (int i = 0; i < 21; ++i) a.in[i] = (const float*)d_in[i];
    a.out = (float*)d_out; a.ws = (unsigned char*)d_ws;
#if defined(MK_CHECK)
    {
        unsigned char* ws = (unsigned char*)d_ws; unsigned* diag = (unsigned*)(ws + WS_DIAG); float* snap = (float*)(ws + WS_SNAP);
        const bf16_t* XN = (const bf16_t*)(ws + WS_XN); const bf16_t* Pb = (const bf16_t*)(ws + WS_P); const bf16_t* OC = (const bf16_t*)(ws + WS_OCAT); const float* LB = (const float*)(ws + WS_LB);
        auto run = [&](int s) { a.lo = s; a.hi = s + 1; hipLaunchKernelGGL(mk_fwd, dim3(grid), dim3(NTHREADS), LDS_BYTES, stream, a); };
        hipLaunchKernelGGL(k_diag_init, dim3(1), dim3(64), 0, stream, diag);
        int s = 0; run(s++);
        for (int l = 0; l < 2; ++l) {
            const unsigned cb = l * 10;
            const float* win = a.in[2] + (size_t)l * D * INCOLS;
            if (l == 1) run(s++);
            run(s++);
            { ChkGemm c{}; c.A = XN; c.lda = D; c.W = win; c.ldw = INCOLS; c.K = D; c.mode = 0; c.Cb = Pb; c.ldc = PCOLS; c.lb = LB + l * 512; c.ncols = PCOLS; c.code = cb + 1; hipLaunchKernelGGL(k_chk_gemm, dim3(64), dim3(96), 0, stream, c, diag); }
            run(s++); run(s++);
            hipLaunchKernelGGL(k_chk_hgrn, dim3(128), dim3(128), 0, stream, Pb, a.in[4] + l * 128, OC, cb + 2, diag);
            hipLaunchKernelGGL(k_chk_gmlp, dim3(8), dim3(64), 0, stream, Pb, a.in[6] + (size_t)l * 4 * 16384, a.in[7] + l * 512, a.in[5] + l * 512, OC + (size_t)MTOK * 512, cb + 3, diag);
            hipLaunchKernelGGL(k_chk_attn, dim3(320), dim3(64), 0, stream, Pb, a.in[8] + l * 64, a.in[9] + l * 64, OC + (size_t)2 * MTOK * 512, cb + 4, diag);
            run(s++);
            { ChkGemm c{}; c.A = XN; c.lda = D; c.W = win + PCOLS; c.ldw = INCOLS; c.K = D; c.mode = 1; c.Cb = (const bf16_t*)(ws + WS_G); c.ldc = GCOLS; c.ncols = GCOLS; c.code = cb + 5; hipLaunchKernelGGL(k_chk_gemm, dim3(64), dim3(96), 0, stream, c, diag); }
            run(s++);
            hipLaunchKernelGGL(k_chk_mix, dim3(64), dim3(96), 0, stream, OC, a.in[10] + (size_t)l * 3 * 512 * D, (const bf16_t*)(ws + WS_G), XN, cb + 6, diag);
            if (l == 1) hipLaunchKernelGGL(k_snapshot, dim3(64), dim3(256), 0, stream, (const float*)d_out, snap);
            run(s++);
            { ChkGemm c{}; c.A = XN; c.lda = D; c.W = a.in[11] + (size_t)l * D * D; c.ldw = D; c.K = D; c.mode = 3; c.Cf = (const float*)d_out; c.xold = l ? snap : a.in[0]; c.use_snap = l; c.ncols = D; c.code = cb + 7; hipLaunchKernelGGL(k_chk_gemm, dim3(64), dim3(96), 0, stream, c, diag); }
            run(s++);
            if (l == 0) {
                run(s++);
                { ChkGemm c{}; c.A = XN; c.lda = D; c.W = a.in[13]; c.W2 = a.in[14]; c.ldw = DFF; c.K = D; c.mode = 4; c.Cb = (const bf16_t*)(ws + WS_HID); c.ldc = DFF; c.ncols = DFF; c.code = cb + 8; hipLaunchKernelGGL(k_chk_gemm, dim3(64), dim3(96), 0, stream, c, diag); }
                hipLaunchKernelGGL(k_snapshot, dim3(64), dim3(256), 0, stream, (const float*)d_out, snap);
                run(s++);
                { ChkGemm c{}; c.A = (const bf16_t*)(ws + WS_HID); c.lda = DFF; c.W = a.in[15]; c.ldw = D; c.K = DFF; c.mode = 3; c.Cf = (const float*)d_out; c.xold = snap; c.use_snap = 1; c.ncols = D; c.code = cb + 9; hipLaunchKernelGGL(k_chk_gemm, dim3(64), dim3(96), 0, stream, c, diag); }
            } else {
                hipLaunchKernelGGL(k_snapshot, dim3(64), dim3(256), 0, stream, (const float*)d_out, snap);
                for (int e = 0; e < 7; ++e) run(s++);
                hipLaunchKernelGGL(k_chk_moe, dim3(16), dim3(256), 0, stream, XN, a.in[16], a.in[17], a.in[18], a.in[19], a.in[20], (const float*)snap, (const float*)d_out, 20u, diag);
            }
        }
        if (s != NSTEPS) fprintf(stderr, "step count mismatch %d\n", s);
        hipLaunchKernelGGL(k_apply_diag, dim3(1024), dim3(256), 0, stream, (float*)d_out, (const unsigned*)diag);
    }
#elif !defined(MK_ONE_LAUNCH)
    for (int s = 0; s < NSTEPS; ++s) { a.lo = s; a.hi = s + 1; hipLaunchKernelGGL(mk_fwd, dim3(grid), dim3(NTHREADS), LDS_BYTES, stream, a); }
#else
    a.lo = 0; a.hi = NSTEPS; hipLaunchKernelGGL(mk_fwd, dim3(grid), dim3(NTHREADS), LDS_BYTES, stream, a);
#endif
}
```
